# Optimizing an MI355X kernel written in HIP

```python
import math
import jax, jax.numpy as jnp
from jax import lax
import numpy as np


D_MODEL = 1024
BATCH = 4
SEQ = 8192
DEPTH = 4

GRID_W = 64
CTX_LEN = 256
N_MIXERS = 3
N_LAYERS_A = (DEPTH + 2) // 3
N_LAYERS_B = (DEPTH + 1) // 3
N_LAYERS_C = DEPTH // 3
EPS = 1e-6
ROPE_BASE = 10000.0
Q_BLOCK = 128
N_MOD = 6

MLA_HEADS = 16
MLA_Q_RANK = 256
MLA_KV_RANK = 256
MLA_NOPE = 64
MLA_ROPE = 32
MLA_V = 64

DIFF_HEAD_DIM = 64
DIFF_HEADS = D_MODEL // (2 * DIFF_HEAD_DIM)

GLA_HEADS = 4
GLA_DK = D_MODEL // 2
GLA_DV = D_MODEL
GLA_GATE_RANK = 16
GLA_GATE_NORM = 16.0
GLA_CHUNK = 64

MOE_GROUPS = 4
MOE_EXPERTS = 4
MOE_TOP_K = 2
MOE_D_EXPERT = 512

kernel_name = 'hybrid_mla_diff_gla_hmoe_prefix_dit'


def rms_norm(x, gain):
    xf = x.astype(jnp.float32)
    xf = xf * lax.rsqrt(jnp.mean(xf * xf, axis=-1, keepdims=True) + EPS)
    return xf.astype(x.dtype) * gain


def modulate(h, shift, scale):
    return h * (1 + scale) + shift


def split_heads(t, n_heads):
    b, n, _ = t.shape
    return t.reshape(b, n, n_heads, -1).transpose(0, 2, 1, 3)


def merge_heads(t):
    b, h, n, d = t.shape
    return t.transpose(0, 2, 1, 3).reshape(b, n, h * d)


def axial_rope_tables(n_rows, rot_dim, dtype):
    row = jnp.repeat(jnp.arange(n_rows, dtype=jnp.float32), GRID_W)
    col = jnp.tile(jnp.arange(GRID_W, dtype=jnp.float32), n_rows)
    n_freq = rot_dim // 4
    inv_freq = ROPE_BASE ** (-jnp.arange(n_freq, dtype=jnp.float32) / n_freq)
    ang = jnp.concatenate([row[:, None] * inv_freq, col[:, None] * inv_freq], axis=-1)
    return jnp.cos(ang).astype(dtype), jnp.sin(ang).astype(dtype)


def apply_rope(t, cos, sin):
    t1, t2 = jnp.split(t, 2, axis=-1)
    return jnp.concatenate([t1 * cos - t2 * sin, t1 * sin + t2 * cos], axis=-1)


def to_blocks(t):
    b, h, n = t.shape[:3]
    t = t.reshape(b, h, n // Q_BLOCK, Q_BLOCK, *t.shape[3:])
    return jnp.moveaxis(t, 2, 0)


def from_blocks(t):
    t = jnp.moveaxis(t, 0, 2)
    return t.reshape(t.shape[0], t.shape[1], -1, t.shape[-1])


def mla_mixer(hc, hl, cos, sin, w_dqkv, q_norm, w_uq, kv_norm, w_ukv, w_o, ctx_out):
    scale = (MLA_NOPE + MLA_ROPE) ** -0.5

    def down(h):
        return jnp.split(h @ w_dqkv, [MLA_Q_RANK, MLA_Q_RANK + MLA_KV_RANK], axis=-1)

    def queries(cq):
        q = split_heads(rms_norm(cq, q_norm) @ w_uq, MLA_HEADS)
        return jnp.split(q, [MLA_NOPE], axis=-1)

    def keys_values(ckv):
        kv = split_heads(rms_norm(ckv, kv_norm) @ w_ukv, MLA_HEADS)
        return jnp.split(kv, [MLA_NOPE], axis=-1)

    def attend(q_nope, q_pe, k_nope, k_pe, v):
        s = jnp.einsum('bhqd,bhkd->bhqk', q_nope, k_nope) + jnp.einsum('bhqr,bkr->bhqk', q_pe, k_pe)
        p = jax.nn.softmax(s.astype(jnp.float32) * scale, axis=-1).astype(v.dtype)
        return jnp.einsum('bhqk,bhkd->bhqd', p, v)

    cq_c, ckv_c, kpe_c = down(hc)
    cq_l, ckv_l, kpe_l = down(hl)
    kn_c, v_c = keys_values(ckv_c)
    kn_l, v_l = keys_values(ckv_l)
    qn_l, qpe_l = queries(cq_l)
    qpe_l = apply_rope(qpe_l, cos, sin)
    kpe_l = apply_rope(kpe_l, cos, sin)
    kn_all = jnp.concatenate([kn_c, kn_l], axis=2)
    kpe_all = jnp.concatenate([kpe_c, kpe_l], axis=1)
    v_all = jnp.concatenate([v_c, v_l], axis=2)
    o_l = from_blocks(lax.map(lambda qb: attend(qb[0], qb[1], kn_all, kpe_all, v_all),
                              (to_blocks(qn_l), to_blocks(qpe_l))))
    y_l = merge_heads(o_l) @ w_o
    if not ctx_out:
        return None, y_l
    qn_c, qpe_c = queries(cq_c)
    y_c = merge_heads(attend(qn_c, qpe_c, kn_c, kpe_c, v_c)) @ w_o
    return y_c, y_l


def diff_mixer(hc, hl, cos, sin, w_qkv, lam, subln, w_o, lam_init, ctx_out):
    scale = DIFF_HEAD_DIM ** -0.5
    lam_full = (jnp.exp(jnp.sum(lam[0] * lam[1], dtype=jnp.float32))
                - jnp.exp(jnp.sum(lam[2] * lam[3], dtype=jnp.float32)) + lam_init)

    def project(h):
        b, n, _ = h.shape
        q, k, v = jnp.split(h @ w_qkv, 3, axis=-1)
        q = q.reshape(b, n, DIFF_HEADS, 2, DIFF_HEAD_DIM).transpose(0, 2, 1, 3, 4)
        k = k.reshape(b, n, DIFF_HEADS, 2, DIFF_HEAD_DIM).transpose(0, 2, 1, 3, 4)
        return q, k, split_heads(v, DIFF_HEADS)

    def attend(q, k, v):
        s = jnp.einsum('bhqsd,bhksd->bhsqk', q, k)
        p = jax.nn.softmax(s.astype(jnp.float32) * scale, axis=-1)
        a = (p[:, :, 0] - lam_full * p[:, :, 1]).astype(v.dtype)
        return jnp.einsum('bhqk,bhkd->bhqd', a, v)

    def out(o):
        return merge_heads(rms_norm(o, subln) * (1.0 - lam_init)) @ w_o

    q_c, k_c, v_c = project(hc)
    q_l, k_l, v_l = project(hl)
    rc, rs = cos[:, None, :], sin[:, None, :]
    q_l = apply_rope(q_l, rc, rs)
    k_l = apply_rope(k_l, rc, rs)
    k_all = jnp.concatenate([k_c, k_l], axis=2)
    v_all = jnp.concatenate([v_c, v_l], axis=2)
    o_l = from_blocks(lax.map(lambda qb: attend(qb, k_all, v_all), to_blocks(q_l)))
    y_l = out(o_l)
    if not ctx_out:
        return None, y_l
    return out(attend(q_c, k_c, v_c)), y_l


def gla_scan_chunked(q, k, v, log_a, s0, with_output):
    b, h, n, dk = q.shape
    dv = v.shape[-1]
    nc = n // GLA_CHUNK
    chunk = lambda t: t.reshape(b, h, nc, GLA_CHUNK, t.shape[-1])
    qc, kc, vc = chunk(q), chunk(k), chunk(v)
    cum = jnp.cumsum(chunk(log_a), axis=3)
    cum_last = cum[:, :, :, -1:, :]
    chunk_kv = jnp.einsum('bhcsk,bhcsv->bhckv', kc * jnp.exp(cum_last - cum), vc)
    decay = jnp.exp(cum_last[:, :, :, 0, :])

    def step(state, inp):
        dec, kv = inp
        return dec[..., None] * state + kv, (state if with_output else None)

    s_final, s_start = lax.scan(step, s0, (jnp.moveaxis(decay, 2, 0), jnp.moveaxis(chunk_kv, 2, 0)))
    if not with_output:
        return None, s_final
    s_start = jnp.moveaxis(s_start, 0, 2)
    q_dec = qc * jnp.exp(cum)
    k_inv = kc * jnp.exp(-cum)
    lower_tri = jnp.tril(jnp.ones((GLA_CHUNK, GLA_CHUNK), dtype=bool))
    att = jnp.where(lower_tri, jnp.einsum('bhcqk,bhcsk->bhcqs', q_dec, k_inv), 0.0)
    o = (jnp.einsum('bhcqk,bhckv->bhcqv', q_dec, s_start)
         + jnp.einsum('bhcqs,bhcsv->bhcqv', att, vc))
    return o.reshape(b, h, n, dv), s_final


def gla_mixer(hc, hl, w_in, w_gate_up, b_gate, head_norm, w_o, ctx_out):
    splits = [GLA_DK, 2 * GLA_DK, 2 * GLA_DK + GLA_DV, 2 * GLA_DK + 2 * GLA_DV,
              2 * GLA_DK + 2 * GLA_DV + GLA_GATE_RANK]
    dk_h, dv_h = GLA_DK // GLA_HEADS, GLA_DV // GLA_HEADS

    def log_decay(z, d):
        a = jax.nn.log_sigmoid((z @ w_gate_up[d] + b_gate[d]).astype(jnp.float32)) / GLA_GATE_NORM
        return split_heads(a, GLA_HEADS)

    def project(h):
        q, k, v, g, zf, zb = jnp.split(h @ w_in, splits, axis=-1)
        q = split_heads(q, GLA_HEADS) * dk_h ** -0.5
        return (q, split_heads(k, GLA_HEADS), split_heads(v, GLA_HEADS), g,
                log_decay(zf, 0), log_decay(zb, 1))

    flip = lambda t: jnp.flip(t, axis=2)

    def out(o, g):
        return (merge_heads(rms_norm(o.astype(g.dtype), head_norm)) * jax.nn.silu(g)) @ w_o

    q_c, k_c, v_c, g_c, af_c, ab_c = project(hc)
    q_l, k_l, v_l, g_l, af_l, ab_l = project(hl)
    zeros = jnp.zeros((hc.shape[0], GLA_HEADS, dk_h, dv_h), jnp.float32)
    o_cf, s_f = gla_scan_chunked(q_c, k_c, v_c, af_c, zeros, ctx_out)
    o_cb, s_b = gla_scan_chunked(flip(q_c), flip(k_c), flip(v_c), flip(ab_c), zeros, ctx_out)
    o_lf, _ = gla_scan_chunked(q_l, k_l, v_l, af_l, s_f, True)
    o_lb, _ = gla_scan_chunked(flip(q_l), flip(k_l), flip(v_l), flip(ab_l), s_b, True)
    y_l = out(o_lf + flip(o_lb), g_l)
    if not ctx_out:
        return None, y_l
    return out(o_cf + flip(o_cb), g_c), y_l


def hier_moe(h, w_group, b_group, w_router, b_router, w_gate, w_up, w_down):
    grp_logits = (h @ w_group + b_group).astype(jnp.float32)
    grp_prob = jax.nn.softmax(grp_logits, axis=-1)
    grp_onehot = jax.nn.one_hot(jnp.argmax(grp_logits, axis=-1), MOE_GROUPS, dtype=jnp.float32)
    grp_w = jnp.sum(grp_prob * grp_onehot, axis=-1, keepdims=True)
    exp_logits = jnp.einsum('bnd,gde->bnge', h, w_router) + b_router
    exp_logits = jnp.einsum('bnge,bng->bne', exp_logits.astype(jnp.float32), grp_onehot)
    top_val, top_idx = lax.top_k(exp_logits, MOE_TOP_K)
    top_w = jax.nn.softmax(top_val, axis=-1) * grp_w
    exp_gate = jnp.einsum('bnk,bnke->bne', top_w, jax.nn.one_hot(top_idx, MOE_EXPERTS, dtype=jnp.float32))
    gate = (grp_onehot[..., None] * exp_gate[..., None, :]).astype(h.dtype)
    y = jnp.zeros_like(h)
    for gi in range(MOE_GROUPS):
        a = jnp.einsum('bnd,edf->bnef', h, w_gate[gi])
        u = jnp.einsum('bnd,edf->bnef', h, w_up[gi])
        y = y + jnp.einsum('bnef,efd->bnd', jax.nn.silu(a) * u * gate[:, :, gi, :, None], w_down[gi])
    return y


def setup_inputs(seed: int = 0) -> dict:
    key = jax.random.key(seed)
    ks = iter(jax.random.split(key, 40))
    f32 = jnp.float32
    D = D_MODEL

    def w(shape, fan_in, mult=1.0):
        return jax.random.normal(next(ks), shape, f32) * (mult * fan_in ** -0.5)

    def gain(shape):
        return 1.0 + 0.05 * jax.random.normal(next(ks), shape, f32)

    def bias(shape, s=0.02):
        return s * jax.random.normal(next(ks), shape, f32)

    return {
        'x': jax.random.normal(next(ks), (BATCH, SEQ, D), f32),
        'c': jax.random.normal(next(ks), (BATCH, D), f32),
        'ctx': jax.random.normal(next(ks), (BATCH, CTX_LEN, D), f32),
        'c_ctx': jax.random.normal(next(ks), (D,), f32),
        'w_ada': w((DEPTH, D, N_MOD * D), D, 0.5),
        'b_ada': bias((DEPTH, N_MOD * D)),
        'norm_mix': gain((DEPTH, D)),
        'norm_ffn': gain((DEPTH, D)),
        'mla_w_dqkv': w((N_LAYERS_A, D, MLA_Q_RANK + MLA_KV_RANK + MLA_ROPE), D),
        'mla_q_norm': gain((N_LAYERS_A, MLA_Q_RANK)),
        'mla_w_uq': w((N_LAYERS_A, MLA_Q_RANK, MLA_HEADS * (MLA_NOPE + MLA_ROPE)), MLA_Q_RANK),
        'mla_kv_norm': gain((N_LAYERS_A, MLA_KV_RANK)),
        'mla_w_ukv': w((N_LAYERS_A, MLA_KV_RANK, MLA_HEADS * (MLA_NOPE + MLA_V)), MLA_KV_RANK),
        'mla_w_o': w((N_LAYERS_A, MLA_HEADS * MLA_V, D), MLA_HEADS * MLA_V),
        'diff_w_qkv': w((N_LAYERS_B, D, 3 * D), D),
        'diff_lambda': bias((N_LAYERS_B, 4, DIFF_HEAD_DIM), 0.1),
        'diff_subln': gain((N_LAYERS_B, 2 * DIFF_HEAD_DIM)),
        'diff_w_o': w((N_LAYERS_B, D, D), D),
        'gla_w_in': w((N_LAYERS_C, D, 2 * GLA_DK + 2 * GLA_DV + 2 * GLA_GATE_RANK), D),
        'gla_w_gate_up': w((N_LAYERS_C, 2, GLA_GATE_RANK, GLA_DK), GLA_GATE_RANK),
        'gla_b_gate': bias((N_LAYERS_C, 2, GLA_DK), 0.1),
        'gla_head_norm': gain((N_LAYERS_C, GLA_DV // GLA_HEADS)),
        'gla_w_o': w((N_LAYERS_C, GLA_DV, D), GLA_DV),
        'moe_w_group': w((DEPTH, D, MOE_GROUPS), D),
        'moe_b_group': bias((DEPTH, MOE_GROUPS), 0.01),
        'moe_w_router': w((DEPTH, MOE_GROUPS, D, MOE_EXPERTS), D),
        'moe_b_router': bias((DEPTH, MOE_GROUPS, MOE_EXPERTS), 0.01),
        'moe_w_gate': w((DEPTH, MOE_GROUPS, MOE_EXPERTS, D, MOE_D_EXPERT), D),
        'moe_w_up': w((DEPTH, MOE_GROUPS, MOE_EXPERTS, D, MOE_D_EXPERT), D),
        'moe_w_down': w((DEPTH, MOE_GROUPS, MOE_EXPERTS, MOE_D_EXPERT, D), MOE_D_EXPERT),
        'final_norm': gain((D,)),
    }


def reference(x, c, ctx, c_ctx, w_ada, b_ada, norm_mix, norm_ffn,
              mla_w_dqkv, mla_q_norm, mla_w_uq, mla_kv_norm, mla_w_ukv, mla_w_o,
              diff_w_qkv, diff_lambda, diff_subln, diff_w_o,
              gla_w_in, gla_w_gate_up, gla_b_gate, gla_head_norm, gla_w_o,
              moe_w_group, moe_b_group, moe_w_router, moe_b_router,
              moe_w_gate, moe_w_up, moe_w_down, final_norm):
    n_tok = x.shape[1]
    ROWS = n_tok // GRID_W
    cos_a, sin_a = axial_rope_tables(ROWS, MLA_ROPE, x.dtype)
    cos_b, sin_b = axial_rope_tables(ROWS, DIFF_HEAD_DIM, x.dtype)
    n_ctx = ctx.shape[1]
    xl, xc = x, ctx
    for li in range(DEPTH):
        last = li == DEPTH - 1
        mod_l = jnp.split((jax.nn.silu(c) @ w_ada[li] + b_ada[li])[:, None, :], N_MOD, axis=-1)
        mod_c = jnp.split(jax.nn.silu(c_ctx) @ w_ada[li] + b_ada[li], N_MOD, axis=-1)
        hl = modulate(rms_norm(xl, norm_mix[li]), mod_l[0], mod_l[1])
        hc = modulate(rms_norm(xc, norm_mix[li]), mod_c[0], mod_c[1])
        kind, j = li % N_MIXERS, li // N_MIXERS
        if kind == 0:
            yc, yl = mla_mixer(hc, hl, cos_a, sin_a, mla_w_dqkv[j], mla_q_norm[j], mla_w_uq[j],
                               mla_kv_norm[j], mla_w_ukv[j], mla_w_o[j], not last)
        elif kind == 1:
            lam_init = 0.8 - 0.6 * math.exp(-0.3 * li)
            yc, yl = diff_mixer(hc, hl, cos_b, sin_b, diff_w_qkv[j], diff_lambda[j], diff_subln[j],
                                diff_w_o[j], lam_init, not last)
        else:
            yc, yl = gla_mixer(hc, hl, gla_w_in[j], gla_w_gate_up[j], gla_b_gate[j],
                               gla_head_norm[j], gla_w_o[j], not last)
        xl = xl + mod_l[2] * yl
        moe = lambda h: hier_moe(h, moe_w_group[li], moe_b_group[li], moe_w_router[li], moe_b_router[li],
                                 moe_w_gate[li], moe_w_up[li], moe_w_down[li])
        hl = modulate(rms_norm(xl, norm_ffn[li]), mod_l[3], mod_l[4])
        if last:
            xl = xl + mod_l[5] * moe(hl)
        else:
            xc = xc + mod_c[2] * yc
            hc = modulate(rms_norm(xc, norm_ffn[li]), mod_c[3], mod_c[4])
            y = moe(jnp.concatenate([hc, hl], axis=1))
            xc = xc + mod_c[5] * y[:, :n_ctx]
            xl = xl + mod_l[5] * y[:, n_ctx:]
    return rms_norm(xl, final_norm)
```

```cpp
#include <hip/hip_runtime.h>
#include <stdint.h>
#include <stdio.h>

#ifndef MK_PER_PHASE
#define MK_PER_PHASE 0
#endif

typedef unsigned short u16;
using bf16x8 = __attribute__((ext_vector_type(8))) short;
using s16x4  = __attribute__((ext_vector_type(4))) short;
using f32x16 = __attribute__((ext_vector_type(16))) float;
using f32x4  = __attribute__((ext_vector_type(4))) float;
using u32x4  = __attribute__((ext_vector_type(4))) unsigned;
using u32x2  = __attribute__((ext_vector_type(2))) unsigned;

constexpr int DM = 1024, NBATCH = 4, SEQ = 8192, CTXL = 256, DEPTH = 4;
constexpr int NCTX = NBATCH * CTXL;
constexpr int NLAT = NBATCH * SEQ;
constexpr int NTOK = NCTX + NLAT;
constexpr int KEYS = CTXL + SEQ;
constexpr float EPS = 1e-6f;
constexpr int NTHR = 512, NWAVE = 8;
constexpr float LOG2E = 1.4426950408889634f;

constexpr size_t al256(size_t x) { return (x + 255) / 256 * 256; }
constexpr size_t WS_CTL   = 0;
constexpr size_t CTL_BYTES = 32768;
constexpr size_t WS_MODS  = WS_CTL + CTL_BYTES;
constexpr size_t WS_ROPEA = WS_MODS + al256((size_t)DEPTH * 5 * 6144 * 4);
constexpr size_t WS_ROPEB = WS_ROPEA + (size_t)2 * SEQ * 16 * 4;
constexpr size_t WS_XC    = WS_ROPEB + (size_t)2 * SEQ * 32 * 4;
constexpr size_t WS_WDQKV = WS_XC + (size_t)NCTX * DM * 4;
constexpr size_t WS_WUQ   = WS_WDQKV + (size_t)2 * 640 * 1024 * 2;
constexpr size_t WS_WUKV  = WS_WUQ + (size_t)2 * 1536 * 256 * 2;
constexpr size_t WS_WOM   = WS_WUKV + (size_t)2 * 2048 * 256 * 2;
constexpr size_t WS_WQKVD = WS_WOM + (size_t)2 * 1024 * 1024 * 2;
constexpr size_t WS_WOD   = WS_WQKVD + (size_t)3072 * 1024 * 2;
constexpr size_t WS_WING  = WS_WOD + (size_t)1024 * 1024 * 2;
constexpr size_t WS_WOG   = WS_WING + (size_t)3200 * 1024 * 2;
constexpr size_t WS_TOK   = WS_WOG + (size_t)1024 * 1024 * 2;
constexpr size_t WS_ROWTOK= WS_TOK + (size_t)NTOK * 16;
constexpr int    RMAX     = 40960;
constexpr size_t WS_ROWW  = WS_ROWTOK + (size_t)RMAX * 4;
constexpr size_t WS_H     = al256(WS_ROWW + (size_t)RMAX * 8);
constexpr size_t H_BYTES  = (size_t)NTOK * DM * 2;
constexpr size_t WS_MOEW  = WS_H + H_BYTES;
constexpr size_t MOE_WGU_BYTES = (size_t)16 * 1024 * 1024 * 2;
constexpr size_t MOE_WD_BYTES  = (size_t)16 * 1024 * 512 * 2;
constexpr size_t MOEW_BYTES = MOE_WGU_BYTES + MOE_WD_BYTES;
constexpr size_t WS_BIG   = WS_MOEW + MOEW_BYTES;
constexpr size_t MLA_Q    = WS_BIG;
constexpr size_t MLA_KN   = MLA_Q + (size_t)NBATCH * 16 * KEYS * 96 * 2;
constexpr size_t MLA_V    = MLA_KN + (size_t)NBATCH * 16 * KEYS * 64 * 2;
constexpr size_t MLA_KPE  = MLA_V + (size_t)NBATCH * 16 * KEYS * 64 * 2;
constexpr size_t MLA_DQ   = MLA_KPE + al256((size_t)NBATCH * KEYS * 32 * 2);
constexpr size_t MLA_CN   = MLA_DQ + (size_t)NTOK * 544 * 4;
constexpr size_t MLA_END  = MLA_CN + (size_t)NTOK * 512 * 2;
constexpr size_t DF_Q     = WS_BIG;
constexpr size_t DF_K     = DF_Q + (size_t)NBATCH * 16 * KEYS * 64 * 2;
constexpr size_t DF_V     = DF_K + (size_t)NBATCH * 16 * KEYS * 64 * 2;
constexpr size_t DF_OS    = DF_V + (size_t)NBATCH * 8 * KEYS * 128 * 2;
constexpr size_t DF_END   = DF_OS + (size_t)2 * NTOK * DM * 2;
constexpr size_t GL_STATE = WS_MOEW;
constexpr size_t GL_STATE_BYTES = (size_t)NBATCH * 4 * 2 * 132 * 128 * 256 * 2;
constexpr size_t GL_DEC   = GL_STATE + GL_STATE_BYTES;
constexpr size_t GL_Q     = GL_DEC + al256((size_t)4224 * 128 * 4);
constexpr size_t GL_K     = GL_Q + (size_t)NTOK * 512 * 2;
constexpr size_t GL_V     = GL_K + (size_t)NTOK * 512 * 2;
constexpr size_t GL_G     = GL_V + (size_t)NTOK * 1024 * 2;
constexpr size_t GL_Z     = GL_G + (size_t)NTOK * 1024 * 2;
constexpr size_t GL_END   = GL_Z + (size_t)NTOK * 32 * 4;
constexpr size_t MOE_ACT  = WS_BIG;
constexpr size_t MOE_END  = MOE_ACT + (size_t)RMAX * 1024 * 2;
constexpr size_t cmax(size_t a, size_t b) { return a > b ? a : b; }
constexpr size_t WS_END   = cmax(cmax(MLA_END, DF_END), cmax(GL_END, MOE_END));

#define XCD_BAR_WORDS 3456
constexpr int CW_CNT = 4096;

#define XB_TMO      128
#define XB_XCNT(j)  (256  + 64 * (j))
#define XB_XSUB(j)  (1280 + 64 * (j))
#define XB_XGEN(j)  (2304 + 64 * (j))
#define XB_TOP      3328
#define XB_TOPGEN   3392
#define XB_SPIN_CAP (1u << 24)
#define LAS __attribute__((address_space(3)))
__device__ __forceinline__ unsigned xb_ld(unsigned* p)              { return __hip_atomic_load(p, __ATOMIC_RELAXED, __HIP_MEMORY_SCOPE_AGENT); }
__device__ __forceinline__ unsigned xb_add(unsigned* p, unsigned v) { return __hip_atomic_fetch_add(p, v, __ATOMIC_RELAXED, __HIP_MEMORY_SCOPE_AGENT); }
__device__ __forceinline__ unsigned xb_xcc_id() { return (unsigned)__builtin_amdgcn_s_getreg((3 << 11) | 20) & 0xFu; }
#define XB_SPIN(cond, bar) do { unsigned _sp = 0; while (cond) { __builtin_amdgcn_s_sleep(1); \
    if ((++_sp & 255u) == 0u) { if (xb_ld(&(bar)[XB_TMO])) break; if (_sp > XB_SPIN_CAP) { atomicAdd(&(bar)[XB_TMO], 1u); break; } } } } while (0)
struct XcdBarrier { unsigned* bar; unsigned x; volatile LAS unsigned* st; };
__device__ __forceinline__ XcdBarrier xcd_barrier_post(unsigned* bar, volatile LAS unsigned* st) {
    XcdBarrier b; b.bar = bar; b.x = xb_xcc_id(); b.st = st;
    if (threadIdx.x == 0) (void)xb_add(&bar[XB_XCNT(b.x)], 1u);
    return b;
}
__device__ __forceinline__ void xcd_barrier_complete(unsigned* bar, unsigned x, unsigned& nloc, unsigned& nx) {
    const unsigned G = gridDim.x * gridDim.y * gridDim.z;
    unsigned sum, cnt, mine, sp = 0u;
    for (;;) {
        sum = 0u; cnt = 0u; mine = 0u;
#pragma unroll
        for (unsigned j = 0; j < 16; ++j) { const unsigned c = xb_ld(&bar[XB_XCNT(j)]); sum += c; cnt += (c > 0u) ? 1u : 0u; mine = (j == x) ? c : mine; }
        if (sum == G) break;
        __builtin_amdgcn_s_sleep(1);
        if ((++sp & 255u) == 0u) { if (xb_ld(&bar[XB_TMO])) break; if (sp > XB_SPIN_CAP) { atomicAdd(&bar[XB_TMO], 1u); break; } }
    }
    nloc = mine > 0u ? mine : 1u; nx = cnt > 0u ? cnt : 1u;
}
__device__ __forceinline__ void xcd_barrier(const XcdBarrier& b) {
    asm volatile("s_waitcnt vmcnt(0)" ::: "memory");
    __syncthreads();
    if (threadIdx.x == 0) {
        unsigned* bar = b.bar;
        __builtin_amdgcn_s_waitcnt(0);
        unsigned nloc = b.st[0], nx = b.st[1];
        if (nloc == 0u) { xcd_barrier_complete(bar, b.x, nloc, nx); b.st[0] = nloc; b.st[1] = nx; }
        const unsigned old = xb_add(&bar[XB_XSUB(b.x)], 1u);
        const unsigned gen = old / nloc;
        if (old + 1u == (gen + 1u) * nloc) {
            __builtin_amdgcn_fence(__ATOMIC_RELEASE, "agent");
            asm volatile("s_waitcnt vmcnt(0)" ::: "memory");
            const unsigned og = xb_add(&bar[XB_TOP], 1u);
            const unsigned tg = og / nx;
            if (og + 1u == (tg + 1u) * nx) xb_add(&bar[XB_TOPGEN], 1u);
            else XB_SPIN(xb_ld(&bar[XB_TOPGEN]) == tg, bar);
            __builtin_amdgcn_fence(__ATOMIC_ACQUIRE, "agent");
            xb_add(&bar[XB_XGEN(b.x)], 1u);
            asm volatile("s_waitcnt vmcnt(0)" ::: "memory");
        } else {
            XB_SPIN(xb_ld(&bar[XB_XGEN(b.x)]) == gen, bar);
            __builtin_amdgcn_fence(__ATOMIC_ACQUIRE, "agent");
            asm volatile("s_waitcnt vmcnt(0)" ::: "memory");
        }
    }
    __syncthreads();
}

__device__ __forceinline__ u16 f2bf(float f) { unsigned u = __float_as_uint(f); u += 0x7FFFu + ((u >> 16) & 1u); return (u16)(u >> 16); }
__device__ __forceinline__ float bf2f(u16 h) { return __uint_as_float((unsigned)h << 16); }
__device__ __forceinline__ unsigned cvtpk(float lo, float hi) { unsigned r; asm volatile("v_cvt_pk_bf16_f32 %0, %1, %2" : "=v"(r) : "v"(lo), "v"(hi)); return r; }
__device__ __forceinline__ float wave_sum(float v) {
#pragma unroll
    for (int o = 32; o; o >>= 1) v += __shfl_xor(v, o);
    return v;
}
__device__ __forceinline__ int crow(int r, int hi) { return (r & 3) + 8 * (r >> 2) + 4 * hi; }
__device__ __forceinline__ void row_bp(int row, int& b, int& pos) {
    if (row < NCTX) { b = row >> 8; pos = row & 255; } else { const int r = row - NCTX; b = r >> 13; pos = CTXL + (r & (SEQ - 1)); }
}
__device__ __forceinline__ float silu_f(float x) { return x / (1.f + __expf(-x)); }
#define SBAR() __builtin_amdgcn_sched_barrier(0)

struct Params { const float* in[31]; float* out; unsigned char* ws; int ph_lo, ph_hi; };

struct RowsPlain  { const u16* base; long ld;
    __device__ __forceinline__ long off(int r) const { return (long)r * ld; }
    __device__ __forceinline__ const u16* kbase(int kt) const { return base + kt * 64; } };
struct RowsGather { const u16* base; long ld; const int* idx;
    __device__ __forceinline__ long off(int r) const { int t = idx[r]; t = t < 0 ? 0 : t; return (long)t * ld; }
    __device__ __forceinline__ const u16* kbase(int kt) const { return base + kt * 64; } };
struct RowsSplitK { const u16* b0; const u16* b1; long ld; int ks;
    __device__ __forceinline__ long off(int r) const { return (long)r * ld; }
    __device__ __forceinline__ const u16* kbase(int kt) const { return kt < ks ? b0 + kt * 64 : b1 + (kt - ks) * 64; } };

constexpr int GEMM_LDS = 2 * 384 * 128;

template <int WM, int WN, class AL, class BL, class EP>
__device__ __forceinline__ void gemm_tile(char* lds, const AL al, const BL bl, EP& ep, int brow, int bcol, int nk) {
    constexpr int BM = WM * 64, BN = WN * 64, STG = (BM + BN) * 128, NA = BM / 64, NB = BN / 64;
    const int tid = threadIdx.x, lane = tid & 63, wid = __builtin_amdgcn_readfirstlane(tid >> 6);
    const int wm = wid / WN, wn = wid % WN, r32 = lane & 31, hi = lane >> 5;
    long aoff[NA], boff[NB];
#pragma unroll
    for (int i = 0; i < NA; ++i) { const int r = (i * 8 + wid) * 8 + (lane >> 3); const int c = (lane & 7) ^ ((r >> 1) & 7); aoff[i] = al.off(brow + r) + c * 8; }
#pragma unroll
    for (int i = 0; i < NB; ++i) { const int r = (i * 8 + wid) * 8 + (lane >> 3); const int c = (lane & 7) ^ ((r >> 1) & 7); boff[i] = bl.off(bcol + r) + c * 8; }
    const int ldsw = wid * 1024 + lane * 16;
    int abase[2], bbase[2];
#pragma unroll
    for (int i = 0; i < 2; ++i) {
        const int ra = wm * 64 + i * 32 + r32; abase[i] = ra * 128 + ((hi ^ ((ra >> 1) & 7)) << 4);
        const int rb = wn * 64 + i * 32 + r32; bbase[i] = BM * 128 + rb * 128 + ((hi ^ ((rb >> 1) & 7)) << 4);
    }
    f32x16 acc[2][2];
#pragma unroll
    for (int i = 0; i < 2; ++i)
#pragma unroll
        for (int j = 0; j < 2; ++j) acc[i][j] = f32x16{};
#define GSTAGE(kt, buf) do { const u16* _ka = al.kbase(kt); const u16* _kb = bl.kbase(kt); char* _d = lds + (buf) * STG + ldsw; \
        _Pragma("unroll") for (int _i = 0; _i < NA; ++_i) __builtin_amdgcn_global_load_lds((const unsigned*)(_ka + aoff[_i]), (unsigned*)(_d + _i * 8192), 16, 0, 0); \
        _Pragma("unroll") for (int _i = 0; _i < NB; ++_i) __builtin_amdgcn_global_load_lds((const unsigned*)(_kb + boff[_i]), (unsigned*)(_d + BM * 128 + _i * 8192), 16, 0, 0); } while (0)
    __syncthreads();
    GSTAGE(0, 0);
    for (int kt = 0; kt < nk; ++kt) {
        asm volatile("s_waitcnt vmcnt(0)" ::: "memory");
        __syncthreads();
        if (kt + 1 < nk) GSTAGE(kt + 1, (kt + 1) & 1);
        const char* sb = lds + (kt & 1) * STG;
#pragma unroll
        for (int ks = 0; ks < 4; ++ks) {
            bf16x8 a0 = *(const bf16x8*)(sb + (abase[0] ^ (ks << 5)));
            bf16x8 a1 = *(const bf16x8*)(sb + (abase[1] ^ (ks << 5)));
            bf16x8 b0 = *(const bf16x8*)(sb + (bbase[0] ^ (ks << 5)));
            bf16x8 b1 = *(const bf16x8*)(sb + (bbase[1] ^ (ks << 5)));
            acc[0][0] = __builtin_amdgcn_mfma_f32_32x32x16_bf16(a0, b0, acc[0][0], 0, 0, 0);
            acc[0][1] = __builtin_amdgcn_mfma_f32_32x32x16_bf16(a0, b1, acc[0][1], 0, 0, 0);
            acc[1][0] = __builtin_amdgcn_mfma_f32_32x32x16_bf16(a1, b0, acc[1][0], 0, 0, 0);
            acc[1][1] = __builtin_amdgcn_mfma_f32_32x32x16_bf16(a1, b1, acc[1][1], 0, 0, 0);
        }
    }
#undef GSTAGE
    ep(acc, brow + wm * 64, bcol + wn * 64, lane);
}

template <int DK, int DV> struct AttnCfg {
    static constexpr int NKB = DK / 32, NVB = DV / 32, ND0 = DK / 16;
    static constexpr int KBYTES = 64 * DK * 2, VBYTES = 64 * DV * 2;
    static constexpr int LDS = 2 * KBYTES + 2 * VBYTES + NWAVE * 64 * 4;
};
constexpr float ATT_THR = 8.f;

__device__ __forceinline__ void partialSM(f32x16& p0, f32x16& p1, float& m_reg, float& mn, float& alpha) {
    float pmax = p0[0];
#pragma unroll
    for (int r = 1; r < 16; ++r) pmax = fmaxf(pmax, p0[r]);
#pragma unroll
    for (int r = 0; r < 16; ++r) pmax = fmaxf(pmax, p1[r]);
    { auto rr = __builtin_amdgcn_permlane32_swap(__float_as_uint(pmax), __float_as_uint(pmax), false, false);
      pmax = fmaxf(__uint_as_float(rr[0]), __uint_as_float(rr[1])); }
    if (__builtin_expect(__all(pmax - m_reg <= ATT_THR), 1)) { mn = m_reg; alpha = 1.f; }
    else { mn = fmaxf(m_reg, pmax); alpha = __builtin_amdgcn_exp2f(m_reg - mn); m_reg = mn; }
#pragma unroll
    for (int r = 0; r < 16; ++r) p0[r] = p0[r] - mn;
#pragma unroll
    for (int r = 0; r < 16; ++r) p1[r] = p1[r] - mn;
#pragma unroll
    for (int r = 0; r < 16; ++r) p0[r] = __builtin_amdgcn_exp2f(p0[r]);
}
#define PK4(P, BASE, OUT) do { unsigned a0 = cvtpk(P[BASE + 0], P[BASE + 1]), a1 = cvtpk(P[BASE + 2], P[BASE + 3]);   \
    unsigned b0 = cvtpk(P[BASE + 4], P[BASE + 5]), b1 = cvtpk(P[BASE + 6], P[BASE + 7]);                              \
    auto r0 = __builtin_amdgcn_permlane32_swap(a0, b0, false, false); auto r1 = __builtin_amdgcn_permlane32_swap(a1, b1, false, false); \
    u32x4 w = {r0[0], r1[0], r0[1], r1[1]}; OUT = *reinterpret_cast<bf16x8*>(&w); } while (0)
__device__ __forceinline__ void finishSM(f32x16& p0, f32x16& p1, float alpha, float& l_reg, bf16x8& pa0, bf16x8& pa1, bf16x8& pa2, bf16x8& pa3) {
#pragma unroll
    for (int r = 0; r < 16; ++r) p1[r] = __builtin_amdgcn_exp2f(p1[r]);
    float ps = 0;
#pragma unroll
    for (int r = 0; r < 16; ++r) ps += p0[r];
#pragma unroll
    for (int r = 0; r < 16; ++r) ps += p1[r];
    { auto rr = __builtin_amdgcn_permlane32_swap(__float_as_uint(ps), __float_as_uint(ps), false, false);
      ps = __uint_as_float(rr[0]) + __uint_as_float(rr[1]); }
    l_reg = l_reg * alpha + ps;
    PK4(p0, 0, pa0); PK4(p0, 8, pa1); PK4(p1, 0, pa2); PK4(p1, 8, pa3);
}
__device__ __forceinline__ int k_lds_off(int row, int blk, int chunk) { return blk * 4096 + row * 64 + ((chunk ^ ((row >> 2) & 3)) << 4); }
template <int ND0>
__device__ __forceinline__ void qkt(f32x16& p0, f32x16& p1, const char* Ks, const bf16x8* qr, int r32, int hi) {
    p0 = f32x16{}; p1 = f32x16{};
#pragma unroll
    for (int d0 = 0; d0 < ND0; ++d0) {
        const int ch = (d0 & 1) * 2 + hi;
        bf16x8 b0 = *reinterpret_cast<const bf16x8*>(Ks + k_lds_off(r32, d0 >> 1, ch));
        bf16x8 b1 = *reinterpret_cast<const bf16x8*>(Ks + k_lds_off(32 + r32, d0 >> 1, ch));
        p0 = __builtin_amdgcn_mfma_f32_32x32x16_bf16(b0, qr[d0], p0, 0, 0, 0);
        p1 = __builtin_amdgcn_mfma_f32_32x32x16_bf16(b1, qr[d0], p1, 0, 0, 0);
    }
}
template <int NVB> __device__ __forceinline__ int v_st(int k, int c) {
    const int kk = (k & ~0xC) | ((k & 4) << 1) | ((k & 8) >> 1);
    return ((kk >> 3) * NVB + (c >> 5)) * 512 + ((kk & 7) * 32 + (c & 31)) * 2;
}
__device__ __forceinline__ int v_rd_base(int lane) { return ((lane & 3) << 3) | (((lane >> 2) & 3) << 6) | (((lane >> 4) & 1) << 5) | (((lane >> 5) & 1) << 8); }
template <int OFF> __device__ __forceinline__ s16x4 tr_read(int vb) {
    s16x4 r; asm volatile("ds_read_b64_tr_b16 %0, %1 offset:%2" : "=&v"(r) : "v"(vb), "i"(OFF) : "memory"); return r;
}
#define PKV(L, H) (bf16x8){L[0], L[1], L[2], L[3], H[0], H[1], H[2], H[3]}
template <int D0, int NVB> __device__ __forceinline__ void pv_one(f32x16& od, int vb, bf16x8 pa0, bf16x8 pa1, bf16x8 pa2, bf16x8 pa3) {
    constexpr int KS = 2 * NVB * 512, HF = NVB * 512, B0 = D0 * 512;
    const s16x4 l0 = tr_read<B0 + 0 * KS>(vb), h0 = tr_read<B0 + 0 * KS + HF>(vb), l1 = tr_read<B0 + 1 * KS>(vb), h1 = tr_read<B0 + 1 * KS + HF>(vb);
    const s16x4 l2 = tr_read<B0 + 2 * KS>(vb), h2 = tr_read<B0 + 2 * KS + HF>(vb), l3 = tr_read<B0 + 3 * KS>(vb), h3 = tr_read<B0 + 3 * KS + HF>(vb);
    asm volatile("s_waitcnt lgkmcnt(0)" ::: "memory"); SBAR();
    od = __builtin_amdgcn_mfma_f32_32x32x16_bf16(pa0, PKV(l0, h0), od, 0, 0, 0);
    od = __builtin_amdgcn_mfma_f32_32x32x16_bf16(pa1, PKV(l1, h1), od, 0, 0, 0);
    od = __builtin_amdgcn_mfma_f32_32x32x16_bf16(pa2, PKV(l2, h2), od, 0, 0, 0);
    od = __builtin_amdgcn_mfma_f32_32x32x16_bf16(pa3, PKV(l3, h3), od, 0, 0, 0);
}
template <int NVB> __device__ __forceinline__ void pv_all(f32x16* o, int vb, bf16x8 pa0, bf16x8 pa1, bf16x8 pa2, bf16x8 pa3) {
    pv_one<0, NVB>(o[0], vb, pa0, pa1, pa2, pa3); pv_one<1, NVB>(o[1], vb, pa0, pa1, pa2, pa3);
    if constexpr (NVB == 4) { pv_one<2, NVB>(o[2], vb, pa0, pa1, pa2, pa3); pv_one<3, NVB>(o[3], vb, pa0, pa1, pa2, pa3); }
}

template <int DK, int DV>
__device__ __forceinline__ void attn_item(const u16* __restrict__ Qb, const u16* __restrict__ Ka, const u16* __restrict__ Kb, const u16* __restrict__ Vh,
                                          int nkeys, u16* __restrict__ Ob, long ldo, char* lds) {
    using C = AttnCfg<DK, DV>;
    constexpr int NVB = C::NVB, ND0 = C::ND0;
    const int tid = threadIdx.x, wid = tid >> 6, lane = tid & 63, r32 = lane & 31, hi = lane >> 5;
    char* V_lds = lds; char* K_lds = lds + 2 * C::VBYTES;
    float* wsc = (float*)(lds + 2 * C::VBYTES + 2 * C::KBYTES) + wid * 64; float* li_l = wsc; float* al_l = wsc + 32;
    float m_reg = -1e30f, l_reg = 0; f32x16 o[NVB]; bf16x8 qr[ND0];
#pragma unroll
    for (int d = 0; d < NVB; ++d) o[d] = f32x16{};
    const u16* Qw = Qb + (long)(wid * 32 + r32) * DK + hi * 8;
#pragma unroll
    for (int d0 = 0; d0 < ND0; ++d0) qr[d0] = *reinterpret_cast<const bf16x8*>(Qw + d0 * 16);
    const int kr = tid >> 3, kc8 = tid & 7;
    const int kdst0 = k_lds_off(kr, kc8 >> 2, kc8 & 3);
    const int kr2 = (tid & 255) >> 2, kc2 = tid & 3;
    const int kdst1 = k_lds_off(kr2, 2, kc2);
    const int vr = (DV == 64) ? (tid >> 3) : (tid >> 4), vc = (DV == 64) ? (tid & 7) * 8 : (tid & 15) * 8;
    const int vst0 = v_st<NVB>(vr, vc), vst1 = v_st<NVB>(32 + vr, vc);
    const int vb0 = (int)(uintptr_t)V_lds + v_rd_base(lane);
    bf16x8 sk0, sk1, sv0, sv1;
#define SLOAD(k0) do { sk0 = *reinterpret_cast<const bf16x8*>(Ka + (long)((k0) + kr) * 64 + kc8 * 8); \
        if constexpr (DK == 96) sk1 = *reinterpret_cast<const bf16x8*>(Kb + (long)((k0) + kr2) * 32 + kc2 * 8); \
        sv0 = *reinterpret_cast<const bf16x8*>(Vh + (long)((k0) + vr) * DV + vc); \
        if constexpr (DV == 128) sv1 = *reinterpret_cast<const bf16x8*>(Vh + (long)((k0) + 32 + vr) * DV + vc); } while (0)
#define SWRITE(b) do { *(bf16x8*)(K_lds + (b) * C::KBYTES + kdst0) = sk0; \
        if constexpr (DK == 96) *(bf16x8*)(K_lds + (b) * C::KBYTES + kdst1) = sk1; \
        *(bf16x8*)(V_lds + (b) * C::VBYTES + vst0) = sv0; \
        if constexpr (DV == 128) *(bf16x8*)(V_lds + (b) * C::VBYTES + vst1) = sv1; } while (0)
#define SWAIT() asm volatile("s_waitcnt vmcnt(0)" ::: "memory")
#define RESC(a) do { if (__any((a) < 1.f)) { if (hi == 0) al_l[r32] = (a); asm volatile("s_waitcnt lgkmcnt(0)" ::: "memory"); \
        _Pragma("unroll") for (int d = 0; d < NVB; ++d) _Pragma("unroll") for (int r = 0; r < 16; ++r) o[d][r] *= al_l[crow(r, hi)]; } } while (0)
    f32x16 pA0, pA1, pB0, pB1; float mnA, mnB, alA, alB; bf16x8 pa0, pa1, pa2, pa3; const int NT = nkeys / 64;
    __syncthreads();
    SLOAD(0); SWAIT(); SWRITE(0); __syncthreads();
    qkt<ND0>(pA0, pA1, K_lds, qr, r32, hi); partialSM(pA0, pA1, m_reg, mnA, alA);
    SLOAD(64);
    SWAIT(); SWRITE(1); __syncthreads();
    for (int j = 1; j + 1 < NT; j += 2) {
        SBAR(); qkt<ND0>(pB0, pB1, K_lds + C::KBYTES, qr, r32, hi);
        finishSM(pA0, pA1, alA, l_reg, pa0, pa1, pa2, pa3); SBAR();
        SLOAD((j + 1) * 64); SBAR();
        pv_all<NVB>(o, vb0, pa0, pa1, pa2, pa3); partialSM(pB0, pB1, m_reg, mnB, alB);
        __syncthreads(); SWAIT(); SWRITE(0);
        RESC(alB); __syncthreads();
        SBAR(); qkt<ND0>(pA0, pA1, K_lds, qr, r32, hi);
        finishSM(pB0, pB1, alB, l_reg, pa0, pa1, pa2, pa3); SBAR();
        SLOAD((j + 2) * 64); SBAR();
        pv_all<NVB>(o, vb0 + C::VBYTES, pa0, pa1, pa2, pa3); partialSM(pA0, pA1, m_reg, mnA, alA);
        __syncthreads(); SWAIT(); SWRITE(1);
        RESC(alA); __syncthreads();
    }
    SBAR(); qkt<ND0>(pB0, pB1, K_lds + C::KBYTES, qr, r32, hi);
    finishSM(pA0, pA1, alA, l_reg, pa0, pa1, pa2, pa3); SBAR();
    pv_all<NVB>(o, vb0, pa0, pa1, pa2, pa3); partialSM(pB0, pB1, m_reg, mnB, alB);
    __syncthreads(); RESC(alB);
    finishSM(pB0, pB1, alB, l_reg, pa0, pa1, pa2, pa3); SBAR();
    pv_all<NVB>(o, vb0 + C::VBYTES, pa0, pa1, pa2, pa3);
    if (hi == 0) li_l[r32] = l_reg; asm volatile("s_waitcnt lgkmcnt(0)" ::: "memory");
    float rli[16];
#pragma unroll
    for (int r = 0; r < 16; ++r) rli[r] = __builtin_amdgcn_rcpf(li_l[crow(r, hi)]);
    u16* Ow = Ob + (long)(wid * 32) * ldo;
#pragma unroll
    for (int r = 0; r < 16; ++r) { const int orow = crow(r, hi);
#pragma unroll
        for (int d0 = 0; d0 < NVB; ++d0) Ow[(long)orow * ldo + d0 * 32 + r32] = f2bf(o[d0][r] * rli[r]); }
#undef SLOAD
#undef SWRITE
#undef SWAIT
#undef RESC
}

struct Frame {
    const Params* p; unsigned char* ws; char* lds; float* out; int G, bx;
    __device__ __forceinline__ const float* in(int i) const { return p->in[i]; }
    template <class T> __device__ __forceinline__ T* W(size_t off) const { return (T*)(ws + off); }
};
constexpr int LDS_BYTES = 147456;
constexpr int LDS_BARW  = LDS_BYTES - 16;
constexpr int LDS_TAB   = 102400;

__device__ __forceinline__ const float* xrow_in(const Frame& F, int row, bool first) {
    if (row < NCTX) return (first ? F.in(2) : F.W<float>(WS_XC)) + (size_t)row * DM;
    return (first ? F.in(0) : (const float*)F.out) + (size_t)(row - NCTX) * DM;
}
__device__ __forceinline__ float* xrow_out(const Frame& F, int row) {
    if (row < NCTX) return F.W<float>(WS_XC) + (size_t)row * DM;
    return F.out + (size_t)(row - NCTX) * DM;
}
__device__ __forceinline__ const float* mod_vec(const Frame& F, int li, int row, int which) {
    const int mr = row < NCTX ? 4 : ((row - NCTX) >> 13);
    return F.W<float>(WS_MODS) + (size_t)(li * 5 + mr) * 6144 + which * 1024;
}

__device__ __forceinline__ void p0_mods(const Frame& F) {
    float* s = (float*)F.lds; float* red = s + 5 * 1024;
    const int tid = threadIdx.x, lane = tid & 63, wid = tid >> 6;
    for (int i = tid; i < 5 * 1024; i += NTHR) { const int r = i >> 10, k = i & 1023; const float v = r < 4 ? F.in(1)[r * 1024 + k] : F.in(3)[k]; s[i] = silu_f(v); }
    __syncthreads();
    for (int item = F.bx; item < DEPTH * 96; item += F.G) {
        const int li = item / 96, cg = item % 96;
        const float* w = F.in(4) + (size_t)li * 1024 * 6144 + cg * 64 + lane;
        float a0 = 0, a1 = 0, a2 = 0, a3 = 0, a4 = 0;
        const int k0 = wid * 128;
#pragma unroll 8
        for (int k = k0; k < k0 + 128; ++k) {
            const float wv = w[(size_t)k * 6144];
            a0 += s[k] * wv; a1 += s[1024 + k] * wv; a2 += s[2048 + k] * wv; a3 += s[3072 + k] * wv; a4 += s[4096 + k] * wv;
        }
        red[(wid * 5 + 0) * 64 + lane] = a0; red[(wid * 5 + 1) * 64 + lane] = a1; red[(wid * 5 + 2) * 64 + lane] = a2;
        red[(wid * 5 + 3) * 64 + lane] = a3; red[(wid * 5 + 4) * 64 + lane] = a4;
        __syncthreads();
        if (tid < 320) { const int r = tid >> 6, l = tid & 63; float sum = 0;
#pragma unroll
            for (int ww = 0; ww < 8; ++ww) sum += red[(ww * 5 + r) * 64 + l];
            F.W<float>(WS_MODS)[(size_t)(li * 5 + r) * 6144 + cg * 64 + l] = sum + F.in(5)[li * 6144 + cg * 64 + l]; }
        __syncthreads();
    }
}
__device__ __forceinline__ void p0_rope(const Frame& F) {
    const int gt = F.bx * NTHR + threadIdx.x, gn = F.G * NTHR;
    float* ca = F.W<float>(WS_ROPEA); float* sa = ca + SEQ * 16; float* cb = F.W<float>(WS_ROPEB); float* sb = cb + SEQ * 32;
    for (int i = gt; i < SEQ * 48; i += gn) {
        int n, f, nf; float* co; float* so; int idx;
        if (i < SEQ * 16) { n = i >> 4; f = i & 15; nf = 8; co = ca; so = sa; idx = i; }
        else { const int j = i - SEQ * 16; n = j >> 5; f = j & 31; nf = 16; co = cb; so = sb; idx = j; }
        const int fi = f % nf; const float pos = (f < nf) ? (float)(n >> 6) : (float)(n & 63);
        const float invf = exp2f(-(float)fi / (float)nf * 13.287712379549449f);
        const float ang = pos * invf;
        float rev = ang * 0.15915494309189535f; rev -= floorf(rev);
        co[idx] = __builtin_amdgcn_cosf(rev); so[idx] = __builtin_amdgcn_sinf(rev);
    }
}
__device__ __forceinline__ int rowmap(int n, int kind) { return kind == 0 ? n : ((n >> 5) * 64 + (kind == 2 ? 32 : 0) + (n & 31)); }
__device__ __forceinline__ void cvt_t(const Frame& F, const float* src, int K, int N, u16* dst, int ldd, int kind, int rot) {
    float* tl = (float*)F.lds; const int tid = threadIdx.x;
    const int tn = (N + 63) / 64, nt = (K / 64) * tn;
    for (int t = (F.bx + rot) % F.G; t < nt; t += F.G) {
        const int k0 = (t / tn) * 64, n0 = (t % tn) * 64;
#pragma unroll
        for (int ps = 0; ps < 2; ++ps) { const int k = (tid >> 4) + ps * 32, n4 = (tid & 15) * 4;
            if (n0 + n4 < N) { const f32x4 v = *(const f32x4*)(src + (size_t)(k0 + k) * N + n0 + n4);
                tl[k * 65 + n4] = v[0]; tl[k * 65 + n4 + 1] = v[1]; tl[k * 65 + n4 + 2] = v[2]; tl[k * 65 + n4 + 3] = v[3]; } }
        __syncthreads();
        { const int n = tid >> 3, kc = (tid & 7) * 8;
          if (n0 + n < N) { u32x4 w;
#pragma unroll
            for (int i = 0; i < 4; ++i) w[i] = cvtpk(tl[(kc + 2 * i) * 65 + n], tl[(kc + 2 * i + 1) * 65 + n]);
            *(u32x4*)(dst + (size_t)rowmap(n0 + n, kind) * ldd + k0 + kc) = w; } }
        __syncthreads();
    }
}
__device__ __forceinline__ void p0_weights(const Frame& F) {
    int rot = 0;
    for (int j = 0; j < 2; ++j) {
        cvt_t(F, F.in(8) + (size_t)j * 1024 * 544, 1024, 544, F.W<u16>(WS_WDQKV) + (size_t)j * 640 * 1024, 1024, 0, rot); rot += 144;
        cvt_t(F, F.in(10) + (size_t)j * 256 * 1536, 256, 1536, F.W<u16>(WS_WUQ) + (size_t)j * 1536 * 256, 256, 0, rot); rot += 96;
        cvt_t(F, F.in(12) + (size_t)j * 256 * 2048, 256, 2048, F.W<u16>(WS_WUKV) + (size_t)j * 2048 * 256, 256, 0, rot); rot += 128;
        cvt_t(F, F.in(13) + (size_t)j * 1024 * 1024, 1024, 1024, F.W<u16>(WS_WOM) + (size_t)j * 1024 * 1024, 1024, 0, rot);
    }
    cvt_t(F, F.in(14), 1024, 3072, F.W<u16>(WS_WQKVD), 1024, 0, rot);
    cvt_t(F, F.in(17), 1024, 1024, F.W<u16>(WS_WOD), 1024, 0, rot);
    cvt_t(F, F.in(18), 1024, 3104, F.W<u16>(WS_WING), 1024, 0, rot); rot += 16;
    cvt_t(F, F.in(22), 1024, 1024, F.W<u16>(WS_WOG), 1024, 0, rot);
}
__device__ __forceinline__ void moe_weights(const Frame& F, int li) {
    int rot = 0;
    for (int e = 0; e < 16; ++e) {
        cvt_t(F, F.in(27) + (size_t)(li * 16 + e) * 1024 * 512, 1024, 512, F.W<u16>(WS_MOEW) + (size_t)e * 1024 * 1024, 1024, 1, rot); rot += 128;
        cvt_t(F, F.in(28) + (size_t)(li * 16 + e) * 1024 * 512, 1024, 512, F.W<u16>(WS_MOEW) + (size_t)e * 1024 * 1024, 1024, 2, rot); rot += 128;
        cvt_t(F, F.in(29) + (size_t)(li * 16 + e) * 512 * 1024, 512, 1024, F.W<u16>(WS_MOEW + MOE_WGU_BYTES) + (size_t)e * 1024 * 512, 512, 0, rot); rot += 128;
    }
}

template <bool ROUTE>
__device__ __forceinline__ void norm_phase(const Frame& F, int li, int row_begin, bool first) {
    const int lane = threadIdx.x & 63, wid = threadIdx.x >> 6;
    const float* gain = F.in(ROUTE ? 7 : 6) + li * DM;
    u16* H = F.W<u16>(WS_H);
    for (int row = row_begin + F.bx * NWAVE + wid; row < NTOK; row += F.G * NWAVE) {
        const float* xr = xrow_in(F, row, first);
        f32x4 v[4];
#pragma unroll
        for (int i = 0; i < 4; ++i) v[i] = *(const f32x4*)(xr + i * 256 + lane * 4);
        float ss = 0;
#pragma unroll
        for (int i = 0; i < 4; ++i) ss += v[i][0] * v[i][0] + v[i][1] * v[i][1] + v[i][2] * v[i][2] + v[i][3] * v[i][3];
        ss = wave_sum(ss);
        const float rinv = rsqrtf(ss * (1.f / DM) + EPS);
        const float* sh = mod_vec(F, li, row, ROUTE ? 3 : 0); const float* sc = mod_vec(F, li, row, ROUTE ? 4 : 1);
        float hv[16];
#pragma unroll
        for (int i = 0; i < 4; ++i) { const int c = i * 256 + lane * 4;
            const f32x4 g = *(const f32x4*)(gain + c), s1 = *(const f32x4*)(sc + c), s0 = *(const f32x4*)(sh + c);
#pragma unroll
            for (int j = 0; j < 4; ++j) hv[i * 4 + j] = (v[i][j] * rinv * g[j]) * (1.f + s1[j]) + s0[j];
            u32x2 w = {cvtpk(hv[i * 4], hv[i * 4 + 1]), cvtpk(hv[i * 4 + 2], hv[i * 4 + 3])};
            *(u32x2*)(H + (size_t)row * DM + c) = w; }
        if constexpr (ROUTE) {
            float gl[4] = {0, 0, 0, 0};
            const float* wg = F.in(23) + (size_t)li * DM * 4;
#pragma unroll
            for (int i = 0; i < 4; ++i)
#pragma unroll
                for (int j = 0; j < 4; ++j) { const f32x4 w4 = *(const f32x4*)(wg + (size_t)(i * 256 + lane * 4 + j) * 4); const float h = hv[i * 4 + j];
                    gl[0] += h * w4[0]; gl[1] += h * w4[1]; gl[2] += h * w4[2]; gl[3] += h * w4[3]; }
#pragma unroll
            for (int g = 0; g < 4; ++g) gl[g] = wave_sum(gl[g]) + F.in(24)[li * 4 + g];
            int gi = 0; float gm = gl[0];
#pragma unroll
            for (int g = 1; g < 4; ++g) if (gl[g] > gm) { gm = gl[g]; gi = g; }
            float den = 0;
#pragma unroll
            for (int g = 0; g < 4; ++g) den += __expf(gl[g] - gm);
            const float grp_w = 1.f / den;
            float el[4] = {0, 0, 0, 0};
            const float* wr = F.in(25) + (size_t)(li * 4 + gi) * DM * 4;
#pragma unroll
            for (int i = 0; i < 4; ++i)
#pragma unroll
                for (int j = 0; j < 4; ++j) { const f32x4 w4 = *(const f32x4*)(wr + (size_t)(i * 256 + lane * 4 + j) * 4); const float h = hv[i * 4 + j];
                    el[0] += h * w4[0]; el[1] += h * w4[1]; el[2] += h * w4[2]; el[3] += h * w4[3]; }
#pragma unroll
            for (int e = 0; e < 4; ++e) el[e] = wave_sum(el[e]) + F.in(26)[(li * 4 + gi) * 4 + e];
            int i1 = 0; float v1 = el[0];
#pragma unroll
            for (int e = 1; e < 4; ++e) if (el[e] > v1) { v1 = el[e]; i1 = e; }
            int i2 = -1; float v2 = -3.0e38f;
#pragma unroll
            for (int e = 0; e < 4; ++e) if (e != i1 && el[e] > v2) { v2 = el[e]; i2 = e; }
            const float t = __expf(v2 - v1); const float w1 = grp_w / (1.f + t), w2 = grp_w * t / (1.f + t);
            const int elo = i1 < i2 ? i1 : i2, ehi = i1 < i2 ? i2 : i1;
            const float wlo = i1 < i2 ? w1 : w2, whi = i1 < i2 ? w2 : w1;
            const int pr = elo == 0 ? ehi - 1 : (elo == 1 ? ehi + 1 : 5);
            const int cls = gi * 6 + pr;
            if (lane == 0) {
                const int pos = (int)atomicAdd(F.W<unsigned>(WS_CTL) + CW_CNT + li * 32 + cls, 1u);
                u32x4 rec = {(unsigned)cls, (unsigned)pos, __float_as_uint(wlo), __float_as_uint(whi)};
                *(u32x4*)(F.W<unsigned char>(WS_TOK) + (size_t)row * 16) = rec;
            }
        }
    }
}

__device__ __forceinline__ void moe_table(const Frame& F, int li, int* tab) {
    if (threadIdx.x == 0) {
        const unsigned* cnt = F.W<unsigned>(WS_CTL) + CW_CNT + li * 32; int off = 0;
        for (int c = 0; c < 24; ++c) { tab[c] = off; const int n = (int)cnt[c]; const int nt = (n + 255) >> 8;
            for (int t = 0; t < nt; ++t) tab[32 + (off >> 8) + t] = c; off += nt << 8; }
        tab[24] = off;
    }
    __syncthreads();
}
__device__ __forceinline__ void moe_scatter(const Frame& F, int li, int row_begin) {
    int* tab = (int*)(F.lds + LDS_TAB);
    moe_table(F, li, tab);
    const unsigned* cnt = F.W<unsigned>(WS_CTL) + CW_CNT + li * 32;
    int* rowtok = F.W<int>(WS_ROWTOK); float* roww = F.W<float>(WS_ROWW);
    const int gt = F.bx * NTHR + threadIdx.x, gn = F.G * NTHR;
    for (int t = row_begin + gt; t < NTOK; t += gn) {
        const u32x4 rec = *(const u32x4*)(F.W<unsigned char>(WS_TOK) + (size_t)t * 16);
        const int r = tab[rec[0]] + (int)rec[1];
        rowtok[r] = t; roww[2 * r] = __uint_as_float(rec[2]); roww[2 * r + 1] = __uint_as_float(rec[3]);
    }
    for (int i = gt; i < 24 * 256; i += gn) { const int c = i >> 8, j = i & 255; const int r = tab[c] + (int)cnt[c] + j;
        const int end = tab[c] + ((((int)cnt[c]) + 255) & ~255);
        if (r < end) { rowtok[r] = -1; roww[2 * r] = 0.f; roww[2 * r + 1] = 0.f; } }
    __syncthreads();
}

struct EpiF32 { float* dst; int ld, ncols;
    __device__ __forceinline__ void operator()(f32x16 (&acc)[2][2], int row0, int col0, int lane) const {
        const int r32 = lane & 31, hi = lane >> 5;
#pragma unroll
        for (int ni = 0; ni < 2; ++ni) { const int col = col0 + ni * 32 + r32;
            if (col < ncols) {
#pragma unroll
                for (int mi = 0; mi < 2; ++mi)
#pragma unroll
                    for (int r = 0; r < 16; ++r) dst[(size_t)(row0 + mi * 32 + crow(r, hi)) * ld + col] = acc[mi][ni][r]; } }
    } };
struct EpiMlaQ { u16* Q; const float* cosA; const float* sinA; float scale;
    __device__ __forceinline__ void operator()(f32x16 (&acc)[2][2], int row0, int col0, int lane) const {
        const int r32 = lane & 31, hi = lane >> 5; const bool lat = row0 >= NCTX;
#pragma unroll
        for (int ni = 0; ni < 2; ++ni) { const int s = (col0 >> 5) + ni, head = s / 3, part = s - head * 3, d = part * 32 + r32;
#pragma unroll
            for (int mi = 0; mi < 2; ++mi)
#pragma unroll
                for (int r = 0; r < 16; ++r) { const int row = row0 + mi * 32 + crow(r, hi); int b, pos; row_bp(row, b, pos);
                    float v = acc[mi][ni][r] * scale;
                    if (part == 2) { const float pt = __shfl_xor(v, 16);
                        if (lat) { const int n = (row - NCTX) & (SEQ - 1), i = r32 & 15; const float cs = cosA[n * 16 + i], sn = sinA[n * 16 + i];
                            v = (r32 & 16) ? pt * sn + v * cs : v * cs - pt * sn; } }
                    Q[((size_t)(b * 16 + head) * KEYS + pos) * 96 + d] = f2bf(v); } }
    } };
struct EpiMlaKV { u16* Kn; long vdelta;
    __device__ __forceinline__ void operator()(f32x16 (&acc)[2][2], int row0, int col0, int lane) const {
        const int r32 = lane & 31, hi = lane >> 5; const int head = col0 >> 7; u16* dst = Kn + (long)((col0 >> 6) & 1) * vdelta;
#pragma unroll
        for (int mi = 0; mi < 2; ++mi)
#pragma unroll
            for (int r = 0; r < 16; ++r) { const int row = row0 + mi * 32 + crow(r, hi); int b, pos; row_bp(row, b, pos);
                u16* o = dst + ((size_t)(b * 16 + head) * KEYS + pos) * 64 + r32;
                o[0] = f2bf(acc[mi][0][r]); o[32] = f2bf(acc[mi][1][r]); }
    } };
struct EpiResid { Frame F; int li, which; bool first;
    __device__ __forceinline__ void operator()(f32x16 (&acc)[2][2], int row0, int col0, int lane) const {
        const int r32 = lane & 31, hi = lane >> 5;
#pragma unroll
        for (int mi = 0; mi < 2; ++mi)
#pragma unroll
            for (int r = 0; r < 16; ++r) { const int row = row0 + mi * 32 + crow(r, hi);
                const float* xi = xrow_in(F, row, first); float* xo = xrow_out(F, row); const float* g = mod_vec(F, li, row, which);
#pragma unroll
                for (int ni = 0; ni < 2; ++ni) { const int col = col0 + ni * 32 + r32; xo[col] = xi[col] + g[col] * acc[mi][ni][r]; } }
    } };
struct EpiMoeB { Frame F; int li; const int* rowtok;
    __device__ __forceinline__ void operator()(f32x16 (&acc)[2][2], int row0, int col0, int lane) const {
        const int r32 = lane & 31, hi = lane >> 5;
#pragma unroll
        for (int mi = 0; mi < 2; ++mi)
#pragma unroll
            for (int r = 0; r < 16; ++r) { const int tok = rowtok[row0 + mi * 32 + crow(r, hi)];
                if (tok >= 0) { float* xo = xrow_out(F, tok); const float* g = mod_vec(F, li, tok, 5);
#pragma unroll
                    for (int ni = 0; ni < 2; ++ni) { const int col = col0 + ni * 32 + r32; xo[col] = xo[col] + g[col] * acc[mi][ni][r]; } } }
    } };
struct EpiMoeA { u16* act; const float* roww; int half, acol0;
    __device__ __forceinline__ void operator()(f32x16 (&acc)[2][2], int row0, int col0, int lane) const {
        const int r32 = lane & 31, hi = lane >> 5; const int ac = acol0 + (col0 >> 6) * 32 + r32;
#pragma unroll
        for (int mi = 0; mi < 2; ++mi)
#pragma unroll
            for (int r = 0; r < 16; ++r) { const int row = row0 + mi * 32 + crow(r, hi);
                const float w = roww[2 * row + half]; const float g = acc[mi][0][r], u = acc[mi][1][r];
                act[(size_t)row * 1024 + ac] = f2bf(silu_f(g) * u * w); }
    } };
struct EpiDiffQKV { u16* Q; long kdelta; u16* V; const float* cosB; const float* sinB; float qscale;
    __device__ __forceinline__ void operator()(f32x16 (&acc)[2][2], int row0, int col0, int lane) const {
        const int r32 = lane & 31, hi = lane >> 5; const int region = col0 >> 10; const bool lat = row0 >= NCTX;
#pragma unroll
        for (int mi = 0; mi < 2; ++mi)
#pragma unroll
            for (int r = 0; r < 16; ++r) { const int row = row0 + mi * 32 + crow(r, hi); int b, pos; row_bp(row, b, pos);
                float t1 = acc[mi][0][r], t2 = acc[mi][1][r];
                if (region < 2) {
                    const int hh = (col0 & 1023) >> 6;
                    if (lat) { const int n = (row - NCTX) & (SEQ - 1); const float cs = cosB[n * 32 + r32], sn = sinB[n * 32 + r32];
                        const float o1 = t1 * cs - t2 * sn, o2 = t1 * sn + t2 * cs; t1 = o1; t2 = o2; }
                    if (region == 0) { t1 *= qscale; t2 *= qscale; }
                    u16* o = Q + (long)region * kdelta + ((size_t)(b * 16 + hh) * KEYS + pos) * 64 + r32;
                    o[0] = f2bf(t1); o[32] = f2bf(t2);
                } else {
                    const int cv = col0 - 2048, head = cv >> 7, dv = (cv & 127) + r32;
                    u16* o = V + ((size_t)(b * 8 + head) * KEYS + pos) * 128 + dv;
                    o[0] = f2bf(t1); o[32] = f2bf(t2);
                } }
    } };
struct EpiGlaIn { u16* q; u16* k; u16* v; u16* g; float* z;
    __device__ __forceinline__ void operator()(f32x16 (&acc)[2][2], int row0, int col0, int lane) const {
        const int r32 = lane & 31, hi = lane >> 5;
#pragma unroll
        for (int mi = 0; mi < 2; ++mi)
#pragma unroll
            for (int r = 0; r < 16; ++r) { const size_t row = row0 + mi * 32 + crow(r, hi);
#pragma unroll
                for (int ni = 0; ni < 2; ++ni) { const int col = col0 + ni * 32 + r32; const float a = acc[mi][ni][r];
                    if (col0 < 512) q[row * 512 + col] = f2bf(a * 0.08838834764831845f);
                    else if (col0 < 1024) k[row * 512 + col - 512] = f2bf(a);
                    else if (col0 < 2048) v[row * 1024 + col - 1024] = f2bf(a);
                    else if (col0 < 3072) g[row * 1024 + col - 2048] = f2bf(a);
                    else if (col < 3104) z[row * 32 + col - 3072] = a; } }
    } };

template <int WM, int WN, class AL, class BL, class EP>
__device__ __forceinline__ void gemm_phase(const Frame& F, const AL al, const BL bl, EP& ep, int mt0, int mt1, int nN, int nk, int tile_off, int tile_total) {
    const int mine = (mt1 - mt0) * nN;
    int t = F.bx - (tile_off % F.G); if (t < 0) t += F.G;
    for (; t < mine; t += F.G) { const int mt = mt0 + t / nN, nt = t % nN; gemm_tile<WM, WN>(F.lds, al, bl, ep, mt * WM * 64, nt * WN * 64, nk); }
    (void)tile_total;
}

__device__ __forceinline__ void mla_rowpass(const Frame& F, int j) {
    const int lane = threadIdx.x & 63, wid = threadIdx.x >> 6;
    const float* DQ = F.W<float>(MLA_DQ); u16* CN = F.W<u16>(MLA_CN); u16* KPE = F.W<u16>(MLA_KPE);
    const float* gq = F.in(9) + j * 256; const float* gk = F.in(11) + j * 256;
    const float* ca = F.W<float>(WS_ROPEA); const float* sa = ca + SEQ * 16;
    for (int row = F.bx * NWAVE + wid; row < NTOK; row += F.G * NWAVE) {
        const float* d = DQ + (size_t)row * 544;
        const f32x4 a = *(const f32x4*)(d + lane * 4), c = *(const f32x4*)(d + 256 + lane * 4);
        float sq = a[0] * a[0] + a[1] * a[1] + a[2] * a[2] + a[3] * a[3], sk = c[0] * c[0] + c[1] * c[1] + c[2] * c[2] + c[3] * c[3];
        sq = wave_sum(sq); sk = wave_sum(sk);
        const float rq = rsqrtf(sq * (1.f / 256.f) + EPS), rk = rsqrtf(sk * (1.f / 256.f) + EPS);
        const f32x4 g1 = *(const f32x4*)(gq + lane * 4), g2 = *(const f32x4*)(gk + lane * 4);
        u32x2 w1 = {cvtpk(a[0] * rq * g1[0], a[1] * rq * g1[1]), cvtpk(a[2] * rq * g1[2], a[3] * rq * g1[3])};
        u32x2 w2 = {cvtpk(c[0] * rk * g2[0], c[1] * rk * g2[1]), cvtpk(c[2] * rk * g2[2], c[3] * rk * g2[3])};
        *(u32x2*)(CN + (size_t)row * 512 + lane * 4) = w1; *(u32x2*)(CN + (size_t)row * 512 + 256 + lane * 4) = w2;
        if (lane < 16) { float t1 = d[512 + lane], t2 = d[528 + lane]; int b, pos; row_bp(row, b, pos);
            if (row >= NCTX) { const int n = (row - NCTX) & (SEQ - 1); const float cs = ca[n * 16 + lane], sn = sa[n * 16 + lane];
                const float o1 = t1 * cs - t2 * sn, o2 = t1 * sn + t2 * cs; t1 = o1; t2 = o2; }
            u16* o = KPE + ((size_t)b * KEYS + pos) * 32 + lane; o[0] = f2bf(t1); o[16] = f2bf(t2); }
    }
}
__device__ __forceinline__ int vcu_of(const Frame& F) { return (F.G % 8 == 0) ? (F.bx % 8) * (F.G / 8) + F.bx / 8 : F.bx; }
__device__ __forceinline__ void mla_attn(const Frame& F, bool ctx_out) {
    const u16* Q = F.W<u16>(MLA_Q); const u16* Kn = F.W<u16>(MLA_KN); const u16* V = F.W<u16>(MLA_V); const u16* Kpe = F.W<u16>(MLA_KPE);
    u16* O = F.W<u16>(MLA_DQ);
    const int nit = 2048 + (ctx_out ? 64 : 0);
    for (int it = vcu_of(F); it < nit; it += F.G) {
        int b, h, qpos, nkeys, orow;
        if (it < 2048) { const int bh = it >> 5, qt = it & 31; b = bh >> 4; h = bh & 15; qpos = CTXL + qt * 256; nkeys = KEYS; orow = NCTX + b * SEQ + qt * 256; }
        else { const int jj = it - 2048; b = jj >> 4; h = jj & 15; qpos = 0; nkeys = CTXL; orow = b * CTXL; }
        const size_t bh = (size_t)(b * 16 + h);
        attn_item<96, 64>(Q + (bh * KEYS + qpos) * 96, Kn + bh * KEYS * 64, Kpe + (size_t)b * KEYS * 32, V + bh * KEYS * 64, nkeys,
                          O + (size_t)orow * DM + h * 64, DM, F.lds);
    }
}
__device__ __forceinline__ void diff_attn(const Frame& F) {
    const u16* Q = F.W<u16>(DF_Q); const u16* K = F.W<u16>(DF_K); const u16* V = F.W<u16>(DF_V); u16* OS = F.W<u16>(DF_OS);
    const int nit = 2048 + 64;
    for (int it = vcu_of(F); it < nit; it += F.G) {
        int b, hh, qpos, nkeys, orow;
        if (it < 2048) { const int bh = it >> 5, qt = it & 31; b = bh >> 4; hh = bh & 15; qpos = CTXL + qt * 256; nkeys = KEYS; orow = NCTX + b * SEQ + qt * 256; }
        else { const int jj = it - 2048; b = jj >> 4; hh = jj & 15; qpos = 0; nkeys = CTXL; orow = b * CTXL; }
        const size_t bh = (size_t)(b * 16 + hh);
        attn_item<64, 128>(Q + (bh * KEYS + qpos) * 64, K + bh * KEYS * 64, nullptr, V + (size_t)(b * 8 + (hh >> 1)) * KEYS * 128, nkeys,
                           OS + (size_t)(hh & 1) * NTOK * DM + (size_t)orow * DM + (hh >> 1) * 128, DM, F.lds);
    }
}
__device__ __forceinline__ void diff_rowpass(const Frame& F, float lam_init) {
    const int lane = threadIdx.x & 63, wid = threadIdx.x >> 6;
    const u16* OS = F.W<u16>(DF_OS); u16* O = F.W<u16>(DF_Q);
    const float* lm = F.in(15);
    const float lam = __expf(wave_sum(lm[lane] * lm[64 + lane])) - __expf(wave_sum(lm[128 + lane] * lm[192 + lane])) + lam_init;
    const float post = 1.f - lam_init;
    float sg[16];
#pragma unroll
    for (int i = 0; i < 16; ++i) sg[i] = F.in(16)[(lane & 7) * 16 + i] * post;
    for (int row = F.bx * NWAVE + wid; row < NTOK; row += F.G * NWAVE) {
        const u16* p0 = OS + (size_t)row * DM + lane * 16; const u16* p1 = p0 + (size_t)NTOK * DM;
        const bf16x8 a0 = *(const bf16x8*)p0, a1 = *(const bf16x8*)(p0 + 8), b0 = *(const bf16x8*)p1, b1 = *(const bf16x8*)(p1 + 8);
        float o[16]; float ss = 0;
#pragma unroll
        for (int i = 0; i < 8; ++i) { o[i] = bf2f((u16)a0[i]) - lam * bf2f((u16)b0[i]); o[8 + i] = bf2f((u16)a1[i]) - lam * bf2f((u16)b1[i]); }
#pragma unroll
        for (int i = 0; i < 16; ++i) ss += o[i] * o[i];
        ss += __shfl_xor(ss, 1); ss += __shfl_xor(ss, 2); ss += __shfl_xor(ss, 4);
        const float rinv = rsqrtf(ss * (1.f / 128.f) + EPS);
        u32x4 w0, w1;
#pragma unroll
        for (int i = 0; i < 4; ++i) { w0[i] = cvtpk(o[2 * i] * rinv * sg[2 * i], o[2 * i + 1] * rinv * sg[2 * i + 1]);
            w1[i] = cvtpk(o[8 + 2 * i] * rinv * sg[8 + 2 * i], o[9 + 2 * i] * rinv * sg[9 + 2 * i]); }
        *(u32x4*)(O + (size_t)row * DM + lane * 16) = w0; *(u32x4*)(O + (size_t)row * DM + lane * 16 + 8) = w1;
    }
}

__device__ __forceinline__ float logsig16(float x) { return (fminf(x, 0.f) - __logf(1.f + __expf(-fabsf(x)))) * 0.0625f; }
constexpr int NCH = KEYS / 64;

__device__ __forceinline__ void gla_g1(const Frame& F) {
    char* KT = F.lds; char* VV = F.lds + 16384; float* ZT = (float*)(F.lds + 49152); float* SEG = (float*)(F.lds + 53248);
    const u16* Kg = F.W<u16>(GL_K); const u16* Vg = F.W<u16>(GL_V); const float* Zg = F.W<float>(GL_Z);
    u16* ST = F.W<u16>(GL_STATE); float* DEC = F.W<float>(GL_DEC);
#pragma unroll 1
    for (int it = F.bx; it < NBATCH * 4 * 2 * NCH; it += F.G) {
        int tid = threadIdx.x; asm volatile("" : "+v"(tid));
        const int lane = tid & 63, wid = tid >> 6, r32 = lane & 31, hi = lane >> 5, kk = tid & 127, jq = tid >> 7;
        const int c = it % NCH, dir = (it / NCH) & 1, bh = it / (2 * NCH), b = bh >> 2, h = bh & 3;
        const int s0 = 64 * c;
        int tbase, tstep;
        if (dir == 0) { tbase = (c < 4) ? b * CTXL + s0 : NCTX + b * SEQ + s0 - CTXL; tstep = 1; }
        else { tbase = (c < 4) ? b * CTXL + (CTXL - 1) - s0 : NCTX + b * SEQ + (SEQ - 1) - (s0 - CTXL); tstep = -1; }
        __syncthreads();
        for (int i = tid; i < 1024; i += NTHR) { const int j = i >> 4, r = i & 15; ZT[i] = Zg[(size_t)(tbase + tstep * j) * 32 + dir * 16 + r]; }
#pragma unroll
        for (int q = 0; q < 4; ++q) { const int id = tid + q * NTHR, key = id >> 5, cc = (id & 31) * 8;
            *(bf16x8*)(VV + v_st<8>(key, cc)) = *(const bf16x8*)(Vg + (size_t)(tbase + tstep * key) * 1024 + h * 256 + cc); }
        float wg[16];
#pragma unroll
        for (int r = 0; r < 16; ++r) wg[r] = F.in(19)[(dir * 16 + r) * 512 + h * 128 + kk];
        const float bias = F.in(20)[dir * 512 + h * 128 + kk];
        __syncthreads();
        float cv[16]; float run = 0;
#pragma unroll
        for (int jj = 0; jj < 16; ++jj) { const int j = jq * 16 + jj; float x = bias;
#pragma unroll
            for (int r = 0; r < 16; ++r) x += ZT[j * 16 + r] * wg[r];
            run += logsig16(x); cv[jj] = run; }
        SEG[jq * 128 + kk] = run;
        __syncthreads();
        float offset = 0, total = 0;
#pragma unroll
        for (int q = 0; q < 4; ++q) { const float sv = SEG[q * 128 + kk]; total += sv; if (q < jq) offset += sv; }
        u32x4 w0, w1;
#pragma unroll
        for (int i = 0; i < 8; ++i) {
            const int j0 = jq * 16 + 2 * i;
            const float k0 = bf2f(Kg[(size_t)(tbase + tstep * j0) * 512 + h * 128 + kk]) * __expf(total - (offset + cv[2 * i]));
            const float k1 = bf2f(Kg[(size_t)(tbase + tstep * (j0 + 1)) * 512 + h * 128 + kk]) * __expf(total - (offset + cv[2 * i + 1]));
            const unsigned pk = cvtpk(k0, k1); if (i < 4) w0[i] = pk; else w1[i - 4] = pk; }
        *(u32x4*)(KT + kk * 128 + (((jq * 2) ^ ((kk >> 1) & 7)) << 4)) = w0;
        *(u32x4*)(KT + kk * 128 + (((jq * 2 + 1) ^ ((kk >> 1) & 7)) << 4)) = w1;
        if (jq == 0) DEC[(size_t)it * 128 + kk] = __expf(total);
        __syncthreads();
        const int mt = wid & 3, vb = (wid >> 2) * 4;
        const int row = mt * 32 + r32, ab = row * 128 + ((hi ^ ((row >> 1) & 7)) << 4);
        const bf16x8 pa0 = *(const bf16x8*)(KT + (ab ^ 0)), pa1 = *(const bf16x8*)(KT + (ab ^ 32)), pa2 = *(const bf16x8*)(KT + (ab ^ 64)), pa3 = *(const bf16x8*)(KT + (ab ^ 96));
        f32x16 acc[4];
#pragma unroll
        for (int n = 0; n < 4; ++n) acc[n] = f32x16{};
        const int vbase = (int)(uintptr_t)VV + v_rd_base(lane) + vb * 512;
        pv_one<0, 8>(acc[0], vbase, pa0, pa1, pa2, pa3); pv_one<1, 8>(acc[1], vbase, pa0, pa1, pa2, pa3);
        pv_one<2, 8>(acc[2], vbase, pa0, pa1, pa2, pa3); pv_one<3, 8>(acc[3], vbase, pa0, pa1, pa2, pa3);
        u16* S = ST + (size_t)it * 128 * 256;
#pragma unroll
        for (int n = 0; n < 4; ++n)
#pragma unroll
            for (int r = 0; r < 16; ++r) S[(mt * 32 + crow(r, hi)) * 256 + (vb + n) * 32 + r32] = f2bf(acc[n][r]);
    }
}
__device__ __forceinline__ void gla_g2(const Frame& F) {
    u16* ST = F.W<u16>(GL_STATE); const float* DEC = F.W<float>(GL_DEC);
    for (int g = F.bx * NTHR + threadIdx.x; g < 32 * 4096; g += F.G * NTHR) {
        const int chain = g >> 12, e = g & 4095, kk = e >> 5, v8 = (e & 31) * 8;
        u16* p = ST + ((size_t)chain * NCH * 128 + kk) * 256 + v8; const float* d = DEC + (size_t)chain * NCH * 128 + kk;
        float f[8];
#pragma unroll
        for (int i = 0; i < 8; ++i) f[i] = 0.f;
        for (int c = 0; c < NCH; c += 4) {
            bf16x8 kv[4]; float dc[4];
#pragma unroll
            for (int u = 0; u < 4; ++u) { kv[u] = *(const bf16x8*)(p + (size_t)(c + u) * 128 * 256); dc[u] = d[(size_t)(c + u) * 128]; }
#pragma unroll
            for (int u = 0; u < 4; ++u) {
                u32x4 w = {cvtpk(f[0], f[1]), cvtpk(f[2], f[3]), cvtpk(f[4], f[5]), cvtpk(f[6], f[7])};
                *(u32x4*)(p + (size_t)(c + u) * 128 * 256) = w;
#pragma unroll
                for (int i = 0; i < 8; ++i) f[i] = dc[u] * f[i] + bf2f((u16)kv[u][i]);
            }
        }
    }
}
__device__ __forceinline__ void gla_g3(const Frame& F) {
    char* QD = F.lds; char* KI = F.lds + 16384; char* VV = F.lds + 32768; char* SS = F.lds + 65536; float* OL = (float*)(F.lds + 65536);
    float* ZT = (float*)(F.lds + 132096); float* SEG = (float*)(F.lds + 136192);
    const u16* Qg = F.W<u16>(GL_Q); const u16* Kg = F.W<u16>(GL_K); const u16* Vg = F.W<u16>(GL_V); const u16* Gg = F.W<u16>(GL_G); const float* Zg = F.W<float>(GL_Z);
    const u16* ST = F.W<u16>(GL_STATE); u16* OUT = F.W<u16>(WS_H);
#pragma unroll 1
    for (int it = F.bx; it < NBATCH * 4 * NCH; it += F.G) {
        int tid = threadIdx.x; asm volatile("" : "+v"(tid));
        const int lane = tid & 63, wid = tid >> 6, r32 = lane & 31, hi = lane >> 5, kk = tid & 127, jq = tid >> 7;
        const int T = it % NCH, bh = it / NCH, b = bh >> 2, h = bh & 3;
        const int t0 = (T < 4) ? b * CTXL + 64 * T : NCTX + b * SEQ + 64 * (T - 4);
        __syncthreads();
#pragma unroll
        for (int q = 0; q < 4; ++q) { const int id = tid + q * NTHR, key = id >> 5, cc = (id & 31) * 8;
            *(bf16x8*)(VV + v_st<8>(key, cc)) = *(const bf16x8*)(Vg + (size_t)(t0 + key) * 1024 + h * 256 + cc); }
        const int itile = wid & 1, vb = (wid >> 1) * 2;
        f32x16 acc[2]; acc[0] = f32x16{}; acc[1] = f32x16{};
#pragma unroll 1
        for (int dir = 0; dir < 2; ++dir) {
            const int cd = dir == 0 ? T : (T < 4 ? 3 - T : 135 - T);
            const u16* Ssrc = ST + (size_t)((bh * 2 + dir) * NCH + cd) * 128 * 256;
#pragma unroll
            for (int q = 0; q < 8; ++q) { const int id = tid + q * NTHR, key = id >> 5, cc = (id & 31) * 8;
                *(bf16x8*)(SS + v_st<8>(key, cc)) = *(const bf16x8*)(Ssrc + (size_t)key * 256 + cc); }
            for (int i = tid; i < 1024; i += NTHR) { const int j = i >> 4, r = i & 15; ZT[i] = Zg[(size_t)(t0 + j) * 32 + dir * 16 + r]; }
            float wg[16];
#pragma unroll
            for (int r = 0; r < 16; ++r) wg[r] = F.in(19)[(dir * 16 + r) * 512 + h * 128 + kk];
            const float bias = F.in(20)[dir * 512 + h * 128 + kk];
            __syncthreads();
            float cv[16]; float run = 0;
#pragma unroll
            for (int u = 0; u < 16; ++u) { const int j = jq * 16 + u; float x = bias;
#pragma unroll
                for (int r = 0; r < 16; ++r) x += ZT[j * 16 + r] * wg[r];
                cv[u] = logsig16(x); }
            if (dir == 0) {
#pragma unroll
                for (int u = 0; u < 16; ++u) { run += cv[u]; cv[u] = run; }
            } else {
#pragma unroll
                for (int u = 15; u >= 0; --u) { run += cv[u]; cv[u] = run; }
            }
            SEG[jq * 128 + kk] = run;
            __syncthreads();
            float offset = 0;
#pragma unroll
            for (int q = 0; q < 4; ++q) { const float sv = SEG[q * 128 + kk]; if (dir == 0 ? (q < jq) : (q > jq)) offset += sv; }
            const int adb = jq * 4096 + ((kk >> 3) << 4) + (kk & 7) * 2;
#pragma unroll
            for (int jj = 0; jj < 16; ++jj) { const int i = jq * 16 + jj; const float cum = offset + cv[jj];
                const float qv = bf2f(Qg[(size_t)(t0 + i) * 512 + h * 128 + kk]) * __expf(cum);
                const float kv = bf2f(Kg[(size_t)(t0 + i) * 512 + h * 128 + kk]) * __expf(-cum);
                const int ad = (adb ^ (jj << 4)) + jj * 256;
                *(u16*)(QD + ad) = f2bf(qv); *(u16*)(KI + ad) = f2bf(kv); }
            __syncthreads();
            {
                const int row = itile * 32 + r32; bf16x8 qa[8];
#pragma unroll
                for (int ks = 0; ks < 8; ++ks) qa[ks] = *(const bf16x8*)(QD + row * 256 + (((ks * 2 + hi) ^ (row & 15)) << 4));
                const int ssb = (int)(uintptr_t)SS + v_rd_base(lane) + vb * 512;
                pv_one<0, 8>(acc[0], ssb, qa[0], qa[1], qa[2], qa[3]); pv_one<0, 8>(acc[0], ssb + 32768, qa[4], qa[5], qa[6], qa[7]);
                pv_one<1, 8>(acc[1], ssb, qa[0], qa[1], qa[2], qa[3]); pv_one<1, 8>(acc[1], ssb + 32768, qa[4], qa[5], qa[6], qa[7]);
                f32x16 p0 = f32x16{}, p1 = f32x16{};
#pragma unroll
                for (int ks = 0; ks < 8; ++ks) {
                    const bf16x8 k0 = *(const bf16x8*)(KI + r32 * 256 + (((ks * 2 + hi) ^ (r32 & 15)) << 4));
                    const bf16x8 k1 = *(const bf16x8*)(KI + (32 + r32) * 256 + (((ks * 2 + hi) ^ (r32 & 15)) << 4));
                    p0 = __builtin_amdgcn_mfma_f32_32x32x16_bf16(k0, qa[ks], p0, 0, 0, 0);
                    p1 = __builtin_amdgcn_mfma_f32_32x32x16_bf16(k1, qa[ks], p1, 0, 0, 0);
                }
                const int iq = itile * 32 + r32;
#pragma unroll
                for (int r = 0; r < 16; ++r) { const int s0 = crow(r, hi), s1 = 32 + s0;
                    const bool k0 = dir == 0 ? (s0 <= iq) : (s0 >= iq), k1 = dir == 0 ? (s1 <= iq) : (s1 >= iq);
                    p0[r] = k0 ? p0[r] : 0.f; p1[r] = k1 ? p1[r] : 0.f; }
                bf16x8 pa0, pa1, pa2, pa3;
                PK4(p0, 0, pa0); PK4(p0, 8, pa1); PK4(p1, 0, pa2); PK4(p1, 8, pa3);
                const int vvb = (int)(uintptr_t)VV + v_rd_base(lane) + vb * 512;
                pv_one<0, 8>(acc[0], vvb, pa0, pa1, pa2, pa3); pv_one<1, 8>(acc[1], vvb, pa0, pa1, pa2, pa3);
            }
            __syncthreads();
        }
        float* olb = OL + (itile * 32 + 4 * hi) * 260 + vb * 32 + r32;
#pragma unroll
        for (int n = 0; n < 2; ++n)
#pragma unroll
            for (int r = 0; r < 16; ++r) olb[((r & 3) + 8 * (r >> 2)) * 260 + n * 32] = acc[n][r];
        __syncthreads();
        {
            const int i = tid >> 3, sg = tid & 7; const float* ol = OL + i * 260 + sg * 32;
            float ss = 0;
#pragma unroll
            for (int u = 0; u < 8; ++u) { const f32x4 t = *(const f32x4*)(ol + u * 4); ss += t[0] * t[0] + t[1] * t[1] + t[2] * t[2] + t[3] * t[3]; }
            ss += __shfl_xor(ss, 1); ss += __shfl_xor(ss, 2); ss += __shfl_xor(ss, 4);
            const float rinv = rsqrtf(ss * (1.f / 256.f) + EPS);
            const u16* gp = Gg + (size_t)(t0 + i) * 1024 + h * 256 + sg * 32; u16* op = OUT + (size_t)(t0 + i) * 1024 + h * 256 + sg * 32;
            const float* hn = F.in(21) + sg * 32;
#pragma unroll
            for (int q = 0; q < 4; ++q) { const bf16x8 g8 = *(const bf16x8*)(gp + q * 8); u32x4 w;
                const f32x4 oa = *(const f32x4*)(ol + q * 8), ob = *(const f32x4*)(ol + q * 8 + 4);
                const float o8[8] = {oa[0], oa[1], oa[2], oa[3], ob[0], ob[1], ob[2], ob[3]};
#pragma unroll
                for (int u = 0; u < 4; ++u) { const int e0 = q * 8 + 2 * u;
                    w[u] = cvtpk(o8[2 * u] * rinv * hn[e0] * silu_f(bf2f((u16)g8[2 * u])), o8[2 * u + 1] * rinv * hn[e0 + 1] * silu_f(bf2f((u16)g8[2 * u + 1]))); }
                *(u32x4*)(op + q * 8) = w; }
        }
    }
}

__device__ __forceinline__ void pair_decode(int p, int& elo, int& ehi) { elo = p < 3 ? 0 : (p < 5 ? 1 : 2); ehi = p < 3 ? p + 1 : (p < 5 ? p - 1 : 3); }
__device__ __forceinline__ void moe_gemm_a(const Frame& F, int li) {
    int* tab = (int*)(F.lds + LDS_TAB); moe_table(F, li, tab);
    const int nmt = tab[24] >> 8;
    for (int tile = F.bx; tile < nmt * 16; tile += F.G) {
        const int mt = tile >> 4, nt = tile & 15, c = tab[32 + mt], g = c / 6; int elo, ehi; pair_decode(c % 6, elo, ehi);
        const int half = nt >> 3, e = half ? ehi : elo;
        RowsGather al{F.W<u16>(WS_H), 1024, F.W<int>(WS_ROWTOK)};
        RowsPlain bl{F.W<u16>(WS_MOEW) + ((size_t)(g * 4 + e) * 1024 + (nt & 7) * 128) * 1024, 1024};
        EpiMoeA ep{F.W<u16>(MOE_ACT), F.W<float>(WS_ROWW), half, half * 512 + (nt & 7) * 64};
        gemm_tile<4, 2>(F.lds, al, bl, ep, mt * 256, 0, 16);
    }
}
__device__ __forceinline__ void moe_gemm_b(const Frame& F, int li) {
    int* tab = (int*)(F.lds + LDS_TAB); moe_table(F, li, tab);
    const int nmt = tab[24] >> 8;
    for (int tile = F.bx; tile < nmt * 8; tile += F.G) {
        const int mt = tile >> 3, nt = tile & 7, c = tab[32 + mt], g = c / 6; int elo, ehi; pair_decode(c % 6, elo, ehi);
        const u16* wd = F.W<u16>(WS_MOEW + MOE_WGU_BYTES);
        RowsPlain al{F.W<u16>(MOE_ACT), 1024};
        RowsSplitK bl{wd + (size_t)(g * 4 + elo) * 1024 * 512, wd + (size_t)(g * 4 + ehi) * 1024 * 512, 512, 8};
        EpiMoeB ep{F, li, F.W<int>(WS_ROWTOK)};
        gemm_tile<4, 2>(F.lds, al, bl, ep, mt * 256, nt * 128, 16);
    }
}
__device__ __forceinline__ void final_norm(const Frame& F) {
    const int lane = threadIdx.x & 63, wid = threadIdx.x >> 6;
    for (int row = F.bx * NWAVE + wid; row < NLAT; row += F.G * NWAVE) {
        float* xr = F.out + (size_t)row * DM; f32x4 v[4];
#pragma unroll
        for (int i = 0; i < 4; ++i) v[i] = *(const f32x4*)(xr + i * 256 + lane * 4);
        float ss = 0;
#pragma unroll
        for (int i = 0; i < 4; ++i) ss += v[i][0] * v[i][0] + v[i][1] * v[i][1] + v[i][2] * v[i][2] + v[i][3] * v[i][3];
        ss = wave_sum(ss); const float rinv = rsqrtf(ss * (1.f / DM) + EPS);
#pragma unroll
        for (int i = 0; i < 4; ++i) { const f32x4 g = *(const f32x4*)(F.in(30) + i * 256 + lane * 4);
            f32x4 o = {v[i][0] * rinv * g[0], v[i][1] * rinv * g[1], v[i][2] * rinv * g[2], v[i][3] * rinv * g[3]};
            *(f32x4*)(xr + i * 256 + lane * 4) = o; }
    }
}

constexpr int N_PHASES = 42;
__global__ void __launch_bounds__(NTHR, 2) fwd_kernel(Params p) {
    extern __shared__ __attribute__((aligned(16))) char lds[];
    Frame F; F.p = &p; F.ws = p.ws; F.lds = lds; F.out = p.out; F.G = (int)gridDim.x; F.bx = (int)blockIdx.x;
    const int lo = p.ph_lo, hi = p.ph_hi;
#if !MK_PER_PHASE
    if (threadIdx.x == 0) *(uint4*)(lds + LDS_BARW) = make_uint4(0u, 0u, 0u, 0u);
    __syncthreads();
    XcdBarrier bar = xcd_barrier_post((unsigned*)(p.ws + WS_CTL), (volatile LAS unsigned*)(lds + LDS_BARW));
#define GRID_BAR() xcd_barrier(bar)
#else
#define GRID_BAR() do {} while (0)
#endif
#ifndef MK_EN
#define MK_EN 0xFFFFFFFFu
#endif
#define EN(g) (((MK_EN) >> (g)) & 1u)
#define IN(k) (lo <= (k) && (k) < hi)
#define SEAM(k) do { if ((k) + 1 < hi) GRID_BAR(); } while (0)

    if (EN(0) && IN(0)) { p0_mods(F); __syncthreads(); p0_rope(F); p0_weights(F); SEAM(0); }

#define LAYER(LI) { constexpr int li = (LI); constexpr int base = 1 + li * 10; constexpr bool first = li == 0, last = li == DEPTH - 1; constexpr int kind = li % 3, j = li / 3; \
        if (EN(1) && IN(base + 0)) { norm_phase<false>(F, li, 0, first); SEAM(base + 0); } \
        if constexpr (kind == 0) { \
            if (EN(2) && IN(base + 1)) { EpiF32 ep{F.W<float>(MLA_DQ), 544, 544}; \
                gemm_phase<4, 2>(F, RowsPlain{F.W<u16>(WS_H), 1024}, RowsPlain{F.W<u16>(WS_WDQKV) + (size_t)j * 640 * 1024, 1024}, ep, 0, 132, 5, 16, 0, 0); SEAM(base + 1); } \
            if (EN(3) && IN(base + 2)) { mla_rowpass(F, j); SEAM(base + 2); } \
            if (EN(2) && IN(base + 3)) { \
                EpiMlaQ eq{F.W<u16>(MLA_Q), F.W<float>(WS_ROPEA), F.W<float>(WS_ROPEA) + SEQ * 16, 0.10206207261596577f * LOG2E}; \
                gemm_phase<4, 2>(F, RowsPlain{F.W<u16>(MLA_CN), 512}, RowsPlain{F.W<u16>(WS_WUQ) + (size_t)j * 1536 * 256, 256}, eq, 0, 132, 12, 4, 0, 0); \
                EpiMlaKV ek{F.W<u16>(MLA_KN), (long)((MLA_V - MLA_KN) / 2)}; \
                gemm_phase<4, 2>(F, RowsPlain{F.W<u16>(MLA_CN) + 256, 512}, RowsPlain{F.W<u16>(WS_WUKV) + (size_t)j * 2048 * 256, 256}, ek, 0, 132, 16, 4, 132 * 12, 0); \
                SEAM(base + 3); } \
            if (EN(4) && IN(base + 4)) { mla_attn(F, !last); SEAM(base + 4); } \
            if (EN(2) && IN(base + 5)) { EpiResid ep{F, li, 2, first}; \
                gemm_phase<4, 2>(F, RowsPlain{F.W<u16>(MLA_DQ), 1024}, RowsPlain{F.W<u16>(WS_WOM) + (size_t)j * 1024 * 1024, 1024}, ep, last ? 4 : 0, 132, 8, 16, 0, 0); SEAM(base + 5); } \
        } else if constexpr (kind == 1) { \
            if (EN(5) && IN(base + 1)) { EpiDiffQKV ep{F.W<u16>(DF_Q), (long)((DF_K - DF_Q) / 2), F.W<u16>(DF_V), F.W<float>(WS_ROPEB), F.W<float>(WS_ROPEB) + SEQ * 32, 0.125f * LOG2E}; \
                gemm_phase<4, 2>(F, RowsPlain{F.W<u16>(WS_H), 1024}, RowsPlain{F.W<u16>(WS_WQKVD), 1024}, ep, 0, 132, 24, 16, 0, 0); SEAM(base + 1); } \
            if (EN(6) && IN(base + 2)) { diff_attn(F); SEAM(base + 2); } \
            if (EN(7) && IN(base + 3)) { diff_rowpass(F, 0.35550906759906f); SEAM(base + 3); } \
            if (EN(5) && IN(base + 4)) { EpiResid ep{F, li, 2, first}; \
                gemm_phase<4, 2>(F, RowsPlain{F.W<u16>(DF_Q), 1024}, RowsPlain{F.W<u16>(WS_WOD), 1024}, ep, 0, 132, 8, 16, 0, 0); SEAM(base + 4); } \
        } else { \
            if (EN(8) && IN(base + 1)) { EpiGlaIn ep{F.W<u16>(GL_Q), F.W<u16>(GL_K), F.W<u16>(GL_V), F.W<u16>(GL_G), F.W<float>(GL_Z)}; \
                gemm_phase<4, 2>(F, RowsPlain{F.W<u16>(WS_H), 1024}, RowsPlain{F.W<u16>(WS_WING), 1024}, ep, 0, 132, 25, 16, 0, 0); SEAM(base + 1); } \
            if (EN(9) && IN(base + 2)) { gla_g1(F); SEAM(base + 2); } \
            if (EN(10) && IN(base + 3)) { gla_g2(F); SEAM(base + 3); } \
            if (EN(11) && IN(base + 4)) { gla_g3(F); SEAM(base + 4); } \
            if (EN(8) && IN(base + 5)) { EpiResid ep{F, li, 2, first}; \
                gemm_phase<4, 2>(F, RowsPlain{F.W<u16>(WS_H), 1024}, RowsPlain{F.W<u16>(WS_WOG), 1024}, ep, 0, 132, 8, 16, 0, 0); SEAM(base + 5); } \
        } \
        if (EN(12) && IN(base + 6)) { norm_phase<true>(F, li, last ? NCTX : 0, false); SEAM(base + 6); } \
        if (EN(13) && IN(base + 7)) { moe_weights(F, li); moe_scatter(F, li, last ? NCTX : 0); SEAM(base + 7); } \
        if (EN(14) && IN(base + 8)) { moe_gemm_a(F, li); SEAM(base + 8); } \
        if (EN(15) && IN(base + 9)) { moe_gemm_b(F, li); SEAM(base + 9); } \
    }
    LAYER(0) LAYER(1) LAYER(2) LAYER(3)
    if (EN(16) && IN(41)) { final_norm(F); }
}

extern "C" void kernel_launch(void* const* d_in, const int* in_sizes, int n_in, void* d_out, int out_size, void* d_ws, size_t ws_size, hipStream_t stream) {
    static int grid = 0;
    if (grid == 0) {
        if (n_in != 31 || out_size != NLAT * DM || ws_size < WS_END) {
            fprintf(stderr, "kernel_launch: built for 31 inputs, out %d floats, ws >= %zu bytes; got n_in %d out %d ws %zu\n", NLAT * DM, (size_t)WS_END, n_in, out_size, ws_size);
            grid = -1; return; }
        int dev = 0, cus = 0;
        if (hipGetDevice(&dev) != hipSuccess || hipDeviceGetAttribute(&cus, hipDeviceAttributeMultiprocessorCount, dev) != hipSuccess) { grid = -1; return; }
        if (hipFuncSetAttribute((const void*)fwd_kernel, hipFuncAttributeMaxDynamicSharedMemorySize, LDS_BYTES) != hipSuccess) { fprintf(stderr, "kernel_launch: hipFuncSetAttribute failed\n"); grid = -1; return; }
        int per_cu = 0;
        if (hipOccupancyMaxActiveBlocksPerMultiprocessor(&per_cu, (const void*)fwd_kernel, NTHR, LDS_BYTES) != hipSuccess || per_cu < 1)
            fprintf(stderr, "kernel_launch: occupancy query reports %d workgroups per CU\n", per_cu);
        (void)hipGetLastError();
        grid = cus;
    }
    if (grid < 0) return;
    (void)in_sizes;
    (void)hipMemsetAsync((char*)d_ws + WS_CTL, 0, CTL_BYTES, stream);
    Params p{};
    for (int i = 0; i < 31; ++i) p.in[i] = (const float*)d_in[i];
    p.out = (float*)d_out; p.ws = (unsigned char*)d_ws;
#if MK_PER_PHASE
    for (int ph = 0; ph < N_PHASES; ++ph) { p.ph_lo = ph; p.ph_hi = ph + 1; hipLaunchKernelGGL(fwd_kernel, dim3(grid), dim3(NTHR), LDS_BYTES, stream, p); }
#else
    p.ph_lo = 0; p.ph_hi = N_PHASES;
    hipLaunchKernelGGL(fwd_kernel, dim3(grid), dim3(NTHR), LDS_BYTES, stream, p);
#endif
}
```

```cpp
#include <hip/hip_runtime.h>
#include <stdint.h>
#include <stdio.h>

#ifndef MK_PER_PHASE
#define MK_PER_PHASE 0
#endif

typedef unsigned short u16;
using bf16x8 = __attribute__((ext_vector_type(8))) short;
using s16x4  = __attribute__((ext_vector_type(4))) short;
using f32x16 = __attribute__((ext_vector_type(16))) float;
using f32x4  = __attribute__((ext_vector_type(4))) float;
using u32x4  = __attribute__((ext_vector_type(4))) unsigned;
using u32x2  = __attribute__((ext_vector_type(2))) unsigned;

constexpr int DM = 1024, NBATCH = 4, SEQ = 8192, CTXL = 256, DEPTH = 4;
constexpr int NCTX = NBATCH * CTXL;
constexpr int NLAT = NBATCH * SEQ;
constexpr int NTOK = NCTX + NLAT;
constexpr int KEYS = CTXL + SEQ;
constexpr float EPS = 1e-6f;
constexpr int NTHR = 512, NWAVE = 8;
constexpr float LOG2E = 1.4426950408889634f;

constexpr size_t al256(size_t x) { return (x + 255) / 256 * 256; }
constexpr size_t WS_CTL   = 0;
constexpr size_t CTL_BYTES = 32768;
constexpr size_t WS_MODS  = WS_CTL + CTL_BYTES;
constexpr size_t WS_ROPEA = WS_MODS + al256((size_t)DEPTH * 5 * 6144 * 4);
constexpr size_t WS_ROPEB = WS_ROPEA + (size_t)2 * SEQ * 16 * 4;
constexpr size_t WS_XC    = WS_ROPEB + (size_t)2 * SEQ * 32 * 4;
constexpr size_t WS_WDQKV = WS_XC + (size_t)NCTX * DM * 4;
constexpr size_t WS_WUQ   = WS_WDQKV + (size_t)2 * 640 * 1024 * 2;
constexpr size_t WS_WUKV  = WS_WUQ + (size_t)2 * 1536 * 256 * 2;
constexpr size_t WS_WOM   = WS_WUKV + (size_t)2 * 2048 * 256 * 2;
constexpr size_t WS_WQKVD = WS_WOM + (size_t)2 * 1024 * 1024 * 2;
constexpr size_t WS_WOD   = WS_WQKVD + (size_t)3072 * 1024 * 2;
constexpr size_t WS_WING  = WS_WOD + (size_t)1024 * 1024 * 2;
constexpr size_t WS_WOG   = WS_WING + (size_t)3200 * 1024 * 2;
constexpr size_t WS_TOK   = WS_WOG + (size_t)1024 * 1024 * 2;
constexpr size_t WS_ROWTOK= WS_TOK + (size_t)NTOK * 16;
constexpr int    RMAX     = 40960;
constexpr size_t WS_ROWW  = WS_ROWTOK + (size_t)RMAX * 4;
constexpr size_t WS_H     = al256(WS_ROWW + (size_t)RMAX * 8);
constexpr size_t H_BYTES  = (size_t)NTOK * DM * 2;
constexpr size_t WS_MOEW  = WS_H + H_BYTES;
constexpr size_t MOE_WGU_BYTES = (size_t)16 * 1024 * 1024 * 2;
constexpr size_t MOE_WD_BYTES  = (size_t)16 * 1024 * 512 * 2;
constexpr size_t MOEW_BYTES = MOE_WGU_BYTES + MOE_WD_BYTES;
constexpr size_t WS_BIG   = WS_MOEW + MOEW_BYTES;
constexpr size_t MLA_Q    = WS_BIG;
constexpr size_t MLA_KN   = MLA_Q + (size_t)NBATCH * 16 * KEYS * 96 * 2;
constexpr size_t MLA_V    = MLA_KN + (size_t)NBATCH * 16 * KEYS * 64 * 2;
constexpr size_t MLA_KPE  = MLA_V + (size_t)NBATCH * 16 * KEYS * 64 * 2;
constexpr size_t MLA_DQ   = MLA_KPE + al256((size_t)NBATCH * KEYS * 32 * 2);
constexpr size_t MLA_CN   = MLA_DQ + (size_t)NTOK * 544 * 4;
constexpr size_t MLA_END  = MLA_CN + (size_t)NTOK * 512 * 2;
constexpr size_t DF_Q     = WS_BIG;
constexpr size_t DF_K     = DF_Q + (size_t)NBATCH * 16 * KEYS * 64 * 2;
constexpr size_t DF_V     = DF_K + (size_t)NBATCH * 16 * KEYS * 64 * 2;
constexpr size_t DF_OS    = DF_V + (size_t)NBATCH * 8 * KEYS * 128 * 2;
constexpr size_t DF_END   = DF_OS + (size_t)2 * NTOK * DM * 2;
constexpr size_t GL_STATE = WS_MOEW;
constexpr size_t GL_STATE_BYTES = (size_t)NBATCH * 4 * 2 * 132 * 128 * 256 * 2;
constexpr size_t GL_DEC   = GL_STATE + GL_STATE_BYTES;
constexpr size_t GL_Q     = GL_DEC + al256((size_t)4224 * 128 * 4);
constexpr size_t GL_K     = GL_Q + (size_t)NTOK * 512 * 2;
constexpr size_t GL_V     = GL_K + (size_t)NTOK * 512 * 2;
constexpr size_t GL_G     = GL_V + (size_t)NTOK * 1024 * 2;
constexpr size_t GL_Z     = GL_G + (size_t)NTOK * 1024 * 2;
constexpr size_t GL_END   = GL_Z + (size_t)NTOK * 32 * 4;
constexpr size_t MOE_ACT  = WS_BIG;
constexpr size_t MOE_END  = MOE_ACT + (size_t)RMAX * 1024 * 2;
constexpr size_t cmax(size_t a, size_t b) { return a > b ? a : b; }
constexpr size_t WS_END   = cmax(cmax(MLA_END, DF_END), cmax(GL_END, MOE_END));

#define XCD_BAR_WORDS 3456
constexpr int CW_CNT = 4096;

#define XB_TMO      128
#define XB_XCNT(j)  (256  + 64 * (j))
#define XB_XSUB(j)  (1280 + 64 * (j))
#define XB_XGEN(j)  (2304 + 64 * (j))
#define XB_TOP      3328
#define XB_TOPGEN   3392
#define XB_SPIN_CAP (1u << 24)
#define LAS __attribute__((address_space(3)))
__device__ __forceinline__ unsigned xb_ld(unsigned* p)              { return __hip_atomic_load(p, __ATOMIC_RELAXED, __HIP_MEMORY_SCOPE_AGENT); }
__device__ __forceinline__ unsigned xb_add(unsigned* p, unsigned v) { return __hip_atomic_fetch_add(p, v, __ATOMIC_RELAXED, __HIP_MEMORY_SCOPE_AGENT); }
__device__ __forceinline__ unsigned xb_xcc_id() { return (unsigned)__builtin_amdgcn_s_getreg((3 << 11) | 20) & 0xFu; }
#define XB_SPIN(cond, bar) do { unsigned _sp = 0; while (cond) { __builtin_amdgcn_s_sleep(1); \
    if ((++_sp & 255u) == 0u) { if (xb_ld(&(bar)[XB_TMO])) break; if (_sp > XB_SPIN_CAP) { atomicAdd(&(bar)[XB_TMO], 1u); break; } } } } while (0)
struct XcdBarrier { unsigned* bar; unsigned x; volatile LAS unsigned* st; };
__device__ __forceinline__ XcdBarrier xcd_barrier_post(unsigned* bar, volatile LAS unsigned* st) {
    XcdBarrier b; b.bar = bar; b.x = xb_xcc_id(); b.st = st;
    if (threadIdx.x == 0) (void)xb_add(&bar[XB_XCNT(b.x)], 1u);
    return b;
}
__device__ __forceinline__ void xcd_barrier_complete(unsigned* bar, unsigned x, unsigned& nloc, unsigned& nx) {
    const unsigned G = gridDim.x * gridDim.y * gridDim.z;
    unsigned sum, cnt, mine, sp = 0u;
    for (;;) {
        sum = 0u; cnt = 0u; mine = 0u;
#pragma unroll
        for (unsigned j = 0; j < 16; ++j) { const unsigned c = xb_ld(&bar[XB_XCNT(j)]); sum += c; cnt += (c > 0u) ? 1u : 0u; mine = (j == x) ? c : mine; }
        if (sum == G) break;
        __builtin_amdgcn_s_sleep(1);
        if ((++sp & 255u) == 0u) { if (xb_ld(&bar[XB_TMO])) break; if (sp > XB_SPIN_CAP) { atomicAdd(&bar[XB_TMO], 1u); break; } }
    }
    nloc = mine > 0u ? mine : 1u; nx = cnt > 0u ? cnt : 1u;
}
__device__ __forceinline__ void xcd_barrier(const XcdBarrier& b) {
    asm volatile("s_waitcnt vmcnt(0)" ::: "memory");
    __syncthreads();
    if (threadIdx.x == 0) {
        unsigned* bar = b.bar;
        __builtin_amdgcn_s_waitcnt(0);
        unsigned nloc = b.st[0], nx = b.st[1];
        if (nloc == 0u) { xcd_barrier_complete(bar, b.x, nloc, nx); b.st[0] = nloc; b.st[1] = nx; }
        const unsigned old = xb_add(&bar[XB_XSUB(b.x)], 1u);
        const unsigned gen = old / nloc;
        if (old + 1u == (gen + 1u) * nloc) {
            __builtin_amdgcn_fence(__ATOMIC_RELEASE, "agent");
            asm volatile("s_waitcnt vmcnt(0)" ::: "memory");
            const unsigned og = xb_add(&bar[XB_TOP], 1u);
            const unsigned tg = og / nx;
            if (og + 1u == (tg + 1u) * nx) xb_add(&bar[XB_TOPGEN], 1u);
            else XB_SPIN(xb_ld(&bar[XB_TOPGEN]) == tg, bar);
            __builtin_amdgcn_fence(__ATOMIC_ACQUIRE, "agent");
            xb_add(&bar[XB_XGEN(b.x)], 1u);
            asm volatile("s_waitcnt vmcnt(0)" ::: "memory");
        } else {
            XB_SPIN(xb_ld(&bar[XB_XGEN(b.x)]) == gen, bar);
            __builtin_amdgcn_fence(__ATOMIC_ACQUIRE, "agent");
            asm volatile("s_waitcnt vmcnt(0)" ::: "memory");
        }
    }
    __syncthreads();
}

__device__ __forceinline__ u16 f2bf(float f) { unsigned u = __float_as_uint(f); u += 0x7FFFu + ((u >> 16) & 1u); return (u16)(u >> 16); }
__device__ __forceinline__ float bf2f(u16 h) { return __uint_as_float((unsigned)h << 16); }
__device__ __forceinline__ unsigned cvtpk(float lo, float hi) { unsigned r; asm volatile("v_cvt_pk_bf16_f32 %0, %1, %2" : "=v"(r) : "v"(lo), "v"(hi)); return r; }
__device__ __forceinline__ float wave_sum(float v) {
#pragma unroll
    for (int o = 32; o; o >>= 1) v += __shfl_xor(v, o);
    return v;
}
__device__ __forceinline__ int crow(int r, int hi) { return (r & 3) + 8 * (r >> 2) + 4 * hi; }
__device__ __forceinline__ void row_bp(int row, int& b, int& pos) {
    if (row < NCTX) { b = row >> 8; pos = row & 255; } else { const int r = row - NCTX; b = r >> 13; pos = CTXL + (r & (SEQ - 1)); }
}
__device__ __forceinline__ float silu_f(float x) { return x / (1.f + __expf(-x)); }
#define SBAR() __builtin_amdgcn_sched_barrier(0)

struct Params { const float* in[31]; float* out; unsigned char* ws; int ph_lo, ph_hi; };

struct RowsPlain  { const u16* base; long ld;
    __device__ __forceinline__ long off(int r) const { return (long)r * ld; }
    __device__ __forceinline__ const u16* kbase(int kt) const { return base + kt * 64; } };
struct RowsGather { const u16* base; long ld; const int* idx;
    __device__ __forceinline__ long off(int r) const { int t = idx[r]; t = t < 0 ? 0 : t; return (long)t * ld; }
    __device__ __forceinline__ const u16* kbase(int kt) const { return base + kt * 64; } };
struct RowsSplitK { const u16* b0; const u16* b1; long ld; int ks;
    __device__ __forceinline__ long off(int r) const { return (long)r * ld; }
    __device__ __forceinline__ const u16* kbase(int kt) const { return kt < ks ? b0 + kt * 64 : b1 + (kt - ks) * 64; } };

constexpr int GEMM_LDS = 2 * 384 * 128;

template <int WM, int WN, class AL, class BL, class EP>
__device__ __forceinline__ void gemm_tile(char* lds, const AL al, const BL bl, EP& ep, int brow, int bcol, int nk) {
    constexpr int BM = WM * 64, BN = WN * 64, STG = (BM + BN) * 128, NA = BM / 64, NB = BN / 64;
    const int tid = threadIdx.x, lane = tid & 63, wid = __builtin_amdgcn_readfirstlane(tid >> 6);
    const int wm = wid / WN, wn = wid % WN, r32 = lane & 31, hi = lane >> 5;
    long aoff[NA], boff[NB];
#pragma unroll
    for (int i = 0; i < NA; ++i) { const int r = (i * 8 + wid) * 8 + (lane >> 3); const int c = (lane & 7) ^ ((r >> 1) & 7); aoff[i] = al.off(brow + r) + c * 8; }
#pragma unroll
    for (int i = 0; i < NB; ++i) { const int r = (i * 8 + wid) * 8 + (lane >> 3); const int c = (lane & 7) ^ ((r >> 1) & 7); boff[i] = bl.off(bcol + r) + c * 8; }
    const int ldsw = wid * 1024 + lane * 16;
    int abase[2], bbase[2];
#pragma unroll
    for (int i = 0; i < 2; ++i) {
        const int ra = wm * 64 + i * 32 + r32; abase[i] = ra * 128 + ((hi ^ ((ra >> 1) & 7)) << 4);
        const int rb = wn * 64 + i * 32 + r32; bbase[i] = BM * 128 + rb * 128 + ((hi ^ ((rb >> 1) & 7)) << 4);
    }
    f32x16 acc[2][2];
#pragma unroll
    for (int i = 0; i < 2; ++i)
#pragma unroll
        for (int j = 0; j < 2; ++j) acc[i][j] = f32x16{};
#define GSTAGE(kt, buf) do { const u16* _ka = al.kbase(kt); const u16* _kb = bl.kbase(kt); char* _d = lds + (buf) * STG + ldsw; \
        _Pragma("unroll") for (int _i = 0; _i < NA; ++_i) __builtin_amdgcn_global_load_lds((const unsigned*)(_ka + aoff[_i]), (unsigned*)(_d + _i * 8192), 16, 0, 0); \
        _Pragma("unroll") for (int _i = 0; _i < NB; ++_i) __builtin_amdgcn_global_load_lds((const unsigned*)(_kb + boff[_i]), (unsigned*)(_d + BM * 128 + _i * 8192), 16, 0, 0); } while (0)
    __syncthreads();
    GSTAGE(0, 0);
    for (int kt = 0; kt < nk; ++kt) {
        asm volatile("s_waitcnt vmcnt(0)" ::: "memory");
        __syncthreads();
        if (kt + 1 < nk) GSTAGE(kt + 1, (kt + 1) & 1);
        const char* sb = lds + (kt & 1) * STG;
#pragma unroll
        for (int ks = 0; ks < 4; ++ks) {
            bf16x8 a0 = *(const bf16x8*)(sb + (abase[0] ^ (ks << 5)));
            bf16x8 a1 = *(const bf16x8*)(sb + (abase[1] ^ (ks << 5)));
            bf16x8 b0 = *(const bf16x8*)(sb + (bbase[0] ^ (ks << 5)));
            bf16x8 b1 = *(const bf16x8*)(sb + (bbase[1] ^ (ks << 5)));
            acc[0][0] = __builtin_amdgcn_mfma_f32_32x32x16_bf16(a0, b0, acc[0][0], 0, 0, 0);
            acc[0][1] = __builtin_amdgcn_mfma_f32_32x32x16_bf16(a0, b1, acc[0][1], 0, 0, 0);
            acc[1][0] = __builtin_amdgcn_mfma_f32_32x32x16_bf16(a1, b0, acc[1][0], 0, 0, 0);
            acc[1][1] = __builtin_amdgcn_mfma_f32_32x32x16_bf16(a1, b1, acc[1][1], 0, 0, 0);
        }
    }
#undef GSTAGE
    ep(acc, brow + wm * 64, bcol + wn * 64, lane);
}


constexpr int GSTG = 384 * 128;
template <class AL_, class BL_, class EP_> struct GTile { AL_ al; BL_ bl; EP_ ep; int brow, bcol; };
template <class AL_, class BL_, class EP_> struct PlainTiles {
    typedef GTile<AL_, BL_, EP_> Tile;
    AL_ al; BL_ bl; EP_ ep; int mt0, nN, ntiles, first, G;
    __device__ __forceinline__ bool get(int i, Tile& t) const {
        const int idx = first + i * G; if (idx >= ntiles) return false;
        t.al = al; t.bl = bl; t.ep = ep; t.brow = (mt0 + idx / nN) * 256; t.bcol = (idx % nN) * 128; return true; }
};
template <int WM, int WN, class P>
__device__ __forceinline__ void gemm_stream(char* lds, const P& prov, int nk) {
    constexpr int BM = WM * 64, BN = WN * 64, NA = BM / 64, NB = BN / 64;
    static_assert(NA + NB == 6, "the counted wait assumes six LDS-DMA loads per wave per K-step");
    const int tid = threadIdx.x, lane = tid & 63, wid = __builtin_amdgcn_readfirstlane(tid >> 6);
    const int wm = wid / WN, wn = wid % WN, r32 = lane & 31, hi = lane >> 5;
    typename P::Tile cur, nxt;
    if (!prov.get(0, cur)) return;
    unsigned aoff[NA], boff[NB], aoffn[NA], boffn[NB];
#define GOFFS(T, AO, BO) do { \
    _Pragma("unroll") for (int _i = 0; _i < NA; ++_i) { const int _r = (_i * 8 + wid) * 8 + (lane >> 3); const int _c = (lane & 7) ^ ((_r >> 1) & 7); AO[_i] = (unsigned)((T).al.off((T).brow + _r) + _c * 8); } \
    _Pragma("unroll") for (int _i = 0; _i < NB; ++_i) { const int _r = (_i * 8 + wid) * 8 + (lane >> 3); const int _c = (lane & 7) ^ ((_r >> 1) & 7); BO[_i] = (unsigned)((T).bl.off((T).bcol + _r) + _c * 8); } } while (0)
#define GSTAGE2(T, AO, BO, kt, slot) do { const u16* _ka = (T).al.kbase(kt); const u16* _kb = (T).bl.kbase(kt); char* _d = lds + (slot) * GSTG + ldsw; \
        _Pragma("unroll") for (int _i = 0; _i < NA; ++_i) __builtin_amdgcn_global_load_lds((const unsigned*)(_ka + AO[_i]), (unsigned*)(_d + _i * 8192), 16, 0, 0); \
        _Pragma("unroll") for (int _i = 0; _i < NB; ++_i) __builtin_amdgcn_global_load_lds((const unsigned*)(_kb + BO[_i]), (unsigned*)(_d + BM * 128 + _i * 8192), 16, 0, 0); } while (0)
    GOFFS(cur, aoff, boff);
    const int ldsw = wid * 1024 + lane * 16;
    int abase[2], bbase[2];
#pragma unroll
    for (int i = 0; i < 2; ++i) {
        const int ra = wm * 64 + i * 32 + r32; abase[i] = ra * 128 + ((hi ^ ((ra >> 1) & 7)) << 4);
        const int rb = wn * 64 + i * 32 + r32; bbase[i] = BM * 128 + rb * 128 + ((hi ^ ((rb >> 1) & 7)) << 4);
    }
    f32x16 acc[2][2];
#pragma unroll
    for (int i = 0; i < 2; ++i)
#pragma unroll
        for (int j = 0; j < 2; ++j) acc[i][j] = f32x16{};
    __syncthreads();
    GSTAGE2(cur, aoff, boff, 0, 0); GSTAGE2(cur, aoff, boff, 1, 1);
    int slot = 0;
    for (int i = 0;; ++i) {
        const bool has_next = prov.get(i + 1, nxt);
        if (has_next) GOFFS(nxt, aoffn, boffn);
        for (int kt = 0; kt < nk; ++kt) {
            if ((kt + 1 < nk) || has_next) asm volatile("s_waitcnt vmcnt(6)" ::: "memory"); else asm volatile("s_waitcnt vmcnt(0)" ::: "memory");
            __builtin_amdgcn_s_barrier();
            const int s2 = slot >= 1 ? slot - 1 : 2;
            if (kt + 2 < nk) GSTAGE2(cur, aoff, boff, kt + 2, s2); else if (has_next) GSTAGE2(nxt, aoffn, boffn, kt + 2 - nk, s2);
            const char* sb = lds + slot * GSTG;
#pragma unroll
            for (int ks = 0; ks < 4; ++ks) {
                bf16x8 a0 = *(const bf16x8*)(sb + (abase[0] ^ (ks << 5)));
                bf16x8 a1 = *(const bf16x8*)(sb + (abase[1] ^ (ks << 5)));
                bf16x8 b0 = *(const bf16x8*)(sb + (bbase[0] ^ (ks << 5)));
                bf16x8 b1 = *(const bf16x8*)(sb + (bbase[1] ^ (ks << 5)));
                acc[0][0] = __builtin_amdgcn_mfma_f32_32x32x16_bf16(b0, a0, acc[0][0], 0, 0, 0);
                acc[0][1] = __builtin_amdgcn_mfma_f32_32x32x16_bf16(b1, a0, acc[0][1], 0, 0, 0);
                acc[1][0] = __builtin_amdgcn_mfma_f32_32x32x16_bf16(b0, a1, acc[1][0], 0, 0, 0);
                acc[1][1] = __builtin_amdgcn_mfma_f32_32x32x16_bf16(b1, a1, acc[1][1], 0, 0, 0);
            }
            slot = slot == 2 ? 0 : slot + 1;
        }
        cur.ep(acc, cur.brow + wm * 64, cur.bcol + wn * 64, lane);
        if (!has_next) break;
#pragma unroll
        for (int a = 0; a < 2; ++a)
#pragma unroll
            for (int b = 0; b < 2; ++b) acc[a][b] = f32x16{};
        cur = nxt;
#pragma unroll
        for (int a = 0; a < NA; ++a) aoff[a] = aoffn[a];
#pragma unroll
        for (int b = 0; b < NB; ++b) boff[b] = boffn[b];
    }
    asm volatile("s_waitcnt vmcnt(0)" ::: "memory");
    __syncthreads();
#undef GOFFS
#undef GSTAGE2
}

template <int DK, int DV> struct AttnCfg {
    static constexpr int NKB = DK / 32, NVB = DV / 32, ND0 = DK / 16;
    static constexpr int KBYTES = 64 * DK * 2, VBYTES = 64 * DV * 2;
    static constexpr int LDS = 2 * KBYTES + 2 * VBYTES + NWAVE * 64 * 4;
};
constexpr float ATT_THR = 8.f;

__device__ __forceinline__ void partialSM(f32x16& p0, f32x16& p1, float& m_reg, float& mn, float& alpha) {
    float pmax = p0[0];
#pragma unroll
    for (int r = 1; r < 16; ++r) pmax = fmaxf(pmax, p0[r]);
#pragma unroll
    for (int r = 0; r < 16; ++r) pmax = fmaxf(pmax, p1[r]);
    { auto rr = __builtin_amdgcn_permlane32_swap(__float_as_uint(pmax), __float_as_uint(pmax), false, false);
      pmax = fmaxf(__uint_as_float(rr[0]), __uint_as_float(rr[1])); }
    if (__builtin_expect(__all(pmax - m_reg <= ATT_THR), 1)) { mn = m_reg; alpha = 1.f; }
    else { mn = fmaxf(m_reg, pmax); alpha = __builtin_amdgcn_exp2f(m_reg - mn); m_reg = mn; }
#pragma unroll
    for (int r = 0; r < 16; ++r) p0[r] = p0[r] - mn;
#pragma unroll
    for (int r = 0; r < 16; ++r) p1[r] = p1[r] - mn;
#pragma unroll
    for (int r = 0; r < 16; ++r) p0[r] = __builtin_amdgcn_exp2f(p0[r]);
}
#define PK4(P, BASE, OUT) do { unsigned a0 = cvtpk(P[BASE + 0], P[BASE + 1]), a1 = cvtpk(P[BASE + 2], P[BASE + 3]);   \
    unsigned b0 = cvtpk(P[BASE + 4], P[BASE + 5]), b1 = cvtpk(P[BASE + 6], P[BASE + 7]);                              \
    auto r0 = __builtin_amdgcn_permlane32_swap(a0, b0, false, false); auto r1 = __builtin_amdgcn_permlane32_swap(a1, b1, false, false); \
    u32x4 w = {r0[0], r1[0], r0[1], r1[1]}; OUT = *reinterpret_cast<bf16x8*>(&w); } while (0)
__device__ __forceinline__ void finishSM(f32x16& p0, f32x16& p1, float alpha, float& l_reg, bf16x8& pa0, bf16x8& pa1, bf16x8& pa2, bf16x8& pa3) {
#pragma unroll
    for (int r = 0; r < 16; ++r) p1[r] = __builtin_amdgcn_exp2f(p1[r]);
    float ps = 0;
#pragma unroll
    for (int r = 0; r < 16; ++r) ps += p0[r];
#pragma unroll
    for (int r = 0; r < 16; ++r) ps += p1[r];
    { auto rr = __builtin_amdgcn_permlane32_swap(__float_as_uint(ps), __float_as_uint(ps), false, false);
      ps = __uint_as_float(rr[0]) + __uint_as_float(rr[1]); }
    l_reg = l_reg * alpha + ps;
    PK4(p0, 0, pa0); PK4(p0, 8, pa1); PK4(p1, 0, pa2); PK4(p1, 8, pa3);
}
__device__ __forceinline__ int k_lds_off(int row, int blk, int chunk) { return blk * 4096 + row * 64 + ((chunk ^ ((row >> 2) & 3)) << 4); }
template <int ND0>
__device__ __forceinline__ void qkt(f32x16& p0, f32x16& p1, const char* Ks, const bf16x8* qr, int r32, int hi) {
    p0 = f32x16{}; p1 = f32x16{};
#pragma unroll
    for (int d0 = 0; d0 < ND0; ++d0) {
        const int ch = (d0 & 1) * 2 + hi;
        bf16x8 b0 = *reinterpret_cast<const bf16x8*>(Ks + k_lds_off(r32, d0 >> 1, ch));
        bf16x8 b1 = *reinterpret_cast<const bf16x8*>(Ks + k_lds_off(32 + r32, d0 >> 1, ch));
        p0 = __builtin_amdgcn_mfma_f32_32x32x16_bf16(b0, qr[d0], p0, 0, 0, 0);
        p1 = __builtin_amdgcn_mfma_f32_32x32x16_bf16(b1, qr[d0], p1, 0, 0, 0);
    }
}
template <int NVB> __device__ __forceinline__ int v_st(int k, int c) {
    const int kk = (k & ~0xC) | ((k & 4) << 1) | ((k & 8) >> 1);
    return ((kk >> 3) * NVB + (c >> 5)) * 512 + ((kk & 7) * 32 + (c & 31)) * 2;
}
__device__ __forceinline__ int v_rd_base(int lane) { return ((lane & 3) << 3) | (((lane >> 2) & 3) << 6) | (((lane >> 4) & 1) << 5) | (((lane >> 5) & 1) << 8); }
template <int OFF> __device__ __forceinline__ s16x4 tr_read(int vb) {
    s16x4 r; asm volatile("ds_read_b64_tr_b16 %0, %1 offset:%2" : "=&v"(r) : "v"(vb), "i"(OFF) : "memory"); return r;
}
#define PKV(L, H) (bf16x8){L[0], L[1], L[2], L[3], H[0], H[1], H[2], H[3]}
template <int D0, int NVB> __device__ __forceinline__ void pv_one(f32x16& od, int vb, bf16x8 pa0, bf16x8 pa1, bf16x8 pa2, bf16x8 pa3) {
    constexpr int KS = 2 * NVB * 512, HF = NVB * 512, B0 = D0 * 512;
    const s16x4 l0 = tr_read<B0 + 0 * KS>(vb), h0 = tr_read<B0 + 0 * KS + HF>(vb), l1 = tr_read<B0 + 1 * KS>(vb), h1 = tr_read<B0 + 1 * KS + HF>(vb);
    const s16x4 l2 = tr_read<B0 + 2 * KS>(vb), h2 = tr_read<B0 + 2 * KS + HF>(vb), l3 = tr_read<B0 + 3 * KS>(vb), h3 = tr_read<B0 + 3 * KS + HF>(vb);
    asm volatile("s_waitcnt lgkmcnt(0)" ::: "memory"); SBAR();
    od = __builtin_amdgcn_mfma_f32_32x32x16_bf16(pa0, PKV(l0, h0), od, 0, 0, 0);
    od = __builtin_amdgcn_mfma_f32_32x32x16_bf16(pa1, PKV(l1, h1), od, 0, 0, 0);
    od = __builtin_amdgcn_mfma_f32_32x32x16_bf16(pa2, PKV(l2, h2), od, 0, 0, 0);
    od = __builtin_amdgcn_mfma_f32_32x32x16_bf16(pa3, PKV(l3, h3), od, 0, 0, 0);
}
template <int NVB> __device__ __forceinline__ void pv_all(f32x16* o, int vb, bf16x8 pa0, bf16x8 pa1, bf16x8 pa2, bf16x8 pa3) {
    pv_one<0, NVB>(o[0], vb, pa0, pa1, pa2, pa3); pv_one<1, NVB>(o[1], vb, pa0, pa1, pa2, pa3);
    if constexpr (NVB == 4) { pv_one<2, NVB>(o[2], vb, pa0, pa1, pa2, pa3); pv_one<3, NVB>(o[3], vb, pa0, pa1, pa2, pa3); }
}

template <int DK, int DV>
__device__ __forceinline__ void attn_item(const u16* __restrict__ Qb, const u16* __restrict__ Ka, const u16* __restrict__ Kb, const u16* __restrict__ Vh,
                                          int nkeys, u16* __restrict__ Ob, long ldo, char* lds) {
    using C = AttnCfg<DK, DV>;
    constexpr int NVB = C::NVB, ND0 = C::ND0;
    const int tid = threadIdx.x, wid = tid >> 6, lane = tid & 63, r32 = lane & 31, hi = lane >> 5;
    char* V_lds = lds; char* K_lds = lds + 2 * C::VBYTES;
    float* wsc = (float*)(lds + 2 * C::VBYTES + 2 * C::KBYTES) + wid * 64; float* li_l = wsc; float* al_l = wsc + 32;
    float m_reg = -1e30f, l_reg = 0; f32x16 o[NVB]; bf16x8 qr[ND0];
#pragma unroll
    for (int d = 0; d < NVB; ++d) o[d] = f32x16{};
    const u16* Qw = Qb + (long)(wid * 32 + r32) * DK + hi * 8;
#pragma unroll
    for (int d0 = 0; d0 < ND0; ++d0) qr[d0] = *reinterpret_cast<const bf16x8*>(Qw + d0 * 16);
    const int kr = tid >> 3, kc8 = tid & 7;
    const int kdst0 = k_lds_off(kr, kc8 >> 2, kc8 & 3);
    const int kr2 = (tid & 255) >> 2, kc2 = tid & 3;
    const int kdst1 = k_lds_off(kr2, 2, kc2);
    const int vr = (DV == 64) ? (tid >> 3) : (tid >> 4), vc = (DV == 64) ? (tid & 7) * 8 : (tid & 15) * 8;
    const int vst0 = v_st<NVB>(vr, vc), vst1 = v_st<NVB>(32 + vr, vc);
    const int vb0 = (int)(uintptr_t)V_lds + v_rd_base(lane);
    bf16x8 skE0, skE1, svE0, svE1, skO0, skO1, svO0, svO1;
#define SLOAD(S, k0) do { sk##S##0 = *reinterpret_cast<const bf16x8*>(Ka + (long)((k0) + kr) * 64 + kc8 * 8); \
        if constexpr (DK == 96) sk##S##1 = *reinterpret_cast<const bf16x8*>(Kb + (long)((k0) + kr2) * 32 + kc2 * 8); \
        sv##S##0 = *reinterpret_cast<const bf16x8*>(Vh + (long)((k0) + vr) * DV + vc); \
        if constexpr (DV == 128) sv##S##1 = *reinterpret_cast<const bf16x8*>(Vh + (long)((k0) + 32 + vr) * DV + vc); } while (0)
#define SWRITE(b, S) do { *(bf16x8*)(K_lds + (b) * C::KBYTES + kdst0) = sk##S##0; \
        if constexpr (DK == 96) *(bf16x8*)(K_lds + (b) * C::KBYTES + kdst1) = sk##S##1; \
        *(bf16x8*)(V_lds + (b) * C::VBYTES + vst0) = sv##S##0; \
        if constexpr (DV == 128) *(bf16x8*)(V_lds + (b) * C::VBYTES + vst1) = sv##S##1; } while (0)
#define SWAIT() asm volatile("s_waitcnt vmcnt(3)" ::: "memory")
#define RESC(a) do { if (__any((a) < 1.f)) { if (hi == 0) al_l[r32] = (a); asm volatile("s_waitcnt lgkmcnt(0)" ::: "memory"); \
        _Pragma("unroll") for (int d = 0; d < NVB; ++d) _Pragma("unroll") for (int r = 0; r < 16; ++r) o[d][r] *= al_l[crow(r, hi)]; } } while (0)
    f32x16 pA0, pA1, pB0, pB1; float mnA, mnB, alA, alB; bf16x8 pa0, pa1, pa2, pa3; const int NT = nkeys / 64;
    __syncthreads();
    SLOAD(E, 0); asm volatile("s_waitcnt vmcnt(0)" ::: "memory"); SWRITE(0, E); __syncthreads();
    qkt<ND0>(pA0, pA1, K_lds, qr, r32, hi); partialSM(pA0, pA1, m_reg, mnA, alA);
    SLOAD(O, 64); if (2 < NT) SLOAD(E, 128);
    SWAIT(); SWRITE(1, O); __syncthreads();
    for (int j = 1; j + 1 < NT; j += 2) {
        SBAR(); qkt<ND0>(pB0, pB1, K_lds + C::KBYTES, qr, r32, hi);
        finishSM(pA0, pA1, alA, l_reg, pa0, pa1, pa2, pa3); SBAR();
        SLOAD(O, (j + 2) * 64); SBAR();
        pv_all<NVB>(o, vb0, pa0, pa1, pa2, pa3); partialSM(pB0, pB1, m_reg, mnB, alB);
        __syncthreads(); SWAIT(); SWRITE(0, E);
        RESC(alB); __syncthreads();
        SBAR(); qkt<ND0>(pA0, pA1, K_lds, qr, r32, hi);
        finishSM(pB0, pB1, alB, l_reg, pa0, pa1, pa2, pa3); SBAR();
        if (j + 3 < NT) SLOAD(E, (j + 3) * 64); SBAR();
        pv_all<NVB>(o, vb0 + C::VBYTES, pa0, pa1, pa2, pa3); partialSM(pA0, pA1, m_reg, mnA, alA);
        __syncthreads(); SWAIT(); SWRITE(1, O);
        RESC(alA); __syncthreads();
    }
    SBAR(); qkt<ND0>(pB0, pB1, K_lds + C::KBYTES, qr, r32, hi);
    finishSM(pA0, pA1, alA, l_reg, pa0, pa1, pa2, pa3); SBAR();
    pv_all<NVB>(o, vb0, pa0, pa1, pa2, pa3); partialSM(pB0, pB1, m_reg, mnB, alB);
    __syncthreads(); RESC(alB);
    finishSM(pB0, pB1, alB, l_reg, pa0, pa1, pa2, pa3); SBAR();
    pv_all<NVB>(o, vb0 + C::VBYTES, pa0, pa1, pa2, pa3);
    if (hi == 0) li_l[r32] = l_reg; asm volatile("s_waitcnt lgkmcnt(0)" ::: "memory");
    float rli[16];
#pragma unroll
    for (int r = 0; r < 16; ++r) rli[r] = __builtin_amdgcn_rcpf(li_l[crow(r, hi)]);
    u16* Ow = Ob + (long)(wid * 32) * ldo;
#pragma unroll
    for (int r = 0; r < 16; ++r) { const int orow = crow(r, hi);
#pragma unroll
        for (int d0 = 0; d0 < NVB; ++d0) Ow[(long)orow * ldo + d0 * 32 + r32] = f2bf(o[d0][r] * rli[r]); }
#undef SLOAD
#undef SWRITE
#undef SWAIT
#undef RESC
}

struct Frame {
    const Params* p; unsigned char* ws; char* lds; float* out; int G, bx;
    __device__ __forceinline__ const float* in(int i) const { return p->in[i]; }
    template <class T> __device__ __forceinline__ T* W(size_t off) const { return (T*)(ws + off); }
};
constexpr int LDS_BYTES = 163840;
constexpr int LDS_BARW  = LDS_BYTES - 16;
constexpr int LDS_TAB   = 147456;

struct ResCtx { const float* x_in; const float* ctx_in; float* xc; float* out; const float* mods;
    __device__ __forceinline__ const float* row_in(int row, bool first) const {
        if (row < NCTX) return (first ? ctx_in : (const float*)xc) + (size_t)row * DM;
        return (first ? x_in : (const float*)out) + (size_t)(row - NCTX) * DM; }
    __device__ __forceinline__ float* row_out(int row) const { return row < NCTX ? xc + (size_t)row * DM : out + (size_t)(row - NCTX) * DM; }
    __device__ __forceinline__ const float* mod(int li, int row, int which) const {
        const int mr = row < NCTX ? 4 : ((row - NCTX) >> 13); return mods + (size_t)(li * 5 + mr) * 6144 + which * 1024; }
};
__device__ __forceinline__ ResCtx res_ctx(const Frame& F) { return ResCtx{F.in(0), F.in(2), F.W<float>(WS_XC), F.out, F.W<float>(WS_MODS)}; }
__device__ __forceinline__ const float* xrow_in(const Frame& F, int row, bool first) { return res_ctx(F).row_in(row, first); }
__device__ __forceinline__ float* xrow_out(const Frame& F, int row) { return res_ctx(F).row_out(row); }
__device__ __forceinline__ const float* mod_vec(const Frame& F, int li, int row, int which) { return res_ctx(F).mod(li, row, which); }

__device__ __forceinline__ void p0_mods(const Frame& F) {
    float* s = (float*)F.lds; float* red = s + 5 * 1024;
    const int tid = threadIdx.x, lane = tid & 63, wid = tid >> 6;
    for (int i = tid; i < 5 * 1024; i += NTHR) { const int r = i >> 10, k = i & 1023; const float v = r < 4 ? F.in(1)[r * 1024 + k] : F.in(3)[k]; s[i] = silu_f(v); }
    __syncthreads();
    for (int item = F.bx; item < DEPTH * 96; item += F.G) {
        const int li = item / 96, cg = item % 96;
        const float* w = F.in(4) + (size_t)li * 1024 * 6144 + cg * 64 + lane;
        float a0 = 0, a1 = 0, a2 = 0, a3 = 0, a4 = 0;
        const int k0 = wid * 128;
#pragma unroll 8
        for (int k = k0; k < k0 + 128; ++k) {
            const float wv = w[(size_t)k * 6144];
            a0 += s[k] * wv; a1 += s[1024 + k] * wv; a2 += s[2048 + k] * wv; a3 += s[3072 + k] * wv; a4 += s[4096 + k] * wv;
        }
        red[(wid * 5 + 0) * 64 + lane] = a0; red[(wid * 5 + 1) * 64 + lane] = a1; red[(wid * 5 + 2) * 64 + lane] = a2;
        red[(wid * 5 + 3) * 64 + lane] = a3; red[(wid * 5 + 4) * 64 + lane] = a4;
        __syncthreads();
        if (tid < 320) { const int r = tid >> 6, l = tid & 63; float sum = 0;
#pragma unroll
            for (int ww = 0; ww < 8; ++ww) sum += red[(ww * 5 + r) * 64 + l];
            F.W<float>(WS_MODS)[(size_t)(li * 5 + r) * 6144 + cg * 64 + l] = sum + F.in(5)[li * 6144 + cg * 64 + l]; }
        __syncthreads();
    }
}
__device__ __forceinline__ void p0_rope(const Frame& F) {
    const int gt = F.bx * NTHR + threadIdx.x, gn = F.G * NTHR;
    float* ca = F.W<float>(WS_ROPEA); float* sa = ca + SEQ * 16; float* cb = F.W<float>(WS_ROPEB); float* sb = cb + SEQ * 32;
    for (int i = gt; i < SEQ * 48; i += gn) {
        int n, f, nf; float* co; float* so; int idx;
        if (i < SEQ * 16) { n = i >> 4; f = i & 15; nf = 8; co = ca; so = sa; idx = i; }
        else { const int j = i - SEQ * 16; n = j >> 5; f = j & 31; nf = 16; co = cb; so = sb; idx = j; }
        const int fi = f % nf; const float pos = (f < nf) ? (float)(n >> 6) : (float)(n & 63);
        const float invf = exp2f(-(float)fi / (float)nf * 13.287712379549449f);
        const float ang = pos * invf;
        float rev = ang * 0.15915494309189535f; rev -= floorf(rev);
        co[idx] = __builtin_amdgcn_cosf(rev); so[idx] = __builtin_amdgcn_sinf(rev);
    }
}
__device__ __forceinline__ int rowmap(int n, int kind) { return kind == 0 ? n : ((n >> 5) * 64 + (kind == 2 ? 32 : 0) + (n & 31)); }
__device__ __forceinline__ void cvt_t(const Frame& F, const float* src, int K, int N, u16* dst, int ldd, int kind, int rot) {
    float* tl = (float*)F.lds; const int tid = threadIdx.x;
    const int tn = (N + 63) / 64, nt = (K / 64) * tn;
    for (int t = (F.bx + rot) % F.G; t < nt; t += F.G) {
        const int k0 = (t / tn) * 64, n0 = (t % tn) * 64;
#pragma unroll
        for (int ps = 0; ps < 2; ++ps) { const int k = (tid >> 4) + ps * 32, n4 = (tid & 15) * 4;
            if (n0 + n4 < N) { const f32x4 v = *(const f32x4*)(src + (size_t)(k0 + k) * N + n0 + n4);
                tl[k * 65 + n4] = v[0]; tl[k * 65 + n4 + 1] = v[1]; tl[k * 65 + n4 + 2] = v[2]; tl[k * 65 + n4 + 3] = v[3]; } }
        __syncthreads();
        { const int n = tid >> 3, kc = (tid & 7) * 8;
          if (n0 + n < N) { u32x4 w;
#pragma unroll
            for (int i = 0; i < 4; ++i) w[i] = cvtpk(tl[(kc + 2 * i) * 65 + n], tl[(kc + 2 * i + 1) * 65 + n]);
            *(u32x4*)(dst + (size_t)rowmap(n0 + n, kind) * ldd + k0 + kc) = w; } }
        __syncthreads();
    }
}
__device__ __forceinline__ void p0_weights(const Frame& F) {
    int rot = 0;
    for (int j = 0; j < 2; ++j) {
        cvt_t(F, F.in(8) + (size_t)j * 1024 * 544, 1024, 544, F.W<u16>(WS_WDQKV) + (size_t)j * 640 * 1024, 1024, 0, rot); rot += 144;
        cvt_t(F, F.in(10) + (size_t)j * 256 * 1536, 256, 1536, F.W<u16>(WS_WUQ) + (size_t)j * 1536 * 256, 256, 0, rot); rot += 96;
        cvt_t(F, F.in(12) + (size_t)j * 256 * 2048, 256, 2048, F.W<u16>(WS_WUKV) + (size_t)j * 2048 * 256, 256, 0, rot); rot += 128;
        cvt_t(F, F.in(13) + (size_t)j * 1024 * 1024, 1024, 1024, F.W<u16>(WS_WOM) + (size_t)j * 1024 * 1024, 1024, 0, rot);
    }
    cvt_t(F, F.in(14), 1024, 3072, F.W<u16>(WS_WQKVD), 1024, 0, rot);
    cvt_t(F, F.in(17), 1024, 1024, F.W<u16>(WS_WOD), 1024, 0, rot);
    cvt_t(F, F.in(18), 1024, 3104, F.W<u16>(WS_WING), 1024, 0, rot); rot += 16;
    cvt_t(F, F.in(22), 1024, 1024, F.W<u16>(WS_WOG), 1024, 0, rot);
}
__device__ __forceinline__ void moe_weights(const Frame& F, int li) {
    int rot = 0;
    for (int e = 0; e < 16; ++e) {
        cvt_t(F, F.in(27) + (size_t)(li * 16 + e) * 1024 * 512, 1024, 512, F.W<u16>(WS_MOEW) + (size_t)e * 1024 * 1024, 1024, 1, rot); rot += 128;
        cvt_t(F, F.in(28) + (size_t)(li * 16 + e) * 1024 * 512, 1024, 512, F.W<u16>(WS_MOEW) + (size_t)e * 1024 * 1024, 1024, 2, rot); rot += 128;
        cvt_t(F, F.in(29) + (size_t)(li * 16 + e) * 512 * 1024, 512, 1024, F.W<u16>(WS_MOEW + MOE_WGU_BYTES) + (size_t)e * 1024 * 512, 512, 0, rot); rot += 128;
    }
}

template <bool ROUTE>
__device__ __forceinline__ void norm_phase(const Frame& F, int li, int row_begin, bool first) {
    const int lane = threadIdx.x & 63, wid = threadIdx.x >> 6;
    const float* gain = F.in(ROUTE ? 7 : 6) + li * DM;
    u16* H = F.W<u16>(WS_H);
    for (int row = row_begin + F.bx * NWAVE + wid; row < NTOK; row += F.G * NWAVE) {
        const float* xr = xrow_in(F, row, first);
        f32x4 v[4];
#pragma unroll
        for (int i = 0; i < 4; ++i) v[i] = *(const f32x4*)(xr + i * 256 + lane * 4);
        float ss = 0;
#pragma unroll
        for (int i = 0; i < 4; ++i) ss += v[i][0] * v[i][0] + v[i][1] * v[i][1] + v[i][2] * v[i][2] + v[i][3] * v[i][3];
        ss = wave_sum(ss);
        const float rinv = rsqrtf(ss * (1.f / DM) + EPS);
        const float* sh = mod_vec(F, li, row, ROUTE ? 3 : 0); const float* sc = mod_vec(F, li, row, ROUTE ? 4 : 1);
        float hv[16];
#pragma unroll
        for (int i = 0; i < 4; ++i) { const int c = i * 256 + lane * 4;
            const f32x4 g = *(const f32x4*)(gain + c), s1 = *(const f32x4*)(sc + c), s0 = *(const f32x4*)(sh + c);
#pragma unroll
            for (int j = 0; j < 4; ++j) hv[i * 4 + j] = (v[i][j] * rinv * g[j]) * (1.f + s1[j]) + s0[j];
            u32x2 w = {cvtpk(hv[i * 4], hv[i * 4 + 1]), cvtpk(hv[i * 4 + 2], hv[i * 4 + 3])};
            *(u32x2*)(H + (size_t)row * DM + c) = w; }
        if constexpr (ROUTE) {
            float gl[4] = {0, 0, 0, 0};
            const float* wg = F.in(23) + (size_t)li * DM * 4;
#pragma unroll
            for (int i = 0; i < 4; ++i)
#pragma unroll
                for (int j = 0; j < 4; ++j) { const f32x4 w4 = *(const f32x4*)(wg + (size_t)(i * 256 + lane * 4 + j) * 4); const float h = hv[i * 4 + j];
                    gl[0] += h * w4[0]; gl[1] += h * w4[1]; gl[2] += h * w4[2]; gl[3] += h * w4[3]; }
#pragma unroll
            for (int g = 0; g < 4; ++g) gl[g] = wave_sum(gl[g]) + F.in(24)[li * 4 + g];
            int gi = 0; float gm = gl[0];
#pragma unroll
            for (int g = 1; g < 4; ++g) if (gl[g] > gm) { gm = gl[g]; gi = g; }
            float den = 0;
#pragma unroll
            for (int g = 0; g < 4; ++g) den += __expf(gl[g] - gm);
            const float grp_w = 1.f / den;
            float el[4] = {0, 0, 0, 0};
            const float* wr = F.in(25) + (size_t)(li * 4 + gi) * DM * 4;
#pragma unroll
            for (int i = 0; i < 4; ++i)
#pragma unroll
                for (int j = 0; j < 4; ++j) { const f32x4 w4 = *(const f32x4*)(wr + (size_t)(i * 256 + lane * 4 + j) * 4); const float h = hv[i * 4 + j];
                    el[0] += h * w4[0]; el[1] += h * w4[1]; el[2] += h * w4[2]; el[3] += h * w4[3]; }
#pragma unroll
            for (int e = 0; e < 4; ++e) el[e] = wave_sum(el[e]) + F.in(26)[(li * 4 + gi) * 4 + e];
            int i1 = 0; float v1 = el[0];
#pragma unroll
            for (int e = 1; e < 4; ++e) if (el[e] > v1) { v1 = el[e]; i1 = e; }
            int i2 = -1; float v2 = -3.0e38f;
#pragma unroll
            for (int e = 0; e < 4; ++e) if (e != i1 && el[e] > v2) { v2 = el[e]; i2 = e; }
            const float t = __expf(v2 - v1); const float w1 = grp_w / (1.f + t), w2 = grp_w * t / (1.f + t);
            const int elo = i1 < i2 ? i1 : i2, ehi = i1 < i2 ? i2 : i1;
            const float wlo = i1 < i2 ? w1 : w2, whi = i1 < i2 ? w2 : w1;
            const int pr = elo == 0 ? ehi - 1 : (elo == 1 ? ehi + 1 : 5);
            const int cls = gi * 6 + pr;
            if (lane == 0) {
                const int pos = (int)atomicAdd(F.W<unsigned>(WS_CTL) + CW_CNT + li * 32 + cls, 1u);
                u32x4 rec = {(unsigned)cls, (unsigned)pos, __float_as_uint(wlo), __float_as_uint(whi)};
                *(u32x4*)(F.W<unsigned char>(WS_TOK) + (size_t)row * 16) = rec;
            }
        }
    }
}

__device__ __forceinline__ void moe_table(const Frame& F, int li, int* tab) {
    if (threadIdx.x == 0) {
        const unsigned* cnt = F.W<unsigned>(WS_CTL) + CW_CNT + li * 32; int off = 0;
        for (int c = 0; c < 24; ++c) { tab[c] = off; const int n = (int)cnt[c]; const int nt = (n + 255) >> 8;
            for (int t = 0; t < nt; ++t) tab[32 + (off >> 8) + t] = c; off += nt << 8; }
        tab[24] = off;
    }
    __syncthreads();
}
__device__ __forceinline__ void moe_scatter(const Frame& F, int li, int row_begin) {
    int* tab = (int*)(F.lds + LDS_TAB);
    moe_table(F, li, tab);
    const unsigned* cnt = F.W<unsigned>(WS_CTL) + CW_CNT + li * 32;
    int* rowtok = F.W<int>(WS_ROWTOK); float* roww = F.W<float>(WS_ROWW);
    const int gt = F.bx * NTHR + threadIdx.x, gn = F.G * NTHR;
    for (int t = row_begin + gt; t < NTOK; t += gn) {
        const u32x4 rec = *(const u32x4*)(F.W<unsigned char>(WS_TOK) + (size_t)t * 16);
        const int r = tab[rec[0]] + (int)rec[1];
        rowtok[r] = t; roww[2 * r] = __uint_as_float(rec[2]); roww[2 * r + 1] = __uint_as_float(rec[3]);
    }
    for (int i = gt; i < 24 * 256; i += gn) { const int c = i >> 8, j = i & 255; const int r = tab[c] + (int)cnt[c] + j;
        const int end = tab[c] + ((((int)cnt[c]) + 255) & ~255);
        if (r < end) { rowtok[r] = -1; roww[2 * r] = 0.f; roww[2 * r + 1] = 0.f; } }
    __syncthreads();
}

#define EPI_ID const int r32 = lane & 31, hi = lane >> 5
__device__ __forceinline__ u32x2 pack4(float a, float b, float c, float d) { u32x2 w = {cvtpk(a, b), cvtpk(c, d)}; return w; }
struct EpiF32 { float* dst; int ld, ncols;
    __device__ __forceinline__ void operator()(f32x16 (&acc)[2][2], int row0, int col0, int lane) const { EPI_ID;
#pragma unroll
        for (int mi = 0; mi < 2; ++mi) { float* o = dst + (size_t)(row0 + mi * 32 + r32) * ld + col0 + 4 * hi;
#pragma unroll
            for (int ni = 0; ni < 2; ++ni) if (col0 + ni * 32 < ncols) {
#pragma unroll
                for (int g = 0; g < 4; ++g) { f32x4 v = {acc[mi][ni][4 * g], acc[mi][ni][4 * g + 1], acc[mi][ni][4 * g + 2], acc[mi][ni][4 * g + 3]}; *(f32x4*)(o + ni * 32 + 8 * g) = v; } } }
    } };
struct EpiMlaQ { u16* Q; const float* cosA; const float* sinA; float scale;
    __device__ __forceinline__ void operator()(f32x16 (&acc)[2][2], int row0, int col0, int lane) const { EPI_ID; const bool lat = row0 >= NCTX;
#pragma unroll
        for (int mi = 0; mi < 2; ++mi) { const int row = row0 + mi * 32 + r32; int b, pos; row_bp(row, b, pos); const int n = (row - NCTX) & (SEQ - 1);
            u16* qrow = Q + ((size_t)(b * 16) * KEYS + pos) * 96 + 4 * hi;
#pragma unroll
            for (int ni = 0; ni < 2; ++ni) { const int s = (col0 >> 5) + ni, head = s / 3, part = s - head * 3; u16* o = qrow + (size_t)head * KEYS * 96 + part * 32;
                float v[16];
#pragma unroll
                for (int r = 0; r < 16; ++r) v[r] = acc[mi][ni][r] * scale;
                if (part == 2 && lat) {
#pragma unroll
                    for (int g = 0; g < 2; ++g) { const f32x4 cs = *(const f32x4*)(cosA + n * 16 + 8 * g + 4 * hi), sn = *(const f32x4*)(sinA + n * 16 + 8 * g + 4 * hi);
#pragma unroll
                        for (int j = 0; j < 4; ++j) { const float t1 = v[4 * g + j], t2 = v[4 * (g + 2) + j]; v[4 * g + j] = t1 * cs[j] - t2 * sn[j]; v[4 * (g + 2) + j] = t1 * sn[j] + t2 * cs[j]; } } }
#pragma unroll
                for (int g = 0; g < 4; ++g) *(u32x2*)(o + 8 * g) = pack4(v[4 * g], v[4 * g + 1], v[4 * g + 2], v[4 * g + 3]); } }
    } };
struct EpiMlaKV { u16* Kn; long vdelta;
    __device__ __forceinline__ void operator()(f32x16 (&acc)[2][2], int row0, int col0, int lane) const { EPI_ID; const int head = col0 >> 7; u16* dst = Kn + (long)((col0 >> 6) & 1) * vdelta;
#pragma unroll
        for (int mi = 0; mi < 2; ++mi) { const int row = row0 + mi * 32 + r32; int b, pos; row_bp(row, b, pos);
            u16* o = dst + ((size_t)(b * 16 + head) * KEYS + pos) * 64 + 4 * hi;
#pragma unroll
            for (int ni = 0; ni < 2; ++ni)
#pragma unroll
                for (int g = 0; g < 4; ++g) *(u32x2*)(o + ni * 32 + 8 * g) = pack4(acc[mi][ni][4 * g], acc[mi][ni][4 * g + 1], acc[mi][ni][4 * g + 2], acc[mi][ni][4 * g + 3]); }
    } };
struct EpiResid { ResCtx F; int li, which; bool first;
    __device__ __forceinline__ void operator()(f32x16 (&acc)[2][2], int row0, int col0, int lane) const { EPI_ID;
#pragma unroll
        for (int mi = 0; mi < 2; ++mi) { const int row = row0 + mi * 32 + r32;
            const float* xi = F.row_in(row, first) + col0 + 4 * hi; float* xo = F.row_out(row) + col0 + 4 * hi; const float* gt = F.mod(li, row, which) + col0 + 4 * hi;
#pragma unroll
            for (int ni = 0; ni < 2; ++ni)
#pragma unroll
                for (int g = 0; g < 4; ++g) { const int c = ni * 32 + 8 * g; const f32x4 x = *(const f32x4*)(xi + c), gg = *(const f32x4*)(gt + c);
                    f32x4 o = {x[0] + gg[0] * acc[mi][ni][4 * g], x[1] + gg[1] * acc[mi][ni][4 * g + 1], x[2] + gg[2] * acc[mi][ni][4 * g + 2], x[3] + gg[3] * acc[mi][ni][4 * g + 3]};
                    *(f32x4*)(xo + c) = o; } }
    } };
struct EpiMoeB { ResCtx F; int li; const int* rowtok;
    __device__ __forceinline__ void operator()(f32x16 (&acc)[2][2], int row0, int col0, int lane) const { EPI_ID;
#pragma unroll
        for (int mi = 0; mi < 2; ++mi) { const int tok = rowtok[row0 + mi * 32 + r32];
            if (tok >= 0) { float* xo = F.row_out(tok) + col0 + 4 * hi; const float* gt = F.mod(li, tok, 5) + col0 + 4 * hi;
#pragma unroll
                for (int ni = 0; ni < 2; ++ni)
#pragma unroll
                    for (int g = 0; g < 4; ++g) { const int c = ni * 32 + 8 * g; const f32x4 x = *(const f32x4*)(xo + c), gg = *(const f32x4*)(gt + c);
                        f32x4 o = {x[0] + gg[0] * acc[mi][ni][4 * g], x[1] + gg[1] * acc[mi][ni][4 * g + 1], x[2] + gg[2] * acc[mi][ni][4 * g + 2], x[3] + gg[3] * acc[mi][ni][4 * g + 3]};
                        *(f32x4*)(xo + c) = o; } } }
    } };
struct EpiMoeA { u16* act; const float* roww; int half, acol0;
    __device__ __forceinline__ void operator()(f32x16 (&acc)[2][2], int row0, int col0, int lane) const { EPI_ID;
#pragma unroll
        for (int mi = 0; mi < 2; ++mi) { const int row = row0 + mi * 32 + r32; const float w = roww[2 * row + half];
            u16* o = act + (size_t)row * 1024 + acol0 + (col0 >> 6) * 32 + 4 * hi;
#pragma unroll
            for (int g = 0; g < 4; ++g) { float v[4];
#pragma unroll
                for (int j = 0; j < 4; ++j) v[j] = silu_f(acc[mi][0][4 * g + j]) * acc[mi][1][4 * g + j] * w;
                *(u32x2*)(o + 8 * g) = pack4(v[0], v[1], v[2], v[3]); } }
    } };
struct EpiDiffQKV { u16* Q; long kdelta; u16* V; const float* cosB; const float* sinB; float qscale;
    __device__ __forceinline__ void operator()(f32x16 (&acc)[2][2], int row0, int col0, int lane) const { EPI_ID; const int region = col0 >> 10; const bool lat = row0 >= NCTX;
#pragma unroll
        for (int mi = 0; mi < 2; ++mi) { const int row = row0 + mi * 32 + r32; int b, pos; row_bp(row, b, pos); const int n = (row - NCTX) & (SEQ - 1);
            if (region < 2) {
                const int hh = (col0 & 1023) >> 6; const float sc = region == 0 ? qscale : 1.f;
                u16* o = Q + (long)region * kdelta + ((size_t)(b * 16 + hh) * KEYS + pos) * 64 + 4 * hi;
#pragma unroll
                for (int g = 0; g < 4; ++g) { f32x4 cs = {1.f, 1.f, 1.f, 1.f}, sn = {0.f, 0.f, 0.f, 0.f};
                    if (lat) { cs = *(const f32x4*)(cosB + n * 32 + 8 * g + 4 * hi); sn = *(const f32x4*)(sinB + n * 32 + 8 * g + 4 * hi); }
                    float o1[4], o2[4];
#pragma unroll
                    for (int j = 0; j < 4; ++j) { const float t1 = acc[mi][0][4 * g + j], t2 = acc[mi][1][4 * g + j]; o1[j] = (t1 * cs[j] - t2 * sn[j]) * sc; o2[j] = (t1 * sn[j] + t2 * cs[j]) * sc; }
                    *(u32x2*)(o + 8 * g) = pack4(o1[0], o1[1], o1[2], o1[3]); *(u32x2*)(o + 32 + 8 * g) = pack4(o2[0], o2[1], o2[2], o2[3]); }
            } else {
                const int cv = col0 - 2048, head = cv >> 7;
                u16* o = V + ((size_t)(b * 8 + head) * KEYS + pos) * 128 + (cv & 127) + 4 * hi;
#pragma unroll
                for (int ni = 0; ni < 2; ++ni)
#pragma unroll
                    for (int g = 0; g < 4; ++g) *(u32x2*)(o + ni * 32 + 8 * g) = pack4(acc[mi][ni][4 * g], acc[mi][ni][4 * g + 1], acc[mi][ni][4 * g + 2], acc[mi][ni][4 * g + 3]);
            } }
    } };
struct EpiGlaIn { u16* q; u16* k; u16* v; u16* g; float* z;
    __device__ __forceinline__ void operator()(f32x16 (&acc)[2][2], int row0, int col0, int lane) const { EPI_ID;
#pragma unroll
        for (int mi = 0; mi < 2; ++mi) { const size_t row = row0 + mi * 32 + r32;
            if (col0 < 3072) {
                u16* o; float sc = 1.f;
                if (col0 < 512) { o = q + row * 512 + col0; sc = 0.08838834764831845f; } else if (col0 < 1024) o = k + row * 512 + (col0 - 512);
                else if (col0 < 2048) o = v + row * 1024 + (col0 - 1024); else o = g + row * 1024 + (col0 - 2048);
                o += 4 * hi;
#pragma unroll
                for (int ni = 0; ni < 2; ++ni)
#pragma unroll
                    for (int gg = 0; gg < 4; ++gg) *(u32x2*)(o + ni * 32 + 8 * gg) = pack4(acc[mi][ni][4 * gg] * sc, acc[mi][ni][4 * gg + 1] * sc, acc[mi][ni][4 * gg + 2] * sc, acc[mi][ni][4 * gg + 3] * sc);
            } else if (col0 == 3072) {
                float* o = z + row * 32 + 4 * hi;
#pragma unroll
                for (int gg = 0; gg < 4; ++gg) { f32x4 t = {acc[mi][0][4 * gg], acc[mi][0][4 * gg + 1], acc[mi][0][4 * gg + 2], acc[mi][0][4 * gg + 3]}; *(f32x4*)(o + 8 * gg) = t; }
            } }
    } };

template <int WM, int WN, class AL, class BL, class EP>
__device__ __forceinline__ void gemm_phase(const Frame& F, const AL al, const BL bl, EP& ep, int mt0, int mt1, int nN, int nk, int tile_off, int tile_total) {
    int first = F.bx - (tile_off % F.G); if (first < 0) first += F.G;
    PlainTiles<AL, BL, EP> prov{al, bl, ep, mt0, nN, (mt1 - mt0) * nN, first, F.G};
    gemm_stream<WM, WN>(F.lds, prov, nk);
    (void)tile_total;
}

__device__ __forceinline__ void mla_rowpass(const Frame& F, int j) {
    const int lane = threadIdx.x & 63, wid = threadIdx.x >> 6;
    const float* DQ = F.W<float>(MLA_DQ); u16* CN = F.W<u16>(MLA_CN); u16* KPE = F.W<u16>(MLA_KPE);
    const float* gq = F.in(9) + j * 256; const float* gk = F.in(11) + j * 256;
    const float* ca = F.W<float>(WS_ROPEA); const float* sa = ca + SEQ * 16;
    for (int row = F.bx * NWAVE + wid; row < NTOK; row += F.G * NWAVE) {
        const float* d = DQ + (size_t)row * 544;
        const f32x4 a = *(const f32x4*)(d + lane * 4), c = *(const f32x4*)(d + 256 + lane * 4);
        float sq = a[0] * a[0] + a[1] * a[1] + a[2] * a[2] + a[3] * a[3], sk = c[0] * c[0] + c[1] * c[1] + c[2] * c[2] + c[3] * c[3];
        sq = wave_sum(sq); sk = wave_sum(sk);
        const float rq = rsqrtf(sq * (1.f / 256.f) + EPS), rk = rsqrtf(sk * (1.f / 256.f) + EPS);
        const f32x4 g1 = *(const f32x4*)(gq + lane * 4), g2 = *(const f32x4*)(gk + lane * 4);
        u32x2 w1 = {cvtpk(a[0] * rq * g1[0], a[1] * rq * g1[1]), cvtpk(a[2] * rq * g1[2], a[3] * rq * g1[3])};
        u32x2 w2 = {cvtpk(c[0] * rk * g2[0], c[1] * rk * g2[1]), cvtpk(c[2] * rk * g2[2], c[3] * rk * g2[3])};
        *(u32x2*)(CN + (size_t)row * 512 + lane * 4) = w1; *(u32x2*)(CN + (size_t)row * 512 + 256 + lane * 4) = w2;
        if (lane < 16) { float t1 = d[512 + lane], t2 = d[528 + lane]; int b, pos; row_bp(row, b, pos);
            if (row >= NCTX) { const int n = (row - NCTX) & (SEQ - 1); const float cs = ca[n * 16 + lane], sn = sa[n * 16 + lane];
                const float o1 = t1 * cs - t2 * sn, o2 = t1 * sn + t2 * cs; t1 = o1; t2 = o2; }
            u16* o = KPE + ((size_t)b * KEYS + pos) * 32 + lane; o[0] = f2bf(t1); o[16] = f2bf(t2); }
    }
}
__device__ __forceinline__ int vcu_of(const Frame& F) { return (F.G % 8 == 0) ? (F.bx % 8) * (F.G / 8) + F.bx / 8 : F.bx; }
__device__ __forceinline__ void mla_attn(const Frame& F, bool ctx_out) {
    const u16* Q = F.W<u16>(MLA_Q); const u16* Kn = F.W<u16>(MLA_KN); const u16* V = F.W<u16>(MLA_V); const u16* Kpe = F.W<u16>(MLA_KPE);
    u16* O = F.W<u16>(MLA_DQ);
    const int nit = 2048 + (ctx_out ? 64 : 0);
    for (int it = vcu_of(F); it < nit; it += F.G) {
        int b, h, qpos, nkeys, orow;
        if (it < 2048) { const int bh = it >> 5, qt = it & 31; b = bh >> 4; h = bh & 15; qpos = CTXL + qt * 256; nkeys = KEYS; orow = NCTX + b * SEQ + qt * 256; }
        else { const int jj = it - 2048; b = jj >> 4; h = jj & 15; qpos = 0; nkeys = CTXL; orow = b * CTXL; }
        const size_t bh = (size_t)(b * 16 + h);
        attn_item<96, 64>(Q + (bh * KEYS + qpos) * 96, Kn + bh * KEYS * 64, Kpe + (size_t)b * KEYS * 32, V + bh * KEYS * 64, nkeys,
                          O + (size_t)orow * DM + h * 64, DM, F.lds);
    }
}
__device__ __forceinline__ void diff_attn(const Frame& F) {
    const u16* Q = F.W<u16>(DF_Q); const u16* K = F.W<u16>(DF_K); const u16* V = F.W<u16>(DF_V); u16* OS = F.W<u16>(DF_OS);
    const int nit = 2048 + 64;
    for (int it = vcu_of(F); it < nit; it += F.G) {
        int b, hh, qpos, nkeys, orow;
        if (it < 2048) { const int bh = it >> 5, qt = it & 31; b = bh >> 4; hh = bh & 15; qpos = CTXL + qt * 256; nkeys = KEYS; orow = NCTX + b * SEQ + qt * 256; }
        else { const int jj = it - 2048; b = jj >> 4; hh = jj & 15; qpos = 0; nkeys = CTXL; orow = b * CTXL; }
        const size_t bh = (size_t)(b * 16 + hh);
        attn_item<64, 128>(Q + (bh * KEYS + qpos) * 64, K + bh * KEYS * 64, nullptr, V + (size_t)(b * 8 + (hh >> 1)) * KEYS * 128, nkeys,
                           OS + (size_t)(hh & 1) * NTOK * DM + (size_t)orow * DM + (hh >> 1) * 128, DM, F.lds);
    }
}
__device__ __forceinline__ void diff_rowpass(const Frame& F, float lam_init) {
    const int lane = threadIdx.x & 63, wid = threadIdx.x >> 6;
    const u16* OS = F.W<u16>(DF_OS); u16* O = F.W<u16>(DF_Q);
    const float* lm = F.in(15);
    const float lam = __expf(wave_sum(lm[lane] * lm[64 + lane])) - __expf(wave_sum(lm[128 + lane] * lm[192 + lane])) + lam_init;
    const float post = 1.f - lam_init;
    float sg[16];
#pragma unroll
    for (int i = 0; i < 16; ++i) sg[i] = F.in(16)[(lane & 7) * 16 + i] * post;
    for (int row = F.bx * NWAVE + wid; row < NTOK; row += F.G * NWAVE) {
        const u16* p0 = OS + (size_t)row * DM + lane * 16; const u16* p1 = p0 + (size_t)NTOK * DM;
        const bf16x8 a0 = *(const bf16x8*)p0, a1 = *(const bf16x8*)(p0 + 8), b0 = *(const bf16x8*)p1, b1 = *(const bf16x8*)(p1 + 8);
        float o[16]; float ss = 0;
#pragma unroll
        for (int i = 0; i < 8; ++i) { o[i] = bf2f((u16)a0[i]) - lam * bf2f((u16)b0[i]); o[8 + i] = bf2f((u16)a1[i]) - lam * bf2f((u16)b1[i]); }
#pragma unroll
        for (int i = 0; i < 16; ++i) ss += o[i] * o[i];
        ss += __shfl_xor(ss, 1); ss += __shfl_xor(ss, 2); ss += __shfl_xor(ss, 4);
        const float rinv = rsqrtf(ss * (1.f / 128.f) + EPS);
        u32x4 w0, w1;
#pragma unroll
        for (int i = 0; i < 4; ++i) { w0[i] = cvtpk(o[2 * i] * rinv * sg[2 * i], o[2 * i + 1] * rinv * sg[2 * i + 1]);
            w1[i] = cvtpk(o[8 + 2 * i] * rinv * sg[8 + 2 * i], o[9 + 2 * i] * rinv * sg[9 + 2 * i]); }
        *(u32x4*)(O + (size_t)row * DM + lane * 16) = w0; *(u32x4*)(O + (size_t)row * DM + lane * 16 + 8) = w1;
    }
}

__device__ __forceinline__ float logsig16(float x) { return (fminf(x, 0.f) - __logf(1.f + __expf(-fabsf(x)))) * 0.0625f; }
constexpr int NCH = KEYS / 64;

__device__ __forceinline__ void gla_g1(const Frame& F) {
    char* KT = F.lds; char* VV = F.lds + 16384; float* ZT = (float*)(F.lds + 49152); float* SEG = (float*)(F.lds + 53248);
    const u16* Kg = F.W<u16>(GL_K); const u16* Vg = F.W<u16>(GL_V); const float* Zg = F.W<float>(GL_Z);
    u16* ST = F.W<u16>(GL_STATE); float* DEC = F.W<float>(GL_DEC);
#pragma unroll 1
    for (int it = F.bx; it < NBATCH * 4 * 2 * NCH; it += F.G) {
        int tid = threadIdx.x; asm volatile("" : "+v"(tid));
        const int lane = tid & 63, wid = tid >> 6, r32 = lane & 31, hi = lane >> 5, kk = tid & 127, jq = tid >> 7;
        const int c = it % NCH, dir = (it / NCH) & 1, bh = it / (2 * NCH), b = bh >> 2, h = bh & 3;
        const int s0 = 64 * c;
        int tbase, tstep;
        if (dir == 0) { tbase = (c < 4) ? b * CTXL + s0 : NCTX + b * SEQ + s0 - CTXL; tstep = 1; }
        else { tbase = (c < 4) ? b * CTXL + (CTXL - 1) - s0 : NCTX + b * SEQ + (SEQ - 1) - (s0 - CTXL); tstep = -1; }
        __syncthreads();
        for (int i = tid; i < 1024; i += NTHR) { const int j = i >> 4, r = i & 15; ZT[i] = Zg[(size_t)(tbase + tstep * j) * 32 + dir * 16 + r]; }
#pragma unroll
        for (int q = 0; q < 4; ++q) { const int id = tid + q * NTHR, key = id >> 5, cc = (id & 31) * 8;
            *(bf16x8*)(VV + v_st<8>(key, cc)) = *(const bf16x8*)(Vg + (size_t)(tbase + tstep * key) * 1024 + h * 256 + cc); }
        float wg[16];
#pragma unroll
        for (int r = 0; r < 16; ++r) wg[r] = F.in(19)[(dir * 16 + r) * 512 + h * 128 + kk];
        const float bias = F.in(20)[dir * 512 + h * 128 + kk];
        __syncthreads();
        float cv[16]; float run = 0;
#pragma unroll
        for (int jj = 0; jj < 16; ++jj) { const int j = jq * 16 + jj; float x = bias;
#pragma unroll
            for (int r = 0; r < 16; ++r) x += ZT[j * 16 + r] * wg[r];
            run += logsig16(x); cv[jj] = run; }
        SEG[jq * 128 + kk] = run;
        __syncthreads();
        float offset = 0, total = 0;
#pragma unroll
        for (int q = 0; q < 4; ++q) { const float sv = SEG[q * 128 + kk]; total += sv; if (q < jq) offset += sv; }
        u32x4 w0, w1;
#pragma unroll
        for (int i = 0; i < 8; ++i) {
            const int j0 = jq * 16 + 2 * i;
            const float k0 = bf2f(Kg[(size_t)(tbase + tstep * j0) * 512 + h * 128 + kk]) * __expf(total - (offset + cv[2 * i]));
            const float k1 = bf2f(Kg[(size_t)(tbase + tstep * (j0 + 1)) * 512 + h * 128 + kk]) * __expf(total - (offset + cv[2 * i + 1]));
            const unsigned pk = cvtpk(k0, k1); if (i < 4) w0[i] = pk; else w1[i - 4] = pk; }
        *(u32x4*)(KT + kk * 128 + (((jq * 2) ^ ((kk >> 1) & 7)) << 4)) = w0;
        *(u32x4*)(KT + kk * 128 + (((jq * 2 + 1) ^ ((kk >> 1) & 7)) << 4)) = w1;
        if (jq == 0) DEC[(size_t)it * 128 + kk] = __expf(total);
        __syncthreads();
        const int mt = wid & 3, vb = (wid >> 2) * 4;
        const int row = mt * 32 + r32, ab = row * 128 + ((hi ^ ((row >> 1) & 7)) << 4);
        const bf16x8 pa0 = *(const bf16x8*)(KT + (ab ^ 0)), pa1 = *(const bf16x8*)(KT + (ab ^ 32)), pa2 = *(const bf16x8*)(KT + (ab ^ 64)), pa3 = *(const bf16x8*)(KT + (ab ^ 96));
        f32x16 acc[4];
#pragma unroll
        for (int n = 0; n < 4; ++n) acc[n] = f32x16{};
        const int vbase = (int)(uintptr_t)VV + v_rd_base(lane) + vb * 512;
        pv_one<0, 8>(acc[0], vbase, pa0, pa1, pa2, pa3); pv_one<1, 8>(acc[1], vbase, pa0, pa1, pa2, pa3);
        pv_one<2, 8>(acc[2], vbase, pa0, pa1, pa2, pa3); pv_one<3, 8>(acc[3], vbase, pa0, pa1, pa2, pa3);
        u16* S = ST + (size_t)it * 128 * 256;
#pragma unroll
        for (int n = 0; n < 4; ++n)
#pragma unroll
            for (int r = 0; r < 16; ++r) S[(mt * 32 + crow(r, hi)) * 256 + (vb + n) * 32 + r32] = f2bf(acc[n][r]);
    }
}
__device__ __forceinline__ void gla_g2(const Frame& F) {
    u16* ST = F.W<u16>(GL_STATE); const float* DEC = F.W<float>(GL_DEC);
    for (int g = F.bx * NTHR + threadIdx.x; g < 32 * 4096; g += F.G * NTHR) {
        const int chain = g >> 12, e = g & 4095, kk = e >> 5, v8 = (e & 31) * 8;
        u16* p = ST + ((size_t)chain * NCH * 128 + kk) * 256 + v8; const float* d = DEC + (size_t)chain * NCH * 128 + kk;
        float f[8];
#pragma unroll
        for (int i = 0; i < 8; ++i) f[i] = 0.f;
        for (int c = 0; c < NCH; c += 4) {
            bf16x8 kv[4]; float dc[4];
#pragma unroll
            for (int u = 0; u < 4; ++u) { kv[u] = *(const bf16x8*)(p + (size_t)(c + u) * 128 * 256); dc[u] = d[(size_t)(c + u) * 128]; }
#pragma unroll
            for (int u = 0; u < 4; ++u) {
                u32x4 w = {cvtpk(f[0], f[1]), cvtpk(f[2], f[3]), cvtpk(f[4], f[5]), cvtpk(f[6], f[7])};
                *(u32x4*)(p + (size_t)(c + u) * 128 * 256) = w;
#pragma unroll
                for (int i = 0; i < 8; ++i) f[i] = dc[u] * f[i] + bf2f((u16)kv[u][i]);
            }
        }
    }
}
__device__ __forceinline__ void gla_g3(const Frame& F) {
    char* QD = F.lds; char* KI = F.lds + 16384; char* VV = F.lds + 32768; char* SS = F.lds + 65536; float* OL = (float*)(F.lds + 65536);
    float* ZT = (float*)(F.lds + 132096); float* SEG = (float*)(F.lds + 136192);
    const u16* Qg = F.W<u16>(GL_Q); const u16* Kg = F.W<u16>(GL_K); const u16* Vg = F.W<u16>(GL_V); const u16* Gg = F.W<u16>(GL_G); const float* Zg = F.W<float>(GL_Z);
    const u16* ST = F.W<u16>(GL_STATE); u16* OUT = F.W<u16>(WS_H);
#pragma unroll 1
    for (int it = F.bx; it < NBATCH * 4 * NCH; it += F.G) {
        int tid = threadIdx.x; asm volatile("" : "+v"(tid));
        const int lane = tid & 63, wid = tid >> 6, r32 = lane & 31, hi = lane >> 5, kk = tid & 127, jq = tid >> 7;
        const int T = it % NCH, bh = it / NCH, b = bh >> 2, h = bh & 3;
        const int t0 = (T < 4) ? b * CTXL + 64 * T : NCTX + b * SEQ + 64 * (T - 4);
        __syncthreads();
#pragma unroll
        for (int q = 0; q < 4; ++q) { const int id = tid + q * NTHR, key = id >> 5, cc = (id & 31) * 8;
            *(bf16x8*)(VV + v_st<8>(key, cc)) = *(const bf16x8*)(Vg + (size_t)(t0 + key) * 1024 + h * 256 + cc); }
        const int itile = wid & 1, vb = (wid >> 1) * 2;
        f32x16 acc[2]; acc[0] = f32x16{}; acc[1] = f32x16{};
#pragma unroll 1
        for (int dir = 0; dir < 2; ++dir) {
            const int cd = dir == 0 ? T : (T < 4 ? 3 - T : 135 - T);
            const u16* Ssrc = ST + (size_t)((bh * 2 + dir) * NCH + cd) * 128 * 256;
#pragma unroll
            for (int q = 0; q < 8; ++q) { const int id = tid + q * NTHR, key = id >> 5, cc = (id & 31) * 8;
                *(bf16x8*)(SS + v_st<8>(key, cc)) = *(const bf16x8*)(Ssrc + (size_t)key * 256 + cc); }
            for (int i = tid; i < 1024; i += NTHR) { const int j = i >> 4, r = i & 15; ZT[i] = Zg[(size_t)(t0 + j) * 32 + dir * 16 + r]; }
            float wg[16];
#pragma unroll
            for (int r = 0; r < 16; ++r) wg[r] = F.in(19)[(dir * 16 + r) * 512 + h * 128 + kk];
            const float bias = F.in(20)[dir * 512 + h * 128 + kk];
            __syncthreads();
            float cv[16]; float run = 0;
#pragma unroll
            for (int u = 0; u < 16; ++u) { const int j = jq * 16 + u; float x = bias;
#pragma unroll
                for (int r = 0; r < 16; ++r) x += ZT[j * 16 + r] * wg[r];
                cv[u] = logsig16(x); }
            if (dir == 0) {
#pragma unroll
                for (int u = 0; u < 16; ++u) { run += cv[u]; cv[u] = run; }
            } else {
#pragma unroll
                for (int u = 15; u >= 0; --u) { run += cv[u]; cv[u] = run; }
            }
            SEG[jq * 128 + kk] = run;
            __syncthreads();
            float offset = 0;
#pragma unroll
            for (int q = 0; q < 4; ++q) { const float sv = SEG[q * 128 + kk]; if (dir == 0 ? (q < jq) : (q > jq)) offset += sv; }
            const int adb = jq * 4096 + ((kk >> 3) << 4) + (kk & 7) * 2;
#pragma unroll
            for (int jj = 0; jj < 16; ++jj) { const int i = jq * 16 + jj; const float cum = offset + cv[jj];
                const float qv = bf2f(Qg[(size_t)(t0 + i) * 512 + h * 128 + kk]) * __expf(cum);
                const float kv = bf2f(Kg[(size_t)(t0 + i) * 512 + h * 128 + kk]) * __expf(-cum);
                const int ad = (adb ^ (jj << 4)) + jj * 256;
                *(u16*)(QD + ad) = f2bf(qv); *(u16*)(KI + ad) = f2bf(kv); }
            __syncthreads();
            {
                const int row = itile * 32 + r32; bf16x8 qa[8];
#pragma unroll
                for (int ks = 0; ks < 8; ++ks) qa[ks] = *(const bf16x8*)(QD + row * 256 + (((ks * 2 + hi) ^ (row & 15)) << 4));
                const int ssb = (int)(uintptr_t)SS + v_rd_base(lane) + vb * 512;
                pv_one<0, 8>(acc[0], ssb, qa[0], qa[1], qa[2], qa[3]); pv_one<0, 8>(acc[0], ssb + 32768, qa[4], qa[5], qa[6], qa[7]);
                pv_one<1, 8>(acc[1], ssb, qa[0], qa[1], qa[2], qa[3]); pv_one<1, 8>(acc[1], ssb + 32768, qa[4], qa[5], qa[6], qa[7]);
                f32x16 p0 = f32x16{}, p1 = f32x16{};
#pragma unroll
                for (int ks = 0; ks < 8; ++ks) {
                    const bf16x8 k0 = *(const bf16x8*)(KI + r32 * 256 + (((ks * 2 + hi) ^ (r32 & 15)) << 4));
                    const bf16x8 k1 = *(const bf16x8*)(KI + (32 + r32) * 256 + (((ks * 2 + hi) ^ (r32 & 15)) << 4));
                    p0 = __builtin_amdgcn_mfma_f32_32x32x16_bf16(k0, qa[ks], p0, 0, 0, 0);
                    p1 = __builtin_amdgcn_mfma_f32_32x32x16_bf16(k1, qa[ks], p1, 0, 0, 0);
                }
                const int iq = itile * 32 + r32;
#pragma unroll
                for (int r = 0; r < 16; ++r) { const int s0 = crow(r, hi), s1 = 32 + s0;
                    const bool k0 = dir == 0 ? (s0 <= iq) : (s0 >= iq), k1 = dir == 0 ? (s1 <= iq) : (s1 >= iq);
                    p0[r] = k0 ? p0[r] : 0.f; p1[r] = k1 ? p1[r] : 0.f; }
                bf16x8 pa0, pa1, pa2, pa3;
                PK4(p0, 0, pa0); PK4(p0, 8, pa1); PK4(p1, 0, pa2); PK4(p1, 8, pa3);
                const int vvb = (int)(uintptr_t)VV + v_rd_base(lane) + vb * 512;
                pv_one<0, 8>(acc[0], vvb, pa0, pa1, pa2, pa3); pv_one<1, 8>(acc[1], vvb, pa0, pa1, pa2, pa3);
            }
            __syncthreads();
        }
        float* olb = OL + (itile * 32 + 4 * hi) * 260 + vb * 32 + r32;
#pragma unroll
        for (int n = 0; n < 2; ++n)
#pragma unroll
            for (int r = 0; r < 16; ++r) olb[((r & 3) + 8 * (r >> 2)) * 260 + n * 32] = acc[n][r];
        __syncthreads();
        {
            const int i = tid >> 3, sg = tid & 7; const float* ol = OL + i * 260 + sg * 32;
            float ss = 0;
#pragma unroll
            for (int u = 0; u < 8; ++u) { const f32x4 t = *(const f32x4*)(ol + u * 4); ss += t[0] * t[0] + t[1] * t[1] + t[2] * t[2] + t[3] * t[3]; }
            ss += __shfl_xor(ss, 1); ss += __shfl_xor(ss, 2); ss += __shfl_xor(ss, 4);
            const float rinv = rsqrtf(ss * (1.f / 256.f) + EPS);
            const u16* gp = Gg + (size_t)(t0 + i) * 1024 + h * 256 + sg * 32; u16* op = OUT + (size_t)(t0 + i) * 1024 + h * 256 + sg * 32;
            const float* hn = F.in(21) + sg * 32;
#pragma unroll
            for (int q = 0; q < 4; ++q) { const bf16x8 g8 = *(const bf16x8*)(gp + q * 8); u32x4 w;
                const f32x4 oa = *(const f32x4*)(ol + q * 8), ob = *(const f32x4*)(ol + q * 8 + 4);
                const float o8[8] = {oa[0], oa[1], oa[2], oa[3], ob[0], ob[1], ob[2], ob[3]};
#pragma unroll
                for (int u = 0; u < 4; ++u) { const int e0 = q * 8 + 2 * u;
                    w[u] = cvtpk(o8[2 * u] * rinv * hn[e0] * silu_f(bf2f((u16)g8[2 * u])), o8[2 * u + 1] * rinv * hn[e0 + 1] * silu_f(bf2f((u16)g8[2 * u + 1]))); }
                *(u32x4*)(op + q * 8) = w; }
        }
    }
}

__device__ __forceinline__ void pair_decode(int p, int& elo, int& ehi) { elo = p < 3 ? 0 : (p < 5 ? 1 : 2); ehi = p < 3 ? p + 1 : (p < 5 ? p - 1 : 3); }
struct MoeATiles {
    typedef GTile<RowsGather, RowsPlain, EpiMoeA> Tile;
    const int* tab; u16* H; const int* rowtok; const u16* wgu; u16* act; const float* roww; int ntiles, first, G;
    __device__ __forceinline__ bool get(int i, Tile& t) const {
        const int tile = first + i * G; if (tile >= ntiles) return false;
        const int mt = tile >> 4, nt = tile & 15, c = tab[32 + mt], g = c / 6; int elo, ehi; pair_decode(c % 6, elo, ehi);
        const int half = nt >> 3, e = half ? ehi : elo;
        t.al = RowsGather{H, 1024, rowtok};
        t.bl = RowsPlain{wgu + ((size_t)(g * 4 + e) * 1024 + (nt & 7) * 128) * 1024, 1024};
        t.ep = EpiMoeA{act, roww, half, half * 512 + (nt & 7) * 64};
        t.brow = mt * 256; t.bcol = 0; return true; }
};
struct MoeBTiles {
    typedef GTile<RowsPlain, RowsSplitK, EpiMoeB> Tile;
    const int* tab; ResCtx F; int li; const u16* wd; const u16* act; const int* rowtok; int ntiles, first, G;
    __device__ __forceinline__ bool get(int i, Tile& t) const {
        const int tile = first + i * G; if (tile >= ntiles) return false;
        const int mt = tile >> 3, nt = tile & 7, c = tab[32 + mt], g = c / 6; int elo, ehi; pair_decode(c % 6, elo, ehi);
        t.al = RowsPlain{act, 1024};
        t.bl = RowsSplitK{wd + (size_t)(g * 4 + elo) * 1024 * 512, wd + (size_t)(g * 4 + ehi) * 1024 * 512, 512, 8};
        t.ep = EpiMoeB{F, li, rowtok};
        t.brow = mt * 256; t.bcol = nt * 128; return true; }
};
__device__ __forceinline__ void moe_gemm_a(const Frame& F, int li) {
    int* tab = (int*)(F.lds + LDS_TAB); moe_table(F, li, tab);
    const int nmt = tab[24] >> 8;
    MoeATiles prov{tab, F.W<u16>(WS_H), F.W<int>(WS_ROWTOK), F.W<u16>(WS_MOEW), F.W<u16>(MOE_ACT), F.W<float>(WS_ROWW), nmt * 16, F.bx, F.G};
    gemm_stream<4, 2>(F.lds, prov, 16);
}
__device__ __forceinline__ void moe_gemm_b(const Frame& F, int li) {
    int* tab = (int*)(F.lds + LDS_TAB); moe_table(F, li, tab);
    const int nmt = tab[24] >> 8;
    MoeBTiles prov{tab, res_ctx(F), li, F.W<u16>(WS_MOEW + MOE_WGU_BYTES), F.W<u16>(MOE_ACT), F.W<int>(WS_ROWTOK), nmt * 8, F.bx, F.G};
    gemm_stream<4, 2>(F.lds, prov, 16);
}
__device__ __forceinline__ void final_norm(const Frame& F) {
    const int lane = threadIdx.x & 63, wid = threadIdx.x >> 6;
    for (int row = F.bx * NWAVE + wid; row < NLAT; row += F.G * NWAVE) {
        float* xr = F.out + (size_t)row * DM; f32x4 v[4];
#pragma unroll
        for (int i = 0; i < 4; ++i) v[i] = *(const f32x4*)(xr + i * 256 + lane * 4);
        float ss = 0;
#pragma unroll
        for (int i = 0; i < 4; ++i) ss += v[i][0] * v[i][0] + v[i][1] * v[i][1] + v[i][2] * v[i][2] + v[i][3] * v[i][3];
        ss = wave_sum(ss); const float rinv = rsqrtf(ss * (1.f / DM) + EPS);
#pragma unroll
        for (int i = 0; i < 4; ++i) { const f32x4 g = *(const f32x4*)(F.in(30) + i * 256 + lane * 4);
            f32x4 o = {v[i][0] * rinv * g[0], v[i][1] * rinv * g[1], v[i][2] * rinv * g[2], v[i][3] * rinv * g[3]};
            *(f32x4*)(xr + i * 256 + lane * 4) = o; }
    }
}

constexpr int N_PHASES = 42;
__global__ void __launch_bounds__(NTHR, 2) fwd_kernel(Params p) {
    extern __shared__ __attribute__((aligned(16))) char lds[];
    Frame F; F.p = &p; F.ws = p.ws; F.lds = lds; F.out = p.out; F.G = (int)gridDim.x; F.bx = (int)blockIdx.x;
    const int lo = p.ph_lo, hi = p.ph_hi;
#if !MK_PER_PHASE
    if (threadIdx.x == 0) *(uint4*)(lds + LDS_BARW) = make_uint4(0u, 0u, 0u, 0u);
    __syncthreads();
    XcdBarrier bar = xcd_barrier_post((unsigned*)(p.ws + WS_CTL), (volatile LAS unsigned*)(lds + LDS_BARW));
#define GRID_BAR() xcd_barrier(bar)
#else
#define GRID_BAR() do {} while (0)
#endif
#ifndef MK_EN
#define MK_EN 0xFFFFFFFFu
#endif
#define EN(g) (((MK_EN) >> (g)) & 1u)
#ifndef MK_REP
#define MK_REP 0u
#endif
#define REP(g) (((MK_REP) >> (g)) & 1u)
#define IN(k) (lo <= (k) && (k) < hi)
#define SEAM(k) do { if ((k) + 1 < hi) GRID_BAR(); } while (0)
#define DUP(g, body) do { body; if (REP(g)) { GRID_BAR(); body; } } while (0)

    if (EN(0) && IN(0)) { DUP(0, (p0_mods(F), __syncthreads(), p0_rope(F), p0_weights(F))); SEAM(0); }

#define LAYER(LI) { constexpr int li = (LI); constexpr int base = 1 + li * 10; constexpr bool first = li == 0, last = li == DEPTH - 1; constexpr int kind = li % 3, j = li / 3; \
        if (EN(1) && IN(base + 0)) { DUP(1, norm_phase<false>(F, li, 0, first)); SEAM(base + 0); } \
        if constexpr (kind == 0) { \
            if (EN(2) && IN(base + 1)) { EpiF32 ep{F.W<float>(MLA_DQ), 544, 544}; \
                gemm_phase<4, 2>(F, RowsPlain{F.W<u16>(WS_H), 1024}, RowsPlain{F.W<u16>(WS_WDQKV) + (size_t)j * 640 * 1024, 1024}, ep, 0, 132, 5, 16, 0, 0); if (REP(2)) { GRID_BAR(); gemm_phase<4, 2>(F, RowsPlain{F.W<u16>(WS_H), 1024}, RowsPlain{F.W<u16>(WS_WDQKV) + (size_t)j * 640 * 1024, 1024}, ep, 0, 132, 5, 16, 0, 0); } SEAM(base + 1); } \
            if (EN(3) && IN(base + 2)) { DUP(3, mla_rowpass(F, j)); SEAM(base + 2); } \
            if (EN(2) && IN(base + 3)) { \
                EpiMlaQ eq{F.W<u16>(MLA_Q), F.W<float>(WS_ROPEA), F.W<float>(WS_ROPEA) + SEQ * 16, 0.10206207261596577f * LOG2E}; \
                gemm_phase<4, 2>(F, RowsPlain{F.W<u16>(MLA_CN), 512}, RowsPlain{F.W<u16>(WS_WUQ) + (size_t)j * 1536 * 256, 256}, eq, 0, 132, 12, 4, 0, 0); \
                EpiMlaKV ek{F.W<u16>(MLA_KN), (long)((MLA_V - MLA_KN) / 2)}; \
                gemm_phase<4, 2>(F, RowsPlain{F.W<u16>(MLA_CN) + 256, 512}, RowsPlain{F.W<u16>(WS_WUKV) + (size_t)j * 2048 * 256, 256}, ek, 0, 132, 16, 4, 132 * 12, 0); \
                SEAM(base + 3); } \
            if (EN(4) && IN(base + 4)) { DUP(4, mla_attn(F, !last)); SEAM(base + 4); } \
            if (EN(2) && IN(base + 5)) { EpiResid ep{res_ctx(F), li, 2, first}; \
                gemm_phase<4, 2>(F, RowsPlain{F.W<u16>(MLA_DQ), 1024}, RowsPlain{F.W<u16>(WS_WOM) + (size_t)j * 1024 * 1024, 1024}, ep, last ? 4 : 0, 132, 8, 16, 0, 0); SEAM(base + 5); } \
        } else if constexpr (kind == 1) { \
            if (EN(5) && IN(base + 1)) { EpiDiffQKV ep{F.W<u16>(DF_Q), (long)((DF_K - DF_Q) / 2), F.W<u16>(DF_V), F.W<float>(WS_ROPEB), F.W<float>(WS_ROPEB) + SEQ * 32, 0.125f * LOG2E}; \
                gemm_phase<4, 2>(F, RowsPlain{F.W<u16>(WS_H), 1024}, RowsPlain{F.W<u16>(WS_WQKVD), 1024}, ep, 0, 132, 24, 16, 0, 0); if (REP(5)) { GRID_BAR(); gemm_phase<4, 2>(F, RowsPlain{F.W<u16>(WS_H), 1024}, RowsPlain{F.W<u16>(WS_WQKVD), 1024}, ep, 0, 132, 24, 16, 0, 0); } SEAM(base + 1); } \
            if (EN(6) && IN(base + 2)) { DUP(6, diff_attn(F)); SEAM(base + 2); } \
            if (EN(7) && IN(base + 3)) { DUP(7, diff_rowpass(F, 0.35550906759906f)); SEAM(base + 3); } \
            if (EN(5) && IN(base + 4)) { EpiResid ep{res_ctx(F), li, 2, first}; \
                gemm_phase<4, 2>(F, RowsPlain{F.W<u16>(DF_Q), 1024}, RowsPlain{F.W<u16>(WS_WOD), 1024}, ep, 0, 132, 8, 16, 0, 0); SEAM(base + 4); } \
        } else { \
            if (EN(8) && IN(base + 1)) { EpiGlaIn ep{F.W<u16>(GL_Q), F.W<u16>(GL_K), F.W<u16>(GL_V), F.W<u16>(GL_G), F.W<float>(GL_Z)}; \
                gemm_phase<4, 2>(F, RowsPlain{F.W<u16>(WS_H), 1024}, RowsPlain{F.W<u16>(WS_WING), 1024}, ep, 0, 132, 25, 16, 0, 0); if (REP(8)) { GRID_BAR(); gemm_phase<4, 2>(F, RowsPlain{F.W<u16>(WS_H), 1024}, RowsPlain{F.W<u16>(WS_WING), 1024}, ep, 0, 132, 25, 16, 0, 0); } SEAM(base + 1); } \
            if (EN(9) && IN(base + 2)) { DUP(9, gla_g1(F)); SEAM(base + 2); } \
            if (EN(10) && IN(base + 3)) { gla_g2(F); SEAM(base + 3); } \
            if (EN(11) && IN(base + 4)) { DUP(11, gla_g3(F)); SEAM(base + 4); } \
            if (EN(8) && IN(base + 5)) { EpiResid ep{res_ctx(F), li, 2, first}; \
                gemm_phase<4, 2>(F, RowsPlain{F.W<u16>(WS_H), 1024}, RowsPlain{F.W<u16>(WS_WOG), 1024}, ep, 0, 132, 8, 16, 0, 0); SEAM(base + 5); } \
        } \
        if (EN(12) && IN(base + 6)) { norm_phase<true>(F, li, last ? NCTX : 0, false); SEAM(base + 6); } \
        if (EN(13) && IN(base + 7)) { DUP(13, (moe_weights(F, li), moe_scatter(F, li, last ? NCTX : 0))); SEAM(base + 7); } \
        if (EN(14) && IN(base + 8)) { DUP(14, moe_gemm_a(F, li)); SEAM(base + 8); } \
        if (EN(15) && IN(base + 9)) { moe_gemm_b(F, li); SEAM(base + 9); } \
    }
    LAYER(0) LAYER(1) LAYER(2) LAYER(3)
    if (EN(16) && IN(41)) { final_norm(F); }
}

extern "C" void kernel_launch(void* const* d_in, const int* in_sizes, int n_in, void* d_out, int out_size, void* d_ws, size_t ws_size, hipStream_t stream) {
    static int grid = 0;
    if (grid == 0) {
        if (n_in != 31 || out_size != NLAT * DM || ws_size < WS_END) {
            fprintf(stderr, "kernel_launch: built for 31 inputs, out %d floats, ws >= %zu bytes; got n_in %d out %d ws %zu\n", NLAT * DM, (size_t)WS_END, n_in, out_size, ws_size);
            grid = -1; return; }
        int dev = 0, cus = 0;
        if (hipGetDevice(&dev) != hipSuccess || hipDeviceGetAttribute(&cus, hipDeviceAttributeMultiprocessorCount, dev) != hipSuccess) { grid = -1; return; }
        if (hipFuncSetAttribute((const void*)fwd_kernel, hipFuncAttributeMaxDynamicSharedMemorySize, LDS_BYTES) != hipSuccess) { fprintf(stderr, "kernel_launch: hipFuncSetAttribute failed\n"); grid = -1; return; }
        int per_cu = 0;
        if (hipOccupancyMaxActiveBlocksPerMultiprocessor(&per_cu, (const void*)fwd_kernel, NTHR, LDS_BYTES) != hipSuccess || per_cu < 1)
            fprintf(stderr, "kernel_launch: occupancy query reports %d workgroups per CU\n", per_cu);
        (void)hipGetLastError();
        grid = cus;
    }
    if (grid < 0) return;
    (void)in_sizes;
    (void)hipMemsetAsync((char*)d_ws + WS_CTL, 0, CTL_BYTES, stream);
    Params p{};
    for (int i = 0; i < 31; ++i) p.in[i] = (const float*)d_in[i];
    p.out = (float*)d_out; p.ws = (unsigned char*)d_ws;
#if MK_PER_PHASE
    for (int ph = 0; ph < N_PHASES; ++ph) { p.ph_lo = ph; p.ph_hi = ph + 1; hipLaunchKernelGGL(fwd_kernel, dim3(grid), dim3(NTHR), LDS_BYTES, stream, p); }
#else
    p.ph_lo = 0; p.ph_hi = N_PHASES;
    hipLaunchKernelGGL(fwd_kernel, dim3(grid), dim3(NTHR), LDS_BYTES, stream, p);
#endif
}
```

```cpp
#include <hip/hip_runtime.h>
#include <stdint.h>
#include <stdio.h>

#ifndef MK_PER_PHASE
#define MK_PER_PHASE 0
#endif

typedef unsigned short u16;
using bf16x8 = __attribute__((ext_vector_type(8))) short;
using s16x4  = __attribute__((ext_vector_type(4))) short;
using f32x16 = __attribute__((ext_vector_type(16))) float;
using f32x4  = __attribute__((ext_vector_type(4))) float;
using u32x4  = __attribute__((ext_vector_type(4))) unsigned;
using u32x2  = __attribute__((ext_vector_type(2))) unsigned;

constexpr int DM = 1024, NBATCH = 4, SEQ = 8192, CTXL = 256, DEPTH = 4;
constexpr int NCTX = NBATCH * CTXL;
constexpr int NLAT = NBATCH * SEQ;
constexpr int NTOK = NCTX + NLAT;
constexpr int KEYS = CTXL + SEQ;
constexpr float EPS = 1e-6f;
constexpr int NTHR = 512, NWAVE = 8;
constexpr float LOG2E = 1.4426950408889634f;

constexpr size_t al256(size_t x) { return (x + 255) / 256 * 256; }
constexpr size_t WS_CTL   = 0;
constexpr size_t CTL_BYTES = 32768;
constexpr size_t WS_MODS  = WS_CTL + CTL_BYTES;
constexpr size_t WS_ROPEA = WS_MODS + al256((size_t)DEPTH * 5 * 6144 * 4);
constexpr size_t WS_ROPEB = WS_ROPEA + (size_t)2 * SEQ * 16 * 4;
constexpr size_t WS_XC    = WS_ROPEB + (size_t)2 * SEQ * 32 * 4;
constexpr size_t WS_WDQKV = WS_XC + (size_t)NCTX * DM * 4;
constexpr size_t WS_WUQ   = WS_WDQKV + (size_t)2 * 640 * 1024 * 2;
constexpr size_t WS_WUKV  = WS_WUQ + (size_t)2 * 1536 * 256 * 2;
constexpr size_t WS_WOM   = WS_WUKV + (size_t)2 * 2048 * 256 * 2;
constexpr size_t WS_WQKVD = WS_WOM + (size_t)2 * 1024 * 1024 * 2;
constexpr size_t WS_WOD   = WS_WQKVD + (size_t)3072 * 1024 * 2;
constexpr size_t WS_WING  = WS_WOD + (size_t)1024 * 1024 * 2;
constexpr size_t WS_WOG   = WS_WING + (size_t)3200 * 1024 * 2;
constexpr size_t WS_TOK   = WS_WOG + (size_t)1024 * 1024 * 2;
constexpr size_t WS_ROWTOK= WS_TOK + (size_t)NTOK * 16;
constexpr int    RMAX     = 40960;
constexpr size_t WS_ROWW  = WS_ROWTOK + (size_t)RMAX * 4;
constexpr size_t WS_H     = al256(WS_ROWW + (size_t)RMAX * 8);
constexpr size_t H_BYTES  = (size_t)NTOK * DM * 2;
constexpr size_t WS_MOEW  = WS_H + H_BYTES;
constexpr size_t MOE_WGU_BYTES = (size_t)16 * 1024 * 1024 * 2;
constexpr size_t MOE_WD_BYTES  = (size_t)16 * 1024 * 512 * 2;
constexpr size_t MOEW_BYTES = MOE_WGU_BYTES + MOE_WD_BYTES;
constexpr size_t WS_BIG   = WS_MOEW + MOEW_BYTES;
constexpr size_t MLA_Q    = WS_BIG;
constexpr size_t MLA_KN   = MLA_Q + (size_t)NBATCH * 16 * KEYS * 96 * 2;
constexpr size_t MLA_V    = MLA_KN + (size_t)NBATCH * 16 * KEYS * 64 * 2;
constexpr size_t MLA_KPE  = MLA_V + (size_t)NBATCH * 16 * KEYS * 64 * 2;
constexpr size_t MLA_DQ   = MLA_KPE + al256((size_t)NBATCH * KEYS * 32 * 2);
constexpr size_t MLA_CN   = MLA_DQ + (size_t)NTOK * 544 * 4;
constexpr size_t MLA_END  = MLA_CN + (size_t)NTOK * 512 * 2;
constexpr size_t DF_Q     = WS_BIG;
constexpr size_t DF_K     = DF_Q + (size_t)NBATCH * 16 * KEYS * 64 * 2;
constexpr size_t DF_V     = DF_K + (size_t)NBATCH * 16 * KEYS * 64 * 2;
constexpr size_t DF_OS    = DF_V + (size_t)NBATCH * 8 * KEYS * 128 * 2;
constexpr size_t DF_END   = DF_OS + (size_t)2 * NTOK * DM * 2;
constexpr size_t GL_STATE = WS_MOEW;
constexpr size_t GL_STATE_BYTES = (size_t)NBATCH * 4 * 2 * 132 * 128 * 256 * 2;
constexpr size_t GL_DEC   = GL_STATE + GL_STATE_BYTES;
constexpr size_t GL_Q     = GL_DEC + al256((size_t)4224 * 128 * 4);
constexpr size_t GL_K     = GL_Q + (size_t)NTOK * 512 * 2;
constexpr size_t GL_V     = GL_K + (size_t)NTOK * 512 * 2;
constexpr size_t GL_G     = GL_V + (size_t)NTOK * 1024 * 2;
constexpr size_t GL_Z     = GL_G + (size_t)NTOK * 1024 * 2;
constexpr size_t GL_END   = GL_Z + (size_t)NTOK * 32 * 4;
constexpr size_t MOE_ACT  = WS_BIG;
constexpr size_t MOE_END  = MOE_ACT + (size_t)RMAX * 1024 * 2;
constexpr size_t cmax(size_t a, size_t b) { return a > b ? a : b; }
constexpr size_t WS_END   = cmax(cmax(MLA_END, DF_END), cmax(GL_END, MOE_END));

#define XCD_BAR_WORDS 3456
constexpr int CW_CNT = 4096;

#define XB_TMO      128
#define XB_XCNT(j)  (256  + 64 * (j))
#define XB_XSUB(j)  (1280 + 64 * (j))
#define XB_XGEN(j)  (2304 + 64 * (j))
#define XB_TOP      3328
#define XB_TOPGEN   3392
#define XB_SPIN_CAP (1u << 24)
#define LAS __attribute__((address_space(3)))
__device__ __forceinline__ unsigned xb_ld(unsigned* p)              { return __hip_atomic_load(p, __ATOMIC_RELAXED, __HIP_MEMORY_SCOPE_AGENT); }
__device__ __forceinline__ unsigned xb_add(unsigned* p, unsigned v) { return __hip_atomic_fetch_add(p, v, __ATOMIC_RELAXED, __HIP_MEMORY_SCOPE_AGENT); }
__device__ __forceinline__ unsigned xb_xcc_id() { return (unsigned)__builtin_amdgcn_s_getreg((3 << 11) | 20) & 0xFu; }
#define XB_SPIN(cond, bar) do { unsigned _sp = 0; while (cond) { __builtin_amdgcn_s_sleep(1); \
    if ((++_sp & 255u) == 0u) { if (xb_ld(&(bar)[XB_TMO])) break; if (_sp > XB_SPIN_CAP) { atomicAdd(&(bar)[XB_TMO], 1u); break; } } } } while (0)
struct XcdBarrier { unsigned* bar; unsigned x; volatile LAS unsigned* st; };
__device__ __forceinline__ XcdBarrier xcd_barrier_post(unsigned* bar, volatile LAS unsigned* st) {
    XcdBarrier b; b.bar = bar; b.x = xb_xcc_id(); b.st = st;
    if (threadIdx.x == 0) (void)xb_add(&bar[XB_XCNT(b.x)], 1u);
    return b;
}
__device__ __forceinline__ void xcd_barrier_complete(unsigned* bar, unsigned x, unsigned& nloc, unsigned& nx) {
    const unsigned G = gridDim.x * gridDim.y * gridDim.z;
    unsigned sum, cnt, mine, sp = 0u;
    for (;;) {
        sum = 0u; cnt = 0u; mine = 0u;
#pragma unroll
        for (unsigned j = 0; j < 16; ++j) { const unsigned c = xb_ld(&bar[XB_XCNT(j)]); sum += c; cnt += (c > 0u) ? 1u : 0u; mine = (j == x) ? c : mine; }
        if (sum == G) break;
        __builtin_amdgcn_s_sleep(1);
        if ((++sp & 255u) == 0u) { if (xb_ld(&bar[XB_TMO])) break; if (sp > XB_SPIN_CAP) { atomicAdd(&bar[XB_TMO], 1u); break; } }
    }
    nloc = mine > 0u ? mine : 1u; nx = cnt > 0u ? cnt : 1u;
}
__device__ __forceinline__ void xcd_barrier(const XcdBarrier& b) {
    asm volatile("s_waitcnt vmcnt(0)" ::: "memory");
    __syncthreads();
    if (threadIdx.x == 0) {
        unsigned* bar = b.bar;
        __builtin_amdgcn_s_waitcnt(0);
        unsigned nloc = b.st[0], nx = b.st[1];
        if (nloc == 0u) { xcd_barrier_complete(bar, b.x, nloc, nx); b.st[0] = nloc; b.st[1] = nx; }
        const unsigned old = xb_add(&bar[XB_XSUB(b.x)], 1u);
        const unsigned gen = old / nloc;
        if (old + 1u == (gen + 1u) * nloc) {
            __builtin_amdgcn_fence(__ATOMIC_RELEASE, "agent");
            asm volatile("s_waitcnt vmcnt(0)" ::: "memory");
            const unsigned og = xb_add(&bar[XB_TOP], 1u);
            const unsigned tg = og / nx;
            if (og + 1u == (tg + 1u) * nx) xb_add(&bar[XB_TOPGEN], 1u);
            else XB_SPIN(xb_ld(&bar[XB_TOPGEN]) == tg, bar);
            __builtin_amdgcn_fence(__ATOMIC_ACQUIRE, "agent");
            xb_add(&bar[XB_XGEN(b.x)], 1u);
            asm volatile("s_waitcnt vmcnt(0)" ::: "memory");
        } else {
            XB_SPIN(xb_ld(&bar[XB_XGEN(b.x)]) == gen, bar);
            __builtin_amdgcn_fence(__ATOMIC_ACQUIRE, "agent");
            asm volatile("s_waitcnt vmcnt(0)" ::: "memory");
        }
    }
    __syncthreads();
}

__device__ __forceinline__ u16 f2bf(float f) { unsigned u = __float_as_uint(f); u += 0x7FFFu + ((u >> 16) & 1u); return (u16)(u >> 16); }
__device__ __forceinline__ float bf2f(u16 h) { return __uint_as_float((unsigned)h << 16); }
__device__ __forceinline__ unsigned cvtpk(float lo, float hi) { unsigned r; asm volatile("v_cvt_pk_bf16_f32 %0, %1, %2" : "=v"(r) : "v"(lo), "v"(hi)); return r; }
__device__ __forceinline__ float wave_sum(float v) {
#pragma unroll
    for (int o = 32; o; o >>= 1) v += __shfl_xor(v, o);
    return v;
}
__device__ __forceinline__ int crow(int r, int hi) { return (r & 3) + 8 * (r >> 2) + 4 * hi; }
__device__ __forceinline__ void row_bp(int row, int& b, int& pos) {
    if (row < NCTX) { b = row >> 8; pos = row & 255; } else { const int r = row - NCTX; b = r >> 13; pos = CTXL + (r & (SEQ - 1)); }
}
__device__ __forceinline__ float silu_f(float x) { return x / (1.f + __expf(-x)); }
#define SBAR() __builtin_amdgcn_sched_barrier(0)

struct Params { const float* in[31]; float* out; unsigned char* ws; int ph_lo, ph_hi; };

struct RowsPlain  { const u16* base; long ld;
    __device__ __forceinline__ long off(int r) const { return (long)r * ld; }
    __device__ __forceinline__ const u16* kbase(int kt) const { return base + kt * 64; } };
struct RowsGather { const u16* base; long ld; const int* idx;
    __device__ __forceinline__ long off(int r) const { int t = idx[r]; t = t < 0 ? 0 : t; return (long)t * ld; }
    __device__ __forceinline__ const u16* kbase(int kt) const { return base + kt * 64; } };
struct RowsSplitK { const u16* b0; const u16* b1; long ld; int ks;
    __device__ __forceinline__ long off(int r) const { return (long)r * ld; }
    __device__ __forceinline__ const u16* kbase(int kt) const { return kt < ks ? b0 + kt * 64 : b1 + (kt - ks) * 64; } };

constexpr int GEMM_LDS = 2 * 384 * 128;

template <int WM, int WN, class AL, class BL, class EP>
__device__ __forceinline__ void gemm_tile(char* lds, const AL al, const BL bl, EP& ep, int brow, int bcol, int nk) {
    constexpr int BM = WM * 64, BN = WN * 64, STG = (BM + BN) * 128, NA = BM / 64, NB = BN / 64;
    const int tid = threadIdx.x, lane = tid & 63, wid = __builtin_amdgcn_readfirstlane(tid >> 6);
    const int wm = wid / WN, wn = wid % WN, r32 = lane & 31, hi = lane >> 5;
    long aoff[NA], boff[NB];
#pragma unroll
    for (int i = 0; i < NA; ++i) { const int r = (i * 8 + wid) * 8 + (lane >> 3); const int c = (lane & 7) ^ ((r >> 1) & 7); aoff[i] = al.off(brow + r) + c * 8; }
#pragma unroll
    for (int i = 0; i < NB; ++i) { const int r = (i * 8 + wid) * 8 + (lane >> 3); const int c = (lane & 7) ^ ((r >> 1) & 7); boff[i] = bl.off(bcol + r) + c * 8; }
    const int ldsw = wid * 1024 + lane * 16;
    int abase[2], bbase[2];
#pragma unroll
    for (int i = 0; i < 2; ++i) {
        const int ra = wm * 64 + i * 32 + r32; abase[i] = ra * 128 + ((hi ^ ((ra >> 1) & 7)) << 4);
        const int rb = wn * 64 + i * 32 + r32; bbase[i] = BM * 128 + rb * 128 + ((hi ^ ((rb >> 1) & 7)) << 4);
    }
    f32x16 acc[2][2];
#pragma unroll
    for (int i = 0; i < 2; ++i)
#pragma unroll
        for (int j = 0; j < 2; ++j) acc[i][j] = f32x16{};
#define GSTAGE(kt, buf) do { const u16* _ka = al.kbase(kt); const u16* _kb = bl.kbase(kt); char* _d = lds + (buf) * STG + ldsw; \
        _Pragma("unroll") for (int _i = 0; _i < NA; ++_i) __builtin_amdgcn_global_load_lds((const unsigned*)(_ka + aoff[_i]), (unsigned*)(_d + _i * 8192), 16, 0, 0); \
        _Pragma("unroll") for (int _i = 0; _i < NB; ++_i) __builtin_amdgcn_global_load_lds((const unsigned*)(_kb + boff[_i]), (unsigned*)(_d + BM * 128 + _i * 8192), 16, 0, 0); } while (0)
    __syncthreads();
    GSTAGE(0, 0);
    for (int kt = 0; kt < nk; ++kt) {
        asm volatile("s_waitcnt vmcnt(0)" ::: "memory");
        __syncthreads();
        if (kt + 1 < nk) GSTAGE(kt + 1, (kt + 1) & 1);
        const char* sb = lds + (kt & 1) * STG;
#pragma unroll
        for (int ks = 0; ks < 4; ++ks) {
            bf16x8 a0 = *(const bf16x8*)(sb + (abase[0] ^ (ks << 5)));
            bf16x8 a1 = *(const bf16x8*)(sb + (abase[1] ^ (ks << 5)));
            bf16x8 b0 = *(const bf16x8*)(sb + (bbase[0] ^ (ks << 5)));
            bf16x8 b1 = *(const bf16x8*)(sb + (bbase[1] ^ (ks << 5)));
            acc[0][0] = __builtin_amdgcn_mfma_f32_32x32x16_bf16(a0, b0, acc[0][0], 0, 0, 0);
            acc[0][1] = __builtin_amdgcn_mfma_f32_32x32x16_bf16(a0, b1, acc[0][1], 0, 0, 0);
            acc[1][0] = __builtin_amdgcn_mfma_f32_32x32x16_bf16(a1, b0, acc[1][0], 0, 0, 0);
            acc[1][1] = __builtin_amdgcn_mfma_f32_32x32x16_bf16(a1, b1, acc[1][1], 0, 0, 0);
        }
    }
#undef GSTAGE
    ep(acc, brow + wm * 64, bcol + wn * 64, lane);
}


constexpr int GSTG = 384 * 128;
template <class AL_, class BL_, class EP_> struct GTile { typedef EP_ EPT; AL_ al; BL_ bl; EP_ ep; int brow, bcol; };
__device__ __forceinline__ bool tile_seq(int i, int bx, int G, int nM, int nN, int& m, int& n) {
    const int s = (G == 256) ? (i * 8 + (bx & 7)) * 32 + (bx >> 3) : bx + i * G;
    if (s >= nM * nN) return false;
    const int full = (nM >> 2) * 4 * nN;
    if (s < full) { const int band = s / (4 * nN), rem = s - band * 4 * nN; n = rem >> 2; m = band * 4 + (rem & 3); }
    else { const int h = nM & 3, rem = s - full; n = rem / h; m = (nM & ~3) + rem - n * h; }
    return true;
}
template <class AL_, class BL_, class EP_> struct PlainTiles {
    typedef GTile<AL_, BL_, EP_> Tile; static constexpr bool EP_CONST = true;
    AL_ al; BL_ bl; EP_ ep; int mt0, nM, nN, bx, G;
    __device__ __forceinline__ bool get(int i, Tile& t) const {
        int m, n; if (!tile_seq(i, bx, G, nM, nN, m, n)) return false;
        t.al = al; t.bl = bl; t.ep = ep; t.brow = (mt0 + m) * 256; t.bcol = n * 128; return true; }
};
template <int WM, int WN, class P>
__device__ __forceinline__ void gemm_stream(char* lds, const P& prov, int nk) {
    constexpr int BM = WM * 64, BN = WN * 64, NA = BM / 64, NB = BN / 64;
    static_assert(NA + NB == 6, "the counted wait assumes six LDS-DMA loads per wave per K-step");
    const int tid = threadIdx.x, lane = tid & 63, wid = __builtin_amdgcn_readfirstlane(tid >> 6);
    const int wm = wid / WN, wn = wid % WN, r32 = lane & 31, hi = lane >> 5;
    typename P::Tile cur, nxt;
    if (!prov.get(0, cur)) return;
    unsigned aoff[NA], boff[NB], aoffn[NA], boffn[NB];
#define GOFFS(T, AO, BO) do { \
    _Pragma("unroll") for (int _i = 0; _i < NA; ++_i) { const int _r = (_i * 8 + wid) * 8 + (lane >> 3); const int _c = (lane & 7) ^ ((_r >> 1) & 7); AO[_i] = (unsigned)((T).al.off((T).brow + _r) + _c * 8); } \
    _Pragma("unroll") for (int _i = 0; _i < NB; ++_i) { const int _r = (_i * 8 + wid) * 8 + (lane >> 3); const int _c = (lane & 7) ^ ((_r >> 1) & 7); BO[_i] = (unsigned)((T).bl.off((T).bcol + _r) + _c * 8); } } while (0)
#define GSTAGE2(T, AO, BO, kt, slot) do { const u16* _ka = (T).al.kbase(kt); const u16* _kb = (T).bl.kbase(kt); char* _d = lds + (slot) * GSTG + ldsw; \
        _Pragma("unroll") for (int _i = 0; _i < NA; ++_i) __builtin_amdgcn_global_load_lds((const unsigned*)(_ka + AO[_i]), (unsigned*)(_d + _i * 8192), 16, 0, 0); \
        _Pragma("unroll") for (int _i = 0; _i < NB; ++_i) __builtin_amdgcn_global_load_lds((const unsigned*)(_kb + BO[_i]), (unsigned*)(_d + BM * 128 + _i * 8192), 16, 0, 0); } while (0)
    GOFFS(cur, aoff, boff);
    const int ldsw = wid * 1024 + lane * 16;
    int abase[2], bbase[2];
#pragma unroll
    for (int i = 0; i < 2; ++i) {
        const int ra = wm * 64 + i * 32 + r32; abase[i] = ra * 128 + ((hi ^ ((ra >> 1) & 7)) << 4);
        const int rb = wn * 64 + i * 32 + r32; bbase[i] = BM * 128 + rb * 128 + ((hi ^ ((rb >> 1) & 7)) << 4);
    }
    f32x16 acc[2][2];
#pragma unroll
    for (int i = 0; i < 2; ++i)
#pragma unroll
        for (int j = 0; j < 2; ++j) acc[i][j] = f32x16{};
    __syncthreads();
    GSTAGE2(cur, aoff, boff, 0, 0); GSTAGE2(cur, aoff, boff, 1, 1);
    int slot = 0; bool pendE = false; typename P::Tile::EPT pep = cur.ep; int pbrow = 0, pbcol = 0;
    for (int i = 0;; ++i) {
        const bool has_next = prov.get(i + 1, nxt);
        if (has_next) GOFFS(nxt, aoffn, boffn);
        for (int kt = 0; kt < nk; ++kt) {
            if ((kt + 1 < nk) || has_next) asm volatile("s_waitcnt vmcnt(6)" ::: "memory"); else asm volatile("s_waitcnt vmcnt(0)" ::: "memory");
            __builtin_amdgcn_s_barrier(); asm volatile("" ::: "memory");
            const int s2 = slot >= 1 ? slot - 1 : 2;
            if (kt + 2 < nk) GSTAGE2(cur, aoff, boff, kt + 2, s2); else if (has_next) GSTAGE2(nxt, aoffn, boffn, kt + 2 - nk, s2);
            if (kt == 0 && pendE) {
                if constexpr (P::EP_CONST) (void)prov.ep(acc, pbrow + wm * 64, pbcol + wn * 64, lane); else (void)pep(acc, pbrow + wm * 64, pbcol + wn * 64, lane);
                pendE = false;
#pragma unroll
                for (int a = 0; a < 2; ++a)
#pragma unroll
                    for (int b = 0; b < 2; ++b) acc[a][b] = f32x16{};
            }
            const char* sb = lds + slot * GSTG;
#pragma unroll
            for (int ks = 0; ks < 4; ++ks) {
                bf16x8 a0 = *(const bf16x8*)(sb + (abase[0] ^ (ks << 5)));
                bf16x8 a1 = *(const bf16x8*)(sb + (abase[1] ^ (ks << 5)));
                bf16x8 b0 = *(const bf16x8*)(sb + (bbase[0] ^ (ks << 5)));
                bf16x8 b1 = *(const bf16x8*)(sb + (bbase[1] ^ (ks << 5)));
                acc[0][0] = __builtin_amdgcn_mfma_f32_32x32x16_bf16(b0, a0, acc[0][0], 0, 0, 0);
                acc[0][1] = __builtin_amdgcn_mfma_f32_32x32x16_bf16(b1, a0, acc[0][1], 0, 0, 0);
                acc[1][0] = __builtin_amdgcn_mfma_f32_32x32x16_bf16(b0, a1, acc[1][0], 0, 0, 0);
                acc[1][1] = __builtin_amdgcn_mfma_f32_32x32x16_bf16(b1, a1, acc[1][1], 0, 0, 0);
            }
            slot = slot == 2 ? 0 : slot + 1;
        }
        if (!has_next) { (void)cur.ep(acc, cur.brow + wm * 64, cur.bcol + wn * 64, lane); break; }
        if constexpr (!P::EP_CONST) pep = cur.ep;
        pbrow = cur.brow; pbcol = cur.bcol; pendE = true;
        cur = nxt;
#pragma unroll
        for (int a = 0; a < NA; ++a) aoff[a] = aoffn[a];
#pragma unroll
        for (int b = 0; b < NB; ++b) boff[b] = boffn[b];
    }
    asm volatile("s_waitcnt vmcnt(0)" ::: "memory");
    __syncthreads();
#undef GOFFS
#undef GSTAGE2
}

template <int DK, int DV> struct AttnCfg {
    static constexpr int NKB = DK / 32, NVB = DV / 32, ND0 = DK / 16;
    static constexpr int KBYTES = 64 * DK * 2, VBYTES = 64 * DV * 2;
    static constexpr int LDS = 2 * KBYTES + 2 * VBYTES + NWAVE * 64 * 4;
};
constexpr float ATT_THR = 8.f;

__device__ __forceinline__ void partialSM(f32x16& p0, f32x16& p1, float& m_reg, float& mn, float& alpha) {
    float pmax = p0[0];
#pragma unroll
    for (int r = 1; r < 16; ++r) pmax = fmaxf(pmax, p0[r]);
#pragma unroll
    for (int r = 0; r < 16; ++r) pmax = fmaxf(pmax, p1[r]);
    { auto rr = __builtin_amdgcn_permlane32_swap(__float_as_uint(pmax), __float_as_uint(pmax), false, false);
      pmax = fmaxf(__uint_as_float(rr[0]), __uint_as_float(rr[1])); }
    if (__builtin_expect(__all(pmax - m_reg <= ATT_THR), 1)) { mn = m_reg; alpha = 1.f; }
    else { mn = fmaxf(m_reg, pmax); alpha = __builtin_amdgcn_exp2f(m_reg - mn); m_reg = mn; }
#pragma unroll
    for (int r = 0; r < 16; ++r) p0[r] = p0[r] - mn;
#pragma unroll
    for (int r = 0; r < 16; ++r) p1[r] = p1[r] - mn;
#pragma unroll
    for (int r = 0; r < 16; ++r) p0[r] = __builtin_amdgcn_exp2f(p0[r]);
}
#define PK4(P, BASE, OUT) do { unsigned a0 = cvtpk(P[BASE + 0], P[BASE + 1]), a1 = cvtpk(P[BASE + 2], P[BASE + 3]);   \
    unsigned b0 = cvtpk(P[BASE + 4], P[BASE + 5]), b1 = cvtpk(P[BASE + 6], P[BASE + 7]);                              \
    auto r0 = __builtin_amdgcn_permlane32_swap(a0, b0, false, false); auto r1 = __builtin_amdgcn_permlane32_swap(a1, b1, false, false); \
    u32x4 w = {r0[0], r1[0], r0[1], r1[1]}; OUT = *reinterpret_cast<bf16x8*>(&w); } while (0)
__device__ __forceinline__ void finishSM(f32x16& p0, f32x16& p1, float alpha, float& l_reg, bf16x8& pa0, bf16x8& pa1, bf16x8& pa2, bf16x8& pa3) {
#pragma unroll
    for (int r = 0; r < 16; ++r) p1[r] = __builtin_amdgcn_exp2f(p1[r]);
    float ps = 0;
#pragma unroll
    for (int r = 0; r < 16; ++r) ps += p0[r];
#pragma unroll
    for (int r = 0; r < 16; ++r) ps += p1[r];
    { auto rr = __builtin_amdgcn_permlane32_swap(__float_as_uint(ps), __float_as_uint(ps), false, false);
      ps = __uint_as_float(rr[0]) + __uint_as_float(rr[1]); }
    l_reg = l_reg * alpha + ps;
    PK4(p0, 0, pa0); PK4(p0, 8, pa1); PK4(p1, 0, pa2); PK4(p1, 8, pa3);
}
template <bool FIRST, bool KEEPN>
__device__ __forceinline__ void psm_rel(f32x16& p0, f32x16& p1, float& m_reg, f32x16& negm, float& alpha) {
    float pmax = fmaxf(p0[0], p1[0]);
#pragma unroll
    for (int r = 1; r < 16; ++r) pmax = fmaxf(pmax, fmaxf(p0[r], p1[r]));
    { auto rr = __builtin_amdgcn_permlane32_swap(__float_as_uint(pmax), __float_as_uint(pmax), false, false);
      pmax = fmaxf(__uint_as_float(rr[0]), __uint_as_float(rr[1])); }
    alpha = 1.f;
    if (FIRST || !__builtin_expect(__all(pmax <= ATT_THR), 1)) {
        const float d = FIRST ? pmax : fmaxf(pmax, 0.f);
        if (!FIRST) alpha = __builtin_amdgcn_exp2f(-d);
        m_reg += d;
#pragma unroll
        for (int r = 0; r < 16; ++r) { p0[r] -= d; p1[r] -= d; if (KEEPN) negm[r] = -m_reg; }
    }
#pragma unroll
    for (int r = 0; r < 16; ++r) p0[r] = __builtin_amdgcn_exp2f(p0[r]);
}
__device__ __forceinline__ bf16x8 pack8(const f32x16& p, int base) {
    u32x4 w = {cvtpk(p[base], p[base + 1]), cvtpk(p[base + 2], p[base + 3]), cvtpk(p[base + 4], p[base + 5]), cvtpk(p[base + 6], p[base + 7])};
    return *reinterpret_cast<bf16x8*>(&w);
}
__device__ __forceinline__ void fsm_rel(f32x16& p0, f32x16& p1, bf16x8& pa0, bf16x8& pa1, bf16x8& pa2, bf16x8& pa3) {
#pragma unroll
    for (int r = 0; r < 16; ++r) p1[r] = __builtin_amdgcn_exp2f(p1[r]);
    pa0 = pack8(p0, 0); pa1 = pack8(p0, 8); pa2 = pack8(p1, 0); pa3 = pack8(p1, 8);
}
__device__ __forceinline__ int k_lds_off(int row, int blk, int chunk) { return blk * 4096 + row * 64 + ((chunk ^ ((row >> 2) & 3)) << 4); }
template <int ND0>
__device__ __forceinline__ void qkt(f32x16& p0, f32x16& p1, const char* Ks, const bf16x8* qr, int r32, int hi, const f32x16& cinit) {
    p0 = cinit; p1 = cinit;
#pragma unroll
    for (int d0 = 0; d0 < ND0; ++d0) {
        const int ch = (d0 & 1) * 2 + hi;
        bf16x8 b0 = *reinterpret_cast<const bf16x8*>(Ks + k_lds_off(r32, d0 >> 1, ch));
        bf16x8 b1 = *reinterpret_cast<const bf16x8*>(Ks + k_lds_off(32 + r32, d0 >> 1, ch));
        p0 = __builtin_amdgcn_mfma_f32_32x32x16_bf16(b0, qr[d0], p0, 0, 0, 0);
        p1 = __builtin_amdgcn_mfma_f32_32x32x16_bf16(b1, qr[d0], p1, 0, 0, 0);
    }
}
template <int NVB, bool SWAP = true> __device__ __forceinline__ int v_st(int k, int c) {
    const int kk = SWAP ? ((k & ~0xC) | ((k & 4) << 1) | ((k & 8) >> 1)) : k;
    return ((kk >> 3) * NVB + (c >> 5)) * 512 + ((kk & 7) * 32 + (c & 31)) * 2;
}
__device__ __forceinline__ int v_rd_base(int lane) { return ((lane & 3) << 3) | (((lane >> 2) & 3) << 6) | (((lane >> 4) & 1) << 5) | (((lane >> 5) & 1) << 8); }
template <int OFF> __device__ __forceinline__ s16x4 tr_read(int vb) {
    s16x4 r; asm volatile("ds_read_b64_tr_b16 %0, %1 offset:%2" : "=&v"(r) : "v"(vb), "i"(OFF) : "memory"); return r;
}
#define PKV(L, H) (bf16x8){L[0], L[1], L[2], L[3], H[0], H[1], H[2], H[3]}
template <int D0, int NVB> __device__ __forceinline__ void pv_one(f32x16& od, int vb, bf16x8 pa0, bf16x8 pa1, bf16x8 pa2, bf16x8 pa3) {
    constexpr int KS = 2 * NVB * 512, HF = NVB * 512, B0 = D0 * 512;
    const s16x4 l0 = tr_read<B0 + 0 * KS>(vb), h0 = tr_read<B0 + 0 * KS + HF>(vb), l1 = tr_read<B0 + 1 * KS>(vb), h1 = tr_read<B0 + 1 * KS + HF>(vb);
    const s16x4 l2 = tr_read<B0 + 2 * KS>(vb), h2 = tr_read<B0 + 2 * KS + HF>(vb), l3 = tr_read<B0 + 3 * KS>(vb), h3 = tr_read<B0 + 3 * KS + HF>(vb);
    asm volatile("s_waitcnt lgkmcnt(0)" ::: "memory"); SBAR();
    od = __builtin_amdgcn_mfma_f32_32x32x16_bf16(pa0, PKV(l0, h0), od, 0, 0, 0);
    od = __builtin_amdgcn_mfma_f32_32x32x16_bf16(pa1, PKV(l1, h1), od, 0, 0, 0);
    od = __builtin_amdgcn_mfma_f32_32x32x16_bf16(pa2, PKV(l2, h2), od, 0, 0, 0);
    od = __builtin_amdgcn_mfma_f32_32x32x16_bf16(pa3, PKV(l3, h3), od, 0, 0, 0);
}
template <int NVB> __device__ __forceinline__ void pv_all(f32x16* o, int vb, bf16x8 pa0, bf16x8 pa1, bf16x8 pa2, bf16x8 pa3) {
    pv_one<0, NVB>(o[0], vb, pa0, pa1, pa2, pa3); pv_one<1, NVB>(o[1], vb, pa0, pa1, pa2, pa3);
    if constexpr (NVB == 4) { pv_one<2, NVB>(o[2], vb, pa0, pa1, pa2, pa3); pv_one<3, NVB>(o[3], vb, pa0, pa1, pa2, pa3); }
}

template <int DK, int DV>
__device__ __forceinline__ void attn_item(const u16* __restrict__ Qb, const u16* __restrict__ Ka, const u16* __restrict__ Kb, const u16* __restrict__ Vh,
                                          int nkeys, u16* __restrict__ Ob, long ldo, char* lds) {
    using C = AttnCfg<DK, DV>;
    constexpr int NVB = C::NVB, ND0 = C::ND0, NKI = (DK / 32) * 4, NVI = DV / 8, NI = NKI + NVI;
    static_assert(NI <= 24, "three LDS-DMA pieces per wave per tile");
    const int tid = threadIdx.x, wid = __builtin_amdgcn_readfirstlane(tid >> 6), lane = tid & 63, r32 = lane & 31, hi = lane >> 5;
    char* K_lds = lds; char* V_lds = lds + 3 * C::KBYTES;
    float* al_l = (float*)(lds + 3 * C::KBYTES + 3 * C::VBYTES) + wid * 32;
    float m_reg = 0.f; f32x16 o[NVB], ol, negm; bf16x8 qr[ND0];
#pragma unroll
    for (int d = 0; d < NVB; ++d) o[d] = f32x16{};
    ol = f32x16{}; negm = f32x16{};
    const u32x4 ones_w = {0x3F803F80u, 0x3F803F80u, 0x3F803F80u, 0x3F803F80u}; const bf16x8 ones = *reinterpret_cast<const bf16x8*>(&ones_w);
    const u16* Qw = Qb + (long)(wid * 32 + r32) * DK + hi * 8;
#pragma unroll
    for (int d0 = 0; d0 < ND0; ++d0) qr[d0] = *reinterpret_cast<const bf16x8*>(Qw + d0 * 16);
    const u16* src[3]; int dst[3], stp[3]; bool isk[3];
#pragma unroll
    for (int i = 0; i < 3; ++i) { int q = wid + 8 * i; if (q >= NI) q -= 8;
        if (q < NKI) { const int blk = q >> 2, part = q & 3, row = 16 * part + (lane >> 2), c = (lane & 3) ^ ((row >> 2) & 3);
            isk[i] = true; dst[i] = blk * 4096 + part * 1024 + lane * 16;
            if (DK == 96 && blk == 2) { src[i] = Kb + row * 32 + c * 8; stp[i] = 64 * 32; } else { src[i] = Ka + row * 64 + blk * 32 + c * 8; stp[i] = 64 * 64; } }
        else { const int v = q - NKI; int key, col;
            if (NVB == 2) { key = 8 * v + ((lane & 31) >> 2); col = (lane >> 5) * 32 + (lane & 3) * 8; }
            else { key = 8 * (v >> 1) + ((lane & 31) >> 2); col = ((v & 1) * 2 + (lane >> 5)) * 32 + (lane & 3) * 8; }
            isk[i] = false; dst[i] = 3 * C::KBYTES + v * 1024 + lane * 16; src[i] = Vh + key * DV + col; stp[i] = 64 * DV; } }
    const int NT = nkeys / 64;
#define LOADG(kt, vt) do { const int _kt = (kt) < NT ? (kt) : NT - 1, _vt = (vt) < NT ? (vt) : NT - 1; const int _ks = _kt % 3, _vs = _vt % 3; \
        _Pragma("unroll") for (int _i = 0; _i < 3; ++_i) { const int _t = isk[_i] ? _kt : _vt; const int _so = isk[_i] ? _ks * C::KBYTES : _vs * C::VBYTES; \
            __builtin_amdgcn_global_load_lds((const unsigned*)(src[_i] + (long)_t * stp[_i]), (unsigned*)(lds + _so + dst[_i]), 16, 0, 0); } } while (0)
#define RESC(a) do { if (__any((a) < 1.f)) { if (hi == 0) al_l[r32] = (a); asm volatile("s_waitcnt lgkmcnt(0)" ::: "memory"); \
        _Pragma("unroll") for (int r = 0; r < 16; ++r) { const float _f = al_l[crow(r, hi)]; ol[r] *= _f; _Pragma("unroll") for (int d = 0; d < NVB; ++d) o[d][r] *= _f; } } } while (0)
#define PVL(vb) do { pv_all<NVB>(o, (vb), pa0, pa1, pa2, pa3); \
        ol = __builtin_amdgcn_mfma_f32_32x32x16_bf16(pa0, ones, ol, 0, 0, 0); ol = __builtin_amdgcn_mfma_f32_32x32x16_bf16(pa1, ones, ol, 0, 0, 0); \
        ol = __builtin_amdgcn_mfma_f32_32x32x16_bf16(pa2, ones, ol, 0, 0, 0); ol = __builtin_amdgcn_mfma_f32_32x32x16_bf16(pa3, ones, ol, 0, 0, 0); } while (0)
#define NEGM() do { if constexpr (DV == 128) { _Pragma("unroll") for (int r = 0; r < 16; ++r) negm[r] = -m_reg; } } while (0)
#define TILEBAR(n) do { if ((n) == 3) asm volatile("s_waitcnt vmcnt(3)" ::: "memory"); else asm volatile("s_waitcnt vmcnt(0)" ::: "memory"); __builtin_amdgcn_s_barrier(); asm volatile("" ::: "memory"); } while (0)
    const int vrb = (int)(uintptr_t)V_lds + v_rd_base(lane);
    f32x16 pA0, pA1, pB0, pB1; float alA, alB; bf16x8 pa0, pa1, pa2, pa3;
    __syncthreads();
    LOADG(0, 0); LOADG(1, 0);
    TILEBAR(3); LOADG(2, 1);
    qkt<ND0>(pA0, pA1, K_lds, qr, r32, hi, negm); psm_rel<true, DV != 128>(pA0, pA1, m_reg, negm, alA);
    int ks = 1, vs = 0;
    for (int j = 1; j + 1 < NT; j += 2) {
        TILEBAR(3); LOADG(j + 2, j + 1);
        SBAR(); NEGM(); qkt<ND0>(pB0, pB1, K_lds + ks * C::KBYTES, qr, r32, hi, negm);
        fsm_rel(pA0, pA1, pa0, pa1, pa2, pa3); SBAR();
        PVL(vrb + vs * C::VBYTES); psm_rel<false, DV != 128>(pB0, pB1, m_reg, negm, alB);
        RESC(alB);
        ks = ks == 2 ? 0 : ks + 1; vs = vs == 2 ? 0 : vs + 1;
        TILEBAR(3); LOADG(j + 3, j + 2);
        SBAR(); NEGM(); qkt<ND0>(pA0, pA1, K_lds + ks * C::KBYTES, qr, r32, hi, negm);
        fsm_rel(pB0, pB1, pa0, pa1, pa2, pa3); SBAR();
        PVL(vrb + vs * C::VBYTES); psm_rel<false, DV != 128>(pA0, pA1, m_reg, negm, alA);
        RESC(alA);
        ks = ks == 2 ? 0 : ks + 1; vs = vs == 2 ? 0 : vs + 1;
    }
    TILEBAR(3);
    SBAR(); NEGM(); qkt<ND0>(pB0, pB1, K_lds + ks * C::KBYTES, qr, r32, hi, negm);
    fsm_rel(pA0, pA1, pa0, pa1, pa2, pa3); SBAR();
    PVL(vrb + vs * C::VBYTES); psm_rel<false, DV != 128>(pB0, pB1, m_reg, negm, alB);
    RESC(alB);
    vs = vs == 2 ? 0 : vs + 1;
    TILEBAR(0);
    fsm_rel(pB0, pB1, pa0, pa1, pa2, pa3); SBAR();
    PVL(vrb + vs * C::VBYTES);
    u16* Ow = Ob + (long)(wid * 32) * ldo;
#pragma unroll
    for (int r = 0; r < 16; ++r) { const int orow = crow(r, hi); const float rl = __builtin_amdgcn_rcpf(ol[r]);
#pragma unroll
        for (int d0 = 0; d0 < NVB; ++d0) Ow[(long)orow * ldo + d0 * 32 + r32] = f2bf(o[d0][r] * rl); }
#undef LOADG
#undef RESC
#undef PVL
#undef NEGM
#undef TILEBAR
}

struct Frame {
    const Params* p; unsigned char* ws; char* lds; float* out; int G, bx;
    __device__ __forceinline__ const float* in(int i) const { return p->in[i]; }
    template <class T> __device__ __forceinline__ T* W(size_t off) const { return (T*)(ws + off); }
};
constexpr int LDS_BYTES = 163840;
constexpr int LDS_BARW  = LDS_BYTES - 16;
constexpr int LDS_TAB   = 147456;

struct ResCtx { const char* src0; long srcd; char* dst0; long dstd; const float* mods;
    __device__ __forceinline__ const float* row_in(int row, int) const { return (const float*)(src0 + (row >= NCTX ? srcd : 0L) + (long)row * (DM * 4)); }
    __device__ __forceinline__ float* row_out(int row) const { return (float*)(dst0 + (row >= NCTX ? dstd : 0L) + (long)row * (DM * 4)); }
    __device__ __forceinline__ const float* mod(int li, int row, int which) const {
        const int mr = row < NCTX ? 4 : ((row - NCTX) >> 13); return mods + (size_t)(li * 5 + mr) * 6144 + which * 1024; }
};
__device__ __forceinline__ ResCtx res_ctx(const Frame& F, bool first = false) {
    const char* sc = (const char*)(first ? F.in(2) : (const float*)F.W<float>(WS_XC)); const char* sl = (const char*)(first ? F.in(0) : (const float*)F.out) - (long)NCTX * DM * 4;
    char* dc = (char*)F.W<float>(WS_XC); char* dl = (char*)F.out - (long)NCTX * DM * 4;
    return ResCtx{sc, (long)(sl - sc), dc, (long)(dl - dc), F.W<float>(WS_MODS)};
}
__device__ __forceinline__ const float* xrow_in(const Frame& F, int row, bool first) { return res_ctx(F, first).row_in(row, 0); }
__device__ __forceinline__ float* xrow_out(const Frame& F, int row) { return res_ctx(F).row_out(row); }
__device__ __forceinline__ const float* mod_vec(const Frame& F, int li, int row, int which) { return res_ctx(F).mod(li, row, which); }

__device__ __forceinline__ void p0_mods(const Frame& F) {
    float* s = (float*)F.lds; float* red = s + 5 * 1024;
    const int tid = threadIdx.x, lane = tid & 63, wid = tid >> 6;
    for (int i = tid; i < 5 * 1024; i += NTHR) { const int r = i >> 10, k = i & 1023; const float v = r < 4 ? F.in(1)[r * 1024 + k] : F.in(3)[k]; s[i] = silu_f(v); }
    __syncthreads();
    for (int item = F.bx; item < DEPTH * 96; item += F.G) {
        const int li = item / 96, cg = item % 96;
        const float* w = F.in(4) + (size_t)li * 1024 * 6144 + cg * 64 + lane;
        float a0 = 0, a1 = 0, a2 = 0, a3 = 0, a4 = 0;
        const int k0 = wid * 128;
#pragma unroll 8
        for (int k = k0; k < k0 + 128; ++k) {
            const float wv = w[(size_t)k * 6144];
            a0 += s[k] * wv; a1 += s[1024 + k] * wv; a2 += s[2048 + k] * wv; a3 += s[3072 + k] * wv; a4 += s[4096 + k] * wv;
        }
        red[(wid * 5 + 0) * 64 + lane] = a0; red[(wid * 5 + 1) * 64 + lane] = a1; red[(wid * 5 + 2) * 64 + lane] = a2;
        red[(wid * 5 + 3) * 64 + lane] = a3; red[(wid * 5 + 4) * 64 + lane] = a4;
        __syncthreads();
        if (tid < 320) { const int r = tid >> 6, l = tid & 63; float sum = 0;
#pragma unroll
            for (int ww = 0; ww < 8; ++ww) sum += red[(ww * 5 + r) * 64 + l];
            F.W<float>(WS_MODS)[(size_t)(li * 5 + r) * 6144 + cg * 64 + l] = sum + F.in(5)[li * 6144 + cg * 64 + l]; }
        __syncthreads();
    }
}
__device__ __forceinline__ void p0_rope(const Frame& F) {
    const int gt = F.bx * NTHR + threadIdx.x, gn = F.G * NTHR;
    float* ca = F.W<float>(WS_ROPEA); float* sa = ca + SEQ * 16; float* cb = F.W<float>(WS_ROPEB); float* sb = cb + SEQ * 32;
    for (int i = gt; i < SEQ * 48; i += gn) {
        int n, f, nf; float* co; float* so; int idx;
        if (i < SEQ * 16) { n = i >> 4; f = i & 15; nf = 8; co = ca; so = sa; idx = i; }
        else { const int j = i - SEQ * 16; n = j >> 5; f = j & 31; nf = 16; co = cb; so = sb; idx = j; }
        const int fi = f % nf; const float pos = (f < nf) ? (float)(n >> 6) : (float)(n & 63);
        const float invf = exp2f(-(float)fi / (float)nf * 13.287712379549449f);
        const float ang = pos * invf;
        float rev = ang * 0.15915494309189535f; rev -= floorf(rev);
        co[idx] = __builtin_amdgcn_cosf(rev); so[idx] = __builtin_amdgcn_sinf(rev);
    }
}
__device__ __forceinline__ int rowmap(int n, int kind) { return kind == 0 ? n : ((n >> 5) * 64 + (kind == 2 ? 32 : 0) + (n & 31)); }
__device__ __forceinline__ void cvt_t(const Frame& F, const float* src, int K, int N, u16* dst, int ldd, int kind, int rot) {
    float* tl = (float*)F.lds; const int tid = threadIdx.x;
    const int tn = (N + 63) / 64, nt = (K / 64) * tn;
    for (int t0 = ((F.bx + rot) % F.G) * 4; t0 < nt; t0 += F.G * 4) {
        f32x4 v[4][2];
#pragma unroll
        for (int u = 0; u < 4; ++u) { const int t = t0 + u; const int k0 = (t / tn) * 64, n0 = (t % tn) * 64;
#pragma unroll
            for (int ps = 0; ps < 2; ++ps) { const int k = (tid >> 4) + ps * 32, n4 = (tid & 15) * 4;
                if (t < nt && n0 + n4 < N) v[u][ps] = *(const f32x4*)(src + (size_t)(k0 + k) * N + n0 + n4); else v[u][ps] = f32x4{0.f, 0.f, 0.f, 0.f}; } }
#pragma unroll
        for (int u = 0; u < 4; ++u)
#pragma unroll
            for (int ps = 0; ps < 2; ++ps) { const int k = (tid >> 4) + ps * 32, n4 = (tid & 15) * 4; float* d = tl + u * 4160 + k * 65 + n4;
                d[0] = v[u][ps][0]; d[1] = v[u][ps][1]; d[2] = v[u][ps][2]; d[3] = v[u][ps][3]; }
        __syncthreads();
#pragma unroll
        for (int u = 0; u < 4; ++u) { const int t = t0 + u; const int k0 = (t / tn) * 64, n0 = (t % tn) * 64;
            const int n = tid >> 3, kc = (tid & 7) * 8; const float* sr = tl + u * 4160;
            if (t < nt && n0 + n < N) { u32x4 w;
#pragma unroll
                for (int i = 0; i < 4; ++i) w[i] = cvtpk(sr[(kc + 2 * i) * 65 + n], sr[(kc + 2 * i + 1) * 65 + n]);
                *(u32x4*)(dst + (size_t)rowmap(n0 + n, kind) * ldd + k0 + kc) = w; } }
        __syncthreads();
    }
}
__device__ __forceinline__ void p0_weights(const Frame& F) {
    int rot = 0;
    for (int j = 0; j < 2; ++j) {
        cvt_t(F, F.in(8) + (size_t)j * 1024 * 544, 1024, 544, F.W<u16>(WS_WDQKV) + (size_t)j * 640 * 1024, 1024, 0, rot); rot += 36;
        cvt_t(F, F.in(10) + (size_t)j * 256 * 1536, 256, 1536, F.W<u16>(WS_WUQ) + (size_t)j * 1536 * 256, 256, 0, rot); rot += 24;
        cvt_t(F, F.in(12) + (size_t)j * 256 * 2048, 256, 2048, F.W<u16>(WS_WUKV) + (size_t)j * 2048 * 256, 256, 0, rot); rot += 32;
        cvt_t(F, F.in(13) + (size_t)j * 1024 * 1024, 1024, 1024, F.W<u16>(WS_WOM) + (size_t)j * 1024 * 1024, 1024, 0, rot);
    }
    cvt_t(F, F.in(14), 1024, 3072, F.W<u16>(WS_WQKVD), 1024, 0, rot);
    cvt_t(F, F.in(17), 1024, 1024, F.W<u16>(WS_WOD), 1024, 0, rot);
    cvt_t(F, F.in(18), 1024, 3104, F.W<u16>(WS_WING), 1024, 0, rot); rot += 4;
    cvt_t(F, F.in(22), 1024, 1024, F.W<u16>(WS_WOG), 1024, 0, rot);
}
__device__ __forceinline__ void moe_weights(const Frame& F, int li) {
    int rot = 0;
    for (int e = 0; e < 16; ++e) {
        cvt_t(F, F.in(27) + (size_t)(li * 16 + e) * 1024 * 512, 1024, 512, F.W<u16>(WS_MOEW) + (size_t)e * 1024 * 1024, 1024, 1, rot); rot += 32;
        cvt_t(F, F.in(28) + (size_t)(li * 16 + e) * 1024 * 512, 1024, 512, F.W<u16>(WS_MOEW) + (size_t)e * 1024 * 1024, 1024, 2, rot); rot += 32;
        cvt_t(F, F.in(29) + (size_t)(li * 16 + e) * 512 * 1024, 512, 1024, F.W<u16>(WS_MOEW + MOE_WGU_BYTES) + (size_t)e * 1024 * 512, 512, 0, rot); rot += 32;
    }
}

#define DPP_ADD(v, CTRL) (v) += __uint_as_float(__builtin_amdgcn_update_dpp(0u, __float_as_uint(v), (CTRL), 0xF, 0xF, false))
__device__ __forceinline__ float wave_sum_fast(float v) {
    DPP_ADD(v, 0xB1); DPP_ADD(v, 0x4E); DPP_ADD(v, 0x141); DPP_ADD(v, 0x140);
    { auto rr = __builtin_amdgcn_permlane16_swap(__float_as_uint(v), __float_as_uint(v), false, false); v = __uint_as_float(rr[0]) + __uint_as_float(rr[1]); }
    { auto rr = __builtin_amdgcn_permlane32_swap(__float_as_uint(v), __float_as_uint(v), false, false); v = __uint_as_float(rr[0]) + __uint_as_float(rr[1]); }
    return v;
}
constexpr int RT_WG = 0, RT_WR = 16384, RT_REC = 81920, RT_CNT = 81920 + 4096, RT_BASE = RT_CNT + 128;
template <bool ROUTE>
__device__ __forceinline__ void norm_phase(const Frame& F, int li, int row_begin, bool first) {
    const int tid = threadIdx.x, lane = tid & 63, wid = tid >> 6;
    const float* gain = F.in(ROUTE ? 7 : 6) + li * DM;
    u16* H = F.W<u16>(WS_H);
    const int per_block = (NTOK - row_begin + F.G - 1) / F.G;
    const int blk0 = row_begin + F.bx * per_block; int blk1 = blk0 + per_block; if (blk1 > NTOK) blk1 = NTOK;
    f32x4* wgL = (f32x4*)(F.lds + RT_WG); f32x4* wrL = (f32x4*)(F.lds + RT_WR); u32x4* recL = (u32x4*)(F.lds + RT_REC);
    unsigned* cntL = (unsigned*)(F.lds + RT_CNT); unsigned* baseL = (unsigned*)(F.lds + RT_BASE);
    if constexpr (ROUTE) {
        __syncthreads();
        const f32x4* wg = (const f32x4*)(F.in(23) + (size_t)li * DM * 4); const f32x4* wr = (const f32x4*)(F.in(25) + (size_t)li * 4 * DM * 4);
        for (int e = tid; e < 1024; e += NTHR) { const int d = ((e >> 8) * 4 + (e & 3)) * 64 + ((e >> 2) & 63); wgL[d] = wg[e]; }
        for (int e = tid; e < 4096; e += NTHR) { const int g = e >> 10, c = e & 1023; const int d = g * 1024 + ((c >> 8) * 4 + (c & 3)) * 64 + ((c >> 2) & 63); wrL[d] = wr[e]; }
        if (tid < 32) cntL[tid] = 0u;
        __syncthreads();
    }
    for (int it = 0; it * 32 < per_block; ++it) {
        int rows[4]; bool ok[4]; f32x4 v[4][4];
#pragma unroll
        for (int u = 0; u < 4; ++u) { rows[u] = blk0 + wid + 8 * (4 * it + u); ok[u] = rows[u] < blk1; if (!ok[u]) rows[u] = blk0; }
#pragma unroll
        for (int u = 0; u < 4; ++u) { const float* xr = xrow_in(F, rows[u], first);
#pragma unroll
            for (int i = 0; i < 4; ++i) v[u][i] = *(const f32x4*)(xr + i * 256 + lane * 4); }
#pragma unroll
        for (int u = 0; u < 4; ++u) {
            const int row = rows[u];
            float ss = 0;
#pragma unroll
            for (int i = 0; i < 4; ++i) ss += v[u][i][0] * v[u][i][0] + v[u][i][1] * v[u][i][1] + v[u][i][2] * v[u][i][2] + v[u][i][3] * v[u][i][3];
            ss = wave_sum_fast(ss);
            const float rinv = rsqrtf(ss * (1.f / DM) + EPS);
            const float* sh = mod_vec(F, li, row, ROUTE ? 3 : 0); const float* sc = mod_vec(F, li, row, ROUTE ? 4 : 1);
            float hv[16];
#pragma unroll
            for (int i = 0; i < 4; ++i) { const int c = i * 256 + lane * 4;
                const f32x4 g = *(const f32x4*)(gain + c), s1 = *(const f32x4*)(sc + c), s0 = *(const f32x4*)(sh + c);
#pragma unroll
                for (int j = 0; j < 4; ++j) hv[i * 4 + j] = (v[u][i][j] * rinv * g[j]) * (1.f + s1[j]) + s0[j];
                if (ok[u]) { u32x2 w = {cvtpk(hv[i * 4], hv[i * 4 + 1]), cvtpk(hv[i * 4 + 2], hv[i * 4 + 3])}; *(u32x2*)(H + (size_t)row * DM + c) = w; } }
            if constexpr (ROUTE) {
                float gl[4] = {0, 0, 0, 0};
#pragma unroll
                for (int q = 0; q < 16; ++q) { const f32x4 w4 = wgL[q * 64 + lane]; const float h = hv[q];
                    gl[0] += h * w4[0]; gl[1] += h * w4[1]; gl[2] += h * w4[2]; gl[3] += h * w4[3]; }
#pragma unroll
                for (int g = 0; g < 4; ++g) gl[g] = wave_sum_fast(gl[g]) + F.in(24)[li * 4 + g];
                int gi = 0; float gm = gl[0];
#pragma unroll
                for (int g = 1; g < 4; ++g) if (gl[g] > gm) { gm = gl[g]; gi = g; }
                gi = __builtin_amdgcn_readfirstlane(gi);
                float den = 0;
#pragma unroll
                for (int g = 0; g < 4; ++g) den += __expf(gl[g] - gm);
                const float grp_w = 1.f / den;
                float el[4] = {0, 0, 0, 0};
                const f32x4* wrg = wrL + gi * 1024;
#pragma unroll
                for (int q = 0; q < 16; ++q) { const f32x4 w4 = wrg[q * 64 + lane]; const float h = hv[q];
                    el[0] += h * w4[0]; el[1] += h * w4[1]; el[2] += h * w4[2]; el[3] += h * w4[3]; }
#pragma unroll
                for (int e = 0; e < 4; ++e) el[e] = wave_sum_fast(el[e]) + F.in(26)[(li * 4 + gi) * 4 + e];
                int i1 = 0; float v1 = el[0];
#pragma unroll
                for (int e = 1; e < 4; ++e) if (el[e] > v1) { v1 = el[e]; i1 = e; }
                int i2 = -1; float v2 = -3.0e38f;
#pragma unroll
                for (int e = 0; e < 4; ++e) if (e != i1 && el[e] > v2) { v2 = el[e]; i2 = e; }
                const float t = __expf(v2 - v1); const float w1 = grp_w / (1.f + t), w2 = grp_w * t / (1.f + t);
                const int elo = i1 < i2 ? i1 : i2, ehi = i1 < i2 ? i2 : i1;
                const float wlo = i1 < i2 ? w1 : w2, whi = i1 < i2 ? w2 : w1;
                const int pr = elo == 0 ? ehi - 1 : (elo == 1 ? ehi + 1 : 5);
                const int cls = gi * 6 + pr;
                if (lane == 0 && ok[u]) {
                    const unsigned rank = atomicAdd(&cntL[cls], 1u);
                    u32x4 rec = {(unsigned)cls, rank, __float_as_uint(wlo), __float_as_uint(whi)};
                    recL[row - blk0] = rec;
                }
            }
        }
    }
    if constexpr (ROUTE) {
        __syncthreads();
        if (tid < 24) baseL[tid] = atomicAdd(F.W<unsigned>(WS_CTL) + CW_CNT + li * 32 + tid, cntL[tid]);
        __syncthreads();
        for (int t = tid; t < blk1 - blk0; t += NTHR) { u32x4 rec = recL[t]; rec[1] += baseL[rec[0]];
            *(u32x4*)(F.W<unsigned char>(WS_TOK) + (size_t)(blk0 + t) * 16) = rec; }
    }
}

__device__ __forceinline__ void moe_table(const Frame& F, int li, int* tab) {
    if (threadIdx.x == 0) {
        const unsigned* cnt = F.W<unsigned>(WS_CTL) + CW_CNT + li * 32; int off = 0;
        for (int c = 0; c < 24; ++c) { tab[c] = off; const int n = (int)cnt[c]; const int nt = (n + 255) >> 8;
            for (int t = 0; t < nt; ++t) tab[32 + (off >> 8) + t] = c; off += nt << 8; }
        tab[24] = off;
    }
    __syncthreads();
}
__device__ __forceinline__ void moe_scatter(const Frame& F, int li, int row_begin) {
    int* tab = (int*)(F.lds + LDS_TAB);
    moe_table(F, li, tab);
    const unsigned* cnt = F.W<unsigned>(WS_CTL) + CW_CNT + li * 32;
    int* rowtok = F.W<int>(WS_ROWTOK); float* roww = F.W<float>(WS_ROWW);
    const int gt = F.bx * NTHR + threadIdx.x, gn = F.G * NTHR;
    for (int t = row_begin + gt; t < NTOK; t += gn) {
        const u32x4 rec = *(const u32x4*)(F.W<unsigned char>(WS_TOK) + (size_t)t * 16);
        const int r = tab[rec[0]] + (int)rec[1];
        rowtok[r] = t; roww[2 * r] = __uint_as_float(rec[2]); roww[2 * r + 1] = __uint_as_float(rec[3]);
    }
    for (int i = gt; i < 24 * 256; i += gn) { const int c = i >> 8, j = i & 255; const int r = tab[c] + (int)cnt[c] + j;
        const int end = tab[c] + ((((int)cnt[c]) + 255) & ~255);
        if (r < end) { rowtok[r] = -1; roww[2 * r] = 0.f; roww[2 * r + 1] = 0.f; } }
    __syncthreads();
}

#define EPI_ID const int r32 = lane & 31, hi = lane >> 5
__device__ __forceinline__ u32x2 pack4(float a, float b, float c, float d) { u32x2 w = {cvtpk(a, b), cvtpk(c, d)}; return w; }
template <int NF> __device__ __forceinline__ void rope_cs(int n, int i, float& cs, float& sn) {
    const int fi = i & (NF - 1); const float pos = (i < NF) ? (float)(n >> 6) : (float)(n & 63);
    const float invf = __builtin_amdgcn_exp2f(-(float)fi / (float)NF * 13.287712379549449f);
    const float ang = pos * invf; float rev = ang * 0.15915494309189535f; rev -= floorf(rev);
    cs = __builtin_amdgcn_cosf(rev); sn = __builtin_amdgcn_sinf(rev);
}
struct EpiF32 { float* dst; int ld, ncols;
    __device__ __forceinline__ int operator()(f32x16 (&acc)[2][2], int row0, int col0, int lane) const { EPI_ID;
#pragma unroll
        for (int mi = 0; mi < 2; ++mi) { float* o = dst + (size_t)(row0 + mi * 32 + r32) * ld + col0 + 4 * hi;
#pragma unroll
            for (int ni = 0; ni < 2; ++ni) if (col0 + ni * 32 < ncols) {
#pragma unroll
                for (int g = 0; g < 4; ++g) { f32x4 v = {acc[mi][ni][4 * g], acc[mi][ni][4 * g + 1], acc[mi][ni][4 * g + 2], acc[mi][ni][4 * g + 3]}; *(f32x4*)(o + ni * 32 + 8 * g) = v; } } }
        return 0;
    } };
struct EpiMlaQ { u16* Q; const float* cosA; const float* sinA; float scale;
    __device__ __forceinline__ int operator()(f32x16 (&acc)[2][2], int row0, int col0, int lane) const { EPI_ID; const bool lat = row0 >= NCTX;
#pragma unroll
        for (int mi = 0; mi < 2; ++mi) { const int row = row0 + mi * 32 + r32; int b, pos; row_bp(row, b, pos); const int n = (row - NCTX) & (SEQ - 1);
            u16* qrow = Q + ((size_t)(b * 16) * KEYS + pos) * 96 + 4 * hi;
#pragma unroll
            for (int ni = 0; ni < 2; ++ni) { const int s = (col0 >> 5) + ni, head = s / 3, part = s - head * 3; u16* o = qrow + (size_t)head * KEYS * 96 + part * 32;
                float v[16];
#pragma unroll
                for (int r = 0; r < 16; ++r) v[r] = acc[mi][ni][r] * scale;
                if (part == 2 && lat) {
#pragma unroll
                    for (int g = 0; g < 2; ++g) {
#pragma unroll
                        for (int j = 0; j < 4; ++j) { float cs, sn; rope_cs<8>(n, 8 * g + 4 * hi + j, cs, sn);
                            const float t1 = v[4 * g + j], t2 = v[4 * (g + 2) + j]; v[4 * g + j] = t1 * cs - t2 * sn; v[4 * (g + 2) + j] = t1 * sn + t2 * cs; } } }
#pragma unroll
                for (int g = 0; g < 4; ++g) *(u32x2*)(o + 8 * g) = pack4(v[4 * g], v[4 * g + 1], v[4 * g + 2], v[4 * g + 3]); } }
        return 16;
    } };
struct EpiMlaKV { u16* Kn; long vdelta;
    __device__ __forceinline__ int operator()(f32x16 (&acc)[2][2], int row0, int col0, int lane) const { EPI_ID; const int head = col0 >> 7; u16* dst = Kn + (long)((col0 >> 6) & 1) * vdelta;
#pragma unroll
        for (int mi = 0; mi < 2; ++mi) { const int row = row0 + mi * 32 + r32; int b, pos; row_bp(row, b, pos);
            u16* o = dst + ((size_t)(b * 16 + head) * KEYS + pos) * 64 + 4 * hi;
#pragma unroll
            for (int ni = 0; ni < 2; ++ni)
#pragma unroll
                for (int g = 0; g < 4; ++g) *(u32x2*)(o + ni * 32 + 8 * g) = pack4(acc[mi][ni][4 * g], acc[mi][ni][4 * g + 1], acc[mi][ni][4 * g + 2], acc[mi][ni][4 * g + 3]); }
        return 16;
    } };
struct EpiResid { ResCtx F; int li, which, first;
    __device__ __forceinline__ int operator()(f32x16 (&acc)[2][2], int row0, int col0, int lane) const { EPI_ID;
#pragma unroll
        for (int mi = 0; mi < 2; ++mi) { const int row = row0 + mi * 32 + r32;
            const float* xi = F.row_in(row, first) + col0 + 4 * hi; float* xo = F.row_out(row) + col0 + 4 * hi; const float* gt = F.mod(li, row, which) + col0 + 4 * hi;
#pragma unroll
            for (int ni = 0; ni < 2; ++ni)
#pragma unroll
                for (int g = 0; g < 4; ++g) { const int c = ni * 32 + 8 * g; const f32x4 x = *(const f32x4*)(xi + c), gg = *(const f32x4*)(gt + c);
                    f32x4 o = {x[0] + gg[0] * acc[mi][ni][4 * g], x[1] + gg[1] * acc[mi][ni][4 * g + 1], x[2] + gg[2] * acc[mi][ni][4 * g + 2], x[3] + gg[3] * acc[mi][ni][4 * g + 3]};
                    *(f32x4*)(xo + c) = o; } }
        return 48;
    } };
struct EpiMoeB { ResCtx F; int li; const int* rowtok;
    __device__ __forceinline__ int operator()(f32x16 (&acc)[2][2], int row0, int col0, int lane) const { EPI_ID;
#pragma unroll
        for (int mi = 0; mi < 2; ++mi) { const int tok = rowtok[row0 + mi * 32 + r32];
            if (tok >= 0) { float* xo = F.row_out(tok) + col0 + 4 * hi; const float* gt = F.mod(li, tok, 5) + col0 + 4 * hi;
#pragma unroll
                for (int ni = 0; ni < 2; ++ni)
#pragma unroll
                    for (int g = 0; g < 4; ++g) { const int c = ni * 32 + 8 * g; const f32x4 x = *(const f32x4*)(xo + c), gg = *(const f32x4*)(gt + c);
                        f32x4 o = {x[0] + gg[0] * acc[mi][ni][4 * g], x[1] + gg[1] * acc[mi][ni][4 * g + 1], x[2] + gg[2] * acc[mi][ni][4 * g + 2], x[3] + gg[3] * acc[mi][ni][4 * g + 3]};
                        *(f32x4*)(xo + c) = o; } } }
        return 0;
    } };
struct EpiMoeA { u16* act; const float* roww; int half, acol0;
    __device__ __forceinline__ int operator()(f32x16 (&acc)[2][2], int row0, int col0, int lane) const { EPI_ID;
#pragma unroll
        for (int mi = 0; mi < 2; ++mi) { const int row = row0 + mi * 32 + r32; const float w = roww[2 * row + half];
            u16* o = act + (size_t)row * 1024 + acol0 + (col0 >> 6) * 32 + 4 * hi;
#pragma unroll
            for (int g = 0; g < 4; ++g) { float v[4];
#pragma unroll
                for (int j = 0; j < 4; ++j) v[j] = silu_f(acc[mi][0][4 * g + j]) * acc[mi][1][4 * g + j] * w;
                *(u32x2*)(o + 8 * g) = pack4(v[0], v[1], v[2], v[3]); } }
        return 8;
    } };
struct EpiDiffQKV { u16* Q; long kdelta; u16* V; const float* cosB; const float* sinB; float qscale;
    __device__ __forceinline__ int operator()(f32x16 (&acc)[2][2], int row0, int col0, int lane) const { EPI_ID; const int region = col0 >> 10; const bool lat = row0 >= NCTX;
#pragma unroll
        for (int mi = 0; mi < 2; ++mi) { const int row = row0 + mi * 32 + r32; int b, pos; row_bp(row, b, pos); const int n = (row - NCTX) & (SEQ - 1);
            if (region < 2) {
                const int hh = (col0 & 1023) >> 6; const float sc = region == 0 ? qscale : 1.f;
                u16* o = Q + (long)region * kdelta + ((size_t)(b * 16 + hh) * KEYS + pos) * 64 + 4 * hi;
#pragma unroll
                for (int g = 0; g < 4; ++g) {
                    float o1[4], o2[4];
#pragma unroll
                    for (int j = 0; j < 4; ++j) { float cs = 1.f, sn = 0.f; if (lat) rope_cs<16>(n, 8 * g + 4 * hi + j, cs, sn);
                        const float t1 = acc[mi][0][4 * g + j], t2 = acc[mi][1][4 * g + j]; o1[j] = (t1 * cs - t2 * sn) * sc; o2[j] = (t1 * sn + t2 * cs) * sc; }
                    *(u32x2*)(o + 8 * g) = pack4(o1[0], o1[1], o1[2], o1[3]); *(u32x2*)(o + 32 + 8 * g) = pack4(o2[0], o2[1], o2[2], o2[3]); }
            } else {
                const int cv = col0 - 2048, head = cv >> 7;
                u16* o = V + ((size_t)(b * 8 + head) * KEYS + pos) * 128 + (cv & 127) + 4 * hi;
#pragma unroll
                for (int ni = 0; ni < 2; ++ni)
#pragma unroll
                    for (int g = 0; g < 4; ++g) *(u32x2*)(o + ni * 32 + 8 * g) = pack4(acc[mi][ni][4 * g], acc[mi][ni][4 * g + 1], acc[mi][ni][4 * g + 2], acc[mi][ni][4 * g + 3]);
            } }
        return 16;
    } };
struct EpiGlaIn { u16* q; u16* k; u16* v; u16* g; float* z;
    __device__ __forceinline__ int operator()(f32x16 (&acc)[2][2], int row0, int col0, int lane) const { EPI_ID;
#pragma unroll
        for (int mi = 0; mi < 2; ++mi) { const size_t row = row0 + mi * 32 + r32;
            if (col0 < 3072) {
                u16* o; float sc = 1.f;
                if (col0 < 512) { o = q + row * 512 + col0; sc = 0.08838834764831845f; } else if (col0 < 1024) o = k + row * 512 + (col0 - 512);
                else if (col0 < 2048) o = v + row * 1024 + (col0 - 1024); else o = g + row * 1024 + (col0 - 2048);
                o += 4 * hi;
#pragma unroll
                for (int ni = 0; ni < 2; ++ni)
#pragma unroll
                    for (int gg = 0; gg < 4; ++gg) *(u32x2*)(o + ni * 32 + 8 * gg) = pack4(acc[mi][ni][4 * gg] * sc, acc[mi][ni][4 * gg + 1] * sc, acc[mi][ni][4 * gg + 2] * sc, acc[mi][ni][4 * gg + 3] * sc);
            } else if (col0 == 3072) {
                float* o = z + row * 32 + 4 * hi;
#pragma unroll
                for (int gg = 0; gg < 4; ++gg) { f32x4 t = {acc[mi][0][4 * gg], acc[mi][0][4 * gg + 1], acc[mi][0][4 * gg + 2], acc[mi][0][4 * gg + 3]}; *(f32x4*)(o + 8 * gg) = t; }
            } }
        return col0 < 3072 ? 16 : (col0 == 3072 ? 8 : 0);
    } };

template <int WM, int WN, class AL, class BL, class EP>
__device__ __forceinline__ void gemm_phase(const Frame& F, const AL al, const BL bl, EP& ep, int mt0, int mt1, int nN, int nk, int tile_off, int tile_total) {
    PlainTiles<AL, BL, EP> prov{al, bl, ep, mt0, mt1 - mt0, nN, F.bx, F.G}; (void)tile_off;
    gemm_stream<WM, WN>(F.lds, prov, nk);
    (void)tile_total;
}

__device__ __forceinline__ void mla_rowpass(const Frame& F, int j) {
    const int lane = threadIdx.x & 63, wid = threadIdx.x >> 6;
    const float* DQ = F.W<float>(MLA_DQ); u16* CN = F.W<u16>(MLA_CN); u16* KPE = F.W<u16>(MLA_KPE);
    const float* gq = F.in(9) + j * 256; const float* gk = F.in(11) + j * 256;
    const float* ca = F.W<float>(WS_ROPEA); const float* sa = ca + SEQ * 16;
    for (int row = F.bx * NWAVE + wid; row < NTOK; row += F.G * NWAVE) {
        const float* d = DQ + (size_t)row * 544;
        const f32x4 a = *(const f32x4*)(d + lane * 4), c = *(const f32x4*)(d + 256 + lane * 4);
        float sq = a[0] * a[0] + a[1] * a[1] + a[2] * a[2] + a[3] * a[3], sk = c[0] * c[0] + c[1] * c[1] + c[2] * c[2] + c[3] * c[3];
        sq = wave_sum(sq); sk = wave_sum(sk);
        const float rq = rsqrtf(sq * (1.f / 256.f) + EPS), rk = rsqrtf(sk * (1.f / 256.f) + EPS);
        const f32x4 g1 = *(const f32x4*)(gq + lane * 4), g2 = *(const f32x4*)(gk + lane * 4);
        u32x2 w1 = {cvtpk(a[0] * rq * g1[0], a[1] * rq * g1[1]), cvtpk(a[2] * rq * g1[2], a[3] * rq * g1[3])};
        u32x2 w2 = {cvtpk(c[0] * rk * g2[0], c[1] * rk * g2[1]), cvtpk(c[2] * rk * g2[2], c[3] * rk * g2[3])};
        *(u32x2*)(CN + (size_t)row * 512 + lane * 4) = w1; *(u32x2*)(CN + (size_t)row * 512 + 256 + lane * 4) = w2;
        if (lane < 16) { float t1 = d[512 + lane], t2 = d[528 + lane]; int b, pos; row_bp(row, b, pos);
            if (row >= NCTX) { const int n = (row - NCTX) & (SEQ - 1); const float cs = ca[n * 16 + lane], sn = sa[n * 16 + lane];
                const float o1 = t1 * cs - t2 * sn, o2 = t1 * sn + t2 * cs; t1 = o1; t2 = o2; }
            u16* o = KPE + ((size_t)b * KEYS + pos) * 32 + lane; o[0] = f2bf(t1); o[16] = f2bf(t2); }
    }
}
__device__ __forceinline__ int vcu_of(const Frame& F) { return (F.G % 8 == 0) ? (F.bx % 8) * (F.G / 8) + F.bx / 8 : F.bx; }
__device__ __forceinline__ void mla_attn(const Frame& F, bool ctx_out) {
    const u16* Q = F.W<u16>(MLA_Q); const u16* Kn = F.W<u16>(MLA_KN); const u16* V = F.W<u16>(MLA_V); const u16* Kpe = F.W<u16>(MLA_KPE);
    u16* O = F.W<u16>(MLA_DQ);
    const int nit = 2048 + (ctx_out ? 64 : 0);
    for (int it = vcu_of(F); it < nit; it += F.G) {
        int b, h, qpos, nkeys, orow;
        if (it < 2048) { const int bh = it >> 5, qt = it & 31; b = bh >> 4; h = bh & 15; qpos = CTXL + qt * 256; nkeys = KEYS; orow = NCTX + b * SEQ + qt * 256; }
        else { const int jj = it - 2048; b = jj >> 4; h = jj & 15; qpos = 0; nkeys = CTXL; orow = b * CTXL; }
        const size_t bh = (size_t)(b * 16 + h);
        attn_item<96, 64>(Q + (bh * KEYS + qpos) * 96, Kn + bh * KEYS * 64, Kpe + (size_t)b * KEYS * 32, V + bh * KEYS * 64, nkeys,
                          O + (size_t)orow * DM + h * 64, DM, F.lds);
    }
}
__device__ __forceinline__ void diff_attn(const Frame& F) {
    const u16* Q = F.W<u16>(DF_Q); const u16* K = F.W<u16>(DF_K); const u16* V = F.W<u16>(DF_V); u16* OS = F.W<u16>(DF_OS);
    const int nit = 2048 + 64;
    for (int it = vcu_of(F); it < nit; it += F.G) {
        int b, hh, qpos, nkeys, orow;
        if (it < 2048) { const int bh = it >> 5, qt = it & 31; b = bh >> 4; hh = bh & 15; qpos = CTXL + qt * 256; nkeys = KEYS; orow = NCTX + b * SEQ + qt * 256; }
        else { const int jj = it - 2048; b = jj >> 4; hh = jj & 15; qpos = 0; nkeys = CTXL; orow = b * CTXL; }
        const size_t bh = (size_t)(b * 16 + hh);
        attn_item<64, 128>(Q + (bh * KEYS + qpos) * 64, K + bh * KEYS * 64, nullptr, V + (size_t)(b * 8 + (hh >> 1)) * KEYS * 128, nkeys,
                           OS + (size_t)(hh & 1) * NTOK * DM + (size_t)orow * DM + (hh >> 1) * 128, DM, F.lds);
    }
}
__device__ __forceinline__ void diff_rowpass(const Frame& F, float lam_init) {
    const int lane = threadIdx.x & 63, wid = threadIdx.x >> 6;
    const u16* OS = F.W<u16>(DF_OS); u16* O = F.W<u16>(DF_Q);
    const float* lm = F.in(15);
    const float lam = __expf(wave_sum(lm[lane] * lm[64 + lane])) - __expf(wave_sum(lm[128 + lane] * lm[192 + lane])) + lam_init;
    const float post = 1.f - lam_init;
    float sg[16];
#pragma unroll
    for (int i = 0; i < 16; ++i) sg[i] = F.in(16)[(lane & 7) * 16 + i] * post;
    for (int row = F.bx * NWAVE + wid; row < NTOK; row += F.G * NWAVE) {
        const u16* p0 = OS + (size_t)row * DM + lane * 16; const u16* p1 = p0 + (size_t)NTOK * DM;
        const bf16x8 a0 = *(const bf16x8*)p0, a1 = *(const bf16x8*)(p0 + 8), b0 = *(const bf16x8*)p1, b1 = *(const bf16x8*)(p1 + 8);
        float o[16]; float ss = 0;
#pragma unroll
        for (int i = 0; i < 8; ++i) { o[i] = bf2f((u16)a0[i]) - lam * bf2f((u16)b0[i]); o[8 + i] = bf2f((u16)a1[i]) - lam * bf2f((u16)b1[i]); }
#pragma unroll
        for (int i = 0; i < 16; ++i) ss += o[i] * o[i];
        ss += __shfl_xor(ss, 1); ss += __shfl_xor(ss, 2); ss += __shfl_xor(ss, 4);
        const float rinv = rsqrtf(ss * (1.f / 128.f) + EPS);
        u32x4 w0, w1;
#pragma unroll
        for (int i = 0; i < 4; ++i) { w0[i] = cvtpk(o[2 * i] * rinv * sg[2 * i], o[2 * i + 1] * rinv * sg[2 * i + 1]);
            w1[i] = cvtpk(o[8 + 2 * i] * rinv * sg[8 + 2 * i], o[9 + 2 * i] * rinv * sg[9 + 2 * i]); }
        *(u32x4*)(O + (size_t)row * DM + lane * 16) = w0; *(u32x4*)(O + (size_t)row * DM + lane * 16 + 8) = w1;
    }
}

__device__ __forceinline__ float logsig16(float x) { return (fminf(x, 0.f) - __logf(1.f + __expf(-fabsf(x)))) * 0.0625f; }
constexpr int NCH = KEYS / 64;

__device__ __forceinline__ void gla_g1(const Frame& F) {
    char* KT = F.lds; char* VV = F.lds + 16384; float* ZT = (float*)(F.lds + 49152); float* SEG = (float*)(F.lds + 53248);
    const u16* Kg = F.W<u16>(GL_K); const u16* Vg = F.W<u16>(GL_V); const float* Zg = F.W<float>(GL_Z);
    u16* ST = F.W<u16>(GL_STATE); float* DEC = F.W<float>(GL_DEC);
#pragma unroll 1
    for (int it = F.bx; it < NBATCH * 4 * 2 * NCH; it += F.G) {
        int tid = threadIdx.x; asm volatile("" : "+v"(tid));
        const int lane = tid & 63, wid = tid >> 6, r32 = lane & 31, hi = lane >> 5, kk = tid & 127, jq = tid >> 7;
        const int c = it % NCH, dir = (it / NCH) & 1, bh = it / (2 * NCH), b = bh >> 2, h = bh & 3;
        const int s0 = 64 * c;
        int tbase, tstep;
        if (dir == 0) { tbase = (c < 4) ? b * CTXL + s0 : NCTX + b * SEQ + s0 - CTXL; tstep = 1; }
        else { tbase = (c < 4) ? b * CTXL + (CTXL - 1) - s0 : NCTX + b * SEQ + (SEQ - 1) - (s0 - CTXL); tstep = -1; }
        __syncthreads();
        for (int i = tid; i < 1024; i += NTHR) { const int j = i >> 4, r = i & 15; ZT[i] = Zg[(size_t)(tbase + tstep * j) * 32 + dir * 16 + r]; }
#pragma unroll
        for (int q = 0; q < 4; ++q) { const int id = tid + q * NTHR, key = id >> 5, cc = (id & 31) * 8;
            *(bf16x8*)(VV + v_st<8>(key, cc)) = *(const bf16x8*)(Vg + (size_t)(tbase + tstep * key) * 1024 + h * 256 + cc); }
        float wg[16];
#pragma unroll
        for (int r = 0; r < 16; ++r) wg[r] = F.in(19)[(dir * 16 + r) * 512 + h * 128 + kk];
        const float bias = F.in(20)[dir * 512 + h * 128 + kk];
        __syncthreads();
        float cv[16]; float run = 0;
#pragma unroll
        for (int jj = 0; jj < 16; ++jj) { const int j = jq * 16 + jj; float x = bias;
#pragma unroll
            for (int r = 0; r < 16; ++r) x += ZT[j * 16 + r] * wg[r];
            run += logsig16(x); cv[jj] = run; }
        SEG[jq * 128 + kk] = run;
        __syncthreads();
        float offset = 0, total = 0;
#pragma unroll
        for (int q = 0; q < 4; ++q) { const float sv = SEG[q * 128 + kk]; total += sv; if (q < jq) offset += sv; }
        u32x4 w0, w1;
#pragma unroll
        for (int i = 0; i < 8; ++i) {
            const int j0 = jq * 16 + 2 * i;
            const float k0 = bf2f(Kg[(size_t)(tbase + tstep * j0) * 512 + h * 128 + kk]) * __expf(total - (offset + cv[2 * i]));
            const float k1 = bf2f(Kg[(size_t)(tbase + tstep * (j0 + 1)) * 512 + h * 128 + kk]) * __expf(total - (offset + cv[2 * i + 1]));
            const unsigned pk = cvtpk(k0, k1); if (i < 4) w0[i] = pk; else w1[i - 4] = pk; }
        *(u32x4*)(KT + kk * 128 + (((jq * 2) ^ ((kk >> 1) & 7)) << 4)) = w0;
        *(u32x4*)(KT + kk * 128 + (((jq * 2 + 1) ^ ((kk >> 1) & 7)) << 4)) = w1;
        if (jq == 0) DEC[(size_t)it * 128 + kk] = __expf(total);
        __syncthreads();
        const int mt = wid & 3, vb = (wid >> 2) * 4;
        const int row = mt * 32 + r32, ab = row * 128 + ((hi ^ ((row >> 1) & 7)) << 4);
        const bf16x8 pa0 = *(const bf16x8*)(KT + (ab ^ 0)), pa1 = *(const bf16x8*)(KT + (ab ^ 32)), pa2 = *(const bf16x8*)(KT + (ab ^ 64)), pa3 = *(const bf16x8*)(KT + (ab ^ 96));
        f32x16 acc[4];
#pragma unroll
        for (int n = 0; n < 4; ++n) acc[n] = f32x16{};
        const int vbase = (int)(uintptr_t)VV + v_rd_base(lane) + vb * 512;
        pv_one<0, 8>(acc[0], vbase, pa0, pa1, pa2, pa3); pv_one<1, 8>(acc[1], vbase, pa0, pa1, pa2, pa3);
        pv_one<2, 8>(acc[2], vbase, pa0, pa1, pa2, pa3); pv_one<3, 8>(acc[3], vbase, pa0, pa1, pa2, pa3);
        u16* S = ST + (size_t)it * 128 * 256;
#pragma unroll
        for (int n = 0; n < 4; ++n)
#pragma unroll
            for (int r = 0; r < 16; ++r) S[(mt * 32 + crow(r, hi)) * 256 + (vb + n) * 32 + r32] = f2bf(acc[n][r]);
    }
}
__device__ __forceinline__ void gla_g2(const Frame& F) {
    u16* ST = F.W<u16>(GL_STATE); const float* DEC = F.W<float>(GL_DEC);
    for (int g = F.bx * NTHR + threadIdx.x; g < 32 * 4096; g += F.G * NTHR) {
        const int chain = g >> 12, e = g & 4095, kk = e >> 5, v8 = (e & 31) * 8;
        u16* p = ST + ((size_t)chain * NCH * 128 + kk) * 256 + v8; const float* d = DEC + (size_t)chain * NCH * 128 + kk;
        float f[8];
#pragma unroll
        for (int i = 0; i < 8; ++i) f[i] = 0.f;
        for (int c = 0; c < NCH; c += 4) {
            bf16x8 kv[4]; float dc[4];
#pragma unroll
            for (int u = 0; u < 4; ++u) { kv[u] = *(const bf16x8*)(p + (size_t)(c + u) * 128 * 256); dc[u] = d[(size_t)(c + u) * 128]; }
#pragma unroll
            for (int u = 0; u < 4; ++u) {
                u32x4 w = {cvtpk(f[0], f[1]), cvtpk(f[2], f[3]), cvtpk(f[4], f[5]), cvtpk(f[6], f[7])};
                *(u32x4*)(p + (size_t)(c + u) * 128 * 256) = w;
#pragma unroll
                for (int i = 0; i < 8; ++i) f[i] = dc[u] * f[i] + bf2f((u16)kv[u][i]);
            }
        }
    }
}
__device__ __forceinline__ void gla_g3(const Frame& F) {
    char* QD = F.lds; char* KI = F.lds + 16384; char* VV = F.lds + 32768; char* SS = F.lds + 65536; float* OL = (float*)(F.lds + 65536);
    float* ZT = (float*)(F.lds + 132096); float* SEG = (float*)(F.lds + 136192);
    const u16* Qg = F.W<u16>(GL_Q); const u16* Kg = F.W<u16>(GL_K); const u16* Vg = F.W<u16>(GL_V); const u16* Gg = F.W<u16>(GL_G); const float* Zg = F.W<float>(GL_Z);
    const u16* ST = F.W<u16>(GL_STATE); u16* OUT = F.W<u16>(WS_H);
#pragma unroll 1
    for (int it = F.bx; it < NBATCH * 4 * NCH; it += F.G) {
        int tid = threadIdx.x; asm volatile("" : "+v"(tid));
        const int lane = tid & 63, wid = tid >> 6, r32 = lane & 31, hi = lane >> 5, kk = tid & 127, jq = tid >> 7;
        const int T = it % NCH, bh = it / NCH, b = bh >> 2, h = bh & 3;
        const int t0 = (T < 4) ? b * CTXL + 64 * T : NCTX + b * SEQ + 64 * (T - 4);
        __syncthreads();
#pragma unroll
        for (int q = 0; q < 4; ++q) { const int id = tid + q * NTHR, key = id >> 5, cc = (id & 31) * 8;
            *(bf16x8*)(VV + v_st<8>(key, cc)) = *(const bf16x8*)(Vg + (size_t)(t0 + key) * 1024 + h * 256 + cc); }
        const int itile = wid & 1, vb = (wid >> 1) * 2;
        f32x16 acc[2]; acc[0] = f32x16{}; acc[1] = f32x16{};
#pragma unroll 1
        for (int dir = 0; dir < 2; ++dir) {
            const int cd = dir == 0 ? T : (T < 4 ? 3 - T : 135 - T);
            const u16* Ssrc = ST + (size_t)((bh * 2 + dir) * NCH + cd) * 128 * 256;
#pragma unroll
            for (int q = 0; q < 8; ++q) { const int id = tid + q * NTHR, key = id >> 5, cc = (id & 31) * 8;
                *(bf16x8*)(SS + v_st<8>(key, cc)) = *(const bf16x8*)(Ssrc + (size_t)key * 256 + cc); }
            for (int i = tid; i < 1024; i += NTHR) { const int j = i >> 4, r = i & 15; ZT[i] = Zg[(size_t)(t0 + j) * 32 + dir * 16 + r]; }
            float wg[16];
#pragma unroll
            for (int r = 0; r < 16; ++r) wg[r] = F.in(19)[(dir * 16 + r) * 512 + h * 128 + kk];
            const float bias = F.in(20)[dir * 512 + h * 128 + kk];
            __syncthreads();
            float cv[16]; float run = 0;
#pragma unroll
            for (int u = 0; u < 16; ++u) { const int j = jq * 16 + u; float x = bias;
#pragma unroll
                for (int r = 0; r < 16; ++r) x += ZT[j * 16 + r] * wg[r];
                cv[u] = logsig16(x); }
            if (dir == 0) {
#pragma unroll
                for (int u = 0; u < 16; ++u) { run += cv[u]; cv[u] = run; }
            } else {
#pragma unroll
                for (int u = 15; u >= 0; --u) { run += cv[u]; cv[u] = run; }
            }
            SEG[jq * 128 + kk] = run;
            __syncthreads();
            float offset = 0;
#pragma unroll
            for (int q = 0; q < 4; ++q) { const float sv = SEG[q * 128 + kk]; if (dir == 0 ? (q < jq) : (q > jq)) offset += sv; }
            const int adb = jq * 4096 + ((kk >> 3) << 4) + (kk & 7) * 2;
#pragma unroll
            for (int jj = 0; jj < 16; ++jj) { const int i = jq * 16 + jj; const float cum = offset + cv[jj];
                const float qv = bf2f(Qg[(size_t)(t0 + i) * 512 + h * 128 + kk]) * __expf(cum);
                const float kv = bf2f(Kg[(size_t)(t0 + i) * 512 + h * 128 + kk]) * __expf(-cum);
                const int ad = (adb ^ (jj << 4)) + jj * 256;
                *(u16*)(QD + ad) = f2bf(qv); *(u16*)(KI + ad) = f2bf(kv); }
            __syncthreads();
            {
                const int row = itile * 32 + r32; bf16x8 qa[8];
#pragma unroll
                for (int ks = 0; ks < 8; ++ks) qa[ks] = *(const bf16x8*)(QD + row * 256 + (((ks * 2 + hi) ^ (row & 15)) << 4));
                const int ssb = (int)(uintptr_t)SS + v_rd_base(lane) + vb * 512;
                pv_one<0, 8>(acc[0], ssb, qa[0], qa[1], qa[2], qa[3]); pv_one<0, 8>(acc[0], ssb + 32768, qa[4], qa[5], qa[6], qa[7]);
                pv_one<1, 8>(acc[1], ssb, qa[0], qa[1], qa[2], qa[3]); pv_one<1, 8>(acc[1], ssb + 32768, qa[4], qa[5], qa[6], qa[7]);
                f32x16 p0 = f32x16{}, p1 = f32x16{};
#pragma unroll
                for (int ks = 0; ks < 8; ++ks) {
                    const bf16x8 k0 = *(const bf16x8*)(KI + r32 * 256 + (((ks * 2 + hi) ^ (r32 & 15)) << 4));
                    const bf16x8 k1 = *(const bf16x8*)(KI + (32 + r32) * 256 + (((ks * 2 + hi) ^ (r32 & 15)) << 4));
                    p0 = __builtin_amdgcn_mfma_f32_32x32x16_bf16(k0, qa[ks], p0, 0, 0, 0);
                    p1 = __builtin_amdgcn_mfma_f32_32x32x16_bf16(k1, qa[ks], p1, 0, 0, 0);
                }
                const int iq = itile * 32 + r32;
#pragma unroll
                for (int r = 0; r < 16; ++r) { const int s0 = crow(r, hi), s1 = 32 + s0;
                    const bool k0 = dir == 0 ? (s0 <= iq) : (s0 >= iq), k1 = dir == 0 ? (s1 <= iq) : (s1 >= iq);
                    p0[r] = k0 ? p0[r] : 0.f; p1[r] = k1 ? p1[r] : 0.f; }
                bf16x8 pa0, pa1, pa2, pa3;
                PK4(p0, 0, pa0); PK4(p0, 8, pa1); PK4(p1, 0, pa2); PK4(p1, 8, pa3);
                const int vvb = (int)(uintptr_t)VV + v_rd_base(lane) + vb * 512;
                pv_one<0, 8>(acc[0], vvb, pa0, pa1, pa2, pa3); pv_one<1, 8>(acc[1], vvb, pa0, pa1, pa2, pa3);
            }
            __syncthreads();
        }
        float* olb = OL + (itile * 32 + 4 * hi) * 260 + vb * 32 + r32;
#pragma unroll
        for (int n = 0; n < 2; ++n)
#pragma unroll
            for (int r = 0; r < 16; ++r) olb[((r & 3) + 8 * (r >> 2)) * 260 + n * 32] = acc[n][r];
        __syncthreads();
        {
            const int i = tid >> 3, sg = tid & 7; const float* ol = OL + i * 260 + sg * 32;
            float ss = 0;
#pragma unroll
            for (int u = 0; u < 8; ++u) { const f32x4 t = *(const f32x4*)(ol + u * 4); ss += t[0] * t[0] + t[1] * t[1] + t[2] * t[2] + t[3] * t[3]; }
            ss += __shfl_xor(ss, 1); ss += __shfl_xor(ss, 2); ss += __shfl_xor(ss, 4);
            const float rinv = rsqrtf(ss * (1.f / 256.f) + EPS);
            const u16* gp = Gg + (size_t)(t0 + i) * 1024 + h * 256 + sg * 32; u16* op = OUT + (size_t)(t0 + i) * 1024 + h * 256 + sg * 32;
            const float* hn = F.in(21) + sg * 32;
#pragma unroll
            for (int q = 0; q < 4; ++q) { const bf16x8 g8 = *(const bf16x8*)(gp + q * 8); u32x4 w;
                const f32x4 oa = *(const f32x4*)(ol + q * 8), ob = *(const f32x4*)(ol + q * 8 + 4);
                const float o8[8] = {oa[0], oa[1], oa[2], oa[3], ob[0], ob[1], ob[2], ob[3]};
#pragma unroll
                for (int u = 0; u < 4; ++u) { const int e0 = q * 8 + 2 * u;
                    w[u] = cvtpk(o8[2 * u] * rinv * hn[e0] * silu_f(bf2f((u16)g8[2 * u])), o8[2 * u + 1] * rinv * hn[e0 + 1] * silu_f(bf2f((u16)g8[2 * u + 1]))); }
                *(u32x4*)(op + q * 8) = w; }
        }
    }
}

__device__ __forceinline__ void pair_decode(int p, int& elo, int& ehi) { elo = p < 3 ? 0 : (p < 5 ? 1 : 2); ehi = p < 3 ? p + 1 : (p < 5 ? p - 1 : 3); }
struct MoeATiles {
    typedef GTile<RowsGather, RowsPlain, EpiMoeA> Tile; static constexpr bool EP_CONST = false; EpiMoeA ep;
    const int* tab; u16* H; const int* rowtok; const u16* wgu; u16* act; const float* roww; int nmt, bx, G;
    __device__ __forceinline__ bool get(int i, Tile& t) const {
        int mt, nt; if (!tile_seq(i, bx, G, nmt, 16, mt, nt)) return false;
        const int c = tab[32 + mt], g = c / 6; int elo, ehi; pair_decode(c % 6, elo, ehi);
        const int half = nt >> 3, e = half ? ehi : elo;
        t.al = RowsGather{H, 1024, rowtok};
        t.bl = RowsPlain{wgu + ((size_t)(g * 4 + e) * 1024 + (nt & 7) * 128) * 1024, 1024};
        t.ep = EpiMoeA{act, roww, half, half * 512 + (nt & 7) * 64};
        t.brow = mt * 256; t.bcol = 0; return true; }
};
struct MoeBTiles {
    typedef GTile<RowsPlain, RowsSplitK, EpiMoeB> Tile; static constexpr bool EP_CONST = false; EpiMoeB ep;
    const int* tab; ResCtx F; int li; const u16* wd; const u16* act; const int* rowtok; int nmt, bx, G;
    __device__ __forceinline__ bool get(int i, Tile& t) const {
        int mt, nt; if (!tile_seq(i, bx, G, nmt, 8, mt, nt)) return false;
        const int c = tab[32 + mt], g = c / 6; int elo, ehi; pair_decode(c % 6, elo, ehi);
        t.al = RowsPlain{act, 1024};
        t.bl = RowsSplitK{wd + (size_t)(g * 4 + elo) * 1024 * 512, wd + (size_t)(g * 4 + ehi) * 1024 * 512, 512, 8};
        t.ep = EpiMoeB{F, li, rowtok};
        t.brow = mt * 256; t.bcol = nt * 128; return true; }
};
__device__ __forceinline__ void moe_gemm_a(const Frame& F, int li) {
    int* tab = (int*)(F.lds + LDS_TAB); moe_table(F, li, tab);
    const int nmt = tab[24] >> 8;
    MoeATiles prov{EpiMoeA{}, tab, F.W<u16>(WS_H), F.W<int>(WS_ROWTOK), F.W<u16>(WS_MOEW), F.W<u16>(MOE_ACT), F.W<float>(WS_ROWW), nmt, F.bx, F.G};
    gemm_stream<4, 2>(F.lds, prov, 16);
}
__device__ __forceinline__ void moe_gemm_b(const Frame& F, int li) {
    int* tab = (int*)(F.lds + LDS_TAB); moe_table(F, li, tab);
    const int nmt = tab[24] >> 8;
    MoeBTiles prov{EpiMoeB{}, tab, res_ctx(F), li, F.W<u16>(WS_MOEW + MOE_WGU_BYTES), F.W<u16>(MOE_ACT), F.W<int>(WS_ROWTOK), nmt, F.bx, F.G};
    gemm_stream<4, 2>(F.lds, prov, 16);
}
__device__ __forceinline__ void final_norm(const Frame& F) {
    const int lane = threadIdx.x & 63, wid = threadIdx.x >> 6;
    for (int row = F.bx * NWAVE + wid; row < NLAT; row += F.G * NWAVE) {
        float* xr = F.out + (size_t)row * DM; f32x4 v[4];
#pragma unroll
        for (int i = 0; i < 4; ++i) v[i] = *(const f32x4*)(xr + i * 256 + lane * 4);
        float ss = 0;
#pragma unroll
        for (int i = 0; i < 4; ++i) ss += v[i][0] * v[i][0] + v[i][1] * v[i][1] + v[i][2] * v[i][2] + v[i][3] * v[i][3];
        ss = wave_sum(ss); const float rinv = rsqrtf(ss * (1.f / DM) + EPS);
#pragma unroll
        for (int i = 0; i < 4; ++i) { const f32x4 g = *(const f32x4*)(F.in(30) + i * 256 + lane * 4);
            f32x4 o = {v[i][0] * rinv * g[0], v[i][1] * rinv * g[1], v[i][2] * rinv * g[2], v[i][3] * rinv * g[3]};
            *(f32x4*)(xr + i * 256 + lane * 4) = o; }
    }
}

constexpr int N_PHASES = 42;
__global__ void __launch_bounds__(NTHR, 2) fwd_kernel(Params p) {
    extern __shared__ __attribute__((aligned(16))) char lds[];
    Frame F; F.p = &p; F.ws = p.ws; F.lds = lds; F.out = p.out; F.G = (int)gridDim.x; F.bx = (int)blockIdx.x;
    const int lo = p.ph_lo, hi = p.ph_hi;
#if !MK_PER_PHASE
    if (threadIdx.x == 0) *(uint4*)(lds + LDS_BARW) = make_uint4(0u, 0u, 0u, 0u);
    __syncthreads();
    XcdBarrier bar = xcd_barrier_post((unsigned*)(p.ws + WS_CTL), (volatile LAS unsigned*)(lds + LDS_BARW));
#define GRID_BAR() xcd_barrier(bar)
#else
#define GRID_BAR() do {} while (0)
#endif
#ifndef MK_EN
#define MK_EN 0xFFFFFFFFu
#endif
#define EN(g) (((MK_EN) >> (g)) & 1u)
#ifndef MK_REP
#define MK_REP 0u
#endif
#define REP(g) (((MK_REP) >> (g)) & 1u)
#define IN(k) (lo <= (k) && (k) < hi)
#define SEAM(k) do { if ((k) + 1 < hi) GRID_BAR(); } while (0)
#define DUP(g, body) do { body; if (REP(g)) { GRID_BAR(); body; } } while (0)

    if (EN(0) && IN(0)) { DUP(0, (p0_mods(F), __syncthreads(), p0_rope(F), p0_weights(F))); SEAM(0); }

#define LAYER(LI) { constexpr int li = (LI); constexpr int base = 1 + li * 10; constexpr bool first = li == 0, last = li == DEPTH - 1; constexpr int kind = li % 3, j = li / 3; \
        if (EN(1) && IN(base + 0)) { DUP(1, norm_phase<false>(F, li, 0, first)); SEAM(base + 0); } \
        if constexpr (kind == 0) { \
            if (EN(2) && IN(base + 1)) { EpiF32 ep{F.W<float>(MLA_DQ), 544, 544}; \
                gemm_phase<4, 2>(F, RowsPlain{F.W<u16>(WS_H), 1024}, RowsPlain{F.W<u16>(WS_WDQKV) + (size_t)j * 640 * 1024, 1024}, ep, 0, 132, 5, 16, 0, 0); if (REP(2)) { GRID_BAR(); gemm_phase<4, 2>(F, RowsPlain{F.W<u16>(WS_H), 1024}, RowsPlain{F.W<u16>(WS_WDQKV) + (size_t)j * 640 * 1024, 1024}, ep, 0, 132, 5, 16, 0, 0); } SEAM(base + 1); } \
            if (EN(3) && IN(base + 2)) { DUP(3, mla_rowpass(F, j)); SEAM(base + 2); } \
            if (EN(2) && IN(base + 3)) { \
                EpiMlaQ eq{F.W<u16>(MLA_Q), F.W<float>(WS_ROPEA), F.W<float>(WS_ROPEA) + SEQ * 16, 0.10206207261596577f * LOG2E}; \
                gemm_phase<4, 2>(F, RowsPlain{F.W<u16>(MLA_CN), 512}, RowsPlain{F.W<u16>(WS_WUQ) + (size_t)j * 1536 * 256, 256}, eq, 0, 132, 12, 4, 0, 0); \
                EpiMlaKV ek{F.W<u16>(MLA_KN), (long)((MLA_V - MLA_KN) / 2)}; \
                gemm_phase<4, 2>(F, RowsPlain{F.W<u16>(MLA_CN) + 256, 512}, RowsPlain{F.W<u16>(WS_WUKV) + (size_t)j * 2048 * 256, 256}, ek, 0, 132, 16, 4, 132 * 12, 0); \
                SEAM(base + 3); } \
            if (EN(4) && IN(base + 4)) { DUP(4, mla_attn(F, !last)); SEAM(base + 4); } \
            if (EN(2) && IN(base + 5)) { EpiResid ep{res_ctx(F, first), li, 2, 0}; \
                gemm_phase<4, 2>(F, RowsPlain{F.W<u16>(MLA_DQ), 1024}, RowsPlain{F.W<u16>(WS_WOM) + (size_t)j * 1024 * 1024, 1024}, ep, last ? 4 : 0, 132, 8, 16, 0, 0); SEAM(base + 5); } \
        } else if constexpr (kind == 1) { \
            if (EN(5) && IN(base + 1)) { EpiDiffQKV ep{F.W<u16>(DF_Q), (long)((DF_K - DF_Q) / 2), F.W<u16>(DF_V), F.W<float>(WS_ROPEB), F.W<float>(WS_ROPEB) + SEQ * 32, 0.125f * LOG2E}; \
                gemm_phase<4, 2>(F, RowsPlain{F.W<u16>(WS_H), 1024}, RowsPlain{F.W<u16>(WS_WQKVD), 1024}, ep, 0, 132, 24, 16, 0, 0); if (REP(5)) { GRID_BAR(); gemm_phase<4, 2>(F, RowsPlain{F.W<u16>(WS_H), 1024}, RowsPlain{F.W<u16>(WS_WQKVD), 1024}, ep, 0, 132, 24, 16, 0, 0); } SEAM(base + 1); } \
            if (EN(6) && IN(base + 2)) { DUP(6, diff_attn(F)); SEAM(base + 2); } \
            if (EN(7) && IN(base + 3)) { DUP(7, diff_rowpass(F, 0.35550906759906f)); SEAM(base + 3); } \
            if (EN(5) && IN(base + 4)) { EpiResid ep{res_ctx(F, first), li, 2, 0}; \
                gemm_phase<4, 2>(F, RowsPlain{F.W<u16>(DF_Q), 1024}, RowsPlain{F.W<u16>(WS_WOD), 1024}, ep, 0, 132, 8, 16, 0, 0); SEAM(base + 4); } \
        } else { \
            if (EN(8) && IN(base + 1)) { EpiGlaIn ep{F.W<u16>(GL_Q), F.W<u16>(GL_K), F.W<u16>(GL_V), F.W<u16>(GL_G), F.W<float>(GL_Z)}; \
                gemm_phase<4, 2>(F, RowsPlain{F.W<u16>(WS_H), 1024}, RowsPlain{F.W<u16>(WS_WING), 1024}, ep, 0, 132, 25, 16, 0, 0); if (REP(8)) { GRID_BAR(); gemm_phase<4, 2>(F, RowsPlain{F.W<u16>(WS_H), 1024}, RowsPlain{F.W<u16>(WS_WING), 1024}, ep, 0, 132, 25, 16, 0, 0); } SEAM(base + 1); } \
            if (EN(9) && IN(base + 2)) { DUP(9, gla_g1(F)); SEAM(base + 2); } \
            if (EN(10) && IN(base + 3)) { gla_g2(F); SEAM(base + 3); } \
            if (EN(11) && IN(base + 4)) { DUP(11, gla_g3(F)); SEAM(base + 4); } \
            if (EN(8) && IN(base + 5)) { EpiResid ep{res_ctx(F, first), li, 2, 0}; \
                gemm_phase<4, 2>(F, RowsPlain{F.W<u16>(WS_H), 1024}, RowsPlain{F.W<u16>(WS_WOG), 1024}, ep, 0, 132, 8, 16, 0, 0); SEAM(base + 5); } \
        } \
        if (EN(12) && IN(base + 6)) { norm_phase<true>(F, li, last ? NCTX : 0, false); SEAM(base + 6); } \
        if (EN(13) && IN(base + 7)) { DUP(13, (moe_weights(F, li), moe_scatter(F, li, last ? NCTX : 0))); SEAM(base + 7); } \
        if (EN(14) && IN(base + 8)) { DUP(14, moe_gemm_a(F, li)); SEAM(base + 8); } \
        if (EN(15) && IN(base + 9)) { moe_gemm_b(F, li); SEAM(base + 9); } \
    }
    LAYER(0) LAYER(1) LAYER(2) LAYER(3)
    if (EN(16) && IN(41)) { final_norm(F); }
}

extern "C" void kernel_launch(void* const* d_in, const int* in_sizes, int n_in, void* d_out, int out_size, void* d_ws, size_t ws_size, hipStream_t stream) {
    static int grid = 0;
    if (grid == 0) {
        if (n_in != 31 || out_size != NLAT * DM || ws_size < WS_END) {
            fprintf(stderr, "kernel_launch: built for 31 inputs, out %d floats, ws >= %zu bytes; got n_in %d out %d ws %zu\n", NLAT * DM, (size_t)WS_END, n_in, out_size, ws_size);
            grid = -1; return; }
        int dev = 0, cus = 0;
        if (hipGetDevice(&dev) != hipSuccess || hipDeviceGetAttribute(&cus, hipDeviceAttributeMultiprocessorCount, dev) != hipSuccess) { grid = -1; return; }
        if (hipFuncSetAttribute((const void*)fwd_kernel, hipFuncAttributeMaxDynamicSharedMemorySize, LDS_BYTES) != hipSuccess) { fprintf(stderr, "kernel_launch: hipFuncSetAttribute failed\n"); grid = -1; return; }
        int per_cu = 0;
        if (hipOccupancyMaxActiveBlocksPerMultiprocessor(&per_cu, (const void*)fwd_kernel, NTHR, LDS_BYTES) != hipSuccess || per_cu < 1)
            fprintf(stderr, "kernel_launch: occupancy query reports %d workgroups per CU\n", per_cu);
        (void)hipGetLastError();
        grid = cus;
    }
    if (grid < 0) return;
    (void)in_sizes;
    (void)hipMemsetAsync((char*)d_ws + WS_CTL, 0, CTL_BYTES, stream);
    Params p{};
    for (int i = 0; i < 31; ++i) p.in[i] = (const float*)d_in[i];
    p.out = (float*)d_out; p.ws = (unsigned char*)d_ws;
#if MK_PER_PHASE
    for (int ph = 0; ph < N_PHASES; ++ph) { p.ph_lo = ph; p.ph_hi = ph + 1; hipLaunchKernelGGL(fwd_kernel, dim3(grid), dim3(NTHR), LDS_BYTES, stream, p); }
#else
#ifdef MK_PROBE_HI
    p.ph_lo = 0; p.ph_hi = MK_PROBE_HI;
    hipLaunchKernelGGL(fwd_kernel, dim3(grid), dim3(NTHR), LDS_BYTES, stream, p);
    (void)hipMemsetAsync((char*)d_ws + WS_CTL, 0, CTL_BYTES, stream);
#endif
    p.ph_lo = 0; p.ph_hi = N_PHASES;
    hipLaunchKernelGGL(fwd_kernel, dim3(grid), dim3(NTHR), LDS_BYTES, stream, p);
#endif
}
```

```cpp
#include <hip/hip_runtime.h>
#include <stdint.h>
#include <stdio.h>

#ifndef MK_PER_PHASE
#define MK_PER_PHASE 0
#endif

typedef unsigned short u16;
using bf16x8 = __attribute__((ext_vector_type(8))) short;
using s16x4  = __attribute__((ext_vector_type(4))) short;
using f32x16 = __attribute__((ext_vector_type(16))) float;
using f32x4  = __attribute__((ext_vector_type(4))) float;
using u32x4  = __attribute__((ext_vector_type(4))) unsigned;
using u32x2  = __attribute__((ext_vector_type(2))) unsigned;

constexpr int DM = 1024, NBATCH = 4, SEQ = 8192, CTXL = 256, DEPTH = 4;
constexpr int NCTX = NBATCH * CTXL;
constexpr int NLAT = NBATCH * SEQ;
constexpr int NTOK = NCTX + NLAT;
constexpr int KEYS = CTXL + SEQ;
constexpr float EPS = 1e-6f;
constexpr int NTHR = 512, NWAVE = 8;
constexpr float LOG2E = 1.4426950408889634f;

constexpr size_t al256(size_t x) { return (x + 255) / 256 * 256; }
constexpr size_t WS_CTL   = 0;
constexpr size_t CTL_BYTES = 32768;
constexpr size_t WS_MODS  = WS_CTL + CTL_BYTES;
constexpr size_t WS_ROPEA = WS_MODS + al256((size_t)DEPTH * 5 * 6144 * 4);
constexpr size_t WS_ROPEB = WS_ROPEA + (size_t)2 * SEQ * 16 * 4;
constexpr size_t WS_XC    = WS_ROPEB + (size_t)2 * SEQ * 32 * 4;
constexpr size_t WS_WDQKV = WS_XC + (size_t)NCTX * DM * 4;
constexpr size_t WS_WUQ   = WS_WDQKV + (size_t)2 * 640 * 1024 * 2;
constexpr size_t WS_WUKV  = WS_WUQ + (size_t)2 * 1536 * 256 * 2;
constexpr size_t WS_WOM   = WS_WUKV + (size_t)2 * 2048 * 256 * 2;
constexpr size_t WS_WQKVD = WS_WOM + (size_t)2 * 1024 * 1024 * 2;
constexpr size_t WS_WOD   = WS_WQKVD + (size_t)3072 * 1024 * 2;
constexpr size_t WS_WING  = WS_WOD + (size_t)1024 * 1024 * 2;
constexpr size_t WS_WOG   = WS_WING + (size_t)3328 * 1024 * 2;
constexpr size_t WS_TOK   = WS_WOG + (size_t)1024 * 1024 * 2;
constexpr size_t WS_ROWTOK= WS_TOK + (size_t)NTOK * 16;
constexpr int    RMAX     = 40960;
constexpr size_t WS_ROWW  = WS_ROWTOK + (size_t)RMAX * 4;
constexpr size_t WS_H     = al256(WS_ROWW + (size_t)RMAX * 8);
constexpr size_t H_BYTES  = (size_t)NTOK * DM * 2;
constexpr size_t WS_MOEW  = WS_H + H_BYTES;
constexpr size_t MOE_WGU_BYTES = (size_t)16 * 1024 * 1024 * 2;
constexpr size_t MOE_WD_BYTES  = (size_t)16 * 1024 * 512 * 2;
constexpr size_t MOEW_BYTES = MOE_WGU_BYTES + MOE_WD_BYTES;
constexpr size_t WS_BIG   = WS_MOEW + MOEW_BYTES;
constexpr size_t MLA_Q    = WS_BIG;
constexpr size_t MLA_KN   = MLA_Q + (size_t)NBATCH * 16 * KEYS * 96 * 2;
constexpr size_t MLA_V    = MLA_KN + (size_t)NBATCH * 16 * KEYS * 64 * 2;
constexpr size_t MLA_KPE  = MLA_V + (size_t)NBATCH * 16 * KEYS * 64 * 2;
constexpr size_t MLA_DQ   = MLA_KPE + al256((size_t)NBATCH * KEYS * 32 * 2);
constexpr size_t MLA_CN   = MLA_DQ + (size_t)NTOK * 544 * 4;
constexpr size_t MLA_END  = MLA_CN + (size_t)NTOK * 512 * 2;
constexpr size_t DF_Q     = WS_BIG;
constexpr size_t DF_K     = DF_Q + (size_t)NBATCH * 16 * KEYS * 64 * 2;
constexpr size_t DF_V     = DF_K + (size_t)NBATCH * 16 * KEYS * 64 * 2;
constexpr size_t DF_OS    = DF_V + (size_t)NBATCH * 8 * KEYS * 128 * 2;
constexpr size_t DF_END   = DF_OS + (size_t)2 * NTOK * DM * 2;
constexpr size_t GL_STATE = WS_MOEW;
constexpr size_t GL_STATE_BYTES = (size_t)NBATCH * 4 * 2 * 132 * 128 * 256 * 2;
constexpr size_t GL_DEC   = GL_STATE + GL_STATE_BYTES;
constexpr size_t GL_Q     = GL_DEC + al256((size_t)4224 * 128 * 4);
constexpr size_t GL_K     = GL_Q + (size_t)NTOK * 512 * 2;
constexpr size_t GL_V     = GL_K + (size_t)NTOK * 512 * 2;
constexpr size_t GL_G     = GL_V + (size_t)NTOK * 1024 * 2;
constexpr size_t GL_Z     = GL_G + (size_t)NTOK * 1024 * 2;
constexpr size_t GL_END   = GL_Z + (size_t)NTOK * 32 * 4;
constexpr size_t MOE_ACT  = WS_BIG;
constexpr size_t MOE_END  = MOE_ACT + (size_t)RMAX * 1024 * 2;
constexpr size_t cmax(size_t a, size_t b) { return a > b ? a : b; }
constexpr size_t WS_END   = cmax(cmax(MLA_END, DF_END), cmax(GL_END, MOE_END));

#define XCD_BAR_WORDS 3456
constexpr int CW_CNT = 4096;

#define XB_TMO      128
#define XB_XCNT(j)  (256  + 64 * (j))
#define XB_XSUB(j)  (1280 + 64 * (j))
#define XB_XGEN(j)  (2304 + 64 * (j))
#define XB_TOP      3328
#define XB_TOPGEN   3392
#define XB_SPIN_CAP (1u << 24)
#define LAS __attribute__((address_space(3)))
__device__ __forceinline__ unsigned xb_ld(unsigned* p)              { return __hip_atomic_load(p, __ATOMIC_RELAXED, __HIP_MEMORY_SCOPE_AGENT); }
__device__ __forceinline__ unsigned xb_add(unsigned* p, unsigned v) { return __hip_atomic_fetch_add(p, v, __ATOMIC_RELAXED, __HIP_MEMORY_SCOPE_AGENT); }
__device__ __forceinline__ unsigned xb_xcc_id() { return (unsigned)__builtin_amdgcn_s_getreg((3 << 11) | 20) & 0xFu; }
#define XB_SPIN(cond, bar) do { unsigned _sp = 0; while (cond) { __builtin_amdgcn_s_sleep(1); \
    if ((++_sp & 255u) == 0u) { if (xb_ld(&(bar)[XB_TMO])) break; if (_sp > XB_SPIN_CAP) { atomicAdd(&(bar)[XB_TMO], 1u); break; } } } } while (0)
struct XcdBarrier { unsigned* bar; unsigned x; volatile LAS unsigned* st; };
__device__ __forceinline__ XcdBarrier xcd_barrier_post(unsigned* bar, volatile LAS unsigned* st) {
    XcdBarrier b; b.bar = bar; b.x = xb_xcc_id(); b.st = st;
    if (threadIdx.x == 0) (void)xb_add(&bar[XB_XCNT(b.x)], 1u);
    return b;
}
__device__ __forceinline__ void xcd_barrier_complete(unsigned* bar, unsigned x, unsigned& nloc, unsigned& nx) {
    const unsigned G = gridDim.x * gridDim.y * gridDim.z;
    unsigned sum, cnt, mine, sp = 0u;
    for (;;) {
        sum = 0u; cnt = 0u; mine = 0u;
#pragma unroll
        for (unsigned j = 0; j < 16; ++j) { const unsigned c = xb_ld(&bar[XB_XCNT(j)]); sum += c; cnt += (c > 0u) ? 1u : 0u; mine = (j == x) ? c : mine; }
        if (sum == G) break;
        __builtin_amdgcn_s_sleep(1);
        if ((++sp & 255u) == 0u) { if (xb_ld(&bar[XB_TMO])) break; if (sp > XB_SPIN_CAP) { atomicAdd(&bar[XB_TMO], 1u); break; } }
    }
    nloc = mine > 0u ? mine : 1u; nx = cnt > 0u ? cnt : 1u;
}
__device__ __forceinline__ void xcd_barrier(const XcdBarrier& b) {
    asm volatile("s_waitcnt vmcnt(0)" ::: "memory");
    __syncthreads();
    if (threadIdx.x == 0) {
        unsigned* bar = b.bar;
        __builtin_amdgcn_s_waitcnt(0);
        unsigned nloc = b.st[0], nx = b.st[1];
        if (nloc == 0u) { xcd_barrier_complete(bar, b.x, nloc, nx); b.st[0] = nloc; b.st[1] = nx; }
        const unsigned old = xb_add(&bar[XB_XSUB(b.x)], 1u);
        const unsigned gen = old / nloc;
        if (old + 1u == (gen + 1u) * nloc) {
            __builtin_amdgcn_fence(__ATOMIC_RELEASE, "agent");
            asm volatile("s_waitcnt vmcnt(0)" ::: "memory");
            const unsigned og = xb_add(&bar[XB_TOP], 1u);
            const unsigned tg = og / nx;
            if (og + 1u == (tg + 1u) * nx) xb_add(&bar[XB_TOPGEN], 1u);
            else XB_SPIN(xb_ld(&bar[XB_TOPGEN]) == tg, bar);
            __builtin_amdgcn_fence(__ATOMIC_ACQUIRE, "agent");
            xb_add(&bar[XB_XGEN(b.x)], 1u);
            asm volatile("s_waitcnt vmcnt(0)" ::: "memory");
        } else {
            XB_SPIN(xb_ld(&bar[XB_XGEN(b.x)]) == gen, bar);
            __builtin_amdgcn_fence(__ATOMIC_ACQUIRE, "agent");
            asm volatile("s_waitcnt vmcnt(0)" ::: "memory");
        }
    }
    __syncthreads();
}

__device__ __forceinline__ u16 f2bf(float f) { unsigned u = __float_as_uint(f); u += 0x7FFFu + ((u >> 16) & 1u); return (u16)(u >> 16); }
__device__ __forceinline__ float bf2f(u16 h) { return __uint_as_float((unsigned)h << 16); }
__device__ __forceinline__ unsigned cvtpk(float lo, float hi) { unsigned r; asm volatile("v_cvt_pk_bf16_f32 %0, %1, %2" : "=v"(r) : "v"(lo), "v"(hi)); return r; }
__device__ __forceinline__ float wave_sum(float v) {
#pragma unroll
    for (int o = 32; o; o >>= 1) v += __shfl_xor(v, o);
    return v;
}
__device__ __forceinline__ int crow(int r, int hi) { return (r & 3) + 8 * (r >> 2) + 4 * hi; }
__device__ __forceinline__ void row_bp(int row, int& b, int& pos) {
    if (row < NCTX) { b = row >> 8; pos = row & 255; } else { const int r = row - NCTX; b = r >> 13; pos = CTXL + (r & (SEQ - 1)); }
}
__device__ __forceinline__ float silu_f(float x) { return x / (1.f + __expf(-x)); }
#define SBAR() __builtin_amdgcn_sched_barrier(0)

struct Params { const float* in[31]; float* out; unsigned char* ws; int ph_lo, ph_hi; };

struct RowsPlain  { const u16* base; long ld;
    __device__ __forceinline__ long off(int r) const { return (long)r * ld; }
    __device__ __forceinline__ const u16* kbase(int kt) const { return base + kt * 64; } };
struct RowsGather { const u16* base; long ld; const int* idx;
    __device__ __forceinline__ long off(int r) const { int t = idx[r]; t = t < 0 ? 0 : t; return (long)t * ld; }
    __device__ __forceinline__ const u16* kbase(int kt) const { return base + kt * 64; } };
struct RowsSplitK { const u16* b0; const u16* b1; long ld; int ks;
    __device__ __forceinline__ long off(int r) const { return (long)r * ld; }
    __device__ __forceinline__ const u16* kbase(int kt) const { return kt < ks ? b0 + kt * 64 : b1 + (kt - ks) * 64; } };

constexpr int GEMM_LDS = 2 * 384 * 128;

template <int WM, int WN, class AL, class BL, class EP>
__device__ __forceinline__ void gemm_tile(char* lds, const AL al, const BL bl, EP& ep, int brow, int bcol, int nk) {
    constexpr int BM = WM * 64, BN = WN * 64, STG = (BM + BN) * 128, NA = BM / 64, NB = BN / 64;
    const int tid = threadIdx.x, lane = tid & 63, wid = __builtin_amdgcn_readfirstlane(tid >> 6);
    const int wm = wid / WN, wn = wid % WN, r32 = lane & 31, hi = lane >> 5;
    long aoff[NA], boff[NB];
#pragma unroll
    for (int i = 0; i < NA; ++i) { const int r = (i * 8 + wid) * 8 + (lane >> 3); const int c = (lane & 7) ^ ((r >> 1) & 7); aoff[i] = al.off(brow + r) + c * 8; }
#pragma unroll
    for (int i = 0; i < NB; ++i) { const int r = (i * 8 + wid) * 8 + (lane >> 3); const int c = (lane & 7) ^ ((r >> 1) & 7); boff[i] = bl.off(bcol + r) + c * 8; }
    const int ldsw = wid * 1024 + lane * 16;
    int abase[2], bbase[2];
#pragma unroll
    for (int i = 0; i < 2; ++i) {
        const int ra = wm * 64 + i * 32 + r32; abase[i] = ra * 128 + ((hi ^ ((ra >> 1) & 7)) << 4);
        const int rb = wn * 64 + i * 32 + r32; bbase[i] = BM * 128 + rb * 128 + ((hi ^ ((rb >> 1) & 7)) << 4);
    }
    f32x16 acc[2][2];
#pragma unroll
    for (int i = 0; i < 2; ++i)
#pragma unroll
        for (int j = 0; j < 2; ++j) acc[i][j] = f32x16{};
#define GSTAGE(kt, buf) do { const u16* _ka = al.kbase(kt); const u16* _kb = bl.kbase(kt); char* _d = lds + (buf) * STG + ldsw; \
        _Pragma("unroll") for (int _i = 0; _i < NA; ++_i) __builtin_amdgcn_global_load_lds((const unsigned*)(_ka + aoff[_i]), (unsigned*)(_d + _i * 8192), 16, 0, 0); \
        _Pragma("unroll") for (int _i = 0; _i < NB; ++_i) __builtin_amdgcn_global_load_lds((const unsigned*)(_kb + boff[_i]), (unsigned*)(_d + BM * 128 + _i * 8192), 16, 0, 0); } while (0)
    __syncthreads();
    GSTAGE(0, 0);
    for (int kt = 0; kt < nk; ++kt) {
        asm volatile("s_waitcnt vmcnt(0)" ::: "memory");
        __syncthreads();
        if (kt + 1 < nk) GSTAGE(kt + 1, (kt + 1) & 1);
        const char* sb = lds + (kt & 1) * STG;
#pragma unroll
        for (int ks = 0; ks < 4; ++ks) {
            bf16x8 a0 = *(const bf16x8*)(sb + (abase[0] ^ (ks << 5)));
            bf16x8 a1 = *(const bf16x8*)(sb + (abase[1] ^ (ks << 5)));
            bf16x8 b0 = *(const bf16x8*)(sb + (bbase[0] ^ (ks << 5)));
            bf16x8 b1 = *(const bf16x8*)(sb + (bbase[1] ^ (ks << 5)));
            acc[0][0] = __builtin_amdgcn_mfma_f32_32x32x16_bf16(a0, b0, acc[0][0], 0, 0, 0);
            acc[0][1] = __builtin_amdgcn_mfma_f32_32x32x16_bf16(a0, b1, acc[0][1], 0, 0, 0);
            acc[1][0] = __builtin_amdgcn_mfma_f32_32x32x16_bf16(a1, b0, acc[1][0], 0, 0, 0);
            acc[1][1] = __builtin_amdgcn_mfma_f32_32x32x16_bf16(a1, b1, acc[1][1], 0, 0, 0);
        }
    }
#undef GSTAGE
    ep(acc, brow + wm * 64, bcol + wn * 64, lane);
}


constexpr int GSTG = 384 * 128;
template <class AL_, class BL_, class EP_> struct GTile { typedef EP_ EPT; AL_ al; BL_ bl; EP_ ep; int brow, bcol; };
__device__ __forceinline__ bool tile_seq(int i, int bx, int G, int nM, int nN, int& m, int& n) {
    const int s = (G == 256) ? (i * 8 + (bx & 7)) * 32 + (bx >> 3) : bx + i * G;
    if (s >= nM * nN) return false;
    const int full = (nM >> 2) * 4 * nN;
    if (s < full) { const int band = s / (4 * nN), rem = s - band * 4 * nN; n = rem >> 2; m = band * 4 + (rem & 3); }
    else { const int h = nM & 3, rem = s - full; n = rem / h; m = (nM & ~3) + rem - n * h; }
    return true;
}
template <class AL_, class BL_, class EP_> struct PlainTiles {
    typedef GTile<AL_, BL_, EP_> Tile; static constexpr bool EP_CONST = true;
    AL_ al; BL_ bl; EP_ ep; int mt0, nM, nN, bx, G;
    __device__ __forceinline__ bool get(int i, Tile& t) const {
        int m, n; if (!tile_seq(i, bx, G, nM, nN, m, n)) return false;
        t.al = al; t.bl = bl; t.ep = ep; t.brow = (mt0 + m) * 256; t.bcol = n * 128; return true; }
};
template <int WM, int WN, class P>
__device__ __forceinline__ void gemm_stream(char* lds, const P& prov, int nk) {
    constexpr int BM = WM * 64, BN = WN * 64, NA = BM / 64, NB = BN / 64;
    static_assert(NA + NB == 6, "the counted wait assumes six LDS-DMA loads per wave per K-step");
    const int tid = threadIdx.x, lane = tid & 63, wid = __builtin_amdgcn_readfirstlane(tid >> 6);
    const int wm = wid / WN, wn = wid % WN, r32 = lane & 31, hi = lane >> 5;
    typename P::Tile cur, nxt;
    if (!prov.get(0, cur)) return;
    unsigned aoff[NA], boff[NB], aoffn[NA], boffn[NB];
#define GOFFS(T, AO, BO) do { \
    _Pragma("unroll") for (int _i = 0; _i < NA; ++_i) { const int _r = (_i * 8 + wid) * 8 + (lane >> 3); const int _c = (lane & 7) ^ ((_r >> 1) & 7); AO[_i] = (unsigned)((T).al.off((T).brow + _r) + _c * 8); } \
    _Pragma("unroll") for (int _i = 0; _i < NB; ++_i) { const int _r = (_i * 8 + wid) * 8 + (lane >> 3); const int _c = (lane & 7) ^ ((_r >> 1) & 7); BO[_i] = (unsigned)((T).bl.off((T).bcol + _r) + _c * 8); } } while (0)
#define GSTAGE2(T, AO, BO, kt, slot) do { const u16* _ka = (T).al.kbase(kt); const u16* _kb = (T).bl.kbase(kt); char* _d = lds + (slot) * GSTG + ldsw; \
        _Pragma("unroll") for (int _i = 0; _i < NA; ++_i) __builtin_amdgcn_global_load_lds((const unsigned*)(_ka + AO[_i]), (unsigned*)(_d + _i * 8192), 16, 0, 0); \
        _Pragma("unroll") for (int _i = 0; _i < NB; ++_i) __builtin_amdgcn_global_load_lds((const unsigned*)(_kb + BO[_i]), (unsigned*)(_d + BM * 128 + _i * 8192), 16, 0, 0); } while (0)
    GOFFS(cur, aoff, boff);
    const int ldsw = wid * 1024 + lane * 16;
    int abase[2], bbase[2];
#pragma unroll
    for (int i = 0; i < 2; ++i) {
        const int ra = wm * 64 + i * 32 + r32; abase[i] = ra * 128 + ((hi ^ ((ra >> 1) & 7)) << 4);
        const int rb = wn * 64 + i * 32 + r32; bbase[i] = BM * 128 + rb * 128 + ((hi ^ ((rb >> 1) & 7)) << 4);
    }
    f32x16 acc[2][2];
#pragma unroll
    for (int i = 0; i < 2; ++i)
#pragma unroll
        for (int j = 0; j < 2; ++j) acc[i][j] = f32x16{};
    __syncthreads();
    GSTAGE2(cur, aoff, boff, 0, 0); GSTAGE2(cur, aoff, boff, 1, 1);
    int slot = 0; bool pendE = false; typename P::Tile::EPT pep = cur.ep; int pbrow = 0, pbcol = 0;
    for (int i = 0;; ++i) {
        const bool has_next = prov.get(i + 1, nxt);
        if (has_next) GOFFS(nxt, aoffn, boffn);
        for (int kt = 0; kt < nk; ++kt) {
            if ((kt + 1 < nk) || has_next) asm volatile("s_waitcnt vmcnt(6)" ::: "memory"); else asm volatile("s_waitcnt vmcnt(0)" ::: "memory");
            __builtin_amdgcn_s_barrier(); asm volatile("" ::: "memory");
            const int s2 = slot >= 1 ? slot - 1 : 2;
            if (kt + 2 < nk) GSTAGE2(cur, aoff, boff, kt + 2, s2); else if (has_next) GSTAGE2(nxt, aoffn, boffn, kt + 2 - nk, s2);
            if (kt == 0 && pendE) {
                if constexpr (P::EP_CONST) (void)prov.ep(acc, pbrow + wm * 64, pbcol + wn * 64, lane); else (void)pep(acc, pbrow + wm * 64, pbcol + wn * 64, lane);
                pendE = false;
#pragma unroll
                for (int a = 0; a < 2; ++a)
#pragma unroll
                    for (int b = 0; b < 2; ++b) acc[a][b] = f32x16{};
            }
            const char* sb = lds + slot * GSTG;
#pragma unroll
            for (int ks = 0; ks < 4; ++ks) {
                bf16x8 a0 = *(const bf16x8*)(sb + (abase[0] ^ (ks << 5)));
                bf16x8 a1 = *(const bf16x8*)(sb + (abase[1] ^ (ks << 5)));
                bf16x8 b0 = *(const bf16x8*)(sb + (bbase[0] ^ (ks << 5)));
                bf16x8 b1 = *(const bf16x8*)(sb + (bbase[1] ^ (ks << 5)));
                acc[0][0] = __builtin_amdgcn_mfma_f32_32x32x16_bf16(b0, a0, acc[0][0], 0, 0, 0);
                acc[0][1] = __builtin_amdgcn_mfma_f32_32x32x16_bf16(b1, a0, acc[0][1], 0, 0, 0);
                acc[1][0] = __builtin_amdgcn_mfma_f32_32x32x16_bf16(b0, a1, acc[1][0], 0, 0, 0);
                acc[1][1] = __builtin_amdgcn_mfma_f32_32x32x16_bf16(b1, a1, acc[1][1], 0, 0, 0);
            }
            slot = slot == 2 ? 0 : slot + 1;
        }
        if (!has_next) { (void)cur.ep(acc, cur.brow + wm * 64, cur.bcol + wn * 64, lane); break; }
        if constexpr (!P::EP_CONST) pep = cur.ep;
        pbrow = cur.brow; pbcol = cur.bcol; pendE = true;
        cur = nxt;
#pragma unroll
        for (int a = 0; a < NA; ++a) aoff[a] = aoffn[a];
#pragma unroll
        for (int b = 0; b < NB; ++b) boff[b] = boffn[b];
    }
    asm volatile("s_waitcnt vmcnt(0)" ::: "memory");
    __syncthreads();
#undef GOFFS
#undef GSTAGE2
}


namespace pg8 {
constexpr int BM = 256, BK = 64, HALF = 128, HTB = HALF * BK * 2, STAGE_BYTES = 8 * HTB;
__device__ __forceinline__ int lds_byte(int r, int c) { const int st = (r >> 4) * 2 + (c >> 5), rr = r & 15, cc = c & 31, ob = rr * 64 + cc * 2; return st * 1024 + (ob ^ (((ob >> 9) & 1) << 5)); }
__device__ __forceinline__ void stage_rc(int b, int& R, int& C) { const int st = b / 1024, sb = b % 1024, swz = sb ^ (((sb >> 9) & 1) << 5); R = (st >> 1) * 16 + swz / 64; C = (st & 1) * 32 + (swz % 64) / 2; }
struct Unit { int pm, pn; };
template <class Epi, class Sched>
__device__ __forceinline__ void gemm_phase(char* lds, const u16* A, const u16* Bt, int K, const Sched& S, const Epi& E) {
    const int tid = threadIdx.x, wid = __builtin_amdgcn_readfirstlane(tid >> 6), lane = tid & 63, wr = wid >> 2, wc = wid & 3, fr = lane & 15, fq = lane >> 4;
    const int nt = K / BK;
    unsigned voffA[2], voffB[2];
#pragma unroll
    for (int i = 0; i < 2; ++i) { int R, C; stage_rc(tid * 16 + i * 8192, R, C); voffA[i] = (unsigned)(R * K + C) * 2u; voffB[i] = voffA[i]; }
    const size_t kstep = (size_t)(BK * 2), hstep = (size_t)HALF * K * 2, tstep = 2 * hstep;
    const unsigned ldsw = (unsigned)wid * 1024u;
    const int aoff = lds_byte(wr * 64 + fr, fq * 8), boff = lds_byte(wc * 32 + fr, fq * 8);
#define PG8_SA(b, h) (((b) * 2 + (h)) * HTB)
#define PG8_SB(b, h) ((4 + (b) * 2 + (h)) * HTB)
#define PG8_STAGE(bufoff, gbase, voff) do { _Pragma("unroll") for (int _i = 0; _i < 2; ++_i) \
        __builtin_amdgcn_global_load_lds((const unsigned*)((const char*)(gbase) + (voff)[_i]), (unsigned*)(lds + (bufoff) + ldsw + _i * 8192), 16, 0, 0); } while (0)
#define PG8_LDA(dst, b, h) do { _Pragma("unroll") for (int m = 0; m < 4; ++m) _Pragma("unroll") for (int k = 0; k < 2; ++k) dst[m][k] = *(const bf16x8*)(lds + PG8_SA(b, h) + aoff + m * 2048 + k * 1024); } while (0)
#define PG8_LDB(dst, b, h) do { _Pragma("unroll") for (int n = 0; n < 2; ++n) _Pragma("unroll") for (int k = 0; k < 2; ++k) dst[n][k] = *(const bf16x8*)(lds + PG8_SB(b, h) + boff + n * 2048 + k * 1024); } while (0)
#define PG8_MMA(ai, bj, At, Bt_) do { __builtin_amdgcn_s_setprio(1); _Pragma("unroll") for (int m = 0; m < 4; ++m) _Pragma("unroll") for (int n = 0; n < 2; ++n) _Pragma("unroll") for (int k = 0; k < 2; ++k) \
        acc[ai][bj][m][n] = __builtin_amdgcn_mfma_f32_16x16x32_bf16(Bt_[n][k], At[m][k], acc[ai][bj][m][n], 0, 0, 0); __builtin_amdgcn_s_setprio(0); } while (0)
#define PG8_WAIT_V(n) asm volatile("s_waitcnt vmcnt(" #n ")" ::: "memory")
#define PG8_WAIT_L(n) asm volatile("s_waitcnt lgkmcnt(" #n ")" ::: "memory")
#define PG8_BAR __builtin_amdgcn_s_barrier()
#define PG8_SCHED __builtin_amdgcn_sched_barrier(0)
    Unit cur, nxt; int ui = 0;
    if (!S.next(0, cur)) return;
    f32x4 acc[2][2][4][2];
#pragma unroll
    for (int a = 0; a < 2; ++a)
#pragma unroll
        for (int b = 0; b < 2; ++b)
#pragma unroll
            for (int m = 0; m < 4; ++m)
#pragma unroll
                for (int n = 0; n < 2; ++n) acc[a][b][m][n] = (f32x4){0.f, 0.f, 0.f, 0.f};
    bf16x8 At[4][2], B0[2][2], B1[2][2];
    const char* cA = (const char*)A + (size_t)cur.pm * tstep; const char* cB = (const char*)Bt + (size_t)cur.pn * tstep;
    __syncthreads();
    PG8_STAGE(PG8_SB(0, 0), cB, voffB); PG8_STAGE(PG8_SA(0, 0), cA, voffA); PG8_STAGE(PG8_SB(0, 1), cB + hstep, voffB); PG8_STAGE(PG8_SA(0, 1), cA + hstep, voffA);
    if (wr == 1) PG8_BAR;
    PG8_WAIT_V(4); PG8_BAR;
    PG8_STAGE(PG8_SB(1, 0), cB + kstep, voffB); PG8_STAGE(PG8_SA(1, 0), cA + kstep, voffA); PG8_STAGE(PG8_SB(1, 1), cB + hstep + kstep, voffB);
    PG8_WAIT_V(6); PG8_BAR;
    for (;;) {
        const bool has_next = S.next(ui + 1, nxt);
        const char* nA = has_next ? (const char*)A + (size_t)nxt.pm * tstep : cA; const char* nB = has_next ? (const char*)Bt + (size_t)nxt.pn * tstep : cB;
        for (int t = 0; t < nt; t += 2) {
            const bool last = (t == nt - 2);
            const char* a1 = cA + (size_t)(t + 1) * kstep;
            const char* a2 = last ? nA : cA + (size_t)(t + 2) * kstep; const char* b2 = last ? nB : cB + (size_t)(t + 2) * kstep;
            const char* a3 = a2 + kstep; const char* b3 = b2 + kstep;
            PG8_LDB(B0, 0, 0); PG8_SCHED; PG8_LDA(At, 0, 0); PG8_STAGE(PG8_SA(1, 1), a1 + hstep, voffA);
            PG8_WAIT_L(8); PG8_BAR; PG8_WAIT_L(0); PG8_MMA(0, 0, At, B0); PG8_BAR; PG8_SCHED;
            PG8_LDB(B1, 0, 1); PG8_STAGE(PG8_SB(0, 0), b2, voffB);
            PG8_BAR; PG8_WAIT_L(0); PG8_MMA(0, 1, At, B1); PG8_BAR;
            PG8_LDA(At, 0, 1); PG8_STAGE(PG8_SA(0, 0), a2, voffA);
            PG8_BAR; PG8_WAIT_L(0); PG8_MMA(1, 0, At, B0); PG8_BAR; PG8_SCHED;
            PG8_STAGE(PG8_SB(0, 1), b2 + hstep, voffB);
            PG8_WAIT_V(6); PG8_BAR; PG8_MMA(1, 1, At, B1); PG8_BAR;
            PG8_LDB(B0, 1, 0); PG8_SCHED; PG8_LDA(At, 1, 0); PG8_STAGE(PG8_SA(0, 1), a2 + hstep, voffA);
            PG8_WAIT_L(8); PG8_BAR; PG8_WAIT_L(0); PG8_MMA(0, 0, At, B0); PG8_BAR; PG8_SCHED;
            PG8_LDB(B1, 1, 1); PG8_STAGE(PG8_SB(1, 0), b3, voffB);
            PG8_BAR; PG8_WAIT_L(0); PG8_MMA(0, 1, At, B1); PG8_BAR;
            PG8_LDA(At, 1, 1); PG8_STAGE(PG8_SA(1, 0), a3, voffA);
            PG8_BAR; PG8_WAIT_L(0); PG8_MMA(1, 0, At, B0); PG8_BAR; PG8_SCHED;
            PG8_STAGE(PG8_SB(1, 1), b3 + hstep, voffB);
            PG8_WAIT_V(6); PG8_BAR; PG8_MMA(1, 1, At, B1); PG8_BAR;
        }
        E(acc, cur, wr, wc, fr, fq);
        if (!has_next) break;
#pragma unroll
        for (int a = 0; a < 2; ++a)
#pragma unroll
            for (int b = 0; b < 2; ++b)
#pragma unroll
                for (int m = 0; m < 4; ++m)
#pragma unroll
                    for (int n = 0; n < 2; ++n) acc[a][b][m][n] = (f32x4){0.f, 0.f, 0.f, 0.f};
        cur = nxt; cA = nA; cB = nB; ++ui;
    }
    PG8_WAIT_V(0);
    if (wr == 0) PG8_BAR;
    PG8_BAR;
#undef PG8_SA
#undef PG8_SB
#undef PG8_STAGE
#undef PG8_LDA
#undef PG8_LDB
#undef PG8_MMA
#undef PG8_WAIT_V
#undef PG8_WAIT_L
#undef PG8_BAR
#undef PG8_SCHED
}
struct SeqOrder { int nM, nN, bx, G;
    __device__ __forceinline__ bool next(int i, Unit& u) const { return tile_seq(i, bx, G, nM, nN, u.pm, u.pn); } };
struct EpiGlaIn8 { u16* q; u16* k; u16* v; u16* g; float* z;
    __device__ __forceinline__ void operator()(const f32x4 (&acc)[2][2][4][2], const Unit& u, int wr, int wc, int fr, int fq) const {
#pragma unroll
        for (int bj = 0; bj < 2; ++bj)
#pragma unroll
            for (int n = 0; n < 2; ++n) { const int c0 = u.pn * 256 + bj * 128 + wc * 32 + n * 16, col = c0 + 4 * fq;
                if (c0 >= 3104) continue;
                u16* base; int ld, cc; float scl = 1.f;
                if (c0 < 512) { base = q; ld = 512; cc = col; scl = 0.08838834764831845f; } else if (c0 < 1024) { base = k; ld = 512; cc = col - 512; }
                else if (c0 < 2048) { base = v; ld = 1024; cc = col - 1024; } else if (c0 < 3072) { base = g; ld = 1024; cc = col - 2048; } else { base = nullptr; ld = 32; cc = col - 3072; }
#pragma unroll
                for (int ai = 0; ai < 2; ++ai)
#pragma unroll
                    for (int m = 0; m < 4; ++m) { const size_t row = (size_t)u.pm * 256 + ai * 128 + wr * 64 + m * 16 + fr; const f32x4 a = acc[ai][bj][m][n];
                        if (c0 < 3072) { u32x2 w = {cvtpk(a[0] * scl, a[1] * scl), cvtpk(a[2] * scl, a[3] * scl)}; *(u32x2*)(base + row * ld + cc) = w; }
                        else *(f32x4*)(z + row * 32 + cc) = a; } }
    } };
}

template <int DK, int DV> struct AttnCfg {
    static constexpr int NKB = DK / 32, NVB = DV / 32, ND0 = DK / 16;
    static constexpr int KBYTES = 64 * DK * 2, VBYTES = 64 * DV * 2;
    static constexpr int LDS = 2 * KBYTES + 2 * VBYTES + NWAVE * 64 * 4;
};
constexpr float ATT_THR = 8.f;

__device__ __forceinline__ void partialSM(f32x16& p0, f32x16& p1, float& m_reg, float& mn, float& alpha) {
    float pmax = p0[0];
#pragma unroll
    for (int r = 1; r < 16; ++r) pmax = fmaxf(pmax, p0[r]);
#pragma unroll
    for (int r = 0; r < 16; ++r) pmax = fmaxf(pmax, p1[r]);
    { auto rr = __builtin_amdgcn_permlane32_swap(__float_as_uint(pmax), __float_as_uint(pmax), false, false);
      pmax = fmaxf(__uint_as_float(rr[0]), __uint_as_float(rr[1])); }
    if (__builtin_expect(__all(pmax - m_reg <= ATT_THR), 1)) { mn = m_reg; alpha = 1.f; }
    else { mn = fmaxf(m_reg, pmax); alpha = __builtin_amdgcn_exp2f(m_reg - mn); m_reg = mn; }
#pragma unroll
    for (int r = 0; r < 16; ++r) p0[r] = p0[r] - mn;
#pragma unroll
    for (int r = 0; r < 16; ++r) p1[r] = p1[r] - mn;
#pragma unroll
    for (int r = 0; r < 16; ++r) p0[r] = __builtin_amdgcn_exp2f(p0[r]);
}
#define PK4(P, BASE, OUT) do { unsigned a0 = cvtpk(P[BASE + 0], P[BASE + 1]), a1 = cvtpk(P[BASE + 2], P[BASE + 3]);   \
    unsigned b0 = cvtpk(P[BASE + 4], P[BASE + 5]), b1 = cvtpk(P[BASE + 6], P[BASE + 7]);                              \
    auto r0 = __builtin_amdgcn_permlane32_swap(a0, b0, false, false); auto r1 = __builtin_amdgcn_permlane32_swap(a1, b1, false, false); \
    u32x4 w = {r0[0], r1[0], r0[1], r1[1]}; OUT = *reinterpret_cast<bf16x8*>(&w); } while (0)
__device__ __forceinline__ void finishSM(f32x16& p0, f32x16& p1, float alpha, float& l_reg, bf16x8& pa0, bf16x8& pa1, bf16x8& pa2, bf16x8& pa3) {
#pragma unroll
    for (int r = 0; r < 16; ++r) p1[r] = __builtin_amdgcn_exp2f(p1[r]);
    float ps = 0;
#pragma unroll
    for (int r = 0; r < 16; ++r) ps += p0[r];
#pragma unroll
    for (int r = 0; r < 16; ++r) ps += p1[r];
    { auto rr = __builtin_amdgcn_permlane32_swap(__float_as_uint(ps), __float_as_uint(ps), false, false);
      ps = __uint_as_float(rr[0]) + __uint_as_float(rr[1]); }
    l_reg = l_reg * alpha + ps;
    PK4(p0, 0, pa0); PK4(p0, 8, pa1); PK4(p1, 0, pa2); PK4(p1, 8, pa3);
}
template <bool FIRST, bool KEEPN>
__device__ __forceinline__ void psm_rel(f32x16& p0, f32x16& p1, float& m_reg, f32x16& negm, float& alpha) {
    float pmax = fmaxf(p0[0], p1[0]);
#pragma unroll
    for (int r = 1; r < 16; ++r) pmax = fmaxf(pmax, fmaxf(p0[r], p1[r]));
    { auto rr = __builtin_amdgcn_permlane32_swap(__float_as_uint(pmax), __float_as_uint(pmax), false, false);
      pmax = fmaxf(__uint_as_float(rr[0]), __uint_as_float(rr[1])); }
    alpha = 1.f;
    if (FIRST || !__builtin_expect(__all(pmax <= ATT_THR), 1)) {
        const float d = FIRST ? pmax : fmaxf(pmax, 0.f);
        if (!FIRST) alpha = __builtin_amdgcn_exp2f(-d);
        m_reg += d;
#pragma unroll
        for (int r = 0; r < 16; ++r) { p0[r] -= d; p1[r] -= d; if (KEEPN) negm[r] = -m_reg; }
    }
#pragma unroll
    for (int r = 0; r < 16; ++r) p0[r] = __builtin_amdgcn_exp2f(p0[r]);
}
__device__ __forceinline__ bf16x8 pack8(const f32x16& p, int base) {
    u32x4 w = {cvtpk(p[base], p[base + 1]), cvtpk(p[base + 2], p[base + 3]), cvtpk(p[base + 4], p[base + 5]), cvtpk(p[base + 6], p[base + 7])};
    return *reinterpret_cast<bf16x8*>(&w);
}
__device__ __forceinline__ void fsm_rel(f32x16& p0, f32x16& p1, bf16x8& pa0, bf16x8& pa1, bf16x8& pa2, bf16x8& pa3) {
#pragma unroll
    for (int r = 0; r < 16; ++r) p1[r] = __builtin_amdgcn_exp2f(p1[r]);
    pa0 = pack8(p0, 0); pa1 = pack8(p0, 8); pa2 = pack8(p1, 0); pa3 = pack8(p1, 8);
}
__device__ __forceinline__ int k_lds_off(int row, int blk, int chunk) { return blk * 4096 + row * 64 + ((chunk ^ ((row >> 2) & 3)) << 4); }
template <int ND0>
__device__ __forceinline__ void qkt(f32x16& p0, f32x16& p1, const char* Ks, const bf16x8* qr, int r32, int hi, const f32x16& cinit) {
    p0 = cinit; p1 = cinit;
#pragma unroll
    for (int d0 = 0; d0 < ND0; ++d0) {
        const int ch = (d0 & 1) * 2 + hi;
        bf16x8 b0 = *reinterpret_cast<const bf16x8*>(Ks + k_lds_off(r32, d0 >> 1, ch));
        bf16x8 b1 = *reinterpret_cast<const bf16x8*>(Ks + k_lds_off(32 + r32, d0 >> 1, ch));
        p0 = __builtin_amdgcn_mfma_f32_32x32x16_bf16(b0, qr[d0], p0, 0, 0, 0);
        p1 = __builtin_amdgcn_mfma_f32_32x32x16_bf16(b1, qr[d0], p1, 0, 0, 0);
    }
}
template <int NVB, bool SWAP = true> __device__ __forceinline__ int v_st(int k, int c) {
    const int kk = SWAP ? ((k & ~0xC) | ((k & 4) << 1) | ((k & 8) >> 1)) : k;
    return ((kk >> 3) * NVB + (c >> 5)) * 512 + ((kk & 7) * 32 + (c & 31)) * 2;
}
__device__ __forceinline__ int v_rd_base(int lane) { return ((lane & 3) << 3) | (((lane >> 2) & 3) << 6) | (((lane >> 4) & 1) << 5) | (((lane >> 5) & 1) << 8); }
template <int OFF> __device__ __forceinline__ s16x4 tr_read(int vb) {
    s16x4 r; asm volatile("ds_read_b64_tr_b16 %0, %1 offset:%2" : "=&v"(r) : "v"(vb), "i"(OFF) : "memory"); return r;
}
#define PKV(L, H) (bf16x8){L[0], L[1], L[2], L[3], H[0], H[1], H[2], H[3]}
template <int D0, int NVB> __device__ __forceinline__ void pv_one(f32x16& od, int vb, bf16x8 pa0, bf16x8 pa1, bf16x8 pa2, bf16x8 pa3) {
    constexpr int KS = 2 * NVB * 512, HF = NVB * 512, B0 = D0 * 512;
    const s16x4 l0 = tr_read<B0 + 0 * KS>(vb), h0 = tr_read<B0 + 0 * KS + HF>(vb), l1 = tr_read<B0 + 1 * KS>(vb), h1 = tr_read<B0 + 1 * KS + HF>(vb);
    const s16x4 l2 = tr_read<B0 + 2 * KS>(vb), h2 = tr_read<B0 + 2 * KS + HF>(vb), l3 = tr_read<B0 + 3 * KS>(vb), h3 = tr_read<B0 + 3 * KS + HF>(vb);
    asm volatile("s_waitcnt lgkmcnt(0)" ::: "memory"); SBAR();
    od = __builtin_amdgcn_mfma_f32_32x32x16_bf16(pa0, PKV(l0, h0), od, 0, 0, 0);
    od = __builtin_amdgcn_mfma_f32_32x32x16_bf16(pa1, PKV(l1, h1), od, 0, 0, 0);
    od = __builtin_amdgcn_mfma_f32_32x32x16_bf16(pa2, PKV(l2, h2), od, 0, 0, 0);
    od = __builtin_amdgcn_mfma_f32_32x32x16_bf16(pa3, PKV(l3, h3), od, 0, 0, 0);
}
template <int NVB> __device__ __forceinline__ void pv_all(f32x16* o, int vb, bf16x8 pa0, bf16x8 pa1, bf16x8 pa2, bf16x8 pa3) {
    pv_one<0, NVB>(o[0], vb, pa0, pa1, pa2, pa3); pv_one<1, NVB>(o[1], vb, pa0, pa1, pa2, pa3);
    if constexpr (NVB == 4) { pv_one<2, NVB>(o[2], vb, pa0, pa1, pa2, pa3); pv_one<3, NVB>(o[3], vb, pa0, pa1, pa2, pa3); }
}

template <int DK, int DV>
__device__ __forceinline__ void attn_item(const u16* __restrict__ Qb, const u16* __restrict__ Ka, const u16* __restrict__ Kb, const u16* __restrict__ Vh,
                                          int nkeys, u16* __restrict__ Ob, long ldo, char* lds) {
    using C = AttnCfg<DK, DV>;
    constexpr int NVB = C::NVB, ND0 = C::ND0, NKI = (DK / 32) * 4, NVI = DV / 8, NI = NKI + NVI;
    static_assert(NI <= 24, "three LDS-DMA pieces per wave per tile");
    const int tid = threadIdx.x, wid = __builtin_amdgcn_readfirstlane(tid >> 6), lane = tid & 63, r32 = lane & 31, hi = lane >> 5;
    char* K_lds = lds; char* V_lds = lds + 3 * C::KBYTES;
    float* al_l = (float*)(lds + 3 * C::KBYTES + 3 * C::VBYTES) + wid * 32;
    float m_reg = 0.f; f32x16 o[NVB], ol, negm; bf16x8 qr[ND0];
#pragma unroll
    for (int d = 0; d < NVB; ++d) o[d] = f32x16{};
    ol = f32x16{}; negm = f32x16{};
    const u32x4 ones_w = {0x3F803F80u, 0x3F803F80u, 0x3F803F80u, 0x3F803F80u}; const bf16x8 ones = *reinterpret_cast<const bf16x8*>(&ones_w);
    const u16* Qw = Qb + (long)(wid * 32 + r32) * DK + hi * 8;
#pragma unroll
    for (int d0 = 0; d0 < ND0; ++d0) qr[d0] = *reinterpret_cast<const bf16x8*>(Qw + d0 * 16);
    const u16* src[3]; int dst[3], stp[3]; bool isk[3];
#pragma unroll
    for (int i = 0; i < 3; ++i) { int q = wid + 8 * i; if (q >= NI) q -= 8;
        if (q < NKI) { const int blk = q >> 2, part = q & 3, row = 16 * part + (lane >> 2), c = (lane & 3) ^ ((row >> 2) & 3);
            isk[i] = true; dst[i] = blk * 4096 + part * 1024 + lane * 16;
            if (DK == 96 && blk == 2) { src[i] = Kb + row * 32 + c * 8; stp[i] = 64 * 32; } else { src[i] = Ka + row * 64 + blk * 32 + c * 8; stp[i] = 64 * 64; } }
        else { const int v = q - NKI; int key, col;
            if (NVB == 2) { key = 8 * v + ((lane & 31) >> 2); col = (lane >> 5) * 32 + (lane & 3) * 8; }
            else { key = 8 * (v >> 1) + ((lane & 31) >> 2); col = ((v & 1) * 2 + (lane >> 5)) * 32 + (lane & 3) * 8; }
            isk[i] = false; dst[i] = 3 * C::KBYTES + v * 1024 + lane * 16; src[i] = Vh + key * DV + col; stp[i] = 64 * DV; } }
    const int NT = nkeys / 64;
#define LOADG(kt, vt) do { const int _kt = (kt) < NT ? (kt) : NT - 1, _vt = (vt) < NT ? (vt) : NT - 1; const int _ks = _kt % 3, _vs = _vt % 3; \
        _Pragma("unroll") for (int _i = 0; _i < 3; ++_i) { const int _t = isk[_i] ? _kt : _vt; const int _so = isk[_i] ? _ks * C::KBYTES : _vs * C::VBYTES; \
            __builtin_amdgcn_global_load_lds((const unsigned*)(src[_i] + (long)_t * stp[_i]), (unsigned*)(lds + _so + dst[_i]), 16, 0, 0); } } while (0)
#define RESC(a) do { if (__any((a) < 1.f)) { if (hi == 0) al_l[r32] = (a); asm volatile("s_waitcnt lgkmcnt(0)" ::: "memory"); \
        _Pragma("unroll") for (int r = 0; r < 16; ++r) { const float _f = al_l[crow(r, hi)]; ol[r] *= _f; _Pragma("unroll") for (int d = 0; d < NVB; ++d) o[d][r] *= _f; } } } while (0)
#define PVL(vb) do { pv_all<NVB>(o, (vb), pa0, pa1, pa2, pa3); \
        ol = __builtin_amdgcn_mfma_f32_32x32x16_bf16(pa0, ones, ol, 0, 0, 0); ol = __builtin_amdgcn_mfma_f32_32x32x16_bf16(pa1, ones, ol, 0, 0, 0); \
        ol = __builtin_amdgcn_mfma_f32_32x32x16_bf16(pa2, ones, ol, 0, 0, 0); ol = __builtin_amdgcn_mfma_f32_32x32x16_bf16(pa3, ones, ol, 0, 0, 0); } while (0)
#define NEGM() do { if constexpr (DV == 128) { _Pragma("unroll") for (int r = 0; r < 16; ++r) negm[r] = -m_reg; } } while (0)
#define TILEBAR(n) do { if ((n) == 3) asm volatile("s_waitcnt vmcnt(3)" ::: "memory"); else asm volatile("s_waitcnt vmcnt(0)" ::: "memory"); __builtin_amdgcn_s_barrier(); asm volatile("" ::: "memory"); } while (0)
    const int vrb = (int)(uintptr_t)V_lds + v_rd_base(lane);
    f32x16 pA0, pA1, pB0, pB1; float alA, alB; bf16x8 pa0, pa1, pa2, pa3;
    __syncthreads();
    LOADG(0, 0); LOADG(1, 0);
    TILEBAR(3); LOADG(2, 1);
    qkt<ND0>(pA0, pA1, K_lds, qr, r32, hi, negm); psm_rel<true, DV != 128>(pA0, pA1, m_reg, negm, alA);
    int ks = 1, vs = 0;
    for (int j = 1; j + 1 < NT; j += 2) {
        TILEBAR(3); LOADG(j + 2, j + 1);
        SBAR(); NEGM(); qkt<ND0>(pB0, pB1, K_lds + ks * C::KBYTES, qr, r32, hi, negm);
        fsm_rel(pA0, pA1, pa0, pa1, pa2, pa3); SBAR();
        PVL(vrb + vs * C::VBYTES); psm_rel<false, DV != 128>(pB0, pB1, m_reg, negm, alB);
        RESC(alB);
        ks = ks == 2 ? 0 : ks + 1; vs = vs == 2 ? 0 : vs + 1;
        TILEBAR(3); LOADG(j + 3, j + 2);
        SBAR(); NEGM(); qkt<ND0>(pA0, pA1, K_lds + ks * C::KBYTES, qr, r32, hi, negm);
        fsm_rel(pB0, pB1, pa0, pa1, pa2, pa3); SBAR();
        PVL(vrb + vs * C::VBYTES); psm_rel<false, DV != 128>(pA0, pA1, m_reg, negm, alA);
        RESC(alA);
        ks = ks == 2 ? 0 : ks + 1; vs = vs == 2 ? 0 : vs + 1;
    }
    TILEBAR(3);
    SBAR(); NEGM(); qkt<ND0>(pB0, pB1, K_lds + ks * C::KBYTES, qr, r32, hi, negm);
    fsm_rel(pA0, pA1, pa0, pa1, pa2, pa3); SBAR();
    PVL(vrb + vs * C::VBYTES); psm_rel<false, DV != 128>(pB0, pB1, m_reg, negm, alB);
    RESC(alB);
    vs = vs == 2 ? 0 : vs + 1;
    TILEBAR(0);
    fsm_rel(pB0, pB1, pa0, pa1, pa2, pa3); SBAR();
    PVL(vrb + vs * C::VBYTES);
    u16* Ow = Ob + (long)(wid * 32) * ldo;
#pragma unroll
    for (int r = 0; r < 16; ++r) { const int orow = crow(r, hi); const float rl = __builtin_amdgcn_rcpf(ol[r]);
#pragma unroll
        for (int d0 = 0; d0 < NVB; ++d0) Ow[(long)orow * ldo + d0 * 32 + r32] = f2bf(o[d0][r] * rl); }
#undef LOADG
#undef RESC
#undef PVL
#undef NEGM
#undef TILEBAR
}

struct Frame {
    const Params* p; unsigned char* ws; char* lds; float* out; int G, bx;
    __device__ __forceinline__ const float* in(int i) const { return p->in[i]; }
    template <class T> __device__ __forceinline__ T* W(size_t off) const { return (T*)(ws + off); }
};
constexpr int LDS_BYTES = 163840;
constexpr int LDS_BARW  = LDS_BYTES - 16;
constexpr int LDS_TAB   = 147456;

struct ResCtx { const char* src0; long srcd; char* dst0; long dstd; const float* mods;
    __device__ __forceinline__ const float* row_in(int row, int) const { return (const float*)(src0 + (row >= NCTX ? srcd : 0L) + (long)row * (DM * 4)); }
    __device__ __forceinline__ float* row_out(int row) const { return (float*)(dst0 + (row >= NCTX ? dstd : 0L) + (long)row * (DM * 4)); }
    __device__ __forceinline__ const float* mod(int li, int row, int which) const {
        const int mr = row < NCTX ? 4 : ((row - NCTX) >> 13); return mods + (size_t)(li * 5 + mr) * 6144 + which * 1024; }
};
__device__ __forceinline__ ResCtx res_ctx(const Frame& F, bool first = false) {
    const char* sc = (const char*)(first ? F.in(2) : (const float*)F.W<float>(WS_XC)); const char* sl = (const char*)(first ? F.in(0) : (const float*)F.out) - (long)NCTX * DM * 4;
    char* dc = (char*)F.W<float>(WS_XC); char* dl = (char*)F.out - (long)NCTX * DM * 4;
    return ResCtx{sc, (long)(sl - sc), dc, (long)(dl - dc), F.W<float>(WS_MODS)};
}
__device__ __forceinline__ const float* xrow_in(const Frame& F, int row, bool first) { return res_ctx(F, first).row_in(row, 0); }
__device__ __forceinline__ float* xrow_out(const Frame& F, int row) { return res_ctx(F).row_out(row); }
__device__ __forceinline__ const float* mod_vec(const Frame& F, int li, int row, int which) { return res_ctx(F).mod(li, row, which); }

__device__ __forceinline__ void p0_mods(const Frame& F) {
    float* s = (float*)F.lds; float* red = s + 5 * 1024;
    const int tid = threadIdx.x, lane = tid & 63, wid = tid >> 6;
    for (int i = tid; i < 5 * 1024; i += NTHR) { const int r = i >> 10, k = i & 1023; const float v = r < 4 ? F.in(1)[r * 1024 + k] : F.in(3)[k]; s[i] = silu_f(v); }
    __syncthreads();
    for (int item = F.bx; item < DEPTH * 96; item += F.G) {
        const int li = item / 96, cg = item % 96;
        const float* w = F.in(4) + (size_t)li * 1024 * 6144 + cg * 64 + lane;
        float a0 = 0, a1 = 0, a2 = 0, a3 = 0, a4 = 0;
        const int k0 = wid * 128;
#pragma unroll 8
        for (int k = k0; k < k0 + 128; ++k) {
            const float wv = w[(size_t)k * 6144];
            a0 += s[k] * wv; a1 += s[1024 + k] * wv; a2 += s[2048 + k] * wv; a3 += s[3072 + k] * wv; a4 += s[4096 + k] * wv;
        }
        red[(wid * 5 + 0) * 64 + lane] = a0; red[(wid * 5 + 1) * 64 + lane] = a1; red[(wid * 5 + 2) * 64 + lane] = a2;
        red[(wid * 5 + 3) * 64 + lane] = a3; red[(wid * 5 + 4) * 64 + lane] = a4;
        __syncthreads();
        if (tid < 320) { const int r = tid >> 6, l = tid & 63; float sum = 0;
#pragma unroll
            for (int ww = 0; ww < 8; ++ww) sum += red[(ww * 5 + r) * 64 + l];
            F.W<float>(WS_MODS)[(size_t)(li * 5 + r) * 6144 + cg * 64 + l] = sum + F.in(5)[li * 6144 + cg * 64 + l]; }
        __syncthreads();
    }
}
__device__ __forceinline__ void p0_rope(const Frame& F) {
    const int gt = F.bx * NTHR + threadIdx.x, gn = F.G * NTHR;
    float* ca = F.W<float>(WS_ROPEA); float* sa = ca + SEQ * 16; float* cb = F.W<float>(WS_ROPEB); float* sb = cb + SEQ * 32;
    for (int i = gt; i < SEQ * 48; i += gn) {
        int n, f, nf; float* co; float* so; int idx;
        if (i < SEQ * 16) { n = i >> 4; f = i & 15; nf = 8; co = ca; so = sa; idx = i; }
        else { const int j = i - SEQ * 16; n = j >> 5; f = j & 31; nf = 16; co = cb; so = sb; idx = j; }
        const int fi = f % nf; const float pos = (f < nf) ? (float)(n >> 6) : (float)(n & 63);
        const float invf = exp2f(-(float)fi / (float)nf * 13.287712379549449f);
        const float ang = pos * invf;
        float rev = ang * 0.15915494309189535f; rev -= floorf(rev);
        co[idx] = __builtin_amdgcn_cosf(rev); so[idx] = __builtin_amdgcn_sinf(rev);
    }
}
__device__ __forceinline__ int rowmap(int n, int kind) { return kind == 0 ? n : ((n >> 5) * 64 + (kind == 2 ? 32 : 0) + (n & 31)); }
__device__ __forceinline__ void cvt_group(float* tl, const float* src, int K, int N, u16* dst, int ldd, int kind, int t0) {
    int tid = threadIdx.x; asm volatile("" : "+v"(tid));
    const int tn = (N + 63) / 64, nt = (K / 64) * tn;
    f32x4 v[4][2];
#pragma unroll
    for (int u = 0; u < 4; ++u) { const int t = t0 + u; const int k0 = (t / tn) * 64, n0 = (t % tn) * 64;
#pragma unroll
        for (int ps = 0; ps < 2; ++ps) { const int k = (tid >> 4) + ps * 32, n4 = (tid & 15) * 4;
            if (t < nt && n0 + n4 < N) v[u][ps] = *(const f32x4*)(src + (size_t)(k0 + k) * N + n0 + n4); else v[u][ps] = f32x4{0.f, 0.f, 0.f, 0.f}; } }
#pragma unroll
    for (int u = 0; u < 4; ++u)
#pragma unroll
        for (int ps = 0; ps < 2; ++ps) { const int k = (tid >> 4) + ps * 32, n4 = (tid & 15) * 4; float* d = tl + u * 4160 + k * 65 + n4;
            d[0] = v[u][ps][0]; d[1] = v[u][ps][1]; d[2] = v[u][ps][2]; d[3] = v[u][ps][3]; }
    __syncthreads();
#pragma unroll
    for (int u = 0; u < 4; ++u) { const int t = t0 + u; const int k0 = (t / tn) * 64, n0 = (t % tn) * 64;
        const int n = tid >> 3, kc = (tid & 7) * 8; const float* sr = tl + u * 4160;
        if (t < nt && n0 + n < N) { u32x4 w;
#pragma unroll
            for (int i = 0; i < 4; ++i) w[i] = cvtpk(sr[(kc + 2 * i) * 65 + n], sr[(kc + 2 * i + 1) * 65 + n]);
            *(u32x4*)(dst + (size_t)rowmap(n0 + n, kind) * ldd + k0 + kc) = w; } }
    __syncthreads();
}
__device__ __forceinline__ void cvt_t(const Frame& F, const float* src, int K, int N, u16* dst, int ldd, int kind, int rot) {
    const int tn = (N + 63) / 64, nt = (K / 64) * tn;
    for (int t0 = ((F.bx + rot) % F.G) * 4; t0 < nt; t0 += F.G * 4) cvt_group((float*)F.lds, src, K, N, dst, ldd, kind, t0);
}
constexpr int MOE_CVT_GROUPS = 16 * 3 * 32, LDS_CVT = 81920;
__device__ __forceinline__ void moe_cvt_group(const Frame& F, int li, int gidx) {
    if (gidx >= MOE_CVT_GROUPS) return;
    const int mat = gidx >> 5, g = gidx & 31, e = mat / 3, kind = mat - e * 3; float* tl = (float*)(F.lds + LDS_CVT);
    if (kind == 0) cvt_group(tl, F.in(27) + (size_t)(li * 16 + e) * 1024 * 512, 1024, 512, F.W<u16>(WS_MOEW) + (size_t)e * 1024 * 1024, 1024, 1, g * 4);
    else if (kind == 1) cvt_group(tl, F.in(28) + (size_t)(li * 16 + e) * 1024 * 512, 1024, 512, F.W<u16>(WS_MOEW) + (size_t)e * 1024 * 1024, 1024, 2, g * 4);
    else cvt_group(tl, F.in(29) + (size_t)(li * 16 + e) * 512 * 1024, 512, 1024, F.W<u16>(WS_MOEW + MOE_WGU_BYTES) + (size_t)e * 1024 * 512, 512, 0, g * 4);
}
__device__ __forceinline__ void p0_weights(const Frame& F) {
    int rot = 0;
    for (int j = 0; j < 2; ++j) {
        cvt_t(F, F.in(8) + (size_t)j * 1024 * 544, 1024, 544, F.W<u16>(WS_WDQKV) + (size_t)j * 640 * 1024, 1024, 0, rot); rot += 36;
        cvt_t(F, F.in(10) + (size_t)j * 256 * 1536, 256, 1536, F.W<u16>(WS_WUQ) + (size_t)j * 1536 * 256, 256, 0, rot); rot += 24;
        cvt_t(F, F.in(12) + (size_t)j * 256 * 2048, 256, 2048, F.W<u16>(WS_WUKV) + (size_t)j * 2048 * 256, 256, 0, rot); rot += 32;
        cvt_t(F, F.in(13) + (size_t)j * 1024 * 1024, 1024, 1024, F.W<u16>(WS_WOM) + (size_t)j * 1024 * 1024, 1024, 0, rot);
    }
    cvt_t(F, F.in(14), 1024, 3072, F.W<u16>(WS_WQKVD), 1024, 0, rot);
    cvt_t(F, F.in(17), 1024, 1024, F.W<u16>(WS_WOD), 1024, 0, rot);
    cvt_t(F, F.in(18), 1024, 3104, F.W<u16>(WS_WING), 1024, 0, rot); rot += 4;
    cvt_t(F, F.in(22), 1024, 1024, F.W<u16>(WS_WOG), 1024, 0, rot);
}
__device__ __forceinline__ void moe_weights(const Frame& F, int li) {
    for (int g = F.bx; g < MOE_CVT_GROUPS; g += F.G) moe_cvt_group(F, li, g);
}

#define DPP_ADD(v, CTRL) (v) += __uint_as_float(__builtin_amdgcn_update_dpp(0u, __float_as_uint(v), (CTRL), 0xF, 0xF, false))
__device__ __forceinline__ float wave_sum_fast(float v) {
    DPP_ADD(v, 0xB1); DPP_ADD(v, 0x4E); DPP_ADD(v, 0x141); DPP_ADD(v, 0x140);
    { auto rr = __builtin_amdgcn_permlane16_swap(__float_as_uint(v), __float_as_uint(v), false, false); v = __uint_as_float(rr[0]) + __uint_as_float(rr[1]); }
    { auto rr = __builtin_amdgcn_permlane32_swap(__float_as_uint(v), __float_as_uint(v), false, false); v = __uint_as_float(rr[0]) + __uint_as_float(rr[1]); }
    return v;
}
constexpr int RT_WG = 0, RT_WR = 16384, RT_REC = 81920, RT_CNT = 81920 + 4096, RT_BASE = RT_CNT + 128;
template <bool ROUTE>
__device__ __forceinline__ void norm_phase(const Frame& F, int li, int row_begin, bool first) {
    const int tid = threadIdx.x, lane = tid & 63, wid = tid >> 6;
    const float* gain = F.in(ROUTE ? 7 : 6) + li * DM;
    u16* H = F.W<u16>(WS_H);
    const int per_block = (NTOK - row_begin + F.G - 1) / F.G;
    const int blk0 = row_begin + F.bx * per_block; int blk1 = blk0 + per_block; if (blk1 > NTOK) blk1 = NTOK;
    f32x4* wgL = (f32x4*)(F.lds + RT_WG); f32x4* wrL = (f32x4*)(F.lds + RT_WR); u32x4* recL = (u32x4*)(F.lds + RT_REC);
    unsigned* cntL = (unsigned*)(F.lds + RT_CNT); unsigned* baseL = (unsigned*)(F.lds + RT_BASE);
    if constexpr (ROUTE) {
        __syncthreads();
        const f32x4* wg = (const f32x4*)(F.in(23) + (size_t)li * DM * 4); const f32x4* wr = (const f32x4*)(F.in(25) + (size_t)li * 4 * DM * 4);
        for (int e = tid; e < 1024; e += NTHR) { const int d = ((e >> 8) * 4 + (e & 3)) * 64 + ((e >> 2) & 63); wgL[d] = wg[e]; }
        for (int e = tid; e < 4096; e += NTHR) { const int g = e >> 10, c = e & 1023; const int d = g * 1024 + ((c >> 8) * 4 + (c & 3)) * 64 + ((c >> 2) & 63); wrL[d] = wr[e]; }
        if (tid < 32) cntL[tid] = 0u;
        __syncthreads();
    }
    for (int it = 0; it * 32 < per_block; ++it) {
        int rows[4]; bool ok[4]; f32x4 v[4][4];
#pragma unroll
        for (int u = 0; u < 4; ++u) { rows[u] = blk0 + wid + 8 * (4 * it + u); ok[u] = rows[u] < blk1; if (!ok[u]) rows[u] = blk0; }
#pragma unroll
        for (int u = 0; u < 4; ++u) { const float* xr = xrow_in(F, rows[u], first);
#pragma unroll
            for (int i = 0; i < 4; ++i) v[u][i] = *(const f32x4*)(xr + i * 256 + lane * 4); }
#pragma unroll
        for (int u = 0; u < 4; ++u) {
            const int row = rows[u];
            float ss = 0;
#pragma unroll
            for (int i = 0; i < 4; ++i) ss += v[u][i][0] * v[u][i][0] + v[u][i][1] * v[u][i][1] + v[u][i][2] * v[u][i][2] + v[u][i][3] * v[u][i][3];
            ss = wave_sum_fast(ss);
            const float rinv = rsqrtf(ss * (1.f / DM) + EPS);
            const float* sh = mod_vec(F, li, row, ROUTE ? 3 : 0); const float* sc = mod_vec(F, li, row, ROUTE ? 4 : 1);
            float hv[16];
#pragma unroll
            for (int i = 0; i < 4; ++i) { const int c = i * 256 + lane * 4;
                const f32x4 g = *(const f32x4*)(gain + c), s1 = *(const f32x4*)(sc + c), s0 = *(const f32x4*)(sh + c);
#pragma unroll
                for (int j = 0; j < 4; ++j) hv[i * 4 + j] = (v[u][i][j] * rinv * g[j]) * (1.f + s1[j]) + s0[j];
                if (ok[u]) { u32x2 w = {cvtpk(hv[i * 4], hv[i * 4 + 1]), cvtpk(hv[i * 4 + 2], hv[i * 4 + 3])}; *(u32x2*)(H + (size_t)row * DM + c) = w; } }
            if constexpr (ROUTE) {
                float gl[4] = {0, 0, 0, 0};
#pragma unroll
                for (int q = 0; q < 16; ++q) { const f32x4 w4 = wgL[q * 64 + lane]; const float h = hv[q];
                    gl[0] += h * w4[0]; gl[1] += h * w4[1]; gl[2] += h * w4[2]; gl[3] += h * w4[3]; }
#pragma unroll
                for (int g = 0; g < 4; ++g) gl[g] = wave_sum_fast(gl[g]) + F.in(24)[li * 4 + g];
                int gi = 0; float gm = gl[0];
#pragma unroll
                for (int g = 1; g < 4; ++g) if (gl[g] > gm) { gm = gl[g]; gi = g; }
                gi = __builtin_amdgcn_readfirstlane(gi);
                float den = 0;
#pragma unroll
                for (int g = 0; g < 4; ++g) den += __expf(gl[g] - gm);
                const float grp_w = 1.f / den;
                float el[4] = {0, 0, 0, 0};
                const f32x4* wrg = wrL + gi * 1024;
#pragma unroll
                for (int q = 0; q < 16; ++q) { const f32x4 w4 = wrg[q * 64 + lane]; const float h = hv[q];
                    el[0] += h * w4[0]; el[1] += h * w4[1]; el[2] += h * w4[2]; el[3] += h * w4[3]; }
#pragma unroll
                for (int e = 0; e < 4; ++e) el[e] = wave_sum_fast(el[e]) + F.in(26)[(li * 4 + gi) * 4 + e];
                int i1 = 0; float v1 = el[0];
#pragma unroll
                for (int e = 1; e < 4; ++e) if (el[e] > v1) { v1 = el[e]; i1 = e; }
                int i2 = -1; float v2 = -3.0e38f;
#pragma unroll
                for (int e = 0; e < 4; ++e) if (e != i1 && el[e] > v2) { v2 = el[e]; i2 = e; }
                const float t = __expf(v2 - v1); const float w1 = grp_w / (1.f + t), w2 = grp_w * t / (1.f + t);
                const int elo = i1 < i2 ? i1 : i2, ehi = i1 < i2 ? i2 : i1;
                const float wlo = i1 < i2 ? w1 : w2, whi = i1 < i2 ? w2 : w1;
                const int pr = elo == 0 ? ehi - 1 : (elo == 1 ? ehi + 1 : 5);
                const int cls = gi * 6 + pr;
                if (lane == 0 && ok[u]) {
                    const unsigned rank = atomicAdd(&cntL[cls], 1u);
                    u32x4 rec = {(unsigned)cls, rank, __float_as_uint(wlo), __float_as_uint(whi)};
                    recL[row - blk0] = rec;
                }
            }
        }
    }
    if constexpr (ROUTE) {
        __syncthreads();
        if (tid < 24) baseL[tid] = atomicAdd(F.W<unsigned>(WS_CTL) + CW_CNT + li * 32 + tid, cntL[tid]);
        __syncthreads();
        for (int t = tid; t < blk1 - blk0; t += NTHR) { u32x4 rec = recL[t]; rec[1] += baseL[rec[0]];
            *(u32x4*)(F.W<unsigned char>(WS_TOK) + (size_t)(blk0 + t) * 16) = rec; }
    }
}

__device__ __forceinline__ void moe_table(const Frame& F, int li, int* tab) {
    if (threadIdx.x == 0) {
        const unsigned* cnt = F.W<unsigned>(WS_CTL) + CW_CNT + li * 32; int off = 0;
        for (int c = 0; c < 24; ++c) { tab[c] = off; const int n = (int)cnt[c]; const int nt = (n + 255) >> 8;
            for (int t = 0; t < nt; ++t) tab[32 + (off >> 8) + t] = c; off += nt << 8; }
        tab[24] = off;
    }
    __syncthreads();
}
__device__ __forceinline__ void moe_scatter(const Frame& F, int li, int row_begin) {
    int* tab = (int*)(F.lds + LDS_TAB);
    moe_table(F, li, tab);
    const unsigned* cnt = F.W<unsigned>(WS_CTL) + CW_CNT + li * 32;
    int* rowtok = F.W<int>(WS_ROWTOK); float* roww = F.W<float>(WS_ROWW);
    const int gt = F.bx * NTHR + threadIdx.x, gn = F.G * NTHR;
    for (int t = row_begin + gt; t < NTOK; t += gn) {
        const u32x4 rec = *(const u32x4*)(F.W<unsigned char>(WS_TOK) + (size_t)t * 16);
        const int r = tab[rec[0]] + (int)rec[1];
        rowtok[r] = t; roww[2 * r] = __uint_as_float(rec[2]); roww[2 * r + 1] = __uint_as_float(rec[3]);
    }
    for (int i = gt; i < 24 * 256; i += gn) { const int c = i >> 8, j = i & 255; const int r = tab[c] + (int)cnt[c] + j;
        const int end = tab[c] + ((((int)cnt[c]) + 255) & ~255);
        if (r < end) { rowtok[r] = -1; roww[2 * r] = 0.f; roww[2 * r + 1] = 0.f; } }
    __syncthreads();
}

#define EPI_ID const int r32 = lane & 31, hi = lane >> 5
__device__ __forceinline__ u32x2 pack4(float a, float b, float c, float d) { u32x2 w = {cvtpk(a, b), cvtpk(c, d)}; return w; }
template <int NF> __device__ __forceinline__ void rope_cs(int n, int i, float& cs, float& sn) {
    const int fi = i & (NF - 1); const float pos = (i < NF) ? (float)(n >> 6) : (float)(n & 63);
    const float invf = __builtin_amdgcn_exp2f(-(float)fi / (float)NF * 13.287712379549449f);
    const float ang = pos * invf; float rev = ang * 0.15915494309189535f; rev -= floorf(rev);
    cs = __builtin_amdgcn_cosf(rev); sn = __builtin_amdgcn_sinf(rev);
}
struct EpiF32 { float* dst; int ld, ncols;
    __device__ __forceinline__ int operator()(f32x16 (&acc)[2][2], int row0, int col0, int lane) const { EPI_ID;
#pragma unroll
        for (int mi = 0; mi < 2; ++mi) { float* o = dst + (size_t)(row0 + mi * 32 + r32) * ld + col0 + 4 * hi;
#pragma unroll
            for (int ni = 0; ni < 2; ++ni) if (col0 + ni * 32 < ncols) {
#pragma unroll
                for (int g = 0; g < 4; ++g) { f32x4 v = {acc[mi][ni][4 * g], acc[mi][ni][4 * g + 1], acc[mi][ni][4 * g + 2], acc[mi][ni][4 * g + 3]}; *(f32x4*)(o + ni * 32 + 8 * g) = v; } } }
        return 0;
    } };
struct EpiMlaQ { u16* Q; const float* cosA; const float* sinA; float scale;
    __device__ __forceinline__ int operator()(f32x16 (&acc)[2][2], int row0, int col0, int lane) const { EPI_ID; const bool lat = row0 >= NCTX;
#pragma unroll
        for (int mi = 0; mi < 2; ++mi) { const int row = row0 + mi * 32 + r32; int b, pos; row_bp(row, b, pos); const int n = (row - NCTX) & (SEQ - 1);
            u16* qrow = Q + ((size_t)(b * 16) * KEYS + pos) * 96 + 4 * hi;
#pragma unroll
            for (int ni = 0; ni < 2; ++ni) { const int s = (col0 >> 5) + ni, head = s / 3, part = s - head * 3; u16* o = qrow + (size_t)head * KEYS * 96 + part * 32;
                float v[16];
#pragma unroll
                for (int r = 0; r < 16; ++r) v[r] = acc[mi][ni][r] * scale;
                if (part == 2 && lat) {
#pragma unroll
                    for (int g = 0; g < 2; ++g) {
#pragma unroll
                        for (int j = 0; j < 4; ++j) { float cs, sn; rope_cs<8>(n, 8 * g + 4 * hi + j, cs, sn);
                            const float t1 = v[4 * g + j], t2 = v[4 * (g + 2) + j]; v[4 * g + j] = t1 * cs - t2 * sn; v[4 * (g + 2) + j] = t1 * sn + t2 * cs; } } }
#pragma unroll
                for (int g = 0; g < 4; ++g) *(u32x2*)(o + 8 * g) = pack4(v[4 * g], v[4 * g + 1], v[4 * g + 2], v[4 * g + 3]); } }
        return 16;
    } };
struct EpiMlaKV { u16* Kn; long vdelta;
    __device__ __forceinline__ int operator()(f32x16 (&acc)[2][2], int row0, int col0, int lane) const { EPI_ID; const int head = col0 >> 7; u16* dst = Kn + (long)((col0 >> 6) & 1) * vdelta;
#pragma unroll
        for (int mi = 0; mi < 2; ++mi) { const int row = row0 + mi * 32 + r32; int b, pos; row_bp(row, b, pos);
            u16* o = dst + ((size_t)(b * 16 + head) * KEYS + pos) * 64 + 4 * hi;
#pragma unroll
            for (int ni = 0; ni < 2; ++ni)
#pragma unroll
                for (int g = 0; g < 4; ++g) *(u32x2*)(o + ni * 32 + 8 * g) = pack4(acc[mi][ni][4 * g], acc[mi][ni][4 * g + 1], acc[mi][ni][4 * g + 2], acc[mi][ni][4 * g + 3]); }
        return 16;
    } };
struct EpiResid { ResCtx F; int li, which, first;
    __device__ __forceinline__ int operator()(f32x16 (&acc)[2][2], int row0, int col0, int lane) const { EPI_ID;
#pragma unroll
        for (int mi = 0; mi < 2; ++mi) { const int row = row0 + mi * 32 + r32;
            const float* xi = F.row_in(row, first) + col0 + 4 * hi; float* xo = F.row_out(row) + col0 + 4 * hi; const float* gt = F.mod(li, row, which) + col0 + 4 * hi;
#pragma unroll
            for (int ni = 0; ni < 2; ++ni)
#pragma unroll
                for (int g = 0; g < 4; ++g) { const int c = ni * 32 + 8 * g; const f32x4 x = *(const f32x4*)(xi + c), gg = *(const f32x4*)(gt + c);
                    f32x4 o = {x[0] + gg[0] * acc[mi][ni][4 * g], x[1] + gg[1] * acc[mi][ni][4 * g + 1], x[2] + gg[2] * acc[mi][ni][4 * g + 2], x[3] + gg[3] * acc[mi][ni][4 * g + 3]};
                    *(f32x4*)(xo + c) = o; } }
        return 48;
    } };
struct EpiMoeB { ResCtx F; int li; const int* rowtok;
    __device__ __forceinline__ int operator()(f32x16 (&acc)[2][2], int row0, int col0, int lane) const { EPI_ID;
#pragma unroll
        for (int mi = 0; mi < 2; ++mi) { const int tok = rowtok[row0 + mi * 32 + r32];
            if (tok >= 0) { float* xo = F.row_out(tok) + col0 + 4 * hi; const float* gt = F.mod(li, tok, 5) + col0 + 4 * hi;
#pragma unroll
                for (int ni = 0; ni < 2; ++ni)
#pragma unroll
                    for (int g = 0; g < 4; ++g) { const int c = ni * 32 + 8 * g; const f32x4 x = *(const f32x4*)(xo + c), gg = *(const f32x4*)(gt + c);
                        f32x4 o = {x[0] + gg[0] * acc[mi][ni][4 * g], x[1] + gg[1] * acc[mi][ni][4 * g + 1], x[2] + gg[2] * acc[mi][ni][4 * g + 2], x[3] + gg[3] * acc[mi][ni][4 * g + 3]};
                        *(f32x4*)(xo + c) = o; } } }
        return 0;
    } };
struct EpiMoeA { u16* act; const float* roww; int half, acol0;
    __device__ __forceinline__ int operator()(f32x16 (&acc)[2][2], int row0, int col0, int lane) const { EPI_ID;
#pragma unroll
        for (int mi = 0; mi < 2; ++mi) { const int row = row0 + mi * 32 + r32; const float w = roww[2 * row + half];
            u16* o = act + (size_t)row * 1024 + acol0 + (col0 >> 6) * 32 + 4 * hi;
#pragma unroll
            for (int g = 0; g < 4; ++g) { float v[4];
#pragma unroll
                for (int j = 0; j < 4; ++j) v[j] = silu_f(acc[mi][0][4 * g + j]) * acc[mi][1][4 * g + j] * w;
                *(u32x2*)(o + 8 * g) = pack4(v[0], v[1], v[2], v[3]); } }
        return 8;
    } };
struct EpiDiffQKV { u16* Q; long kdelta; u16* V; const float* cosB; const float* sinB; float qscale;
    __device__ __forceinline__ int operator()(f32x16 (&acc)[2][2], int row0, int col0, int lane) const { EPI_ID; const int region = col0 >> 10; const bool lat = row0 >= NCTX;
#pragma unroll
        for (int mi = 0; mi < 2; ++mi) { const int row = row0 + mi * 32 + r32; int b, pos; row_bp(row, b, pos); const int n = (row - NCTX) & (SEQ - 1);
            if (region < 2) {
                const int hh = (col0 & 1023) >> 6; const float sc = region == 0 ? qscale : 1.f;
                u16* o = Q + (long)region * kdelta + ((size_t)(b * 16 + hh) * KEYS + pos) * 64 + 4 * hi;
#pragma unroll
                for (int g = 0; g < 4; ++g) {
                    float o1[4], o2[4];
#pragma unroll
                    for (int j = 0; j < 4; ++j) { float cs = 1.f, sn = 0.f; if (lat) rope_cs<16>(n, 8 * g + 4 * hi + j, cs, sn);
                        const float t1 = acc[mi][0][4 * g + j], t2 = acc[mi][1][4 * g + j]; o1[j] = (t1 * cs - t2 * sn) * sc; o2[j] = (t1 * sn + t2 * cs) * sc; }
                    *(u32x2*)(o + 8 * g) = pack4(o1[0], o1[1], o1[2], o1[3]); *(u32x2*)(o + 32 + 8 * g) = pack4(o2[0], o2[1], o2[2], o2[3]); }
            } else {
                const int cv = col0 - 2048, head = cv >> 7;
                u16* o = V + ((size_t)(b * 8 + head) * KEYS + pos) * 128 + (cv & 127) + 4 * hi;
#pragma unroll
                for (int ni = 0; ni < 2; ++ni)
#pragma unroll
                    for (int g = 0; g < 4; ++g) *(u32x2*)(o + ni * 32 + 8 * g) = pack4(acc[mi][ni][4 * g], acc[mi][ni][4 * g + 1], acc[mi][ni][4 * g + 2], acc[mi][ni][4 * g + 3]);
            } }
        return 16;
    } };
struct EpiGlaIn { u16* q; u16* k; u16* v; u16* g; float* z;
    __device__ __forceinline__ int operator()(f32x16 (&acc)[2][2], int row0, int col0, int lane) const { EPI_ID;
#pragma unroll
        for (int mi = 0; mi < 2; ++mi) { const size_t row = row0 + mi * 32 + r32;
            if (col0 < 3072) {
                u16* o; float sc = 1.f;
                if (col0 < 512) { o = q + row * 512 + col0; sc = 0.08838834764831845f; } else if (col0 < 1024) o = k + row * 512 + (col0 - 512);
                else if (col0 < 2048) o = v + row * 1024 + (col0 - 1024); else o = g + row * 1024 + (col0 - 2048);
                o += 4 * hi;
#pragma unroll
                for (int ni = 0; ni < 2; ++ni)
#pragma unroll
                    for (int gg = 0; gg < 4; ++gg) *(u32x2*)(o + ni * 32 + 8 * gg) = pack4(acc[mi][ni][4 * gg] * sc, acc[mi][ni][4 * gg + 1] * sc, acc[mi][ni][4 * gg + 2] * sc, acc[mi][ni][4 * gg + 3] * sc);
            } else if (col0 == 3072) {
                float* o = z + row * 32 + 4 * hi;
#pragma unroll
                for (int gg = 0; gg < 4; ++gg) { f32x4 t = {acc[mi][0][4 * gg], acc[mi][0][4 * gg + 1], acc[mi][0][4 * gg + 2], acc[mi][0][4 * gg + 3]}; *(f32x4*)(o + 8 * gg) = t; }
            } }
        return col0 < 3072 ? 16 : (col0 == 3072 ? 8 : 0);
    } };

template <int WM, int WN, class AL, class BL, class EP>
__device__ __forceinline__ void gemm_phase(const Frame& F, const AL al, const BL bl, EP& ep, int mt0, int mt1, int nN, int nk, int tile_off, int tile_total) {
    PlainTiles<AL, BL, EP> prov{al, bl, ep, mt0, mt1 - mt0, nN, F.bx, F.G}; (void)tile_off;
    gemm_stream<WM, WN>(F.lds, prov, nk);
    (void)tile_total;
}

__device__ __forceinline__ void mla_rowpass(const Frame& F, int j) {
    const int lane = threadIdx.x & 63, wid = threadIdx.x >> 6;
    const float* DQ = F.W<float>(MLA_DQ); u16* CN = F.W<u16>(MLA_CN); u16* KPE = F.W<u16>(MLA_KPE);
    const float* gq = F.in(9) + j * 256; const float* gk = F.in(11) + j * 256;
    const float* ca = F.W<float>(WS_ROPEA); const float* sa = ca + SEQ * 16;
    for (int row = F.bx * NWAVE + wid; row < NTOK; row += F.G * NWAVE) {
        const float* d = DQ + (size_t)row * 544;
        const f32x4 a = *(const f32x4*)(d + lane * 4), c = *(const f32x4*)(d + 256 + lane * 4);
        float sq = a[0] * a[0] + a[1] * a[1] + a[2] * a[2] + a[3] * a[3], sk = c[0] * c[0] + c[1] * c[1] + c[2] * c[2] + c[3] * c[3];
        sq = wave_sum(sq); sk = wave_sum(sk);
        const float rq = rsqrtf(sq * (1.f / 256.f) + EPS), rk = rsqrtf(sk * (1.f / 256.f) + EPS);
        const f32x4 g1 = *(const f32x4*)(gq + lane * 4), g2 = *(const f32x4*)(gk + lane * 4);
        u32x2 w1 = {cvtpk(a[0] * rq * g1[0], a[1] * rq * g1[1]), cvtpk(a[2] * rq * g1[2], a[3] * rq * g1[3])};
        u32x2 w2 = {cvtpk(c[0] * rk * g2[0], c[1] * rk * g2[1]), cvtpk(c[2] * rk * g2[2], c[3] * rk * g2[3])};
        *(u32x2*)(CN + (size_t)row * 512 + lane * 4) = w1; *(u32x2*)(CN + (size_t)row * 512 + 256 + lane * 4) = w2;
        if (lane < 16) { float t1 = d[512 + lane], t2 = d[528 + lane]; int b, pos; row_bp(row, b, pos);
            if (row >= NCTX) { const int n = (row - NCTX) & (SEQ - 1); const float cs = ca[n * 16 + lane], sn = sa[n * 16 + lane];
                const float o1 = t1 * cs - t2 * sn, o2 = t1 * sn + t2 * cs; t1 = o1; t2 = o2; }
            u16* o = KPE + ((size_t)b * KEYS + pos) * 32 + lane; o[0] = f2bf(t1); o[16] = f2bf(t2); }
    }
}
__device__ __forceinline__ int vcu_of(const Frame& F) { return (F.G % 8 == 0) ? (F.bx % 8) * (F.G / 8) + F.bx / 8 : F.bx; }
__device__ __forceinline__ void mla_attn(const Frame& F, bool ctx_out, int li) {
    const u16* Q = F.W<u16>(MLA_Q); const u16* Kn = F.W<u16>(MLA_KN); const u16* V = F.W<u16>(MLA_V); const u16* Kpe = F.W<u16>(MLA_KPE);
    u16* O = F.W<u16>(MLA_DQ);
    const int nit = 2048 + (ctx_out ? 64 : 0); int nrun = 0;
#pragma unroll 1
    for (int it = vcu_of(F); it < nit; it += F.G) {
        int b, h, qpos, nkeys, orow;
        if (it < 2048) { const int bh = it >> 5, qt = it & 31; b = bh >> 4; h = bh & 15; qpos = CTXL + qt * 256; nkeys = KEYS; orow = NCTX + b * SEQ + qt * 256; }
        else { const int jj = it - 2048; b = jj >> 4; h = jj & 15; qpos = 0; nkeys = CTXL; orow = b * CTXL; }
        const size_t bh = (size_t)(b * 16 + h);
        attn_item<96, 64>(Q + (bh * KEYS + qpos) * 96, Kn + bh * KEYS * 64, Kpe + (size_t)b * KEYS * 32, V + bh * KEYS * 64, nkeys,
                          O + (size_t)orow * DM + h * 64, DM, F.lds);
        moe_cvt_group(F, li, F.bx + nrun * F.G); ++nrun;
    }
    for (; F.bx + nrun * F.G < MOE_CVT_GROUPS; ++nrun) moe_cvt_group(F, li, F.bx + nrun * F.G);
}
__device__ __forceinline__ void diff_attn(const Frame& F, int li) {
    const u16* Q = F.W<u16>(DF_Q); const u16* K = F.W<u16>(DF_K); const u16* V = F.W<u16>(DF_V); u16* OS = F.W<u16>(DF_OS);
    const int nit = 2048 + 64; int nrun = 0;
#pragma unroll 1
    for (int it = vcu_of(F); it < nit; it += F.G) {
        int b, hh, qpos, nkeys, orow;
        if (it < 2048) { const int bh = it >> 5, qt = it & 31; b = bh >> 4; hh = bh & 15; qpos = CTXL + qt * 256; nkeys = KEYS; orow = NCTX + b * SEQ + qt * 256; }
        else { const int jj = it - 2048; b = jj >> 4; hh = jj & 15; qpos = 0; nkeys = CTXL; orow = b * CTXL; }
        const size_t bh = (size_t)(b * 16 + hh);
        attn_item<64, 128>(Q + (bh * KEYS + qpos) * 64, K + bh * KEYS * 64, nullptr, V + (size_t)(b * 8 + (hh >> 1)) * KEYS * 128, nkeys,
                           OS + (size_t)(hh & 1) * NTOK * DM + (size_t)orow * DM + (hh >> 1) * 128, DM, F.lds);
        moe_cvt_group(F, li, F.bx + nrun * F.G); ++nrun;
    }
    for (; F.bx + nrun * F.G < MOE_CVT_GROUPS; ++nrun) moe_cvt_group(F, li, F.bx + nrun * F.G);
}
__device__ __forceinline__ void diff_rowpass(const Frame& F, float lam_init) {
    const int lane = threadIdx.x & 63, wid = threadIdx.x >> 6;
    const u16* OS = F.W<u16>(DF_OS); u16* O = F.W<u16>(DF_Q);
    const float* lm = F.in(15);
    const float lam = __expf(wave_sum(lm[lane] * lm[64 + lane])) - __expf(wave_sum(lm[128 + lane] * lm[192 + lane])) + lam_init;
    const float post = 1.f - lam_init;
    float sg[16];
#pragma unroll
    for (int i = 0; i < 16; ++i) sg[i] = F.in(16)[(lane & 7) * 16 + i] * post;
    for (int row = F.bx * NWAVE + wid; row < NTOK; row += F.G * NWAVE) {
        const u16* p0 = OS + (size_t)row * DM + lane * 16; const u16* p1 = p0 + (size_t)NTOK * DM;
        const bf16x8 a0 = *(const bf16x8*)p0, a1 = *(const bf16x8*)(p0 + 8), b0 = *(const bf16x8*)p1, b1 = *(const bf16x8*)(p1 + 8);
        float o[16]; float ss = 0;
#pragma unroll
        for (int i = 0; i < 8; ++i) { o[i] = bf2f((u16)a0[i]) - lam * bf2f((u16)b0[i]); o[8 + i] = bf2f((u16)a1[i]) - lam * bf2f((u16)b1[i]); }
#pragma unroll
        for (int i = 0; i < 16; ++i) ss += o[i] * o[i];
        ss += __shfl_xor(ss, 1); ss += __shfl_xor(ss, 2); ss += __shfl_xor(ss, 4);
        const float rinv = rsqrtf(ss * (1.f / 128.f) + EPS);
        u32x4 w0, w1;
#pragma unroll
        for (int i = 0; i < 4; ++i) { w0[i] = cvtpk(o[2 * i] * rinv * sg[2 * i], o[2 * i + 1] * rinv * sg[2 * i + 1]);
            w1[i] = cvtpk(o[8 + 2 * i] * rinv * sg[8 + 2 * i], o[9 + 2 * i] * rinv * sg[9 + 2 * i]); }
        *(u32x4*)(O + (size_t)row * DM + lane * 16) = w0; *(u32x4*)(O + (size_t)row * DM + lane * 16 + 8) = w1;
    }
}

__device__ __forceinline__ float logsig16(float x) { return (fminf(x, 0.f) - __logf(1.f + __expf(-fabsf(x)))) * 0.0625f; }
constexpr int NCH = KEYS / 64;

__device__ __forceinline__ void gla_g1(const Frame& F) {
    char* KT = F.lds; char* VV = F.lds + 16384; float* ZT = (float*)(F.lds + 49152); float* SEG = (float*)(F.lds + 53248);
    const u16* Kg = F.W<u16>(GL_K); const u16* Vg = F.W<u16>(GL_V); const float* Zg = F.W<float>(GL_Z);
    u16* ST = F.W<u16>(GL_STATE); float* DEC = F.W<float>(GL_DEC);
#pragma unroll 1
    for (int it = F.bx; it < NBATCH * 4 * 2 * NCH; it += F.G) {
        int tid = threadIdx.x; asm volatile("" : "+v"(tid));
        const int lane = tid & 63, wid = tid >> 6, r32 = lane & 31, hi = lane >> 5, kk = tid & 127, jq = tid >> 7;
        const int c = it % NCH, dir = (it / NCH) & 1, bh = it / (2 * NCH), b = bh >> 2, h = bh & 3;
        const int s0 = 64 * c;
        int tbase, tstep;
        if (dir == 0) { tbase = (c < 4) ? b * CTXL + s0 : NCTX + b * SEQ + s0 - CTXL; tstep = 1; }
        else { tbase = (c < 4) ? b * CTXL + (CTXL - 1) - s0 : NCTX + b * SEQ + (SEQ - 1) - (s0 - CTXL); tstep = -1; }
        __syncthreads();
        for (int i = tid; i < 1024; i += NTHR) { const int j = i >> 4, r = i & 15; ZT[i] = Zg[(size_t)(tbase + tstep * j) * 32 + dir * 16 + r]; }
#pragma unroll
        for (int q = 0; q < 4; ++q) { const int id = tid + q * NTHR, key = id >> 5, cc = (id & 31) * 8;
            *(bf16x8*)(VV + v_st<8>(key, cc)) = *(const bf16x8*)(Vg + (size_t)(tbase + tstep * key) * 1024 + h * 256 + cc); }
        float wg[16];
#pragma unroll
        for (int r = 0; r < 16; ++r) wg[r] = F.in(19)[(dir * 16 + r) * 512 + h * 128 + kk];
        const float bias = F.in(20)[dir * 512 + h * 128 + kk];
        __syncthreads();
        float cv[16]; float run = 0;
#pragma unroll
        for (int jj = 0; jj < 16; ++jj) { const int j = jq * 16 + jj; float x = bias;
#pragma unroll
            for (int r = 0; r < 16; ++r) x += ZT[j * 16 + r] * wg[r];
            run += logsig16(x); cv[jj] = run; }
        SEG[jq * 128 + kk] = run;
        __syncthreads();
        float offset = 0, total = 0;
#pragma unroll
        for (int q = 0; q < 4; ++q) { const float sv = SEG[q * 128 + kk]; total += sv; if (q < jq) offset += sv; }
        u32x4 w0, w1;
#pragma unroll
        for (int i = 0; i < 8; ++i) {
            const int j0 = jq * 16 + 2 * i;
            const float k0 = bf2f(Kg[(size_t)(tbase + tstep * j0) * 512 + h * 128 + kk]) * __expf(total - (offset + cv[2 * i]));
            const float k1 = bf2f(Kg[(size_t)(tbase + tstep * (j0 + 1)) * 512 + h * 128 + kk]) * __expf(total - (offset + cv[2 * i + 1]));
            const unsigned pk = cvtpk(k0, k1); if (i < 4) w0[i] = pk; else w1[i - 4] = pk; }
        *(u32x4*)(KT + kk * 128 + (((jq * 2) ^ ((kk >> 1) & 7)) << 4)) = w0;
        *(u32x4*)(KT + kk * 128 + (((jq * 2 + 1) ^ ((kk >> 1) & 7)) << 4)) = w1;
        if (jq == 0) DEC[(size_t)it * 128 + kk] = __expf(total);
        __syncthreads();
        const int mt = wid & 3, vb = (wid >> 2) * 4;
        const int row = mt * 32 + r32, ab = row * 128 + ((hi ^ ((row >> 1) & 7)) << 4);
        const bf16x8 pa0 = *(const bf16x8*)(KT + (ab ^ 0)), pa1 = *(const bf16x8*)(KT + (ab ^ 32)), pa2 = *(const bf16x8*)(KT + (ab ^ 64)), pa3 = *(const bf16x8*)(KT + (ab ^ 96));
        f32x16 acc[4];
#pragma unroll
        for (int n = 0; n < 4; ++n) acc[n] = f32x16{};
        const int vbase = (int)(uintptr_t)VV + v_rd_base(lane) + vb * 512;
        pv_one<0, 8>(acc[0], vbase, pa0, pa1, pa2, pa3); pv_one<1, 8>(acc[1], vbase, pa0, pa1, pa2, pa3);
        pv_one<2, 8>(acc[2], vbase, pa0, pa1, pa2, pa3); pv_one<3, 8>(acc[3], vbase, pa0, pa1, pa2, pa3);
        u16* S = ST + (size_t)it * 128 * 256;
#pragma unroll
        for (int n = 0; n < 4; ++n)
#pragma unroll
            for (int r = 0; r < 16; ++r) S[(mt * 32 + crow(r, hi)) * 256 + (vb + n) * 32 + r32] = f2bf(acc[n][r]);
    }
}
__device__ __forceinline__ void gla_g2(const Frame& F) {
    u16* ST = F.W<u16>(GL_STATE); const float* DEC = F.W<float>(GL_DEC);
    for (int g = F.bx * NTHR + threadIdx.x; g < 32 * 4096; g += F.G * NTHR) {
        const int chain = g >> 12, e = g & 4095, kk = e >> 5, v8 = (e & 31) * 8;
        u16* p = ST + ((size_t)chain * NCH * 128 + kk) * 256 + v8; const float* d = DEC + (size_t)chain * NCH * 128 + kk;
        float f[8];
#pragma unroll
        for (int i = 0; i < 8; ++i) f[i] = 0.f;
        for (int c = 0; c < NCH; c += 4) {
            bf16x8 kv[4]; float dc[4];
#pragma unroll
            for (int u = 0; u < 4; ++u) { kv[u] = *(const bf16x8*)(p + (size_t)(c + u) * 128 * 256); dc[u] = d[(size_t)(c + u) * 128]; }
#pragma unroll
            for (int u = 0; u < 4; ++u) {
                u32x4 w = {cvtpk(f[0], f[1]), cvtpk(f[2], f[3]), cvtpk(f[4], f[5]), cvtpk(f[6], f[7])};
                *(u32x4*)(p + (size_t)(c + u) * 128 * 256) = w;
#pragma unroll
                for (int i = 0; i < 8; ++i) f[i] = dc[u] * f[i] + bf2f((u16)kv[u][i]);
            }
        }
    }
}
__device__ __forceinline__ void gla_g3(const Frame& F) {
    char* QD = F.lds; char* KI = F.lds + 16384; char* VV = F.lds + 32768; char* SS = F.lds + 65536; float* OL = (float*)(F.lds + 65536);
    float* ZT = (float*)(F.lds + 132096); float* SEG = (float*)(F.lds + 136192);
    const u16* Qg = F.W<u16>(GL_Q); const u16* Kg = F.W<u16>(GL_K); const u16* Vg = F.W<u16>(GL_V); const u16* Gg = F.W<u16>(GL_G); const float* Zg = F.W<float>(GL_Z);
    const u16* ST = F.W<u16>(GL_STATE); u16* OUT = F.W<u16>(WS_H);
#pragma unroll 1
    for (int it = F.bx; it < NBATCH * 4 * NCH; it += F.G) {
        int tid = threadIdx.x; asm volatile("" : "+v"(tid));
        const int lane = tid & 63, wid = tid >> 6, r32 = lane & 31, hi = lane >> 5, kk = tid & 127, jq = tid >> 7;
        const int T = it % NCH, bh = it / NCH, b = bh >> 2, h = bh & 3;
        const int t0 = (T < 4) ? b * CTXL + 64 * T : NCTX + b * SEQ + 64 * (T - 4);
        __syncthreads();
#pragma unroll
        for (int q = 0; q < 4; ++q) { const int id = tid + q * NTHR, key = id >> 5, cc = (id & 31) * 8;
            *(bf16x8*)(VV + v_st<8>(key, cc)) = *(const bf16x8*)(Vg + (size_t)(t0 + key) * 1024 + h * 256 + cc); }
        const int itile = wid & 1, vb = (wid >> 1) * 2;
        f32x16 acc[2]; acc[0] = f32x16{}; acc[1] = f32x16{};
#pragma unroll 1
        for (int dir = 0; dir < 2; ++dir) {
            const int cd = dir == 0 ? T : (T < 4 ? 3 - T : 135 - T);
            const u16* Ssrc = ST + (size_t)((bh * 2 + dir) * NCH + cd) * 128 * 256;
#pragma unroll
            for (int q = 0; q < 8; ++q) { const int id = tid + q * NTHR, key = id >> 5, cc = (id & 31) * 8;
                *(bf16x8*)(SS + v_st<8>(key, cc)) = *(const bf16x8*)(Ssrc + (size_t)key * 256 + cc); }
            for (int i = tid; i < 1024; i += NTHR) { const int j = i >> 4, r = i & 15; ZT[i] = Zg[(size_t)(t0 + j) * 32 + dir * 16 + r]; }
            float wg[16];
#pragma unroll
            for (int r = 0; r < 16; ++r) wg[r] = F.in(19)[(dir * 16 + r) * 512 + h * 128 + kk];
            const float bias = F.in(20)[dir * 512 + h * 128 + kk];
            __syncthreads();
            float cv[16]; float run = 0;
#pragma unroll
            for (int u = 0; u < 16; ++u) { const int j = jq * 16 + u; float x = bias;
#pragma unroll
                for (int r = 0; r < 16; ++r) x += ZT[j * 16 + r] * wg[r];
                cv[u] = logsig16(x); }
            if (dir == 0) {
#pragma unroll
                for (int u = 0; u < 16; ++u) { run += cv[u]; cv[u] = run; }
            } else {
#pragma unroll
                for (int u = 15; u >= 0; --u) { run += cv[u]; cv[u] = run; }
            }
            SEG[jq * 128 + kk] = run;
            __syncthreads();
            float offset = 0;
#pragma unroll
            for (int q = 0; q < 4; ++q) { const float sv = SEG[q * 128 + kk]; if (dir == 0 ? (q < jq) : (q > jq)) offset += sv; }
            const int adb = jq * 4096 + ((kk >> 3) << 4) + (kk & 7) * 2;
#pragma unroll
            for (int jj = 0; jj < 16; ++jj) { const int i = jq * 16 + jj; const float cum = offset + cv[jj];
                const float qv = bf2f(Qg[(size_t)(t0 + i) * 512 + h * 128 + kk]) * __expf(cum);
                const float kv = bf2f(Kg[(size_t)(t0 + i) * 512 + h * 128 + kk]) * __expf(-cum);
                const int ad = (adb ^ (jj << 4)) + jj * 256;
                *(u16*)(QD + ad) = f2bf(qv); *(u16*)(KI + ad) = f2bf(kv); }
            __syncthreads();
            {
                const int row = itile * 32 + r32; bf16x8 qa[8];
#pragma unroll
                for (int ks = 0; ks < 8; ++ks) qa[ks] = *(const bf16x8*)(QD + row * 256 + (((ks * 2 + hi) ^ (row & 15)) << 4));
                const int ssb = (int)(uintptr_t)SS + v_rd_base(lane) + vb * 512;
                pv_one<0, 8>(acc[0], ssb, qa[0], qa[1], qa[2], qa[3]); pv_one<0, 8>(acc[0], ssb + 32768, qa[4], qa[5], qa[6], qa[7]);
                pv_one<1, 8>(acc[1], ssb, qa[0], qa[1], qa[2], qa[3]); pv_one<1, 8>(acc[1], ssb + 32768, qa[4], qa[5], qa[6], qa[7]);
                f32x16 p0 = f32x16{}, p1 = f32x16{};
#pragma unroll
                for (int ks = 0; ks < 8; ++ks) {
                    const bf16x8 k0 = *(const bf16x8*)(KI + r32 * 256 + (((ks * 2 + hi) ^ (r32 & 15)) << 4));
                    const bf16x8 k1 = *(const bf16x8*)(KI + (32 + r32) * 256 + (((ks * 2 + hi) ^ (r32 & 15)) << 4));
                    p0 = __builtin_amdgcn_mfma_f32_32x32x16_bf16(k0, qa[ks], p0, 0, 0, 0);
                    p1 = __builtin_amdgcn_mfma_f32_32x32x16_bf16(k1, qa[ks], p1, 0, 0, 0);
                }
                const int iq = itile * 32 + r32;
#pragma unroll
                for (int r = 0; r < 16; ++r) { const int s0 = crow(r, hi), s1 = 32 + s0;
                    const bool k0 = dir == 0 ? (s0 <= iq) : (s0 >= iq), k1 = dir == 0 ? (s1 <= iq) : (s1 >= iq);
                    p0[r] = k0 ? p0[r] : 0.f; p1[r] = k1 ? p1[r] : 0.f; }
                bf16x8 pa0, pa1, pa2, pa3;
                PK4(p0, 0, pa0); PK4(p0, 8, pa1); PK4(p1, 0, pa2); PK4(p1, 8, pa3);
                const int vvb = (int)(uintptr_t)VV + v_rd_base(lane) + vb * 512;
                pv_one<0, 8>(acc[0], vvb, pa0, pa1, pa2, pa3); pv_one<1, 8>(acc[1], vvb, pa0, pa1, pa2, pa3);
            }
            __syncthreads();
        }
        float* olb = OL + (itile * 32 + 4 * hi) * 260 + vb * 32 + r32;
#pragma unroll
        for (int n = 0; n < 2; ++n)
#pragma unroll
            for (int r = 0; r < 16; ++r) olb[((r & 3) + 8 * (r >> 2)) * 260 + n * 32] = acc[n][r];
        __syncthreads();
        {
            const int i = tid >> 3, sg = tid & 7; const float* ol = OL + i * 260 + sg * 32;
            float ss = 0;
#pragma unroll
            for (int u = 0; u < 8; ++u) { const f32x4 t = *(const f32x4*)(ol + u * 4); ss += t[0] * t[0] + t[1] * t[1] + t[2] * t[2] + t[3] * t[3]; }
            ss += __shfl_xor(ss, 1); ss += __shfl_xor(ss, 2); ss += __shfl_xor(ss, 4);
            const float rinv = rsqrtf(ss * (1.f / 256.f) + EPS);
            const u16* gp = Gg + (size_t)(t0 + i) * 1024 + h * 256 + sg * 32; u16* op = OUT + (size_t)(t0 + i) * 1024 + h * 256 + sg * 32;
            const float* hn = F.in(21) + sg * 32;
#pragma unroll
            for (int q = 0; q < 4; ++q) { const bf16x8 g8 = *(const bf16x8*)(gp + q * 8); u32x4 w;
                const f32x4 oa = *(const f32x4*)(ol + q * 8), ob = *(const f32x4*)(ol + q * 8 + 4);
                const float o8[8] = {oa[0], oa[1], oa[2], oa[3], ob[0], ob[1], ob[2], ob[3]};
#pragma unroll
                for (int u = 0; u < 4; ++u) { const int e0 = q * 8 + 2 * u;
                    w[u] = cvtpk(o8[2 * u] * rinv * hn[e0] * silu_f(bf2f((u16)g8[2 * u])), o8[2 * u + 1] * rinv * hn[e0 + 1] * silu_f(bf2f((u16)g8[2 * u + 1]))); }
                *(u32x4*)(op + q * 8) = w; }
        }
    }
}

__device__ __forceinline__ void pair_decode(int p, int& elo, int& ehi) { elo = p < 3 ? 0 : (p < 5 ? 1 : 2); ehi = p < 3 ? p + 1 : (p < 5 ? p - 1 : 3); }
struct MoeATiles {
    typedef GTile<RowsGather, RowsPlain, EpiMoeA> Tile; static constexpr bool EP_CONST = false; EpiMoeA ep;
    const int* tab; u16* H; const int* rowtok; const u16* wgu; u16* act; const float* roww; int nmt, bx, G;
    __device__ __forceinline__ bool get(int i, Tile& t) const {
        int mt, nt; if (!tile_seq(i, bx, G, nmt, 16, mt, nt)) return false;
        const int c = tab[32 + mt], g = c / 6; int elo, ehi; pair_decode(c % 6, elo, ehi);
        const int half = nt >> 3, e = half ? ehi : elo;
        t.al = RowsGather{H, 1024, rowtok};
        t.bl = RowsPlain{wgu + ((size_t)(g * 4 + e) * 1024 + (nt & 7) * 128) * 1024, 1024};
        t.ep = EpiMoeA{act, roww, half, half * 512 + (nt & 7) * 64};
        t.brow = mt * 256; t.bcol = 0; return true; }
};
struct MoeBTiles {
    typedef GTile<RowsPlain, RowsSplitK, EpiMoeB> Tile; static constexpr bool EP_CONST = false; EpiMoeB ep;
    const int* tab; ResCtx F; int li; const u16* wd; const u16* act; const int* rowtok; int nmt, bx, G;
    __device__ __forceinline__ bool get(int i, Tile& t) const {
        int mt, nt; if (!tile_seq(i, bx, G, nmt, 8, mt, nt)) return false;
        const int c = tab[32 + mt], g = c / 6; int elo, ehi; pair_decode(c % 6, elo, ehi);
        t.al = RowsPlain{act, 1024};
        t.bl = RowsSplitK{wd + (size_t)(g * 4 + elo) * 1024 * 512, wd + (size_t)(g * 4 + ehi) * 1024 * 512, 512, 8};
        t.ep = EpiMoeB{F, li, rowtok};
        t.brow = mt * 256; t.bcol = nt * 128; return true; }
};
__device__ __forceinline__ void moe_gemm_a(const Frame& F, int li) {
    int* tab = (int*)(F.lds + LDS_TAB); moe_table(F, li, tab);
    const int nmt = tab[24] >> 8;
    MoeATiles prov{EpiMoeA{}, tab, F.W<u16>(WS_H), F.W<int>(WS_ROWTOK), F.W<u16>(WS_MOEW), F.W<u16>(MOE_ACT), F.W<float>(WS_ROWW), nmt, F.bx, F.G};
    gemm_stream<4, 2>(F.lds, prov, 16);
}
__device__ __forceinline__ void moe_gemm_b(const Frame& F, int li) {
    int* tab = (int*)(F.lds + LDS_TAB); moe_table(F, li, tab);
    const int nmt = tab[24] >> 8;
    MoeBTiles prov{EpiMoeB{}, tab, res_ctx(F), li, F.W<u16>(WS_MOEW + MOE_WGU_BYTES), F.W<u16>(MOE_ACT), F.W<int>(WS_ROWTOK), nmt, F.bx, F.G};
    gemm_stream<4, 2>(F.lds, prov, 16);
}
__device__ __forceinline__ void final_norm(const Frame& F) {
    const int lane = threadIdx.x & 63, wid = threadIdx.x >> 6;
    for (int row = F.bx * NWAVE + wid; row < NLAT; row += F.G * NWAVE) {
        float* xr = F.out + (size_t)row * DM; f32x4 v[4];
#pragma unroll
        for (int i = 0; i < 4; ++i) v[i] = *(const f32x4*)(xr + i * 256 + lane * 4);
        float ss = 0;
#pragma unroll
        for (int i = 0; i < 4; ++i) ss += v[i][0] * v[i][0] + v[i][1] * v[i][1] + v[i][2] * v[i][2] + v[i][3] * v[i][3];
        ss = wave_sum(ss); const float rinv = rsqrtf(ss * (1.f / DM) + EPS);
#pragma unroll
        for (int i = 0; i < 4; ++i) { const f32x4 g = *(const f32x4*)(F.in(30) + i * 256 + lane * 4);
            f32x4 o = {v[i][0] * rinv * g[0], v[i][1] * rinv * g[1], v[i][2] * rinv * g[2], v[i][3] * rinv * g[3]};
            *(f32x4*)(xr + i * 256 + lane * 4) = o; }
    }
}

constexpr int N_PHASES = 42;
__global__ void __launch_bounds__(NTHR, 2) fwd_kernel(Params p) {
    extern __shared__ __attribute__((aligned(16))) char lds[];
    Frame F; F.p = &p; F.ws = p.ws; F.lds = lds; F.out = p.out; F.G = (int)gridDim.x; F.bx = (int)blockIdx.x;
    const int lo = p.ph_lo, hi = p.ph_hi;
#if !MK_PER_PHASE
    if (threadIdx.x == 0) *(uint4*)(lds + LDS_BARW) = make_uint4(0u, 0u, 0u, 0u);
    __syncthreads();
    XcdBarrier bar = xcd_barrier_post((unsigned*)(p.ws + WS_CTL), (volatile LAS unsigned*)(lds + LDS_BARW));
#define GRID_BAR() xcd_barrier(bar)
#else
#define GRID_BAR() do {} while (0)
#endif
#ifndef MK_EN
#define MK_EN 0xFFFFFFFFu
#endif
#define EN(g) (((MK_EN) >> (g)) & 1u)
#ifndef MK_REP
#define MK_REP 0u
#endif
#define REP(g) (((MK_REP) >> (g)) & 1u)
#define IN(k) (lo <= (k) && (k) < hi)
#define SEAM(k) do { if ((k) + 1 < hi) GRID_BAR(); } while (0)
#define DUP(g, body) do { body; if (REP(g)) { GRID_BAR(); body; } } while (0)

    if (EN(0) && IN(0)) { DUP(0, (p0_mods(F), __syncthreads(), p0_rope(F), p0_weights(F))); SEAM(0); }

#define LAYER(LI) { constexpr int li = (LI); constexpr int base = 1 + li * 10; constexpr bool first = li == 0, last = li == DEPTH - 1; constexpr int kind = li % 3, j = li / 3; \
        if (EN(1) && IN(base + 0)) { DUP(1, norm_phase<false>(F, li, 0, first)); SEAM(base + 0); } \
        if constexpr (kind == 0) { \
            if (EN(2) && IN(base + 1)) { EpiF32 ep{F.W<float>(MLA_DQ), 544, 544}; \
                gemm_phase<4, 2>(F, RowsPlain{F.W<u16>(WS_H), 1024}, RowsPlain{F.W<u16>(WS_WDQKV) + (size_t)j * 640 * 1024, 1024}, ep, 0, 132, 5, 16, 0, 0); if (REP(2)) { GRID_BAR(); gemm_phase<4, 2>(F, RowsPlain{F.W<u16>(WS_H), 1024}, RowsPlain{F.W<u16>(WS_WDQKV) + (size_t)j * 640 * 1024, 1024}, ep, 0, 132, 5, 16, 0, 0); } SEAM(base + 1); } \
            if (EN(3) && IN(base + 2)) { DUP(3, mla_rowpass(F, j)); SEAM(base + 2); } \
            if (EN(2) && IN(base + 3)) { \
                EpiMlaQ eq{F.W<u16>(MLA_Q), F.W<float>(WS_ROPEA), F.W<float>(WS_ROPEA) + SEQ * 16, 0.10206207261596577f * LOG2E}; \
                gemm_phase<4, 2>(F, RowsPlain{F.W<u16>(MLA_CN), 512}, RowsPlain{F.W<u16>(WS_WUQ) + (size_t)j * 1536 * 256, 256}, eq, 0, 132, 12, 4, 0, 0); \
                EpiMlaKV ek{F.W<u16>(MLA_KN), (long)((MLA_V - MLA_KN) / 2)}; \
                gemm_phase<4, 2>(F, RowsPlain{F.W<u16>(MLA_CN) + 256, 512}, RowsPlain{F.W<u16>(WS_WUKV) + (size_t)j * 2048 * 256, 256}, ek, 0, 132, 16, 4, 132 * 12, 0); \
                SEAM(base + 3); } \
            if (EN(4) && IN(base + 4)) { DUP(4, mla_attn(F, !last, li)); SEAM(base + 4); } \
            if (EN(2) && IN(base + 5)) { EpiResid ep{res_ctx(F, first), li, 2, 0}; \
                gemm_phase<4, 2>(F, RowsPlain{F.W<u16>(MLA_DQ), 1024}, RowsPlain{F.W<u16>(WS_WOM) + (size_t)j * 1024 * 1024, 1024}, ep, last ? 4 : 0, 132, 8, 16, 0, 0); SEAM(base + 5); } \
        } else if constexpr (kind == 1) { \
            if (EN(5) && IN(base + 1)) { EpiDiffQKV ep{F.W<u16>(DF_Q), (long)((DF_K - DF_Q) / 2), F.W<u16>(DF_V), F.W<float>(WS_ROPEB), F.W<float>(WS_ROPEB) + SEQ * 32, 0.125f * LOG2E}; \
                gemm_phase<4, 2>(F, RowsPlain{F.W<u16>(WS_H), 1024}, RowsPlain{F.W<u16>(WS_WQKVD), 1024}, ep, 0, 132, 24, 16, 0, 0); if (REP(5)) { GRID_BAR(); gemm_phase<4, 2>(F, RowsPlain{F.W<u16>(WS_H), 1024}, RowsPlain{F.W<u16>(WS_WQKVD), 1024}, ep, 0, 132, 24, 16, 0, 0); } SEAM(base + 1); } \
            if (EN(6) && IN(base + 2)) { DUP(6, diff_attn(F, li)); SEAM(base + 2); } \
            if (EN(7) && IN(base + 3)) { DUP(7, diff_rowpass(F, 0.35550906759906f)); SEAM(base + 3); } \
            if (EN(5) && IN(base + 4)) { EpiResid ep{res_ctx(F, first), li, 2, 0}; \
                gemm_phase<4, 2>(F, RowsPlain{F.W<u16>(DF_Q), 1024}, RowsPlain{F.W<u16>(WS_WOD), 1024}, ep, 0, 132, 8, 16, 0, 0); SEAM(base + 4); } \
        } else { \
            if (EN(8) && IN(base + 1)) { pg8::SeqOrder S8{132, 13, F.bx, F.G}; pg8::EpiGlaIn8 E8{F.W<u16>(GL_Q), F.W<u16>(GL_K), F.W<u16>(GL_V), F.W<u16>(GL_G), F.W<float>(GL_Z)}; \
                pg8::gemm_phase(F.lds, F.W<u16>(WS_H), F.W<u16>(WS_WING), 1024, S8, E8); \
                if (REP(8)) { GRID_BAR(); pg8::gemm_phase(F.lds, F.W<u16>(WS_H), F.W<u16>(WS_WING), 1024, S8, E8); } SEAM(base + 1); } \
            if (EN(9) && IN(base + 2)) { DUP(9, gla_g1(F)); SEAM(base + 2); } \
            if (EN(10) && IN(base + 3)) { gla_g2(F); SEAM(base + 3); } \
            if (EN(11) && IN(base + 4)) { DUP(11, gla_g3(F)); SEAM(base + 4); } \
            if (EN(8) && IN(base + 5)) { EpiResid ep{res_ctx(F, first), li, 2, 0}; \
                gemm_phase<4, 2>(F, RowsPlain{F.W<u16>(WS_H), 1024}, RowsPlain{F.W<u16>(WS_WOG), 1024}, ep, 0, 132, 8, 16, 0, 0); SEAM(base + 5); } \
        } \
        if (EN(12) && IN(base + 6)) { norm_phase<true>(F, li, last ? NCTX : 0, false); SEAM(base + 6); } \
        if (EN(13) && IN(base + 7)) { DUP(13, ((kind == 2 ? moe_weights(F, li) : (void)0), moe_scatter(F, li, last ? NCTX : 0))); SEAM(base + 7); } \
        if (EN(14) && IN(base + 8)) { DUP(14, moe_gemm_a(F, li)); SEAM(base + 8); } \
        if (EN(15) && IN(base + 9)) { moe_gemm_b(F, li); SEAM(base + 9); } \
    }
    LAYER(0) LAYER(1) LAYER(2) LAYER(3)
    if (EN(16) && IN(41)) { final_norm(F); }
}

extern "C" void kernel_launch(void* const* d_in, const int* in_sizes, int n_in, void* d_out, int out_size, void* d_ws, size_t ws_size, hipStream_t stream) {
    static int grid = 0;
    if (grid == 0) {
        if (n_in != 31 || out_size != NLAT * DM || ws_size < WS_END) {
            fprintf(stderr, "kernel_launch: built for 31 inputs, out %d floats, ws >= %zu bytes; got n_in %d out %d ws %zu\n", NLAT * DM, (size_t)WS_END, n_in, out_size, ws_size);
            grid = -1; return; }
        int dev = 0, cus = 0;
        if (hipGetDevice(&dev) != hipSuccess || hipDeviceGetAttribute(&cus, hipDeviceAttributeMultiprocessorCount, dev) != hipSuccess) { grid = -1; return; }
        if (hipFuncSetAttribute((const void*)fwd_kernel, hipFuncAttributeMaxDynamicSharedMemorySize, LDS_BYTES) != hipSuccess) { fprintf(stderr, "kernel_launch: hipFuncSetAttribute failed\n"); grid = -1; return; }
        int per_cu = 0;
        if (hipOccupancyMaxActiveBlocksPerMultiprocessor(&per_cu, (const void*)fwd_kernel, NTHR, LDS_BYTES) != hipSuccess || per_cu < 1)
            fprintf(stderr, "kernel_launch: occupancy query reports %d workgroups per CU\n", per_cu);
        (void)hipGetLastError();
        grid = cus;
    }
    if (grid < 0) return;
    (void)in_sizes;
    (void)hipMemsetAsync((char*)d_ws + WS_CTL, 0, CTL_BYTES, stream);
    Params p{};
    for (int i = 0; i < 31; ++i) p.in[i] = (const float*)d_in[i];
    p.out = (float*)d_out; p.ws = (unsigned char*)d_ws;
#if MK_PER_PHASE
    for (int ph = 0; ph < N_PHASES; ++ph) { p.ph_lo = ph; p.ph_hi = ph + 1; hipLaunchKernelGGL(fwd_kernel, dim3(grid), dim3(NTHR), LDS_BYTES, stream, p); }
#else
#ifdef MK_PROBE_HI
    p.ph_lo = 0; p.ph_hi = MK_PROBE_HI;
    hipLaunchKernelGGL(fwd_kernel, dim3(grid), dim3(NTHR), LDS_BYTES, stream, p);
    (void)hipMemsetAsync((char*)d_ws + WS_CTL, 0, CTL_BYTES, stream);
#endif
    p.ph_lo = 0; p.ph_hi = N_PHASES;
    hipLaunchKernelGGL(fwd_kernel, dim3(grid), dim3(NTHR), LDS_BYTES, stream, p);
#endif
}
```

```cpp
#include <hip/hip_runtime.h>
#include <stdint.h>
#include <stdio.h>

#ifndef MK_PER_PHASE
#define MK_PER_PHASE 0
#endif

typedef unsigned short u16;
using bf16x8 = __attribute__((ext_vector_type(8))) short;
using s16x4  = __attribute__((ext_vector_type(4))) short;
using f32x16 = __attribute__((ext_vector_type(16))) float;
using f32x4  = __attribute__((ext_vector_type(4))) float;
using u32x4  = __attribute__((ext_vector_type(4))) unsigned;
using u32x2  = __attribute__((ext_vector_type(2))) unsigned;

constexpr int DM = 1024, NBATCH = 4, SEQ = 8192, CTXL = 256, DEPTH = 4;
constexpr int NCTX = NBATCH * CTXL;
constexpr int NLAT = NBATCH * SEQ;
constexpr int NTOK = NCTX + NLAT;
constexpr int KEYS = CTXL + SEQ;
constexpr float EPS = 1e-6f;
constexpr int NTHR = 512, NWAVE = 8;
constexpr float LOG2E = 1.4426950408889634f;

constexpr size_t al256(size_t x) { return (x + 255) / 256 * 256; }
constexpr size_t WS_CTL   = 0;
constexpr size_t CTL_BYTES = 32768;
constexpr size_t WS_MODS  = WS_CTL + CTL_BYTES;
constexpr size_t WS_ROPEA = WS_MODS + al256((size_t)DEPTH * 5 * 6144 * 4);
constexpr size_t WS_ROPEB = WS_ROPEA + (size_t)2 * SEQ * 16 * 4;
constexpr size_t WS_XC    = WS_ROPEB + (size_t)2 * SEQ * 32 * 4;
constexpr size_t WS_WDQKV = WS_XC + (size_t)NCTX * DM * 4;
constexpr size_t WS_WUQ   = WS_WDQKV + (size_t)2 * 640 * 1024 * 2;
constexpr size_t WS_WUKV  = WS_WUQ + (size_t)2 * 1536 * 256 * 2;
constexpr size_t WS_WOM   = WS_WUKV + (size_t)2 * 2048 * 256 * 2;
constexpr size_t WS_WQKVD = WS_WOM + (size_t)2 * 1024 * 1024 * 2;
constexpr size_t WS_WOD   = WS_WQKVD + (size_t)3072 * 1024 * 2;
constexpr size_t WS_WING  = WS_WOD + (size_t)1024 * 1024 * 2;
constexpr size_t WS_WOG   = WS_WING + (size_t)3328 * 1024 * 2;
constexpr size_t WS_TOK   = WS_WOG + (size_t)1024 * 1024 * 2;
constexpr size_t WS_ROWTOK= WS_TOK + (size_t)NTOK * 16;
constexpr int    RMAX     = 40960;
constexpr size_t WS_ROWW  = WS_ROWTOK + (size_t)RMAX * 4;
constexpr size_t WS_H     = al256(WS_ROWW + (size_t)RMAX * 8);
constexpr size_t H_BYTES  = (size_t)NTOK * DM * 2;
constexpr size_t WS_MOEW  = WS_H + H_BYTES;
constexpr size_t MOE_WGU_BYTES = (size_t)16 * 1024 * 1024 * 2;
constexpr size_t MOE_WD_BYTES  = (size_t)16 * 1024 * 512 * 2;
constexpr size_t MOEW_BYTES = MOE_WGU_BYTES + MOE_WD_BYTES;
constexpr size_t WS_BIG   = WS_MOEW + MOEW_BYTES;
constexpr size_t MLA_Q    = WS_BIG;
constexpr size_t MLA_KN   = MLA_Q + (size_t)NBATCH * 16 * KEYS * 96 * 2;
constexpr size_t MLA_V    = MLA_KN + (size_t)NBATCH * 16 * KEYS * 64 * 2;
constexpr size_t MLA_KPE  = MLA_V + (size_t)NBATCH * 16 * KEYS * 64 * 2;
constexpr size_t MLA_DQ   = MLA_KPE + al256((size_t)NBATCH * KEYS * 32 * 2);
constexpr size_t MLA_CN   = MLA_DQ + (size_t)NTOK * 544 * 4;
constexpr size_t MLA_END  = MLA_CN + (size_t)NTOK * 512 * 2;
constexpr size_t DF_Q     = WS_BIG;
constexpr size_t DF_K     = DF_Q + (size_t)NBATCH * 16 * KEYS * 64 * 2;
constexpr size_t DF_V     = DF_K + (size_t)NBATCH * 16 * KEYS * 64 * 2;
constexpr size_t DF_OS    = DF_V + (size_t)NBATCH * 8 * KEYS * 128 * 2;
constexpr size_t DF_END   = DF_OS + (size_t)2 * NTOK * DM * 2;
constexpr size_t GL_STATE = WS_MOEW;
constexpr size_t GL_STATE_BYTES = (size_t)NBATCH * 4 * 2 * 132 * 128 * 256 * 2;
constexpr size_t GL_DEC   = GL_STATE + GL_STATE_BYTES;
constexpr size_t GL_Q     = GL_DEC + al256((size_t)4224 * 128 * 4);
constexpr size_t GL_K     = GL_Q + (size_t)NTOK * 512 * 2;
constexpr size_t GL_V     = GL_K + (size_t)NTOK * 512 * 2;
constexpr size_t GL_G     = GL_V + (size_t)NTOK * 1024 * 2;
constexpr size_t GL_Z     = GL_G + (size_t)NTOK * 1024 * 2;
constexpr size_t GL_END   = GL_Z + (size_t)NTOK * 32 * 4;
constexpr size_t MOE_ACT  = WS_BIG;
constexpr size_t MOE_END  = MOE_ACT + (size_t)RMAX * 1024 * 2;
constexpr size_t cmax(size_t a, size_t b) { return a > b ? a : b; }
constexpr size_t WS_END   = cmax(cmax(MLA_END, DF_END), cmax(GL_END, MOE_END));

#define XCD_BAR_WORDS 3456
constexpr int CW_CNT = 4096;

#define XB_TMO      128
#define XB_XCNT(j)  (256  + 64 * (j))
#define XB_XSUB(j)  (1280 + 64 * (j))
#define XB_XGEN(j)  (2304 + 64 * (j))
#define XB_TOP      3328
#define XB_TOPGEN   3392
#define XB_SPIN_CAP (1u << 24)
#define LAS __attribute__((address_space(3)))
__device__ __forceinline__ unsigned xb_ld(unsigned* p)              { return __hip_atomic_load(p, __ATOMIC_RELAXED, __HIP_MEMORY_SCOPE_AGENT); }
__device__ __forceinline__ unsigned xb_add(unsigned* p, unsigned v) { return __hip_atomic_fetch_add(p, v, __ATOMIC_RELAXED, __HIP_MEMORY_SCOPE_AGENT); }
__device__ __forceinline__ unsigned xb_xcc_id() { return (unsigned)__builtin_amdgcn_s_getreg((3 << 11) | 20) & 0xFu; }
#define XB_SPIN(cond, bar) do { unsigned _sp = 0; while (cond) { __builtin_amdgcn_s_sleep(1); \
    if ((++_sp & 255u) == 0u) { if (xb_ld(&(bar)[XB_TMO])) break; if (_sp > XB_SPIN_CAP) { atomicAdd(&(bar)[XB_TMO], 1u); break; } } } } while (0)
struct XcdBarrier { unsigned* bar; unsigned x; volatile LAS unsigned* st; };
__device__ __forceinline__ XcdBarrier xcd_barrier_post(unsigned* bar, volatile LAS unsigned* st) {
    XcdBarrier b; b.bar = bar; b.x = xb_xcc_id(); b.st = st;
    if (threadIdx.x == 0) (void)xb_add(&bar[XB_XCNT(b.x)], 1u);
    return b;
}
__device__ __forceinline__ void xcd_barrier_complete(unsigned* bar, unsigned x, unsigned& nloc, unsigned& nx) {
    const unsigned G = gridDim.x * gridDim.y * gridDim.z;
    unsigned sum, cnt, mine, sp = 0u;
    for (;;) {
        sum = 0u; cnt = 0u; mine = 0u;
#pragma unroll
        for (unsigned j = 0; j < 16; ++j) { const unsigned c = xb_ld(&bar[XB_XCNT(j)]); sum += c; cnt += (c > 0u) ? 1u : 0u; mine = (j == x) ? c : mine; }
        if (sum == G) break;
        __builtin_amdgcn_s_sleep(1);
        if ((++sp & 255u) == 0u) { if (xb_ld(&bar[XB_TMO])) break; if (sp > XB_SPIN_CAP) { atomicAdd(&bar[XB_TMO], 1u); break; } }
    }
    nloc = mine > 0u ? mine : 1u; nx = cnt > 0u ? cnt : 1u;
}
__device__ __forceinline__ void xcd_barrier(const XcdBarrier& b) {
    asm volatile("s_waitcnt vmcnt(0)" ::: "memory");
    __syncthreads();
    if (threadIdx.x == 0) {
        unsigned* bar = b.bar;
        __builtin_amdgcn_s_waitcnt(0);
        unsigned nloc = b.st[0], nx = b.st[1];
        if (nloc == 0u) { xcd_barrier_complete(bar, b.x, nloc, nx); b.st[0] = nloc; b.st[1] = nx; }
        const unsigned old = xb_add(&bar[XB_XSUB(b.x)], 1u);
        const unsigned gen = old / nloc;
        if (old + 1u == (gen + 1u) * nloc) {
            __builtin_amdgcn_fence(__ATOMIC_RELEASE, "agent");
            asm volatile("s_waitcnt vmcnt(0)" ::: "memory");
            const unsigned og = xb_add(&bar[XB_TOP], 1u);
            const unsigned tg = og / nx;
            if (og + 1u == (tg + 1u) * nx) xb_add(&bar[XB_TOPGEN], 1u);
            else XB_SPIN(xb_ld(&bar[XB_TOPGEN]) == tg, bar);
            __builtin_amdgcn_fence(__ATOMIC_ACQUIRE, "agent");
            xb_add(&bar[XB_XGEN(b.x)], 1u);
            asm volatile("s_waitcnt vmcnt(0)" ::: "memory");
        } else {
            XB_SPIN(xb_ld(&bar[XB_XGEN(b.x)]) == gen, bar);
            __builtin_amdgcn_fence(__ATOMIC_ACQUIRE, "agent");
            asm volatile("s_waitcnt vmcnt(0)" ::: "memory");
        }
    }
    __syncthreads();
}

__device__ __forceinline__ u16 f2bf(float f) { unsigned u = __float_as_uint(f); u += 0x7FFFu + ((u >> 16) & 1u); return (u16)(u >> 16); }
__device__ __forceinline__ float bf2f(u16 h) { return __uint_as_float((unsigned)h << 16); }
__device__ __forceinline__ unsigned cvtpk(float lo, float hi) { unsigned r; asm volatile("v_cvt_pk_bf16_f32 %0, %1, %2" : "=v"(r) : "v"(lo), "v"(hi)); return r; }
__device__ __forceinline__ float wave_sum(float v) {
#pragma unroll
    for (int o = 32; o; o >>= 1) v += __shfl_xor(v, o);
    return v;
}
__device__ __forceinline__ int crow(int r, int hi) { return (r & 3) + 8 * (r >> 2) + 4 * hi; }
__device__ __forceinline__ void row_bp(int row, int& b, int& pos) {
    if (row < NCTX) { b = row >> 8; pos = row & 255; } else { const int r = row - NCTX; b = r >> 13; pos = CTXL + (r & (SEQ - 1)); }
}
__device__ __forceinline__ float silu_f(float x) { return x / (1.f + __expf(-x)); }
#define SBAR() __builtin_amdgcn_sched_barrier(0)

struct Params { const float* in[31]; float* out; unsigned char* ws; int ph_lo, ph_hi; };

struct RowsPlain  { const u16* base; long ld;
    __device__ __forceinline__ long off(int r) const { return (long)r * ld; }
    __device__ __forceinline__ const u16* kbase(int kt) const { return base + kt * 64; } };
struct RowsGather { const u16* base; long ld; const int* idx;
    __device__ __forceinline__ long off(int r) const { int t = idx[r]; t = t < 0 ? 0 : t; return (long)t * ld; }
    __device__ __forceinline__ const u16* kbase(int kt) const { return base + kt * 64; } };
struct RowsSplitK { const u16* b0; const u16* b1; long ld; int ks;
    __device__ __forceinline__ long off(int r) const { return (long)r * ld; }
    __device__ __forceinline__ const u16* kbase(int kt) const { return kt < ks ? b0 + kt * 64 : b1 + (kt - ks) * 64; } };

constexpr int GEMM_LDS = 2 * 384 * 128;

template <int WM, int WN, class AL, class BL, class EP>
__device__ __forceinline__ void gemm_tile(char* lds, const AL al, const BL bl, EP& ep, int brow, int bcol, int nk) {
    constexpr int BM = WM * 64, BN = WN * 64, STG = (BM + BN) * 128, NA = BM / 64, NB = BN / 64;
    const int tid = threadIdx.x, lane = tid & 63, wid = __builtin_amdgcn_readfirstlane(tid >> 6);
    const int wm = wid / WN, wn = wid % WN, r32 = lane & 31, hi = lane >> 5;
    long aoff[NA], boff[NB];
#pragma unroll
    for (int i = 0; i < NA; ++i) { const int r = (i * 8 + wid) * 8 + (lane >> 3); const int c = (lane & 7) ^ ((r >> 1) & 7); aoff[i] = al.off(brow + r) + c * 8; }
#pragma unroll
    for (int i = 0; i < NB; ++i) { const int r = (i * 8 + wid) * 8 + (lane >> 3); const int c = (lane & 7) ^ ((r >> 1) & 7); boff[i] = bl.off(bcol + r) + c * 8; }
    const int ldsw = wid * 1024 + lane * 16;
    int abase[2], bbase[2];
#pragma unroll
    for (int i = 0; i < 2; ++i) {
        const int ra = wm * 64 + i * 32 + r32; abase[i] = ra * 128 + ((hi ^ ((ra >> 1) & 7)) << 4);
        const int rb = wn * 64 + i * 32 + r32; bbase[i] = BM * 128 + rb * 128 + ((hi ^ ((rb >> 1) & 7)) << 4);
    }
    f32x16 acc[2][2];
#pragma unroll
    for (int i = 0; i < 2; ++i)
#pragma unroll
        for (int j = 0; j < 2; ++j) acc[i][j] = f32x16{};
#define GSTAGE(kt, buf) do { const u16* _ka = al.kbase(kt); const u16* _kb = bl.kbase(kt); char* _d = lds + (buf) * STG + ldsw; \
        _Pragma("unroll") for (int _i = 0; _i < NA; ++_i) __builtin_amdgcn_global_load_lds((const unsigned*)(_ka + aoff[_i]), (unsigned*)(_d + _i * 8192), 16, 0, 0); \
        _Pragma("unroll") for (int _i = 0; _i < NB; ++_i) __builtin_amdgcn_global_load_lds((const unsigned*)(_kb + boff[_i]), (unsigned*)(_d + BM * 128 + _i * 8192), 16, 0, 0); } while (0)
    __syncthreads();
    GSTAGE(0, 0);
    for (int kt = 0; kt < nk; ++kt) {
        asm volatile("s_waitcnt vmcnt(0)" ::: "memory");
        __syncthreads();
        if (kt + 1 < nk) GSTAGE(kt + 1, (kt + 1) & 1);
        const char* sb = lds + (kt & 1) * STG;
#pragma unroll
        for (int ks = 0; ks < 4; ++ks) {
            bf16x8 a0 = *(const bf16x8*)(sb + (abase[0] ^ (ks << 5)));
            bf16x8 a1 = *(const bf16x8*)(sb + (abase[1] ^ (ks << 5)));
            bf16x8 b0 = *(const bf16x8*)(sb + (bbase[0] ^ (ks << 5)));
            bf16x8 b1 = *(const bf16x8*)(sb + (bbase[1] ^ (ks << 5)));
            acc[0][0] = __builtin_amdgcn_mfma_f32_32x32x16_bf16(a0, b0, acc[0][0], 0, 0, 0);
            acc[0][1] = __builtin_amdgcn_mfma_f32_32x32x16_bf16(a0, b1, acc[0][1], 0, 0, 0);
            acc[1][0] = __builtin_amdgcn_mfma_f32_32x32x16_bf16(a1, b0, acc[1][0], 0, 0, 0);
            acc[1][1] = __builtin_amdgcn_mfma_f32_32x32x16_bf16(a1, b1, acc[1][1], 0, 0, 0);
        }
    }
#undef GSTAGE
    ep(acc, brow + wm * 64, bcol + wn * 64, lane);
}


constexpr int GSTG = 384 * 128;
template <class AL_, class BL_, class EP_> struct GTile { typedef EP_ EPT; AL_ al; BL_ bl; EP_ ep; int brow, bcol; };
__device__ __forceinline__ bool tile_seq(int i, int bx, int G, int nM, int nN, int& m, int& n) {
    const int s = (G == 256) ? (i * 8 + (bx & 7)) * 32 + (bx >> 3) : bx + i * G;
    if (s >= nM * nN) return false;
    const int full = (nM >> 2) * 4 * nN;
    if (s < full) { const int band = s / (4 * nN), rem = s - band * 4 * nN; n = rem >> 2; m = band * 4 + (rem & 3); }
    else { const int h = nM & 3, rem = s - full; n = rem / h; m = (nM & ~3) + rem - n * h; }
    return true;
}
template <class AL_, class BL_, class EP_> struct PlainTiles {
    typedef GTile<AL_, BL_, EP_> Tile; static constexpr bool EP_CONST = true;
    AL_ al; BL_ bl; EP_ ep; int mt0, nM, nN, bx, G;
    __device__ __forceinline__ bool get(int i, Tile& t) const {
        int m, n; if (!tile_seq(i, bx, G, nM, nN, m, n)) return false;
        t.al = al; t.bl = bl; t.ep = ep; t.brow = (mt0 + m) * 256; t.bcol = n * 128; return true; }
};
template <int WM, int WN, class P>
__device__ __forceinline__ void gemm_stream(char* lds, const P& prov, int nk) {
    constexpr int BM = WM * 64, BN = WN * 64, NA = BM / 64, NB = BN / 64;
    static_assert(NA + NB == 6, "the counted wait assumes six LDS-DMA loads per wave per K-step");
    const int tid = threadIdx.x, lane = tid & 63, wid = __builtin_amdgcn_readfirstlane(tid >> 6);
    const int wm = wid / WN, wn = wid % WN, r32 = lane & 31, hi = lane >> 5;
    typename P::Tile cur, nxt;
    if (!prov.get(0, cur)) return;
    unsigned aoff[NA], boff[NB], aoffn[NA], boffn[NB];
#define GOFFS(T, AO, BO) do { \
    _Pragma("unroll") for (int _i = 0; _i < NA; ++_i) { const int _r = (_i * 8 + wid) * 8 + (lane >> 3); const int _c = (lane & 7) ^ ((_r >> 1) & 7); AO[_i] = (unsigned)((T).al.off((T).brow + _r) + _c * 8); } \
    _Pragma("unroll") for (int _i = 0; _i < NB; ++_i) { const int _r = (_i * 8 + wid) * 8 + (lane >> 3); const int _c = (lane & 7) ^ ((_r >> 1) & 7); BO[_i] = (unsigned)((T).bl.off((T).bcol + _r) + _c * 8); } } while (0)
#define GSTAGE2(T, AO, BO, kt, slot) do { const u16* _ka = (T).al.kbase(kt); const u16* _kb = (T).bl.kbase(kt); char* _d = lds + (slot) * GSTG + ldsw; \
        _Pragma("unroll") for (int _i = 0; _i < NA; ++_i) __builtin_amdgcn_global_load_lds((const unsigned*)(_ka + AO[_i]), (unsigned*)(_d + _i * 8192), 16, 0, 0); \
        _Pragma("unroll") for (int _i = 0; _i < NB; ++_i) __builtin_amdgcn_global_load_lds((const unsigned*)(_kb + BO[_i]), (unsigned*)(_d + BM * 128 + _i * 8192), 16, 0, 0); } while (0)
    GOFFS(cur, aoff, boff);
    const int ldsw = wid * 1024 + lane * 16;
    int abase[2], bbase[2];
#pragma unroll
    for (int i = 0; i < 2; ++i) {
        const int ra = wm * 64 + i * 32 + r32; abase[i] = ra * 128 + ((hi ^ ((ra >> 1) & 7)) << 4);
        const int rb = wn * 64 + i * 32 + r32; bbase[i] = BM * 128 + rb * 128 + ((hi ^ ((rb >> 1) & 7)) << 4);
    }
    f32x16 acc[2][2];
#pragma unroll
    for (int i = 0; i < 2; ++i)
#pragma unroll
        for (int j = 0; j < 2; ++j) acc[i][j] = f32x16{};
    __syncthreads();
    GSTAGE2(cur, aoff, boff, 0, 0); GSTAGE2(cur, aoff, boff, 1, 1);
    int slot = 0; bool pendE = false; typename P::Tile::EPT pep = cur.ep; int pbrow = 0, pbcol = 0;
    for (int i = 0;; ++i) {
        const bool has_next = prov.get(i + 1, nxt);
        if (has_next) GOFFS(nxt, aoffn, boffn);
        for (int kt = 0; kt < nk; ++kt) {
            if ((kt + 1 < nk) || has_next) asm volatile("s_waitcnt vmcnt(6)" ::: "memory"); else asm volatile("s_waitcnt vmcnt(0)" ::: "memory");
            __builtin_amdgcn_s_barrier(); asm volatile("" ::: "memory");
            const int s2 = slot >= 1 ? slot - 1 : 2;
            if (kt + 2 < nk) GSTAGE2(cur, aoff, boff, kt + 2, s2); else if (has_next) GSTAGE2(nxt, aoffn, boffn, kt + 2 - nk, s2);
            if (kt == 0 && pendE) {
                if constexpr (P::EP_CONST) (void)prov.ep(acc, pbrow + wm * 64, pbcol + wn * 64, lane); else (void)pep(acc, pbrow + wm * 64, pbcol + wn * 64, lane);
                pendE = false;
#pragma unroll
                for (int a = 0; a < 2; ++a)
#pragma unroll
                    for (int b = 0; b < 2; ++b) acc[a][b] = f32x16{};
            }
            const char* sb = lds + slot * GSTG;
#pragma unroll
            for (int ks = 0; ks < 4; ++ks) {
                bf16x8 a0 = *(const bf16x8*)(sb + (abase[0] ^ (ks << 5)));
                bf16x8 a1 = *(const bf16x8*)(sb + (abase[1] ^ (ks << 5)));
                bf16x8 b0 = *(const bf16x8*)(sb + (bbase[0] ^ (ks << 5)));
                bf16x8 b1 = *(const bf16x8*)(sb + (bbase[1] ^ (ks << 5)));
                acc[0][0] = __builtin_amdgcn_mfma_f32_32x32x16_bf16(b0, a0, acc[0][0], 0, 0, 0);
                acc[0][1] = __builtin_amdgcn_mfma_f32_32x32x16_bf16(b1, a0, acc[0][1], 0, 0, 0);
                acc[1][0] = __builtin_amdgcn_mfma_f32_32x32x16_bf16(b0, a1, acc[1][0], 0, 0, 0);
                acc[1][1] = __builtin_amdgcn_mfma_f32_32x32x16_bf16(b1, a1, acc[1][1], 0, 0, 0);
            }
            slot = slot == 2 ? 0 : slot + 1;
        }
        if (!has_next) { (void)cur.ep(acc, cur.brow + wm * 64, cur.bcol + wn * 64, lane); break; }
        if constexpr (!P::EP_CONST) pep = cur.ep;
        pbrow = cur.brow; pbcol = cur.bcol; pendE = true;
        cur = nxt;
#pragma unroll
        for (int a = 0; a < NA; ++a) aoff[a] = aoffn[a];
#pragma unroll
        for (int b = 0; b < NB; ++b) boff[b] = boffn[b];
    }
    asm volatile("s_waitcnt vmcnt(0)" ::: "memory");
    __syncthreads();
#undef GOFFS
#undef GSTAGE2
}


template <int NF> __device__ __forceinline__ void rope_cs(int n, int i, float& cs, float& sn) {
    const int fi = i & (NF - 1); const float pos = (i < NF) ? (float)(n >> 6) : (float)(n & 63);
    const float invf = __builtin_amdgcn_exp2f(-(float)fi / (float)NF * 13.287712379549449f);
    const float ang = pos * invf; float rev = ang * 0.15915494309189535f; rev -= floorf(rev);
    cs = __builtin_amdgcn_cosf(rev); sn = __builtin_amdgcn_sinf(rev);
}
namespace pg8 {
constexpr int BM = 256, BK = 64, HALF = 128, HTB = HALF * BK * 2, STAGE_BYTES = 8 * HTB;
__device__ __forceinline__ int lds_byte(int r, int c) { const int st = (r >> 4) * 2 + (c >> 5), rr = r & 15, cc = c & 31, ob = rr * 64 + cc * 2; return st * 1024 + (ob ^ (((ob >> 9) & 1) << 5)); }
__device__ __forceinline__ void stage_rc(int b, int& R, int& C) { const int st = b / 1024, sb = b % 1024, swz = sb ^ (((sb >> 9) & 1) << 5); R = (st >> 1) * 16 + swz / 64; C = (st & 1) * 32 + (swz % 64) / 2; }
struct Unit { int pm, pn; };
template <class Epi, class Sched>
__device__ __forceinline__ void gemm_phase(char* lds, const u16* A, int K, const Sched& S, const Epi& E) {
    constexpr bool GA = Sched::GATHER;
    const int tid = threadIdx.x, wid = __builtin_amdgcn_readfirstlane(tid >> 6), lane = tid & 63, wr = wid >> 2, wc = wid & 3, fr = lane & 15, fq = lane >> 4;
    const int nt = K / BK;
    unsigned voffB[2], vc0[2], vc1[2], vn0[2], vn1[2]; int sR[2], sC[2];
#pragma unroll
    for (int i = 0; i < 2; ++i) { stage_rc(tid * 16 + i * 8192, sR[i], sC[i]); voffB[i] = (unsigned)(sR[i] * K + sC[i]) * 2u; }
    const size_t kstep = (size_t)(BK * 2), hstep = (size_t)HALF * K * 2;
    const unsigned ldsw = (unsigned)wid * 1024u;
    const int aoff = lds_byte(wr * 64 + fr, fq * 8), boff = lds_byte(wc * 32 + fr, fq * 8);
#define PG8_AOFFS(u, v0, v1) do { _Pragma("unroll") for (int _i = 0; _i < 2; ++_i) { \
        if constexpr (GA) { v0[_i] = (unsigned)S.arow(u, sR[_i]) * (unsigned)(K * 2) + (unsigned)sC[_i] * 2u; v1[_i] = (unsigned)S.arow(u, HALF + sR[_i]) * (unsigned)(K * 2) + (unsigned)sC[_i] * 2u; } \
        else { v0[_i] = (unsigned)((u).pm * 256 + sR[_i]) * (unsigned)(K * 2) + (unsigned)sC[_i] * 2u; v1[_i] = v0[_i] + (unsigned)hstep; } } } while (0)
#define PG8_SA(b, h) (((b) * 2 + (h)) * HTB)
#define PG8_SB(b, h) ((4 + (b) * 2 + (h)) * HTB)
#define PG8_STAGE(bufoff, gbase, voff) do { _Pragma("unroll") for (int _i = 0; _i < 2; ++_i) \
        __builtin_amdgcn_global_load_lds((const unsigned*)((const char*)(gbase) + (voff)[_i]), (unsigned*)(lds + (bufoff) + ldsw + _i * 8192), 16, 0, 0); } while (0)
#define PG8_STA(bufoff, kt, h, nx) do { const char* _g = (const char*)A + (size_t)(kt) * kstep; unsigned _v[2]; \
        _Pragma("unroll") for (int _i = 0; _i < 2; ++_i) _v[_i] = (nx) ? ((h) ? vn1[_i] : vn0[_i]) : ((h) ? vc1[_i] : vc0[_i]); PG8_STAGE(bufoff, _g, _v); } while (0)
#define PG8_LDA(dst, b, h) do { _Pragma("unroll") for (int m = 0; m < 4; ++m) _Pragma("unroll") for (int k = 0; k < 2; ++k) dst[m][k] = *(const bf16x8*)(lds + PG8_SA(b, h) + aoff + m * 2048 + k * 1024); } while (0)
#define PG8_LDB(dst, b, h) do { _Pragma("unroll") for (int n = 0; n < 2; ++n) _Pragma("unroll") for (int k = 0; k < 2; ++k) dst[n][k] = *(const bf16x8*)(lds + PG8_SB(b, h) + boff + n * 2048 + k * 1024); } while (0)
#define PG8_MMA(ai, bj, At, Bt_) do { __builtin_amdgcn_s_setprio(1); _Pragma("unroll") for (int m = 0; m < 4; ++m) _Pragma("unroll") for (int n = 0; n < 2; ++n) _Pragma("unroll") for (int k = 0; k < 2; ++k) \
        acc[ai][bj][m][n] = __builtin_amdgcn_mfma_f32_16x16x32_bf16(Bt_[n][k], At[m][k], acc[ai][bj][m][n], 0, 0, 0); __builtin_amdgcn_s_setprio(0); } while (0)
#define PG8_WAIT_V(n) asm volatile("s_waitcnt vmcnt(" #n ")" ::: "memory")
#define PG8_WAIT_L(n) asm volatile("s_waitcnt lgkmcnt(" #n ")" ::: "memory")
#define PG8_BAR __builtin_amdgcn_s_barrier()
#define PG8_SCHED __builtin_amdgcn_sched_barrier(0)
    Unit cur, nxt; int ui = 0;
    if (!S.next(0, cur)) return;
    f32x4 acc[2][2][4][2];
#pragma unroll
    for (int a = 0; a < 2; ++a)
#pragma unroll
        for (int b = 0; b < 2; ++b)
#pragma unroll
            for (int m = 0; m < 4; ++m)
#pragma unroll
                for (int n = 0; n < 2; ++n) acc[a][b][m][n] = (f32x4){0.f, 0.f, 0.f, 0.f};
    bf16x8 At[4][2], B0[2][2], B1[2][2];
    PG8_AOFFS(cur, vc0, vc1);
    const char* cB = (const char*)S.bbase(cur);
    __syncthreads();
    PG8_STAGE(PG8_SB(0, 0), cB, voffB); PG8_STA(PG8_SA(0, 0), 0, 0, false); PG8_STAGE(PG8_SB(0, 1), cB + hstep, voffB); PG8_STA(PG8_SA(0, 1), 0, 1, false);
    if (wr == 1) PG8_BAR;
    PG8_WAIT_V(4); PG8_BAR;
    PG8_STAGE(PG8_SB(1, 0), cB + kstep, voffB); PG8_STA(PG8_SA(1, 0), 1, 0, false); PG8_STAGE(PG8_SB(1, 1), cB + hstep + kstep, voffB);
    PG8_WAIT_V(6); PG8_BAR;
    for (;;) {
        const bool has_next = S.next(ui + 1, nxt);
        const char* nB = cB;
        if (has_next) { PG8_AOFFS(nxt, vn0, vn1); nB = (const char*)S.bbase(nxt); }
        else {
#pragma unroll
            for (int i = 0; i < 2; ++i) { vn0[i] = vc0[i]; vn1[i] = vc1[i]; } }
        for (int t = 0; t < nt; t += 2) {
            const bool last = (t == nt - 2);
            const int k2 = last ? 0 : t + 2, k3 = k2 + 1;
            const char* b2 = last ? nB : cB + (size_t)(t + 2) * kstep; const char* b3 = b2 + kstep;
            PG8_LDB(B0, 0, 0); PG8_SCHED; PG8_LDA(At, 0, 0); PG8_STA(PG8_SA(1, 1), t + 1, 1, false);
            PG8_WAIT_L(8); PG8_BAR; PG8_WAIT_L(0); PG8_MMA(0, 0, At, B0); PG8_BAR; PG8_SCHED;
            PG8_LDB(B1, 0, 1); PG8_STAGE(PG8_SB(0, 0), b2, voffB);
            PG8_BAR; PG8_WAIT_L(0); PG8_MMA(0, 1, At, B1); PG8_BAR;
            PG8_LDA(At, 0, 1); PG8_STA(PG8_SA(0, 0), k2, 0, last);
            PG8_BAR; PG8_WAIT_L(0); PG8_MMA(1, 0, At, B0); PG8_BAR; PG8_SCHED;
            PG8_STAGE(PG8_SB(0, 1), b2 + hstep, voffB);
            PG8_WAIT_V(6); PG8_BAR; PG8_MMA(1, 1, At, B1); PG8_BAR;
            PG8_LDB(B0, 1, 0); PG8_SCHED; PG8_LDA(At, 1, 0); PG8_STA(PG8_SA(0, 1), k2, 1, last);
            PG8_WAIT_L(8); PG8_BAR; PG8_WAIT_L(0); PG8_MMA(0, 0, At, B0); PG8_BAR; PG8_SCHED;
            PG8_LDB(B1, 1, 1); PG8_STAGE(PG8_SB(1, 0), b3, voffB);
            PG8_BAR; PG8_WAIT_L(0); PG8_MMA(0, 1, At, B1); PG8_BAR;
            PG8_LDA(At, 1, 1); PG8_STA(PG8_SA(1, 0), k3, 0, last);
            PG8_BAR; PG8_WAIT_L(0); PG8_MMA(1, 0, At, B0); PG8_BAR; PG8_SCHED;
            PG8_STAGE(PG8_SB(1, 1), b3 + hstep, voffB);
            PG8_WAIT_V(6); PG8_BAR; PG8_MMA(1, 1, At, B1); PG8_BAR;
        }
        E(acc, cur, wr, wc, fr, fq);
        if (!has_next) break;
#pragma unroll
        for (int a = 0; a < 2; ++a)
#pragma unroll
            for (int b = 0; b < 2; ++b)
#pragma unroll
                for (int m = 0; m < 4; ++m)
#pragma unroll
                    for (int n = 0; n < 2; ++n) acc[a][b][m][n] = (f32x4){0.f, 0.f, 0.f, 0.f};
        cur = nxt; cB = nB; ++ui;
#pragma unroll
        for (int i = 0; i < 2; ++i) { vc0[i] = vn0[i]; vc1[i] = vn1[i]; }
    }
    PG8_WAIT_V(0);
    if (wr == 0) PG8_BAR;
    PG8_BAR;
#undef PG8_AOFFS
#undef PG8_STA
#undef PG8_SA
#undef PG8_SB
#undef PG8_STAGE
#undef PG8_LDA
#undef PG8_LDB
#undef PG8_MMA
#undef PG8_WAIT_V
#undef PG8_WAIT_L
#undef PG8_BAR
#undef PG8_SCHED
}
struct SeqOrder { static constexpr bool GATHER = false; const u16* Bt; int K, nM, nN, bx, G, mt0;
    __device__ __forceinline__ bool next(int i, Unit& u) const { const bool ok = tile_seq(i, bx, G, nM, nN, u.pm, u.pn); u.pm += mt0; return ok; }
    __device__ __forceinline__ const u16* bbase(const Unit& u) const { return Bt + (size_t)u.pn * 256 * K; }
    __device__ __forceinline__ int arow(const Unit& u, int r) const { return u.pm * 256 + r; } };
struct EpiGlaIn8 { u16* q; u16* k; u16* v; u16* g; float* z;
    __device__ __forceinline__ void operator()(const f32x4 (&acc)[2][2][4][2], const Unit& u, int wr, int wc, int fr, int fq) const {
#pragma unroll
        for (int bj = 0; bj < 2; ++bj)
#pragma unroll
            for (int n = 0; n < 2; ++n) { const int c0 = u.pn * 256 + bj * 128 + wc * 32 + n * 16, col = c0 + 4 * fq;
                if (c0 >= 3104) continue;
                u16* base; int ld, cc; float scl = 1.f;
                if (c0 < 512) { base = q; ld = 512; cc = col; scl = 0.08838834764831845f; } else if (c0 < 1024) { base = k; ld = 512; cc = col - 512; }
                else if (c0 < 2048) { base = v; ld = 1024; cc = col - 1024; } else if (c0 < 3072) { base = g; ld = 1024; cc = col - 2048; } else { base = nullptr; ld = 32; cc = col - 3072; }
#pragma unroll
                for (int ai = 0; ai < 2; ++ai)
#pragma unroll
                    for (int m = 0; m < 4; ++m) { const size_t row = (size_t)u.pm * 256 + ai * 128 + wr * 64 + m * 16 + fr; const f32x4 a = acc[ai][bj][m][n];
                        if (c0 < 3072) { u32x2 w = {cvtpk(a[0] * scl, a[1] * scl), cvtpk(a[2] * scl, a[3] * scl)}; *(u32x2*)(base + row * ld + cc) = w; }
                        else *(f32x4*)(z + row * 32 + cc) = a; } }
    } };
struct EpiDiffQKV8 { u16* Q; long kdelta; u16* V; float qscale;
    __device__ __forceinline__ void operator()(const f32x4 (&acc)[2][2][4][2], const Unit& u, int wr, int wc, int fr, int fq) const {
#pragma unroll
        for (int ai = 0; ai < 2; ++ai)
#pragma unroll
            for (int m = 0; m < 4; ++m) { int frr = fr; asm volatile("" : "+v"(frr));
                const int row = u.pm * 256 + ai * 128 + wr * 64 + m * 16 + frr; int b, pos; row_bp(row, b, pos); const bool lat = row >= NCTX; const int np = (row - NCTX) & (SEQ - 1);
                if (u.pn < 8) { const int region = u.pn >> 2, hh = (u.pn & 3) * 4 + wc; const float scl = region == 0 ? qscale : 1.f;
                    u16* o = Q + (long)region * kdelta + ((size_t)(b * 16 + hh) * KEYS + pos) * 64;
#pragma unroll
                    for (int n = 0; n < 2; ++n) { const int d0 = 16 * n + 4 * fq; const f32x4 t1 = acc[ai][0][m][n], t2 = acc[ai][1][m][n]; float o1[4], o2[4];
#pragma unroll
                        for (int j = 0; j < 4; ++j) { float cs = 1.f, sn = 0.f; if (lat) rope_cs<16>(np, d0 + j, cs, sn); o1[j] = (t1[j] * cs - t2[j] * sn) * scl; o2[j] = (t1[j] * sn + t2[j] * cs) * scl; }
                        u32x2 w1 = {cvtpk(o1[0], o1[1]), cvtpk(o1[2], o1[3])}, w2 = {cvtpk(o2[0], o2[1]), cvtpk(o2[2], o2[3])};
                        *(u32x2*)(o + d0) = w1; *(u32x2*)(o + 32 + d0) = w2; }
                } else {
#pragma unroll
                    for (int bj = 0; bj < 2; ++bj) { const int head = (u.pn - 8) * 2 + bj; u16* o = V + ((size_t)(b * 8 + head) * KEYS + pos) * 128 + wc * 32 + 4 * fq;
#pragma unroll
                        for (int n = 0; n < 2; ++n) { const f32x4 a = acc[ai][bj][m][n]; u32x2 w = {cvtpk(a[0], a[1]), cvtpk(a[2], a[3])}; *(u32x2*)(o + 16 * n) = w; } }
                } }
    } };
struct MoeAOrder { static constexpr bool GATHER = true; const int* tab; const int* rowtok; const u16* wgu; int nmt, bx, G;
    __device__ __forceinline__ bool next(int i, Unit& u) const { return tile_seq(i, bx, G, nmt, 8, u.pm, u.pn); }
    __device__ __forceinline__ const u16* bbase(const Unit& u) const {
        const int c = tab[32 + u.pm], g = c / 6, p = c - g * 6; const int elo = p < 3 ? 0 : (p < 5 ? 1 : 2), ehi = p < 3 ? p + 1 : (p < 5 ? p - 1 : 3);
        const int e = (u.pn >> 2) ? ehi : elo; return wgu + ((size_t)(g * 4 + e) * 1024 + (u.pn & 3) * 256) * 1024; }
    __device__ __forceinline__ int arow(const Unit& u, int r) const { const int t = rowtok[u.pm * 256 + r]; return t < 0 ? 0 : t; } };
struct EpiMoeA8 { u16* act; const float* roww;
    __device__ __forceinline__ void operator()(const f32x4 (&acc)[2][2][4][2], const Unit& u, int wr, int wc, int fr, int fq) const {
        const int half = u.pn >> 2, cb = half * 512 + (u.pn & 3) * 128 + wc * 32 + 4 * fq;
#pragma unroll
        for (int ai = 0; ai < 2; ++ai)
#pragma unroll
            for (int m = 0; m < 4; ++m) { const size_t row = (size_t)u.pm * 256 + ai * 128 + wr * 64 + m * 16 + fr; const float w = roww[2 * row + half];
#pragma unroll
                for (int n = 0; n < 2; ++n) { const f32x4 gt = acc[ai][0][m][n], up = acc[ai][1][m][n]; float v[4];
#pragma unroll
                    for (int j = 0; j < 4; ++j) v[j] = silu_f(gt[j]) * up[j] * w;
                    u32x2 pk = {cvtpk(v[0], v[1]), cvtpk(v[2], v[3])}; *(u32x2*)(act + row * 1024 + cb + 16 * n) = pk; } }
    } };
}

template <int DK, int DV> struct AttnCfg {
    static constexpr int NKB = DK / 32, NVB = DV / 32, ND0 = DK / 16;
    static constexpr int KBYTES = 64 * DK * 2, VBYTES = 64 * DV * 2;
    static constexpr int LDS = 2 * KBYTES + 2 * VBYTES + NWAVE * 64 * 4;
};
constexpr float ATT_THR = 8.f;

__device__ __forceinline__ void partialSM(f32x16& p0, f32x16& p1, float& m_reg, float& mn, float& alpha) {
    float pmax = p0[0];
#pragma unroll
    for (int r = 1; r < 16; ++r) pmax = fmaxf(pmax, p0[r]);
#pragma unroll
    for (int r = 0; r < 16; ++r) pmax = fmaxf(pmax, p1[r]);
    { auto rr = __builtin_amdgcn_permlane32_swap(__float_as_uint(pmax), __float_as_uint(pmax), false, false);
      pmax = fmaxf(__uint_as_float(rr[0]), __uint_as_float(rr[1])); }
    if (__builtin_expect(__all(pmax - m_reg <= ATT_THR), 1)) { mn = m_reg; alpha = 1.f; }
    else { mn = fmaxf(m_reg, pmax); alpha = __builtin_amdgcn_exp2f(m_reg - mn); m_reg = mn; }
#pragma unroll
    for (int r = 0; r < 16; ++r) p0[r] = p0[r] - mn;
#pragma unroll
    for (int r = 0; r < 16; ++r) p1[r] = p1[r] - mn;
#pragma unroll
    for (int r = 0; r < 16; ++r) p0[r] = __builtin_amdgcn_exp2f(p0[r]);
}
#define PK4(P, BASE, OUT) do { unsigned a0 = cvtpk(P[BASE + 0], P[BASE + 1]), a1 = cvtpk(P[BASE + 2], P[BASE + 3]);   \
    unsigned b0 = cvtpk(P[BASE + 4], P[BASE + 5]), b1 = cvtpk(P[BASE + 6], P[BASE + 7]);                              \
    auto r0 = __builtin_amdgcn_permlane32_swap(a0, b0, false, false); auto r1 = __builtin_amdgcn_permlane32_swap(a1, b1, false, false); \
    u32x4 w = {r0[0], r1[0], r0[1], r1[1]}; OUT = *reinterpret_cast<bf16x8*>(&w); } while (0)
__device__ __forceinline__ void finishSM(f32x16& p0, f32x16& p1, float alpha, float& l_reg, bf16x8& pa0, bf16x8& pa1, bf16x8& pa2, bf16x8& pa3) {
#pragma unroll
    for (int r = 0; r < 16; ++r) p1[r] = __builtin_amdgcn_exp2f(p1[r]);
    float ps = 0;
#pragma unroll
    for (int r = 0; r < 16; ++r) ps += p0[r];
#pragma unroll
    for (int r = 0; r < 16; ++r) ps += p1[r];
    { auto rr = __builtin_amdgcn_permlane32_swap(__float_as_uint(ps), __float_as_uint(ps), false, false);
      ps = __uint_as_float(rr[0]) + __uint_as_float(rr[1]); }
    l_reg = l_reg * alpha + ps;
    PK4(p0, 0, pa0); PK4(p0, 8, pa1); PK4(p1, 0, pa2); PK4(p1, 8, pa3);
}
template <bool FIRST, bool KEEPN>
__device__ __forceinline__ void psm_rel(f32x16& p0, f32x16& p1, float& m_reg, f32x16& negm, float& alpha) {
    float pmax = fmaxf(p0[0], p1[0]);
#pragma unroll
    for (int r = 1; r < 16; ++r) pmax = fmaxf(pmax, fmaxf(p0[r], p1[r]));
    { auto rr = __builtin_amdgcn_permlane32_swap(__float_as_uint(pmax), __float_as_uint(pmax), false, false);
      pmax = fmaxf(__uint_as_float(rr[0]), __uint_as_float(rr[1])); }
    alpha = 1.f;
    if (FIRST || !__builtin_expect(__all(pmax <= ATT_THR), 1)) {
        const float d = FIRST ? pmax : fmaxf(pmax, 0.f);
        if (!FIRST) alpha = __builtin_amdgcn_exp2f(-d);
        m_reg += d;
#pragma unroll
        for (int r = 0; r < 16; ++r) { p0[r] -= d; p1[r] -= d; if (KEEPN) negm[r] = -m_reg; }
    }
#pragma unroll
    for (int r = 0; r < 16; ++r) p0[r] = __builtin_amdgcn_exp2f(p0[r]);
}
__device__ __forceinline__ bf16x8 pack8(const f32x16& p, int base) {
    u32x4 w = {cvtpk(p[base], p[base + 1]), cvtpk(p[base + 2], p[base + 3]), cvtpk(p[base + 4], p[base + 5]), cvtpk(p[base + 6], p[base + 7])};
    return *reinterpret_cast<bf16x8*>(&w);
}
__device__ __forceinline__ void fsm_rel(f32x16& p0, f32x16& p1, bf16x8& pa0, bf16x8& pa1, bf16x8& pa2, bf16x8& pa3) {
#pragma unroll
    for (int r = 0; r < 16; ++r) p1[r] = __builtin_amdgcn_exp2f(p1[r]);
    pa0 = pack8(p0, 0); pa1 = pack8(p0, 8); pa2 = pack8(p1, 0); pa3 = pack8(p1, 8);
}
__device__ __forceinline__ int k_lds_off(int row, int blk, int chunk) { return blk * 4096 + row * 64 + ((chunk ^ ((row >> 2) & 3)) << 4); }
template <int ND0>
__device__ __forceinline__ void qkt(f32x16& p0, f32x16& p1, const char* Ks, const bf16x8* qr, int r32, int hi, const f32x16& cinit) {
    p0 = cinit; p1 = cinit;
#pragma unroll
    for (int d0 = 0; d0 < ND0; ++d0) {
        const int ch = (d0 & 1) * 2 + hi;
        bf16x8 b0 = *reinterpret_cast<const bf16x8*>(Ks + k_lds_off(r32, d0 >> 1, ch));
        bf16x8 b1 = *reinterpret_cast<const bf16x8*>(Ks + k_lds_off(32 + r32, d0 >> 1, ch));
        p0 = __builtin_amdgcn_mfma_f32_32x32x16_bf16(b0, qr[d0], p0, 0, 0, 0);
        p1 = __builtin_amdgcn_mfma_f32_32x32x16_bf16(b1, qr[d0], p1, 0, 0, 0);
    }
}
template <int NVB, bool SWAP = true> __device__ __forceinline__ int v_st(int k, int c) {
    const int kk = SWAP ? ((k & ~0xC) | ((k & 4) << 1) | ((k & 8) >> 1)) : k;
    return ((kk >> 3) * NVB + (c >> 5)) * 512 + ((kk & 7) * 32 + (c & 31)) * 2;
}
__device__ __forceinline__ int v_rd_base(int lane) { return ((lane & 3) << 3) | (((lane >> 2) & 3) << 6) | (((lane >> 4) & 1) << 5) | (((lane >> 5) & 1) << 8); }
template <int OFF> __device__ __forceinline__ s16x4 tr_read(int vb) {
    s16x4 r; asm volatile("ds_read_b64_tr_b16 %0, %1 offset:%2" : "=&v"(r) : "v"(vb), "i"(OFF) : "memory"); return r;
}
#define PKV(L, H) (bf16x8){L[0], L[1], L[2], L[3], H[0], H[1], H[2], H[3]}
template <int D0, int NVB> __device__ __forceinline__ void pv_one(f32x16& od, int vb, bf16x8 pa0, bf16x8 pa1, bf16x8 pa2, bf16x8 pa3) {
    constexpr int KS = 2 * NVB * 512, HF = NVB * 512, B0 = D0 * 512;
    const s16x4 l0 = tr_read<B0 + 0 * KS>(vb), h0 = tr_read<B0 + 0 * KS + HF>(vb), l1 = tr_read<B0 + 1 * KS>(vb), h1 = tr_read<B0 + 1 * KS + HF>(vb);
    const s16x4 l2 = tr_read<B0 + 2 * KS>(vb), h2 = tr_read<B0 + 2 * KS + HF>(vb), l3 = tr_read<B0 + 3 * KS>(vb), h3 = tr_read<B0 + 3 * KS + HF>(vb);
    asm volatile("s_waitcnt lgkmcnt(0)" ::: "memory"); SBAR();
    od = __builtin_amdgcn_mfma_f32_32x32x16_bf16(pa0, PKV(l0, h0), od, 0, 0, 0);
    od = __builtin_amdgcn_mfma_f32_32x32x16_bf16(pa1, PKV(l1, h1), od, 0, 0, 0);
    od = __builtin_amdgcn_mfma_f32_32x32x16_bf16(pa2, PKV(l2, h2), od, 0, 0, 0);
    od = __builtin_amdgcn_mfma_f32_32x32x16_bf16(pa3, PKV(l3, h3), od, 0, 0, 0);
}
template <int NVB> __device__ __forceinline__ void pv_all(f32x16* o, int vb, bf16x8 pa0, bf16x8 pa1, bf16x8 pa2, bf16x8 pa3) {
    pv_one<0, NVB>(o[0], vb, pa0, pa1, pa2, pa3); pv_one<1, NVB>(o[1], vb, pa0, pa1, pa2, pa3);
    if constexpr (NVB == 4) { pv_one<2, NVB>(o[2], vb, pa0, pa1, pa2, pa3); pv_one<3, NVB>(o[3], vb, pa0, pa1, pa2, pa3); }
}

template <int DK, int DV>
__device__ __forceinline__ void attn_item(const u16* __restrict__ Qb, const u16* __restrict__ Ka, const u16* __restrict__ Kb, const u16* __restrict__ Vh,
                                          int nkeys, u16* __restrict__ Ob, long ldo, char* lds) {
    using C = AttnCfg<DK, DV>;
    constexpr int NVB = C::NVB, ND0 = C::ND0, NKI = (DK / 32) * 4, NVI = DV / 8, NI = NKI + NVI;
    static_assert(NI <= 24, "three LDS-DMA pieces per wave per tile");
    const int tid = threadIdx.x, wid = __builtin_amdgcn_readfirstlane(tid >> 6), lane = tid & 63, r32 = lane & 31, hi = lane >> 5;
    char* K_lds = lds; char* V_lds = lds + 3 * C::KBYTES;
    float* al_l = (float*)(lds + 3 * C::KBYTES + 3 * C::VBYTES) + wid * 32;
    float m_reg = 0.f; f32x16 o[NVB], ol, negm; bf16x8 qr[ND0];
#pragma unroll
    for (int d = 0; d < NVB; ++d) o[d] = f32x16{};
    ol = f32x16{}; negm = f32x16{};
    const u32x4 ones_w = {0x3F803F80u, 0x3F803F80u, 0x3F803F80u, 0x3F803F80u}; const bf16x8 ones = *reinterpret_cast<const bf16x8*>(&ones_w);
    const u16* Qw = Qb + (long)(wid * 32 + r32) * DK + hi * 8;
#pragma unroll
    for (int d0 = 0; d0 < ND0; ++d0) qr[d0] = *reinterpret_cast<const bf16x8*>(Qw + d0 * 16);
    const u16* src[3]; int dst[3], stp[3]; bool isk[3];
#pragma unroll
    for (int i = 0; i < 3; ++i) { int q = wid + 8 * i; if (q >= NI) q -= 8;
        if (q < NKI) { const int blk = q >> 2, part = q & 3, row = 16 * part + (lane >> 2), c = (lane & 3) ^ ((row >> 2) & 3);
            isk[i] = true; dst[i] = blk * 4096 + part * 1024 + lane * 16;
            if (DK == 96 && blk == 2) { src[i] = Kb + row * 32 + c * 8; stp[i] = 64 * 32; } else { src[i] = Ka + row * 64 + blk * 32 + c * 8; stp[i] = 64 * 64; } }
        else { const int v = q - NKI; int key, col;
            if (NVB == 2) { key = 8 * v + ((lane & 31) >> 2); col = (lane >> 5) * 32 + (lane & 3) * 8; }
            else { key = 8 * (v >> 1) + ((lane & 31) >> 2); col = ((v & 1) * 2 + (lane >> 5)) * 32 + (lane & 3) * 8; }
            isk[i] = false; dst[i] = 3 * C::KBYTES + v * 1024 + lane * 16; src[i] = Vh + key * DV + col; stp[i] = 64 * DV; } }
    const int NT = nkeys / 64;
#define LOADG(kt, vt) do { const int _kt = (kt) < NT ? (kt) : NT - 1, _vt = (vt) < NT ? (vt) : NT - 1; const int _ks = _kt % 3, _vs = _vt % 3; \
        _Pragma("unroll") for (int _i = 0; _i < 3; ++_i) { const int _t = isk[_i] ? _kt : _vt; const int _so = isk[_i] ? _ks * C::KBYTES : _vs * C::VBYTES; \
            __builtin_amdgcn_global_load_lds((const unsigned*)(src[_i] + (long)_t * stp[_i]), (unsigned*)(lds + _so + dst[_i]), 16, 0, 0); } } while (0)
#define RESC(a) do { if (__any((a) < 1.f)) { if (hi == 0) al_l[r32] = (a); asm volatile("s_waitcnt lgkmcnt(0)" ::: "memory"); \
        _Pragma("unroll") for (int r = 0; r < 16; ++r) { const float _f = al_l[crow(r, hi)]; ol[r] *= _f; _Pragma("unroll") for (int d = 0; d < NVB; ++d) o[d][r] *= _f; } } } while (0)
#define PVL(vb) do { pv_all<NVB>(o, (vb), pa0, pa1, pa2, pa3); \
        ol = __builtin_amdgcn_mfma_f32_32x32x16_bf16(pa0, ones, ol, 0, 0, 0); ol = __builtin_amdgcn_mfma_f32_32x32x16_bf16(pa1, ones, ol, 0, 0, 0); \
        ol = __builtin_amdgcn_mfma_f32_32x32x16_bf16(pa2, ones, ol, 0, 0, 0); ol = __builtin_amdgcn_mfma_f32_32x32x16_bf16(pa3, ones, ol, 0, 0, 0); } while (0)
#define NEGM() do { if constexpr (DV == 128) { _Pragma("unroll") for (int r = 0; r < 16; ++r) negm[r] = -m_reg; } } while (0)
#define TILEBAR(n) do { if ((n) == 3) asm volatile("s_waitcnt vmcnt(3)" ::: "memory"); else asm volatile("s_waitcnt vmcnt(0)" ::: "memory"); __builtin_amdgcn_s_barrier(); asm volatile("" ::: "memory"); } while (0)
    const int vrb = (int)(uintptr_t)V_lds + v_rd_base(lane);
    f32x16 pA0, pA1, pB0, pB1; float alA, alB; bf16x8 pa0, pa1, pa2, pa3;
    __syncthreads();
    LOADG(0, 0); LOADG(1, 0);
    TILEBAR(3); LOADG(2, 1);
    qkt<ND0>(pA0, pA1, K_lds, qr, r32, hi, negm); psm_rel<true, DV != 128>(pA0, pA1, m_reg, negm, alA);
    int ks = 1, vs = 0;
    for (int j = 1; j + 1 < NT; j += 2) {
        TILEBAR(3); LOADG(j + 2, j + 1);
        SBAR(); NEGM(); qkt<ND0>(pB0, pB1, K_lds + ks * C::KBYTES, qr, r32, hi, negm);
        fsm_rel(pA0, pA1, pa0, pa1, pa2, pa3); SBAR();
        PVL(vrb + vs * C::VBYTES); psm_rel<false, DV != 128>(pB0, pB1, m_reg, negm, alB);
        RESC(alB);
        ks = ks == 2 ? 0 : ks + 1; vs = vs == 2 ? 0 : vs + 1;
        TILEBAR(3); LOADG(j + 3, j + 2);
        SBAR(); NEGM(); qkt<ND0>(pA0, pA1, K_lds + ks * C::KBYTES, qr, r32, hi, negm);
        fsm_rel(pB0, pB1, pa0, pa1, pa2, pa3); SBAR();
        PVL(vrb + vs * C::VBYTES); psm_rel<false, DV != 128>(pA0, pA1, m_reg, negm, alA);
        RESC(alA);
        ks = ks == 2 ? 0 : ks + 1; vs = vs == 2 ? 0 : vs + 1;
    }
    TILEBAR(3);
    SBAR(); NEGM(); qkt<ND0>(pB0, pB1, K_lds + ks * C::KBYTES, qr, r32, hi, negm);
    fsm_rel(pA0, pA1, pa0, pa1, pa2, pa3); SBAR();
    PVL(vrb + vs * C::VBYTES); psm_rel<false, DV != 128>(pB0, pB1, m_reg, negm, alB);
    RESC(alB);
    vs = vs == 2 ? 0 : vs + 1;
    TILEBAR(0);
    fsm_rel(pB0, pB1, pa0, pa1, pa2, pa3); SBAR();
    PVL(vrb + vs * C::VBYTES);
    u16* Ow = Ob + (long)(wid * 32) * ldo;
#pragma unroll
    for (int r = 0; r < 16; ++r) { const int orow = crow(r, hi); const float rl = __builtin_amdgcn_rcpf(ol[r]);
#pragma unroll
        for (int d0 = 0; d0 < NVB; ++d0) Ow[(long)orow * ldo + d0 * 32 + r32] = f2bf(o[d0][r] * rl); }
#undef LOADG
#undef RESC
#undef PVL
#undef NEGM
#undef TILEBAR
}

struct Frame {
    const Params* p; unsigned char* ws; char* lds; float* out; int G, bx;
    __device__ __forceinline__ const float* in(int i) const { return p->in[i]; }
    template <class T> __device__ __forceinline__ T* W(size_t off) const { return (T*)(ws + off); }
};
constexpr int LDS_BYTES = 163840;
constexpr int LDS_BARW  = LDS_BYTES - 16;
constexpr int LDS_TAB   = 147456;

struct ResCtx { const char* src0; long srcd; char* dst0; long dstd; const float* mods;
    __device__ __forceinline__ const float* row_in(int row, int) const { return (const float*)(src0 + (row >= NCTX ? srcd : 0L) + (long)row * (DM * 4)); }
    __device__ __forceinline__ float* row_out(int row) const { return (float*)(dst0 + (row >= NCTX ? dstd : 0L) + (long)row * (DM * 4)); }
    __device__ __forceinline__ const float* mod(int li, int row, int which) const {
        const int mr = row < NCTX ? 4 : ((row - NCTX) >> 13); return mods + (size_t)(li * 5 + mr) * 6144 + which * 1024; }
};
__device__ __forceinline__ ResCtx res_ctx(const Frame& F, bool first = false) {
    const char* sc = (const char*)(first ? F.in(2) : (const float*)F.W<float>(WS_XC)); const char* sl = (const char*)(first ? F.in(0) : (const float*)F.out) - (long)NCTX * DM * 4;
    char* dc = (char*)F.W<float>(WS_XC); char* dl = (char*)F.out - (long)NCTX * DM * 4;
    return ResCtx{sc, (long)(sl - sc), dc, (long)(dl - dc), F.W<float>(WS_MODS)};
}
__device__ __forceinline__ const float* xrow_in(const Frame& F, int row, bool first) { return res_ctx(F, first).row_in(row, 0); }
__device__ __forceinline__ float* xrow_out(const Frame& F, int row) { return res_ctx(F).row_out(row); }
__device__ __forceinline__ const float* mod_vec(const Frame& F, int li, int row, int which) { return res_ctx(F).mod(li, row, which); }

struct EpiResid8 { ResCtx F; int li;
    __device__ __forceinline__ void operator()(const f32x4 (&acc)[2][2][4][2], const pg8::Unit& u, int wr, int wc, int fr, int fq) const {
#pragma unroll
        for (int ai = 0; ai < 2; ++ai)
#pragma unroll
            for (int m = 0; m < 4; ++m) { int frr = fr; asm volatile("" : "+v"(frr));
                const int row = u.pm * 256 + ai * 128 + wr * 64 + m * 16 + frr, c0 = u.pn * 256 + wc * 32 + 4 * fq;
                const float* xi = F.row_in(row, 0) + c0; float* xo = F.row_out(row) + c0; const float* gt = F.mod(li, row, 2) + c0;
#pragma unroll
                for (int bj = 0; bj < 2; ++bj)
#pragma unroll
                    for (int n = 0; n < 2; ++n) { const int c = bj * 128 + n * 16; const f32x4 x = *(const f32x4*)(xi + c), g = *(const f32x4*)(gt + c), a = acc[ai][bj][m][n];
                        f32x4 o = {x[0] + g[0] * a[0], x[1] + g[1] * a[1], x[2] + g[2] * a[2], x[3] + g[3] * a[3]}; *(f32x4*)(xo + c) = o; } }
    } };

__device__ __forceinline__ void p0_mods(const Frame& F) {
    float* s = (float*)F.lds; float* red = s + 5 * 1024;
    const int tid = threadIdx.x, lane = tid & 63, wid = tid >> 6;
    for (int i = tid; i < 5 * 1024; i += NTHR) { const int r = i >> 10, k = i & 1023; const float v = r < 4 ? F.in(1)[r * 1024 + k] : F.in(3)[k]; s[i] = silu_f(v); }
    __syncthreads();
    for (int item = F.bx; item < DEPTH * 96; item += F.G) {
        const int li = item / 96, cg = item % 96;
        const float* w = F.in(4) + (size_t)li * 1024 * 6144 + cg * 64 + lane;
        float a0 = 0, a1 = 0, a2 = 0, a3 = 0, a4 = 0;
        const int k0 = wid * 128;
#pragma unroll 8
        for (int k = k0; k < k0 + 128; ++k) {
            const float wv = w[(size_t)k * 6144];
            a0 += s[k] * wv; a1 += s[1024 + k] * wv; a2 += s[2048 + k] * wv; a3 += s[3072 + k] * wv; a4 += s[4096 + k] * wv;
        }
        red[(wid * 5 + 0) * 64 + lane] = a0; red[(wid * 5 + 1) * 64 + lane] = a1; red[(wid * 5 + 2) * 64 + lane] = a2;
        red[(wid * 5 + 3) * 64 + lane] = a3; red[(wid * 5 + 4) * 64 + lane] = a4;
        __syncthreads();
        if (tid < 320) { const int r = tid >> 6, l = tid & 63; float sum = 0;
#pragma unroll
            for (int ww = 0; ww < 8; ++ww) sum += red[(ww * 5 + r) * 64 + l];
            F.W<float>(WS_MODS)[(size_t)(li * 5 + r) * 6144 + cg * 64 + l] = sum + F.in(5)[li * 6144 + cg * 64 + l]; }
        __syncthreads();
    }
}
__device__ __forceinline__ void p0_rope(const Frame& F) {
    const int gt = F.bx * NTHR + threadIdx.x, gn = F.G * NTHR;
    float* ca = F.W<float>(WS_ROPEA); float* sa = ca + SEQ * 16; float* cb = F.W<float>(WS_ROPEB); float* sb = cb + SEQ * 32;
    for (int i = gt; i < SEQ * 48; i += gn) {
        int n, f, nf; float* co; float* so; int idx;
        if (i < SEQ * 16) { n = i >> 4; f = i & 15; nf = 8; co = ca; so = sa; idx = i; }
        else { const int j = i - SEQ * 16; n = j >> 5; f = j & 31; nf = 16; co = cb; so = sb; idx = j; }
        const int fi = f % nf; const float pos = (f < nf) ? (float)(n >> 6) : (float)(n & 63);
        const float invf = exp2f(-(float)fi / (float)nf * 13.287712379549449f);
        const float ang = pos * invf;
        float rev = ang * 0.15915494309189535f; rev -= floorf(rev);
        co[idx] = __builtin_amdgcn_cosf(rev); so[idx] = __builtin_amdgcn_sinf(rev);
    }
}
__device__ __forceinline__ int rowmap(int n, int kind) {
    if (kind == 0) return n;
    if (kind == 3) { if (n >= 2048) return n; const int hh = n >> 6, dim = n & 63; return (hh >> 2) * 256 + (dim >> 5) * 128 + (hh & 3) * 32 + (dim & 31); }
    return (n >> 7) * 256 + (kind == 2 ? 128 : 0) + (n & 127);
}
__device__ __forceinline__ void cvt_group(float* tl, const float* src, int K, int N, u16* dst, int ldd, int kind, int t0) {
    int tid = threadIdx.x; asm volatile("" : "+v"(tid));
    const int tn = (N + 63) / 64, nt = (K / 64) * tn;
    f32x4 v[4][2];
#pragma unroll
    for (int u = 0; u < 4; ++u) { const int t = t0 + u; const int k0 = (t / tn) * 64, n0 = (t % tn) * 64;
#pragma unroll
        for (int ps = 0; ps < 2; ++ps) { const int k = (tid >> 4) + ps * 32, n4 = (tid & 15) * 4;
            if (t < nt && n0 + n4 < N) v[u][ps] = *(const f32x4*)(src + (size_t)(k0 + k) * N + n0 + n4); else v[u][ps] = f32x4{0.f, 0.f, 0.f, 0.f}; } }
#pragma unroll
    for (int u = 0; u < 4; ++u)
#pragma unroll
        for (int ps = 0; ps < 2; ++ps) { const int k = (tid >> 4) + ps * 32, n4 = (tid & 15) * 4; float* d = tl + u * 4160 + k * 65 + n4;
            d[0] = v[u][ps][0]; d[1] = v[u][ps][1]; d[2] = v[u][ps][2]; d[3] = v[u][ps][3]; }
    __syncthreads();
#pragma unroll
    for (int u = 0; u < 4; ++u) { const int t = t0 + u; const int k0 = (t / tn) * 64, n0 = (t % tn) * 64;
        const int n = tid >> 3, kc = (tid & 7) * 8; const float* sr = tl + u * 4160;
        if (t < nt && n0 + n < N) { u32x4 w;
#pragma unroll
            for (int i = 0; i < 4; ++i) w[i] = cvtpk(sr[(kc + 2 * i) * 65 + n], sr[(kc + 2 * i + 1) * 65 + n]);
            *(u32x4*)(dst + (size_t)rowmap(n0 + n, kind) * ldd + k0 + kc) = w; } }
    __syncthreads();
}
__device__ __forceinline__ void cvt_t(const Frame& F, const float* src, int K, int N, u16* dst, int ldd, int kind, int rot) {
    const int tn = (N + 63) / 64, nt = (K / 64) * tn;
    for (int t0 = ((F.bx + rot) % F.G) * 4; t0 < nt; t0 += F.G * 4) cvt_group((float*)F.lds, src, K, N, dst, ldd, kind, t0);
}
constexpr int MOE_CVT_GROUPS = 16 * 3 * 32, LDS_CVT = 81920;
__device__ __forceinline__ void moe_cvt_group(const Frame& F, int li, int gidx) {
    if (gidx >= MOE_CVT_GROUPS) return;
    const int mat = gidx >> 5, g = gidx & 31, e = mat / 3, kind = mat - e * 3; float* tl = (float*)(F.lds + LDS_CVT);
    if (kind == 0) cvt_group(tl, F.in(27) + (size_t)(li * 16 + e) * 1024 * 512, 1024, 512, F.W<u16>(WS_MOEW) + (size_t)e * 1024 * 1024, 1024, 1, g * 4);
    else if (kind == 1) cvt_group(tl, F.in(28) + (size_t)(li * 16 + e) * 1024 * 512, 1024, 512, F.W<u16>(WS_MOEW) + (size_t)e * 1024 * 1024, 1024, 2, g * 4);
    else cvt_group(tl, F.in(29) + (size_t)(li * 16 + e) * 512 * 1024, 512, 1024, F.W<u16>(WS_MOEW + MOE_WGU_BYTES) + (size_t)e * 1024 * 512, 512, 0, g * 4);
}
__device__ __forceinline__ void p0_weights(const Frame& F) {
    int rot = 0;
    for (int j = 0; j < 2; ++j) {
        cvt_t(F, F.in(8) + (size_t)j * 1024 * 544, 1024, 544, F.W<u16>(WS_WDQKV) + (size_t)j * 640 * 1024, 1024, 0, rot); rot += 36;
        cvt_t(F, F.in(10) + (size_t)j * 256 * 1536, 256, 1536, F.W<u16>(WS_WUQ) + (size_t)j * 1536 * 256, 256, 0, rot); rot += 24;
        cvt_t(F, F.in(12) + (size_t)j * 256 * 2048, 256, 2048, F.W<u16>(WS_WUKV) + (size_t)j * 2048 * 256, 256, 0, rot); rot += 32;
        cvt_t(F, F.in(13) + (size_t)j * 1024 * 1024, 1024, 1024, F.W<u16>(WS_WOM) + (size_t)j * 1024 * 1024, 1024, 0, rot);
    }
    cvt_t(F, F.in(14), 1024, 3072, F.W<u16>(WS_WQKVD), 1024, 3, rot);
    cvt_t(F, F.in(17), 1024, 1024, F.W<u16>(WS_WOD), 1024, 0, rot);
    cvt_t(F, F.in(18), 1024, 3104, F.W<u16>(WS_WING), 1024, 0, rot); rot += 4;
    cvt_t(F, F.in(22), 1024, 1024, F.W<u16>(WS_WOG), 1024, 0, rot);
}
__device__ __forceinline__ void moe_weights(const Frame& F, int li) {
    for (int g = F.bx; g < MOE_CVT_GROUPS; g += F.G) moe_cvt_group(F, li, g);
}

#define DPP_ADD(v, CTRL) (v) += __uint_as_float(__builtin_amdgcn_update_dpp(0u, __float_as_uint(v), (CTRL), 0xF, 0xF, false))
__device__ __forceinline__ float wave_sum_fast(float v) {
    DPP_ADD(v, 0xB1); DPP_ADD(v, 0x4E); DPP_ADD(v, 0x141); DPP_ADD(v, 0x140);
    { auto rr = __builtin_amdgcn_permlane16_swap(__float_as_uint(v), __float_as_uint(v), false, false); v = __uint_as_float(rr[0]) + __uint_as_float(rr[1]); }
    { auto rr = __builtin_amdgcn_permlane32_swap(__float_as_uint(v), __float_as_uint(v), false, false); v = __uint_as_float(rr[0]) + __uint_as_float(rr[1]); }
    return v;
}
constexpr int RT_WG = 0, RT_WR = 16384, RT_REC = 81920, RT_CNT = 81920 + 4096, RT_BASE = RT_CNT + 128;
template <bool ROUTE>
__device__ __forceinline__ void norm_phase(const Frame& F, int li, int row_begin, bool first) {
    const int tid = threadIdx.x, lane = tid & 63, wid = tid >> 6;
    const float* gain = F.in(ROUTE ? 7 : 6) + li * DM;
    u16* H = F.W<u16>(WS_H);
    const int per_block = (NTOK - row_begin + F.G - 1) / F.G;
    const int blk0 = row_begin + F.bx * per_block; int blk1 = blk0 + per_block; if (blk1 > NTOK) blk1 = NTOK;
    f32x4* wgL = (f32x4*)(F.lds + RT_WG); f32x4* wrL = (f32x4*)(F.lds + RT_WR); u32x4* recL = (u32x4*)(F.lds + RT_REC);
    unsigned* cntL = (unsigned*)(F.lds + RT_CNT); unsigned* baseL = (unsigned*)(F.lds + RT_BASE);
    if constexpr (ROUTE) {
        __syncthreads();
        const f32x4* wg = (const f32x4*)(F.in(23) + (size_t)li * DM * 4); const f32x4* wr = (const f32x4*)(F.in(25) + (size_t)li * 4 * DM * 4);
        for (int e = tid; e < 1024; e += NTHR) { const int d = ((e >> 8) * 4 + (e & 3)) * 64 + ((e >> 2) & 63); wgL[d] = wg[e]; }
        for (int e = tid; e < 4096; e += NTHR) { const int g = e >> 10, c = e & 1023; const int d = g * 1024 + ((c >> 8) * 4 + (c & 3)) * 64 + ((c >> 2) & 63); wrL[d] = wr[e]; }
        if (tid < 32) cntL[tid] = 0u;
        __syncthreads();
    }
    for (int it = 0; it * 32 < per_block; ++it) {
        int rows[4]; bool ok[4]; f32x4 v[4][4];
#pragma unroll
        for (int u = 0; u < 4; ++u) { rows[u] = blk0 + wid + 8 * (4 * it + u); ok[u] = rows[u] < blk1; if (!ok[u]) rows[u] = blk0; }
#pragma unroll
        for (int u = 0; u < 4; ++u) { const float* xr = xrow_in(F, rows[u], first);
#pragma unroll
            for (int i = 0; i < 4; ++i) v[u][i] = *(const f32x4*)(xr + i * 256 + lane * 4); }
#pragma unroll
        for (int u = 0; u < 4; ++u) {
            const int row = rows[u];
            float ss = 0;
#pragma unroll
            for (int i = 0; i < 4; ++i) ss += v[u][i][0] * v[u][i][0] + v[u][i][1] * v[u][i][1] + v[u][i][2] * v[u][i][2] + v[u][i][3] * v[u][i][3];
            ss = wave_sum_fast(ss);
            const float rinv = rsqrtf(ss * (1.f / DM) + EPS);
            const float* sh = mod_vec(F, li, row, ROUTE ? 3 : 0); const float* sc = mod_vec(F, li, row, ROUTE ? 4 : 1);
            float hv[16];
#pragma unroll
            for (int i = 0; i < 4; ++i) { const int c = i * 256 + lane * 4;
                const f32x4 g = *(const f32x4*)(gain + c), s1 = *(const f32x4*)(sc + c), s0 = *(const f32x4*)(sh + c);
#pragma unroll
                for (int j = 0; j < 4; ++j) hv[i * 4 + j] = (v[u][i][j] * rinv * g[j]) * (1.f + s1[j]) + s0[j];
                if (ok[u]) { u32x2 w = {cvtpk(hv[i * 4], hv[i * 4 + 1]), cvtpk(hv[i * 4 + 2], hv[i * 4 + 3])}; *(u32x2*)(H + (size_t)row * DM + c) = w; } }
            if constexpr (ROUTE) {
                float gl[4] = {0, 0, 0, 0};
#pragma unroll
                for (int q = 0; q < 16; ++q) { const f32x4 w4 = wgL[q * 64 + lane]; const float h = hv[q];
                    gl[0] += h * w4[0]; gl[1] += h * w4[1]; gl[2] += h * w4[2]; gl[3] += h * w4[3]; }
#pragma unroll
                for (int g = 0; g < 4; ++g) gl[g] = wave_sum_fast(gl[g]) + F.in(24)[li * 4 + g];
                int gi = 0; float gm = gl[0];
#pragma unroll
                for (int g = 1; g < 4; ++g) if (gl[g] > gm) { gm = gl[g]; gi = g; }
                gi = __builtin_amdgcn_readfirstlane(gi);
                float den = 0;
#pragma unroll
                for (int g = 0; g < 4; ++g) den += __expf(gl[g] - gm);
                const float grp_w = 1.f / den;
                float el[4] = {0, 0, 0, 0};
                const f32x4* wrg = wrL + gi * 1024;
#pragma unroll
                for (int q = 0; q < 16; ++q) { const f32x4 w4 = wrg[q * 64 + lane]; const float h = hv[q];
                    el[0] += h * w4[0]; el[1] += h * w4[1]; el[2] += h * w4[2]; el[3] += h * w4[3]; }
#pragma unroll
                for (int e = 0; e < 4; ++e) el[e] = wave_sum_fast(el[e]) + F.in(26)[(li * 4 + gi) * 4 + e];
                int i1 = 0; float v1 = el[0];
#pragma unroll
                for (int e = 1; e < 4; ++e) if (el[e] > v1) { v1 = el[e]; i1 = e; }
                int i2 = -1; float v2 = -3.0e38f;
#pragma unroll
                for (int e = 0; e < 4; ++e) if (e != i1 && el[e] > v2) { v2 = el[e]; i2 = e; }
                const float t = __expf(v2 - v1); const float w1 = grp_w / (1.f + t), w2 = grp_w * t / (1.f + t);
                const int elo = i1 < i2 ? i1 : i2, ehi = i1 < i2 ? i2 : i1;
                const float wlo = i1 < i2 ? w1 : w2, whi = i1 < i2 ? w2 : w1;
                const int pr = elo == 0 ? ehi - 1 : (elo == 1 ? ehi + 1 : 5);
                const int cls = gi * 6 + pr;
                if (lane == 0 && ok[u]) {
                    const unsigned rank = atomicAdd(&cntL[cls], 1u);
                    u32x4 rec = {(unsigned)cls, rank, __float_as_uint(wlo), __float_as_uint(whi)};
                    recL[row - blk0] = rec;
                }
            }
        }
    }
    if constexpr (ROUTE) {
        __syncthreads();
        if (tid < 24) baseL[tid] = atomicAdd(F.W<unsigned>(WS_CTL) + CW_CNT + li * 32 + tid, cntL[tid]);
        __syncthreads();
        for (int t = tid; t < blk1 - blk0; t += NTHR) { u32x4 rec = recL[t]; rec[1] += baseL[rec[0]];
            *(u32x4*)(F.W<unsigned char>(WS_TOK) + (size_t)(blk0 + t) * 16) = rec; }
    }
}

__device__ __forceinline__ void moe_table(const Frame& F, int li, int* tab) {
    if (threadIdx.x == 0) {
        const unsigned* cnt = F.W<unsigned>(WS_CTL) + CW_CNT + li * 32; int off = 0;
        for (int c = 0; c < 24; ++c) { tab[c] = off; const int n = (int)cnt[c]; const int nt = (n + 255) >> 8;
            for (int t = 0; t < nt; ++t) tab[32 + (off >> 8) + t] = c; off += nt << 8; }
        tab[24] = off;
    }
    __syncthreads();
}
__device__ __forceinline__ void moe_scatter(const Frame& F, int li, int row_begin) {
    int* tab = (int*)(F.lds + LDS_TAB);
    moe_table(F, li, tab);
    const unsigned* cnt = F.W<unsigned>(WS_CTL) + CW_CNT + li * 32;
    int* rowtok = F.W<int>(WS_ROWTOK); float* roww = F.W<float>(WS_ROWW);
    const int gt = F.bx * NTHR + threadIdx.x, gn = F.G * NTHR;
    for (int t = row_begin + gt; t < NTOK; t += gn) {
        const u32x4 rec = *(const u32x4*)(F.W<unsigned char>(WS_TOK) + (size_t)t * 16);
        const int r = tab[rec[0]] + (int)rec[1];
        rowtok[r] = t; roww[2 * r] = __uint_as_float(rec[2]); roww[2 * r + 1] = __uint_as_float(rec[3]);
    }
    for (int i = gt; i < 24 * 256; i += gn) { const int c = i >> 8, j = i & 255; const int r = tab[c] + (int)cnt[c] + j;
        const int end = tab[c] + ((((int)cnt[c]) + 255) & ~255);
        if (r < end) { rowtok[r] = -1; roww[2 * r] = 0.f; roww[2 * r + 1] = 0.f; } }
    __syncthreads();
}

#define EPI_ID const int r32 = lane & 31, hi = lane >> 5
__device__ __forceinline__ u32x2 pack4(float a, float b, float c, float d) { u32x2 w = {cvtpk(a, b), cvtpk(c, d)}; return w; }
struct EpiF32 { float* dst; int ld, ncols;
    __device__ __forceinline__ int operator()(f32x16 (&acc)[2][2], int row0, int col0, int lane) const { EPI_ID;
#pragma unroll
        for (int mi = 0; mi < 2; ++mi) { float* o = dst + (size_t)(row0 + mi * 32 + r32) * ld + col0 + 4 * hi;
#pragma unroll
            for (int ni = 0; ni < 2; ++ni) if (col0 + ni * 32 < ncols) {
#pragma unroll
                for (int g = 0; g < 4; ++g) { f32x4 v = {acc[mi][ni][4 * g], acc[mi][ni][4 * g + 1], acc[mi][ni][4 * g + 2], acc[mi][ni][4 * g + 3]}; *(f32x4*)(o + ni * 32 + 8 * g) = v; } } }
        return 0;
    } };
struct EpiMlaQ { u16* Q; const float* cosA; const float* sinA; float scale;
    __device__ __forceinline__ int operator()(f32x16 (&acc)[2][2], int row0, int col0, int lane) const { EPI_ID; const bool lat = row0 >= NCTX;
#pragma unroll
        for (int mi = 0; mi < 2; ++mi) { const int row = row0 + mi * 32 + r32; int b, pos; row_bp(row, b, pos); const int n = (row - NCTX) & (SEQ - 1);
            u16* qrow = Q + ((size_t)(b * 16) * KEYS + pos) * 96 + 4 * hi;
#pragma unroll
            for (int ni = 0; ni < 2; ++ni) { const int s = (col0 >> 5) + ni, head = s / 3, part = s - head * 3; u16* o = qrow + (size_t)head * KEYS * 96 + part * 32;
                float v[16];
#pragma unroll
                for (int r = 0; r < 16; ++r) v[r] = acc[mi][ni][r] * scale;
                if (part == 2 && lat) {
#pragma unroll
                    for (int g = 0; g < 2; ++g) {
#pragma unroll
                        for (int j = 0; j < 4; ++j) { float cs, sn; rope_cs<8>(n, 8 * g + 4 * hi + j, cs, sn);
                            const float t1 = v[4 * g + j], t2 = v[4 * (g + 2) + j]; v[4 * g + j] = t1 * cs - t2 * sn; v[4 * (g + 2) + j] = t1 * sn + t2 * cs; } } }
#pragma unroll
                for (int g = 0; g < 4; ++g) *(u32x2*)(o + 8 * g) = pack4(v[4 * g], v[4 * g + 1], v[4 * g + 2], v[4 * g + 3]); } }
        return 16;
    } };
struct EpiMlaKV { u16* Kn; long vdelta;
    __device__ __forceinline__ int operator()(f32x16 (&acc)[2][2], int row0, int col0, int lane) const { EPI_ID; const int head = col0 >> 7; u16* dst = Kn + (long)((col0 >> 6) & 1) * vdelta;
#pragma unroll
        for (int mi = 0; mi < 2; ++mi) { const int row = row0 + mi * 32 + r32; int b, pos; row_bp(row, b, pos);
            u16* o = dst + ((size_t)(b * 16 + head) * KEYS + pos) * 64 + 4 * hi;
#pragma unroll
            for (int ni = 0; ni < 2; ++ni)
#pragma unroll
                for (int g = 0; g < 4; ++g) *(u32x2*)(o + ni * 32 + 8 * g) = pack4(acc[mi][ni][4 * g], acc[mi][ni][4 * g + 1], acc[mi][ni][4 * g + 2], acc[mi][ni][4 * g + 3]); }
        return 16;
    } };
struct EpiResid { ResCtx F; int li, which, first;
    __device__ __forceinline__ int operator()(f32x16 (&acc)[2][2], int row0, int col0, int lane) const { EPI_ID;
#pragma unroll
        for (int mi = 0; mi < 2; ++mi) { const int row = row0 + mi * 32 + r32;
            const float* xi = F.row_in(row, first) + col0 + 4 * hi; float* xo = F.row_out(row) + col0 + 4 * hi; const float* gt = F.mod(li, row, which) + col0 + 4 * hi;
#pragma unroll
            for (int ni = 0; ni < 2; ++ni)
#pragma unroll
                for (int g = 0; g < 4; ++g) { const int c = ni * 32 + 8 * g; const f32x4 x = *(const f32x4*)(xi + c), gg = *(const f32x4*)(gt + c);
                    f32x4 o = {x[0] + gg[0] * acc[mi][ni][4 * g], x[1] + gg[1] * acc[mi][ni][4 * g + 1], x[2] + gg[2] * acc[mi][ni][4 * g + 2], x[3] + gg[3] * acc[mi][ni][4 * g + 3]};
                    *(f32x4*)(xo + c) = o; } }
        return 48;
    } };
struct EpiMoeB { ResCtx F; int li; const int* rowtok;
    __device__ __forceinline__ int operator()(f32x16 (&acc)[2][2], int row0, int col0, int lane) const { EPI_ID;
#pragma unroll
        for (int mi = 0; mi < 2; ++mi) { const int tok = rowtok[row0 + mi * 32 + r32];
            if (tok >= 0) { float* xo = F.row_out(tok) + col0 + 4 * hi; const float* gt = F.mod(li, tok, 5) + col0 + 4 * hi;
#pragma unroll
                for (int ni = 0; ni < 2; ++ni)
#pragma unroll
                    for (int g = 0; g < 4; ++g) { const int c = ni * 32 + 8 * g; const f32x4 x = *(const f32x4*)(xo + c), gg = *(const f32x4*)(gt + c);
                        f32x4 o = {x[0] + gg[0] * acc[mi][ni][4 * g], x[1] + gg[1] * acc[mi][ni][4 * g + 1], x[2] + gg[2] * acc[mi][ni][4 * g + 2], x[3] + gg[3] * acc[mi][ni][4 * g + 3]};
                        *(f32x4*)(xo + c) = o; } } }
        return 0;
    } };
struct EpiMoeA { u16* act; const float* roww; int half, acol0;
    __device__ __forceinline__ int operator()(f32x16 (&acc)[2][2], int row0, int col0, int lane) const { EPI_ID;
#pragma unroll
        for (int mi = 0; mi < 2; ++mi) { const int row = row0 + mi * 32 + r32; const float w = roww[2 * row + half];
            u16* o = act + (size_t)row * 1024 + acol0 + (col0 >> 6) * 32 + 4 * hi;
#pragma unroll
            for (int g = 0; g < 4; ++g) { float v[4];
#pragma unroll
                for (int j = 0; j < 4; ++j) v[j] = silu_f(acc[mi][0][4 * g + j]) * acc[mi][1][4 * g + j] * w;
                *(u32x2*)(o + 8 * g) = pack4(v[0], v[1], v[2], v[3]); } }
        return 8;
    } };
struct EpiDiffQKV { u16* Q; long kdelta; u16* V; const float* cosB; const float* sinB; float qscale;
    __device__ __forceinline__ int operator()(f32x16 (&acc)[2][2], int row0, int col0, int lane) const { EPI_ID; const int region = col0 >> 10; const bool lat = row0 >= NCTX;
#pragma unroll
        for (int mi = 0; mi < 2; ++mi) { const int row = row0 + mi * 32 + r32; int b, pos; row_bp(row, b, pos); const int n = (row - NCTX) & (SEQ - 1);
            if (region < 2) {
                const int hh = (col0 & 1023) >> 6; const float sc = region == 0 ? qscale : 1.f;
                u16* o = Q + (long)region * kdelta + ((size_t)(b * 16 + hh) * KEYS + pos) * 64 + 4 * hi;
#pragma unroll
                for (int g = 0; g < 4; ++g) {
                    float o1[4], o2[4];
#pragma unroll
                    for (int j = 0; j < 4; ++j) { float cs = 1.f, sn = 0.f; if (lat) rope_cs<16>(n, 8 * g + 4 * hi + j, cs, sn);
                        const float t1 = acc[mi][0][4 * g + j], t2 = acc[mi][1][4 * g + j]; o1[j] = (t1 * cs - t2 * sn) * sc; o2[j] = (t1 * sn + t2 * cs) * sc; }
                    *(u32x2*)(o + 8 * g) = pack4(o1[0], o1[1], o1[2], o1[3]); *(u32x2*)(o + 32 + 8 * g) = pack4(o2[0], o2[1], o2[2], o2[3]); }
            } else {
                const int cv = col0 - 2048, head = cv >> 7;
                u16* o = V + ((size_t)(b * 8 + head) * KEYS + pos) * 128 + (cv & 127) + 4 * hi;
#pragma unroll
                for (int ni = 0; ni < 2; ++ni)
#pragma unroll
                    for (int g = 0; g < 4; ++g) *(u32x2*)(o + ni * 32 + 8 * g) = pack4(acc[mi][ni][4 * g], acc[mi][ni][4 * g + 1], acc[mi][ni][4 * g + 2], acc[mi][ni][4 * g + 3]);
            } }
        return 16;
    } };
struct EpiGlaIn { u16* q; u16* k; u16* v; u16* g; float* z;
    __device__ __forceinline__ int operator()(f32x16 (&acc)[2][2], int row0, int col0, int lane) const { EPI_ID;
#pragma unroll
        for (int mi = 0; mi < 2; ++mi) { const size_t row = row0 + mi * 32 + r32;
            if (col0 < 3072) {
                u16* o; float sc = 1.f;
                if (col0 < 512) { o = q + row * 512 + col0; sc = 0.08838834764831845f; } else if (col0 < 1024) o = k + row * 512 + (col0 - 512);
                else if (col0 < 2048) o = v + row * 1024 + (col0 - 1024); else o = g + row * 1024 + (col0 - 2048);
                o += 4 * hi;
#pragma unroll
                for (int ni = 0; ni < 2; ++ni)
#pragma unroll
                    for (int gg = 0; gg < 4; ++gg) *(u32x2*)(o + ni * 32 + 8 * gg) = pack4(acc[mi][ni][4 * gg] * sc, acc[mi][ni][4 * gg + 1] * sc, acc[mi][ni][4 * gg + 2] * sc, acc[mi][ni][4 * gg + 3] * sc);
            } else if (col0 == 3072) {
                float* o = z + row * 32 + 4 * hi;
#pragma unroll
                for (int gg = 0; gg < 4; ++gg) { f32x4 t = {acc[mi][0][4 * gg], acc[mi][0][4 * gg + 1], acc[mi][0][4 * gg + 2], acc[mi][0][4 * gg + 3]}; *(f32x4*)(o + 8 * gg) = t; }
            } }
        return col0 < 3072 ? 16 : (col0 == 3072 ? 8 : 0);
    } };

template <int WM, int WN, class AL, class BL, class EP>
__device__ __forceinline__ void gemm_phase(const Frame& F, const AL al, const BL bl, EP& ep, int mt0, int mt1, int nN, int nk, int tile_off, int tile_total) {
    PlainTiles<AL, BL, EP> prov{al, bl, ep, mt0, mt1 - mt0, nN, F.bx, F.G}; (void)tile_off;
    gemm_stream<WM, WN>(F.lds, prov, nk);
    (void)tile_total;
}

__device__ __forceinline__ void mla_rowpass(const Frame& F, int j) {
    const int lane = threadIdx.x & 63, wid = threadIdx.x >> 6;
    const float* DQ = F.W<float>(MLA_DQ); u16* CN = F.W<u16>(MLA_CN); u16* KPE = F.W<u16>(MLA_KPE);
    const float* gq = F.in(9) + j * 256; const float* gk = F.in(11) + j * 256;
    const float* ca = F.W<float>(WS_ROPEA); const float* sa = ca + SEQ * 16;
    for (int row = F.bx * NWAVE + wid; row < NTOK; row += F.G * NWAVE) {
        const float* d = DQ + (size_t)row * 544;
        const f32x4 a = *(const f32x4*)(d + lane * 4), c = *(const f32x4*)(d + 256 + lane * 4);
        float sq = a[0] * a[0] + a[1] * a[1] + a[2] * a[2] + a[3] * a[3], sk = c[0] * c[0] + c[1] * c[1] + c[2] * c[2] + c[3] * c[3];
        sq = wave_sum(sq); sk = wave_sum(sk);
        const float rq = rsqrtf(sq * (1.f / 256.f) + EPS), rk = rsqrtf(sk * (1.f / 256.f) + EPS);
        const f32x4 g1 = *(const f32x4*)(gq + lane * 4), g2 = *(const f32x4*)(gk + lane * 4);
        u32x2 w1 = {cvtpk(a[0] * rq * g1[0], a[1] * rq * g1[1]), cvtpk(a[2] * rq * g1[2], a[3] * rq * g1[3])};
        u32x2 w2 = {cvtpk(c[0] * rk * g2[0], c[1] * rk * g2[1]), cvtpk(c[2] * rk * g2[2], c[3] * rk * g2[3])};
        *(u32x2*)(CN + (size_t)row * 512 + lane * 4) = w1; *(u32x2*)(CN + (size_t)row * 512 + 256 + lane * 4) = w2;
        if (lane < 16) { float t1 = d[512 + lane], t2 = d[528 + lane]; int b, pos; row_bp(row, b, pos);
            if (row >= NCTX) { const int n = (row - NCTX) & (SEQ - 1); const float cs = ca[n * 16 + lane], sn = sa[n * 16 + lane];
                const float o1 = t1 * cs - t2 * sn, o2 = t1 * sn + t2 * cs; t1 = o1; t2 = o2; }
            u16* o = KPE + ((size_t)b * KEYS + pos) * 32 + lane; o[0] = f2bf(t1); o[16] = f2bf(t2); }
    }
}
__device__ __forceinline__ int vcu_of(const Frame& F) { return (F.G % 8 == 0) ? (F.bx % 8) * (F.G / 8) + F.bx / 8 : F.bx; }
__device__ __forceinline__ void mla_attn(const Frame& F, bool ctx_out, int li) {
    const u16* Q = F.W<u16>(MLA_Q); const u16* Kn = F.W<u16>(MLA_KN); const u16* V = F.W<u16>(MLA_V); const u16* Kpe = F.W<u16>(MLA_KPE);
    u16* O = F.W<u16>(MLA_DQ);
    const int nit = 2048 + (ctx_out ? 64 : 0); int nrun = 0;
#pragma unroll 1
    for (int it = vcu_of(F); it < nit; it += F.G) {
        int b, h, qpos, nkeys, orow;
        if (it < 2048) { const int bh = it >> 5, qt = it & 31; b = bh >> 4; h = bh & 15; qpos = CTXL + qt * 256; nkeys = KEYS; orow = NCTX + b * SEQ + qt * 256; }
        else { const int jj = it - 2048; b = jj >> 4; h = jj & 15; qpos = 0; nkeys = CTXL; orow = b * CTXL; }
        const size_t bh = (size_t)(b * 16 + h);
        attn_item<96, 64>(Q + (bh * KEYS + qpos) * 96, Kn + bh * KEYS * 64, Kpe + (size_t)b * KEYS * 32, V + bh * KEYS * 64, nkeys,
                          O + (size_t)orow * DM + h * 64, DM, F.lds);
        moe_cvt_group(F, li, F.bx + nrun * F.G); ++nrun;
    }
    for (; F.bx + nrun * F.G < MOE_CVT_GROUPS; ++nrun) moe_cvt_group(F, li, F.bx + nrun * F.G);
}
__device__ __forceinline__ void diff_attn(const Frame& F, int li) {
    const u16* Q = F.W<u16>(DF_Q); const u16* K = F.W<u16>(DF_K); const u16* V = F.W<u16>(DF_V); u16* OS = F.W<u16>(DF_OS);
    const int nit = 2048 + 64; int nrun = 0;
#pragma unroll 1
    for (int it = vcu_of(F); it < nit; it += F.G) {
        int b, hh, qpos, nkeys, orow;
        if (it < 2048) { const int bh = it >> 5, qt = it & 31; b = bh >> 4; hh = bh & 15; qpos = CTXL + qt * 256; nkeys = KEYS; orow = NCTX + b * SEQ + qt * 256; }
        else { const int jj = it - 2048; b = jj >> 4; hh = jj & 15; qpos = 0; nkeys = CTXL; orow = b * CTXL; }
        const size_t bh = (size_t)(b * 16 + hh);
        attn_item<64, 128>(Q + (bh * KEYS + qpos) * 64, K + bh * KEYS * 64, nullptr, V + (size_t)(b * 8 + (hh >> 1)) * KEYS * 128, nkeys,
                           OS + (size_t)(hh & 1) * NTOK * DM + (size_t)orow * DM + (hh >> 1) * 128, DM, F.lds);
        moe_cvt_group(F, li, F.bx + nrun * F.G); ++nrun;
    }
    for (; F.bx + nrun * F.G < MOE_CVT_GROUPS; ++nrun) moe_cvt_group(F, li, F.bx + nrun * F.G);
}
__device__ __forceinline__ void diff_rowpass(const Frame& F, float lam_init) {
    const int lane = threadIdx.x & 63, wid = threadIdx.x >> 6;
    const u16* OS = F.W<u16>(DF_OS); u16* O = F.W<u16>(DF_Q);
    const float* lm = F.in(15);
    const float lam = __expf(wave_sum(lm[lane] * lm[64 + lane])) - __expf(wave_sum(lm[128 + lane] * lm[192 + lane])) + lam_init;
    const float post = 1.f - lam_init;
    float sg[16];
#pragma unroll
    for (int i = 0; i < 16; ++i) sg[i] = F.in(16)[(lane & 7) * 16 + i] * post;
    for (int row = F.bx * NWAVE + wid; row < NTOK; row += F.G * NWAVE) {
        const u16* p0 = OS + (size_t)row * DM + lane * 16; const u16* p1 = p0 + (size_t)NTOK * DM;
        const bf16x8 a0 = *(const bf16x8*)p0, a1 = *(const bf16x8*)(p0 + 8), b0 = *(const bf16x8*)p1, b1 = *(const bf16x8*)(p1 + 8);
        float o[16]; float ss = 0;
#pragma unroll
        for (int i = 0; i < 8; ++i) { o[i] = bf2f((u16)a0[i]) - lam * bf2f((u16)b0[i]); o[8 + i] = bf2f((u16)a1[i]) - lam * bf2f((u16)b1[i]); }
#pragma unroll
        for (int i = 0; i < 16; ++i) ss += o[i] * o[i];
        ss += __shfl_xor(ss, 1); ss += __shfl_xor(ss, 2); ss += __shfl_xor(ss, 4);
        const float rinv = rsqrtf(ss * (1.f / 128.f) + EPS);
        u32x4 w0, w1;
#pragma unroll
        for (int i = 0; i < 4; ++i) { w0[i] = cvtpk(o[2 * i] * rinv * sg[2 * i], o[2 * i + 1] * rinv * sg[2 * i + 1]);
            w1[i] = cvtpk(o[8 + 2 * i] * rinv * sg[8 + 2 * i], o[9 + 2 * i] * rinv * sg[9 + 2 * i]); }
        *(u32x4*)(O + (size_t)row * DM + lane * 16) = w0; *(u32x4*)(O + (size_t)row * DM + lane * 16 + 8) = w1;
    }
}

__device__ __forceinline__ float logsig16(float x) { return (fminf(x, 0.f) - __logf(1.f + __expf(-fabsf(x)))) * 0.0625f; }
constexpr int NCH = KEYS / 64;

__device__ __forceinline__ void gla_g1(const Frame& F) {
    char* KT = F.lds; char* VV = F.lds + 16384; float* ZT = (float*)(F.lds + 49152); float* SEG = (float*)(F.lds + 53248);
    const u16* Kg = F.W<u16>(GL_K); const u16* Vg = F.W<u16>(GL_V); const float* Zg = F.W<float>(GL_Z);
    u16* ST = F.W<u16>(GL_STATE); float* DEC = F.W<float>(GL_DEC);
#pragma unroll 1
    for (int it = F.bx; it < NBATCH * 4 * 2 * NCH; it += F.G) {
        int tid = threadIdx.x; asm volatile("" : "+v"(tid));
        const int lane = tid & 63, wid = tid >> 6, r32 = lane & 31, hi = lane >> 5, kk = tid & 127, jq = tid >> 7;
        const int c = it % NCH, dir = (it / NCH) & 1, bh = it / (2 * NCH), b = bh >> 2, h = bh & 3;
        const int s0 = 64 * c;
        int tbase, tstep;
        if (dir == 0) { tbase = (c < 4) ? b * CTXL + s0 : NCTX + b * SEQ + s0 - CTXL; tstep = 1; }
        else { tbase = (c < 4) ? b * CTXL + (CTXL - 1) - s0 : NCTX + b * SEQ + (SEQ - 1) - (s0 - CTXL); tstep = -1; }
        __syncthreads();
        for (int i = tid; i < 1024; i += NTHR) { const int j = i >> 4, r = i & 15; ZT[i] = Zg[(size_t)(tbase + tstep * j) * 32 + dir * 16 + r]; }
#pragma unroll
        for (int q = 0; q < 4; ++q) { const int id = tid + q * NTHR, key = id >> 5, cc = (id & 31) * 8;
            *(bf16x8*)(VV + v_st<8>(key, cc)) = *(const bf16x8*)(Vg + (size_t)(tbase + tstep * key) * 1024 + h * 256 + cc); }
        float wg[16];
#pragma unroll
        for (int r = 0; r < 16; ++r) wg[r] = F.in(19)[(dir * 16 + r) * 512 + h * 128 + kk];
        const float bias = F.in(20)[dir * 512 + h * 128 + kk];
        __syncthreads();
        float cv[16]; float run = 0;
#pragma unroll
        for (int jj = 0; jj < 16; ++jj) { const int j = jq * 16 + jj; float x = bias;
#pragma unroll
            for (int r = 0; r < 16; ++r) x += ZT[j * 16 + r] * wg[r];
            run += logsig16(x); cv[jj] = run; }
        SEG[jq * 128 + kk] = run;
        __syncthreads();
        float offset = 0, total = 0;
#pragma unroll
        for (int q = 0; q < 4; ++q) { const float sv = SEG[q * 128 + kk]; total += sv; if (q < jq) offset += sv; }
        u32x4 w0, w1;
#pragma unroll
        for (int i = 0; i < 8; ++i) {
            const int j0 = jq * 16 + 2 * i;
            const float k0 = bf2f(Kg[(size_t)(tbase + tstep * j0) * 512 + h * 128 + kk]) * __expf(total - (offset + cv[2 * i]));
            const float k1 = bf2f(Kg[(size_t)(tbase + tstep * (j0 + 1)) * 512 + h * 128 + kk]) * __expf(total - (offset + cv[2 * i + 1]));
            const unsigned pk = cvtpk(k0, k1); if (i < 4) w0[i] = pk; else w1[i - 4] = pk; }
        *(u32x4*)(KT + kk * 128 + (((jq * 2) ^ ((kk >> 1) & 7)) << 4)) = w0;
        *(u32x4*)(KT + kk * 128 + (((jq * 2 + 1) ^ ((kk >> 1) & 7)) << 4)) = w1;
        if (jq == 0) DEC[(size_t)it * 128 + kk] = __expf(total);
        __syncthreads();
        const int mt = wid & 3, vb = (wid >> 2) * 4;
        const int row = mt * 32 + r32, ab = row * 128 + ((hi ^ ((row >> 1) & 7)) << 4);
        const bf16x8 pa0 = *(const bf16x8*)(KT + (ab ^ 0)), pa1 = *(const bf16x8*)(KT + (ab ^ 32)), pa2 = *(const bf16x8*)(KT + (ab ^ 64)), pa3 = *(const bf16x8*)(KT + (ab ^ 96));
        f32x16 acc[4];
#pragma unroll
        for (int n = 0; n < 4; ++n) acc[n] = f32x16{};
        const int vbase = (int)(uintptr_t)VV + v_rd_base(lane) + vb * 512;
        pv_one<0, 8>(acc[0], vbase, pa0, pa1, pa2, pa3); pv_one<1, 8>(acc[1], vbase, pa0, pa1, pa2, pa3);
        pv_one<2, 8>(acc[2], vbase, pa0, pa1, pa2, pa3); pv_one<3, 8>(acc[3], vbase, pa0, pa1, pa2, pa3);
        u16* S = ST + (size_t)it * 128 * 256;
#pragma unroll
        for (int n = 0; n < 4; ++n)
#pragma unroll
            for (int r = 0; r < 16; ++r) S[(mt * 32 + crow(r, hi)) * 256 + (vb + n) * 32 + r32] = f2bf(acc[n][r]);
    }
}
__device__ __forceinline__ void gla_g2(const Frame& F) {
    u16* ST = F.W<u16>(GL_STATE); const float* DEC = F.W<float>(GL_DEC);
    for (int g = F.bx * NTHR + threadIdx.x; g < 32 * 4096; g += F.G * NTHR) {
        const int chain = g >> 12, e = g & 4095, kk = e >> 5, v8 = (e & 31) * 8;
        u16* p = ST + ((size_t)chain * NCH * 128 + kk) * 256 + v8; const float* d = DEC + (size_t)chain * NCH * 128 + kk;
        float f[8];
#pragma unroll
        for (int i = 0; i < 8; ++i) f[i] = 0.f;
        for (int c = 0; c < NCH; c += 4) {
            bf16x8 kv[4]; float dc[4];
#pragma unroll
            for (int u = 0; u < 4; ++u) { kv[u] = *(const bf16x8*)(p + (size_t)(c + u) * 128 * 256); dc[u] = d[(size_t)(c + u) * 128]; }
#pragma unroll
            for (int u = 0; u < 4; ++u) {
                u32x4 w = {cvtpk(f[0], f[1]), cvtpk(f[2], f[3]), cvtpk(f[4], f[5]), cvtpk(f[6], f[7])};
                *(u32x4*)(p + (size_t)(c + u) * 128 * 256) = w;
#pragma unroll
                for (int i = 0; i < 8; ++i) f[i] = dc[u] * f[i] + bf2f((u16)kv[u][i]);
            }
        }
    }
}
__device__ __forceinline__ void gla_g3(const Frame& F) {
    char* QD = F.lds; char* KI = F.lds + 16384; char* VV = F.lds + 32768; char* SS = F.lds + 65536; float* OL = (float*)(F.lds + 65536);
    float* ZT = (float*)(F.lds + 132096); float* SEG = (float*)(F.lds + 136192);
    const u16* Qg = F.W<u16>(GL_Q); const u16* Kg = F.W<u16>(GL_K); const u16* Vg = F.W<u16>(GL_V); const u16* Gg = F.W<u16>(GL_G); const float* Zg = F.W<float>(GL_Z);
    const u16* ST = F.W<u16>(GL_STATE); u16* OUT = F.W<u16>(WS_H);
#pragma unroll 1
    for (int it = F.bx; it < NBATCH * 4 * NCH; it += F.G) {
        int tid = threadIdx.x; asm volatile("" : "+v"(tid));
        const int lane = tid & 63, wid = tid >> 6, r32 = lane & 31, hi = lane >> 5, kk = tid & 127, jq = tid >> 7;
        const int T = it % NCH, bh = it / NCH, b = bh >> 2, h = bh & 3;
        const int t0 = (T < 4) ? b * CTXL + 64 * T : NCTX + b * SEQ + 64 * (T - 4);
        __syncthreads();
#pragma unroll
        for (int q = 0; q < 4; ++q) { const int id = tid + q * NTHR, key = id >> 5, cc = (id & 31) * 8;
            *(bf16x8*)(VV + v_st<8>(key, cc)) = *(const bf16x8*)(Vg + (size_t)(t0 + key) * 1024 + h * 256 + cc); }
        const int itile = wid & 1, vb = (wid >> 1) * 2;
        f32x16 acc[2]; acc[0] = f32x16{}; acc[1] = f32x16{};
#pragma unroll 1
        for (int dir = 0; dir < 2; ++dir) {
            const int cd = dir == 0 ? T : (T < 4 ? 3 - T : 135 - T);
            const u16* Ssrc = ST + (size_t)((bh * 2 + dir) * NCH + cd) * 128 * 256;
#pragma unroll
            for (int q = 0; q < 8; ++q) { const int id = tid + q * NTHR, key = id >> 5, cc = (id & 31) * 8;
                *(bf16x8*)(SS + v_st<8>(key, cc)) = *(const bf16x8*)(Ssrc + (size_t)key * 256 + cc); }
            for (int i = tid; i < 1024; i += NTHR) { const int j = i >> 4, r = i & 15; ZT[i] = Zg[(size_t)(t0 + j) * 32 + dir * 16 + r]; }
            float wg[16];
#pragma unroll
            for (int r = 0; r < 16; ++r) wg[r] = F.in(19)[(dir * 16 + r) * 512 + h * 128 + kk];
            const float bias = F.in(20)[dir * 512 + h * 128 + kk];
            __syncthreads();
            float cv[16]; float run = 0;
#pragma unroll
            for (int u = 0; u < 16; ++u) { const int j = jq * 16 + u; float x = bias;
#pragma unroll
                for (int r = 0; r < 16; ++r) x += ZT[j * 16 + r] * wg[r];
                cv[u] = logsig16(x); }
            if (dir == 0) {
#pragma unroll
                for (int u = 0; u < 16; ++u) { run += cv[u]; cv[u] = run; }
            } else {
#pragma unroll
                for (int u = 15; u >= 0; --u) { run += cv[u]; cv[u] = run; }
            }
            SEG[jq * 128 + kk] = run;
            __syncthreads();
            float offset = 0;
#pragma unroll
            for (int q = 0; q < 4; ++q) { const float sv = SEG[q * 128 + kk]; if (dir == 0 ? (q < jq) : (q > jq)) offset += sv; }
            const int adb = jq * 4096 + ((kk >> 3) << 4) + (kk & 7) * 2;
#pragma unroll
            for (int jj = 0; jj < 16; ++jj) { const int i = jq * 16 + jj; const float cum = offset + cv[jj];
                const float qv = bf2f(Qg[(size_t)(t0 + i) * 512 + h * 128 + kk]) * __expf(cum);
                const float kv = bf2f(Kg[(size_t)(t0 + i) * 512 + h * 128 + kk]) * __expf(-cum);
                const int ad = (adb ^ (jj << 4)) + jj * 256;
                *(u16*)(QD + ad) = f2bf(qv); *(u16*)(KI + ad) = f2bf(kv); }
            __syncthreads();
            {
                const int row = itile * 32 + r32; bf16x8 qa[8];
#pragma unroll
                for (int ks = 0; ks < 8; ++ks) qa[ks] = *(const bf16x8*)(QD + row * 256 + (((ks * 2 + hi) ^ (row & 15)) << 4));
                const int ssb = (int)(uintptr_t)SS + v_rd_base(lane) + vb * 512;
                pv_one<0, 8>(acc[0], ssb, qa[0], qa[1], qa[2], qa[3]); pv_one<0, 8>(acc[0], ssb + 32768, qa[4], qa[5], qa[6], qa[7]);
                pv_one<1, 8>(acc[1], ssb, qa[0], qa[1], qa[2], qa[3]); pv_one<1, 8>(acc[1], ssb + 32768, qa[4], qa[5], qa[6], qa[7]);
                f32x16 p0 = f32x16{}, p1 = f32x16{};
#pragma unroll
                for (int ks = 0; ks < 8; ++ks) {
                    const bf16x8 k0 = *(const bf16x8*)(KI + r32 * 256 + (((ks * 2 + hi) ^ (r32 & 15)) << 4));
                    const bf16x8 k1 = *(const bf16x8*)(KI + (32 + r32) * 256 + (((ks * 2 + hi) ^ (r32 & 15)) << 4));
                    p0 = __builtin_amdgcn_mfma_f32_32x32x16_bf16(k0, qa[ks], p0, 0, 0, 0);
                    p1 = __builtin_amdgcn_mfma_f32_32x32x16_bf16(k1, qa[ks], p1, 0, 0, 0);
                }
                const int iq = itile * 32 + r32;
#pragma unroll
                for (int r = 0; r < 16; ++r) { const int s0 = crow(r, hi), s1 = 32 + s0;
                    const bool k0 = dir == 0 ? (s0 <= iq) : (s0 >= iq), k1 = dir == 0 ? (s1 <= iq) : (s1 >= iq);
                    p0[r] = k0 ? p0[r] : 0.f; p1[r] = k1 ? p1[r] : 0.f; }
                bf16x8 pa0, pa1, pa2, pa3;
                PK4(p0, 0, pa0); PK4(p0, 8, pa1); PK4(p1, 0, pa2); PK4(p1, 8, pa3);
                const int vvb = (int)(uintptr_t)VV + v_rd_base(lane) + vb * 512;
                pv_one<0, 8>(acc[0], vvb, pa0, pa1, pa2, pa3); pv_one<1, 8>(acc[1], vvb, pa0, pa1, pa2, pa3);
            }
            __syncthreads();
        }
        float* olb = OL + (itile * 32 + 4 * hi) * 260 + vb * 32 + r32;
#pragma unroll
        for (int n = 0; n < 2; ++n)
#pragma unroll
            for (int r = 0; r < 16; ++r) olb[((r & 3) + 8 * (r >> 2)) * 260 + n * 32] = acc[n][r];
        __syncthreads();
        {
            const int i = tid >> 3, sg = tid & 7; const float* ol = OL + i * 260 + sg * 32;
            float ss = 0;
#pragma unroll
            for (int u = 0; u < 8; ++u) { const f32x4 t = *(const f32x4*)(ol + u * 4); ss += t[0] * t[0] + t[1] * t[1] + t[2] * t[2] + t[3] * t[3]; }
            ss += __shfl_xor(ss, 1); ss += __shfl_xor(ss, 2); ss += __shfl_xor(ss, 4);
            const float rinv = rsqrtf(ss * (1.f / 256.f) + EPS);
            const u16* gp = Gg + (size_t)(t0 + i) * 1024 + h * 256 + sg * 32; u16* op = OUT + (size_t)(t0 + i) * 1024 + h * 256 + sg * 32;
            const float* hn = F.in(21) + sg * 32;
#pragma unroll
            for (int q = 0; q < 4; ++q) { const bf16x8 g8 = *(const bf16x8*)(gp + q * 8); u32x4 w;
                const f32x4 oa = *(const f32x4*)(ol + q * 8), ob = *(const f32x4*)(ol + q * 8 + 4);
                const float o8[8] = {oa[0], oa[1], oa[2], oa[3], ob[0], ob[1], ob[2], ob[3]};
#pragma unroll
                for (int u = 0; u < 4; ++u) { const int e0 = q * 8 + 2 * u;
                    w[u] = cvtpk(o8[2 * u] * rinv * hn[e0] * silu_f(bf2f((u16)g8[2 * u])), o8[2 * u + 1] * rinv * hn[e0 + 1] * silu_f(bf2f((u16)g8[2 * u + 1]))); }
                *(u32x4*)(op + q * 8) = w; }
        }
    }
}

__device__ __forceinline__ void pair_decode(int p, int& elo, int& ehi) { elo = p < 3 ? 0 : (p < 5 ? 1 : 2); ehi = p < 3 ? p + 1 : (p < 5 ? p - 1 : 3); }
struct MoeATiles {
    typedef GTile<RowsGather, RowsPlain, EpiMoeA> Tile; static constexpr bool EP_CONST = false; EpiMoeA ep;
    const int* tab; u16* H; const int* rowtok; const u16* wgu; u16* act; const float* roww; int nmt, bx, G;
    __device__ __forceinline__ bool get(int i, Tile& t) const {
        int mt, nt; if (!tile_seq(i, bx, G, nmt, 16, mt, nt)) return false;
        const int c = tab[32 + mt], g = c / 6; int elo, ehi; pair_decode(c % 6, elo, ehi);
        const int half = nt >> 3, e = half ? ehi : elo;
        t.al = RowsGather{H, 1024, rowtok};
        t.bl = RowsPlain{wgu + ((size_t)(g * 4 + e) * 1024 + (nt & 7) * 128) * 1024, 1024};
        t.ep = EpiMoeA{act, roww, half, half * 512 + (nt & 7) * 64};
        t.brow = mt * 256; t.bcol = 0; return true; }
};
struct MoeBTiles {
    typedef GTile<RowsPlain, RowsSplitK, EpiMoeB> Tile; static constexpr bool EP_CONST = false; EpiMoeB ep;
    const int* tab; ResCtx F; int li; const u16* wd; const u16* act; const int* rowtok; int nmt, bx, G;
    __device__ __forceinline__ bool get(int i, Tile& t) const {
        int mt, nt; if (!tile_seq(i, bx, G, nmt, 8, mt, nt)) return false;
        const int c = tab[32 + mt], g = c / 6; int elo, ehi; pair_decode(c % 6, elo, ehi);
        t.al = RowsPlain{act, 1024};
        t.bl = RowsSplitK{wd + (size_t)(g * 4 + elo) * 1024 * 512, wd + (size_t)(g * 4 + ehi) * 1024 * 512, 512, 8};
        t.ep = EpiMoeB{F, li, rowtok};
        t.brow = mt * 256; t.bcol = nt * 128; return true; }
};
__device__ __forceinline__ void moe_gemm_a(const Frame& F, int li) {
    int* tab = (int*)(F.lds + LDS_TAB); moe_table(F, li, tab);
    const int nmt = tab[24] >> 8;
    pg8::MoeAOrder S8{tab, F.W<int>(WS_ROWTOK), F.W<u16>(WS_MOEW), nmt, F.bx, F.G}; pg8::EpiMoeA8 E8{F.W<u16>(MOE_ACT), F.W<float>(WS_ROWW)};
    pg8::gemm_phase(F.lds, F.W<u16>(WS_H), 1024, S8, E8);
}
__device__ __forceinline__ void moe_gemm_b(const Frame& F, int li) {
    int* tab = (int*)(F.lds + LDS_TAB); moe_table(F, li, tab);
    const int nmt = tab[24] >> 8;
    MoeBTiles prov{EpiMoeB{}, tab, res_ctx(F), li, F.W<u16>(WS_MOEW + MOE_WGU_BYTES), F.W<u16>(MOE_ACT), F.W<int>(WS_ROWTOK), nmt, F.bx, F.G};
    gemm_stream<4, 2>(F.lds, prov, 16);
}
__device__ __forceinline__ void final_norm(const Frame& F) {
    const int lane = threadIdx.x & 63, wid = threadIdx.x >> 6;
    for (int row = F.bx * NWAVE + wid; row < NLAT; row += F.G * NWAVE) {
        float* xr = F.out + (size_t)row * DM; f32x4 v[4];
#pragma unroll
        for (int i = 0; i < 4; ++i) v[i] = *(const f32x4*)(xr + i * 256 + lane * 4);
        float ss = 0;
#pragma unroll
        for (int i = 0; i < 4; ++i) ss += v[i][0] * v[i][0] + v[i][1] * v[i][1] + v[i][2] * v[i][2] + v[i][3] * v[i][3];
        ss = wave_sum(ss); const float rinv = rsqrtf(ss * (1.f / DM) + EPS);
#pragma unroll
        for (int i = 0; i < 4; ++i) { const f32x4 g = *(const f32x4*)(F.in(30) + i * 256 + lane * 4);
            f32x4 o = {v[i][0] * rinv * g[0], v[i][1] * rinv * g[1], v[i][2] * rinv * g[2], v[i][3] * rinv * g[3]};
            *(f32x4*)(xr + i * 256 + lane * 4) = o; }
    }
}

constexpr int N_PHASES = 42;
__global__ void __launch_bounds__(NTHR, 2) fwd_kernel(Params p) {
    extern __shared__ __attribute__((aligned(16))) char lds[];
    Frame F; F.p = &p; F.ws = p.ws; F.lds = lds; F.out = p.out; F.G = (int)gridDim.x; F.bx = (int)blockIdx.x;
    const int lo = p.ph_lo, hi = p.ph_hi;
#if !MK_PER_PHASE
    if (threadIdx.x == 0) *(uint4*)(lds + LDS_BARW) = make_uint4(0u, 0u, 0u, 0u);
    __syncthreads();
    XcdBarrier bar = xcd_barrier_post((unsigned*)(p.ws + WS_CTL), (volatile LAS unsigned*)(lds + LDS_BARW));
#define GRID_BAR() xcd_barrier(bar)
#else
#define GRID_BAR() do {} while (0)
#endif
#ifndef MK_EN
#define MK_EN 0xFFFFFFFFu
#endif
#define EN(g) (((MK_EN) >> (g)) & 1u)
#ifndef MK_REP
#define MK_REP 0u
#endif
#define REP(g) (((MK_REP) >> (g)) & 1u)
#define IN(k) (lo <= (k) && (k) < hi)
#define SEAM(k) do { if ((k) + 1 < hi) GRID_BAR(); } while (0)
#define DUP(g, body) do { body; if (REP(g)) { GRID_BAR(); body; } } while (0)

    if (EN(0) && IN(0)) { DUP(0, (p0_mods(F), __syncthreads(), p0_rope(F), p0_weights(F))); SEAM(0); }

#define LAYER(LI) { constexpr int li = (LI); constexpr int base = 1 + li * 10; constexpr bool first = li == 0, last = li == DEPTH - 1; constexpr int kind = li % 3, j = li / 3; \
        if (EN(1) && IN(base + 0)) { DUP(1, norm_phase<false>(F, li, 0, first)); SEAM(base + 0); } \
        if constexpr (kind == 0) { \
            if (EN(2) && IN(base + 1)) { EpiF32 ep{F.W<float>(MLA_DQ), 544, 544}; \
                gemm_phase<4, 2>(F, RowsPlain{F.W<u16>(WS_H), 1024}, RowsPlain{F.W<u16>(WS_WDQKV) + (size_t)j * 640 * 1024, 1024}, ep, 0, 132, 5, 16, 0, 0); if (REP(2)) { GRID_BAR(); gemm_phase<4, 2>(F, RowsPlain{F.W<u16>(WS_H), 1024}, RowsPlain{F.W<u16>(WS_WDQKV) + (size_t)j * 640 * 1024, 1024}, ep, 0, 132, 5, 16, 0, 0); } SEAM(base + 1); } \
            if (EN(3) && IN(base + 2)) { DUP(3, mla_rowpass(F, j)); SEAM(base + 2); } \
            if (EN(2) && IN(base + 3)) { \
                EpiMlaQ eq{F.W<u16>(MLA_Q), F.W<float>(WS_ROPEA), F.W<float>(WS_ROPEA) + SEQ * 16, 0.10206207261596577f * LOG2E}; \
                gemm_phase<4, 2>(F, RowsPlain{F.W<u16>(MLA_CN), 512}, RowsPlain{F.W<u16>(WS_WUQ) + (size_t)j * 1536 * 256, 256}, eq, 0, 132, 12, 4, 0, 0); \
                EpiMlaKV ek{F.W<u16>(MLA_KN), (long)((MLA_V - MLA_KN) / 2)}; \
                gemm_phase<4, 2>(F, RowsPlain{F.W<u16>(MLA_CN) + 256, 512}, RowsPlain{F.W<u16>(WS_WUKV) + (size_t)j * 2048 * 256, 256}, ek, 0, 132, 16, 4, 132 * 12, 0); \
                SEAM(base + 3); } \
            if (EN(4) && IN(base + 4)) { DUP(4, mla_attn(F, !last, li)); SEAM(base + 4); } \
            if (EN(2) && IN(base + 5)) { pg8::SeqOrder S8{F.W<u16>(WS_WOM) + (size_t)j * 1024 * 1024, 1024, last ? 128 : 132, 4, F.bx, F.G, last ? 4 : 0}; EpiResid8 E8{res_ctx(F, first), li}; \
                pg8::gemm_phase(F.lds, F.W<u16>(MLA_DQ), 1024, S8, E8); SEAM(base + 5); } \
        } else if constexpr (kind == 1) { \
            if (EN(5) && IN(base + 1)) { pg8::SeqOrder S8{F.W<u16>(WS_WQKVD), 1024, 132, 12, F.bx, F.G, 0}; pg8::EpiDiffQKV8 E8{F.W<u16>(DF_Q), (long)((DF_K - DF_Q) / 2), F.W<u16>(DF_V), 0.125f * LOG2E}; \
                pg8::gemm_phase(F.lds, F.W<u16>(WS_H), 1024, S8, E8); \
                if (REP(5)) { GRID_BAR(); pg8::gemm_phase(F.lds, F.W<u16>(WS_H), 1024, S8, E8); } SEAM(base + 1); } \
            if (EN(6) && IN(base + 2)) { DUP(6, diff_attn(F, li)); SEAM(base + 2); } \
            if (EN(7) && IN(base + 3)) { DUP(7, diff_rowpass(F, 0.35550906759906f)); SEAM(base + 3); } \
            if (EN(5) && IN(base + 4)) { pg8::SeqOrder S8{F.W<u16>(WS_WOD), 1024, 132, 4, F.bx, F.G, 0}; EpiResid8 E8{res_ctx(F, first), li}; \
                pg8::gemm_phase(F.lds, F.W<u16>(DF_Q), 1024, S8, E8); SEAM(base + 4); } \
        } else { \
            if (EN(8) && IN(base + 1)) { pg8::SeqOrder S8{F.W<u16>(WS_WING), 1024, 132, 13, F.bx, F.G, 0}; pg8::EpiGlaIn8 E8{F.W<u16>(GL_Q), F.W<u16>(GL_K), F.W<u16>(GL_V), F.W<u16>(GL_G), F.W<float>(GL_Z)}; \
                pg8::gemm_phase(F.lds, F.W<u16>(WS_H), 1024, S8, E8); \
                if (REP(8)) { GRID_BAR(); pg8::gemm_phase(F.lds, F.W<u16>(WS_H), 1024, S8, E8); } SEAM(base + 1); } \
            if (EN(9) && IN(base + 2)) { DUP(9, gla_g1(F)); SEAM(base + 2); } \
            if (EN(10) && IN(base + 3)) { gla_g2(F); SEAM(base + 3); } \
            if (EN(11) && IN(base + 4)) { DUP(11, gla_g3(F)); SEAM(base + 4); } \
            if (EN(8) && IN(base + 5)) { pg8::SeqOrder S8{F.W<u16>(WS_WOG), 1024, 132, 4, F.bx, F.G, 0}; EpiResid8 E8{res_ctx(F, first), li}; \
                pg8::gemm_phase(F.lds, F.W<u16>(WS_H), 1024, S8, E8); SEAM(base + 5); } \
        } \
        if (EN(12) && IN(base + 6)) { norm_phase<true>(F, li, last ? NCTX : 0, false); SEAM(base + 6); } \
        if (EN(13) && IN(base + 7)) { DUP(13, ((kind == 2 ? moe_weights(F, li) : (void)0), moe_scatter(F, li, last ? NCTX : 0))); SEAM(base + 7); } \
        if (EN(14) && IN(base + 8)) { DUP(14, moe_gemm_a(F, li)); SEAM(base + 8); } \
        if (EN(15) && IN(base + 9)) { moe_gemm_b(F, li); SEAM(base + 9); } \
    }
    LAYER(0) LAYER(1) LAYER(2) LAYER(3)
    if (EN(16) && IN(41)) { final_norm(F); }
}

extern "C" void kernel_launch(void* const* d_in, const int* in_sizes, int n_in, void* d_out, int out_size, void* d_ws, size_t ws_size, hipStream_t stream) {
    static int grid = 0;
    if (grid == 0) {
        if (n_in != 31 || out_size != NLAT * DM || ws_size < WS_END) {
            fprintf(stderr, "kernel_launch: built for 31 inputs, out %d floats, ws >= %zu bytes; got n_in %d out %d ws %zu\n", NLAT * DM, (size_t)WS_END, n_in, out_size, ws_size);
            grid = -1; return; }
        int dev = 0, cus = 0;
        if (hipGetDevice(&dev) != hipSuccess || hipDeviceGetAttribute(&cus, hipDeviceAttributeMultiprocessorCount, dev) != hipSuccess) { grid = -1; return; }
        if (hipFuncSetAttribute((const void*)fwd_kernel, hipFuncAttributeMaxDynamicSharedMemorySize, LDS_BYTES) != hipSuccess) { fprintf(stderr, "kernel_launch: hipFuncSetAttribute failed\n"); grid = -1; return; }
        int per_cu = 0;
        if (hipOccupancyMaxActiveBlocksPerMultiprocessor(&per_cu, (const void*)fwd_kernel, NTHR, LDS_BYTES) != hipSuccess || per_cu < 1)
            fprintf(stderr, "kernel_launch: occupancy query reports %d workgroups per CU\n", per_cu);
        (void)hipGetLastError();
        grid = cus;
    }
    if (grid < 0) return;
    (void)in_sizes;
    (void)hipMemsetAsync((char*)d_ws + WS_CTL, 0, CTL_BYTES, stream);
    Params p{};
    for (int i = 0; i < 31; ++i) p.in[i] = (const float*)d_in[i];
    p.out = (float*)d_out; p.ws = (unsigned char*)d_ws;
#if MK_PER_PHASE
    for (int ph = 0; ph < N_PHASES; ++ph) { p.ph_lo = ph; p.ph_hi = ph + 1; hipLaunchKernelGGL(fwd_kernel, dim3(grid), dim3(NTHR), LDS_BYTES, stream, p); }
#else
#ifdef MK_PROBE_HI
    p.ph_lo = 0; p.ph_hi = MK_PROBE_HI;
    hipLaunchKernelGGL(fwd_kernel, dim3(grid), dim3(NTHR), LDS_BYTES, stream, p);
    (void)hipMemsetAsync((char*)d_ws + WS_CTL, 0, CTL_BYTES, stream);
#endif
    p.ph_lo = 0; p.ph_hi = N_PHASES;
    hipLaunchKernelGGL(fwd_kernel, dim3(grid), dim3(NTHR), LDS_BYTES, stream, p);
#endif
}
```

```cpp
#include <hip/hip_runtime.h>
#include <stdint.h>
#include <stdio.h>

#ifndef MK_PER_PHASE
#define MK_PER_PHASE 0
#endif

typedef unsigned short u16;
using bf16x8 = __attribute__((ext_vector_type(8))) short;
using s16x4  = __attribute__((ext_vector_type(4))) short;
using f32x16 = __attribute__((ext_vector_type(16))) float;
using f32x4  = __attribute__((ext_vector_type(4))) float;
using u32x4  = __attribute__((ext_vector_type(4))) unsigned;
using u32x2  = __attribute__((ext_vector_type(2))) unsigned;

constexpr int DM = 1024, NBATCH = 4, SEQ = 8192, CTXL = 256, DEPTH = 4;
constexpr int NCTX = NBATCH * CTXL;
constexpr int NLAT = NBATCH * SEQ;
constexpr int NTOK = NCTX + NLAT;
constexpr int KEYS = CTXL + SEQ;
constexpr float EPS = 1e-6f;
constexpr int NTHR = 512, NWAVE = 8;
constexpr float LOG2E = 1.4426950408889634f;

constexpr size_t al256(size_t x) { return (x + 255) / 256 * 256; }
constexpr size_t WS_CTL   = 0;
constexpr size_t CTL_BYTES = 32768;
constexpr size_t WS_MODS  = WS_CTL + CTL_BYTES;
constexpr size_t WS_ROPEA = WS_MODS + al256((size_t)DEPTH * 5 * 6144 * 4);
constexpr size_t WS_ROPEB = WS_ROPEA + (size_t)2 * SEQ * 16 * 4;
constexpr size_t WS_XC    = WS_ROPEB + (size_t)2 * SEQ * 32 * 4;
constexpr size_t WS_WDQKV = WS_XC + (size_t)NCTX * DM * 4;
constexpr size_t WS_WUQ   = WS_WDQKV + (size_t)2 * 640 * 1024 * 2;
constexpr size_t WS_WUKV  = WS_WUQ + (size_t)2 * 1536 * 256 * 2;
constexpr size_t WS_WOM   = WS_WUKV + (size_t)2 * 2048 * 256 * 2;
constexpr size_t WS_WQKVD = WS_WOM + (size_t)2 * 1024 * 1024 * 2;
constexpr size_t WS_WOD   = WS_WQKVD + (size_t)3072 * 1024 * 2;
constexpr size_t WS_WING  = WS_WOD + (size_t)1024 * 1024 * 2;
constexpr size_t WS_WOG   = WS_WING + (size_t)3328 * 1024 * 2;
constexpr size_t WS_TOK   = WS_WOG + (size_t)1024 * 1024 * 2;
constexpr size_t WS_ROWTOK= WS_TOK + (size_t)NTOK * 16;
constexpr int    RMAX     = 40960;
constexpr size_t WS_ROWW  = WS_ROWTOK + (size_t)RMAX * 4;
constexpr size_t WS_H     = al256(WS_ROWW + (size_t)RMAX * 8);
constexpr size_t H_BYTES  = (size_t)NTOK * DM * 2;
constexpr size_t WS_MOEW  = WS_H + H_BYTES;
constexpr size_t MOE_WGU_BYTES = (size_t)16 * 1024 * 1024 * 2;
constexpr size_t MOE_WD_BYTES  = (size_t)16 * 1024 * 512 * 2;
constexpr size_t MOEW_BYTES = MOE_WGU_BYTES + MOE_WD_BYTES;
constexpr size_t WS_BIG   = WS_MOEW + MOEW_BYTES;
constexpr size_t MLA_Q    = WS_BIG;
constexpr size_t MLA_KN   = MLA_Q + (size_t)NBATCH * 16 * KEYS * 96 * 2;
constexpr size_t MLA_V    = MLA_KN + (size_t)NBATCH * 16 * KEYS * 64 * 2;
constexpr size_t MLA_KPE  = MLA_V + (size_t)NBATCH * 16 * KEYS * 64 * 2;
constexpr size_t MLA_DQ   = MLA_KPE + al256((size_t)NBATCH * KEYS * 32 * 2);
constexpr size_t MLA_CN   = MLA_DQ + (size_t)NTOK * 544 * 4;
constexpr size_t MLA_END  = MLA_CN + (size_t)NTOK * 512 * 2;
constexpr size_t DF_Q     = WS_BIG;
constexpr size_t DF_K     = DF_Q + (size_t)NBATCH * 16 * KEYS * 64 * 2;
constexpr size_t DF_V     = DF_K + (size_t)NBATCH * 16 * KEYS * 64 * 2;
constexpr size_t DF_OS    = DF_V + (size_t)NBATCH * 8 * KEYS * 128 * 2;
constexpr size_t DF_END   = DF_OS + (size_t)2 * NTOK * DM * 2;
constexpr size_t GL_STATE = WS_MOEW;
constexpr size_t GL_STATE_BYTES = (size_t)NBATCH * 4 * 2 * 132 * 128 * 256 * 2;
constexpr size_t GL_DEC   = GL_STATE + GL_STATE_BYTES;
constexpr size_t GL_Q     = GL_DEC + al256((size_t)4224 * 128 * 4);
constexpr size_t GL_K     = GL_Q + (size_t)NTOK * 512 * 2;
constexpr size_t GL_V     = GL_K + (size_t)NTOK * 512 * 2;
constexpr size_t GL_G     = GL_V + (size_t)NTOK * 1024 * 2;
constexpr size_t GL_Z     = GL_G + (size_t)NTOK * 1024 * 2;
constexpr size_t GL_END   = GL_Z + (size_t)NTOK * 32 * 4;
constexpr size_t MOE_ACT  = WS_BIG;
constexpr size_t MOE_END  = MOE_ACT + (size_t)RMAX * 1024 * 2;
constexpr size_t cmax(size_t a, size_t b) { return a > b ? a : b; }
constexpr size_t WS_END   = cmax(cmax(MLA_END, DF_END), cmax(GL_END, MOE_END));

#define XCD_BAR_WORDS 3456
constexpr int CW_CNT = 4096;

#define XB_TMO      128
#define XB_XCNT(j)  (256  + 64 * (j))
#define XB_XSUB(j)  (1280 + 64 * (j))
#define XB_XGEN(j)  (2304 + 64 * (j))
#define XB_TOP      3328
#define XB_TOPGEN   3392
#define XB_SPIN_CAP (1u << 24)
#define LAS __attribute__((address_space(3)))
__device__ __forceinline__ unsigned xb_ld(unsigned* p)              { return __hip_atomic_load(p, __ATOMIC_RELAXED, __HIP_MEMORY_SCOPE_AGENT); }
__device__ __forceinline__ unsigned xb_add(unsigned* p, unsigned v) { return __hip_atomic_fetch_add(p, v, __ATOMIC_RELAXED, __HIP_MEMORY_SCOPE_AGENT); }
__device__ __forceinline__ unsigned xb_xcc_id() { return (unsigned)__builtin_amdgcn_s_getreg((3 << 11) | 20) & 0xFu; }
#define XB_SPIN(cond, bar) do { unsigned _sp = 0; while (cond) { __builtin_amdgcn_s_sleep(1); \
    if ((++_sp & 255u) == 0u) { if (xb_ld(&(bar)[XB_TMO])) break; if (_sp > XB_SPIN_CAP) { atomicAdd(&(bar)[XB_TMO], 1u); break; } } } } while (0)
struct XcdBarrier { unsigned* bar; unsigned x; volatile LAS unsigned* st; };
__device__ __forceinline__ XcdBarrier xcd_barrier_post(unsigned* bar, volatile LAS unsigned* st) {
    XcdBarrier b; b.bar = bar; b.x = xb_xcc_id(); b.st = st;
    if (threadIdx.x == 0) (void)xb_add(&bar[XB_XCNT(b.x)], 1u);
    return b;
}
__device__ __forceinline__ void xcd_barrier_complete(unsigned* bar, unsigned x, unsigned& nloc, unsigned& nx) {
    const unsigned G = gridDim.x * gridDim.y * gridDim.z;
    unsigned sum, cnt, mine, sp = 0u;
    for (;;) {
        sum = 0u; cnt = 0u; mine = 0u;
#pragma unroll
        for (unsigned j = 0; j < 16; ++j) { const unsigned c = xb_ld(&bar[XB_XCNT(j)]); sum += c; cnt += (c > 0u) ? 1u : 0u; mine = (j == x) ? c : mine; }
        if (sum == G) break;
        __builtin_amdgcn_s_sleep(1);
        if ((++sp & 255u) == 0u) { if (xb_ld(&bar[XB_TMO])) break; if (sp > XB_SPIN_CAP) { atomicAdd(&bar[XB_TMO], 1u); break; } }
    }
    nloc = mine > 0u ? mine : 1u; nx = cnt > 0u ? cnt : 1u;
}
__device__ __forceinline__ void xcd_barrier(const XcdBarrier& b) {
    asm volatile("s_waitcnt vmcnt(0)" ::: "memory");
    __syncthreads();
    if (threadIdx.x == 0) {
        unsigned* bar = b.bar;
        __builtin_amdgcn_s_waitcnt(0);
        unsigned nloc = b.st[0], nx = b.st[1];
        if (nloc == 0u) { xcd_barrier_complete(bar, b.x, nloc, nx); b.st[0] = nloc; b.st[1] = nx; }
        const unsigned old = xb_add(&bar[XB_XSUB(b.x)], 1u);
        const unsigned gen = old / nloc;
        if (old + 1u == (gen + 1u) * nloc) {
            __builtin_amdgcn_fence(__ATOMIC_RELEASE, "agent");
            asm volatile("s_waitcnt vmcnt(0)" ::: "memory");
            const unsigned og = xb_add(&bar[XB_TOP], 1u);
            const unsigned tg = og / nx;
            if (og + 1u == (tg + 1u) * nx) xb_add(&bar[XB_TOPGEN], 1u);
            else XB_SPIN(xb_ld(&bar[XB_TOPGEN]) == tg, bar);
            __builtin_amdgcn_fence(__ATOMIC_ACQUIRE, "agent");
            xb_add(&bar[XB_XGEN(b.x)], 1u);
            asm volatile("s_waitcnt vmcnt(0)" ::: "memory");
        } else {
            XB_SPIN(xb_ld(&bar[XB_XGEN(b.x)]) == gen, bar);
            __builtin_amdgcn_fence(__ATOMIC_ACQUIRE, "agent");
            asm volatile("s_waitcnt vmcnt(0)" ::: "memory");
        }
    }
    __syncthreads();
}

__device__ __forceinline__ u16 f2bf(float f) { unsigned u = __float_as_uint(f); u += 0x7FFFu + ((u >> 16) & 1u); return (u16)(u >> 16); }
__device__ __forceinline__ float bf2f(u16 h) { return __uint_as_float((unsigned)h << 16); }
__device__ __forceinline__ unsigned cvtpk(float lo, float hi) { unsigned r; asm volatile("v_cvt_pk_bf16_f32 %0, %1, %2" : "=v"(r) : "v"(lo), "v"(hi)); return r; }
__device__ __forceinline__ float wave_sum(float v) {
#pragma unroll
    for (int o = 32; o; o >>= 1) v += __shfl_xor(v, o);
    return v;
}
__device__ __forceinline__ int crow(int r, int hi) { return (r & 3) + 8 * (r >> 2) + 4 * hi; }
__device__ __forceinline__ void row_bp(int row, int& b, int& pos) {
    if (row < NCTX) { b = row >> 8; pos = row & 255; } else { const int r = row - NCTX; b = r >> 13; pos = CTXL + (r & (SEQ - 1)); }
}
__device__ __forceinline__ float silu_f(float x) { return x / (1.f + __expf(-x)); }
#define SBAR() __builtin_amdgcn_sched_barrier(0)

struct Params { const float* in[31]; float* out; unsigned char* ws; int ph_lo, ph_hi; };

struct RowsPlain  { const u16* base; long ld;
    __device__ __forceinline__ long off(int r) const { return (long)r * ld; }
    __device__ __forceinline__ const u16* kbase(int kt) const { return base + kt * 64; } };
struct RowsGather { const u16* base; long ld; const int* idx;
    __device__ __forceinline__ long off(int r) const { int t = idx[r]; t = t < 0 ? 0 : t; return (long)t * ld; }
    __device__ __forceinline__ const u16* kbase(int kt) const { return base + kt * 64; } };
struct RowsSplitK { const u16* b0; const u16* b1; long ld; int ks;
    __device__ __forceinline__ long off(int r) const { return (long)r * ld; }
    __device__ __forceinline__ const u16* kbase(int kt) const { return kt < ks ? b0 + kt * 64 : b1 + (kt - ks) * 64; } };

constexpr int GEMM_LDS = 2 * 384 * 128;

template <int WM, int WN, class AL, class BL, class EP>
__device__ __forceinline__ void gemm_tile(char* lds, const AL al, const BL bl, EP& ep, int brow, int bcol, int nk) {
    constexpr int BM = WM * 64, BN = WN * 64, STG = (BM + BN) * 128, NA = BM / 64, NB = BN / 64;
    const int tid = threadIdx.x, lane = tid & 63, wid = __builtin_amdgcn_readfirstlane(tid >> 6);
    const int wm = wid / WN, wn = wid % WN, r32 = lane & 31, hi = lane >> 5;
    long aoff[NA], boff[NB];
#pragma unroll
    for (int i = 0; i < NA; ++i) { const int r = (i * 8 + wid) * 8 + (lane >> 3); const int c = (lane & 7) ^ ((r >> 1) & 7); aoff[i] = al.off(brow + r) + c * 8; }
#pragma unroll
    for (int i = 0; i < NB; ++i) { const int r = (i * 8 + wid) * 8 + (lane >> 3); const int c = (lane & 7) ^ ((r >> 1) & 7); boff[i] = bl.off(bcol + r) + c * 8; }
    const int ldsw = wid * 1024 + lane * 16;
    int abase[2], bbase[2];
#pragma unroll
    for (int i = 0; i < 2; ++i) {
        const int ra = wm * 64 + i * 32 + r32; abase[i] = ra * 128 + ((hi ^ ((ra >> 1) & 7)) << 4);
        const int rb = wn * 64 + i * 32 + r32; bbase[i] = BM * 128 + rb * 128 + ((hi ^ ((rb >> 1) & 7)) << 4);
    }
    f32x16 acc[2][2];
#pragma unroll
    for (int i = 0; i < 2; ++i)
#pragma unroll
        for (int j = 0; j < 2; ++j) acc[i][j] = f32x16{};
#define GSTAGE(kt, buf) do { const u16* _ka = al.kbase(kt); const u16* _kb = bl.kbase(kt); char* _d = lds + (buf) * STG + ldsw; \
        _Pragma("unroll") for (int _i = 0; _i < NA; ++_i) __builtin_amdgcn_global_load_lds((const unsigned*)(_ka + aoff[_i]), (unsigned*)(_d + _i * 8192), 16, 0, 0); \
        _Pragma("unroll") for (int _i = 0; _i < NB; ++_i) __builtin_amdgcn_global_load_lds((const unsigned*)(_kb + boff[_i]), (unsigned*)(_d + BM * 128 + _i * 8192), 16, 0, 0); } while (0)
    __syncthreads();
    GSTAGE(0, 0);
    for (int kt = 0; kt < nk; ++kt) {
        asm volatile("s_waitcnt vmcnt(0)" ::: "memory");
        __syncthreads();
        if (kt + 1 < nk) GSTAGE(kt + 1, (kt + 1) & 1);
        const char* sb = lds + (kt & 1) * STG;
#pragma unroll
        for (int ks = 0; ks < 4; ++ks) {
            bf16x8 a0 = *(const bf16x8*)(sb + (abase[0] ^ (ks << 5)));
            bf16x8 a1 = *(const bf16x8*)(sb + (abase[1] ^ (ks << 5)));
            bf16x8 b0 = *(const bf16x8*)(sb + (bbase[0] ^ (ks << 5)));
            bf16x8 b1 = *(const bf16x8*)(sb + (bbase[1] ^ (ks << 5)));
            acc[0][0] = __builtin_amdgcn_mfma_f32_32x32x16_bf16(a0, b0, acc[0][0], 0, 0, 0);
            acc[0][1] = __builtin_amdgcn_mfma_f32_32x32x16_bf16(a0, b1, acc[0][1], 0, 0, 0);
            acc[1][0] = __builtin_amdgcn_mfma_f32_32x32x16_bf16(a1, b0, acc[1][0], 0, 0, 0);
            acc[1][1] = __builtin_amdgcn_mfma_f32_32x32x16_bf16(a1, b1, acc[1][1], 0, 0, 0);
        }
    }
#undef GSTAGE
    ep(acc, brow + wm * 64, bcol + wn * 64, lane);
}


constexpr int GSTG = 384 * 128;
template <class AL_, class BL_, class EP_> struct GTile { typedef EP_ EPT; AL_ al; BL_ bl; EP_ ep; int brow, bcol; };
__device__ __forceinline__ bool tile_seq(int i, int bx, int G, int nM, int nN, int& m, int& n) {
    const int s = (G == 256) ? (i * 8 + (bx & 7)) * 32 + (bx >> 3) : bx + i * G;
    if (s >= nM * nN) return false;
    const int full = (nM >> 2) * 4 * nN;
    if (s < full) { const int band = s / (4 * nN), rem = s - band * 4 * nN; n = rem >> 2; m = band * 4 + (rem & 3); }
    else { const int h = nM & 3, rem = s - full; n = rem / h; m = (nM & ~3) + rem - n * h; }
    return true;
}
template <class AL_, class BL_, class EP_> struct PlainTiles {
    typedef GTile<AL_, BL_, EP_> Tile; static constexpr bool EP_CONST = true;
    AL_ al; BL_ bl; EP_ ep; int mt0, nM, nN, bx, G;
    __device__ __forceinline__ bool get(int i, Tile& t) const {
        int m, n; if (!tile_seq(i, bx, G, nM, nN, m, n)) return false;
        t.al = al; t.bl = bl; t.ep = ep; t.brow = (mt0 + m) * 256; t.bcol = n * 128; return true; }
};
template <int WM, int WN, class P>
__device__ __forceinline__ void gemm_stream(char* lds, const P& prov, int nk) {
    constexpr int BM = WM * 64, BN = WN * 64, NA = BM / 64, NB = BN / 64;
    static_assert(NA + NB == 6, "the counted wait assumes six LDS-DMA loads per wave per K-step");
    const int tid = threadIdx.x, lane = tid & 63, wid = __builtin_amdgcn_readfirstlane(tid >> 6);
    const int wm = wid / WN, wn = wid % WN, r32 = lane & 31, hi = lane >> 5;
    typename P::Tile cur, nxt;
    if (!prov.get(0, cur)) return;
    unsigned aoff[NA], boff[NB], aoffn[NA], boffn[NB];
#define GOFFS(T, AO, BO) do { \
    _Pragma("unroll") for (int _i = 0; _i < NA; ++_i) { const int _r = (_i * 8 + wid) * 8 + (lane >> 3); const int _c = (lane & 7) ^ ((_r >> 1) & 7); AO[_i] = (unsigned)((T).al.off((T).brow + _r) + _c * 8); } \
    _Pragma("unroll") for (int _i = 0; _i < NB; ++_i) { const int _r = (_i * 8 + wid) * 8 + (lane >> 3); const int _c = (lane & 7) ^ ((_r >> 1) & 7); BO[_i] = (unsigned)((T).bl.off((T).bcol + _r) + _c * 8); } } while (0)
#define GSTAGE2(T, AO, BO, kt, slot) do { const u16* _ka = (T).al.kbase(kt); const u16* _kb = (T).bl.kbase(kt); char* _d = lds + (slot) * GSTG + ldsw; \
        _Pragma("unroll") for (int _i = 0; _i < NA; ++_i) __builtin_amdgcn_global_load_lds((const unsigned*)(_ka + AO[_i]), (unsigned*)(_d + _i * 8192), 16, 0, 0); \
        _Pragma("unroll") for (int _i = 0; _i < NB; ++_i) __builtin_amdgcn_global_load_lds((const unsigned*)(_kb + BO[_i]), (unsigned*)(_d + BM * 128 + _i * 8192), 16, 0, 0); } while (0)
    GOFFS(cur, aoff, boff);
    const int ldsw = wid * 1024 + lane * 16;
    int abase[2], bbase[2];
#pragma unroll
    for (int i = 0; i < 2; ++i) {
        const int ra = wm * 64 + i * 32 + r32; abase[i] = ra * 128 + ((hi ^ ((ra >> 1) & 7)) << 4);
        const int rb = wn * 64 + i * 32 + r32; bbase[i] = BM * 128 + rb * 128 + ((hi ^ ((rb >> 1) & 7)) << 4);
    }
    f32x16 acc[2][2];
#pragma unroll
    for (int i = 0; i < 2; ++i)
#pragma unroll
        for (int j = 0; j < 2; ++j) acc[i][j] = f32x16{};
    __syncthreads();
    GSTAGE2(cur, aoff, boff, 0, 0); GSTAGE2(cur, aoff, boff, 1, 1);
    int slot = 0; bool pendE = false; typename P::Tile::EPT pep = cur.ep; int pbrow = 0, pbcol = 0;
    for (int i = 0;; ++i) {
        const bool has_next = prov.get(i + 1, nxt);
        if (has_next) GOFFS(nxt, aoffn, boffn);
        for (int kt = 0; kt < nk; ++kt) {
            if ((kt + 1 < nk) || has_next) asm volatile("s_waitcnt vmcnt(6)" ::: "memory"); else asm volatile("s_waitcnt vmcnt(0)" ::: "memory");
            __builtin_amdgcn_s_barrier(); asm volatile("" ::: "memory");
            const int s2 = slot >= 1 ? slot - 1 : 2;
            if (kt + 2 < nk) GSTAGE2(cur, aoff, boff, kt + 2, s2); else if (has_next) GSTAGE2(nxt, aoffn, boffn, kt + 2 - nk, s2);
            if (kt == 0 && pendE) {
                if constexpr (P::EP_CONST) (void)prov.ep(acc, pbrow + wm * 64, pbcol + wn * 64, lane); else (void)pep(acc, pbrow + wm * 64, pbcol + wn * 64, lane);
                pendE = false;
#pragma unroll
                for (int a = 0; a < 2; ++a)
#pragma unroll
                    for (int b = 0; b < 2; ++b) acc[a][b] = f32x16{};
            }
            const char* sb = lds + slot * GSTG;
#pragma unroll
            for (int ks = 0; ks < 4; ++ks) {
                bf16x8 a0 = *(const bf16x8*)(sb + (abase[0] ^ (ks << 5)));
                bf16x8 a1 = *(const bf16x8*)(sb + (abase[1] ^ (ks << 5)));
                bf16x8 b0 = *(const bf16x8*)(sb + (bbase[0] ^ (ks << 5)));
                bf16x8 b1 = *(const bf16x8*)(sb + (bbase[1] ^ (ks << 5)));
                acc[0][0] = __builtin_amdgcn_mfma_f32_32x32x16_bf16(b0, a0, acc[0][0], 0, 0, 0);
                acc[0][1] = __builtin_amdgcn_mfma_f32_32x32x16_bf16(b1, a0, acc[0][1], 0, 0, 0);
                acc[1][0] = __builtin_amdgcn_mfma_f32_32x32x16_bf16(b0, a1, acc[1][0], 0, 0, 0);
                acc[1][1] = __builtin_amdgcn_mfma_f32_32x32x16_bf16(b1, a1, acc[1][1], 0, 0, 0);
            }
            slot = slot == 2 ? 0 : slot + 1;
        }
        if (!has_next) { (void)cur.ep(acc, cur.brow + wm * 64, cur.bcol + wn * 64, lane); break; }
        if constexpr (!P::EP_CONST) pep = cur.ep;
        pbrow = cur.brow; pbcol = cur.bcol; pendE = true;
        cur = nxt;
#pragma unroll
        for (int a = 0; a < NA; ++a) aoff[a] = aoffn[a];
#pragma unroll
        for (int b = 0; b < NB; ++b) boff[b] = boffn[b];
    }
    asm volatile("s_waitcnt vmcnt(0)" ::: "memory");
    __syncthreads();
#undef GOFFS
#undef GSTAGE2
}


template <int NF> __device__ __forceinline__ void rope_cs(int n, int i, float& cs, float& sn) {
    const int fi = i & (NF - 1); const float pos = (i < NF) ? (float)(n >> 6) : (float)(n & 63);
    const float invf = __builtin_amdgcn_exp2f(-(float)fi / (float)NF * 13.287712379549449f);
    const float ang = pos * invf; float rev = ang * 0.15915494309189535f; rev -= floorf(rev);
    cs = __builtin_amdgcn_cosf(rev); sn = __builtin_amdgcn_sinf(rev);
}
namespace pg8 {
constexpr int BM = 256, BK = 64, HALF = 128, HTB = HALF * BK * 2, STAGE_BYTES = 8 * HTB;
__device__ __forceinline__ int lds_byte(int r, int c) { const int st = (r >> 4) * 2 + (c >> 5), rr = r & 15, cc = c & 31, ob = rr * 64 + cc * 2; return st * 1024 + (ob ^ (((ob >> 9) & 1) << 5)); }
__device__ __forceinline__ void stage_rc(int b, int& R, int& C) { const int st = b / 1024, sb = b % 1024, swz = sb ^ (((sb >> 9) & 1) << 5); R = (st >> 1) * 16 + swz / 64; C = (st & 1) * 32 + (swz % 64) / 2; }
struct Unit { int pm, pn; };
template <class Epi, class Sched>
__device__ __forceinline__ void gemm_phase(char* lds, int lda, int K, const Sched& S, const Epi& E) {
    constexpr bool GA = Sched::GATHER;
    const int tid = threadIdx.x, wid = __builtin_amdgcn_readfirstlane(tid >> 6), lane = tid & 63, wr = wid >> 2, wc = wid & 3, fr = lane & 15, fq = lane >> 4;
    const int nt = K / BK;
    unsigned voffB[2], vbA[2], vc0[2], vc1[2], vn0[2], vn1[2]; int sR[2], sC[2];
#pragma unroll
    for (int i = 0; i < 2; ++i) { stage_rc(tid * 16 + i * 8192, sR[i], sC[i]); voffB[i] = (unsigned)(sR[i] * K + sC[i]) * 2u; vbA[i] = (unsigned)(sR[i] * lda + sC[i]) * 2u; }
    const size_t kstep = (size_t)(BK * 2), hstep = (size_t)HALF * K * 2, hstepA = (size_t)HALF * lda * 2;
    const unsigned ldsw = (unsigned)wid * 1024u;
    const int aoff = lds_byte(wr * 64 + fr, fq * 8), boff = lds_byte(wc * 32 + fr, fq * 8);
#define PG8_AOFFS(u, v0, v1) do { _Pragma("unroll") for (int _i = 0; _i < 2; ++_i) { \
        if constexpr (GA) { v0[_i] = (unsigned)S.arow(u, sR[_i]) * (unsigned)(lda * 2) + (unsigned)sC[_i] * 2u; v1[_i] = (unsigned)S.arow(u, HALF + sR[_i]) * (unsigned)(lda * 2) + (unsigned)sC[_i] * 2u; } \
        else { v0[_i] = vbA[_i] + (unsigned)(u).pm * (unsigned)(256 * lda * 2); v1[_i] = v0[_i] + (unsigned)hstepA; } } } while (0)
#define PG8_SA(b, h) (((b) * 2 + (h)) * HTB)
#define PG8_SB(b, h) ((4 + (b) * 2 + (h)) * HTB)
#define PG8_STAGE(bufoff, gbase, voff) do { _Pragma("unroll") for (int _i = 0; _i < 2; ++_i) \
        __builtin_amdgcn_global_load_lds((const unsigned*)((const char*)(gbase) + (voff)[_i]), (unsigned*)(lds + (bufoff) + ldsw + _i * 8192), 16, 0, 0); } while (0)
#define PG8_STA(bufoff, kt, h, nx) do { const char* _g = ((nx) ? nAb : cAb) + (size_t)(kt) * kstep; unsigned _v[2]; \
        _Pragma("unroll") for (int _i = 0; _i < 2; ++_i) _v[_i] = (nx) ? ((h) ? vn1[_i] : vn0[_i]) : ((h) ? vc1[_i] : vc0[_i]); PG8_STAGE(bufoff, _g, _v); } while (0)
#define PG8_LDA(dst, b, h) do { _Pragma("unroll") for (int m = 0; m < 4; ++m) _Pragma("unroll") for (int k = 0; k < 2; ++k) dst[m][k] = *(const bf16x8*)(lds + PG8_SA(b, h) + aoff + m * 2048 + k * 1024); } while (0)
#define PG8_LDB(dst, b, h) do { _Pragma("unroll") for (int n = 0; n < 2; ++n) _Pragma("unroll") for (int k = 0; k < 2; ++k) dst[n][k] = *(const bf16x8*)(lds + PG8_SB(b, h) + boff + n * 2048 + k * 1024); } while (0)
#define PG8_MMA(ai, bj, At, Bt_) do { __builtin_amdgcn_s_setprio(1); _Pragma("unroll") for (int m = 0; m < 4; ++m) _Pragma("unroll") for (int n = 0; n < 2; ++n) _Pragma("unroll") for (int k = 0; k < 2; ++k) \
        acc[ai][bj][m][n] = __builtin_amdgcn_mfma_f32_16x16x32_bf16(Bt_[n][k], At[m][k], acc[ai][bj][m][n], 0, 0, 0); __builtin_amdgcn_s_setprio(0); } while (0)
#define PG8_WAIT_V(n) asm volatile("s_waitcnt vmcnt(" #n ")" ::: "memory")
#define PG8_WAIT_L(n) asm volatile("s_waitcnt lgkmcnt(" #n ")" ::: "memory")
#define PG8_BAR __builtin_amdgcn_s_barrier()
#define PG8_SCHED __builtin_amdgcn_sched_barrier(0)
    Unit cur, nxt; int ui = 0;
    if (!S.next(0, cur)) return;
    f32x4 acc[2][2][4][2];
#pragma unroll
    for (int a = 0; a < 2; ++a)
#pragma unroll
        for (int b = 0; b < 2; ++b)
#pragma unroll
            for (int m = 0; m < 4; ++m)
#pragma unroll
                for (int n = 0; n < 2; ++n) acc[a][b][m][n] = (f32x4){0.f, 0.f, 0.f, 0.f};
    bf16x8 At[4][2], B0[2][2], B1[2][2];
    PG8_AOFFS(cur, vc0, vc1);
    const char* cB = (const char*)S.bbase(cur); const char* cAb = (const char*)S.abase(cur); const char* nAb = cAb;
    __syncthreads();
    PG8_STAGE(PG8_SB(0, 0), cB, voffB); PG8_STA(PG8_SA(0, 0), 0, 0, false); PG8_STAGE(PG8_SB(0, 1), cB + hstep, voffB); PG8_STA(PG8_SA(0, 1), 0, 1, false);
    if (wr == 1) PG8_BAR;
    PG8_WAIT_V(4); PG8_BAR;
    PG8_STAGE(PG8_SB(1, 0), cB + kstep, voffB); PG8_STA(PG8_SA(1, 0), 1, 0, false); PG8_STAGE(PG8_SB(1, 1), cB + hstep + kstep, voffB);
    PG8_WAIT_V(6); PG8_BAR;
    for (;;) {
        const bool has_next = S.next(ui + 1, nxt);
        const char* nB = cB;
        nAb = cAb;
        if (has_next) { PG8_AOFFS(nxt, vn0, vn1); nB = (const char*)S.bbase(nxt); nAb = (const char*)S.abase(nxt); }
        else {
#pragma unroll
            for (int i = 0; i < 2; ++i) { vn0[i] = vc0[i]; vn1[i] = vc1[i]; } }
#pragma unroll 1
        for (int t = 0; t < nt; t += 2) {
            const bool last = (t == nt - 2);
            const int k2 = last ? 0 : t + 2, k3 = k2 + 1;
            const char* b2 = last ? nB : cB + (size_t)(t + 2) * kstep; const char* b3 = b2 + kstep;
            PG8_LDB(B0, 0, 0); PG8_SCHED; PG8_LDA(At, 0, 0); PG8_STA(PG8_SA(1, 1), t + 1, 1, false);
            PG8_WAIT_L(8); PG8_BAR; PG8_WAIT_L(0); PG8_MMA(0, 0, At, B0); PG8_BAR; PG8_SCHED;
            PG8_LDB(B1, 0, 1); PG8_STAGE(PG8_SB(0, 0), b2, voffB);
            PG8_BAR; PG8_WAIT_L(0); PG8_MMA(0, 1, At, B1); PG8_BAR;
            PG8_LDA(At, 0, 1); PG8_STA(PG8_SA(0, 0), k2, 0, last);
            PG8_BAR; PG8_WAIT_L(0); PG8_MMA(1, 0, At, B0); PG8_BAR; PG8_SCHED;
            PG8_STAGE(PG8_SB(0, 1), b2 + hstep, voffB);
            PG8_WAIT_V(6); PG8_BAR; PG8_MMA(1, 1, At, B1); PG8_BAR;
            PG8_LDB(B0, 1, 0); PG8_SCHED; PG8_LDA(At, 1, 0); PG8_STA(PG8_SA(0, 1), k2, 1, last);
            PG8_WAIT_L(8); PG8_BAR; PG8_WAIT_L(0); PG8_MMA(0, 0, At, B0); PG8_BAR; PG8_SCHED;
            PG8_LDB(B1, 1, 1); PG8_STAGE(PG8_SB(1, 0), b3, voffB);
            PG8_BAR; PG8_WAIT_L(0); PG8_MMA(0, 1, At, B1); PG8_BAR;
            PG8_LDA(At, 1, 1); PG8_STA(PG8_SA(1, 0), k3, 0, last);
            PG8_BAR; PG8_WAIT_L(0); PG8_MMA(1, 0, At, B0); PG8_BAR; PG8_SCHED;
            PG8_STAGE(PG8_SB(1, 1), b3 + hstep, voffB);
            PG8_WAIT_V(6); PG8_BAR; PG8_MMA(1, 1, At, B1); PG8_BAR;
        }
        E(acc, cur, wr, wc, fr, fq);
        if (!has_next) break;
#pragma unroll
        for (int a = 0; a < 2; ++a)
#pragma unroll
            for (int b = 0; b < 2; ++b)
#pragma unroll
                for (int m = 0; m < 4; ++m)
#pragma unroll
                    for (int n = 0; n < 2; ++n) acc[a][b][m][n] = (f32x4){0.f, 0.f, 0.f, 0.f};
        cur = nxt; cB = nB; cAb = nAb; ++ui;
#pragma unroll
        for (int i = 0; i < 2; ++i) { vc0[i] = vn0[i]; vc1[i] = vn1[i]; }
    }
    PG8_WAIT_V(0);
    if (wr == 0) PG8_BAR;
    PG8_BAR;
#undef PG8_AOFFS
#undef PG8_STA
#undef PG8_SA
#undef PG8_SB
#undef PG8_STAGE
#undef PG8_LDA
#undef PG8_LDB
#undef PG8_MMA
#undef PG8_WAIT_V
#undef PG8_WAIT_L
#undef PG8_BAR
#undef PG8_SCHED
}
struct SeqOrder { static constexpr bool GATHER = false; const u16* A; const u16* Bt; int K, nM, nN, bx, G, mt0;
    __device__ __forceinline__ const u16* abase(const Unit&) const { return A; }
    __device__ __forceinline__ bool next(int i, Unit& u) const { const bool ok = tile_seq(i, bx, G, nM, nN, u.pm, u.pn); u.pm += mt0; return ok; }
    __device__ __forceinline__ const u16* bbase(const Unit& u) const { return Bt + (size_t)u.pn * 256 * K; }
    __device__ __forceinline__ int arow(const Unit& u, int r) const { return u.pm * 256 + r; } };
struct EpiGlaIn8 { u16* q; u16* k; u16* v; u16* g; float* z;
    __device__ __forceinline__ void operator()(const f32x4 (&acc)[2][2][4][2], const Unit& u, int wr, int wc, int fr, int fq) const {
#pragma unroll
        for (int bj = 0; bj < 2; ++bj)
#pragma unroll
            for (int n = 0; n < 2; ++n) { const int c0 = u.pn * 256 + bj * 128 + wc * 32 + n * 16, col = c0 + 4 * fq;
                if (c0 >= 3104) continue;
                u16* base; int ld, cc; float scl = 1.f;
                if (c0 < 512) { base = q; ld = 512; cc = col; scl = 0.08838834764831845f; } else if (c0 < 1024) { base = k; ld = 512; cc = col - 512; }
                else if (c0 < 2048) { base = v; ld = 1024; cc = col - 1024; } else if (c0 < 3072) { base = g; ld = 1024; cc = col - 2048; } else { base = nullptr; ld = 32; cc = col - 3072; }
#pragma unroll
                for (int ai = 0; ai < 2; ++ai)
#pragma unroll
                    for (int m = 0; m < 4; ++m) { const size_t row = (size_t)u.pm * 256 + ai * 128 + wr * 64 + m * 16 + fr; const f32x4 a = acc[ai][bj][m][n];
                        if (c0 < 3072) { u32x2 w = {cvtpk(a[0] * scl, a[1] * scl), cvtpk(a[2] * scl, a[3] * scl)}; *(u32x2*)(base + row * ld + cc) = w; }
                        else *(f32x4*)(z + row * 32 + cc) = a; } }
    } };
struct EpiDiffQKV8 { u16* Q; long kdelta; u16* V; float qscale;
    __device__ __forceinline__ void operator()(const f32x4 (&acc)[2][2][4][2], const Unit& u, int wr, int wc, int fr, int fq) const {
#pragma unroll
        for (int ai = 0; ai < 2; ++ai)
#pragma unroll
            for (int m = 0; m < 4; ++m) { int frr = fr; asm volatile("" : "+v"(frr));
                const int row = u.pm * 256 + ai * 128 + wr * 64 + m * 16 + frr; int b, pos; row_bp(row, b, pos); const bool lat = row >= NCTX; const int np = (row - NCTX) & (SEQ - 1);
                if (u.pn < 8) { const int region = u.pn >> 2, hh = (u.pn & 3) * 4 + wc; const float scl = region == 0 ? qscale : 1.f;
                    u16* o = Q + (long)region * kdelta + ((size_t)(b * 16 + hh) * KEYS + pos) * 64;
#pragma unroll
                    for (int n = 0; n < 2; ++n) { const int d0 = 16 * n + 4 * fq; const f32x4 t1 = acc[ai][0][m][n], t2 = acc[ai][1][m][n]; float o1[4], o2[4];
#pragma unroll
                        for (int j = 0; j < 4; ++j) { float cs = 1.f, sn = 0.f; if (lat) rope_cs<16>(np, d0 + j, cs, sn); o1[j] = (t1[j] * cs - t2[j] * sn) * scl; o2[j] = (t1[j] * sn + t2[j] * cs) * scl; }
                        u32x2 w1 = {cvtpk(o1[0], o1[1]), cvtpk(o1[2], o1[3])}, w2 = {cvtpk(o2[0], o2[1]), cvtpk(o2[2], o2[3])};
                        *(u32x2*)(o + d0) = w1; *(u32x2*)(o + 32 + d0) = w2; }
                } else {
#pragma unroll
                    for (int bj = 0; bj < 2; ++bj) { const int head = (u.pn - 8) * 2 + bj; u16* o = V + ((size_t)(b * 8 + head) * KEYS + pos) * 128 + wc * 32 + 4 * fq;
#pragma unroll
                        for (int n = 0; n < 2; ++n) { const f32x4 a = acc[ai][bj][m][n]; u32x2 w = {cvtpk(a[0], a[1]), cvtpk(a[2], a[3])}; *(u32x2*)(o + 16 * n) = w; } }
                } }
    } };
struct MoeAOrder { static constexpr bool GATHER = true; const u16* A; const int* tab; const int* rowtok; const u16* wgu; int nmt, bx, G;
    __device__ __forceinline__ const u16* abase(const Unit&) const { return A; }
    __device__ __forceinline__ bool next(int i, Unit& u) const { return tile_seq(i, bx, G, nmt, 8, u.pm, u.pn); }
    __device__ __forceinline__ const u16* bbase(const Unit& u) const {
        const int c = tab[32 + u.pm], g = c / 6, p = c - g * 6; const int elo = p < 3 ? 0 : (p < 5 ? 1 : 2), ehi = p < 3 ? p + 1 : (p < 5 ? p - 1 : 3);
        const int e = (u.pn >> 2) ? ehi : elo; return wgu + ((size_t)(g * 4 + e) * 1024 + (u.pn & 3) * 256) * 1024; }
    __device__ __forceinline__ int arow(const Unit& u, int r) const { const int t = rowtok[u.pm * 256 + r]; return t < 0 ? 0 : t; } };
struct EpiMoeA8 { u16* act; const float* roww;
    __device__ __forceinline__ void operator()(const f32x4 (&acc)[2][2][4][2], const Unit& u, int wr, int wc, int fr, int fq) const {
        const int half = u.pn >> 2, cb = half * 512 + (u.pn & 3) * 128 + wc * 32 + 4 * fq;
#pragma unroll
        for (int ai = 0; ai < 2; ++ai)
#pragma unroll
            for (int m = 0; m < 4; ++m) { const size_t row = (size_t)u.pm * 256 + ai * 128 + wr * 64 + m * 16 + fr; const float w = roww[2 * row + half];
#pragma unroll
                for (int n = 0; n < 2; ++n) { const f32x4 gt = acc[ai][0][m][n], up = acc[ai][1][m][n]; float v[4];
#pragma unroll
                    for (int j = 0; j < 4; ++j) v[j] = silu_f(gt[j]) * up[j] * w;
                    u32x2 pk = {cvtpk(v[0], v[1]), cvtpk(v[2], v[3])}; *(u32x2*)(act + row * 1024 + cb + 16 * n) = pk; } }
    } };
struct MlaUpOrder { static constexpr bool GATHER = false; const u16* CN; const u16* wuq; const u16* wukv; int bx, G;
    __device__ __forceinline__ bool next(int i, Unit& u) const { return tile_seq(i, bx, G, 132, 14, u.pm, u.pn); }
    __device__ __forceinline__ const u16* abase(const Unit& u) const { return u.pn < 6 ? CN : CN + 256; }
    __device__ __forceinline__ const u16* bbase(const Unit& u) const { return u.pn < 6 ? wuq + (size_t)u.pn * 256 * 256 : wukv + (size_t)(u.pn - 6) * 256 * 256; }
    __device__ __forceinline__ int arow(const Unit& u, int r) const { return u.pm * 256 + r; } };
struct EpiMlaUp8 { u16* Q; u16* Kn; long vdelta; float qscale;
    __device__ __forceinline__ void operator()(const f32x4 (&acc)[2][2][4][2], const Unit& u, int wr, int wc, int fr, int fq) const {
#pragma unroll
        for (int ai = 0; ai < 2; ++ai)
#pragma unroll
            for (int m = 0; m < 4; ++m) { int frr = fr; asm volatile("" : "+v"(frr));
                const int row = u.pm * 256 + ai * 128 + wr * 64 + m * 16 + frr; int b, pos; row_bp(row, b, pos); const bool lat = row >= NCTX; const int np = (row - NCTX) & (SEQ - 1);
                if (u.pn < 6) {
#pragma unroll
                    for (int bj = 0; bj < 2; ++bj) { const int sb = 8 * u.pn + 4 * bj + wc, head = sb / 3, part = sb - head * 3;
                        f32x4 v0 = acc[ai][bj][m][0] * qscale, v1 = acc[ai][bj][m][1] * qscale;
                        if (part == 2 && lat) {
#pragma unroll
                            for (int j = 0; j < 4; ++j) { float cs, sn; rope_cs<8>(np, 4 * fq + j, cs, sn); const float t1 = v0[j], t2 = v1[j]; v0[j] = t1 * cs - t2 * sn; v1[j] = t1 * sn + t2 * cs; } }
                        u16* o = Q + ((size_t)(b * 16 + head) * KEYS + pos) * 96 + part * 32 + 4 * fq;
                        u32x2 w0 = {cvtpk(v0[0], v0[1]), cvtpk(v0[2], v0[3])}, w1 = {cvtpk(v1[0], v1[1]), cvtpk(v1[2], v1[3])}; *(u32x2*)o = w0; *(u32x2*)(o + 16) = w1; }
                } else {
#pragma unroll
                    for (int bj = 0; bj < 2; ++bj) { const int head = (u.pn - 6) * 2 + bj; u16* o = Kn + (long)(wc >> 1) * vdelta + ((size_t)(b * 16 + head) * KEYS + pos) * 64 + (wc & 1) * 32 + 4 * fq;
#pragma unroll
                        for (int n = 0; n < 2; ++n) { const f32x4 a = acc[ai][bj][m][n]; u32x2 w = {cvtpk(a[0], a[1]), cvtpk(a[2], a[3])}; *(u32x2*)(o + 16 * n) = w; } }
                } }
    } };
}

template <int DK, int DV> struct AttnCfg {
    static constexpr int NKB = DK / 32, NVB = DV / 32, ND0 = DK / 16;
    static constexpr int KBYTES = 64 * DK * 2, VBYTES = 64 * DV * 2;
    static constexpr int LDS = 2 * KBYTES + 2 * VBYTES + NWAVE * 64 * 4;
};
constexpr float ATT_THR = 8.f;

__device__ __forceinline__ void partialSM(f32x16& p0, f32x16& p1, float& m_reg, float& mn, float& alpha) {
    float pmax = p0[0];
#pragma unroll
    for (int r = 1; r < 16; ++r) pmax = fmaxf(pmax, p0[r]);
#pragma unroll
    for (int r = 0; r < 16; ++r) pmax = fmaxf(pmax, p1[r]);
    { auto rr = __builtin_amdgcn_permlane32_swap(__float_as_uint(pmax), __float_as_uint(pmax), false, false);
      pmax = fmaxf(__uint_as_float(rr[0]), __uint_as_float(rr[1])); }
    if (__builtin_expect(__all(pmax - m_reg <= ATT_THR), 1)) { mn = m_reg; alpha = 1.f; }
    else { mn = fmaxf(m_reg, pmax); alpha = __builtin_amdgcn_exp2f(m_reg - mn); m_reg = mn; }
#pragma unroll
    for (int r = 0; r < 16; ++r) p0[r] = p0[r] - mn;
#pragma unroll
    for (int r = 0; r < 16; ++r) p1[r] = p1[r] - mn;
#pragma unroll
    for (int r = 0; r < 16; ++r) p0[r] = __builtin_amdgcn_exp2f(p0[r]);
}
#define PK4(P, BASE, OUT) do { unsigned a0 = cvtpk(P[BASE + 0], P[BASE + 1]), a1 = cvtpk(P[BASE + 2], P[BASE + 3]);   \
    unsigned b0 = cvtpk(P[BASE + 4], P[BASE + 5]), b1 = cvtpk(P[BASE + 6], P[BASE + 7]);                              \
    auto r0 = __builtin_amdgcn_permlane32_swap(a0, b0, false, false); auto r1 = __builtin_amdgcn_permlane32_swap(a1, b1, false, false); \
    u32x4 w = {r0[0], r1[0], r0[1], r1[1]}; OUT = *reinterpret_cast<bf16x8*>(&w); } while (0)
__device__ __forceinline__ void finishSM(f32x16& p0, f32x16& p1, float alpha, float& l_reg, bf16x8& pa0, bf16x8& pa1, bf16x8& pa2, bf16x8& pa3) {
#pragma unroll
    for (int r = 0; r < 16; ++r) p1[r] = __builtin_amdgcn_exp2f(p1[r]);
    float ps = 0;
#pragma unroll
    for (int r = 0; r < 16; ++r) ps += p0[r];
#pragma unroll
    for (int r = 0; r < 16; ++r) ps += p1[r];
    { auto rr = __builtin_amdgcn_permlane32_swap(__float_as_uint(ps), __float_as_uint(ps), false, false);
      ps = __uint_as_float(rr[0]) + __uint_as_float(rr[1]); }
    l_reg = l_reg * alpha + ps;
    PK4(p0, 0, pa0); PK4(p0, 8, pa1); PK4(p1, 0, pa2); PK4(p1, 8, pa3);
}
template <bool FIRST, bool KEEPN>
__device__ __forceinline__ void psm_rel(f32x16& p0, f32x16& p1, float& m_reg, f32x16& negm, float& alpha) {
    float pmax = fmaxf(p0[0], p1[0]);
#pragma unroll
    for (int r = 1; r < 16; ++r) pmax = fmaxf(pmax, fmaxf(p0[r], p1[r]));
    { auto rr = __builtin_amdgcn_permlane32_swap(__float_as_uint(pmax), __float_as_uint(pmax), false, false);
      pmax = fmaxf(__uint_as_float(rr[0]), __uint_as_float(rr[1])); }
    alpha = 1.f;
    if (FIRST || !__builtin_expect(__all(pmax <= ATT_THR), 1)) {
        const float d = FIRST ? pmax : fmaxf(pmax, 0.f);
        if (!FIRST) alpha = __builtin_amdgcn_exp2f(-d);
        m_reg += d;
#pragma unroll
        for (int r = 0; r < 16; ++r) { p0[r] -= d; p1[r] -= d; if (KEEPN) negm[r] = -m_reg; }
    }
#pragma unroll
    for (int r = 0; r < 16; ++r) p0[r] = __builtin_amdgcn_exp2f(p0[r]);
}
__device__ __forceinline__ bf16x8 pack8(const f32x16& p, int base) {
    u32x4 w = {cvtpk(p[base], p[base + 1]), cvtpk(p[base + 2], p[base + 3]), cvtpk(p[base + 4], p[base + 5]), cvtpk(p[base + 6], p[base + 7])};
    return *reinterpret_cast<bf16x8*>(&w);
}
__device__ __forceinline__ void fsm_rel(f32x16& p0, f32x16& p1, bf16x8& pa0, bf16x8& pa1, bf16x8& pa2, bf16x8& pa3) {
#pragma unroll
    for (int r = 0; r < 16; ++r) p1[r] = __builtin_amdgcn_exp2f(p1[r]);
    pa0 = pack8(p0, 0); pa1 = pack8(p0, 8); pa2 = pack8(p1, 0); pa3 = pack8(p1, 8);
}
__device__ __forceinline__ int k_lds_off(int row, int blk, int chunk) { return blk * 4096 + row * 64 + ((chunk ^ ((row >> 2) & 3)) << 4); }
template <int ND0>
__device__ __forceinline__ void qkt(f32x16& p0, f32x16& p1, const char* Ks, const bf16x8* qr, int r32, int hi, const f32x16& cinit) {
    p0 = cinit; p1 = cinit;
#pragma unroll
    for (int d0 = 0; d0 < ND0; ++d0) {
        const int ch = (d0 & 1) * 2 + hi;
        bf16x8 b0 = *reinterpret_cast<const bf16x8*>(Ks + k_lds_off(r32, d0 >> 1, ch));
        bf16x8 b1 = *reinterpret_cast<const bf16x8*>(Ks + k_lds_off(32 + r32, d0 >> 1, ch));
        p0 = __builtin_amdgcn_mfma_f32_32x32x16_bf16(b0, qr[d0], p0, 0, 0, 0);
        p1 = __builtin_amdgcn_mfma_f32_32x32x16_bf16(b1, qr[d0], p1, 0, 0, 0);
    }
}
template <int NVB, bool SWAP = true> __device__ __forceinline__ int v_st(int k, int c) {
    const int kk = SWAP ? ((k & ~0xC) | ((k & 4) << 1) | ((k & 8) >> 1)) : k;
    return ((kk >> 3) * NVB + (c >> 5)) * 512 + ((kk & 7) * 32 + (c & 31)) * 2;
}
__device__ __forceinline__ int v_rd_base(int lane) { return ((lane & 3) << 3) | (((lane >> 2) & 3) << 6) | (((lane >> 4) & 1) << 5) | (((lane >> 5) & 1) << 8); }
template <int OFF> __device__ __forceinline__ s16x4 tr_read(int vb) {
    s16x4 r; asm volatile("ds_read_b64_tr_b16 %0, %1 offset:%2" : "=&v"(r) : "v"(vb), "i"(OFF) : "memory"); return r;
}
#define PKV(L, H) (bf16x8){L[0], L[1], L[2], L[3], H[0], H[1], H[2], H[3]}
template <int D0, int NVB> __device__ __forceinline__ void pv_one(f32x16& od, int vb, bf16x8 pa0, bf16x8 pa1, bf16x8 pa2, bf16x8 pa3) {
    constexpr int KS = 2 * NVB * 512, HF = NVB * 512, B0 = D0 * 512;
    const s16x4 l0 = tr_read<B0 + 0 * KS>(vb), h0 = tr_read<B0 + 0 * KS + HF>(vb), l1 = tr_read<B0 + 1 * KS>(vb), h1 = tr_read<B0 + 1 * KS + HF>(vb);
    const s16x4 l2 = tr_read<B0 + 2 * KS>(vb), h2 = tr_read<B0 + 2 * KS + HF>(vb), l3 = tr_read<B0 + 3 * KS>(vb), h3 = tr_read<B0 + 3 * KS + HF>(vb);
    asm volatile("s_waitcnt lgkmcnt(0)" ::: "memory"); SBAR();
    od = __builtin_amdgcn_mfma_f32_32x32x16_bf16(pa0, PKV(l0, h0), od, 0, 0, 0);
    od = __builtin_amdgcn_mfma_f32_32x32x16_bf16(pa1, PKV(l1, h1), od, 0, 0, 0);
    od = __builtin_amdgcn_mfma_f32_32x32x16_bf16(pa2, PKV(l2, h2), od, 0, 0, 0);
    od = __builtin_amdgcn_mfma_f32_32x32x16_bf16(pa3, PKV(l3, h3), od, 0, 0, 0);
}
template <int NVB> __device__ __forceinline__ void pv_all(f32x16* o, int vb, bf16x8 pa0, bf16x8 pa1, bf16x8 pa2, bf16x8 pa3) {
    pv_one<0, NVB>(o[0], vb, pa0, pa1, pa2, pa3); pv_one<1, NVB>(o[1], vb, pa0, pa1, pa2, pa3);
    if constexpr (NVB == 4) { pv_one<2, NVB>(o[2], vb, pa0, pa1, pa2, pa3); pv_one<3, NVB>(o[3], vb, pa0, pa1, pa2, pa3); }
}

template <int DK, int DV>
__device__ __forceinline__ void attn_item(const u16* __restrict__ Qb, const u16* __restrict__ Ka, const u16* __restrict__ Kb, const u16* __restrict__ Vh,
                                          int nkeys, u16* __restrict__ Ob, long ldo, char* lds) {
    using C = AttnCfg<DK, DV>;
    constexpr int NVB = C::NVB, ND0 = C::ND0, NKI = (DK / 32) * 4, NVI = DV / 8, NI = NKI + NVI;
    static_assert(NI <= 24, "three LDS-DMA pieces per wave per tile");
    const int tid = threadIdx.x, wid = __builtin_amdgcn_readfirstlane(tid >> 6), lane = tid & 63, r32 = lane & 31, hi = lane >> 5;
    char* K_lds = lds; char* V_lds = lds + 3 * C::KBYTES;
    float* al_l = (float*)(lds + 3 * C::KBYTES + 3 * C::VBYTES) + wid * 32;
    float m_reg = 0.f; f32x16 o[NVB], ol, negm; bf16x8 qr[ND0];
#pragma unroll
    for (int d = 0; d < NVB; ++d) o[d] = f32x16{};
    ol = f32x16{}; negm = f32x16{};
    const u32x4 ones_w = {0x3F803F80u, 0x3F803F80u, 0x3F803F80u, 0x3F803F80u}; const bf16x8 ones = *reinterpret_cast<const bf16x8*>(&ones_w);
    const u16* Qw = Qb + (long)(wid * 32 + r32) * DK + hi * 8;
#pragma unroll
    for (int d0 = 0; d0 < ND0; ++d0) qr[d0] = *reinterpret_cast<const bf16x8*>(Qw + d0 * 16);
    const u16* src[3]; int dst[3], stp[3]; bool isk[3];
#pragma unroll
    for (int i = 0; i < 3; ++i) { int q = wid + 8 * i; if (q >= NI) q -= 8;
        if (q < NKI) { const int blk = q >> 2, part = q & 3, row = 16 * part + (lane >> 2), c = (lane & 3) ^ ((row >> 2) & 3);
            isk[i] = true; dst[i] = blk * 4096 + part * 1024 + lane * 16;
            if (DK == 96 && blk == 2) { src[i] = Kb + row * 32 + c * 8; stp[i] = 64 * 32; } else { src[i] = Ka + row * 64 + blk * 32 + c * 8; stp[i] = 64 * 64; } }
        else { const int v = q - NKI; int key, col;
            if (NVB == 2) { key = 8 * v + ((lane & 31) >> 2); col = (lane >> 5) * 32 + (lane & 3) * 8; }
            else { key = 8 * (v >> 1) + ((lane & 31) >> 2); col = ((v & 1) * 2 + (lane >> 5)) * 32 + (lane & 3) * 8; }
            isk[i] = false; dst[i] = 3 * C::KBYTES + v * 1024 + lane * 16; src[i] = Vh + key * DV + col; stp[i] = 64 * DV; } }
    const int NT = nkeys / 64;
#define LOADG(kt, vt) do { const int _kt = (kt) < NT ? (kt) : NT - 1, _vt = (vt) < NT ? (vt) : NT - 1; const int _ks = _kt % 3, _vs = _vt % 3; \
        _Pragma("unroll") for (int _i = 0; _i < 3; ++_i) { const int _t = isk[_i] ? _kt : _vt; const int _so = isk[_i] ? _ks * C::KBYTES : _vs * C::VBYTES; \
            __builtin_amdgcn_global_load_lds((const unsigned*)(src[_i] + (long)_t * stp[_i]), (unsigned*)(lds + _so + dst[_i]), 16, 0, 0); } } while (0)
#define RESC(a) do { if (__any((a) < 1.f)) { if (hi == 0) al_l[r32] = (a); asm volatile("s_waitcnt lgkmcnt(0)" ::: "memory"); \
        _Pragma("unroll") for (int r = 0; r < 16; ++r) { const float _f = al_l[crow(r, hi)]; ol[r] *= _f; _Pragma("unroll") for (int d = 0; d < NVB; ++d) o[d][r] *= _f; } } } while (0)
#define PVL(vb) do { pv_all<NVB>(o, (vb), pa0, pa1, pa2, pa3); \
        ol = __builtin_amdgcn_mfma_f32_32x32x16_bf16(pa0, ones, ol, 0, 0, 0); ol = __builtin_amdgcn_mfma_f32_32x32x16_bf16(pa1, ones, ol, 0, 0, 0); \
        ol = __builtin_amdgcn_mfma_f32_32x32x16_bf16(pa2, ones, ol, 0, 0, 0); ol = __builtin_amdgcn_mfma_f32_32x32x16_bf16(pa3, ones, ol, 0, 0, 0); } while (0)
#define NEGM() do { if constexpr (DV == 128) { _Pragma("unroll") for (int r = 0; r < 16; ++r) negm[r] = -m_reg; } } while (0)
#define TILEBAR(n) do { if ((n) == 3) asm volatile("s_waitcnt vmcnt(3)" ::: "memory"); else asm volatile("s_waitcnt vmcnt(0)" ::: "memory"); __builtin_amdgcn_s_barrier(); asm volatile("" ::: "memory"); } while (0)
    const int vrb = (int)(uintptr_t)V_lds + v_rd_base(lane);
    f32x16 pA0, pA1, pB0, pB1; float alA, alB; bf16x8 pa0, pa1, pa2, pa3;
    __syncthreads();
    LOADG(0, 0); LOADG(1, 0);
    TILEBAR(3); LOADG(2, 1);
    qkt<ND0>(pA0, pA1, K_lds, qr, r32, hi, negm); psm_rel<true, DV != 128>(pA0, pA1, m_reg, negm, alA);
    int ks = 1, vs = 0;
    for (int j = 1; j + 1 < NT; j += 2) {
        TILEBAR(3); LOADG(j + 2, j + 1);
        SBAR(); NEGM(); qkt<ND0>(pB0, pB1, K_lds + ks * C::KBYTES, qr, r32, hi, negm);
        fsm_rel(pA0, pA1, pa0, pa1, pa2, pa3);
        PVL(vrb + vs * C::VBYTES); psm_rel<false, DV != 128>(pB0, pB1, m_reg, negm, alB);
        RESC(alB);
        ks = ks == 2 ? 0 : ks + 1; vs = vs == 2 ? 0 : vs + 1;
        TILEBAR(3); LOADG(j + 3, j + 2);
        SBAR(); NEGM(); qkt<ND0>(pA0, pA1, K_lds + ks * C::KBYTES, qr, r32, hi, negm);
        fsm_rel(pB0, pB1, pa0, pa1, pa2, pa3);
        PVL(vrb + vs * C::VBYTES); psm_rel<false, DV != 128>(pA0, pA1, m_reg, negm, alA);
        RESC(alA);
        ks = ks == 2 ? 0 : ks + 1; vs = vs == 2 ? 0 : vs + 1;
    }
    TILEBAR(3);
    SBAR(); NEGM(); qkt<ND0>(pB0, pB1, K_lds + ks * C::KBYTES, qr, r32, hi, negm);
    fsm_rel(pA0, pA1, pa0, pa1, pa2, pa3); SBAR();
    PVL(vrb + vs * C::VBYTES); psm_rel<false, DV != 128>(pB0, pB1, m_reg, negm, alB);
    RESC(alB);
    vs = vs == 2 ? 0 : vs + 1;
    TILEBAR(0);
    fsm_rel(pB0, pB1, pa0, pa1, pa2, pa3); SBAR();
    PVL(vrb + vs * C::VBYTES);
    u16* Ow = Ob + (long)(wid * 32) * ldo;
#pragma unroll
    for (int r = 0; r < 16; ++r) { const int orow = crow(r, hi); const float rl = __builtin_amdgcn_rcpf(ol[r]);
#pragma unroll
        for (int d0 = 0; d0 < NVB; ++d0) Ow[(long)orow * ldo + d0 * 32 + r32] = f2bf(o[d0][r] * rl); }
#undef LOADG
#undef RESC
#undef PVL
#undef NEGM
#undef TILEBAR
}

struct Frame {
    const Params* p; unsigned char* ws; char* lds; float* out; int G, bx;
    __device__ __forceinline__ const float* in(int i) const { return p->in[i]; }
    template <class T> __device__ __forceinline__ T* W(size_t off) const { return (T*)(ws + off); }
};
constexpr int LDS_BYTES = 163840;
constexpr int LDS_BARW  = LDS_BYTES - 16;
constexpr int LDS_TAB   = 147456;

struct ResCtx { const char* src0; long srcd; char* dst0; long dstd; const float* mods;
    __device__ __forceinline__ const float* row_in(int row, int) const { return (const float*)(src0 + (row >= NCTX ? srcd : 0L) + (long)row * (DM * 4)); }
    __device__ __forceinline__ float* row_out(int row) const { return (float*)(dst0 + (row >= NCTX ? dstd : 0L) + (long)row * (DM * 4)); }
    __device__ __forceinline__ const float* mod(int li, int row, int which) const {
        const int mr = row < NCTX ? 4 : ((row - NCTX) >> 13); return mods + (size_t)(li * 5 + mr) * 6144 + which * 1024; }
};
__device__ __forceinline__ ResCtx res_ctx(const Frame& F, bool first = false) {
    const char* sc = (const char*)(first ? F.in(2) : (const float*)F.W<float>(WS_XC)); const char* sl = (const char*)(first ? F.in(0) : (const float*)F.out) - (long)NCTX * DM * 4;
    char* dc = (char*)F.W<float>(WS_XC); char* dl = (char*)F.out - (long)NCTX * DM * 4;
    return ResCtx{sc, (long)(sl - sc), dc, (long)(dl - dc), F.W<float>(WS_MODS)};
}
__device__ __forceinline__ const float* xrow_in(const Frame& F, int row, bool first) { return res_ctx(F, first).row_in(row, 0); }
__device__ __forceinline__ float* xrow_out(const Frame& F, int row) { return res_ctx(F).row_out(row); }
__device__ __forceinline__ const float* mod_vec(const Frame& F, int li, int row, int which) { return res_ctx(F).mod(li, row, which); }

struct EpiResid8 { ResCtx F; int li;
    __device__ __forceinline__ void operator()(const f32x4 (&acc)[2][2][4][2], const pg8::Unit& u, int wr, int wc, int fr, int fq) const {
#pragma unroll
        for (int ai = 0; ai < 2; ++ai)
#pragma unroll
            for (int m = 0; m < 4; ++m) { int frr = fr; asm volatile("" : "+v"(frr));
                const int row = u.pm * 256 + ai * 128 + wr * 64 + m * 16 + frr, c0 = u.pn * 256 + wc * 32 + 4 * fq;
                const float* xi = F.row_in(row, 0) + c0; float* xo = F.row_out(row) + c0; const float* gt = F.mod(li, row, 2) + c0;
#pragma unroll
                for (int bj = 0; bj < 2; ++bj)
#pragma unroll
                    for (int n = 0; n < 2; ++n) { const int c = bj * 128 + n * 16; const f32x4 x = *(const f32x4*)(xi + c), g = *(const f32x4*)(gt + c), a = acc[ai][bj][m][n];
                        f32x4 o = {x[0] + g[0] * a[0], x[1] + g[1] * a[1], x[2] + g[2] * a[2], x[3] + g[3] * a[3]}; *(f32x4*)(xo + c) = o; } }
    } };

__device__ __forceinline__ void p0_mods(const Frame& F) {
    float* s = (float*)F.lds; float* red = s + 5 * 1024;
    const int tid = threadIdx.x, lane = tid & 63, wid = tid >> 6;
    for (int i = tid; i < 5 * 1024; i += NTHR) { const int r = i >> 10, k = i & 1023; const float v = r < 4 ? F.in(1)[r * 1024 + k] : F.in(3)[k]; s[i] = silu_f(v); }
    __syncthreads();
    for (int item = F.bx; item < DEPTH * 96; item += F.G) {
        const int li = item / 96, cg = item % 96;
        const float* w = F.in(4) + (size_t)li * 1024 * 6144 + cg * 64 + lane;
        float a0 = 0, a1 = 0, a2 = 0, a3 = 0, a4 = 0;
        const int k0 = wid * 128;
#pragma unroll 8
        for (int k = k0; k < k0 + 128; ++k) {
            const float wv = w[(size_t)k * 6144];
            a0 += s[k] * wv; a1 += s[1024 + k] * wv; a2 += s[2048 + k] * wv; a3 += s[3072 + k] * wv; a4 += s[4096 + k] * wv;
        }
        red[(wid * 5 + 0) * 64 + lane] = a0; red[(wid * 5 + 1) * 64 + lane] = a1; red[(wid * 5 + 2) * 64 + lane] = a2;
        red[(wid * 5 + 3) * 64 + lane] = a3; red[(wid * 5 + 4) * 64 + lane] = a4;
        __syncthreads();
        if (tid < 320) { const int r = tid >> 6, l = tid & 63; float sum = 0;
#pragma unroll
            for (int ww = 0; ww < 8; ++ww) sum += red[(ww * 5 + r) * 64 + l];
            F.W<float>(WS_MODS)[(size_t)(li * 5 + r) * 6144 + cg * 64 + l] = sum + F.in(5)[li * 6144 + cg * 64 + l]; }
        __syncthreads();
    }
}
__device__ __forceinline__ void p0_rope(const Frame& F) {
    const int gt = F.bx * NTHR + threadIdx.x, gn = F.G * NTHR;
    float* ca = F.W<float>(WS_ROPEA); float* sa = ca + SEQ * 16; float* cb = F.W<float>(WS_ROPEB); float* sb = cb + SEQ * 32;
    for (int i = gt; i < SEQ * 48; i += gn) {
        int n, f, nf; float* co; float* so; int idx;
        if (i < SEQ * 16) { n = i >> 4; f = i & 15; nf = 8; co = ca; so = sa; idx = i; }
        else { const int j = i - SEQ * 16; n = j >> 5; f = j & 31; nf = 16; co = cb; so = sb; idx = j; }
        const int fi = f % nf; const float pos = (f < nf) ? (float)(n >> 6) : (float)(n & 63);
        const float invf = exp2f(-(float)fi / (float)nf * 13.287712379549449f);
        const float ang = pos * invf;
        float rev = ang * 0.15915494309189535f; rev -= floorf(rev);
        co[idx] = __builtin_amdgcn_cosf(rev); so[idx] = __builtin_amdgcn_sinf(rev);
    }
}
__device__ __forceinline__ int rowmap(int n, int kind) {
    if (kind == 0) return n;
    if (kind == 3) { if (n >= 2048) return n; const int hh = n >> 6, dim = n & 63; return (hh >> 2) * 256 + (dim >> 5) * 128 + (hh & 3) * 32 + (dim & 31); }
    return (n >> 7) * 256 + (kind == 2 ? 128 : 0) + (n & 127);
}
__device__ __forceinline__ void cvt_group(float* tl, const float* src, int K, int N, u16* dst, int ldd, int kind, int t0) {
    int tid = threadIdx.x; asm volatile("" : "+v"(tid));
    const int tn = (N + 63) / 64, nt = (K / 64) * tn;
    f32x4 v[4][2];
#pragma unroll
    for (int u = 0; u < 4; ++u) { const int t = t0 + u; const int k0 = (t / tn) * 64, n0 = (t % tn) * 64;
#pragma unroll
        for (int ps = 0; ps < 2; ++ps) { const int k = (tid >> 4) + ps * 32, n4 = (tid & 15) * 4;
            if (t < nt && n0 + n4 < N) v[u][ps] = *(const f32x4*)(src + (size_t)(k0 + k) * N + n0 + n4); else v[u][ps] = f32x4{0.f, 0.f, 0.f, 0.f}; } }
#pragma unroll
    for (int u = 0; u < 4; ++u)
#pragma unroll
        for (int ps = 0; ps < 2; ++ps) { const int k = (tid >> 4) + ps * 32, n4 = (tid & 15) * 4; float* d = tl + u * 4160 + k * 65 + n4;
            d[0] = v[u][ps][0]; d[1] = v[u][ps][1]; d[2] = v[u][ps][2]; d[3] = v[u][ps][3]; }
    __syncthreads();
#pragma unroll
    for (int u = 0; u < 4; ++u) { const int t = t0 + u; const int k0 = (t / tn) * 64, n0 = (t % tn) * 64;
        const int n = tid >> 3, kc = (tid & 7) * 8; const float* sr = tl + u * 4160;
        if (t < nt && n0 + n < N) { u32x4 w;
#pragma unroll
            for (int i = 0; i < 4; ++i) w[i] = cvtpk(sr[(kc + 2 * i) * 65 + n], sr[(kc + 2 * i + 1) * 65 + n]);
            *(u32x4*)(dst + (size_t)rowmap(n0 + n, kind) * ldd + k0 + kc) = w; } }
    __syncthreads();
}
__device__ __forceinline__ void cvt_t(const Frame& F, const float* src, int K, int N, u16* dst, int ldd, int kind, int rot) {
    const int tn = (N + 63) / 64, nt = (K / 64) * tn;
    for (int t0 = ((F.bx + rot) % F.G) * 4; t0 < nt; t0 += F.G * 4) cvt_group((float*)F.lds, src, K, N, dst, ldd, kind, t0);
}
constexpr int MOE_CVT_GROUPS = 16 * 3 * 32, LDS_CVT = 81920;
__device__ __forceinline__ void moe_cvt_group(const Frame& F, int li, int gidx) {
    if (gidx >= MOE_CVT_GROUPS) return;
    const int mat = gidx >> 5, g = gidx & 31, e = mat / 3, kind = mat - e * 3; float* tl = (float*)(F.lds + LDS_CVT);
    if (kind == 0) cvt_group(tl, F.in(27) + (size_t)(li * 16 + e) * 1024 * 512, 1024, 512, F.W<u16>(WS_MOEW) + (size_t)e * 1024 * 1024, 1024, 1, g * 4);
    else if (kind == 1) cvt_group(tl, F.in(28) + (size_t)(li * 16 + e) * 1024 * 512, 1024, 512, F.W<u16>(WS_MOEW) + (size_t)e * 1024 * 1024, 1024, 2, g * 4);
    else cvt_group(tl, F.in(29) + (size_t)(li * 16 + e) * 512 * 1024, 512, 1024, F.W<u16>(WS_MOEW + MOE_WGU_BYTES) + (size_t)e * 1024 * 512, 512, 0, g * 4);
}
__device__ __forceinline__ void p0_weights(const Frame& F) {
    int rot = 0;
    for (int j = 0; j < 2; ++j) {
        cvt_t(F, F.in(8) + (size_t)j * 1024 * 544, 1024, 544, F.W<u16>(WS_WDQKV) + (size_t)j * 640 * 1024, 1024, 0, rot); rot += 36;
        cvt_t(F, F.in(10) + (size_t)j * 256 * 1536, 256, 1536, F.W<u16>(WS_WUQ) + (size_t)j * 1536 * 256, 256, 0, rot); rot += 24;
        cvt_t(F, F.in(12) + (size_t)j * 256 * 2048, 256, 2048, F.W<u16>(WS_WUKV) + (size_t)j * 2048 * 256, 256, 0, rot); rot += 32;
        cvt_t(F, F.in(13) + (size_t)j * 1024 * 1024, 1024, 1024, F.W<u16>(WS_WOM) + (size_t)j * 1024 * 1024, 1024, 0, rot);
    }
    cvt_t(F, F.in(14), 1024, 3072, F.W<u16>(WS_WQKVD), 1024, 3, rot);
    cvt_t(F, F.in(17), 1024, 1024, F.W<u16>(WS_WOD), 1024, 0, rot);
    cvt_t(F, F.in(18), 1024, 3104, F.W<u16>(WS_WING), 1024, 0, rot); rot += 4;
    cvt_t(F, F.in(22), 1024, 1024, F.W<u16>(WS_WOG), 1024, 0, rot);
}
__device__ __forceinline__ void moe_weights(const Frame& F, int li) {
    for (int g = F.bx; g < MOE_CVT_GROUPS; g += F.G) moe_cvt_group(F, li, g);
}

#define DPP_ADD(v, CTRL) (v) += __uint_as_float(__builtin_amdgcn_update_dpp(0u, __float_as_uint(v), (CTRL), 0xF, 0xF, false))
__device__ __forceinline__ float wave_sum_fast(float v) {
    DPP_ADD(v, 0xB1); DPP_ADD(v, 0x4E); DPP_ADD(v, 0x141); DPP_ADD(v, 0x140);
    { auto rr = __builtin_amdgcn_permlane16_swap(__float_as_uint(v), __float_as_uint(v), false, false); v = __uint_as_float(rr[0]) + __uint_as_float(rr[1]); }
    { auto rr = __builtin_amdgcn_permlane32_swap(__float_as_uint(v), __float_as_uint(v), false, false); v = __uint_as_float(rr[0]) + __uint_as_float(rr[1]); }
    return v;
}
constexpr int RT_WG = 0, RT_WR = 16384, RT_REC = 81920, RT_CNT = 81920 + 4096, RT_BASE = RT_CNT + 128;
template <bool ROUTE>
__device__ __forceinline__ void norm_phase(const Frame& F, int li, int row_begin, bool first) {
    const int tid = threadIdx.x, lane = tid & 63, wid = tid >> 6;
    const float* gain = F.in(ROUTE ? 7 : 6) + li * DM;
    u16* H = F.W<u16>(WS_H);
    const int per_block = (NTOK - row_begin + F.G - 1) / F.G;
    const int blk0 = row_begin + F.bx * per_block; int blk1 = blk0 + per_block; if (blk1 > NTOK) blk1 = NTOK;
    f32x4* wgL = (f32x4*)(F.lds + RT_WG); f32x4* wrL = (f32x4*)(F.lds + RT_WR); u32x4* recL = (u32x4*)(F.lds + RT_REC);
    unsigned* cntL = (unsigned*)(F.lds + RT_CNT); unsigned* baseL = (unsigned*)(F.lds + RT_BASE);
    if constexpr (ROUTE) {
        __syncthreads();
        const f32x4* wg = (const f32x4*)(F.in(23) + (size_t)li * DM * 4); const f32x4* wr = (const f32x4*)(F.in(25) + (size_t)li * 4 * DM * 4);
        for (int e = tid; e < 1024; e += NTHR) { const int d = ((e >> 8) * 4 + (e & 3)) * 64 + ((e >> 2) & 63); wgL[d] = wg[e]; }
        for (int e = tid; e < 4096; e += NTHR) { const int g = e >> 10, c = e & 1023; const int d = g * 1024 + ((c >> 8) * 4 + (c & 3)) * 64 + ((c >> 2) & 63); wrL[d] = wr[e]; }
        if (tid < 32) cntL[tid] = 0u;
        __syncthreads();
    }
    for (int it = 0; it * 32 < per_block; ++it) {
        int rows[4]; bool ok[4]; f32x4 v[4][4];
#pragma unroll
        for (int u = 0; u < 4; ++u) { rows[u] = blk0 + wid + 8 * (4 * it + u); ok[u] = rows[u] < blk1; if (!ok[u]) rows[u] = blk0; }
#pragma unroll
        for (int u = 0; u < 4; ++u) { const float* xr = xrow_in(F, rows[u], first);
#pragma unroll
            for (int i = 0; i < 4; ++i) v[u][i] = *(const f32x4*)(xr + i * 256 + lane * 4); }
#pragma unroll
        for (int u = 0; u < 4; ++u) {
            const int row = rows[u];
            float ss = 0;
#pragma unroll
            for (int i = 0; i < 4; ++i) ss += v[u][i][0] * v[u][i][0] + v[u][i][1] * v[u][i][1] + v[u][i][2] * v[u][i][2] + v[u][i][3] * v[u][i][3];
            ss = wave_sum_fast(ss);
            const float rinv = rsqrtf(ss * (1.f / DM) + EPS);
            const float* sh = mod_vec(F, li, row, ROUTE ? 3 : 0); const float* sc = mod_vec(F, li, row, ROUTE ? 4 : 1);
            float hv[16];
#pragma unroll
            for (int i = 0; i < 4; ++i) { const int c = i * 256 + lane * 4;
                const f32x4 g = *(const f32x4*)(gain + c), s1 = *(const f32x4*)(sc + c), s0 = *(const f32x4*)(sh + c);
#pragma unroll
                for (int j = 0; j < 4; ++j) hv[i * 4 + j] = (v[u][i][j] * rinv * g[j]) * (1.f + s1[j]) + s0[j];
                if (ok[u]) { u32x2 w = {cvtpk(hv[i * 4], hv[i * 4 + 1]), cvtpk(hv[i * 4 + 2], hv[i * 4 + 3])}; *(u32x2*)(H + (size_t)row * DM + c) = w; } }
            if constexpr (ROUTE) {
                float gl[4] = {0, 0, 0, 0};
#pragma unroll
                for (int q = 0; q < 16; ++q) { const f32x4 w4 = wgL[q * 64 + lane]; const float h = hv[q];
                    gl[0] += h * w4[0]; gl[1] += h * w4[1]; gl[2] += h * w4[2]; gl[3] += h * w4[3]; }
#pragma unroll
                for (int g = 0; g < 4; ++g) gl[g] = wave_sum_fast(gl[g]) + F.in(24)[li * 4 + g];
                int gi = 0; float gm = gl[0];
#pragma unroll
                for (int g = 1; g < 4; ++g) if (gl[g] > gm) { gm = gl[g]; gi = g; }
                gi = __builtin_amdgcn_readfirstlane(gi);
                float den = 0;
#pragma unroll
                for (int g = 0; g < 4; ++g) den += __expf(gl[g] - gm);
                const float grp_w = 1.f / den;
                float el[4] = {0, 0, 0, 0};
                const f32x4* wrg = wrL + gi * 1024;
#pragma unroll
                for (int q = 0; q < 16; ++q) { const f32x4 w4 = wrg[q * 64 + lane]; const float h = hv[q];
                    el[0] += h * w4[0]; el[1] += h * w4[1]; el[2] += h * w4[2]; el[3] += h * w4[3]; }
#pragma unroll
                for (int e = 0; e < 4; ++e) el[e] = wave_sum_fast(el[e]) + F.in(26)[(li * 4 + gi) * 4 + e];
                int i1 = 0; float v1 = el[0];
#pragma unroll
                for (int e = 1; e < 4; ++e) if (el[e] > v1) { v1 = el[e]; i1 = e; }
                int i2 = -1; float v2 = -3.0e38f;
#pragma unroll
                for (int e = 0; e < 4; ++e) if (e != i1 && el[e] > v2) { v2 = el[e]; i2 = e; }
                const float t = __expf(v2 - v1); const float w1 = grp_w / (1.f + t), w2 = grp_w * t / (1.f + t);
                const int elo = i1 < i2 ? i1 : i2, ehi = i1 < i2 ? i2 : i1;
                const float wlo = i1 < i2 ? w1 : w2, whi = i1 < i2 ? w2 : w1;
                const int pr = elo == 0 ? ehi - 1 : (elo == 1 ? ehi + 1 : 5);
                const int cls = gi * 6 + pr;
                if (lane == 0 && ok[u]) {
                    const unsigned rank = atomicAdd(&cntL[cls], 1u);
                    u32x4 rec = {(unsigned)cls, rank, __float_as_uint(wlo), __float_as_uint(whi)};
                    recL[row - blk0] = rec;
                }
            }
        }
    }
    if constexpr (ROUTE) {
        __syncthreads();
        if (tid < 24) baseL[tid] = atomicAdd(F.W<unsigned>(WS_CTL) + CW_CNT + li * 32 + tid, cntL[tid]);
        __syncthreads();
        for (int t = tid; t < blk1 - blk0; t += NTHR) { u32x4 rec = recL[t]; rec[1] += baseL[rec[0]];
            *(u32x4*)(F.W<unsigned char>(WS_TOK) + (size_t)(blk0 + t) * 16) = rec; }
    }
}

__device__ __forceinline__ void moe_table(const Frame& F, int li, int* tab) {
    if (threadIdx.x == 0) {
        const unsigned* cnt = F.W<unsigned>(WS_CTL) + CW_CNT + li * 32; int off = 0;
        for (int c = 0; c < 24; ++c) { tab[c] = off; const int n = (int)cnt[c]; const int nt = (n + 255) >> 8;
            for (int t = 0; t < nt; ++t) tab[32 + (off >> 8) + t] = c; off += nt << 8; }
        tab[24] = off;
    }
    __syncthreads();
}
__device__ __forceinline__ void moe_scatter(const Frame& F, int li, int row_begin) {
    int* tab = (int*)(F.lds + LDS_TAB);
    moe_table(F, li, tab);
    const unsigned* cnt = F.W<unsigned>(WS_CTL) + CW_CNT + li * 32;
    int* rowtok = F.W<int>(WS_ROWTOK); float* roww = F.W<float>(WS_ROWW);
    const int gt = F.bx * NTHR + threadIdx.x, gn = F.G * NTHR;
    for (int t = row_begin + gt; t < NTOK; t += gn) {
        const u32x4 rec = *(const u32x4*)(F.W<unsigned char>(WS_TOK) + (size_t)t * 16);
        const int r = tab[rec[0]] + (int)rec[1];
        rowtok[r] = t; roww[2 * r] = __uint_as_float(rec[2]); roww[2 * r + 1] = __uint_as_float(rec[3]);
    }
    for (int i = gt; i < 24 * 256; i += gn) { const int c = i >> 8, j = i & 255; const int r = tab[c] + (int)cnt[c] + j;
        const int end = tab[c] + ((((int)cnt[c]) + 255) & ~255);
        if (r < end) { rowtok[r] = -1; roww[2 * r] = 0.f; roww[2 * r + 1] = 0.f; } }
    __syncthreads();
}

#define EPI_ID const int r32 = lane & 31, hi = lane >> 5
__device__ __forceinline__ u32x2 pack4(float a, float b, float c, float d) { u32x2 w = {cvtpk(a, b), cvtpk(c, d)}; return w; }
struct EpiF32 { float* dst; int ld, ncols;
    __device__ __forceinline__ int operator()(f32x16 (&acc)[2][2], int row0, int col0, int lane) const { EPI_ID;
#pragma unroll
        for (int mi = 0; mi < 2; ++mi) { float* o = dst + (size_t)(row0 + mi * 32 + r32) * ld + col0 + 4 * hi;
#pragma unroll
            for (int ni = 0; ni < 2; ++ni) if (col0 + ni * 32 < ncols) {
#pragma unroll
                for (int g = 0; g < 4; ++g) { f32x4 v = {acc[mi][ni][4 * g], acc[mi][ni][4 * g + 1], acc[mi][ni][4 * g + 2], acc[mi][ni][4 * g + 3]}; *(f32x4*)(o + ni * 32 + 8 * g) = v; } } }
        return 0;
    } };
struct EpiMlaQ { u16* Q; const float* cosA; const float* sinA; float scale;
    __device__ __forceinline__ int operator()(f32x16 (&acc)[2][2], int row0, int col0, int lane) const { EPI_ID; const bool lat = row0 >= NCTX;
#pragma unroll
        for (int mi = 0; mi < 2; ++mi) { const int row = row0 + mi * 32 + r32; int b, pos; row_bp(row, b, pos); const int n = (row - NCTX) & (SEQ - 1);
            u16* qrow = Q + ((size_t)(b * 16) * KEYS + pos) * 96 + 4 * hi;
#pragma unroll
            for (int ni = 0; ni < 2; ++ni) { const int s = (col0 >> 5) + ni, head = s / 3, part = s - head * 3; u16* o = qrow + (size_t)head * KEYS * 96 + part * 32;
                float v[16];
#pragma unroll
                for (int r = 0; r < 16; ++r) v[r] = acc[mi][ni][r] * scale;
                if (part == 2 && lat) {
#pragma unroll
                    for (int g = 0; g < 2; ++g) {
#pragma unroll
                        for (int j = 0; j < 4; ++j) { float cs, sn; rope_cs<8>(n, 8 * g + 4 * hi + j, cs, sn);
                            const float t1 = v[4 * g + j], t2 = v[4 * (g + 2) + j]; v[4 * g + j] = t1 * cs - t2 * sn; v[4 * (g + 2) + j] = t1 * sn + t2 * cs; } } }
#pragma unroll
                for (int g = 0; g < 4; ++g) *(u32x2*)(o + 8 * g) = pack4(v[4 * g], v[4 * g + 1], v[4 * g + 2], v[4 * g + 3]); } }
        return 16;
    } };
struct EpiMlaKV { u16* Kn; long vdelta;
    __device__ __forceinline__ int operator()(f32x16 (&acc)[2][2], int row0, int col0, int lane) const { EPI_ID; const int head = col0 >> 7; u16* dst = Kn + (long)((col0 >> 6) & 1) * vdelta;
#pragma unroll
        for (int mi = 0; mi < 2; ++mi) { const int row = row0 + mi * 32 + r32; int b, pos; row_bp(row, b, pos);
            u16* o = dst + ((size_t)(b * 16 + head) * KEYS + pos) * 64 + 4 * hi;
#pragma unroll
            for (int ni = 0; ni < 2; ++ni)
#pragma unroll
                for (int g = 0; g < 4; ++g) *(u32x2*)(o + ni * 32 + 8 * g) = pack4(acc[mi][ni][4 * g], acc[mi][ni][4 * g + 1], acc[mi][ni][4 * g + 2], acc[mi][ni][4 * g + 3]); }
        return 16;
    } };
struct EpiResid { ResCtx F; int li, which, first;
    __device__ __forceinline__ int operator()(f32x16 (&acc)[2][2], int row0, int col0, int lane) const { EPI_ID;
#pragma unroll
        for (int mi = 0; mi < 2; ++mi) { const int row = row0 + mi * 32 + r32;
            const float* xi = F.row_in(row, first) + col0 + 4 * hi; float* xo = F.row_out(row) + col0 + 4 * hi; const float* gt = F.mod(li, row, which) + col0 + 4 * hi;
#pragma unroll
            for (int ni = 0; ni < 2; ++ni)
#pragma unroll
                for (int g = 0; g < 4; ++g) { const int c = ni * 32 + 8 * g; const f32x4 x = *(const f32x4*)(xi + c), gg = *(const f32x4*)(gt + c);
                    f32x4 o = {x[0] + gg[0] * acc[mi][ni][4 * g], x[1] + gg[1] * acc[mi][ni][4 * g + 1], x[2] + gg[2] * acc[mi][ni][4 * g + 2], x[3] + gg[3] * acc[mi][ni][4 * g + 3]};
                    *(f32x4*)(xo + c) = o; } }
        return 48;
    } };
struct EpiMoeB { ResCtx F; int li; const int* rowtok;
    __device__ __forceinline__ int operator()(f32x16 (&acc)[2][2], int row0, int col0, int lane) const { EPI_ID;
#pragma unroll
        for (int mi = 0; mi < 2; ++mi) { const int tok = rowtok[row0 + mi * 32 + r32];
            if (tok >= 0) { float* xo = F.row_out(tok) + col0 + 4 * hi; const float* gt = F.mod(li, tok, 5) + col0 + 4 * hi;
#pragma unroll
                for (int ni = 0; ni < 2; ++ni)
#pragma unroll
                    for (int g = 0; g < 4; ++g) { const int c = ni * 32 + 8 * g; const f32x4 x = *(const f32x4*)(xo + c), gg = *(const f32x4*)(gt + c);
                        f32x4 o = {x[0] + gg[0] * acc[mi][ni][4 * g], x[1] + gg[1] * acc[mi][ni][4 * g + 1], x[2] + gg[2] * acc[mi][ni][4 * g + 2], x[3] + gg[3] * acc[mi][ni][4 * g + 3]};
                        *(f32x4*)(xo + c) = o; } } }
        return 0;
    } };
struct EpiMoeA { u16* act; const float* roww; int half, acol0;
    __device__ __forceinline__ int operator()(f32x16 (&acc)[2][2], int row0, int col0, int lane) const { EPI_ID;
#pragma unroll
        for (int mi = 0; mi < 2; ++mi) { const int row = row0 + mi * 32 + r32; const float w = roww[2 * row + half];
            u16* o = act + (size_t)row * 1024 + acol0 + (col0 >> 6) * 32 + 4 * hi;
#pragma unroll
            for (int g = 0; g < 4; ++g) { float v[4];
#pragma unroll
                for (int j = 0; j < 4; ++j) v[j] = silu_f(acc[mi][0][4 * g + j]) * acc[mi][1][4 * g + j] * w;
                *(u32x2*)(o + 8 * g) = pack4(v[0], v[1], v[2], v[3]); } }
        return 8;
    } };
struct EpiDiffQKV { u16* Q; long kdelta; u16* V; const float* cosB; const float* sinB; float qscale;
    __device__ __forceinline__ int operator()(f32x16 (&acc)[2][2], int row0, int col0, int lane) const { EPI_ID; const int region = col0 >> 10; const bool lat = row0 >= NCTX;
#pragma unroll
        for (int mi = 0; mi < 2; ++mi) { const int row = row0 + mi * 32 + r32; int b, pos; row_bp(row, b, pos); const int n = (row - NCTX) & (SEQ - 1);
            if (region < 2) {
                const int hh = (col0 & 1023) >> 6; const float sc = region == 0 ? qscale : 1.f;
                u16* o = Q + (long)region * kdelta + ((size_t)(b * 16 + hh) * KEYS + pos) * 64 + 4 * hi;
#pragma unroll
                for (int g = 0; g < 4; ++g) {
                    float o1[4], o2[4];
#pragma unroll
                    for (int j = 0; j < 4; ++j) { float cs = 1.f, sn = 0.f; if (lat) rope_cs<16>(n, 8 * g + 4 * hi + j, cs, sn);
                        const float t1 = acc[mi][0][4 * g + j], t2 = acc[mi][1][4 * g + j]; o1[j] = (t1 * cs - t2 * sn) * sc; o2[j] = (t1 * sn + t2 * cs) * sc; }
                    *(u32x2*)(o + 8 * g) = pack4(o1[0], o1[1], o1[2], o1[3]); *(u32x2*)(o + 32 + 8 * g) = pack4(o2[0], o2[1], o2[2], o2[3]); }
            } else {
                const int cv = col0 - 2048, head = cv >> 7;
                u16* o = V + ((size_t)(b * 8 + head) * KEYS + pos) * 128 + (cv & 127) + 4 * hi;
#pragma unroll
                for (int ni = 0; ni < 2; ++ni)
#pragma unroll
                    for (int g = 0; g < 4; ++g) *(u32x2*)(o + ni * 32 + 8 * g) = pack4(acc[mi][ni][4 * g], acc[mi][ni][4 * g + 1], acc[mi][ni][4 * g + 2], acc[mi][ni][4 * g + 3]);
            } }
        return 16;
    } };
struct EpiGlaIn { u16* q; u16* k; u16* v; u16* g; float* z;
    __device__ __forceinline__ int operator()(f32x16 (&acc)[2][2], int row0, int col0, int lane) const { EPI_ID;
#pragma unroll
        for (int mi = 0; mi < 2; ++mi) { const size_t row = row0 + mi * 32 + r32;
            if (col0 < 3072) {
                u16* o; float sc = 1.f;
                if (col0 < 512) { o = q + row * 512 + col0; sc = 0.08838834764831845f; } else if (col0 < 1024) o = k + row * 512 + (col0 - 512);
                else if (col0 < 2048) o = v + row * 1024 + (col0 - 1024); else o = g + row * 1024 + (col0 - 2048);
                o += 4 * hi;
#pragma unroll
                for (int ni = 0; ni < 2; ++ni)
#pragma unroll
                    for (int gg = 0; gg < 4; ++gg) *(u32x2*)(o + ni * 32 + 8 * gg) = pack4(acc[mi][ni][4 * gg] * sc, acc[mi][ni][4 * gg + 1] * sc, acc[mi][ni][4 * gg + 2] * sc, acc[mi][ni][4 * gg + 3] * sc);
            } else if (col0 == 3072) {
                float* o = z + row * 32 + 4 * hi;
#pragma unroll
                for (int gg = 0; gg < 4; ++gg) { f32x4 t = {acc[mi][0][4 * gg], acc[mi][0][4 * gg + 1], acc[mi][0][4 * gg + 2], acc[mi][0][4 * gg + 3]}; *(f32x4*)(o + 8 * gg) = t; }
            } }
        return col0 < 3072 ? 16 : (col0 == 3072 ? 8 : 0);
    } };

template <int WM, int WN, class AL, class BL, class EP>
__device__ __forceinline__ void gemm_phase(const Frame& F, const AL al, const BL bl, EP& ep, int mt0, int mt1, int nN, int nk, int tile_off, int tile_total) {
    PlainTiles<AL, BL, EP> prov{al, bl, ep, mt0, mt1 - mt0, nN, F.bx, F.G}; (void)tile_off;
    gemm_stream<WM, WN>(F.lds, prov, nk);
    (void)tile_total;
}

__device__ __forceinline__ void mla_rowpass(const Frame& F, int j) {
    const int lane = threadIdx.x & 63, wid = threadIdx.x >> 6;
    const float* DQ = F.W<float>(MLA_DQ); u16* CN = F.W<u16>(MLA_CN); u16* KPE = F.W<u16>(MLA_KPE);
    const float* gq = F.in(9) + j * 256; const float* gk = F.in(11) + j * 256;
    const float* ca = F.W<float>(WS_ROPEA); const float* sa = ca + SEQ * 16;
    for (int row = F.bx * NWAVE + wid; row < NTOK; row += F.G * NWAVE) {
        const float* d = DQ + (size_t)row * 544;
        const f32x4 a = *(const f32x4*)(d + lane * 4), c = *(const f32x4*)(d + 256 + lane * 4);
        float sq = a[0] * a[0] + a[1] * a[1] + a[2] * a[2] + a[3] * a[3], sk = c[0] * c[0] + c[1] * c[1] + c[2] * c[2] + c[3] * c[3];
        sq = wave_sum(sq); sk = wave_sum(sk);
        const float rq = rsqrtf(sq * (1.f / 256.f) + EPS), rk = rsqrtf(sk * (1.f / 256.f) + EPS);
        const f32x4 g1 = *(const f32x4*)(gq + lane * 4), g2 = *(const f32x4*)(gk + lane * 4);
        u32x2 w1 = {cvtpk(a[0] * rq * g1[0], a[1] * rq * g1[1]), cvtpk(a[2] * rq * g1[2], a[3] * rq * g1[3])};
        u32x2 w2 = {cvtpk(c[0] * rk * g2[0], c[1] * rk * g2[1]), cvtpk(c[2] * rk * g2[2], c[3] * rk * g2[3])};
        *(u32x2*)(CN + (size_t)row * 512 + lane * 4) = w1; *(u32x2*)(CN + (size_t)row * 512 + 256 + lane * 4) = w2;
        if (lane < 16) { float t1 = d[512 + lane], t2 = d[528 + lane]; int b, pos; row_bp(row, b, pos);
            if (row >= NCTX) { const int n = (row - NCTX) & (SEQ - 1); const float cs = ca[n * 16 + lane], sn = sa[n * 16 + lane];
                const float o1 = t1 * cs - t2 * sn, o2 = t1 * sn + t2 * cs; t1 = o1; t2 = o2; }
            u16* o = KPE + ((size_t)b * KEYS + pos) * 32 + lane; o[0] = f2bf(t1); o[16] = f2bf(t2); }
    }
}
__device__ __forceinline__ int vcu_of(const Frame& F) { return (F.G % 8 == 0) ? (F.bx % 8) * (F.G / 8) + F.bx / 8 : F.bx; }
__device__ __forceinline__ void mla_attn(const Frame& F, bool ctx_out, int li) {
    const u16* Q = F.W<u16>(MLA_Q); const u16* Kn = F.W<u16>(MLA_KN); const u16* V = F.W<u16>(MLA_V); const u16* Kpe = F.W<u16>(MLA_KPE);
    u16* O = F.W<u16>(MLA_DQ);
    const int nit = 2048 + (ctx_out ? 64 : 0); int nrun = 0;
#pragma unroll 1
    for (int it = vcu_of(F); it < nit; it += F.G) {
        int b, h, qpos, nkeys, orow;
        if (it < 2048) { const int bh = it >> 5, qt = it & 31; b = bh >> 4; h = bh & 15; qpos = CTXL + qt * 256; nkeys = KEYS; orow = NCTX + b * SEQ + qt * 256; }
        else { const int jj = it - 2048; b = jj >> 4; h = jj & 15; qpos = 0; nkeys = CTXL; orow = b * CTXL; }
        const size_t bh = (size_t)(b * 16 + h);
        attn_item<96, 64>(Q + (bh * KEYS + qpos) * 96, Kn + bh * KEYS * 64, Kpe + (size_t)b * KEYS * 32, V + bh * KEYS * 64, nkeys,
                          O + (size_t)orow * DM + h * 64, DM, F.lds);
        moe_cvt_group(F, li, F.bx + nrun * F.G); ++nrun;
    }
    for (; F.bx + nrun * F.G < MOE_CVT_GROUPS; ++nrun) moe_cvt_group(F, li, F.bx + nrun * F.G);
}
__device__ __forceinline__ void diff_attn(const Frame& F, int li) {
    const u16* Q = F.W<u16>(DF_Q); const u16* K = F.W<u16>(DF_K); const u16* V = F.W<u16>(DF_V); u16* OS = F.W<u16>(DF_OS);
    const int nit = 2048 + 64; int nrun = 0;
#pragma unroll 1
    for (int it = vcu_of(F); it < nit; it += F.G) {
        int b, hh, qpos, nkeys, orow;
        if (it < 2048) { const int bh = it >> 5, qt = it & 31; b = bh >> 4; hh = bh & 15; qpos = CTXL + qt * 256; nkeys = KEYS; orow = NCTX + b * SEQ + qt * 256; }
        else { const int jj = it - 2048; b = jj >> 4; hh = jj & 15; qpos = 0; nkeys = CTXL; orow = b * CTXL; }
        const size_t bh = (size_t)(b * 16 + hh);
        attn_item<64, 128>(Q + (bh * KEYS + qpos) * 64, K + bh * KEYS * 64, nullptr, V + (size_t)(b * 8 + (hh >> 1)) * KEYS * 128, nkeys,
                           OS + (size_t)(hh & 1) * NTOK * DM + (size_t)orow * DM + (hh >> 1) * 128, DM, F.lds);
        moe_cvt_group(F, li, F.bx + nrun * F.G); ++nrun;
    }
    for (; F.bx + nrun * F.G < MOE_CVT_GROUPS; ++nrun) moe_cvt_group(F, li, F.bx + nrun * F.G);
}
__device__ __forceinline__ void diff_rowpass(const Frame& F, float lam_init) {
    const int lane = threadIdx.x & 63, wid = threadIdx.x >> 6;
    const u16* OS = F.W<u16>(DF_OS); u16* O = F.W<u16>(DF_Q);
    const float* lm = F.in(15);
    const float lam = __expf(wave_sum(lm[lane] * lm[64 + lane])) - __expf(wave_sum(lm[128 + lane] * lm[192 + lane])) + lam_init;
    const float post = 1.f - lam_init;
    float sg[16];
#pragma unroll
    for (int i = 0; i < 16; ++i) sg[i] = F.in(16)[(lane & 7) * 16 + i] * post;
    for (int row = F.bx * NWAVE + wid; row < NTOK; row += F.G * NWAVE) {
        const u16* p0 = OS + (size_t)row * DM + lane * 16; const u16* p1 = p0 + (size_t)NTOK * DM;
        const bf16x8 a0 = *(const bf16x8*)p0, a1 = *(const bf16x8*)(p0 + 8), b0 = *(const bf16x8*)p1, b1 = *(const bf16x8*)(p1 + 8);
        float o[16]; float ss = 0;
#pragma unroll
        for (int i = 0; i < 8; ++i) { o[i] = bf2f((u16)a0[i]) - lam * bf2f((u16)b0[i]); o[8 + i] = bf2f((u16)a1[i]) - lam * bf2f((u16)b1[i]); }
#pragma unroll
        for (int i = 0; i < 16; ++i) ss += o[i] * o[i];
        ss += __shfl_xor(ss, 1); ss += __shfl_xor(ss, 2); ss += __shfl_xor(ss, 4);
        const float rinv = rsqrtf(ss * (1.f / 128.f) + EPS);
        u32x4 w0, w1;
#pragma unroll
        for (int i = 0; i < 4; ++i) { w0[i] = cvtpk(o[2 * i] * rinv * sg[2 * i], o[2 * i + 1] * rinv * sg[2 * i + 1]);
            w1[i] = cvtpk(o[8 + 2 * i] * rinv * sg[8 + 2 * i], o[9 + 2 * i] * rinv * sg[9 + 2 * i]); }
        *(u32x4*)(O + (size_t)row * DM + lane * 16) = w0; *(u32x4*)(O + (size_t)row * DM + lane * 16 + 8) = w1;
    }
}

__device__ __forceinline__ float logsig16(float x) { return (fminf(x, 0.f) - __logf(1.f + __expf(-fabsf(x)))) * 0.0625f; }
constexpr int NCH = KEYS / 64;

__device__ __forceinline__ void gla_g1(const Frame& F) {
    char* KT = F.lds; char* VV = F.lds + 16384; float* ZT = (float*)(F.lds + 49152); float* SEG = (float*)(F.lds + 53248);
    const u16* Kg = F.W<u16>(GL_K); const u16* Vg = F.W<u16>(GL_V); const float* Zg = F.W<float>(GL_Z);
    u16* ST = F.W<u16>(GL_STATE); float* DEC = F.W<float>(GL_DEC);
#pragma unroll 1
    for (int it = F.bx; it < NBATCH * 4 * 2 * NCH; it += F.G) {
        int tid = threadIdx.x; asm volatile("" : "+v"(tid));
        const int lane = tid & 63, wid = tid >> 6, r32 = lane & 31, hi = lane >> 5, kk = tid & 127, jq = tid >> 7;
        const int c = it % NCH, dir = (it / NCH) & 1, bh = it / (2 * NCH), b = bh >> 2, h = bh & 3;
        const int s0 = 64 * c;
        int tbase, tstep;
        if (dir == 0) { tbase = (c < 4) ? b * CTXL + s0 : NCTX + b * SEQ + s0 - CTXL; tstep = 1; }
        else { tbase = (c < 4) ? b * CTXL + (CTXL - 1) - s0 : NCTX + b * SEQ + (SEQ - 1) - (s0 - CTXL); tstep = -1; }
        __syncthreads();
        for (int i = tid; i < 1024; i += NTHR) { const int j = i >> 4, r = i & 15; ZT[i] = Zg[(size_t)(tbase + tstep * j) * 32 + dir * 16 + r]; }
#pragma unroll
        for (int q = 0; q < 4; ++q) { const int id = tid + q * NTHR, key = id >> 5, cc = (id & 31) * 8;
            *(bf16x8*)(VV + v_st<8>(key, cc)) = *(const bf16x8*)(Vg + (size_t)(tbase + tstep * key) * 1024 + h * 256 + cc); }
        float wg[16];
#pragma unroll
        for (int r = 0; r < 16; ++r) wg[r] = F.in(19)[(dir * 16 + r) * 512 + h * 128 + kk];
        const float bias = F.in(20)[dir * 512 + h * 128 + kk];
        __syncthreads();
        float cv[16]; float run = 0;
#pragma unroll
        for (int jj = 0; jj < 16; ++jj) { const int j = jq * 16 + jj; float x = bias;
#pragma unroll
            for (int r = 0; r < 16; ++r) x += ZT[j * 16 + r] * wg[r];
            run += logsig16(x); cv[jj] = run; }
        SEG[jq * 128 + kk] = run;
        __syncthreads();
        float offset = 0, total = 0;
#pragma unroll
        for (int q = 0; q < 4; ++q) { const float sv = SEG[q * 128 + kk]; total += sv; if (q < jq) offset += sv; }
        u32x4 w0, w1;
#pragma unroll
        for (int i = 0; i < 8; ++i) {
            const int j0 = jq * 16 + 2 * i;
            const float k0 = bf2f(Kg[(size_t)(tbase + tstep * j0) * 512 + h * 128 + kk]) * __expf(total - (offset + cv[2 * i]));
            const float k1 = bf2f(Kg[(size_t)(tbase + tstep * (j0 + 1)) * 512 + h * 128 + kk]) * __expf(total - (offset + cv[2 * i + 1]));
            const unsigned pk = cvtpk(k0, k1); if (i < 4) w0[i] = pk; else w1[i - 4] = pk; }
        *(u32x4*)(KT + kk * 128 + (((jq * 2) ^ ((kk >> 1) & 7)) << 4)) = w0;
        *(u32x4*)(KT + kk * 128 + (((jq * 2 + 1) ^ ((kk >> 1) & 7)) << 4)) = w1;
        if (jq == 0) DEC[(size_t)it * 128 + kk] = __expf(total);
        __syncthreads();
        const int mt = wid & 3, vb = (wid >> 2) * 4;
        const int row = mt * 32 + r32, ab = row * 128 + ((hi ^ ((row >> 1) & 7)) << 4);
        const bf16x8 pa0 = *(const bf16x8*)(KT + (ab ^ 0)), pa1 = *(const bf16x8*)(KT + (ab ^ 32)), pa2 = *(const bf16x8*)(KT + (ab ^ 64)), pa3 = *(const bf16x8*)(KT + (ab ^ 96));
        f32x16 acc[4];
#pragma unroll
        for (int n = 0; n < 4; ++n) acc[n] = f32x16{};
        const int vbase = (int)(uintptr_t)VV + v_rd_base(lane) + vb * 512;
        pv_one<0, 8>(acc[0], vbase, pa0, pa1, pa2, pa3); pv_one<1, 8>(acc[1], vbase, pa0, pa1, pa2, pa3);
        pv_one<2, 8>(acc[2], vbase, pa0, pa1, pa2, pa3); pv_one<3, 8>(acc[3], vbase, pa0, pa1, pa2, pa3);
        u16* S = ST + (size_t)it * 128 * 256;
#pragma unroll
        for (int n = 0; n < 4; ++n)
#pragma unroll
            for (int r = 0; r < 16; ++r) S[(mt * 32 + crow(r, hi)) * 256 + (vb + n) * 32 + r32] = f2bf(acc[n][r]);
    }
}
__device__ __forceinline__ void gla_g2(const Frame& F) {
    u16* ST = F.W<u16>(GL_STATE); const float* DEC = F.W<float>(GL_DEC);
    for (int g = F.bx * NTHR + threadIdx.x; g < 32 * 4096; g += F.G * NTHR) {
        const int chain = g >> 12, e = g & 4095, kk = e >> 5, v8 = (e & 31) * 8;
        u16* p = ST + ((size_t)chain * NCH * 128 + kk) * 256 + v8; const float* d = DEC + (size_t)chain * NCH * 128 + kk;
        float f[8];
#pragma unroll
        for (int i = 0; i < 8; ++i) f[i] = 0.f;
        for (int c = 0; c < NCH; c += 4) {
            bf16x8 kv[4]; float dc[4];
#pragma unroll
            for (int u = 0; u < 4; ++u) { kv[u] = *(const bf16x8*)(p + (size_t)(c + u) * 128 * 256); dc[u] = d[(size_t)(c + u) * 128]; }
#pragma unroll
            for (int u = 0; u < 4; ++u) {
                u32x4 w = {cvtpk(f[0], f[1]), cvtpk(f[2], f[3]), cvtpk(f[4], f[5]), cvtpk(f[6], f[7])};
                *(u32x4*)(p + (size_t)(c + u) * 128 * 256) = w;
#pragma unroll
                for (int i = 0; i < 8; ++i) f[i] = dc[u] * f[i] + bf2f((u16)kv[u][i]);
            }
        }
    }
}
__device__ __forceinline__ void gla_g3(const Frame& F) {
    char* QD = F.lds; char* KI = F.lds + 16384; char* VV = F.lds + 32768; char* SS = F.lds + 65536; float* OL = (float*)(F.lds + 65536);
    float* ZT = (float*)(F.lds + 132096); float* SEG = (float*)(F.lds + 136192);
    const u16* Qg = F.W<u16>(GL_Q); const u16* Kg = F.W<u16>(GL_K); const u16* Vg = F.W<u16>(GL_V); const u16* Gg = F.W<u16>(GL_G); const float* Zg = F.W<float>(GL_Z);
    const u16* ST = F.W<u16>(GL_STATE); u16* OUT = F.W<u16>(WS_H);
#pragma unroll 1
    for (int it = F.bx; it < NBATCH * 4 * NCH; it += F.G) {
        int tid = threadIdx.x; asm volatile("" : "+v"(tid));
        const int lane = tid & 63, wid = tid >> 6, r32 = lane & 31, hi = lane >> 5, kk = tid & 127, jq = tid >> 7;
        const int T = it % NCH, bh = it / NCH, b = bh >> 2, h = bh & 3;
        const int t0 = (T < 4) ? b * CTXL + 64 * T : NCTX + b * SEQ + 64 * (T - 4);
        __syncthreads();
#pragma unroll
        for (int q = 0; q < 4; ++q) { const int id = tid + q * NTHR, key = id >> 5, cc = (id & 31) * 8;
            *(bf16x8*)(VV + v_st<8>(key, cc)) = *(const bf16x8*)(Vg + (size_t)(t0 + key) * 1024 + h * 256 + cc); }
        const int itile = wid & 1, vb = (wid >> 1) * 2;
        f32x16 acc[2]; acc[0] = f32x16{}; acc[1] = f32x16{};
#pragma unroll 1
        for (int dir = 0; dir < 2; ++dir) {
            const int cd = dir == 0 ? T : (T < 4 ? 3 - T : 135 - T);
            const u16* Ssrc = ST + (size_t)((bh * 2 + dir) * NCH + cd) * 128 * 256;
#pragma unroll
            for (int q = 0; q < 8; ++q) { const int id = tid + q * NTHR, key = id >> 5, cc = (id & 31) * 8;
                *(bf16x8*)(SS + v_st<8>(key, cc)) = *(const bf16x8*)(Ssrc + (size_t)key * 256 + cc); }
            for (int i = tid; i < 1024; i += NTHR) { const int j = i >> 4, r = i & 15; ZT[i] = Zg[(size_t)(t0 + j) * 32 + dir * 16 + r]; }
            float wg[16];
#pragma unroll
            for (int r = 0; r < 16; ++r) wg[r] = F.in(19)[(dir * 16 + r) * 512 + h * 128 + kk];
            const float bias = F.in(20)[dir * 512 + h * 128 + kk];
            __syncthreads();
            float cv[16]; float run = 0;
#pragma unroll
            for (int u = 0; u < 16; ++u) { const int j = jq * 16 + u; float x = bias;
#pragma unroll
                for (int r = 0; r < 16; ++r) x += ZT[j * 16 + r] * wg[r];
                cv[u] = logsig16(x); }
            if (dir == 0) {
#pragma unroll
                for (int u = 0; u < 16; ++u) { run += cv[u]; cv[u] = run; }
            } else {
#pragma unroll
                for (int u = 15; u >= 0; --u) { run += cv[u]; cv[u] = run; }
            }
            SEG[jq * 128 + kk] = run;
            __syncthreads();
            float offset = 0;
#pragma unroll
            for (int q = 0; q < 4; ++q) { const float sv = SEG[q * 128 + kk]; if (dir == 0 ? (q < jq) : (q > jq)) offset += sv; }
            const int adb = jq * 4096 + ((kk >> 3) << 4) + (kk & 7) * 2;
#pragma unroll
            for (int jj = 0; jj < 16; ++jj) { const int i = jq * 16 + jj; const float cum = offset + cv[jj];
                const float qv = bf2f(Qg[(size_t)(t0 + i) * 512 + h * 128 + kk]) * __expf(cum);
                const float kv = bf2f(Kg[(size_t)(t0 + i) * 512 + h * 128 + kk]) * __expf(-cum);
                const int ad = (adb ^ (jj << 4)) + jj * 256;
                *(u16*)(QD + ad) = f2bf(qv); *(u16*)(KI + ad) = f2bf(kv); }
            __syncthreads();
            {
                const int row = itile * 32 + r32; bf16x8 qa[8];
#pragma unroll
                for (int ks = 0; ks < 8; ++ks) qa[ks] = *(const bf16x8*)(QD + row * 256 + (((ks * 2 + hi) ^ (row & 15)) << 4));
                const int ssb = (int)(uintptr_t)SS + v_rd_base(lane) + vb * 512;
                pv_one<0, 8>(acc[0], ssb, qa[0], qa[1], qa[2], qa[3]); pv_one<0, 8>(acc[0], ssb + 32768, qa[4], qa[5], qa[6], qa[7]);
                pv_one<1, 8>(acc[1], ssb, qa[0], qa[1], qa[2], qa[3]); pv_one<1, 8>(acc[1], ssb + 32768, qa[4], qa[5], qa[6], qa[7]);
                f32x16 p0 = f32x16{}, p1 = f32x16{};
#pragma unroll
                for (int ks = 0; ks < 8; ++ks) {
                    const bf16x8 k0 = *(const bf16x8*)(KI + r32 * 256 + (((ks * 2 + hi) ^ (r32 & 15)) << 4));
                    const bf16x8 k1 = *(const bf16x8*)(KI + (32 + r32) * 256 + (((ks * 2 + hi) ^ (r32 & 15)) << 4));
                    p0 = __builtin_amdgcn_mfma_f32_32x32x16_bf16(k0, qa[ks], p0, 0, 0, 0);
                    p1 = __builtin_amdgcn_mfma_f32_32x32x16_bf16(k1, qa[ks], p1, 0, 0, 0);
                }
                const int iq = itile * 32 + r32;
#pragma unroll
                for (int r = 0; r < 16; ++r) { const int s0 = crow(r, hi), s1 = 32 + s0;
                    const bool k0 = dir == 0 ? (s0 <= iq) : (s0 >= iq), k1 = dir == 0 ? (s1 <= iq) : (s1 >= iq);
                    p0[r] = k0 ? p0[r] : 0.f; p1[r] = k1 ? p1[r] : 0.f; }
                bf16x8 pa0, pa1, pa2, pa3;
                PK4(p0, 0, pa0); PK4(p0, 8, pa1); PK4(p1, 0, pa2); PK4(p1, 8, pa3);
                const int vvb = (int)(uintptr_t)VV + v_rd_base(lane) + vb * 512;
                pv_one<0, 8>(acc[0], vvb, pa0, pa1, pa2, pa3); pv_one<1, 8>(acc[1], vvb, pa0, pa1, pa2, pa3);
            }
            __syncthreads();
        }
        float* olb = OL + (itile * 32 + 4 * hi) * 260 + vb * 32 + r32;
#pragma unroll
        for (int n = 0; n < 2; ++n)
#pragma unroll
            for (int r = 0; r < 16; ++r) olb[((r & 3) + 8 * (r >> 2)) * 260 + n * 32] = acc[n][r];
        __syncthreads();
        {
            const int i = tid >> 3, sg = tid & 7; const float* ol = OL + i * 260 + sg * 32;
            float ss = 0;
#pragma unroll
            for (int u = 0; u < 8; ++u) { const f32x4 t = *(const f32x4*)(ol + u * 4); ss += t[0] * t[0] + t[1] * t[1] + t[2] * t[2] + t[3] * t[3]; }
            ss += __shfl_xor(ss, 1); ss += __shfl_xor(ss, 2); ss += __shfl_xor(ss, 4);
            const float rinv = rsqrtf(ss * (1.f / 256.f) + EPS);
            const u16* gp = Gg + (size_t)(t0 + i) * 1024 + h * 256 + sg * 32; u16* op = OUT + (size_t)(t0 + i) * 1024 + h * 256 + sg * 32;
            const float* hn = F.in(21) + sg * 32;
#pragma unroll
            for (int q = 0; q < 4; ++q) { const bf16x8 g8 = *(const bf16x8*)(gp + q * 8); u32x4 w;
                const f32x4 oa = *(const f32x4*)(ol + q * 8), ob = *(const f32x4*)(ol + q * 8 + 4);
                const float o8[8] = {oa[0], oa[1], oa[2], oa[3], ob[0], ob[1], ob[2], ob[3]};
#pragma unroll
                for (int u = 0; u < 4; ++u) { const int e0 = q * 8 + 2 * u;
                    w[u] = cvtpk(o8[2 * u] * rinv * hn[e0] * silu_f(bf2f((u16)g8[2 * u])), o8[2 * u + 1] * rinv * hn[e0 + 1] * silu_f(bf2f((u16)g8[2 * u + 1]))); }
                *(u32x4*)(op + q * 8) = w; }
        }
    }
}

__device__ __forceinline__ void pair_decode(int p, int& elo, int& ehi) { elo = p < 3 ? 0 : (p < 5 ? 1 : 2); ehi = p < 3 ? p + 1 : (p < 5 ? p - 1 : 3); }
struct MoeATiles {
    typedef GTile<RowsGather, RowsPlain, EpiMoeA> Tile; static constexpr bool EP_CONST = false; EpiMoeA ep;
    const int* tab; u16* H; const int* rowtok; const u16* wgu; u16* act; const float* roww; int nmt, bx, G;
    __device__ __forceinline__ bool get(int i, Tile& t) const {
        int mt, nt; if (!tile_seq(i, bx, G, nmt, 16, mt, nt)) return false;
        const int c = tab[32 + mt], g = c / 6; int elo, ehi; pair_decode(c % 6, elo, ehi);
        const int half = nt >> 3, e = half ? ehi : elo;
        t.al = RowsGather{H, 1024, rowtok};
        t.bl = RowsPlain{wgu + ((size_t)(g * 4 + e) * 1024 + (nt & 7) * 128) * 1024, 1024};
        t.ep = EpiMoeA{act, roww, half, half * 512 + (nt & 7) * 64};
        t.brow = mt * 256; t.bcol = 0; return true; }
};
struct MoeBTiles {
    typedef GTile<RowsPlain, RowsSplitK, EpiMoeB> Tile; static constexpr bool EP_CONST = false; EpiMoeB ep;
    const int* tab; ResCtx F; int li; const u16* wd; const u16* act; const int* rowtok; int nmt, bx, G;
    __device__ __forceinline__ bool get(int i, Tile& t) const {
        int mt, nt; if (!tile_seq(i, bx, G, nmt, 8, mt, nt)) return false;
        const int c = tab[32 + mt], g = c / 6; int elo, ehi; pair_decode(c % 6, elo, ehi);
        t.al = RowsPlain{act, 1024};
        t.bl = RowsSplitK{wd + (size_t)(g * 4 + elo) * 1024 * 512, wd + (size_t)(g * 4 + ehi) * 1024 * 512, 512, 8};
        t.ep = EpiMoeB{F, li, rowtok};
        t.brow = mt * 256; t.bcol = nt * 128; return true; }
};
__device__ __forceinline__ void moe_gemm_a(const Frame& F, int li) {
    int* tab = (int*)(F.lds + LDS_TAB); moe_table(F, li, tab);
    const int nmt = tab[24] >> 8;
    pg8::MoeAOrder S8{F.W<u16>(WS_H), tab, F.W<int>(WS_ROWTOK), F.W<u16>(WS_MOEW), nmt, F.bx, F.G}; pg8::EpiMoeA8 E8{F.W<u16>(MOE_ACT), F.W<float>(WS_ROWW)};
    pg8::gemm_phase(F.lds, 1024, 1024, S8, E8);
}
__device__ __forceinline__ void moe_gemm_b(const Frame& F, int li) {
    int* tab = (int*)(F.lds + LDS_TAB); moe_table(F, li, tab);
    const int nmt = tab[24] >> 8;
    MoeBTiles prov{EpiMoeB{}, tab, res_ctx(F), li, F.W<u16>(WS_MOEW + MOE_WGU_BYTES), F.W<u16>(MOE_ACT), F.W<int>(WS_ROWTOK), nmt, F.bx, F.G};
    gemm_stream<4, 2>(F.lds, prov, 16);
}
__device__ __forceinline__ void final_norm(const Frame& F) {
    const int lane = threadIdx.x & 63, wid = threadIdx.x >> 6;
    for (int row = F.bx * NWAVE + wid; row < NLAT; row += F.G * NWAVE) {
        float* xr = F.out + (size_t)row * DM; f32x4 v[4];
#pragma unroll
        for (int i = 0; i < 4; ++i) v[i] = *(const f32x4*)(xr + i * 256 + lane * 4);
        float ss = 0;
#pragma unroll
        for (int i = 0; i < 4; ++i) ss += v[i][0] * v[i][0] + v[i][1] * v[i][1] + v[i][2] * v[i][2] + v[i][3] * v[i][3];
        ss = wave_sum(ss); const float rinv = rsqrtf(ss * (1.f / DM) + EPS);
#pragma unroll
        for (int i = 0; i < 4; ++i) { const f32x4 g = *(const f32x4*)(F.in(30) + i * 256 + lane * 4);
            f32x4 o = {v[i][0] * rinv * g[0], v[i][1] * rinv * g[1], v[i][2] * rinv * g[2], v[i][3] * rinv * g[3]};
            *(f32x4*)(xr + i * 256 + lane * 4) = o; }
    }
}

constexpr int N_PHASES = 42;
__global__ void __launch_bounds__(NTHR, 2) fwd_kernel(Params p) {
    extern __shared__ __attribute__((aligned(16))) char lds[];
    Frame F; F.p = &p; F.ws = p.ws; F.lds = lds; F.out = p.out; F.G = (int)gridDim.x; F.bx = (int)blockIdx.x;
    const int lo = p.ph_lo, hi = p.ph_hi;
#if !MK_PER_PHASE
    if (threadIdx.x == 0) *(uint4*)(lds + LDS_BARW) = make_uint4(0u, 0u, 0u, 0u);
    __syncthreads();
    XcdBarrier bar = xcd_barrier_post((unsigned*)(p.ws + WS_CTL), (volatile LAS unsigned*)(lds + LDS_BARW));
#define GRID_BAR() xcd_barrier(bar)
#else
#define GRID_BAR() do {} while (0)
#endif
#ifndef MK_EN
#define MK_EN 0xFFFFFFFFu
#endif
#define EN(g) (((MK_EN) >> (g)) & 1u)
#ifndef MK_REP
#define MK_REP 0u
#endif
#define REP(g) (((MK_REP) >> (g)) & 1u)
#define IN(k) (lo <= (k) && (k) < hi)
#define SEAM(k) do { if ((k) + 1 < hi) GRID_BAR(); } while (0)
#define DUP(g, body) do { body; if (REP(g)) { GRID_BAR(); body; } } while (0)

    if (EN(0) && IN(0)) { DUP(0, (p0_mods(F), __syncthreads(), p0_rope(F), p0_weights(F))); SEAM(0); }

#define LAYER(LI) { constexpr int li = (LI); constexpr int base = 1 + li * 10; constexpr bool first = li == 0, last = li == DEPTH - 1; constexpr int kind = li % 3, j = li / 3; \
        if (EN(1) && IN(base + 0)) { DUP(1, norm_phase<false>(F, li, 0, first)); SEAM(base + 0); } \
        if constexpr (kind == 0) { \
            if (EN(2) && IN(base + 1)) { EpiF32 ep{F.W<float>(MLA_DQ), 544, 544}; \
                gemm_phase<4, 2>(F, RowsPlain{F.W<u16>(WS_H), 1024}, RowsPlain{F.W<u16>(WS_WDQKV) + (size_t)j * 640 * 1024, 1024}, ep, 0, 132, 5, 16, 0, 0); if (REP(2)) { GRID_BAR(); gemm_phase<4, 2>(F, RowsPlain{F.W<u16>(WS_H), 1024}, RowsPlain{F.W<u16>(WS_WDQKV) + (size_t)j * 640 * 1024, 1024}, ep, 0, 132, 5, 16, 0, 0); } SEAM(base + 1); } \
            if (EN(3) && IN(base + 2)) { DUP(3, mla_rowpass(F, j)); SEAM(base + 2); } \
            if (EN(2) && IN(base + 3)) { pg8::MlaUpOrder S8{F.W<u16>(MLA_CN), F.W<u16>(WS_WUQ) + (size_t)j * 1536 * 256, F.W<u16>(WS_WUKV) + (size_t)j * 2048 * 256, F.bx, F.G}; \
                pg8::EpiMlaUp8 E8{F.W<u16>(MLA_Q), F.W<u16>(MLA_KN), (long)((MLA_V - MLA_KN) / 2), 0.10206207261596577f * LOG2E}; \
                pg8::gemm_phase(F.lds, 512, 256, S8, E8); SEAM(base + 3); } \
            if (EN(4) && IN(base + 4)) { DUP(4, mla_attn(F, !last, li)); SEAM(base + 4); } \
            if (EN(2) && IN(base + 5)) { pg8::SeqOrder S8{F.W<u16>(MLA_DQ), F.W<u16>(WS_WOM) + (size_t)j * 1024 * 1024, 1024, last ? 128 : 132, 4, F.bx, F.G, last ? 4 : 0}; EpiResid8 E8{res_ctx(F, first), li}; \
                pg8::gemm_phase(F.lds, 1024, 1024, S8, E8); SEAM(base + 5); } \
        } else if constexpr (kind == 1) { \
            if (EN(5) && IN(base + 1)) { pg8::SeqOrder S8{F.W<u16>(WS_H), F.W<u16>(WS_WQKVD), 1024, 132, 12, F.bx, F.G, 0}; pg8::EpiDiffQKV8 E8{F.W<u16>(DF_Q), (long)((DF_K - DF_Q) / 2), F.W<u16>(DF_V), 0.125f * LOG2E}; \
                pg8::gemm_phase(F.lds, 1024, 1024, S8, E8); \
                if (REP(5)) { GRID_BAR(); pg8::gemm_phase(F.lds, 1024, 1024, S8, E8); } SEAM(base + 1); } \
            if (EN(6) && IN(base + 2)) { DUP(6, diff_attn(F, li)); SEAM(base + 2); } \
            if (EN(7) && IN(base + 3)) { DUP(7, diff_rowpass(F, 0.35550906759906f)); SEAM(base + 3); } \
            if (EN(5) && IN(base + 4)) { pg8::SeqOrder S8{F.W<u16>(DF_Q), F.W<u16>(WS_WOD), 1024, 132, 4, F.bx, F.G, 0}; EpiResid8 E8{res_ctx(F, first), li}; \
                pg8::gemm_phase(F.lds, 1024, 1024, S8, E8); SEAM(base + 4); } \
        } else { \
            if (EN(8) && IN(base + 1)) { pg8::SeqOrder S8{F.W<u16>(WS_H), F.W<u16>(WS_WING), 1024, 132, 13, F.bx, F.G, 0}; pg8::EpiGlaIn8 E8{F.W<u16>(GL_Q), F.W<u16>(GL_K), F.W<u16>(GL_V), F.W<u16>(GL_G), F.W<float>(GL_Z)}; \
                pg8::gemm_phase(F.lds, 1024, 1024, S8, E8); \
                if (REP(8)) { GRID_BAR(); pg8::gemm_phase(F.lds, 1024, 1024, S8, E8); } SEAM(base + 1); } \
            if (EN(9) && IN(base + 2)) { DUP(9, gla_g1(F)); SEAM(base + 2); } \
            if (EN(10) && IN(base + 3)) { gla_g2(F); SEAM(base + 3); } \
            if (EN(11) && IN(base + 4)) { DUP(11, gla_g3(F)); SEAM(base + 4); } \
            if (EN(8) && IN(base + 5)) { pg8::SeqOrder S8{F.W<u16>(WS_H), F.W<u16>(WS_WOG), 1024, 132, 4, F.bx, F.G, 0}; EpiResid8 E8{res_ctx(F, first), li}; \
                pg8::gemm_phase(F.lds, 1024, 1024, S8, E8); SEAM(base + 5); } \
        } \
        if (EN(12) && IN(base + 6)) { norm_phase<true>(F, li, last ? NCTX : 0, false); SEAM(base + 6); } \
        if (EN(13) && IN(base + 7)) { DUP(13, ((kind == 2 ? moe_weights(F, li) : (void)0), moe_scatter(F, li, last ? NCTX : 0))); SEAM(base + 7); } \
        if (EN(14) && IN(base + 8)) { DUP(14, moe_gemm_a(F, li)); SEAM(base + 8); } \
        if (EN(15) && IN(base + 9)) { moe_gemm_b(F, li); SEAM(base + 9); } \
    }
    LAYER(0) LAYER(1) LAYER(2) LAYER(3)
    if (EN(16) && IN(41)) { final_norm(F); }
}

extern "C" void kernel_launch(void* const* d_in, const int* in_sizes, int n_in, void* d_out, int out_size, void* d_ws, size_t ws_size, hipStream_t stream) {
    static int grid = 0;
    if (grid == 0) {
        if (n_in != 31 || out_size != NLAT * DM || ws_size < WS_END) {
            fprintf(stderr, "kernel_launch: built for 31 inputs, out %d floats, ws >= %zu bytes; got n_in %d out %d ws %zu\n", NLAT * DM, (size_t)WS_END, n_in, out_size, ws_size);
            grid = -1; return; }
        int dev = 0, cus = 0;
        if (hipGetDevice(&dev) != hipSuccess || hipDeviceGetAttribute(&cus, hipDeviceAttributeMultiprocessorCount, dev) != hipSuccess) { grid = -1; return; }
        if (hipFuncSetAttribute((const void*)fwd_kernel, hipFuncAttributeMaxDynamicSharedMemorySize, LDS_BYTES) != hipSuccess) { fprintf(stderr, "kernel_launch: hipFuncSetAttribute failed\n"); grid = -1; return; }
        int per_cu = 0;
        if (hipOccupancyMaxActiveBlocksPerMultiprocessor(&per_cu, (const void*)fwd_kernel, NTHR, LDS_BYTES) != hipSuccess || per_cu < 1)
            fprintf(stderr, "kernel_launch: occupancy query reports %d workgroups per CU\n", per_cu);
        (void)hipGetLastError();
        grid = cus;
    }
    if (grid < 0) return;
    (void)in_sizes;
    (void)hipMemsetAsync((char*)d_ws + WS_CTL, 0, CTL_BYTES, stream);
    Params p{};
    for (int i = 0; i < 31; ++i) p.in[i] = (const float*)d_in[i];
    p.out = (float*)d_out; p.ws = (unsigned char*)d_ws;
#if MK_PER_PHASE
    for (int ph = 0; ph < N_PHASES; ++ph) { p.ph_lo = ph; p.ph_hi = ph + 1; hipLaunchKernelGGL(fwd_kernel, dim3(grid), dim3(NTHR), LDS_BYTES, stream, p); }
#else
#ifdef MK_PROBE_HI
    p.ph_lo = 0; p.ph_hi = MK_PROBE_HI;
    hipLaunchKernelGGL(fwd_kernel, dim3(grid), dim3(NTHR), LDS_BYTES, stream, p);
    (void)hipMemsetAsync((char*)d_ws + WS_CTL, 0, CTL_BYTES, stream);
#endif
    p.ph_lo = 0; p.ph_hi = N_PHASES;
    hipLaunchKernelGGL(fwd_kernel, dim3(grid), dim3(NTHR), LDS_BYTES, stream, p);
#endif
}
```

```cpp
#include <hip/hip_runtime.h>
#include <stdint.h>
#include <stdio.h>

#ifndef MK_PER_PHASE
#define MK_PER_PHASE 0
#endif

typedef unsigned short u16;
using bf16x8 = __attribute__((ext_vector_type(8))) short;
using s16x4  = __attribute__((ext_vector_type(4))) short;
using f32x16 = __attribute__((ext_vector_type(16))) float;
using f32x4  = __attribute__((ext_vector_type(4))) float;
using u32x4  = __attribute__((ext_vector_type(4))) unsigned;
using u32x2  = __attribute__((ext_vector_type(2))) unsigned;

constexpr int DM = 1024, NBATCH = 4, SEQ = 8192, CTXL = 256, DEPTH = 4;
constexpr int NCTX = NBATCH * CTXL;
constexpr int NLAT = NBATCH * SEQ;
constexpr int NTOK = NCTX + NLAT;
constexpr int KEYS = CTXL + SEQ;
constexpr float EPS = 1e-6f;
constexpr int NTHR = 512, NWAVE = 8;
constexpr float LOG2E = 1.4426950408889634f;

constexpr size_t al256(size_t x) { return (x + 255) / 256 * 256; }
constexpr size_t WS_CTL   = 0;
constexpr size_t CTL_BYTES = 32768;
constexpr size_t WS_MODS  = WS_CTL + CTL_BYTES;
constexpr size_t WS_ROPEA = WS_MODS + al256((size_t)DEPTH * 5 * 6144 * 4);
constexpr size_t WS_ROPEB = WS_ROPEA + (size_t)2 * SEQ * 16 * 4;
constexpr size_t WS_XC    = WS_ROPEB + (size_t)2 * SEQ * 32 * 4;
constexpr size_t WS_WDQKV = WS_XC + (size_t)NCTX * DM * 4;
constexpr size_t WS_WUQ   = WS_WDQKV + (size_t)2 * 640 * 1024 * 2;
constexpr size_t WS_WUKV  = WS_WUQ + (size_t)2 * 1536 * 256 * 2;
constexpr size_t WS_WOM   = WS_WUKV + (size_t)2 * 2048 * 256 * 2;
constexpr size_t WS_WQKVD = WS_WOM + (size_t)2 * 1024 * 1024 * 2;
constexpr size_t WS_WOD   = WS_WQKVD + (size_t)3072 * 1024 * 2;
constexpr size_t WS_WING  = WS_WOD + (size_t)1024 * 1024 * 2;
constexpr size_t WS_WOG   = WS_WING + (size_t)3328 * 1024 * 2;
constexpr size_t WS_TOK   = WS_WOG + (size_t)1024 * 1024 * 2;
constexpr size_t WS_ROWTOK= WS_TOK + (size_t)NTOK * 16;
constexpr int    RMAX     = 40960;
constexpr size_t WS_ROWW  = WS_ROWTOK + (size_t)RMAX * 4;
constexpr size_t WS_H     = al256(WS_ROWW + (size_t)RMAX * 8);
constexpr size_t H_BYTES  = (size_t)NTOK * DM * 2;
constexpr size_t WS_MOEW  = WS_H + H_BYTES;
constexpr size_t MOE_WGU_BYTES = (size_t)16 * 1024 * 1024 * 2;
constexpr size_t MOE_WD_BYTES  = (size_t)16 * 1024 * 512 * 2;
constexpr size_t MOEW_BYTES = MOE_WGU_BYTES + MOE_WD_BYTES;
constexpr size_t WS_BIG   = WS_MOEW + MOEW_BYTES;
constexpr size_t MLA_Q    = WS_BIG;
constexpr size_t MLA_KN   = MLA_Q + (size_t)NBATCH * 16 * KEYS * 96 * 2;
constexpr size_t MLA_V    = MLA_KN + (size_t)NBATCH * 16 * KEYS * 64 * 2;
constexpr size_t MLA_KPE  = MLA_V + (size_t)NBATCH * 16 * KEYS * 64 * 2;
constexpr size_t MLA_DQ   = MLA_KPE + al256((size_t)NBATCH * KEYS * 32 * 2);
constexpr size_t MLA_CN   = MLA_DQ + (size_t)NTOK * 544 * 4;
constexpr size_t MLA_END  = MLA_CN + (size_t)NTOK * 512 * 2;
constexpr size_t DF_Q     = WS_BIG;
constexpr size_t DF_K     = DF_Q + (size_t)NBATCH * 16 * KEYS * 64 * 2;
constexpr size_t DF_V     = DF_K + (size_t)NBATCH * 16 * KEYS * 64 * 2;
constexpr size_t DF_OS    = DF_V + (size_t)NBATCH * 8 * KEYS * 128 * 2;
constexpr size_t DF_END   = DF_OS + (size_t)2 * NTOK * DM * 2;
constexpr size_t GL_STATE = WS_MOEW;
constexpr size_t GL_STATE_BYTES = (size_t)NBATCH * 4 * 2 * 132 * 128 * 256 * 2;
constexpr size_t GL_DEC   = GL_STATE + GL_STATE_BYTES;
constexpr size_t GL_Q     = GL_DEC + al256((size_t)4224 * 128 * 4);
constexpr size_t GL_K     = GL_Q + (size_t)NTOK * 512 * 2;
constexpr size_t GL_V     = GL_K + (size_t)NTOK * 512 * 2;
constexpr size_t GL_G     = GL_V + (size_t)NTOK * 1024 * 2;
constexpr size_t GL_Z     = GL_G + (size_t)NTOK * 1024 * 2;
constexpr size_t GL_END   = GL_Z + (size_t)NTOK * 32 * 4;
constexpr size_t MOE_ACT  = WS_BIG;
constexpr size_t MOE_END  = MOE_ACT + (size_t)RMAX * 1024 * 2;
constexpr size_t cmax(size_t a, size_t b) { return a > b ? a : b; }
constexpr size_t WS_END   = cmax(cmax(MLA_END, DF_END), cmax(GL_END, MOE_END));

#define XCD_BAR_WORDS 3456
constexpr int CW_CNT = 4096;

#define XB_TMO      128
#define XB_XCNT(j)  (256  + 64 * (j))
#define XB_XSUB(j)  (1280 + 64 * (j))
#define XB_XGEN(j)  (2304 + 64 * (j))
#define XB_TOP      3328
#define XB_TOPGEN   3392
#define XB_SPIN_CAP (1u << 24)
#define LAS __attribute__((address_space(3)))
__device__ __forceinline__ unsigned xb_ld(unsigned* p)              { return __hip_atomic_load(p, __ATOMIC_RELAXED, __HIP_MEMORY_SCOPE_AGENT); }
__device__ __forceinline__ unsigned xb_add(unsigned* p, unsigned v) { return __hip_atomic_fetch_add(p, v, __ATOMIC_RELAXED, __HIP_MEMORY_SCOPE_AGENT); }
__device__ __forceinline__ unsigned xb_xcc_id() { return (unsigned)__builtin_amdgcn_s_getreg((3 << 11) | 20) & 0xFu; }
#define XB_SPIN(cond, bar) do { unsigned _sp = 0; while (cond) { __builtin_amdgcn_s_sleep(1); \
    if ((++_sp & 255u) == 0u) { if (xb_ld(&(bar)[XB_TMO])) break; if (_sp > XB_SPIN_CAP) { atomicAdd(&(bar)[XB_TMO], 1u); break; } } } } while (0)
struct XcdBarrier { unsigned* bar; unsigned x; volatile LAS unsigned* st; };
__device__ __forceinline__ XcdBarrier xcd_barrier_post(unsigned* bar, volatile LAS unsigned* st) {
    XcdBarrier b; b.bar = bar; b.x = xb_xcc_id(); b.st = st;
    if (threadIdx.x == 0) (void)xb_add(&bar[XB_XCNT(b.x)], 1u);
    return b;
}
__device__ __forceinline__ void xcd_barrier_complete(unsigned* bar, unsigned x, unsigned& nloc, unsigned& nx) {
    const unsigned G = gridDim.x * gridDim.y * gridDim.z;
    unsigned sum, cnt, mine, sp = 0u;
    for (;;) {
        sum = 0u; cnt = 0u; mine = 0u;
#pragma unroll
        for (unsigned j = 0; j < 16; ++j) { const unsigned c = xb_ld(&bar[XB_XCNT(j)]); sum += c; cnt += (c > 0u) ? 1u : 0u; mine = (j == x) ? c : mine; }
        if (sum == G) break;
        __builtin_amdgcn_s_sleep(1);
        if ((++sp & 255u) == 0u) { if (xb_ld(&bar[XB_TMO])) break; if (sp > XB_SPIN_CAP) { atomicAdd(&bar[XB_TMO], 1u); break; } }
    }
    nloc = mine > 0u ? mine : 1u; nx = cnt > 0u ? cnt : 1u;
}
__device__ __forceinline__ void xcd_barrier(const XcdBarrier& b) {
    asm volatile("s_waitcnt vmcnt(0)" ::: "memory");
    __syncthreads();
    if (threadIdx.x == 0) {
        unsigned* bar = b.bar;
        __builtin_amdgcn_s_waitcnt(0);
        unsigned nloc = b.st[0], nx = b.st[1];
        if (nloc == 0u) { xcd_barrier_complete(bar, b.x, nloc, nx); b.st[0] = nloc; b.st[1] = nx; }
        const unsigned old = xb_add(&bar[XB_XSUB(b.x)], 1u);
        const unsigned gen = old / nloc;
        if (old + 1u == (gen + 1u) * nloc) {
            __builtin_amdgcn_fence(__ATOMIC_RELEASE, "agent");
            asm volatile("s_waitcnt vmcnt(0)" ::: "memory");
            const unsigned og = xb_add(&bar[XB_TOP], 1u);
            const unsigned tg = og / nx;
            if (og + 1u == (tg + 1u) * nx) xb_add(&bar[XB_TOPGEN], 1u);
            else XB_SPIN(xb_ld(&bar[XB_TOPGEN]) == tg, bar);
            __builtin_amdgcn_fence(__ATOMIC_ACQUIRE, "agent");
            xb_add(&bar[XB_XGEN(b.x)], 1u);
            asm volatile("s_waitcnt vmcnt(0)" ::: "memory");
        } else {
            XB_SPIN(xb_ld(&bar[XB_XGEN(b.x)]) == gen, bar);
            __builtin_amdgcn_fence(__ATOMIC_ACQUIRE, "agent");
            asm volatile("s_waitcnt vmcnt(0)" ::: "memory");
        }
    }
    __syncthreads();
}

__device__ __forceinline__ u16 f2bf(float f) { unsigned u = __float_as_uint(f); u += 0x7FFFu + ((u >> 16) & 1u); return (u16)(u >> 16); }
__device__ __forceinline__ float bf2f(u16 h) { return __uint_as_float((unsigned)h << 16); }
__device__ __forceinline__ unsigned cvtpk(float lo, float hi) { unsigned r; asm volatile("v_cvt_pk_bf16_f32 %0, %1, %2" : "=v"(r) : "v"(lo), "v"(hi)); return r; }
__device__ __forceinline__ float wave_sum(float v) {
#pragma unroll
    for (int o = 32; o; o >>= 1) v += __shfl_xor(v, o);
    return v;
}
__device__ __forceinline__ int crow(int r, int hi) { return (r & 3) + 8 * (r >> 2) + 4 * hi; }
__device__ __forceinline__ void row_bp(int row, int& b, int& pos) {
    if (row < NCTX) { b = row >> 8; pos = row & 255; } else { const int r = row - NCTX; b = r >> 13; pos = CTXL + (r & (SEQ - 1)); }
}
__device__ __forceinline__ float silu_f(float x) { return x / (1.f + __expf(-x)); }
#define SBAR() __builtin_amdgcn_sched_barrier(0)

struct Params { const float* in[31]; float* out; unsigned char* ws; int ph_lo, ph_hi; };

struct RowsPlain  { const u16* base; long ld;
    __device__ __forceinline__ long off(int r) const { return (long)r * ld; }
    __device__ __forceinline__ const u16* kbase(int kt) const { return base + kt * 64; } };
struct RowsGather { const u16* base; long ld; const int* idx;
    __device__ __forceinline__ long off(int r) const { int t = idx[r]; t = t < 0 ? 0 : t; return (long)t * ld; }
    __device__ __forceinline__ const u16* kbase(int kt) const { return base + kt * 64; } };
struct RowsSplitK { const u16* b0; const u16* b1; long ld; int ks;
    __device__ __forceinline__ long off(int r) const { return (long)r * ld; }
    __device__ __forceinline__ const u16* kbase(int kt) const { return kt < ks ? b0 + kt * 64 : b1 + (kt - ks) * 64; } };

constexpr int GEMM_LDS = 2 * 384 * 128;

template <int WM, int WN, class AL, class BL, class EP>
__device__ __forceinline__ void gemm_tile(char* lds, const AL al, const BL bl, EP& ep, int brow, int bcol, int nk) {
    constexpr int BM = WM * 64, BN = WN * 64, STG = (BM + BN) * 128, NA = BM / 64, NB = BN / 64;
    const int tid = threadIdx.x, lane = tid & 63, wid = __builtin_amdgcn_readfirstlane(tid >> 6);
    const int wm = wid / WN, wn = wid % WN, r32 = lane & 31, hi = lane >> 5;
    long aoff[NA], boff[NB];
#pragma unroll
    for (int i = 0; i < NA; ++i) { const int r = (i * 8 + wid) * 8 + (lane >> 3); const int c = (lane & 7) ^ ((r >> 1) & 7); aoff[i] = al.off(brow + r) + c * 8; }
#pragma unroll
    for (int i = 0; i < NB; ++i) { const int r = (i * 8 + wid) * 8 + (lane >> 3); const int c = (lane & 7) ^ ((r >> 1) & 7); boff[i] = bl.off(bcol + r) + c * 8; }
    const int ldsw = wid * 1024 + lane * 16;
    int abase[2], bbase[2];
#pragma unroll
    for (int i = 0; i < 2; ++i) {
        const int ra = wm * 64 + i * 32 + r32; abase[i] = ra * 128 + ((hi ^ ((ra >> 1) & 7)) << 4);
        const int rb = wn * 64 + i * 32 + r32; bbase[i] = BM * 128 + rb * 128 + ((hi ^ ((rb >> 1) & 7)) << 4);
    }
    f32x16 acc[2][2];
#pragma unroll
    for (int i = 0; i < 2; ++i)
#pragma unroll
        for (int j = 0; j < 2; ++j) acc[i][j] = f32x16{};
#define GSTAGE(kt, buf) do { const u16* _ka = al.kbase(kt); const u16* _kb = bl.kbase(kt); char* _d = lds + (buf) * STG + ldsw; \
        _Pragma("unroll") for (int _i = 0; _i < NA; ++_i) __builtin_amdgcn_global_load_lds((const unsigned*)(_ka + aoff[_i]), (unsigned*)(_d + _i * 8192), 16, 0, 0); \
        _Pragma("unroll") for (int _i = 0; _i < NB; ++_i) __builtin_amdgcn_global_load_lds((const unsigned*)(_kb + boff[_i]), (unsigned*)(_d + BM * 128 + _i * 8192), 16, 0, 0); } while (0)
    __syncthreads();
    GSTAGE(0, 0);
    for (int kt = 0; kt < nk; ++kt) {
        asm volatile("s_waitcnt vmcnt(0)" ::: "memory");
        __syncthreads();
        if (kt + 1 < nk) GSTAGE(kt + 1, (kt + 1) & 1);
        const char* sb = lds + (kt & 1) * STG;
#pragma unroll
        for (int ks = 0; ks < 4; ++ks) {
            bf16x8 a0 = *(const bf16x8*)(sb + (abase[0] ^ (ks << 5)));
            bf16x8 a1 = *(const bf16x8*)(sb + (abase[1] ^ (ks << 5)));
            bf16x8 b0 = *(const bf16x8*)(sb + (bbase[0] ^ (ks << 5)));
            bf16x8 b1 = *(const bf16x8*)(sb + (bbase[1] ^ (ks << 5)));
            acc[0][0] = __builtin_amdgcn_mfma_f32_32x32x16_bf16(a0, b0, acc[0][0], 0, 0, 0);
            acc[0][1] = __builtin_amdgcn_mfma_f32_32x32x16_bf16(a0, b1, acc[0][1], 0, 0, 0);
            acc[1][0] = __builtin_amdgcn_mfma_f32_32x32x16_bf16(a1, b0, acc[1][0], 0, 0, 0);
            acc[1][1] = __builtin_amdgcn_mfma_f32_32x32x16_bf16(a1, b1, acc[1][1], 0, 0, 0);
        }
    }
#undef GSTAGE
    ep(acc, brow + wm * 64, bcol + wn * 64, lane);
}


constexpr int GSTG = 384 * 128;
template <class AL_, class BL_, class EP_> struct GTile { typedef EP_ EPT; AL_ al; BL_ bl; EP_ ep; int brow, bcol; };
__device__ __forceinline__ bool tile_seq(int i, int bx, int G, int nM, int nN, int& m, int& n) {
    const int s = (G == 256) ? (i * 8 + (bx & 7)) * 32 + (bx >> 3) : bx + i * G;
    if (s >= nM * nN) return false;
    const int full = (nM >> 2) * 4 * nN;
    if (s < full) { const int band = s / (4 * nN), rem = s - band * 4 * nN; n = rem >> 2; m = band * 4 + (rem & 3); }
    else { const int h = nM & 3, rem = s - full; n = rem / h; m = (nM & ~3) + rem - n * h; }
    return true;
}
template <class AL_, class BL_, class EP_> struct PlainTiles {
    typedef GTile<AL_, BL_, EP_> Tile; static constexpr bool EP_CONST = true;
    AL_ al; BL_ bl; EP_ ep; int mt0, nM, nN, bx, G;
    __device__ __forceinline__ bool get(int i, Tile& t) const {
        int m, n; if (!tile_seq(i, bx, G, nM, nN, m, n)) return false;
        t.al = al; t.bl = bl; t.ep = ep; t.brow = (mt0 + m) * 256; t.bcol = n * 128; return true; }
};
template <int WM, int WN, class P>
__device__ __forceinline__ void gemm_stream(char* lds, const P& prov, int nk) {
    constexpr int BM = WM * 64, BN = WN * 64, NA = BM / 64, NB = BN / 64;
    static_assert(NA + NB == 6, "the counted wait assumes six LDS-DMA loads per wave per K-step");
    const int tid = threadIdx.x, lane = tid & 63, wid = __builtin_amdgcn_readfirstlane(tid >> 6);
    const int wm = wid / WN, wn = wid % WN, r32 = lane & 31, hi = lane >> 5;
    typename P::Tile cur, nxt;
    if (!prov.get(0, cur)) return;
    unsigned aoff[NA], boff[NB], aoffn[NA], boffn[NB];
#define GOFFS(T, AO, BO) do { \
    _Pragma("unroll") for (int _i = 0; _i < NA; ++_i) { const int _r = (_i * 8 + wid) * 8 + (lane >> 3); const int _c = (lane & 7) ^ ((_r >> 1) & 7); AO[_i] = (unsigned)((T).al.off((T).brow + _r) + _c * 8); } \
    _Pragma("unroll") for (int _i = 0; _i < NB; ++_i) { const int _r = (_i * 8 + wid) * 8 + (lane >> 3); const int _c = (lane & 7) ^ ((_r >> 1) & 7); BO[_i] = (unsigned)((T).bl.off((T).bcol + _r) + _c * 8); } } while (0)
#define GSTAGE2(T, AO, BO, kt, slot) do { const u16* _ka = (T).al.kbase(kt); const u16* _kb = (T).bl.kbase(kt); char* _d = lds + (slot) * GSTG + ldsw; \
        _Pragma("unroll") for (int _i = 0; _i < NA; ++_i) __builtin_amdgcn_global_load_lds((const unsigned*)(_ka + AO[_i]), (unsigned*)(_d + _i * 8192), 16, 0, 0); \
        _Pragma("unroll") for (int _i = 0; _i < NB; ++_i) __builtin_amdgcn_global_load_lds((const unsigned*)(_kb + BO[_i]), (unsigned*)(_d + BM * 128 + _i * 8192), 16, 0, 0); } while (0)
    GOFFS(cur, aoff, boff);
    const int ldsw = wid * 1024 + lane * 16;
    int abase[2], bbase[2];
#pragma unroll
    for (int i = 0; i < 2; ++i) {
        const int ra = wm * 64 + i * 32 + r32; abase[i] = ra * 128 + ((hi ^ ((ra >> 1) & 7)) << 4);
        const int rb = wn * 64 + i * 32 + r32; bbase[i] = BM * 128 + rb * 128 + ((hi ^ ((rb >> 1) & 7)) << 4);
    }
    f32x16 acc[2][2];
#pragma unroll
    for (int i = 0; i < 2; ++i)
#pragma unroll
        for (int j = 0; j < 2; ++j) acc[i][j] = f32x16{};
    __syncthreads();
    GSTAGE2(cur, aoff, boff, 0, 0); GSTAGE2(cur, aoff, boff, 1, 1);
    int slot = 0; bool pendE = false; typename P::Tile::EPT pep = cur.ep; int pbrow = 0, pbcol = 0;
    for (int i = 0;; ++i) {
        const bool has_next = prov.get(i + 1, nxt);
        if (has_next) GOFFS(nxt, aoffn, boffn);
        for (int kt = 0; kt < nk; ++kt) {
            if ((kt + 1 < nk) || has_next) asm volatile("s_waitcnt vmcnt(6)" ::: "memory"); else asm volatile("s_waitcnt vmcnt(0)" ::: "memory");
            __builtin_amdgcn_s_barrier(); asm volatile("" ::: "memory");
            const int s2 = slot >= 1 ? slot - 1 : 2;
            if (kt + 2 < nk) GSTAGE2(cur, aoff, boff, kt + 2, s2); else if (has_next) GSTAGE2(nxt, aoffn, boffn, kt + 2 - nk, s2);
            if (kt == 0 && pendE) {
                if constexpr (P::EP_CONST) (void)prov.ep(acc, pbrow + wm * 64, pbcol + wn * 64, lane); else (void)pep(acc, pbrow + wm * 64, pbcol + wn * 64, lane);
                pendE = false;
#pragma unroll
                for (int a = 0; a < 2; ++a)
#pragma unroll
                    for (int b = 0; b < 2; ++b) acc[a][b] = f32x16{};
            }
            const char* sb = lds + slot * GSTG;
#pragma unroll
            for (int ks = 0; ks < 4; ++ks) {
                bf16x8 a0 = *(const bf16x8*)(sb + (abase[0] ^ (ks << 5)));
                bf16x8 a1 = *(const bf16x8*)(sb + (abase[1] ^ (ks << 5)));
                bf16x8 b0 = *(const bf16x8*)(sb + (bbase[0] ^ (ks << 5)));
                bf16x8 b1 = *(const bf16x8*)(sb + (bbase[1] ^ (ks << 5)));
                acc[0][0] = __builtin_amdgcn_mfma_f32_32x32x16_bf16(b0, a0, acc[0][0], 0, 0, 0);
                acc[0][1] = __builtin_amdgcn_mfma_f32_32x32x16_bf16(b1, a0, acc[0][1], 0, 0, 0);
                acc[1][0] = __builtin_amdgcn_mfma_f32_32x32x16_bf16(b0, a1, acc[1][0], 0, 0, 0);
                acc[1][1] = __builtin_amdgcn_mfma_f32_32x32x16_bf16(b1, a1, acc[1][1], 0, 0, 0);
            }
            slot = slot == 2 ? 0 : slot + 1;
        }
        if (!has_next) { (void)cur.ep(acc, cur.brow + wm * 64, cur.bcol + wn * 64, lane); break; }
        if constexpr (!P::EP_CONST) pep = cur.ep;
        pbrow = cur.brow; pbcol = cur.bcol; pendE = true;
        cur = nxt;
#pragma unroll
        for (int a = 0; a < NA; ++a) aoff[a] = aoffn[a];
#pragma unroll
        for (int b = 0; b < NB; ++b) boff[b] = boffn[b];
    }
    asm volatile("s_waitcnt vmcnt(0)" ::: "memory");
    __syncthreads();
#undef GOFFS
#undef GSTAGE2
}


template <int NF> __device__ __forceinline__ void rope_cs(int n, int i, float& cs, float& sn) {
    const int fi = i & (NF - 1); const float pos = (i < NF) ? (float)(n >> 6) : (float)(n & 63);
    const float invf = __builtin_amdgcn_exp2f(-(float)fi / (float)NF * 13.287712379549449f);
    const float ang = pos * invf; float rev = ang * 0.15915494309189535f; rev -= floorf(rev);
    cs = __builtin_amdgcn_cosf(rev); sn = __builtin_amdgcn_sinf(rev);
}
namespace pg8 {
constexpr int BM = 256, BK = 64, HALF = 128, HTB = HALF * BK * 2, STAGE_BYTES = 8 * HTB;
__device__ __forceinline__ int lds_byte(int r, int c) { const int st = (r >> 4) * 2 + (c >> 5), rr = r & 15, cc = c & 31, ob = rr * 64 + cc * 2; return st * 1024 + (ob ^ (((ob >> 9) & 1) << 5)); }
__device__ __forceinline__ void stage_rc(int b, int& R, int& C) { const int st = b / 1024, sb = b % 1024, swz = sb ^ (((sb >> 9) & 1) << 5); R = (st >> 1) * 16 + swz / 64; C = (st & 1) * 32 + (swz % 64) / 2; }
struct Unit { int pm, pn; };
template <class Epi, class Sched>
__device__ __forceinline__ void gemm_phase(char* lds, int lda, int K, const Sched& S, const Epi& E) {
    constexpr bool GA = Sched::GATHER;
    const int tid = threadIdx.x, wid = __builtin_amdgcn_readfirstlane(tid >> 6), lane = tid & 63, wr = wid >> 2, wc = wid & 3, fr = lane & 15, fq = lane >> 4;
    const int nt = K / BK;
    unsigned voffB[2], vbA[2], vc0[2], vc1[2], vn0[2], vn1[2]; int sR[2], sC[2];
#pragma unroll
    for (int i = 0; i < 2; ++i) { stage_rc(tid * 16 + i * 8192, sR[i], sC[i]); voffB[i] = (unsigned)(sR[i] * K + sC[i]) * 2u; vbA[i] = (unsigned)(sR[i] * lda + sC[i]) * 2u; }
    const size_t kstep = (size_t)(BK * 2), hstep = (size_t)HALF * K * 2, hstepA = (size_t)HALF * lda * 2;
    const unsigned ldsw = (unsigned)wid * 1024u;
    const int aoff = lds_byte(wr * 64 + fr, fq * 8), boff = lds_byte(wc * 32 + fr, fq * 8);
#define PG8_AOFFS(u, v0, v1) do { _Pragma("unroll") for (int _i = 0; _i < 2; ++_i) { \
        if constexpr (GA) { v0[_i] = (unsigned)S.arow(u, sR[_i]) * (unsigned)(lda * 2) + (unsigned)sC[_i] * 2u; v1[_i] = (unsigned)S.arow(u, HALF + sR[_i]) * (unsigned)(lda * 2) + (unsigned)sC[_i] * 2u; } \
        else { v0[_i] = vbA[_i] + (unsigned)(u).pm * (unsigned)(256 * lda * 2); v1[_i] = v0[_i] + (unsigned)hstepA; } } } while (0)
#define PG8_SA(b, h) (((b) * 2 + (h)) * HTB)
#define PG8_SB(b, h) ((4 + (b) * 2 + (h)) * HTB)
#define PG8_STAGE(bufoff, gbase, voff) do { _Pragma("unroll") for (int _i = 0; _i < 2; ++_i) \
        __builtin_amdgcn_global_load_lds((const unsigned*)((const char*)(gbase) + (voff)[_i]), (unsigned*)(lds + (bufoff) + ldsw + _i * 8192), 16, 0, 0); } while (0)
#define PG8_STA(bufoff, kt, h, nx) do { const char* _g = ((nx) ? nAb : cAb) + (size_t)(kt) * kstep; unsigned _v[2]; \
        _Pragma("unroll") for (int _i = 0; _i < 2; ++_i) _v[_i] = (nx) ? ((h) ? vn1[_i] : vn0[_i]) : ((h) ? vc1[_i] : vc0[_i]); PG8_STAGE(bufoff, _g, _v); } while (0)
#define PG8_LDA(dst, b, h) do { _Pragma("unroll") for (int m = 0; m < 4; ++m) _Pragma("unroll") for (int k = 0; k < 2; ++k) dst[m][k] = *(const bf16x8*)(lds + PG8_SA(b, h) + aoff + m * 2048 + k * 1024); } while (0)
#define PG8_LDB(dst, b, h) do { _Pragma("unroll") for (int n = 0; n < 2; ++n) _Pragma("unroll") for (int k = 0; k < 2; ++k) dst[n][k] = *(const bf16x8*)(lds + PG8_SB(b, h) + boff + n * 2048 + k * 1024); } while (0)
#define PG8_MMA(ai, bj, At, Bt_) do { __builtin_amdgcn_s_setprio(1); _Pragma("unroll") for (int m = 0; m < 4; ++m) _Pragma("unroll") for (int n = 0; n < 2; ++n) _Pragma("unroll") for (int k = 0; k < 2; ++k) \
        acc[ai][bj][m][n] = __builtin_amdgcn_mfma_f32_16x16x32_bf16(Bt_[n][k], At[m][k], acc[ai][bj][m][n], 0, 0, 0); __builtin_amdgcn_s_setprio(0); } while (0)
#define PG8_WAIT_V(n) asm volatile("s_waitcnt vmcnt(" #n ")" ::: "memory")
#define PG8_WAIT_L(n) asm volatile("s_waitcnt lgkmcnt(" #n ")" ::: "memory")
#define PG8_BAR __builtin_amdgcn_s_barrier()
#define PG8_SCHED __builtin_amdgcn_sched_barrier(0)
    Unit cur, nxt; int ui = 0;
    if (!S.next(0, cur)) return;
    f32x4 acc[2][2][4][2];
#pragma unroll
    for (int a = 0; a < 2; ++a)
#pragma unroll
        for (int b = 0; b < 2; ++b)
#pragma unroll
            for (int m = 0; m < 4; ++m)
#pragma unroll
                for (int n = 0; n < 2; ++n) acc[a][b][m][n] = (f32x4){0.f, 0.f, 0.f, 0.f};
    bf16x8 At[4][2], B0[2][2], B1[2][2];
    PG8_AOFFS(cur, vc0, vc1);
    const char* cB = (const char*)S.bbase(cur); const char* cAb = (const char*)S.abase(cur); const char* nAb = cAb;
    __syncthreads();
    PG8_STAGE(PG8_SB(0, 0), cB, voffB); PG8_STA(PG8_SA(0, 0), 0, 0, false); PG8_STAGE(PG8_SB(0, 1), cB + hstep, voffB); PG8_STA(PG8_SA(0, 1), 0, 1, false);
    if (wr == 1) PG8_BAR;
    PG8_WAIT_V(4); PG8_BAR;
    PG8_STAGE(PG8_SB(1, 0), cB + kstep, voffB); PG8_STA(PG8_SA(1, 0), 1, 0, false); PG8_STAGE(PG8_SB(1, 1), cB + hstep + kstep, voffB);
    PG8_WAIT_V(6); PG8_BAR;
    for (;;) {
        const bool has_next = S.next(ui + 1, nxt);
        const char* nB = cB;
        nAb = cAb;
        if (has_next) { PG8_AOFFS(nxt, vn0, vn1); nB = (const char*)S.bbase(nxt); nAb = (const char*)S.abase(nxt); }
        else {
#pragma unroll
            for (int i = 0; i < 2; ++i) { vn0[i] = vc0[i]; vn1[i] = vc1[i]; } }
#pragma unroll 1
        for (int t = 0; t < nt; t += 2) {
            const bool last = (t == nt - 2);
            const int k2 = last ? 0 : t + 2, k3 = k2 + 1;
            const char* b2 = last ? nB : cB + (size_t)(t + 2) * kstep; const char* b3 = b2 + kstep;
            PG8_LDB(B0, 0, 0); PG8_SCHED; PG8_LDA(At, 0, 0); PG8_STA(PG8_SA(1, 1), t + 1, 1, false);
            PG8_WAIT_L(8); PG8_BAR; PG8_WAIT_L(0); PG8_MMA(0, 0, At, B0); PG8_BAR; PG8_SCHED;
            PG8_LDB(B1, 0, 1); PG8_STAGE(PG8_SB(0, 0), b2, voffB);
            PG8_BAR; PG8_WAIT_L(0); PG8_MMA(0, 1, At, B1); PG8_BAR;
            PG8_LDA(At, 0, 1); PG8_STA(PG8_SA(0, 0), k2, 0, last);
            PG8_BAR; PG8_WAIT_L(0); PG8_MMA(1, 0, At, B0); PG8_BAR; PG8_SCHED;
            PG8_STAGE(PG8_SB(0, 1), b2 + hstep, voffB);
            PG8_WAIT_V(6); PG8_BAR; PG8_MMA(1, 1, At, B1); PG8_BAR;
            PG8_LDB(B0, 1, 0); PG8_SCHED; PG8_LDA(At, 1, 0); PG8_STA(PG8_SA(0, 1), k2, 1, last);
            PG8_WAIT_L(8); PG8_BAR; PG8_WAIT_L(0); PG8_MMA(0, 0, At, B0); PG8_BAR; PG8_SCHED;
            PG8_LDB(B1, 1, 1); PG8_STAGE(PG8_SB(1, 0), b3, voffB);
            PG8_BAR; PG8_WAIT_L(0); PG8_MMA(0, 1, At, B1); PG8_BAR;
            PG8_LDA(At, 1, 1); PG8_STA(PG8_SA(1, 0), k3, 0, last);
            PG8_BAR; PG8_WAIT_L(0); PG8_MMA(1, 0, At, B0); PG8_BAR; PG8_SCHED;
            PG8_STAGE(PG8_SB(1, 1), b3 + hstep, voffB);
            PG8_WAIT_V(6); PG8_BAR; PG8_MMA(1, 1, At, B1); PG8_BAR;
        }
        E(acc, cur, wr, wc, fr, fq);
        if (!has_next) break;
#pragma unroll
        for (int a = 0; a < 2; ++a)
#pragma unroll
            for (int b = 0; b < 2; ++b)
#pragma unroll
                for (int m = 0; m < 4; ++m)
#pragma unroll
                    for (int n = 0; n < 2; ++n) acc[a][b][m][n] = (f32x4){0.f, 0.f, 0.f, 0.f};
        cur = nxt; cB = nB; cAb = nAb; ++ui;
#pragma unroll
        for (int i = 0; i < 2; ++i) { vc0[i] = vn0[i]; vc1[i] = vn1[i]; }
    }
    PG8_WAIT_V(0);
    if (wr == 0) PG8_BAR;
    PG8_BAR;
#undef PG8_AOFFS
#undef PG8_STA
#undef PG8_SA
#undef PG8_SB
#undef PG8_STAGE
#undef PG8_LDA
#undef PG8_LDB
#undef PG8_MMA
#undef PG8_WAIT_V
#undef PG8_WAIT_L
#undef PG8_BAR
#undef PG8_SCHED
}
struct SeqOrder { static constexpr bool GATHER = false; const u16* A; const u16* Bt; int K, nM, nN, bx, G, mt0;
    __device__ __forceinline__ const u16* abase(const Unit&) const { return A; }
    __device__ __forceinline__ bool next(int i, Unit& u) const { const bool ok = tile_seq(i, bx, G, nM, nN, u.pm, u.pn); u.pm += mt0; return ok; }
    __device__ __forceinline__ const u16* bbase(const Unit& u) const { return Bt + (size_t)u.pn * 256 * K; }
    __device__ __forceinline__ int arow(const Unit& u, int r) const { return u.pm * 256 + r; } };
struct EpiGlaIn8 { u16* q; u16* k; u16* v; u16* g; float* z;
    __device__ __forceinline__ void operator()(const f32x4 (&acc)[2][2][4][2], const Unit& u, int wr, int wc, int fr, int fq) const {
#pragma unroll
        for (int bj = 0; bj < 2; ++bj)
#pragma unroll
            for (int n = 0; n < 2; ++n) { const int c0 = u.pn * 256 + bj * 128 + wc * 32 + n * 16, col = c0 + 4 * fq;
                if (c0 >= 3104) continue;
                u16* base; int ld, cc; float scl = 1.f;
                if (c0 < 512) { base = q; ld = 512; cc = col; scl = 0.08838834764831845f; } else if (c0 < 1024) { base = k; ld = 512; cc = col - 512; }
                else if (c0 < 2048) { base = v; ld = 1024; cc = col - 1024; } else if (c0 < 3072) { base = g; ld = 1024; cc = col - 2048; } else { base = nullptr; ld = 32; cc = col - 3072; }
#pragma unroll
                for (int ai = 0; ai < 2; ++ai)
#pragma unroll
                    for (int m = 0; m < 4; ++m) { const size_t row = (size_t)u.pm * 256 + ai * 128 + wr * 64 + m * 16 + fr; const f32x4 a = acc[ai][bj][m][n];
                        if (c0 < 3072) { u32x2 w = {cvtpk(a[0] * scl, a[1] * scl), cvtpk(a[2] * scl, a[3] * scl)}; *(u32x2*)(base + row * ld + cc) = w; }
                        else *(f32x4*)(z + row * 32 + cc) = a; } }
    } };
struct EpiDiffQKV8 { u16* Q; long kdelta; u16* V; float qscale;
    __device__ __forceinline__ void operator()(const f32x4 (&acc)[2][2][4][2], const Unit& u, int wr, int wc, int fr, int fq) const {
#pragma unroll
        for (int ai = 0; ai < 2; ++ai)
#pragma unroll
            for (int m = 0; m < 4; ++m) { int frr = fr; asm volatile("" : "+v"(frr));
                const int row = u.pm * 256 + ai * 128 + wr * 64 + m * 16 + frr; int b, pos; row_bp(row, b, pos); const bool lat = row >= NCTX; const int np = (row - NCTX) & (SEQ - 1);
                if (u.pn < 8) { const int region = u.pn >> 2, hh = (u.pn & 3) * 4 + wc; const float scl = region == 0 ? qscale : 1.f;
                    u16* o = Q + (long)region * kdelta + ((size_t)(b * 16 + hh) * KEYS + pos) * 64;
#pragma unroll
                    for (int n = 0; n < 2; ++n) { const int d0 = 16 * n + 4 * fq; const f32x4 t1 = acc[ai][0][m][n], t2 = acc[ai][1][m][n]; float o1[4], o2[4];
#pragma unroll
                        for (int j = 0; j < 4; ++j) { float cs = 1.f, sn = 0.f; if (lat) rope_cs<16>(np, d0 + j, cs, sn); o1[j] = (t1[j] * cs - t2[j] * sn) * scl; o2[j] = (t1[j] * sn + t2[j] * cs) * scl; }
                        u32x2 w1 = {cvtpk(o1[0], o1[1]), cvtpk(o1[2], o1[3])}, w2 = {cvtpk(o2[0], o2[1]), cvtpk(o2[2], o2[3])};
                        *(u32x2*)(o + d0) = w1; *(u32x2*)(o + 32 + d0) = w2; }
                } else {
#pragma unroll
                    for (int bj = 0; bj < 2; ++bj) { const int head = (u.pn - 8) * 2 + bj; u16* o = V + ((size_t)(b * 8 + head) * KEYS + pos) * 128 + wc * 32 + 4 * fq;
#pragma unroll
                        for (int n = 0; n < 2; ++n) { const f32x4 a = acc[ai][bj][m][n]; u32x2 w = {cvtpk(a[0], a[1]), cvtpk(a[2], a[3])}; *(u32x2*)(o + 16 * n) = w; } }
                } }
    } };
struct MoeAOrder { static constexpr bool GATHER = true; const u16* A; const int* tab; const int* rowtok; const u16* wgu; int nmt, bx, G;
    __device__ __forceinline__ const u16* abase(const Unit&) const { return A; }
    __device__ __forceinline__ bool next(int i, Unit& u) const { return tile_seq(i, bx, G, nmt, 8, u.pm, u.pn); }
    __device__ __forceinline__ const u16* bbase(const Unit& u) const {
        const int c = tab[32 + u.pm], g = c / 6, p = c - g * 6; const int elo = p < 3 ? 0 : (p < 5 ? 1 : 2), ehi = p < 3 ? p + 1 : (p < 5 ? p - 1 : 3);
        const int e = (u.pn >> 2) ? ehi : elo; return wgu + ((size_t)(g * 4 + e) * 1024 + (u.pn & 3) * 256) * 1024; }
    __device__ __forceinline__ int arow(const Unit& u, int r) const { const int t = rowtok[u.pm * 256 + r]; return t < 0 ? 0 : t; } };
struct EpiMoeA8 { u16* act; const float* roww;
    __device__ __forceinline__ void operator()(const f32x4 (&acc)[2][2][4][2], const Unit& u, int wr, int wc, int fr, int fq) const {
        const int half = u.pn >> 2, cb = half * 512 + (u.pn & 3) * 128 + wc * 32 + 4 * fq;
#pragma unroll
        for (int ai = 0; ai < 2; ++ai)
#pragma unroll
            for (int m = 0; m < 4; ++m) { const size_t row = (size_t)u.pm * 256 + ai * 128 + wr * 64 + m * 16 + fr; const float w = roww[2 * row + half];
#pragma unroll
                for (int n = 0; n < 2; ++n) { const f32x4 gt = acc[ai][0][m][n], up = acc[ai][1][m][n]; float v[4];
#pragma unroll
                    for (int j = 0; j < 4; ++j) v[j] = silu_f(gt[j]) * up[j] * w;
                    u32x2 pk = {cvtpk(v[0], v[1]), cvtpk(v[2], v[3])}; *(u32x2*)(act + row * 1024 + cb + 16 * n) = pk; } }
    } };
struct MlaUpOrder { static constexpr bool GATHER = false; const u16* CN; const u16* wuq; const u16* wukv; int bx, G;
    __device__ __forceinline__ bool next(int i, Unit& u) const { return tile_seq(i, bx, G, 132, 14, u.pm, u.pn); }
    __device__ __forceinline__ const u16* abase(const Unit& u) const { return u.pn < 6 ? CN : CN + 256; }
    __device__ __forceinline__ const u16* bbase(const Unit& u) const { return u.pn < 6 ? wuq + (size_t)u.pn * 256 * 256 : wukv + (size_t)(u.pn - 6) * 256 * 256; }
    __device__ __forceinline__ int arow(const Unit& u, int r) const { return u.pm * 256 + r; } };
struct EpiMlaUp8 { u16* Q; u16* Kn; long vdelta; float qscale;
    __device__ __forceinline__ void operator()(const f32x4 (&acc)[2][2][4][2], const Unit& u, int wr, int wc, int fr, int fq) const {
#pragma unroll
        for (int ai = 0; ai < 2; ++ai)
#pragma unroll
            for (int m = 0; m < 4; ++m) { int frr = fr; asm volatile("" : "+v"(frr));
                const int row = u.pm * 256 + ai * 128 + wr * 64 + m * 16 + frr; int b, pos; row_bp(row, b, pos); const bool lat = row >= NCTX; const int np = (row - NCTX) & (SEQ - 1);
                if (u.pn < 6) {
#pragma unroll
                    for (int bj = 0; bj < 2; ++bj) { const int sb = 8 * u.pn + 4 * bj + wc, head = sb / 3, part = sb - head * 3;
                        f32x4 v0 = acc[ai][bj][m][0] * qscale, v1 = acc[ai][bj][m][1] * qscale;
                        if (part == 2 && lat) {
#pragma unroll
                            for (int j = 0; j < 4; ++j) { float cs, sn; rope_cs<8>(np, 4 * fq + j, cs, sn); const float t1 = v0[j], t2 = v1[j]; v0[j] = t1 * cs - t2 * sn; v1[j] = t1 * sn + t2 * cs; } }
                        u16* o = Q + ((size_t)(b * 16 + head) * KEYS + pos) * 96 + part * 32 + 4 * fq;
                        u32x2 w0 = {cvtpk(v0[0], v0[1]), cvtpk(v0[2], v0[3])}, w1 = {cvtpk(v1[0], v1[1]), cvtpk(v1[2], v1[3])}; *(u32x2*)o = w0; *(u32x2*)(o + 16) = w1; }
                } else {
#pragma unroll
                    for (int bj = 0; bj < 2; ++bj) { const int head = (u.pn - 6) * 2 + bj; u16* o = Kn + (long)(wc >> 1) * vdelta + ((size_t)(b * 16 + head) * KEYS + pos) * 64 + (wc & 1) * 32 + 4 * fq;
#pragma unroll
                        for (int n = 0; n < 2; ++n) { const f32x4 a = acc[ai][bj][m][n]; u32x2 w = {cvtpk(a[0], a[1]), cvtpk(a[2], a[3])}; *(u32x2*)(o + 16 * n) = w; } }
                } }
    } };
}

template <int DK, int DV> struct AttnCfg {
    static constexpr int NKB = DK / 32, NVB = DV / 32, ND0 = DK / 16;
    static constexpr int KBYTES = 64 * DK * 2, VBYTES = 64 * DV * 2;
    static constexpr int LDS = 2 * KBYTES + 2 * VBYTES + NWAVE * 64 * 4;
};
constexpr float ATT_THR = 8.f;

__device__ __forceinline__ void partialSM(f32x16& p0, f32x16& p1, float& m_reg, float& mn, float& alpha) {
    float pmax = p0[0];
#pragma unroll
    for (int r = 1; r < 16; ++r) pmax = fmaxf(pmax, p0[r]);
#pragma unroll
    for (int r = 0; r < 16; ++r) pmax = fmaxf(pmax, p1[r]);
    { auto rr = __builtin_amdgcn_permlane32_swap(__float_as_uint(pmax), __float_as_uint(pmax), false, false);
      pmax = fmaxf(__uint_as_float(rr[0]), __uint_as_float(rr[1])); }
    if (__builtin_expect(__all(pmax - m_reg <= ATT_THR), 1)) { mn = m_reg; alpha = 1.f; }
    else { mn = fmaxf(m_reg, pmax); alpha = __builtin_amdgcn_exp2f(m_reg - mn); m_reg = mn; }
#pragma unroll
    for (int r = 0; r < 16; ++r) p0[r] = p0[r] - mn;
#pragma unroll
    for (int r = 0; r < 16; ++r) p1[r] = p1[r] - mn;
#pragma unroll
    for (int r = 0; r < 16; ++r) p0[r] = __builtin_amdgcn_exp2f(p0[r]);
}
#define PK4(P, BASE, OUT) do { unsigned a0 = cvtpk(P[BASE + 0], P[BASE + 1]), a1 = cvtpk(P[BASE + 2], P[BASE + 3]);   \
    unsigned b0 = cvtpk(P[BASE + 4], P[BASE + 5]), b1 = cvtpk(P[BASE + 6], P[BASE + 7]);                              \
    auto r0 = __builtin_amdgcn_permlane32_swap(a0, b0, false, false); auto r1 = __builtin_amdgcn_permlane32_swap(a1, b1, false, false); \
    u32x4 w = {r0[0], r1[0], r0[1], r1[1]}; OUT = *reinterpret_cast<bf16x8*>(&w); } while (0)
__device__ __forceinline__ void finishSM(f32x16& p0, f32x16& p1, float alpha, float& l_reg, bf16x8& pa0, bf16x8& pa1, bf16x8& pa2, bf16x8& pa3) {
#pragma unroll
    for (int r = 0; r < 16; ++r) p1[r] = __builtin_amdgcn_exp2f(p1[r]);
    float ps = 0;
#pragma unroll
    for (int r = 0; r < 16; ++r) ps += p0[r];
#pragma unroll
    for (int r = 0; r < 16; ++r) ps += p1[r];
    { auto rr = __builtin_amdgcn_permlane32_swap(__float_as_uint(ps), __float_as_uint(ps), false, false);
      ps = __uint_as_float(rr[0]) + __uint_as_float(rr[1]); }
    l_reg = l_reg * alpha + ps;
    PK4(p0, 0, pa0); PK4(p0, 8, pa1); PK4(p1, 0, pa2); PK4(p1, 8, pa3);
}
template <bool FIRST, bool KEEPN>
__device__ __forceinline__ void psm_rel(f32x16& p0, f32x16& p1, float& m_reg, f32x16& negm, float& alpha) {
    float pmax = fmaxf(p0[0], p1[0]);
#pragma unroll
    for (int r = 1; r < 16; ++r) pmax = fmaxf(pmax, fmaxf(p0[r], p1[r]));
    { auto rr = __builtin_amdgcn_permlane32_swap(__float_as_uint(pmax), __float_as_uint(pmax), false, false);
      pmax = fmaxf(__uint_as_float(rr[0]), __uint_as_float(rr[1])); }
    alpha = 1.f;
    if (FIRST || !__builtin_expect(__all(pmax <= ATT_THR), 1)) {
        const float d = FIRST ? pmax : fmaxf(pmax, 0.f);
        if (!FIRST) alpha = __builtin_amdgcn_exp2f(-d);
        m_reg += d;
#pragma unroll
        for (int r = 0; r < 16; ++r) { p0[r] -= d; p1[r] -= d; if (KEEPN) negm[r] = -m_reg; }
    }
#pragma unroll
    for (int r = 0; r < 16; ++r) p0[r] = __builtin_amdgcn_exp2f(p0[r]);
}
__device__ __forceinline__ bf16x8 pack8(const f32x16& p, int base) {
    u32x4 w = {cvtpk(p[base], p[base + 1]), cvtpk(p[base + 2], p[base + 3]), cvtpk(p[base + 4], p[base + 5]), cvtpk(p[base + 6], p[base + 7])};
    return *reinterpret_cast<bf16x8*>(&w);
}
__device__ __forceinline__ void fsm_rel(f32x16& p0, f32x16& p1, bf16x8& pa0, bf16x8& pa1, bf16x8& pa2, bf16x8& pa3) {
#pragma unroll
    for (int r = 0; r < 16; ++r) p1[r] = __builtin_amdgcn_exp2f(p1[r]);
    pa0 = pack8(p0, 0); pa1 = pack8(p0, 8); pa2 = pack8(p1, 0); pa3 = pack8(p1, 8);
}
__device__ __forceinline__ int k_lds_off(int row, int blk, int chunk) { return blk * 4096 + row * 64 + ((chunk ^ ((row >> 2) & 3)) << 4); }
template <int ND0>
__device__ __forceinline__ void qkt(f32x16& p0, f32x16& p1, const char* Ks, const bf16x8* qr, int r32, int hi, const f32x16& cinit) {
    p0 = cinit; p1 = cinit;
#pragma unroll
    for (int d0 = 0; d0 < ND0; ++d0) {
        const int ch = (d0 & 1) * 2 + hi;
        bf16x8 b0 = *reinterpret_cast<const bf16x8*>(Ks + k_lds_off(r32, d0 >> 1, ch));
        bf16x8 b1 = *reinterpret_cast<const bf16x8*>(Ks + k_lds_off(32 + r32, d0 >> 1, ch));
        p0 = __builtin_amdgcn_mfma_f32_32x32x16_bf16(b0, qr[d0], p0, 0, 0, 0);
        p1 = __builtin_amdgcn_mfma_f32_32x32x16_bf16(b1, qr[d0], p1, 0, 0, 0);
    }
}
template <int NVB, bool SWAP = true> __device__ __forceinline__ int v_st(int k, int c) {
    const int kk = SWAP ? ((k & ~0xC) | ((k & 4) << 1) | ((k & 8) >> 1)) : k;
    return ((kk >> 3) * NVB + (c >> 5)) * 512 + ((kk & 7) * 32 + (c & 31)) * 2;
}
__device__ __forceinline__ int v_rd_base(int lane) { return ((lane & 3) << 3) | (((lane >> 2) & 3) << 6) | (((lane >> 4) & 1) << 5) | (((lane >> 5) & 1) << 8); }
template <int OFF> __device__ __forceinline__ s16x4 tr_read(int vb) {
    return __builtin_amdgcn_ds_read_tr16_b64_v4i16((LAS s16x4*)(unsigned)(vb + OFF));
}
#define PKV(L, H) (bf16x8){L[0], L[1], L[2], L[3], H[0], H[1], H[2], H[3]}
template <int D0, int NVB> __device__ __forceinline__ void pv_one(f32x16& od, int vb, bf16x8 pa0, bf16x8 pa1, bf16x8 pa2, bf16x8 pa3) {
    constexpr int KS = 2 * NVB * 512, HF = NVB * 512, B0 = D0 * 512;
    const s16x4 l0 = tr_read<B0 + 0 * KS>(vb), h0 = tr_read<B0 + 0 * KS + HF>(vb), l1 = tr_read<B0 + 1 * KS>(vb), h1 = tr_read<B0 + 1 * KS + HF>(vb);
    const s16x4 l2 = tr_read<B0 + 2 * KS>(vb), h2 = tr_read<B0 + 2 * KS + HF>(vb), l3 = tr_read<B0 + 3 * KS>(vb), h3 = tr_read<B0 + 3 * KS + HF>(vb);
    od = __builtin_amdgcn_mfma_f32_32x32x16_bf16(pa0, PKV(l0, h0), od, 0, 0, 0);
    od = __builtin_amdgcn_mfma_f32_32x32x16_bf16(pa1, PKV(l1, h1), od, 0, 0, 0);
    od = __builtin_amdgcn_mfma_f32_32x32x16_bf16(pa2, PKV(l2, h2), od, 0, 0, 0);
    od = __builtin_amdgcn_mfma_f32_32x32x16_bf16(pa3, PKV(l3, h3), od, 0, 0, 0);
}
template <int NVB> __device__ __forceinline__ void pv_all(f32x16* o, int vb, bf16x8 pa0, bf16x8 pa1, bf16x8 pa2, bf16x8 pa3) {
    pv_one<0, NVB>(o[0], vb, pa0, pa1, pa2, pa3); pv_one<1, NVB>(o[1], vb, pa0, pa1, pa2, pa3);
    if constexpr (NVB == 4) { pv_one<2, NVB>(o[2], vb, pa0, pa1, pa2, pa3); pv_one<3, NVB>(o[3], vb, pa0, pa1, pa2, pa3); }
}

template <int DK, int DV>
__device__ __forceinline__ void attn_item(const u16* __restrict__ Qb, const u16* __restrict__ Ka, const u16* __restrict__ Kb, const u16* __restrict__ Vh,
                                          int nkeys, u16* __restrict__ Ob, long ldo, char* lds) {
    using C = AttnCfg<DK, DV>;
    constexpr int NVB = C::NVB, ND0 = C::ND0, NKI = (DK / 32) * 4, NVI = DV / 8, NI = NKI + NVI;
    static_assert(NI <= 24, "three LDS-DMA pieces per wave per tile");
    const int tid = threadIdx.x, wid = __builtin_amdgcn_readfirstlane(tid >> 6), lane = tid & 63, r32 = lane & 31, hi = lane >> 5;
    char* K_lds = lds; char* V_lds = lds + 3 * C::KBYTES;
    float* al_l = (float*)(lds + 3 * C::KBYTES + 3 * C::VBYTES) + wid * 32;
    float m_reg = 0.f; f32x16 o[NVB], ol, negm; bf16x8 qr[ND0];
#pragma unroll
    for (int d = 0; d < NVB; ++d) o[d] = f32x16{};
    ol = f32x16{}; negm = f32x16{};
    const u32x4 ones_w = {0x3F803F80u, 0x3F803F80u, 0x3F803F80u, 0x3F803F80u}; const bf16x8 ones = *reinterpret_cast<const bf16x8*>(&ones_w);
    const u16* Qw = Qb + (long)(wid * 32 + r32) * DK + hi * 8;
#pragma unroll
    for (int d0 = 0; d0 < ND0; ++d0) qr[d0] = *reinterpret_cast<const bf16x8*>(Qw + d0 * 16);
    const u16* src[3]; int dst[3], stp[3]; bool isk[3];
#pragma unroll
    for (int i = 0; i < 3; ++i) { int q = wid + 8 * i; if (q >= NI) q -= 8;
        if (q < NKI) { const int blk = q >> 2, part = q & 3, row = 16 * part + (lane >> 2), c = (lane & 3) ^ ((row >> 2) & 3);
            isk[i] = true; dst[i] = blk * 4096 + part * 1024 + lane * 16;
            if (DK == 96 && blk == 2) { src[i] = Kb + row * 32 + c * 8; stp[i] = 64 * 32; } else { src[i] = Ka + row * 64 + blk * 32 + c * 8; stp[i] = 64 * 64; } }
        else { const int v = q - NKI; int key, col;
            if (NVB == 2) { key = 8 * v + ((lane & 31) >> 2); col = (lane >> 5) * 32 + (lane & 3) * 8; }
            else { key = 8 * (v >> 1) + ((lane & 31) >> 2); col = ((v & 1) * 2 + (lane >> 5)) * 32 + (lane & 3) * 8; }
            isk[i] = false; dst[i] = 3 * C::KBYTES + v * 1024 + lane * 16; src[i] = Vh + key * DV + col; stp[i] = 64 * DV; } }
    const int NT = nkeys / 64;
#define LOADG(kt, vt) do { const int _kt = (kt) < NT ? (kt) : NT - 1, _vt = (vt) < NT ? (vt) : NT - 1; const int _ks = _kt % 3, _vs = _vt % 3; \
        _Pragma("unroll") for (int _i = 0; _i < 3; ++_i) { const int _t = isk[_i] ? _kt : _vt; const int _so = isk[_i] ? _ks * C::KBYTES : _vs * C::VBYTES; \
            __builtin_amdgcn_global_load_lds((const unsigned*)(src[_i] + (long)_t * stp[_i]), (unsigned*)(lds + _so + dst[_i]), 16, 0, 0); } } while (0)
#define RESC(a) do { if (__any((a) < 1.f)) { if (hi == 0) al_l[r32] = (a); asm volatile("s_waitcnt lgkmcnt(0)" ::: "memory"); \
        _Pragma("unroll") for (int r = 0; r < 16; ++r) { const float _f = al_l[crow(r, hi)]; ol[r] *= _f; _Pragma("unroll") for (int d = 0; d < NVB; ++d) o[d][r] *= _f; } } } while (0)
#define PVL(vb) do { pv_all<NVB>(o, (vb), pa0, pa1, pa2, pa3); \
        ol = __builtin_amdgcn_mfma_f32_32x32x16_bf16(pa0, ones, ol, 0, 0, 0); ol = __builtin_amdgcn_mfma_f32_32x32x16_bf16(pa1, ones, ol, 0, 0, 0); \
        ol = __builtin_amdgcn_mfma_f32_32x32x16_bf16(pa2, ones, ol, 0, 0, 0); ol = __builtin_amdgcn_mfma_f32_32x32x16_bf16(pa3, ones, ol, 0, 0, 0); } while (0)
#define NEGM() do { if constexpr (DV == 128) { _Pragma("unroll") for (int r = 0; r < 16; ++r) negm[r] = -m_reg; } } while (0)
#define TILEBAR(n) do { if ((n) == 3) asm volatile("s_waitcnt vmcnt(3)" ::: "memory"); else asm volatile("s_waitcnt vmcnt(0)" ::: "memory"); __builtin_amdgcn_s_barrier(); asm volatile("" ::: "memory"); } while (0)
    const int vrb = (int)(uintptr_t)V_lds + v_rd_base(lane);
    f32x16 pA0, pA1, pB0, pB1; float alA, alB; bf16x8 pa0, pa1, pa2, pa3;
    __syncthreads();
    LOADG(0, 0); LOADG(1, 0);
    TILEBAR(3); LOADG(2, 1);
    qkt<ND0>(pA0, pA1, K_lds, qr, r32, hi, negm); psm_rel<true, DV != 128>(pA0, pA1, m_reg, negm, alA);
    int ks = 1, vs = 0;
    for (int j = 1; j + 1 < NT; j += 2) {
        TILEBAR(3); LOADG(j + 2, j + 1);
        SBAR(); NEGM(); qkt<ND0>(pB0, pB1, K_lds + ks * C::KBYTES, qr, r32, hi, negm);
        fsm_rel(pA0, pA1, pa0, pa1, pa2, pa3);
        PVL(vrb + vs * C::VBYTES); psm_rel<false, DV != 128>(pB0, pB1, m_reg, negm, alB);
        RESC(alB);
        ks = ks == 2 ? 0 : ks + 1; vs = vs == 2 ? 0 : vs + 1;
        TILEBAR(3); LOADG(j + 3, j + 2);
        SBAR(); NEGM(); qkt<ND0>(pA0, pA1, K_lds + ks * C::KBYTES, qr, r32, hi, negm);
        fsm_rel(pB0, pB1, pa0, pa1, pa2, pa3);
        PVL(vrb + vs * C::VBYTES); psm_rel<false, DV != 128>(pA0, pA1, m_reg, negm, alA);
        RESC(alA);
        ks = ks == 2 ? 0 : ks + 1; vs = vs == 2 ? 0 : vs + 1;
    }
    TILEBAR(3);
    SBAR(); NEGM(); qkt<ND0>(pB0, pB1, K_lds + ks * C::KBYTES, qr, r32, hi, negm);
    fsm_rel(pA0, pA1, pa0, pa1, pa2, pa3); SBAR();
    PVL(vrb + vs * C::VBYTES); psm_rel<false, DV != 128>(pB0, pB1, m_reg, negm, alB);
    RESC(alB);
    vs = vs == 2 ? 0 : vs + 1;
    TILEBAR(0);
    fsm_rel(pB0, pB1, pa0, pa1, pa2, pa3); SBAR();
    PVL(vrb + vs * C::VBYTES);
    u16* Ow = Ob + (long)(wid * 32) * ldo;
#pragma unroll
    for (int r = 0; r < 16; ++r) { const int orow = crow(r, hi); const float rl = __builtin_amdgcn_rcpf(ol[r]);
#pragma unroll
        for (int d0 = 0; d0 < NVB; ++d0) Ow[(long)orow * ldo + d0 * 32 + r32] = f2bf(o[d0][r] * rl); }
#undef LOADG
#undef RESC
#undef PVL
#undef NEGM
#undef TILEBAR
}

struct Frame {
    const Params* p; unsigned char* ws; char* lds; float* out; int G, bx;
    __device__ __forceinline__ const float* in(int i) const { return p->in[i]; }
    template <class T> __device__ __forceinline__ T* W(size_t off) const { return (T*)(ws + off); }
};
constexpr int LDS_BYTES = 163840;
constexpr int LDS_BARW  = LDS_BYTES - 16;
constexpr int LDS_TAB   = 147456;

struct ResCtx { const char* src0; long srcd; char* dst0; long dstd; const float* mods;
    __device__ __forceinline__ const float* row_in(int row, int) const { return (const float*)(src0 + (row >= NCTX ? srcd : 0L) + (long)row * (DM * 4)); }
    __device__ __forceinline__ float* row_out(int row) const { return (float*)(dst0 + (row >= NCTX ? dstd : 0L) + (long)row * (DM * 4)); }
    __device__ __forceinline__ const float* mod(int li, int row, int which) const {
        const int mr = row < NCTX ? 4 : ((row - NCTX) >> 13); return mods + (size_t)(li * 5 + mr) * 6144 + which * 1024; }
};
__device__ __forceinline__ ResCtx res_ctx(const Frame& F, bool first = false) {
    const char* sc = (const char*)(first ? F.in(2) : (const float*)F.W<float>(WS_XC)); const char* sl = (const char*)(first ? F.in(0) : (const float*)F.out) - (long)NCTX * DM * 4;
    char* dc = (char*)F.W<float>(WS_XC); char* dl = (char*)F.out - (long)NCTX * DM * 4;
    return ResCtx{sc, (long)(sl - sc), dc, (long)(dl - dc), F.W<float>(WS_MODS)};
}
__device__ __forceinline__ const float* xrow_in(const Frame& F, int row, bool first) { return res_ctx(F, first).row_in(row, 0); }
__device__ __forceinline__ float* xrow_out(const Frame& F, int row) { return res_ctx(F).row_out(row); }
__device__ __forceinline__ const float* mod_vec(const Frame& F, int li, int row, int which) { return res_ctx(F).mod(li, row, which); }

struct EpiResid8 { ResCtx F; int li;
    __device__ __forceinline__ void operator()(const f32x4 (&acc)[2][2][4][2], const pg8::Unit& u, int wr, int wc, int fr, int fq) const {
#pragma unroll
        for (int ai = 0; ai < 2; ++ai)
#pragma unroll
            for (int m = 0; m < 4; ++m) { int frr = fr; asm volatile("" : "+v"(frr));
                const int row = u.pm * 256 + ai * 128 + wr * 64 + m * 16 + frr, c0 = u.pn * 256 + wc * 32 + 4 * fq;
                const float* xi = F.row_in(row, 0) + c0; float* xo = F.row_out(row) + c0; const float* gt = F.mod(li, row, 2) + c0;
#pragma unroll
                for (int bj = 0; bj < 2; ++bj)
#pragma unroll
                    for (int n = 0; n < 2; ++n) { const int c = bj * 128 + n * 16; const f32x4 x = *(const f32x4*)(xi + c), g = *(const f32x4*)(gt + c), a = acc[ai][bj][m][n];
                        f32x4 o = {x[0] + g[0] * a[0], x[1] + g[1] * a[1], x[2] + g[2] * a[2], x[3] + g[3] * a[3]}; *(f32x4*)(xo + c) = o; } }
    } };

__device__ __forceinline__ void p0_mods(const Frame& F) {
    float* s = (float*)F.lds; float* red = s + 5 * 1024;
    const int tid = threadIdx.x, lane = tid & 63, wid = tid >> 6;
    for (int i = tid; i < 5 * 1024; i += NTHR) { const int r = i >> 10, k = i & 1023; const float v = r < 4 ? F.in(1)[r * 1024 + k] : F.in(3)[k]; s[i] = silu_f(v); }
    __syncthreads();
    for (int item = F.bx; item < DEPTH * 96; item += F.G) {
        const int li = item / 96, cg = item % 96;
        const float* w = F.in(4) + (size_t)li * 1024 * 6144 + cg * 64 + lane;
        float a0 = 0, a1 = 0, a2 = 0, a3 = 0, a4 = 0;
        const int k0 = wid * 128;
#pragma unroll 8
        for (int k = k0; k < k0 + 128; ++k) {
            const float wv = w[(size_t)k * 6144];
            a0 += s[k] * wv; a1 += s[1024 + k] * wv; a2 += s[2048 + k] * wv; a3 += s[3072 + k] * wv; a4 += s[4096 + k] * wv;
        }
        red[(wid * 5 + 0) * 64 + lane] = a0; red[(wid * 5 + 1) * 64 + lane] = a1; red[(wid * 5 + 2) * 64 + lane] = a2;
        red[(wid * 5 + 3) * 64 + lane] = a3; red[(wid * 5 + 4) * 64 + lane] = a4;
        __syncthreads();
        if (tid < 320) { const int r = tid >> 6, l = tid & 63; float sum = 0;
#pragma unroll
            for (int ww = 0; ww < 8; ++ww) sum += red[(ww * 5 + r) * 64 + l];
            F.W<float>(WS_MODS)[(size_t)(li * 5 + r) * 6144 + cg * 64 + l] = sum + F.in(5)[li * 6144 + cg * 64 + l]; }
        __syncthreads();
    }
}
__device__ __forceinline__ void p0_rope(const Frame& F) {
    const int gt = F.bx * NTHR + threadIdx.x, gn = F.G * NTHR;
    float* ca = F.W<float>(WS_ROPEA); float* sa = ca + SEQ * 16; float* cb = F.W<float>(WS_ROPEB); float* sb = cb + SEQ * 32;
    for (int i = gt; i < SEQ * 48; i += gn) {
        int n, f, nf; float* co; float* so; int idx;
        if (i < SEQ * 16) { n = i >> 4; f = i & 15; nf = 8; co = ca; so = sa; idx = i; }
        else { const int j = i - SEQ * 16; n = j >> 5; f = j & 31; nf = 16; co = cb; so = sb; idx = j; }
        const int fi = f % nf; const float pos = (f < nf) ? (float)(n >> 6) : (float)(n & 63);
        const float invf = exp2f(-(float)fi / (float)nf * 13.287712379549449f);
        const float ang = pos * invf;
        float rev = ang * 0.15915494309189535f; rev -= floorf(rev);
        co[idx] = __builtin_amdgcn_cosf(rev); so[idx] = __builtin_amdgcn_sinf(rev);
    }
}
__device__ __forceinline__ int rowmap(int n, int kind) {
    if (kind == 0) return n;
    if (kind == 3) { if (n >= 2048) return n; const int hh = n >> 6, dim = n & 63; return (hh >> 2) * 256 + (dim >> 5) * 128 + (hh & 3) * 32 + (dim & 31); }
    return (n >> 7) * 256 + (kind == 2 ? 128 : 0) + (n & 127);
}
__device__ __forceinline__ void cvt_group(float* tl, const float* src, int K, int N, u16* dst, int ldd, int kind, int t0) {
    int tid = threadIdx.x; asm volatile("" : "+v"(tid));
    const int tn = (N + 63) / 64, nt = (K / 64) * tn;
    f32x4 v[4][2];
#pragma unroll
    for (int u = 0; u < 4; ++u) { const int t = t0 + u; const int k0 = (t / tn) * 64, n0 = (t % tn) * 64;
#pragma unroll
        for (int ps = 0; ps < 2; ++ps) { const int k = (tid >> 4) + ps * 32, n4 = (tid & 15) * 4;
            if (t < nt && n0 + n4 < N) v[u][ps] = *(const f32x4*)(src + (size_t)(k0 + k) * N + n0 + n4); else v[u][ps] = f32x4{0.f, 0.f, 0.f, 0.f}; } }
#pragma unroll
    for (int u = 0; u < 4; ++u)
#pragma unroll
        for (int ps = 0; ps < 2; ++ps) { const int k = (tid >> 4) + ps * 32, n4 = (tid & 15) * 4; float* d = tl + u * 4160 + k * 65 + n4;
            d[0] = v[u][ps][0]; d[1] = v[u][ps][1]; d[2] = v[u][ps][2]; d[3] = v[u][ps][3]; }
    __syncthreads();
#pragma unroll
    for (int u = 0; u < 4; ++u) { const int t = t0 + u; const int k0 = (t / tn) * 64, n0 = (t % tn) * 64;
        const int n = tid >> 3, kc = (tid & 7) * 8; const float* sr = tl + u * 4160;
        if (t < nt && n0 + n < N) { u32x4 w;
#pragma unroll
            for (int i = 0; i < 4; ++i) w[i] = cvtpk(sr[(kc + 2 * i) * 65 + n], sr[(kc + 2 * i + 1) * 65 + n]);
            *(u32x4*)(dst + (size_t)rowmap(n0 + n, kind) * ldd + k0 + kc) = w; } }
    __syncthreads();
}
__device__ __forceinline__ void cvt_t(const Frame& F, const float* src, int K, int N, u16* dst, int ldd, int kind, int rot) {
    const int tn = (N + 63) / 64, nt = (K / 64) * tn;
    for (int t0 = ((F.bx + rot) % F.G) * 4; t0 < nt; t0 += F.G * 4) cvt_group((float*)F.lds, src, K, N, dst, ldd, kind, t0);
}
constexpr int MOE_CVT_GROUPS = 16 * 3 * 32, LDS_CVT = 81920;
__device__ __forceinline__ void moe_cvt_group(const Frame& F, int li, int gidx) {
    if (gidx >= MOE_CVT_GROUPS) return;
    const int mat = gidx >> 5, g = gidx & 31, e = mat / 3, kind = mat - e * 3; float* tl = (float*)(F.lds + LDS_CVT);
    if (kind == 0) cvt_group(tl, F.in(27) + (size_t)(li * 16 + e) * 1024 * 512, 1024, 512, F.W<u16>(WS_MOEW) + (size_t)e * 1024 * 1024, 1024, 1, g * 4);
    else if (kind == 1) cvt_group(tl, F.in(28) + (size_t)(li * 16 + e) * 1024 * 512, 1024, 512, F.W<u16>(WS_MOEW) + (size_t)e * 1024 * 1024, 1024, 2, g * 4);
    else cvt_group(tl, F.in(29) + (size_t)(li * 16 + e) * 512 * 1024, 512, 1024, F.W<u16>(WS_MOEW + MOE_WGU_BYTES) + (size_t)e * 1024 * 512, 512, 0, g * 4);
}
__device__ __forceinline__ void p0_weights(const Frame& F) {
    int rot = 0;
    for (int j = 0; j < 2; ++j) {
        cvt_t(F, F.in(8) + (size_t)j * 1024 * 544, 1024, 544, F.W<u16>(WS_WDQKV) + (size_t)j * 640 * 1024, 1024, 0, rot); rot += 36;
        cvt_t(F, F.in(10) + (size_t)j * 256 * 1536, 256, 1536, F.W<u16>(WS_WUQ) + (size_t)j * 1536 * 256, 256, 0, rot); rot += 24;
        cvt_t(F, F.in(12) + (size_t)j * 256 * 2048, 256, 2048, F.W<u16>(WS_WUKV) + (size_t)j * 2048 * 256, 256, 0, rot); rot += 32;
        cvt_t(F, F.in(13) + (size_t)j * 1024 * 1024, 1024, 1024, F.W<u16>(WS_WOM) + (size_t)j * 1024 * 1024, 1024, 0, rot);
    }
    cvt_t(F, F.in(14), 1024, 3072, F.W<u16>(WS_WQKVD), 1024, 3, rot);
    cvt_t(F, F.in(17), 1024, 1024, F.W<u16>(WS_WOD), 1024, 0, rot);
    cvt_t(F, F.in(18), 1024, 3104, F.W<u16>(WS_WING), 1024, 0, rot); rot += 4;
    cvt_t(F, F.in(22), 1024, 1024, F.W<u16>(WS_WOG), 1024, 0, rot);
}
__device__ __forceinline__ void moe_weights(const Frame& F, int li) {
    for (int g = F.bx; g < MOE_CVT_GROUPS; g += F.G) moe_cvt_group(F, li, g);
}

#define DPP_ADD(v, CTRL) (v) += __uint_as_float(__builtin_amdgcn_update_dpp(0u, __float_as_uint(v), (CTRL), 0xF, 0xF, false))
__device__ __forceinline__ float wave_sum_fast(float v) {
    DPP_ADD(v, 0xB1); DPP_ADD(v, 0x4E); DPP_ADD(v, 0x141); DPP_ADD(v, 0x140);
    { auto rr = __builtin_amdgcn_permlane16_swap(__float_as_uint(v), __float_as_uint(v), false, false); v = __uint_as_float(rr[0]) + __uint_as_float(rr[1]); }
    { auto rr = __builtin_amdgcn_permlane32_swap(__float_as_uint(v), __float_as_uint(v), false, false); v = __uint_as_float(rr[0]) + __uint_as_float(rr[1]); }
    return v;
}
constexpr int RT_WG = 0, RT_WR = 16384, RT_REC = 81920, RT_CNT = 81920 + 4096, RT_BASE = RT_CNT + 128;
template <bool ROUTE>
__device__ __forceinline__ void norm_phase(const Frame& F, int li, int row_begin, bool first) {
    const int tid = threadIdx.x, lane = tid & 63, wid = tid >> 6;
    const float* gain = F.in(ROUTE ? 7 : 6) + li * DM;
    u16* H = F.W<u16>(WS_H);
    const int per_block = (NTOK - row_begin + F.G - 1) / F.G;
    const int blk0 = row_begin + F.bx * per_block; int blk1 = blk0 + per_block; if (blk1 > NTOK) blk1 = NTOK;
    f32x4* wgL = (f32x4*)(F.lds + RT_WG); f32x4* wrL = (f32x4*)(F.lds + RT_WR); u32x4* recL = (u32x4*)(F.lds + RT_REC);
    unsigned* cntL = (unsigned*)(F.lds + RT_CNT); unsigned* baseL = (unsigned*)(F.lds + RT_BASE);
    if constexpr (ROUTE) {
        __syncthreads();
        const f32x4* wg = (const f32x4*)(F.in(23) + (size_t)li * DM * 4); const f32x4* wr = (const f32x4*)(F.in(25) + (size_t)li * 4 * DM * 4);
        for (int e = tid; e < 1024; e += NTHR) { const int d = ((e >> 8) * 4 + (e & 3)) * 64 + ((e >> 2) & 63); wgL[d] = wg[e]; }
        for (int e = tid; e < 4096; e += NTHR) { const int g = e >> 10, c = e & 1023; const int d = g * 1024 + ((c >> 8) * 4 + (c & 3)) * 64 + ((c >> 2) & 63); wrL[d] = wr[e]; }
        if (tid < 32) cntL[tid] = 0u;
        __syncthreads();
    }
    for (int it = 0; it * 32 < per_block; ++it) {
        int rows[4]; bool ok[4]; f32x4 v[4][4];
#pragma unroll
        for (int u = 0; u < 4; ++u) { rows[u] = blk0 + wid + 8 * (4 * it + u); ok[u] = rows[u] < blk1; if (!ok[u]) rows[u] = blk0; }
#pragma unroll
        for (int u = 0; u < 4; ++u) { const float* xr = xrow_in(F, rows[u], first);
#pragma unroll
            for (int i = 0; i < 4; ++i) v[u][i] = *(const f32x4*)(xr + i * 256 + lane * 4); }
#pragma unroll
        for (int u = 0; u < 4; ++u) {
            const int row = rows[u];
            float ss = 0;
#pragma unroll
            for (int i = 0; i < 4; ++i) ss += v[u][i][0] * v[u][i][0] + v[u][i][1] * v[u][i][1] + v[u][i][2] * v[u][i][2] + v[u][i][3] * v[u][i][3];
            ss = wave_sum_fast(ss);
            const float rinv = rsqrtf(ss * (1.f / DM) + EPS);
            const float* sh = mod_vec(F, li, row, ROUTE ? 3 : 0); const float* sc = mod_vec(F, li, row, ROUTE ? 4 : 1);
            float hv[16];
#pragma unroll
            for (int i = 0; i < 4; ++i) { const int c = i * 256 + lane * 4;
                const f32x4 g = *(const f32x4*)(gain + c), s1 = *(const f32x4*)(sc + c), s0 = *(const f32x4*)(sh + c);
#pragma unroll
                for (int j = 0; j < 4; ++j) hv[i * 4 + j] = (v[u][i][j] * rinv * g[j]) * (1.f + s1[j]) + s0[j];
                if (ok[u]) { u32x2 w = {cvtpk(hv[i * 4], hv[i * 4 + 1]), cvtpk(hv[i * 4 + 2], hv[i * 4 + 3])}; *(u32x2*)(H + (size_t)row * DM + c) = w; } }
            if constexpr (ROUTE) {
                float gl[4] = {0, 0, 0, 0};
#pragma unroll
                for (int q = 0; q < 16; ++q) { const f32x4 w4 = wgL[q * 64 + lane]; const float h = hv[q];
                    gl[0] += h * w4[0]; gl[1] += h * w4[1]; gl[2] += h * w4[2]; gl[3] += h * w4[3]; }
#pragma unroll
                for (int g = 0; g < 4; ++g) gl[g] = wave_sum_fast(gl[g]) + F.in(24)[li * 4 + g];
                int gi = 0; float gm = gl[0];
#pragma unroll
                for (int g = 1; g < 4; ++g) if (gl[g] > gm) { gm = gl[g]; gi = g; }
                gi = __builtin_amdgcn_readfirstlane(gi);
                float den = 0;
#pragma unroll
                for (int g = 0; g < 4; ++g) den += __expf(gl[g] - gm);
                const float grp_w = 1.f / den;
                float el[4] = {0, 0, 0, 0};
                const f32x4* wrg = wrL + gi * 1024;
#pragma unroll
                for (int q = 0; q < 16; ++q) { const f32x4 w4 = wrg[q * 64 + lane]; const float h = hv[q];
                    el[0] += h * w4[0]; el[1] += h * w4[1]; el[2] += h * w4[2]; el[3] += h * w4[3]; }
#pragma unroll
                for (int e = 0; e < 4; ++e) el[e] = wave_sum_fast(el[e]) + F.in(26)[(li * 4 + gi) * 4 + e];
                int i1 = 0; float v1 = el[0];
#pragma unroll
                for (int e = 1; e < 4; ++e) if (el[e] > v1) { v1 = el[e]; i1 = e; }
                int i2 = -1; float v2 = -3.0e38f;
#pragma unroll
                for (int e = 0; e < 4; ++e) if (e != i1 && el[e] > v2) { v2 = el[e]; i2 = e; }
                const float t = __expf(v2 - v1); const float w1 = grp_w / (1.f + t), w2 = grp_w * t / (1.f + t);
                const int elo = i1 < i2 ? i1 : i2, ehi = i1 < i2 ? i2 : i1;
                const float wlo = i1 < i2 ? w1 : w2, whi = i1 < i2 ? w2 : w1;
                const int pr = elo == 0 ? ehi - 1 : (elo == 1 ? ehi + 1 : 5);
                const int cls = gi * 6 + pr;
                if (lane == 0 && ok[u]) {
                    const unsigned rank = atomicAdd(&cntL[cls], 1u);
                    u32x4 rec = {(unsigned)cls, rank, __float_as_uint(wlo), __float_as_uint(whi)};
                    recL[row - blk0] = rec;
                }
            }
        }
    }
    if constexpr (ROUTE) {
        __syncthreads();
        if (tid < 24) baseL[tid] = atomicAdd(F.W<unsigned>(WS_CTL) + CW_CNT + li * 32 + tid, cntL[tid]);
        __syncthreads();
        for (int t = tid; t < blk1 - blk0; t += NTHR) { u32x4 rec = recL[t]; rec[1] += baseL[rec[0]];
            *(u32x4*)(F.W<unsigned char>(WS_TOK) + (size_t)(blk0 + t) * 16) = rec; }
    }
}

__device__ __forceinline__ void moe_table(const Frame& F, int li, int* tab) {
    if (threadIdx.x == 0) {
        const unsigned* cnt = F.W<unsigned>(WS_CTL) + CW_CNT + li * 32; int off = 0;
        for (int c = 0; c < 24; ++c) { tab[c] = off; const int n = (int)cnt[c]; const int nt = (n + 255) >> 8;
            for (int t = 0; t < nt; ++t) tab[32 + (off >> 8) + t] = c; off += nt << 8; }
        tab[24] = off;
    }
    __syncthreads();
}
__device__ __forceinline__ void moe_scatter(const Frame& F, int li, int row_begin) {
    int* tab = (int*)(F.lds + LDS_TAB);
    moe_table(F, li, tab);
    const unsigned* cnt = F.W<unsigned>(WS_CTL) + CW_CNT + li * 32;
    int* rowtok = F.W<int>(WS_ROWTOK); float* roww = F.W<float>(WS_ROWW);
    const int gt = F.bx * NTHR + threadIdx.x, gn = F.G * NTHR;
    for (int t = row_begin + gt; t < NTOK; t += gn) {
        const u32x4 rec = *(const u32x4*)(F.W<unsigned char>(WS_TOK) + (size_t)t * 16);
        const int r = tab[rec[0]] + (int)rec[1];
        rowtok[r] = t; roww[2 * r] = __uint_as_float(rec[2]); roww[2 * r + 1] = __uint_as_float(rec[3]);
    }
    for (int i = gt; i < 24 * 256; i += gn) { const int c = i >> 8, j = i & 255; const int r = tab[c] + (int)cnt[c] + j;
        const int end = tab[c] + ((((int)cnt[c]) + 255) & ~255);
        if (r < end) { rowtok[r] = -1; roww[2 * r] = 0.f; roww[2 * r + 1] = 0.f; } }
    __syncthreads();
}

#define EPI_ID const int r32 = lane & 31, hi = lane >> 5
__device__ __forceinline__ u32x2 pack4(float a, float b, float c, float d) { u32x2 w = {cvtpk(a, b), cvtpk(c, d)}; return w; }
struct EpiF32 { float* dst; int ld, ncols;
    __device__ __forceinline__ int operator()(f32x16 (&acc)[2][2], int row0, int col0, int lane) const { EPI_ID;
#pragma unroll
        for (int mi = 0; mi < 2; ++mi) { float* o = dst + (size_t)(row0 + mi * 32 + r32) * ld + col0 + 4 * hi;
#pragma unroll
            for (int ni = 0; ni < 2; ++ni) if (col0 + ni * 32 < ncols) {
#pragma unroll
                for (int g = 0; g < 4; ++g) { f32x4 v = {acc[mi][ni][4 * g], acc[mi][ni][4 * g + 1], acc[mi][ni][4 * g + 2], acc[mi][ni][4 * g + 3]}; *(f32x4*)(o + ni * 32 + 8 * g) = v; } } }
        return 0;
    } };
struct EpiMlaQ { u16* Q; const float* cosA; const float* sinA; float scale;
    __device__ __forceinline__ int operator()(f32x16 (&acc)[2][2], int row0, int col0, int lane) const { EPI_ID; const bool lat = row0 >= NCTX;
#pragma unroll
        for (int mi = 0; mi < 2; ++mi) { const int row = row0 + mi * 32 + r32; int b, pos; row_bp(row, b, pos); const int n = (row - NCTX) & (SEQ - 1);
            u16* qrow = Q + ((size_t)(b * 16) * KEYS + pos) * 96 + 4 * hi;
#pragma unroll
            for (int ni = 0; ni < 2; ++ni) { const int s = (col0 >> 5) + ni, head = s / 3, part = s - head * 3; u16* o = qrow + (size_t)head * KEYS * 96 + part * 32;
                float v[16];
#pragma unroll
                for (int r = 0; r < 16; ++r) v[r] = acc[mi][ni][r] * scale;
                if (part == 2 && lat) {
#pragma unroll
                    for (int g = 0; g < 2; ++g) {
#pragma unroll
                        for (int j = 0; j < 4; ++j) { float cs, sn; rope_cs<8>(n, 8 * g + 4 * hi + j, cs, sn);
                            const float t1 = v[4 * g + j], t2 = v[4 * (g + 2) + j]; v[4 * g + j] = t1 * cs - t2 * sn; v[4 * (g + 2) + j] = t1 * sn + t2 * cs; } } }
#pragma unroll
                for (int g = 0; g < 4; ++g) *(u32x2*)(o + 8 * g) = pack4(v[4 * g], v[4 * g + 1], v[4 * g + 2], v[4 * g + 3]); } }
        return 16;
    } };
struct EpiMlaKV { u16* Kn; long vdelta;
    __device__ __forceinline__ int operator()(f32x16 (&acc)[2][2], int row0, int col0, int lane) const { EPI_ID; const int head = col0 >> 7; u16* dst = Kn + (long)((col0 >> 6) & 1) * vdelta;
#pragma unroll
        for (int mi = 0; mi < 2; ++mi) { const int row = row0 + mi * 32 + r32; int b, pos; row_bp(row, b, pos);
            u16* o = dst + ((size_t)(b * 16 + head) * KEYS + pos) * 64 + 4 * hi;
#pragma unroll
            for (int ni = 0; ni < 2; ++ni)
#pragma unroll
                for (int g = 0; g < 4; ++g) *(u32x2*)(o + ni * 32 + 8 * g) = pack4(acc[mi][ni][4 * g], acc[mi][ni][4 * g + 1], acc[mi][ni][4 * g + 2], acc[mi][ni][4 * g + 3]); }
        return 16;
    } };
struct EpiResid { ResCtx F; int li, which, first;
    __device__ __forceinline__ int operator()(f32x16 (&acc)[2][2], int row0, int col0, int lane) const { EPI_ID;
#pragma unroll
        for (int mi = 0; mi < 2; ++mi) { const int row = row0 + mi * 32 + r32;
            const float* xi = F.row_in(row, first) + col0 + 4 * hi; float* xo = F.row_out(row) + col0 + 4 * hi; const float* gt = F.mod(li, row, which) + col0 + 4 * hi;
#pragma unroll
            for (int ni = 0; ni < 2; ++ni)
#pragma unroll
                for (int g = 0; g < 4; ++g) { const int c = ni * 32 + 8 * g; const f32x4 x = *(const f32x4*)(xi + c), gg = *(const f32x4*)(gt + c);
                    f32x4 o = {x[0] + gg[0] * acc[mi][ni][4 * g], x[1] + gg[1] * acc[mi][ni][4 * g + 1], x[2] + gg[2] * acc[mi][ni][4 * g + 2], x[3] + gg[3] * acc[mi][ni][4 * g + 3]};
                    *(f32x4*)(xo + c) = o; } }
        return 48;
    } };
struct EpiMoeB { ResCtx F; int li; const int* rowtok;
    __device__ __forceinline__ int operator()(f32x16 (&acc)[2][2], int row0, int col0, int lane) const { EPI_ID;
#pragma unroll
        for (int mi = 0; mi < 2; ++mi) { const int tok = rowtok[row0 + mi * 32 + r32];
            if (tok >= 0) { float* xo = F.row_out(tok) + col0 + 4 * hi; const float* gt = F.mod(li, tok, 5) + col0 + 4 * hi;
#pragma unroll
                for (int ni = 0; ni < 2; ++ni)
#pragma unroll
                    for (int g = 0; g < 4; ++g) { const int c = ni * 32 + 8 * g; const f32x4 x = *(const f32x4*)(xo + c), gg = *(const f32x4*)(gt + c);
                        f32x4 o = {x[0] + gg[0] * acc[mi][ni][4 * g], x[1] + gg[1] * acc[mi][ni][4 * g + 1], x[2] + gg[2] * acc[mi][ni][4 * g + 2], x[3] + gg[3] * acc[mi][ni][4 * g + 3]};
                        *(f32x4*)(xo + c) = o; } } }
        return 0;
    } };
struct EpiMoeA { u16* act; const float* roww; int half, acol0;
    __device__ __forceinline__ int operator()(f32x16 (&acc)[2][2], int row0, int col0, int lane) const { EPI_ID;
#pragma unroll
        for (int mi = 0; mi < 2; ++mi) { const int row = row0 + mi * 32 + r32; const float w = roww[2 * row + half];
            u16* o = act + (size_t)row * 1024 + acol0 + (col0 >> 6) * 32 + 4 * hi;
#pragma unroll
            for (int g = 0; g < 4; ++g) { float v[4];
#pragma unroll
                for (int j = 0; j < 4; ++j) v[j] = silu_f(acc[mi][0][4 * g + j]) * acc[mi][1][4 * g + j] * w;
                *(u32x2*)(o + 8 * g) = pack4(v[0], v[1], v[2], v[3]); } }
        return 8;
    } };
struct EpiDiffQKV { u16* Q; long kdelta; u16* V; const float* cosB; const float* sinB; float qscale;
    __device__ __forceinline__ int operator()(f32x16 (&acc)[2][2], int row0, int col0, int lane) const { EPI_ID; const int region = col0 >> 10; const bool lat = row0 >= NCTX;
#pragma unroll
        for (int mi = 0; mi < 2; ++mi) { const int row = row0 + mi * 32 + r32; int b, pos; row_bp(row, b, pos); const int n = (row - NCTX) & (SEQ - 1);
            if (region < 2) {
                const int hh = (col0 & 1023) >> 6; const float sc = region == 0 ? qscale : 1.f;
                u16* o = Q + (long)region * kdelta + ((size_t)(b * 16 + hh) * KEYS + pos) * 64 + 4 * hi;
#pragma unroll
                for (int g = 0; g < 4; ++g) {
                    float o1[4], o2[4];
#pragma unroll
                    for (int j = 0; j < 4; ++j) { float cs = 1.f, sn = 0.f; if (lat) rope_cs<16>(n, 8 * g + 4 * hi + j, cs, sn);
                        const float t1 = acc[mi][0][4 * g + j], t2 = acc[mi][1][4 * g + j]; o1[j] = (t1 * cs - t2 * sn) * sc; o2[j] = (t1 * sn + t2 * cs) * sc; }
                    *(u32x2*)(o + 8 * g) = pack4(o1[0], o1[1], o1[2], o1[3]); *(u32x2*)(o + 32 + 8 * g) = pack4(o2[0], o2[1], o2[2], o2[3]); }
            } else {
                const int cv = col0 - 2048, head = cv >> 7;
                u16* o = V + ((size_t)(b * 8 + head) * KEYS + pos) * 128 + (cv & 127) + 4 * hi;
#pragma unroll
                for (int ni = 0; ni < 2; ++ni)
#pragma unroll
                    for (int g = 0; g < 4; ++g) *(u32x2*)(o + ni * 32 + 8 * g) = pack4(acc[mi][ni][4 * g], acc[mi][ni][4 * g + 1], acc[mi][ni][4 * g + 2], acc[mi][ni][4 * g + 3]);
            } }
        return 16;
    } };
struct EpiGlaIn { u16* q; u16* k; u16* v; u16* g; float* z;
    __device__ __forceinline__ int operator()(f32x16 (&acc)[2][2], int row0, int col0, int lane) const { EPI_ID;
#pragma unroll
        for (int mi = 0; mi < 2; ++mi) { const size_t row = row0 + mi * 32 + r32;
            if (col0 < 3072) {
                u16* o; float sc = 1.f;
                if (col0 < 512) { o = q + row * 512 + col0; sc = 0.08838834764831845f; } else if (col0 < 1024) o = k + row * 512 + (col0 - 512);
                else if (col0 < 2048) o = v + row * 1024 + (col0 - 1024); else o = g + row * 1024 + (col0 - 2048);
                o += 4 * hi;
#pragma unroll
                for (int ni = 0; ni < 2; ++ni)
#pragma unroll
                    for (int gg = 0; gg < 4; ++gg) *(u32x2*)(o + ni * 32 + 8 * gg) = pack4(acc[mi][ni][4 * gg] * sc, acc[mi][ni][4 * gg + 1] * sc, acc[mi][ni][4 * gg + 2] * sc, acc[mi][ni][4 * gg + 3] * sc);
            } else if (col0 == 3072) {
                float* o = z + row * 32 + 4 * hi;
#pragma unroll
                for (int gg = 0; gg < 4; ++gg) { f32x4 t = {acc[mi][0][4 * gg], acc[mi][0][4 * gg + 1], acc[mi][0][4 * gg + 2], acc[mi][0][4 * gg + 3]}; *(f32x4*)(o + 8 * gg) = t; }
            } }
        return col0 < 3072 ? 16 : (col0 == 3072 ? 8 : 0);
    } };

template <int WM, int WN, class AL, class BL, class EP>
__device__ __forceinline__ void gemm_phase(const Frame& F, const AL al, const BL bl, EP& ep, int mt0, int mt1, int nN, int nk, int tile_off, int tile_total) {
    PlainTiles<AL, BL, EP> prov{al, bl, ep, mt0, mt1 - mt0, nN, F.bx, F.G}; (void)tile_off;
    gemm_stream<WM, WN>(F.lds, prov, nk);
    (void)tile_total;
}

__device__ __forceinline__ void mla_rowpass(const Frame& F, int j) {
    const int lane = threadIdx.x & 63, wid = threadIdx.x >> 6;
    const float* DQ = F.W<float>(MLA_DQ); u16* CN = F.W<u16>(MLA_CN); u16* KPE = F.W<u16>(MLA_KPE);
    const float* gq = F.in(9) + j * 256; const float* gk = F.in(11) + j * 256;
    const float* ca = F.W<float>(WS_ROPEA); const float* sa = ca + SEQ * 16;
    for (int row = F.bx * NWAVE + wid; row < NTOK; row += F.G * NWAVE) {
        const float* d = DQ + (size_t)row * 544;
        const f32x4 a = *(const f32x4*)(d + lane * 4), c = *(const f32x4*)(d + 256 + lane * 4);
        float sq = a[0] * a[0] + a[1] * a[1] + a[2] * a[2] + a[3] * a[3], sk = c[0] * c[0] + c[1] * c[1] + c[2] * c[2] + c[3] * c[3];
        sq = wave_sum(sq); sk = wave_sum(sk);
        const float rq = rsqrtf(sq * (1.f / 256.f) + EPS), rk = rsqrtf(sk * (1.f / 256.f) + EPS);
        const f32x4 g1 = *(const f32x4*)(gq + lane * 4), g2 = *(const f32x4*)(gk + lane * 4);
        u32x2 w1 = {cvtpk(a[0] * rq * g1[0], a[1] * rq * g1[1]), cvtpk(a[2] * rq * g1[2], a[3] * rq * g1[3])};
        u32x2 w2 = {cvtpk(c[0] * rk * g2[0], c[1] * rk * g2[1]), cvtpk(c[2] * rk * g2[2], c[3] * rk * g2[3])};
        *(u32x2*)(CN + (size_t)row * 512 + lane * 4) = w1; *(u32x2*)(CN + (size_t)row * 512 + 256 + lane * 4) = w2;
        if (lane < 16) { float t1 = d[512 + lane], t2 = d[528 + lane]; int b, pos; row_bp(row, b, pos);
            if (row >= NCTX) { const int n = (row - NCTX) & (SEQ - 1); const float cs = ca[n * 16 + lane], sn = sa[n * 16 + lane];
                const float o1 = t1 * cs - t2 * sn, o2 = t1 * sn + t2 * cs; t1 = o1; t2 = o2; }
            u16* o = KPE + ((size_t)b * KEYS + pos) * 32 + lane; o[0] = f2bf(t1); o[16] = f2bf(t2); }
    }
}
__device__ __forceinline__ int vcu_of(const Frame& F) { return (F.G % 8 == 0) ? (F.bx % 8) * (F.G / 8) + F.bx / 8 : F.bx; }
__device__ __forceinline__ void mla_attn(const Frame& F, bool ctx_out, int li) {
    const u16* Q = F.W<u16>(MLA_Q); const u16* Kn = F.W<u16>(MLA_KN); const u16* V = F.W<u16>(MLA_V); const u16* Kpe = F.W<u16>(MLA_KPE);
    u16* O = F.W<u16>(MLA_DQ);
    const int nit = 2048 + (ctx_out ? 64 : 0); int nrun = 0;
#pragma unroll 1
    for (int it = vcu_of(F); it < nit; it += F.G) {
        int b, h, qpos, nkeys, orow;
        if (it < 2048) { const int bh = it >> 5, qt = it & 31; b = bh >> 4; h = bh & 15; qpos = CTXL + qt * 256; nkeys = KEYS; orow = NCTX + b * SEQ + qt * 256; }
        else { const int jj = it - 2048; b = jj >> 4; h = jj & 15; qpos = 0; nkeys = CTXL; orow = b * CTXL; }
        const size_t bh = (size_t)(b * 16 + h);
        attn_item<96, 64>(Q + (bh * KEYS + qpos) * 96, Kn + bh * KEYS * 64, Kpe + (size_t)b * KEYS * 32, V + bh * KEYS * 64, nkeys,
                          O + (size_t)orow * DM + h * 64, DM, F.lds);
        moe_cvt_group(F, li, F.bx + nrun * F.G); ++nrun;
    }
    for (; F.bx + nrun * F.G < MOE_CVT_GROUPS; ++nrun) moe_cvt_group(F, li, F.bx + nrun * F.G);
}
__device__ __forceinline__ void diff_attn(const Frame& F, int li) {
    const u16* Q = F.W<u16>(DF_Q); const u16* K = F.W<u16>(DF_K); const u16* V = F.W<u16>(DF_V); u16* OS = F.W<u16>(DF_OS);
    const int nit = 2048 + 64; int nrun = 0;
#pragma unroll 1
    for (int it = vcu_of(F); it < nit; it += F.G) {
        int b, hh, qpos, nkeys, orow;
        if (it < 2048) { const int bh = it >> 5, qt = it & 31; b = bh >> 4; hh = bh & 15; qpos = CTXL + qt * 256; nkeys = KEYS; orow = NCTX + b * SEQ + qt * 256; }
        else { const int jj = it - 2048; b = jj >> 4; hh = jj & 15; qpos = 0; nkeys = CTXL; orow = b * CTXL; }
        const size_t bh = (size_t)(b * 16 + hh);
        attn_item<64, 128>(Q + (bh * KEYS + qpos) * 64, K + bh * KEYS * 64, nullptr, V + (size_t)(b * 8 + (hh >> 1)) * KEYS * 128, nkeys,
                           OS + (size_t)(hh & 1) * NTOK * DM + (size_t)orow * DM + (hh >> 1) * 128, DM, F.lds);
        moe_cvt_group(F, li, F.bx + nrun * F.G); ++nrun;
    }
    for (; F.bx + nrun * F.G < MOE_CVT_GROUPS; ++nrun) moe_cvt_group(F, li, F.bx + nrun * F.G);
}
__device__ __forceinline__ void diff_rowpass(const Frame& F, float lam_init) {
    const int lane = threadIdx.x & 63, wid = threadIdx.x >> 6;
    const u16* OS = F.W<u16>(DF_OS); u16* O = F.W<u16>(DF_Q);
    const float* lm = F.in(15);
    const float lam = __expf(wave_sum(lm[lane] * lm[64 + lane])) - __expf(wave_sum(lm[128 + lane] * lm[192 + lane])) + lam_init;
    const float post = 1.f - lam_init;
    float sg[16];
#pragma unroll
    for (int i = 0; i < 16; ++i) sg[i] = F.in(16)[(lane & 7) * 16 + i] * post;
    for (int row = F.bx * NWAVE + wid; row < NTOK; row += F.G * NWAVE) {
        const u16* p0 = OS + (size_t)row * DM + lane * 16; const u16* p1 = p0 + (size_t)NTOK * DM;
        const bf16x8 a0 = *(const bf16x8*)p0, a1 = *(const bf16x8*)(p0 + 8), b0 = *(const bf16x8*)p1, b1 = *(const bf16x8*)(p1 + 8);
        float o[16]; float ss = 0;
#pragma unroll
        for (int i = 0; i < 8; ++i) { o[i] = bf2f((u16)a0[i]) - lam * bf2f((u16)b0[i]); o[8 + i] = bf2f((u16)a1[i]) - lam * bf2f((u16)b1[i]); }
#pragma unroll
        for (int i = 0; i < 16; ++i) ss += o[i] * o[i];
        ss += __shfl_xor(ss, 1); ss += __shfl_xor(ss, 2); ss += __shfl_xor(ss, 4);
        const float rinv = rsqrtf(ss * (1.f / 128.f) + EPS);
        u32x4 w0, w1;
#pragma unroll
        for (int i = 0; i < 4; ++i) { w0[i] = cvtpk(o[2 * i] * rinv * sg[2 * i], o[2 * i + 1] * rinv * sg[2 * i + 1]);
            w1[i] = cvtpk(o[8 + 2 * i] * rinv * sg[8 + 2 * i], o[9 + 2 * i] * rinv * sg[9 + 2 * i]); }
        *(u32x4*)(O + (size_t)row * DM + lane * 16) = w0; *(u32x4*)(O + (size_t)row * DM + lane * 16 + 8) = w1;
    }
}

__device__ __forceinline__ float logsig16(float x) { return (fminf(x, 0.f) - __logf(1.f + __expf(-fabsf(x)))) * 0.0625f; }
constexpr int NCH = KEYS / 64;

__device__ __forceinline__ void gla_g1(const Frame& F) {
    char* KT = F.lds; char* VV = F.lds + 16384; float* ZT = (float*)(F.lds + 49152); float* SEG = (float*)(F.lds + 53248);
    const u16* Kg = F.W<u16>(GL_K); const u16* Vg = F.W<u16>(GL_V); const float* Zg = F.W<float>(GL_Z);
    u16* ST = F.W<u16>(GL_STATE); float* DEC = F.W<float>(GL_DEC);
#pragma unroll 1
    for (int it = F.bx; it < NBATCH * 4 * 2 * NCH; it += F.G) {
        int tid = threadIdx.x; asm volatile("" : "+v"(tid));
        const int lane = tid & 63, wid = tid >> 6, r32 = lane & 31, hi = lane >> 5, kk = tid & 127, jq = tid >> 7;
        const int c = it % NCH, dir = (it / NCH) & 1, bh = it / (2 * NCH), b = bh >> 2, h = bh & 3;
        const int s0 = 64 * c;
        int tbase, tstep;
        if (dir == 0) { tbase = (c < 4) ? b * CTXL + s0 : NCTX + b * SEQ + s0 - CTXL; tstep = 1; }
        else { tbase = (c < 4) ? b * CTXL + (CTXL - 1) - s0 : NCTX + b * SEQ + (SEQ - 1) - (s0 - CTXL); tstep = -1; }
        __syncthreads();
        for (int i = tid; i < 1024; i += NTHR) { const int j = i >> 4, r = i & 15; ZT[i] = Zg[(size_t)(tbase + tstep * j) * 32 + dir * 16 + r]; }
#pragma unroll
        for (int q = 0; q < 4; ++q) { const int id = tid + q * NTHR, key = id >> 5, cc = (id & 31) * 8;
            *(bf16x8*)(VV + v_st<8>(key, cc)) = *(const bf16x8*)(Vg + (size_t)(tbase + tstep * key) * 1024 + h * 256 + cc); }
        float wg[16];
#pragma unroll
        for (int r = 0; r < 16; ++r) wg[r] = F.in(19)[(dir * 16 + r) * 512 + h * 128 + kk];
        const float bias = F.in(20)[dir * 512 + h * 128 + kk];
        __syncthreads();
        float cv[16]; float run = 0;
#pragma unroll
        for (int jj = 0; jj < 16; ++jj) { const int j = jq * 16 + jj; float x = bias;
#pragma unroll
            for (int r = 0; r < 16; ++r) x += ZT[j * 16 + r] * wg[r];
            run += logsig16(x); cv[jj] = run; }
        SEG[jq * 128 + kk] = run;
        __syncthreads();
        float offset = 0, total = 0;
#pragma unroll
        for (int q = 0; q < 4; ++q) { const float sv = SEG[q * 128 + kk]; total += sv; if (q < jq) offset += sv; }
        u32x4 w0, w1;
#pragma unroll
        for (int i = 0; i < 8; ++i) {
            const int j0 = jq * 16 + 2 * i;
            const float k0 = bf2f(Kg[(size_t)(tbase + tstep * j0) * 512 + h * 128 + kk]) * __expf(total - (offset + cv[2 * i]));
            const float k1 = bf2f(Kg[(size_t)(tbase + tstep * (j0 + 1)) * 512 + h * 128 + kk]) * __expf(total - (offset + cv[2 * i + 1]));
            const unsigned pk = cvtpk(k0, k1); if (i < 4) w0[i] = pk; else w1[i - 4] = pk; }
        *(u32x4*)(KT + kk * 128 + (((jq * 2) ^ ((kk >> 1) & 7)) << 4)) = w0;
        *(u32x4*)(KT + kk * 128 + (((jq * 2 + 1) ^ ((kk >> 1) & 7)) << 4)) = w1;
        if (jq == 0) DEC[(size_t)it * 128 + kk] = __expf(total);
        __syncthreads();
        const int mt = wid & 3, vb = (wid >> 2) * 4;
        const int row = mt * 32 + r32, ab = row * 128 + ((hi ^ ((row >> 1) & 7)) << 4);
        const bf16x8 pa0 = *(const bf16x8*)(KT + (ab ^ 0)), pa1 = *(const bf16x8*)(KT + (ab ^ 32)), pa2 = *(const bf16x8*)(KT + (ab ^ 64)), pa3 = *(const bf16x8*)(KT + (ab ^ 96));
        f32x16 acc[4];
#pragma unroll
        for (int n = 0; n < 4; ++n) acc[n] = f32x16{};
        const int vbase = (int)(uintptr_t)VV + v_rd_base(lane) + vb * 512;
        pv_one<0, 8>(acc[0], vbase, pa0, pa1, pa2, pa3); pv_one<1, 8>(acc[1], vbase, pa0, pa1, pa2, pa3);
        pv_one<2, 8>(acc[2], vbase, pa0, pa1, pa2, pa3); pv_one<3, 8>(acc[3], vbase, pa0, pa1, pa2, pa3);
        u16* S = ST + (size_t)it * 128 * 256;
#pragma unroll
        for (int n = 0; n < 4; ++n)
#pragma unroll
            for (int r = 0; r < 16; ++r) S[(mt * 32 + crow(r, hi)) * 256 + (vb + n) * 32 + r32] = f2bf(acc[n][r]);
    }
}
__device__ __forceinline__ void gla_g2(const Frame& F) {
    u16* ST = F.W<u16>(GL_STATE); const float* DEC = F.W<float>(GL_DEC);
    for (int g = F.bx * NTHR + threadIdx.x; g < 32 * 4096; g += F.G * NTHR) {
        const int chain = g >> 12, e = g & 4095, kk = e >> 5, v8 = (e & 31) * 8;
        u16* p = ST + ((size_t)chain * NCH * 128 + kk) * 256 + v8; const float* d = DEC + (size_t)chain * NCH * 128 + kk;
        float f[8];
#pragma unroll
        for (int i = 0; i < 8; ++i) f[i] = 0.f;
        for (int c = 0; c < NCH; c += 4) {
            bf16x8 kv[4]; float dc[4];
#pragma unroll
            for (int u = 0; u < 4; ++u) { kv[u] = *(const bf16x8*)(p + (size_t)(c + u) * 128 * 256); dc[u] = d[(size_t)(c + u) * 128]; }
#pragma unroll
            for (int u = 0; u < 4; ++u) {
                u32x4 w = {cvtpk(f[0], f[1]), cvtpk(f[2], f[3]), cvtpk(f[4], f[5]), cvtpk(f[6], f[7])};
                *(u32x4*)(p + (size_t)(c + u) * 128 * 256) = w;
#pragma unroll
                for (int i = 0; i < 8; ++i) f[i] = dc[u] * f[i] + bf2f((u16)kv[u][i]);
            }
        }
    }
}
__device__ __forceinline__ void gla_g3(const Frame& F) {
    char* QD = F.lds; char* KI = F.lds + 16384; char* VV = F.lds + 32768; char* SS = F.lds + 65536; float* OL = (float*)(F.lds + 65536);
    float* ZT = (float*)(F.lds + 132096); float* SEG = (float*)(F.lds + 136192);
    const u16* Qg = F.W<u16>(GL_Q); const u16* Kg = F.W<u16>(GL_K); const u16* Vg = F.W<u16>(GL_V); const u16* Gg = F.W<u16>(GL_G); const float* Zg = F.W<float>(GL_Z);
    const u16* ST = F.W<u16>(GL_STATE); u16* OUT = F.W<u16>(WS_H);
#pragma unroll 1
    for (int it = F.bx; it < NBATCH * 4 * NCH; it += F.G) {
        int tid = threadIdx.x; asm volatile("" : "+v"(tid));
        const int lane = tid & 63, wid = tid >> 6, r32 = lane & 31, hi = lane >> 5, kk = tid & 127, jq = tid >> 7;
        const int T = it % NCH, bh = it / NCH, b = bh >> 2, h = bh & 3;
        const int t0 = (T < 4) ? b * CTXL + 64 * T : NCTX + b * SEQ + 64 * (T - 4);
        __syncthreads();
#pragma unroll
        for (int q = 0; q < 4; ++q) { const int id = tid + q * NTHR, key = id >> 5, cc = (id & 31) * 8;
            *(bf16x8*)(VV + v_st<8>(key, cc)) = *(const bf16x8*)(Vg + (size_t)(t0 + key) * 1024 + h * 256 + cc); }
        const int itile = wid & 1, vb = (wid >> 1) * 2;
        f32x16 acc[2]; acc[0] = f32x16{}; acc[1] = f32x16{};
#pragma unroll 1
        for (int dir = 0; dir < 2; ++dir) {
            const int cd = dir == 0 ? T : (T < 4 ? 3 - T : 135 - T);
            const u16* Ssrc = ST + (size_t)((bh * 2 + dir) * NCH + cd) * 128 * 256;
#pragma unroll
            for (int q = 0; q < 8; ++q) { const int id = tid + q * NTHR, key = id >> 5, cc = (id & 31) * 8;
                *(bf16x8*)(SS + v_st<8>(key, cc)) = *(const bf16x8*)(Ssrc + (size_t)key * 256 + cc); }
            for (int i = tid; i < 1024; i += NTHR) { const int j = i >> 4, r = i & 15; ZT[i] = Zg[(size_t)(t0 + j) * 32 + dir * 16 + r]; }
            float wg[16];
#pragma unroll
            for (int r = 0; r < 16; ++r) wg[r] = F.in(19)[(dir * 16 + r) * 512 + h * 128 + kk];
            const float bias = F.in(20)[dir * 512 + h * 128 + kk];
            __syncthreads();
            float cv[16]; float run = 0;
#pragma unroll
            for (int u = 0; u < 16; ++u) { const int j = jq * 16 + u; float x = bias;
#pragma unroll
                for (int r = 0; r < 16; ++r) x += ZT[j * 16 + r] * wg[r];
                cv[u] = logsig16(x); }
            if (dir == 0) {
#pragma unroll
                for (int u = 0; u < 16; ++u) { run += cv[u]; cv[u] = run; }
            } else {
#pragma unroll
                for (int u = 15; u >= 0; --u) { run += cv[u]; cv[u] = run; }
            }
            SEG[jq * 128 + kk] = run;
            __syncthreads();
            float offset = 0;
#pragma unroll
            for (int q = 0; q < 4; ++q) { const float sv = SEG[q * 128 + kk]; if (dir == 0 ? (q < jq) : (q > jq)) offset += sv; }
            const int adb = jq * 4096 + ((kk >> 3) << 4) + (kk & 7) * 2;
#pragma unroll
            for (int jj = 0; jj < 16; ++jj) { const int i = jq * 16 + jj; const float cum = offset + cv[jj];
                const float qv = bf2f(Qg[(size_t)(t0 + i) * 512 + h * 128 + kk]) * __expf(cum);
                const float kv = bf2f(Kg[(size_t)(t0 + i) * 512 + h * 128 + kk]) * __expf(-cum);
                const int ad = (adb ^ (jj << 4)) + jj * 256;
                *(u16*)(QD + ad) = f2bf(qv); *(u16*)(KI + ad) = f2bf(kv); }
            __syncthreads();
            {
                const int row = itile * 32 + r32; bf16x8 qa[8];
#pragma unroll
                for (int ks = 0; ks < 8; ++ks) qa[ks] = *(const bf16x8*)(QD + row * 256 + (((ks * 2 + hi) ^ (row & 15)) << 4));
                const int ssb = (int)(uintptr_t)SS + v_rd_base(lane) + vb * 512;
                pv_one<0, 8>(acc[0], ssb, qa[0], qa[1], qa[2], qa[3]); pv_one<0, 8>(acc[0], ssb + 32768, qa[4], qa[5], qa[6], qa[7]);
                pv_one<1, 8>(acc[1], ssb, qa[0], qa[1], qa[2], qa[3]); pv_one<1, 8>(acc[1], ssb + 32768, qa[4], qa[5], qa[6], qa[7]);
                f32x16 p0 = f32x16{}, p1 = f32x16{};
#pragma unroll
                for (int ks = 0; ks < 8; ++ks) {
                    const bf16x8 k0 = *(const bf16x8*)(KI + r32 * 256 + (((ks * 2 + hi) ^ (r32 & 15)) << 4));
                    const bf16x8 k1 = *(const bf16x8*)(KI + (32 + r32) * 256 + (((ks * 2 + hi) ^ (r32 & 15)) << 4));
                    p0 = __builtin_amdgcn_mfma_f32_32x32x16_bf16(k0, qa[ks], p0, 0, 0, 0);
                    p1 = __builtin_amdgcn_mfma_f32_32x32x16_bf16(k1, qa[ks], p1, 0, 0, 0);
                }
                const int iq = itile * 32 + r32;
#pragma unroll
                for (int r = 0; r < 16; ++r) { const int s0 = crow(r, hi), s1 = 32 + s0;
                    const bool k0 = dir == 0 ? (s0 <= iq) : (s0 >= iq), k1 = dir == 0 ? (s1 <= iq) : (s1 >= iq);
                    p0[r] = k0 ? p0[r] : 0.f; p1[r] = k1 ? p1[r] : 0.f; }
                bf16x8 pa0, pa1, pa2, pa3;
                PK4(p0, 0, pa0); PK4(p0, 8, pa1); PK4(p1, 0, pa2); PK4(p1, 8, pa3);
                const int vvb = (int)(uintptr_t)VV + v_rd_base(lane) + vb * 512;
                pv_one<0, 8>(acc[0], vvb, pa0, pa1, pa2, pa3); pv_one<1, 8>(acc[1], vvb, pa0, pa1, pa2, pa3);
            }
            __syncthreads();
        }
        float* olb = OL + (itile * 32 + 4 * hi) * 260 + vb * 32 + r32;
#pragma unroll
        for (int n = 0; n < 2; ++n)
#pragma unroll
            for (int r = 0; r < 16; ++r) olb[((r & 3) + 8 * (r >> 2)) * 260 + n * 32] = acc[n][r];
        __syncthreads();
        {
            const int i = tid >> 3, sg = tid & 7; const float* ol = OL + i * 260 + sg * 32;
            float ss = 0;
#pragma unroll
            for (int u = 0; u < 8; ++u) { const f32x4 t = *(const f32x4*)(ol + u * 4); ss += t[0] * t[0] + t[1] * t[1] + t[2] * t[2] + t[3] * t[3]; }
            ss += __shfl_xor(ss, 1); ss += __shfl_xor(ss, 2); ss += __shfl_xor(ss, 4);
            const float rinv = rsqrtf(ss * (1.f / 256.f) + EPS);
            const u16* gp = Gg + (size_t)(t0 + i) * 1024 + h * 256 + sg * 32; u16* op = OUT + (size_t)(t0 + i) * 1024 + h * 256 + sg * 32;
            const float* hn = F.in(21) + sg * 32;
#pragma unroll
            for (int q = 0; q < 4; ++q) { const bf16x8 g8 = *(const bf16x8*)(gp + q * 8); u32x4 w;
                const f32x4 oa = *(const f32x4*)(ol + q * 8), ob = *(const f32x4*)(ol + q * 8 + 4);
                const float o8[8] = {oa[0], oa[1], oa[2], oa[3], ob[0], ob[1], ob[2], ob[3]};
#pragma unroll
                for (int u = 0; u < 4; ++u) { const int e0 = q * 8 + 2 * u;
                    w[u] = cvtpk(o8[2 * u] * rinv * hn[e0] * silu_f(bf2f((u16)g8[2 * u])), o8[2 * u + 1] * rinv * hn[e0 + 1] * silu_f(bf2f((u16)g8[2 * u + 1]))); }
                *(u32x4*)(op + q * 8) = w; }
        }
    }
}

__device__ __forceinline__ void pair_decode(int p, int& elo, int& ehi) { elo = p < 3 ? 0 : (p < 5 ? 1 : 2); ehi = p < 3 ? p + 1 : (p < 5 ? p - 1 : 3); }
struct MoeATiles {
    typedef GTile<RowsGather, RowsPlain, EpiMoeA> Tile; static constexpr bool EP_CONST = false; EpiMoeA ep;
    const int* tab; u16* H; const int* rowtok; const u16* wgu; u16* act; const float* roww; int nmt, bx, G;
    __device__ __forceinline__ bool get(int i, Tile& t) const {
        int mt, nt; if (!tile_seq(i, bx, G, nmt, 16, mt, nt)) return false;
        const int c = tab[32 + mt], g = c / 6; int elo, ehi; pair_decode(c % 6, elo, ehi);
        const int half = nt >> 3, e = half ? ehi : elo;
        t.al = RowsGather{H, 1024, rowtok};
        t.bl = RowsPlain{wgu + ((size_t)(g * 4 + e) * 1024 + (nt & 7) * 128) * 1024, 1024};
        t.ep = EpiMoeA{act, roww, half, half * 512 + (nt & 7) * 64};
        t.brow = mt * 256; t.bcol = 0; return true; }
};
struct MoeBTiles {
    typedef GTile<RowsPlain, RowsSplitK, EpiMoeB> Tile; static constexpr bool EP_CONST = false; EpiMoeB ep;
    const int* tab; ResCtx F; int li; const u16* wd; const u16* act; const int* rowtok; int nmt, bx, G;
    __device__ __forceinline__ bool get(int i, Tile& t) const {
        int mt, nt; if (!tile_seq(i, bx, G, nmt, 8, mt, nt)) return false;
        const int c = tab[32 + mt], g = c / 6; int elo, ehi; pair_decode(c % 6, elo, ehi);
        t.al = RowsPlain{act, 1024};
        t.bl = RowsSplitK{wd + (size_t)(g * 4 + elo) * 1024 * 512, wd + (size_t)(g * 4 + ehi) * 1024 * 512, 512, 8};
        t.ep = EpiMoeB{F, li, rowtok};
        t.brow = mt * 256; t.bcol = nt * 128; return true; }
};
__device__ __forceinline__ void moe_gemm_a(const Frame& F, int li) {
    int* tab = (int*)(F.lds + LDS_TAB); moe_table(F, li, tab);
    const int nmt = tab[24] >> 8;
    pg8::MoeAOrder S8{F.W<u16>(WS_H), tab, F.W<int>(WS_ROWTOK), F.W<u16>(WS_MOEW), nmt, F.bx, F.G}; pg8::EpiMoeA8 E8{F.W<u16>(MOE_ACT), F.W<float>(WS_ROWW)};
    pg8::gemm_phase(F.lds, 1024, 1024, S8, E8);
}
__device__ __forceinline__ void moe_gemm_b(const Frame& F, int li) {
    int* tab = (int*)(F.lds + LDS_TAB); moe_table(F, li, tab);
    const int nmt = tab[24] >> 8;
    MoeBTiles prov{EpiMoeB{}, tab, res_ctx(F), li, F.W<u16>(WS_MOEW + MOE_WGU_BYTES), F.W<u16>(MOE_ACT), F.W<int>(WS_ROWTOK), nmt, F.bx, F.G};
    gemm_stream<4, 2>(F.lds, prov, 16);
}
__device__ __forceinline__ void final_norm(const Frame& F) {
    const int lane = threadIdx.x & 63, wid = threadIdx.x >> 6;
    for (int row = F.bx * NWAVE + wid; row < NLAT; row += F.G * NWAVE) {
        float* xr = F.out + (size_t)row * DM; f32x4 v[4];
#pragma unroll
        for (int i = 0; i < 4; ++i) v[i] = *(const f32x4*)(xr + i * 256 + lane * 4);
        float ss = 0;
#pragma unroll
        for (int i = 0; i < 4; ++i) ss += v[i][0] * v[i][0] + v[i][1] * v[i][1] + v[i][2] * v[i][2] + v[i][3] * v[i][3];
        ss = wave_sum(ss); const float rinv = rsqrtf(ss * (1.f / DM) + EPS);
#pragma unroll
        for (int i = 0; i < 4; ++i) { const f32x4 g = *(const f32x4*)(F.in(30) + i * 256 + lane * 4);
            f32x4 o = {v[i][0] * rinv * g[0], v[i][1] * rinv * g[1], v[i][2] * rinv * g[2], v[i][3] * rinv * g[3]};
            *(f32x4*)(xr + i * 256 + lane * 4) = o; }
    }
}

constexpr int N_PHASES = 42;
__global__ void __launch_bounds__(NTHR, 2) fwd_kernel(Params p) {
    extern __shared__ __attribute__((aligned(16))) char lds[];
    Frame F; F.p = &p; F.ws = p.ws; F.lds = lds; F.out = p.out; F.G = (int)gridDim.x; F.bx = (int)blockIdx.x;
    const int lo = p.ph_lo, hi = p.ph_hi;
#if !MK_PER_PHASE
    if (threadIdx.x == 0) *(uint4*)(lds + LDS_BARW) = make_uint4(0u, 0u, 0u, 0u);
    __syncthreads();
    XcdBarrier bar = xcd_barrier_post((unsigned*)(p.ws + WS_CTL), (volatile LAS unsigned*)(lds + LDS_BARW));
#define GRID_BAR() xcd_barrier(bar)
#else
#define GRID_BAR() do {} while (0)
#endif
#ifndef MK_EN
#define MK_EN 0xFFFFFFFFu
#endif
#define EN(g) (((MK_EN) >> (g)) & 1u)
#ifndef MK_REP
#define MK_REP 0u
#endif
#define REP(g) (((MK_REP) >> (g)) & 1u)
#define IN(k) (lo <= (k) && (k) < hi)
#define SEAM(k) do { if ((k) + 1 < hi) GRID_BAR(); } while (0)
#define DUP(g, body) do { body; if (REP(g)) { GRID_BAR(); body; } } while (0)

    if (EN(0) && IN(0)) { DUP(0, (p0_mods(F), __syncthreads(), p0_rope(F), p0_weights(F))); SEAM(0); }

#define LAYER(LI) { constexpr int li = (LI); constexpr int base = 1 + li * 10; constexpr bool first = li == 0, last = li == DEPTH - 1; constexpr int kind = li % 3, j = li / 3; \
        if (EN(1) && IN(base + 0)) { DUP(1, norm_phase<false>(F, li, 0, first)); SEAM(base + 0); } \
        if constexpr (kind == 0) { \
            if (EN(2) && IN(base + 1)) { EpiF32 ep{F.W<float>(MLA_DQ), 544, 544}; \
                gemm_phase<4, 2>(F, RowsPlain{F.W<u16>(WS_H), 1024}, RowsPlain{F.W<u16>(WS_WDQKV) + (size_t)j * 640 * 1024, 1024}, ep, 0, 132, 5, 16, 0, 0); if (REP(2)) { GRID_BAR(); gemm_phase<4, 2>(F, RowsPlain{F.W<u16>(WS_H), 1024}, RowsPlain{F.W<u16>(WS_WDQKV) + (size_t)j * 640 * 1024, 1024}, ep, 0, 132, 5, 16, 0, 0); } SEAM(base + 1); } \
            if (EN(3) && IN(base + 2)) { DUP(3, mla_rowpass(F, j)); SEAM(base + 2); } \
            if (EN(2) && IN(base + 3)) { pg8::MlaUpOrder S8{F.W<u16>(MLA_CN), F.W<u16>(WS_WUQ) + (size_t)j * 1536 * 256, F.W<u16>(WS_WUKV) + (size_t)j * 2048 * 256, F.bx, F.G}; \
                pg8::EpiMlaUp8 E8{F.W<u16>(MLA_Q), F.W<u16>(MLA_KN), (long)((MLA_V - MLA_KN) / 2), 0.10206207261596577f * LOG2E}; \
                pg8::gemm_phase(F.lds, 512, 256, S8, E8); SEAM(base + 3); } \
            if (EN(4) && IN(base + 4)) { DUP(4, mla_attn(F, !last, li)); SEAM(base + 4); } \
            if (EN(2) && IN(base + 5)) { pg8::SeqOrder S8{F.W<u16>(MLA_DQ), F.W<u16>(WS_WOM) + (size_t)j * 1024 * 1024, 1024, last ? 128 : 132, 4, F.bx, F.G, last ? 4 : 0}; EpiResid8 E8{res_ctx(F, first), li}; \
                pg8::gemm_phase(F.lds, 1024, 1024, S8, E8); SEAM(base + 5); } \
        } else if constexpr (kind == 1) { \
            if (EN(5) && IN(base + 1)) { pg8::SeqOrder S8{F.W<u16>(WS_H), F.W<u16>(WS_WQKVD), 1024, 132, 12, F.bx, F.G, 0}; pg8::EpiDiffQKV8 E8{F.W<u16>(DF_Q), (long)((DF_K - DF_Q) / 2), F.W<u16>(DF_V), 0.125f * LOG2E}; \
                pg8::gemm_phase(F.lds, 1024, 1024, S8, E8); \
                if (REP(5)) { GRID_BAR(); pg8::gemm_phase(F.lds, 1024, 1024, S8, E8); } SEAM(base + 1); } \
            if (EN(6) && IN(base + 2)) { DUP(6, diff_attn(F, li)); SEAM(base + 2); } \
            if (EN(7) && IN(base + 3)) { DUP(7, diff_rowpass(F, 0.35550906759906f)); SEAM(base + 3); } \
            if (EN(5) && IN(base + 4)) { pg8::SeqOrder S8{F.W<u16>(DF_Q), F.W<u16>(WS_WOD), 1024, 132, 4, F.bx, F.G, 0}; EpiResid8 E8{res_ctx(F, first), li}; \
                pg8::gemm_phase(F.lds, 1024, 1024, S8, E8); SEAM(base + 4); } \
        } else { \
            if (EN(8) && IN(base + 1)) { pg8::SeqOrder S8{F.W<u16>(WS_H), F.W<u16>(WS_WING), 1024, 132, 13, F.bx, F.G, 0}; pg8::EpiGlaIn8 E8{F.W<u16>(GL_Q), F.W<u16>(GL_K), F.W<u16>(GL_V), F.W<u16>(GL_G), F.W<float>(GL_Z)}; \
                pg8::gemm_phase(F.lds, 1024, 1024, S8, E8); \
                if (REP(8)) { GRID_BAR(); pg8::gemm_phase(F.lds, 1024, 1024, S8, E8); } SEAM(base + 1); } \
            if (EN(9) && IN(base + 2)) { DUP(9, gla_g1(F)); SEAM(base + 2); } \
            if (EN(10) && IN(base + 3)) { gla_g2(F); SEAM(base + 3); } \
            if (EN(11) && IN(base + 4)) { DUP(11, gla_g3(F)); SEAM(base + 4); } \
            if (EN(8) && IN(base + 5)) { pg8::SeqOrder S8{F.W<u16>(WS_H), F.W<u16>(WS_WOG), 1024, 132, 4, F.bx, F.G, 0}; EpiResid8 E8{res_ctx(F, first), li}; \
                pg8::gemm_phase(F.lds, 1024, 1024, S8, E8); SEAM(base + 5); } \
        } \
        if (EN(12) && IN(base + 6)) { norm_phase<true>(F, li, last ? NCTX : 0, false); SEAM(base + 6); } \
        if (EN(13) && IN(base + 7)) { DUP(13, ((kind == 2 ? moe_weights(F, li) : (void)0), moe_scatter(F, li, last ? NCTX : 0))); SEAM(base + 7); } \
        if (EN(14) && IN(base + 8)) { DUP(14, moe_gemm_a(F, li)); SEAM(base + 8); } \
        if (EN(15) && IN(base + 9)) { moe_gemm_b(F, li); SEAM(base + 9); } \
    }
    LAYER(0) LAYER(1) LAYER(2) LAYER(3)
    if (EN(16) && IN(41)) { final_norm(F); }
}

extern "C" void kernel_launch(void* const* d_in, const int* in_sizes, int n_in, void* d_out, int out_size, void* d_ws, size_t ws_size, hipStream_t stream) {
    static int grid = 0;
    if (grid == 0) {
        if (n_in != 31 || out_size != NLAT * DM || ws_size < WS_END) {
            fprintf(stderr, "kernel_launch: built for 31 inputs, out %d floats, ws >= %zu bytes; got n_in %d out %d ws %zu\n", NLAT * DM, (size_t)WS_END, n_in, out_size, ws_size);
            grid = -1; return; }
        int dev = 0, cus = 0;
        if (hipGetDevice(&dev) != hipSuccess || hipDeviceGetAttribute(&cus, hipDeviceAttributeMultiprocessorCount, dev) != hipSuccess) { grid = -1; return; }
        if (hipFuncSetAttribute((const void*)fwd_kernel, hipFuncAttributeMaxDynamicSharedMemorySize, LDS_BYTES) != hipSuccess) { fprintf(stderr, "kernel_launch: hipFuncSetAttribute failed\n"); grid = -1; return; }
        int per_cu = 0;
        if (hipOccupancyMaxActiveBlocksPerMultiprocessor(&per_cu, (const void*)fwd_kernel, NTHR, LDS_BYTES) != hipSuccess || per_cu < 1)
            fprintf(stderr, "kernel_launch: occupancy query reports %d workgroups per CU\n", per_cu);
        (void)hipGetLastError();
        grid = cus;
    }
    if (grid < 0) return;
    (void)in_sizes;
    (void)hipMemsetAsync((char*)d_ws + WS_CTL, 0, CTL_BYTES, stream);
    Params p{};
    for (int i = 0; i < 31; ++i) p.in[i] = (const float*)d_in[i];
    p.out = (float*)d_out; p.ws = (unsigned char*)d_ws;
#if MK_PER_PHASE
    for (int ph = 0; ph < N_PHASES; ++ph) { p.ph_lo = ph; p.ph_hi = ph + 1; hipLaunchKernelGGL(fwd_kernel, dim3(grid), dim3(NTHR), LDS_BYTES, stream, p); }
#else
#ifdef MK_PROBE_HI
    p.ph_lo = 0; p.ph_hi = MK_PROBE_HI;
    hipLaunchKernelGGL(fwd_kernel, dim3(grid), dim3(NTHR), LDS_BYTES, stream, p);
    (void)hipMemsetAsync((char*)d_ws + WS_CTL, 0, CTL_BYTES, stream);
#endif
    p.ph_lo = 0; p.ph_hi = N_PHASES;
    hipLaunchKernelGGL(fwd_kernel, dim3(grid), dim3(NTHR), LDS_BYTES, stream, p);
#endif
}
```

```cpp
#include <hip/hip_runtime.h>
#include <stdint.h>
#include <stdio.h>

#ifndef MK_PER_PHASE
#define MK_PER_PHASE 0
#endif

typedef unsigned short u16;
using bf16x8 = __attribute__((ext_vector_type(8))) short;
using s16x4  = __attribute__((ext_vector_type(4))) short;
using f32x16 = __attribute__((ext_vector_type(16))) float;
using f32x4  = __attribute__((ext_vector_type(4))) float;
using u32x4  = __attribute__((ext_vector_type(4))) unsigned;
using u32x2  = __attribute__((ext_vector_type(2))) unsigned;

constexpr int DM = 1024, NBATCH = 4, SEQ = 8192, CTXL = 256, DEPTH = 4;
constexpr int NCTX = NBATCH * CTXL;
constexpr int NLAT = NBATCH * SEQ;
constexpr int NTOK = NCTX + NLAT;
constexpr int KEYS = CTXL + SEQ;
constexpr float EPS = 1e-6f;
constexpr int NTHR = 512, NWAVE = 8;
constexpr float LOG2E = 1.4426950408889634f;

constexpr size_t al256(size_t x) { return (x + 255) / 256 * 256; }
constexpr size_t WS_CTL   = 0;
constexpr size_t CTL_BYTES = 32768;
constexpr size_t WS_MODS  = WS_CTL + CTL_BYTES;
constexpr size_t WS_ROPEA = WS_MODS + al256((size_t)DEPTH * 5 * 6144 * 4);
constexpr size_t WS_ROPEB = WS_ROPEA + (size_t)2 * SEQ * 16 * 4;
constexpr size_t WS_XC    = WS_ROPEB + (size_t)2 * SEQ * 32 * 4;
constexpr size_t WS_WDQKV = WS_XC + (size_t)NCTX * DM * 4;
constexpr size_t WS_WUQ   = WS_WDQKV + (size_t)2 * 640 * 1024 * 2;
constexpr size_t WS_WUKV  = WS_WUQ + (size_t)2 * 1536 * 256 * 2;
constexpr size_t WS_WOM   = WS_WUKV + (size_t)2 * 2048 * 256 * 2;
constexpr size_t WS_WQKVD = WS_WOM + (size_t)2 * 1024 * 1024 * 2;
constexpr size_t WS_WOD   = WS_WQKVD + (size_t)3072 * 1024 * 2;
constexpr size_t WS_WING  = WS_WOD + (size_t)1024 * 1024 * 2;
constexpr size_t WS_WOG   = WS_WING + (size_t)3328 * 1024 * 2;
constexpr size_t WS_TOK   = WS_WOG + (size_t)1024 * 1024 * 2;
constexpr size_t WS_ROWTOK= WS_TOK + (size_t)NTOK * 16;
constexpr int    RMAX     = 40960;
constexpr size_t WS_ROWW  = WS_ROWTOK + (size_t)RMAX * 4;
constexpr size_t WS_H     = al256(WS_ROWW + (size_t)RMAX * 8);
constexpr size_t H_BYTES  = (size_t)NTOK * DM * 2;
constexpr size_t WS_MOEW  = WS_H + H_BYTES;
constexpr size_t MOE_WGU_BYTES = (size_t)16 * 1024 * 1024 * 2;
constexpr size_t MOE_WD_BYTES  = (size_t)16 * 1024 * 512 * 2;
constexpr size_t MOEW_BYTES = MOE_WGU_BYTES + MOE_WD_BYTES;
constexpr size_t WS_BIG   = WS_MOEW + MOEW_BYTES;
constexpr size_t MLA_Q    = WS_BIG;
constexpr size_t MLA_KN   = MLA_Q + (size_t)NBATCH * 16 * KEYS * 96 * 2;
constexpr size_t MLA_V    = MLA_KN + (size_t)NBATCH * 16 * KEYS * 64 * 2;
constexpr size_t MLA_KPE  = MLA_V + (size_t)NBATCH * 16 * KEYS * 64 * 2;
constexpr size_t MLA_DQ   = MLA_KPE + al256((size_t)NBATCH * KEYS * 32 * 2);
constexpr size_t MLA_CN   = MLA_DQ + (size_t)NTOK * 544 * 4;
constexpr size_t MLA_END  = MLA_CN + (size_t)NTOK * 512 * 2;
constexpr size_t DF_Q     = WS_BIG;
constexpr size_t DF_K     = DF_Q + (size_t)NBATCH * 16 * KEYS * 64 * 2;
constexpr size_t DF_V     = DF_K + (size_t)NBATCH * 16 * KEYS * 64 * 2;
constexpr size_t DF_OS    = DF_V + (size_t)NBATCH * 8 * KEYS * 128 * 2;
constexpr size_t DF_END   = DF_OS + (size_t)2 * NTOK * DM * 2;
constexpr size_t GL_STATE = WS_MOEW;
constexpr size_t GL_STATE_BYTES = (size_t)NBATCH * 4 * 2 * 132 * 128 * 256 * 2;
constexpr size_t GL_DEC   = GL_STATE + GL_STATE_BYTES;
constexpr size_t GL_Q     = GL_DEC + al256((size_t)4224 * 128 * 4);
constexpr size_t GL_K     = GL_Q + (size_t)NTOK * 512 * 2;
constexpr size_t GL_V     = GL_K + (size_t)NTOK * 512 * 2;
constexpr size_t GL_G     = GL_V + (size_t)NTOK * 1024 * 2;
constexpr size_t GL_Z     = GL_G + (size_t)NTOK * 1024 * 2;
constexpr size_t GL_END   = GL_Z + (size_t)NTOK * 32 * 4;
constexpr size_t MOE_ACT  = WS_BIG;
constexpr size_t MOE_END  = MOE_ACT + (size_t)RMAX * 1024 * 2;
constexpr size_t cmax(size_t a, size_t b) { return a > b ? a : b; }
constexpr size_t WS_END   = cmax(cmax(MLA_END, DF_END), cmax(GL_END, MOE_END));

#define XCD_BAR_WORDS 3456
constexpr int CW_CNT = 4096;
constexpr int CW_KMAX = 4352;
constexpr int CW_PEMAX = CW_KMAX + 512;

#define XB_TMO      128
#define XB_XCNT(j)  (256  + 64 * (j))
#define XB_XSUB(j)  (1280 + 64 * (j))
#define XB_XGEN(j)  (2304 + 64 * (j))
#define XB_TOP      3328
#define XB_TOPGEN   3392
#define XB_SPIN_CAP (1u << 24)
#define LAS __attribute__((address_space(3)))
__device__ __forceinline__ unsigned xb_ld(unsigned* p)              { return __hip_atomic_load(p, __ATOMIC_RELAXED, __HIP_MEMORY_SCOPE_AGENT); }
__device__ __forceinline__ unsigned xb_add(unsigned* p, unsigned v) { return __hip_atomic_fetch_add(p, v, __ATOMIC_RELAXED, __HIP_MEMORY_SCOPE_AGENT); }
__device__ __forceinline__ unsigned xb_xcc_id() { return (unsigned)__builtin_amdgcn_s_getreg((3 << 11) | 20) & 0xFu; }
#define XB_SPIN(cond, bar) do { unsigned _sp = 0; while (cond) { __builtin_amdgcn_s_sleep(1); \
    if ((++_sp & 255u) == 0u) { if (xb_ld(&(bar)[XB_TMO])) break; if (_sp > XB_SPIN_CAP) { atomicAdd(&(bar)[XB_TMO], 1u); break; } } } } while (0)
struct XcdBarrier { unsigned* bar; unsigned x; volatile LAS unsigned* st; };
__device__ __forceinline__ XcdBarrier xcd_barrier_post(unsigned* bar, volatile LAS unsigned* st) {
    XcdBarrier b; b.bar = bar; b.x = xb_xcc_id(); b.st = st;
    if (threadIdx.x == 0) (void)xb_add(&bar[XB_XCNT(b.x)], 1u);
    return b;
}
__device__ __forceinline__ void xcd_barrier_complete(unsigned* bar, unsigned x, unsigned& nloc, unsigned& nx) {
    const unsigned G = gridDim.x * gridDim.y * gridDim.z;
    unsigned sum, cnt, mine, sp = 0u;
    for (;;) {
        sum = 0u; cnt = 0u; mine = 0u;
#pragma unroll
        for (unsigned j = 0; j < 16; ++j) { const unsigned c = xb_ld(&bar[XB_XCNT(j)]); sum += c; cnt += (c > 0u) ? 1u : 0u; mine = (j == x) ? c : mine; }
        if (sum == G) break;
        __builtin_amdgcn_s_sleep(1);
        if ((++sp & 255u) == 0u) { if (xb_ld(&bar[XB_TMO])) break; if (sp > XB_SPIN_CAP) { atomicAdd(&bar[XB_TMO], 1u); break; } }
    }
    nloc = mine > 0u ? mine : 1u; nx = cnt > 0u ? cnt : 1u;
}
__device__ __forceinline__ void xcd_barrier(const XcdBarrier& b) {
    asm volatile("s_waitcnt vmcnt(0)" ::: "memory");
    __syncthreads();
    if (threadIdx.x == 0) {
        unsigned* bar = b.bar;
        __builtin_amdgcn_s_waitcnt(0);
        unsigned nloc = b.st[0], nx = b.st[1];
        if (nloc == 0u) { xcd_barrier_complete(bar, b.x, nloc, nx); b.st[0] = nloc; b.st[1] = nx; }
        const unsigned old = xb_add(&bar[XB_XSUB(b.x)], 1u);
        const unsigned gen = old / nloc;
        if (old + 1u == (gen + 1u) * nloc) {
            __builtin_amdgcn_fence(__ATOMIC_RELEASE, "agent");
            asm volatile("s_waitcnt vmcnt(0)" ::: "memory");
            const unsigned og = xb_add(&bar[XB_TOP], 1u);
            const unsigned tg = og / nx;
            if (og + 1u == (tg + 1u) * nx) xb_add(&bar[XB_TOPGEN], 1u);
            else XB_SPIN(xb_ld(&bar[XB_TOPGEN]) == tg, bar);
            __builtin_amdgcn_fence(__ATOMIC_ACQUIRE, "agent");
            xb_add(&bar[XB_XGEN(b.x)], 1u);
            asm volatile("s_waitcnt vmcnt(0)" ::: "memory");
        } else {
            XB_SPIN(xb_ld(&bar[XB_XGEN(b.x)]) == gen, bar);
            __builtin_amdgcn_fence(__ATOMIC_ACQUIRE, "agent");
            asm volatile("s_waitcnt vmcnt(0)" ::: "memory");
        }
    }
    __syncthreads();
}

__device__ __forceinline__ u16 f2bf(float f) { unsigned u = __float_as_uint(f); u += 0x7FFFu + ((u >> 16) & 1u); return (u16)(u >> 16); }
__device__ __forceinline__ float bf2f(u16 h) { return __uint_as_float((unsigned)h << 16); }
__device__ __forceinline__ unsigned cvtpk(float lo, float hi) { unsigned r; asm volatile("v_cvt_pk_bf16_f32 %0, %1, %2" : "=v"(r) : "v"(lo), "v"(hi)); return r; }
__device__ __forceinline__ float wave_sum(float v) {
#pragma unroll
    for (int o = 32; o; o >>= 1) v += __shfl_xor(v, o);
    return v;
}
__device__ __forceinline__ float wave_max_fast(float v) {
#define DPP_MAX(v, CTRL) (v) = fmaxf((v), __uint_as_float(__builtin_amdgcn_update_dpp(0u, __float_as_uint(v), (CTRL), 0xF, 0xF, false)))
    DPP_MAX(v, 0xB1); DPP_MAX(v, 0x4E); DPP_MAX(v, 0x141); DPP_MAX(v, 0x140);
#undef DPP_MAX
    { auto rr = __builtin_amdgcn_permlane16_swap(__float_as_uint(v), __float_as_uint(v), false, false); v = fmaxf(__uint_as_float(rr[0]), __uint_as_float(rr[1])); }
    { auto rr = __builtin_amdgcn_permlane32_swap(__float_as_uint(v), __float_as_uint(v), false, false); v = fmaxf(__uint_as_float(rr[0]), __uint_as_float(rr[1])); }
    return v;
}
__device__ __forceinline__ float sum_fq(float v) {
    { auto rr = __builtin_amdgcn_permlane16_swap(__float_as_uint(v), __float_as_uint(v), false, false); v = __uint_as_float(rr[0]) + __uint_as_float(rr[1]); }
    { auto rr = __builtin_amdgcn_permlane32_swap(__float_as_uint(v), __float_as_uint(v), false, false); v = __uint_as_float(rr[0]) + __uint_as_float(rr[1]); }
    return v;
}
__device__ __forceinline__ void atomic_fmax_pos(unsigned* p, float v) { atomicMax(p, __float_as_uint(v)); }
__device__ __forceinline__ int crow(int r, int hi) { return (r & 3) + 8 * (r >> 2) + 4 * hi; }
__device__ __forceinline__ void row_bp(int row, int& b, int& pos) {
    if (row < NCTX) { b = row >> 8; pos = row & 255; } else { const int r = row - NCTX; b = r >> 13; pos = CTXL + (r & (SEQ - 1)); }
}
__device__ __forceinline__ float silu_f(float x) { return x / (1.f + __expf(-x)); }
#define SBAR() __builtin_amdgcn_sched_barrier(0)

struct Params { const float* in[31]; float* out; unsigned char* ws; int ph_lo, ph_hi; };

struct RowsPlain  { const u16* base; long ld;
    __device__ __forceinline__ long off(int r) const { return (long)r * ld; }
    __device__ __forceinline__ const u16* kbase(int kt) const { return base + kt * 64; } };
struct RowsGather { const u16* base; long ld; const int* idx;
    __device__ __forceinline__ long off(int r) const { int t = idx[r]; t = t < 0 ? 0 : t; return (long)t * ld; }
    __device__ __forceinline__ const u16* kbase(int kt) const { return base + kt * 64; } };
struct RowsSplitK { const u16* b0; const u16* b1; long ld; int ks;
    __device__ __forceinline__ long off(int r) const { return (long)r * ld; }
    __device__ __forceinline__ const u16* kbase(int kt) const { return kt < ks ? b0 + kt * 64 : b1 + (kt - ks) * 64; } };

constexpr int GEMM_LDS = 2 * 384 * 128;

template <int WM, int WN, class AL, class BL, class EP>
__device__ __forceinline__ void gemm_tile(char* lds, const AL al, const BL bl, EP& ep, int brow, int bcol, int nk) {
    constexpr int BM = WM * 64, BN = WN * 64, STG = (BM + BN) * 128, NA = BM / 64, NB = BN / 64;
    const int tid = threadIdx.x, lane = tid & 63, wid = __builtin_amdgcn_readfirstlane(tid >> 6);
    const int wm = wid / WN, wn = wid % WN, r32 = lane & 31, hi = lane >> 5;
    long aoff[NA], boff[NB];
#pragma unroll
    for (int i = 0; i < NA; ++i) { const int r = (i * 8 + wid) * 8 + (lane >> 3); const int c = (lane & 7) ^ ((r >> 1) & 7); aoff[i] = al.off(brow + r) + c * 8; }
#pragma unroll
    for (int i = 0; i < NB; ++i) { const int r = (i * 8 + wid) * 8 + (lane >> 3); const int c = (lane & 7) ^ ((r >> 1) & 7); boff[i] = bl.off(bcol + r) + c * 8; }
    const int ldsw = wid * 1024 + lane * 16;
    int abase[2], bbase[2];
#pragma unroll
    for (int i = 0; i < 2; ++i) {
        const int ra = wm * 64 + i * 32 + r32; abase[i] = ra * 128 + ((hi ^ ((ra >> 1) & 7)) << 4);
        const int rb = wn * 64 + i * 32 + r32; bbase[i] = BM * 128 + rb * 128 + ((hi ^ ((rb >> 1) & 7)) << 4);
    }
    f32x16 acc[2][2];
#pragma unroll
    for (int i = 0; i < 2; ++i)
#pragma unroll
        for (int j = 0; j < 2; ++j) acc[i][j] = f32x16{};
#define GSTAGE(kt, buf) do { const u16* _ka = al.kbase(kt); const u16* _kb = bl.kbase(kt); char* _d = lds + (buf) * STG + ldsw; \
        _Pragma("unroll") for (int _i = 0; _i < NA; ++_i) __builtin_amdgcn_global_load_lds((const unsigned*)(_ka + aoff[_i]), (unsigned*)(_d + _i * 8192), 16, 0, 0); \
        _Pragma("unroll") for (int _i = 0; _i < NB; ++_i) __builtin_amdgcn_global_load_lds((const unsigned*)(_kb + boff[_i]), (unsigned*)(_d + BM * 128 + _i * 8192), 16, 0, 0); } while (0)
    __syncthreads();
    GSTAGE(0, 0);
    for (int kt = 0; kt < nk; ++kt) {
        asm volatile("s_waitcnt vmcnt(0)" ::: "memory");
        __syncthreads();
        if (kt + 1 < nk) GSTAGE(kt + 1, (kt + 1) & 1);
        const char* sb = lds + (kt & 1) * STG;
#pragma unroll
        for (int ks = 0; ks < 4; ++ks) {
            bf16x8 a0 = *(const bf16x8*)(sb + (abase[0] ^ (ks << 5)));
            bf16x8 a1 = *(const bf16x8*)(sb + (abase[1] ^ (ks << 5)));
            bf16x8 b0 = *(const bf16x8*)(sb + (bbase[0] ^ (ks << 5)));
            bf16x8 b1 = *(const bf16x8*)(sb + (bbase[1] ^ (ks << 5)));
            acc[0][0] = __builtin_amdgcn_mfma_f32_32x32x16_bf16(a0, b0, acc[0][0], 0, 0, 0);
            acc[0][1] = __builtin_amdgcn_mfma_f32_32x32x16_bf16(a0, b1, acc[0][1], 0, 0, 0);
            acc[1][0] = __builtin_amdgcn_mfma_f32_32x32x16_bf16(a1, b0, acc[1][0], 0, 0, 0);
            acc[1][1] = __builtin_amdgcn_mfma_f32_32x32x16_bf16(a1, b1, acc[1][1], 0, 0, 0);
        }
    }
#undef GSTAGE
    ep(acc, brow + wm * 64, bcol + wn * 64, lane);
}


constexpr int GSTG = 384 * 128;
template <class AL_, class BL_, class EP_> struct GTile { typedef EP_ EPT; AL_ al; BL_ bl; EP_ ep; int brow, bcol; };
__device__ __forceinline__ bool tile_seq(int i, int bx, int G, int nM, int nN, int& m, int& n) {
    const int s = (G == 256) ? (i * 8 + (bx & 7)) * 32 + (bx >> 3) : bx + i * G;
    if (s >= nM * nN) return false;
    const int full = (nM >> 2) * 4 * nN;
    if (s < full) { const int band = s / (4 * nN), rem = s - band * 4 * nN; n = rem >> 2; m = band * 4 + (rem & 3); }
    else { const int h = nM & 3, rem = s - full; n = rem / h; m = (nM & ~3) + rem - n * h; }
    return true;
}
template <class AL_, class BL_, class EP_> struct PlainTiles {
    typedef GTile<AL_, BL_, EP_> Tile; static constexpr bool EP_CONST = true;
    AL_ al; BL_ bl; EP_ ep; int mt0, nM, nN, bx, G;
    __device__ __forceinline__ bool get(int i, Tile& t) const {
        int m, n; if (!tile_seq(i, bx, G, nM, nN, m, n)) return false;
        t.al = al; t.bl = bl; t.ep = ep; t.brow = (mt0 + m) * 256; t.bcol = n * 128; return true; }
};
template <int WM, int WN, class P>
__device__ __forceinline__ void gemm_stream(char* lds, const P& prov, int nk) {
    constexpr int BM = WM * 64, BN = WN * 64, NA = BM / 64, NB = BN / 64;
    static_assert(NA + NB == 6, "the counted wait assumes six LDS-DMA loads per wave per K-step");
    const int tid = threadIdx.x, lane = tid & 63, wid = __builtin_amdgcn_readfirstlane(tid >> 6);
    const int wm = wid / WN, wn = wid % WN, r32 = lane & 31, hi = lane >> 5;
    typename P::Tile cur, nxt;
    if (!prov.get(0, cur)) return;
    unsigned aoff[NA], boff[NB], aoffn[NA], boffn[NB];
#define GOFFS(T, AO, BO) do { \
    _Pragma("unroll") for (int _i = 0; _i < NA; ++_i) { const int _r = (_i * 8 + wid) * 8 + (lane >> 3); const int _c = (lane & 7) ^ ((_r >> 1) & 7); AO[_i] = (unsigned)((T).al.off((T).brow + _r) + _c * 8); } \
    _Pragma("unroll") for (int _i = 0; _i < NB; ++_i) { const int _r = (_i * 8 + wid) * 8 + (lane >> 3); const int _c = (lane & 7) ^ ((_r >> 1) & 7); BO[_i] = (unsigned)((T).bl.off((T).bcol + _r) + _c * 8); } } while (0)
#define GSTAGE2(T, AO, BO, kt, slot) do { const u16* _ka = (T).al.kbase(kt); const u16* _kb = (T).bl.kbase(kt); char* _d = lds + (slot) * GSTG + ldsw; \
        _Pragma("unroll") for (int _i = 0; _i < NA; ++_i) __builtin_amdgcn_global_load_lds((const unsigned*)(_ka + AO[_i]), (unsigned*)(_d + _i * 8192), 16, 0, 0); \
        _Pragma("unroll") for (int _i = 0; _i < NB; ++_i) __builtin_amdgcn_global_load_lds((const unsigned*)(_kb + BO[_i]), (unsigned*)(_d + BM * 128 + _i * 8192), 16, 0, 0); } while (0)
    GOFFS(cur, aoff, boff);
    const int ldsw = wid * 1024 + lane * 16;
    int abase[2], bbase[2];
#pragma unroll
    for (int i = 0; i < 2; ++i) {
        const int ra = wm * 64 + i * 32 + r32; abase[i] = ra * 128 + ((hi ^ ((ra >> 1) & 7)) << 4);
        const int rb = wn * 64 + i * 32 + r32; bbase[i] = BM * 128 + rb * 128 + ((hi ^ ((rb >> 1) & 7)) << 4);
    }
    f32x16 acc[2][2];
#pragma unroll
    for (int i = 0; i < 2; ++i)
#pragma unroll
        for (int j = 0; j < 2; ++j) acc[i][j] = f32x16{};
    __syncthreads();
    GSTAGE2(cur, aoff, boff, 0, 0); GSTAGE2(cur, aoff, boff, 1, 1);
    int slot = 0; bool pendE = false; typename P::Tile::EPT pep = cur.ep; int pbrow = 0, pbcol = 0;
    for (int i = 0;; ++i) {
        const bool has_next = prov.get(i + 1, nxt);
        if (has_next) GOFFS(nxt, aoffn, boffn);
        for (int kt = 0; kt < nk; ++kt) {
            if ((kt + 1 < nk) || has_next) asm volatile("s_waitcnt vmcnt(6)" ::: "memory"); else asm volatile("s_waitcnt vmcnt(0)" ::: "memory");
            __builtin_amdgcn_s_barrier(); asm volatile("" ::: "memory");
            const int s2 = slot >= 1 ? slot - 1 : 2;
            if (kt + 2 < nk) GSTAGE2(cur, aoff, boff, kt + 2, s2); else if (has_next) GSTAGE2(nxt, aoffn, boffn, kt + 2 - nk, s2);
            if (kt == 0 && pendE) {
                if constexpr (P::EP_CONST) (void)prov.ep(acc, pbrow + wm * 64, pbcol + wn * 64, lane); else (void)pep(acc, pbrow + wm * 64, pbcol + wn * 64, lane);
                pendE = false;
#pragma unroll
                for (int a = 0; a < 2; ++a)
#pragma unroll
                    for (int b = 0; b < 2; ++b) acc[a][b] = f32x16{};
            }
            const char* sb = lds + slot * GSTG;
#pragma unroll
            for (int ks = 0; ks < 4; ++ks) {
                bf16x8 a0 = *(const bf16x8*)(sb + (abase[0] ^ (ks << 5)));
                bf16x8 a1 = *(const bf16x8*)(sb + (abase[1] ^ (ks << 5)));
                bf16x8 b0 = *(const bf16x8*)(sb + (bbase[0] ^ (ks << 5)));
                bf16x8 b1 = *(const bf16x8*)(sb + (bbase[1] ^ (ks << 5)));
                acc[0][0] = __builtin_amdgcn_mfma_f32_32x32x16_bf16(b0, a0, acc[0][0], 0, 0, 0);
                acc[0][1] = __builtin_amdgcn_mfma_f32_32x32x16_bf16(b1, a0, acc[0][1], 0, 0, 0);
                acc[1][0] = __builtin_amdgcn_mfma_f32_32x32x16_bf16(b0, a1, acc[1][0], 0, 0, 0);
                acc[1][1] = __builtin_amdgcn_mfma_f32_32x32x16_bf16(b1, a1, acc[1][1], 0, 0, 0);
            }
            slot = slot == 2 ? 0 : slot + 1;
        }
        if (!has_next) { (void)cur.ep(acc, cur.brow + wm * 64, cur.bcol + wn * 64, lane); break; }
        if constexpr (!P::EP_CONST) pep = cur.ep;
        pbrow = cur.brow; pbcol = cur.bcol; pendE = true;
        cur = nxt;
#pragma unroll
        for (int a = 0; a < NA; ++a) aoff[a] = aoffn[a];
#pragma unroll
        for (int b = 0; b < NB; ++b) boff[b] = boffn[b];
    }
    asm volatile("s_waitcnt vmcnt(0)" ::: "memory");
    __syncthreads();
#undef GOFFS
#undef GSTAGE2
}


template <int NF> __device__ __forceinline__ void rope_cs(int n, int i, float& cs, float& sn) {
    const int fi = i & (NF - 1); const float pos = (i < NF) ? (float)(n >> 6) : (float)(n & 63);
    const float invf = __builtin_amdgcn_exp2f(-(float)fi / (float)NF * 13.287712379549449f);
    const float ang = pos * invf; float rev = ang * 0.15915494309189535f; rev -= floorf(rev);
    cs = __builtin_amdgcn_cosf(rev); sn = __builtin_amdgcn_sinf(rev);
}
namespace pg8 {
constexpr int BM = 256, BK = 64, HALF = 128, HTB = HALF * BK * 2, STAGE_BYTES = 8 * HTB;
__device__ __forceinline__ int lds_byte(int r, int c) { const int st = (r >> 4) * 2 + (c >> 5), rr = r & 15, cc = c & 31, ob = rr * 64 + cc * 2; return st * 1024 + (ob ^ (((ob >> 9) & 1) << 5)); }
__device__ __forceinline__ void stage_rc(int b, int& R, int& C) { const int st = b / 1024, sb = b % 1024, swz = sb ^ (((sb >> 9) & 1) << 5); R = (st >> 1) * 16 + swz / 64; C = (st & 1) * 32 + (swz % 64) / 2; }
struct Unit { int pm, pn; };
template <class Epi, class Sched>
__device__ __forceinline__ void gemm_phase(char* lds, int lda, int K, const Sched& S, const Epi& E) {
    constexpr bool GA = Sched::GATHER;
    const int tid = threadIdx.x, wid = __builtin_amdgcn_readfirstlane(tid >> 6), lane = tid & 63, wr = wid >> 2, wc = wid & 3, fr = lane & 15, fq = lane >> 4;
    const int nt = K / BK;
    unsigned voffB[2], vbA[2], vc0[2], vc1[2], vn0[2], vn1[2]; int sR[2], sC[2];
#pragma unroll
    for (int i = 0; i < 2; ++i) { stage_rc(tid * 16 + i * 8192, sR[i], sC[i]); voffB[i] = (unsigned)(sR[i] * K + sC[i]) * 2u; vbA[i] = (unsigned)(sR[i] * lda + sC[i]) * 2u; }
    const size_t kstep = (size_t)(BK * 2), hstep = (size_t)HALF * K * 2, hstepA = (size_t)HALF * lda * 2;
    const unsigned ldsw = (unsigned)wid * 1024u;
    const int aoff = lds_byte(wr * 64 + fr, fq * 8), boff = lds_byte(wc * 32 + fr, fq * 8);
#define PG8_AOFFS(u, v0, v1) do { _Pragma("unroll") for (int _i = 0; _i < 2; ++_i) { \
        if constexpr (GA) { v0[_i] = (unsigned)S.arow(u, sR[_i]) * (unsigned)(lda * 2) + (unsigned)sC[_i] * 2u; v1[_i] = (unsigned)S.arow(u, HALF + sR[_i]) * (unsigned)(lda * 2) + (unsigned)sC[_i] * 2u; } \
        else { v0[_i] = vbA[_i] + (unsigned)(u).pm * (unsigned)(256 * lda * 2); v1[_i] = v0[_i] + (unsigned)hstepA; } } } while (0)
#define PG8_SA(b, h) (((b) * 2 + (h)) * HTB)
#define PG8_SB(b, h) ((4 + (b) * 2 + (h)) * HTB)
#define PG8_STAGE(bufoff, gbase, voff) do { _Pragma("unroll") for (int _i = 0; _i < 2; ++_i) \
        __builtin_amdgcn_global_load_lds((const unsigned*)((const char*)(gbase) + (voff)[_i]), (unsigned*)(lds + (bufoff) + ldsw + _i * 8192), 16, 0, 0); } while (0)
#define PG8_STA(bufoff, kt, h, nx) do { const char* _g = ((nx) ? nAb : cAb) + (size_t)(kt) * kstep; unsigned _v[2]; \
        _Pragma("unroll") for (int _i = 0; _i < 2; ++_i) _v[_i] = (nx) ? ((h) ? vn1[_i] : vn0[_i]) : ((h) ? vc1[_i] : vc0[_i]); PG8_STAGE(bufoff, _g, _v); } while (0)
#define PG8_LDA(dst, b, h) do { _Pragma("unroll") for (int m = 0; m < 4; ++m) _Pragma("unroll") for (int k = 0; k < 2; ++k) dst[m][k] = *(const bf16x8*)(lds + PG8_SA(b, h) + aoff + m * 2048 + k * 1024); } while (0)
#define PG8_LDB(dst, b, h) do { _Pragma("unroll") for (int n = 0; n < 2; ++n) _Pragma("unroll") for (int k = 0; k < 2; ++k) dst[n][k] = *(const bf16x8*)(lds + PG8_SB(b, h) + boff + n * 2048 + k * 1024); } while (0)
#define PG8_MMA(ai, bj, At, Bt_) do { __builtin_amdgcn_s_setprio(1); _Pragma("unroll") for (int m = 0; m < 4; ++m) _Pragma("unroll") for (int n = 0; n < 2; ++n) _Pragma("unroll") for (int k = 0; k < 2; ++k) \
        acc[ai][bj][m][n] = __builtin_amdgcn_mfma_f32_16x16x32_bf16(Bt_[n][k], At[m][k], acc[ai][bj][m][n], 0, 0, 0); __builtin_amdgcn_s_setprio(0); } while (0)
#define PG8_WAIT_V(n) asm volatile("s_waitcnt vmcnt(" #n ")" ::: "memory")
#define PG8_WAIT_L(n) asm volatile("s_waitcnt lgkmcnt(" #n ")" ::: "memory")
#define PG8_BAR __builtin_amdgcn_s_barrier()
#define PG8_SCHED __builtin_amdgcn_sched_barrier(0)
    Unit cur, nxt; int ui = 0;
    if (!S.next(0, cur)) return;
    f32x4 acc[2][2][4][2];
#pragma unroll
    for (int a = 0; a < 2; ++a)
#pragma unroll
        for (int b = 0; b < 2; ++b)
#pragma unroll
            for (int m = 0; m < 4; ++m)
#pragma unroll
                for (int n = 0; n < 2; ++n) acc[a][b][m][n] = (f32x4){0.f, 0.f, 0.f, 0.f};
    bf16x8 At[4][2], B0[2][2], B1[2][2];
    PG8_AOFFS(cur, vc0, vc1);
    const char* cB = (const char*)S.bbase(cur); const char* cAb = (const char*)S.abase(cur); const char* nAb = cAb;
    __syncthreads();
    PG8_STAGE(PG8_SB(0, 0), cB, voffB); PG8_STA(PG8_SA(0, 0), 0, 0, false); PG8_STAGE(PG8_SB(0, 1), cB + hstep, voffB); PG8_STA(PG8_SA(0, 1), 0, 1, false);
    if (wr == 1) PG8_BAR;
    PG8_WAIT_V(4); PG8_BAR;
    PG8_STAGE(PG8_SB(1, 0), cB + kstep, voffB); PG8_STA(PG8_SA(1, 0), 1, 0, false); PG8_STAGE(PG8_SB(1, 1), cB + hstep + kstep, voffB);
    PG8_WAIT_V(6); PG8_BAR;
    for (;;) {
        const bool has_next = S.next(ui + 1, nxt);
        const char* nB = cB;
        nAb = cAb;
        if (has_next) { PG8_AOFFS(nxt, vn0, vn1); nB = (const char*)S.bbase(nxt); nAb = (const char*)S.abase(nxt); }
        else {
#pragma unroll
            for (int i = 0; i < 2; ++i) { vn0[i] = vc0[i]; vn1[i] = vc1[i]; } }
#pragma unroll 1
        for (int t = 0; t < nt; t += 2) {
            const bool last = (t == nt - 2);
            const int k2 = last ? 0 : t + 2, k3 = k2 + 1;
            const char* b2 = last ? nB : cB + (size_t)(t + 2) * kstep; const char* b3 = b2 + kstep;
            PG8_LDB(B0, 0, 0); PG8_SCHED; PG8_LDA(At, 0, 0); PG8_STA(PG8_SA(1, 1), t + 1, 1, false);
            PG8_WAIT_L(8); PG8_BAR; PG8_WAIT_L(0); PG8_MMA(0, 0, At, B0); PG8_BAR; PG8_SCHED;
            PG8_LDB(B1, 0, 1); PG8_STAGE(PG8_SB(0, 0), b2, voffB);
            PG8_BAR; PG8_WAIT_L(0); PG8_MMA(0, 1, At, B1); PG8_BAR;
            PG8_LDA(At, 0, 1); PG8_STA(PG8_SA(0, 0), k2, 0, last);
            PG8_BAR; PG8_WAIT_L(0); PG8_MMA(1, 0, At, B0); PG8_BAR; PG8_SCHED;
            PG8_STAGE(PG8_SB(0, 1), b2 + hstep, voffB);
            PG8_WAIT_V(6); PG8_BAR; PG8_MMA(1, 1, At, B1); PG8_BAR;
            PG8_LDB(B0, 1, 0); PG8_SCHED; PG8_LDA(At, 1, 0); PG8_STA(PG8_SA(0, 1), k2, 1, last);
            PG8_WAIT_L(8); PG8_BAR; PG8_WAIT_L(0); PG8_MMA(0, 0, At, B0); PG8_BAR; PG8_SCHED;
            PG8_LDB(B1, 1, 1); PG8_STAGE(PG8_SB(1, 0), b3, voffB);
            PG8_BAR; PG8_WAIT_L(0); PG8_MMA(0, 1, At, B1); PG8_BAR;
            PG8_LDA(At, 1, 1); PG8_STA(PG8_SA(1, 0), k3, 0, last);
            PG8_BAR; PG8_WAIT_L(0); PG8_MMA(1, 0, At, B0); PG8_BAR; PG8_SCHED;
            PG8_STAGE(PG8_SB(1, 1), b3 + hstep, voffB);
            PG8_WAIT_V(6); PG8_BAR; PG8_MMA(1, 1, At, B1); PG8_BAR;
        }
        E(acc, cur, wr, wc, fr, fq);
        if (!has_next) break;
#pragma unroll
        for (int a = 0; a < 2; ++a)
#pragma unroll
            for (int b = 0; b < 2; ++b)
#pragma unroll
                for (int m = 0; m < 4; ++m)
#pragma unroll
                    for (int n = 0; n < 2; ++n) acc[a][b][m][n] = (f32x4){0.f, 0.f, 0.f, 0.f};
        cur = nxt; cB = nB; cAb = nAb; ++ui;
#pragma unroll
        for (int i = 0; i < 2; ++i) { vc0[i] = vn0[i]; vc1[i] = vn1[i]; }
    }
    PG8_WAIT_V(0);
    if (wr == 0) PG8_BAR;
    PG8_BAR;
#undef PG8_AOFFS
#undef PG8_STA
#undef PG8_SA
#undef PG8_SB
#undef PG8_STAGE
#undef PG8_LDA
#undef PG8_LDB
#undef PG8_MMA
#undef PG8_WAIT_V
#undef PG8_WAIT_L
#undef PG8_BAR
#undef PG8_SCHED
}
struct SeqOrder { static constexpr bool GATHER = false; const u16* A; const u16* Bt; int K, nM, nN, bx, G, mt0;
    __device__ __forceinline__ const u16* abase(const Unit&) const { return A; }
    __device__ __forceinline__ bool next(int i, Unit& u) const { const bool ok = tile_seq(i, bx, G, nM, nN, u.pm, u.pn); u.pm += mt0; return ok; }
    __device__ __forceinline__ const u16* bbase(const Unit& u) const { return Bt + (size_t)u.pn * 256 * K; }
    __device__ __forceinline__ int arow(const Unit& u, int r) const { return u.pm * 256 + r; } };
struct EpiGlaIn8 { u16* q; u16* k; u16* v; u16* g; float* z;
    __device__ __forceinline__ void operator()(const f32x4 (&acc)[2][2][4][2], const Unit& u, int wr, int wc, int fr, int fq) const {
#pragma unroll
        for (int bj = 0; bj < 2; ++bj)
#pragma unroll
            for (int n = 0; n < 2; ++n) { const int c0 = u.pn * 256 + bj * 128 + wc * 32 + n * 16, col = c0 + 4 * fq;
                if (c0 >= 3104) continue;
                u16* base; int ld, cc; float scl = 1.f;
                if (c0 < 512) { base = q; ld = 512; cc = col; scl = 0.08838834764831845f; } else if (c0 < 1024) { base = k; ld = 512; cc = col - 512; }
                else if (c0 < 2048) { base = v; ld = 1024; cc = col - 1024; } else if (c0 < 3072) { base = g; ld = 1024; cc = col - 2048; } else { base = nullptr; ld = 32; cc = col - 3072; }
#pragma unroll
                for (int ai = 0; ai < 2; ++ai)
#pragma unroll
                    for (int m = 0; m < 4; ++m) { const size_t row = (size_t)u.pm * 256 + ai * 128 + wr * 64 + m * 16 + fr; const f32x4 a = acc[ai][bj][m][n];
                        if (c0 < 3072) { u32x2 w = {cvtpk(a[0] * scl, a[1] * scl), cvtpk(a[2] * scl, a[3] * scl)}; *(u32x2*)(base + row * ld + cc) = w; }
                        else *(f32x4*)(z + row * 32 + cc) = a; } }
    } };
struct EpiDiffQKV8 { u16* Q; long kdelta; u16* V; float qscale; unsigned* km;
    __device__ __forceinline__ void operator()(const f32x4 (&acc)[2][2][4][2], const Unit& u, int wr, int wc, int fr, int fq) const {
        float kmx = 0.f;
#pragma unroll
        for (int ai = 0; ai < 2; ++ai)
#pragma unroll
            for (int m = 0; m < 4; ++m) { int frr = fr; asm volatile("" : "+v"(frr));
                const int row = u.pm * 256 + ai * 128 + wr * 64 + m * 16 + frr; int b, pos; row_bp(row, b, pos); const bool lat = row >= NCTX; const int np = (row - NCTX) & (SEQ - 1);
                if (u.pn < 8) { const int region = u.pn >> 2, hh = (u.pn & 3) * 4 + wc; const float scl = region == 0 ? qscale : 1.f; float ks2 = 0.f;
                    u16* o = Q + (long)region * kdelta + ((size_t)(b * 16 + hh) * KEYS + pos) * 64;
#pragma unroll
                    for (int n = 0; n < 2; ++n) { const int d0 = 16 * n + 4 * fq; const f32x4 t1 = acc[ai][0][m][n], t2 = acc[ai][1][m][n]; float o1[4], o2[4];
#pragma unroll
                        for (int j = 0; j < 4; ++j) { float cs = 1.f, sn = 0.f; if (lat) rope_cs<16>(np, d0 + j, cs, sn); o1[j] = (t1[j] * cs - t2[j] * sn) * scl; o2[j] = (t1[j] * sn + t2[j] * cs) * scl; }
                        u32x2 w1 = {cvtpk(o1[0], o1[1]), cvtpk(o1[2], o1[3])}, w2 = {cvtpk(o2[0], o2[1]), cvtpk(o2[2], o2[3])};
                        *(u32x2*)(o + d0) = w1; *(u32x2*)(o + 32 + d0) = w2;
#pragma unroll
                        for (int j = 0; j < 4; ++j) ks2 += o1[j] * o1[j] + o2[j] * o2[j]; }
                    kmx = fmaxf(kmx, ks2);
                } else {
#pragma unroll
                    for (int bj = 0; bj < 2; ++bj) { const int head = (u.pn - 8) * 2 + bj; u16* o = V + ((size_t)(b * 8 + head) * KEYS + pos) * 128 + wc * 32 + 4 * fq;
#pragma unroll
                        for (int n = 0; n < 2; ++n) { const f32x4 a = acc[ai][bj][m][n]; u32x2 w = {cvtpk(a[0], a[1]), cvtpk(a[2], a[3])}; *(u32x2*)(o + 16 * n) = w; } }
                } }
        if (u.pn >= 4 && u.pn < 8) {
            const int b = u.pm < 4 ? u.pm : ((u.pm - 4) >> 5); const float v = wave_max_fast(sum_fq(kmx));
            if (fr == 0 && fq == 0) atomic_fmax_pos(km + ((b * 16 + (u.pn & 3) * 4 + wc) * 2), v); }
    } };
struct MoeAOrder { static constexpr bool GATHER = true; const u16* A; const int* tab; const int* rowtok; const u16* wgu; int nmt, bx, G;
    __device__ __forceinline__ const u16* abase(const Unit&) const { return A; }
    __device__ __forceinline__ bool next(int i, Unit& u) const { return tile_seq(i, bx, G, nmt, 8, u.pm, u.pn); }
    __device__ __forceinline__ const u16* bbase(const Unit& u) const {
        const int c = tab[32 + u.pm], g = c / 6, p = c - g * 6; const int elo = p < 3 ? 0 : (p < 5 ? 1 : 2), ehi = p < 3 ? p + 1 : (p < 5 ? p - 1 : 3);
        const int e = (u.pn >> 2) ? ehi : elo; return wgu + ((size_t)(g * 4 + e) * 1024 + (u.pn & 3) * 256) * 1024; }
    __device__ __forceinline__ int arow(const Unit& u, int r) const { const int t = rowtok[u.pm * 256 + r]; return t < 0 ? 0 : t; } };
struct EpiMoeA8 { u16* act; const float* roww;
    __device__ __forceinline__ void operator()(const f32x4 (&acc)[2][2][4][2], const Unit& u, int wr, int wc, int fr, int fq) const {
        const int half = u.pn >> 2, cb = half * 512 + (u.pn & 3) * 128 + wc * 32 + 4 * fq;
#pragma unroll
        for (int ai = 0; ai < 2; ++ai)
#pragma unroll
            for (int m = 0; m < 4; ++m) { const size_t row = (size_t)u.pm * 256 + ai * 128 + wr * 64 + m * 16 + fr; const float w = roww[2 * row + half];
#pragma unroll
                for (int n = 0; n < 2; ++n) { const f32x4 gt = acc[ai][0][m][n], up = acc[ai][1][m][n]; float v[4];
#pragma unroll
                    for (int j = 0; j < 4; ++j) v[j] = silu_f(gt[j]) * up[j] * w;
                    u32x2 pk = {cvtpk(v[0], v[1]), cvtpk(v[2], v[3])}; *(u32x2*)(act + row * 1024 + cb + 16 * n) = pk; } }
    } };
struct MlaUpOrder { static constexpr bool GATHER = false; const u16* CN; const u16* wuq; const u16* wukv; int bx, G;
    __device__ __forceinline__ bool next(int i, Unit& u) const { return tile_seq(i, bx, G, 132, 14, u.pm, u.pn); }
    __device__ __forceinline__ const u16* abase(const Unit& u) const { return u.pn < 6 ? CN : CN + 256; }
    __device__ __forceinline__ const u16* bbase(const Unit& u) const { return u.pn < 6 ? wuq + (size_t)u.pn * 256 * 256 : wukv + (size_t)(u.pn - 6) * 256 * 256; }
    __device__ __forceinline__ int arow(const Unit& u, int r) const { return u.pm * 256 + r; } };
struct EpiMlaUp8 { u16* Q; u16* Kn; long vdelta; float qscale; unsigned* km;
    __device__ __forceinline__ void operator()(const f32x4 (&acc)[2][2][4][2], const Unit& u, int wr, int wc, int fr, int fq) const {
        float kmx[2] = {0.f, 0.f};
#pragma unroll
        for (int ai = 0; ai < 2; ++ai)
#pragma unroll
            for (int m = 0; m < 4; ++m) { int frr = fr; asm volatile("" : "+v"(frr));
                const int row = u.pm * 256 + ai * 128 + wr * 64 + m * 16 + frr; int b, pos; row_bp(row, b, pos); const bool lat = row >= NCTX; const int np = (row - NCTX) & (SEQ - 1);
                if (u.pn < 6) {
#pragma unroll
                    for (int bj = 0; bj < 2; ++bj) { const int sb = 8 * u.pn + 4 * bj + wc, head = sb / 3, part = sb - head * 3;
                        f32x4 v0 = acc[ai][bj][m][0] * qscale, v1 = acc[ai][bj][m][1] * qscale;
                        if (part == 2 && lat) {
#pragma unroll
                            for (int j = 0; j < 4; ++j) { float cs, sn; rope_cs<8>(np, 4 * fq + j, cs, sn); const float t1 = v0[j], t2 = v1[j]; v0[j] = t1 * cs - t2 * sn; v1[j] = t1 * sn + t2 * cs; } }
                        u16* o = Q + ((size_t)(b * 16 + head) * KEYS + pos) * 96 + part * 32 + 4 * fq;
                        u32x2 w0 = {cvtpk(v0[0], v0[1]), cvtpk(v0[2], v0[3])}, w1 = {cvtpk(v1[0], v1[1]), cvtpk(v1[2], v1[3])}; *(u32x2*)o = w0; *(u32x2*)(o + 16) = w1; }
                } else {
#pragma unroll
                    for (int bj = 0; bj < 2; ++bj) { const int head = (u.pn - 6) * 2 + bj; u16* o = Kn + (long)(wc >> 1) * vdelta + ((size_t)(b * 16 + head) * KEYS + pos) * 64 + (wc & 1) * 32 + 4 * fq;
                        float s2 = 0.f;
#pragma unroll
                        for (int n = 0; n < 2; ++n) { const f32x4 a = acc[ai][bj][m][n]; u32x2 w = {cvtpk(a[0], a[1]), cvtpk(a[2], a[3])}; *(u32x2*)(o + 16 * n) = w;
                            s2 += a[0] * a[0] + a[1] * a[1] + a[2] * a[2] + a[3] * a[3]; }
                        kmx[bj] = fmaxf(kmx[bj], s2); }
                } }
        if (u.pn >= 6 && wc < 2) {
            const int b = u.pm < 4 ? u.pm : ((u.pm - 4) >> 5);
#pragma unroll
            for (int bj = 0; bj < 2; ++bj) { const float v = wave_max_fast(sum_fq(kmx[bj])); if (fr == 0 && fq == 0) atomic_fmax_pos(km + ((b * 16 + (u.pn - 6) * 2 + bj) * 2 + wc), v); }
        }
    } };
}

template <int DK, int DV> struct AttnCfg {
    static constexpr int NKB = DK / 32, NVB = DV / 32, ND0 = DK / 16;
    static constexpr int KBYTES = 64 * DK * 2, VBYTES = 64 * DV * 2;
    static constexpr int LDS = 2 * KBYTES + 2 * VBYTES + NWAVE * 64 * 4;
};
constexpr float ATT_THR = 8.f;

__device__ __forceinline__ void partialSM(f32x16& p0, f32x16& p1, float& m_reg, float& mn, float& alpha) {
    float pmax = p0[0];
#pragma unroll
    for (int r = 1; r < 16; ++r) pmax = fmaxf(pmax, p0[r]);
#pragma unroll
    for (int r = 0; r < 16; ++r) pmax = fmaxf(pmax, p1[r]);
    { auto rr = __builtin_amdgcn_permlane32_swap(__float_as_uint(pmax), __float_as_uint(pmax), false, false);
      pmax = fmaxf(__uint_as_float(rr[0]), __uint_as_float(rr[1])); }
    if (__builtin_expect(__all(pmax - m_reg <= ATT_THR), 1)) { mn = m_reg; alpha = 1.f; }
    else { mn = fmaxf(m_reg, pmax); alpha = __builtin_amdgcn_exp2f(m_reg - mn); m_reg = mn; }
#pragma unroll
    for (int r = 0; r < 16; ++r) p0[r] = p0[r] - mn;
#pragma unroll
    for (int r = 0; r < 16; ++r) p1[r] = p1[r] - mn;
#pragma unroll
    for (int r = 0; r < 16; ++r) p0[r] = __builtin_amdgcn_exp2f(p0[r]);
}
#define PK4(P, BASE, OUT) do { unsigned a0 = cvtpk(P[BASE + 0], P[BASE + 1]), a1 = cvtpk(P[BASE + 2], P[BASE + 3]);   \
    unsigned b0 = cvtpk(P[BASE + 4], P[BASE + 5]), b1 = cvtpk(P[BASE + 6], P[BASE + 7]);                              \
    auto r0 = __builtin_amdgcn_permlane32_swap(a0, b0, false, false); auto r1 = __builtin_amdgcn_permlane32_swap(a1, b1, false, false); \
    u32x4 w = {r0[0], r1[0], r0[1], r1[1]}; OUT = *reinterpret_cast<bf16x8*>(&w); } while (0)
__device__ __forceinline__ void finishSM(f32x16& p0, f32x16& p1, float alpha, float& l_reg, bf16x8& pa0, bf16x8& pa1, bf16x8& pa2, bf16x8& pa3) {
#pragma unroll
    for (int r = 0; r < 16; ++r) p1[r] = __builtin_amdgcn_exp2f(p1[r]);
    float ps = 0;
#pragma unroll
    for (int r = 0; r < 16; ++r) ps += p0[r];
#pragma unroll
    for (int r = 0; r < 16; ++r) ps += p1[r];
    { auto rr = __builtin_amdgcn_permlane32_swap(__float_as_uint(ps), __float_as_uint(ps), false, false);
      ps = __uint_as_float(rr[0]) + __uint_as_float(rr[1]); }
    l_reg = l_reg * alpha + ps;
    PK4(p0, 0, pa0); PK4(p0, 8, pa1); PK4(p1, 0, pa2); PK4(p1, 8, pa3);
}
__device__ __forceinline__ void psm_first(f32x16& p0, f32x16& p1, float bound, float& m_reg, f32x16& negm) {
    float pmax = fmaxf(p0[0], p1[0]);
#pragma unroll
    for (int r = 1; r < 16; ++r) pmax = fmaxf(pmax, fmaxf(p0[r], p1[r]));
    { auto rr = __builtin_amdgcn_permlane32_swap(__float_as_uint(pmax), __float_as_uint(pmax), false, false);
      pmax = fmaxf(__uint_as_float(rr[0]), __uint_as_float(rr[1])); }
    m_reg = fminf(bound, pmax + 64.f);
#pragma unroll
    for (int r = 0; r < 16; ++r) { p0[r] -= m_reg; p1[r] -= m_reg; negm[r] = -m_reg; }
#pragma unroll
    for (int r = 0; r < 16; ++r) p0[r] = __builtin_amdgcn_exp2f(p0[r]);
}
__device__ __forceinline__ void psm_fix(f32x16& p0) {
#pragma unroll
    for (int r = 0; r < 16; ++r) p0[r] = __builtin_amdgcn_exp2f(p0[r]);
}
template <bool FIRST, bool KEEPN>
__device__ __forceinline__ void psm_rel(f32x16& p0, f32x16& p1, float& m_reg, f32x16& negm, float& alpha) {
    float pmax = fmaxf(p0[0], p1[0]);
#pragma unroll
    for (int r = 1; r < 16; ++r) pmax = fmaxf(pmax, fmaxf(p0[r], p1[r]));
    { auto rr = __builtin_amdgcn_permlane32_swap(__float_as_uint(pmax), __float_as_uint(pmax), false, false);
      pmax = fmaxf(__uint_as_float(rr[0]), __uint_as_float(rr[1])); }
    alpha = 1.f;
    if (FIRST || !__builtin_expect(__all(pmax <= ATT_THR), 1)) {
        const float d = FIRST ? pmax : fmaxf(pmax, 0.f);
        if (!FIRST) alpha = __builtin_amdgcn_exp2f(-d);
        m_reg += d;
#pragma unroll
        for (int r = 0; r < 16; ++r) { p0[r] -= d; p1[r] -= d; if (KEEPN) negm[r] = -m_reg; }
    }
#pragma unroll
    for (int r = 0; r < 16; ++r) p0[r] = __builtin_amdgcn_exp2f(p0[r]);
}
__device__ __forceinline__ bf16x8 pack8(const f32x16& p, int base) {
    u32x4 w = {cvtpk(p[base], p[base + 1]), cvtpk(p[base + 2], p[base + 3]), cvtpk(p[base + 4], p[base + 5]), cvtpk(p[base + 6], p[base + 7])};
    return *reinterpret_cast<bf16x8*>(&w);
}
__device__ __forceinline__ void fsm_rel(f32x16& p0, f32x16& p1, bf16x8& pa0, bf16x8& pa1, bf16x8& pa2, bf16x8& pa3) {
#pragma unroll
    for (int r = 0; r < 16; ++r) p1[r] = __builtin_amdgcn_exp2f(p1[r]);
    pa0 = pack8(p0, 0); pa1 = pack8(p0, 8); pa2 = pack8(p1, 0); pa3 = pack8(p1, 8);
}
__device__ __forceinline__ int k_lds_off(int row, int blk, int chunk) { return blk * 4096 + row * 64 + ((chunk ^ ((row >> 2) & 3)) << 4); }
template <int ND0>
__device__ __forceinline__ void qkt(f32x16& p0, f32x16& p1, const char* Ks, const bf16x8* qr, int r32, int hi, const f32x16& cinit) {
    p0 = cinit; p1 = cinit;
#pragma unroll
    for (int d0 = 0; d0 < ND0; ++d0) {
        const int ch = (d0 & 1) * 2 + hi;
        bf16x8 b0 = *reinterpret_cast<const bf16x8*>(Ks + k_lds_off(r32, d0 >> 1, ch));
        bf16x8 b1 = *reinterpret_cast<const bf16x8*>(Ks + k_lds_off(32 + r32, d0 >> 1, ch));
        p0 = __builtin_amdgcn_mfma_f32_32x32x16_bf16(b0, qr[d0], p0, 0, 0, 0);
        p1 = __builtin_amdgcn_mfma_f32_32x32x16_bf16(b1, qr[d0], p1, 0, 0, 0);
    }
}
template <int NVB, bool SWAP = true> __device__ __forceinline__ int v_st(int k, int c) {
    const int kk = SWAP ? ((k & ~0xC) | ((k & 4) << 1) | ((k & 8) >> 1)) : k;
    return ((kk >> 3) * NVB + (c >> 5)) * 512 + ((kk & 7) * 32 + (c & 31)) * 2;
}
__device__ __forceinline__ int v_rd_base(int lane) { return ((lane & 3) << 3) | (((lane >> 2) & 3) << 6) | (((lane >> 4) & 1) << 5) | (((lane >> 5) & 1) << 8); }
template <int OFF> __device__ __forceinline__ s16x4 tr_read(int vb) {
    return __builtin_amdgcn_ds_read_tr16_b64_v4i16((LAS s16x4*)(unsigned)(vb + OFF));
}
#define PKV(L, H) (bf16x8){L[0], L[1], L[2], L[3], H[0], H[1], H[2], H[3]}
template <int D0, int NVB> __device__ __forceinline__ void pv_one(f32x16& od, int vb, bf16x8 pa0, bf16x8 pa1, bf16x8 pa2, bf16x8 pa3) {
    constexpr int KS = 2 * NVB * 512, HF = NVB * 512, B0 = D0 * 512;
    const s16x4 l0 = tr_read<B0 + 0 * KS>(vb), h0 = tr_read<B0 + 0 * KS + HF>(vb), l1 = tr_read<B0 + 1 * KS>(vb), h1 = tr_read<B0 + 1 * KS + HF>(vb);
    const s16x4 l2 = tr_read<B0 + 2 * KS>(vb), h2 = tr_read<B0 + 2 * KS + HF>(vb), l3 = tr_read<B0 + 3 * KS>(vb), h3 = tr_read<B0 + 3 * KS + HF>(vb);
    od = __builtin_amdgcn_mfma_f32_32x32x16_bf16(pa0, PKV(l0, h0), od, 0, 0, 0);
    od = __builtin_amdgcn_mfma_f32_32x32x16_bf16(pa1, PKV(l1, h1), od, 0, 0, 0);
    od = __builtin_amdgcn_mfma_f32_32x32x16_bf16(pa2, PKV(l2, h2), od, 0, 0, 0);
    od = __builtin_amdgcn_mfma_f32_32x32x16_bf16(pa3, PKV(l3, h3), od, 0, 0, 0);
}
template <int NVB> __device__ __forceinline__ void pv_all(f32x16* o, int vb, bf16x8 pa0, bf16x8 pa1, bf16x8 pa2, bf16x8 pa3) {
    pv_one<0, NVB>(o[0], vb, pa0, pa1, pa2, pa3); pv_one<1, NVB>(o[1], vb, pa0, pa1, pa2, pa3);
    if constexpr (NVB == 4) { pv_one<2, NVB>(o[2], vb, pa0, pa1, pa2, pa3); pv_one<3, NVB>(o[3], vb, pa0, pa1, pa2, pa3); }
}

template <int DK, int DV>
__device__ __forceinline__ void attn_item(const u16* __restrict__ Qb, const u16* __restrict__ Ka, const u16* __restrict__ Kb, const u16* __restrict__ Vh,
                                          int nkeys, u16* __restrict__ Ob, long ldo, char* lds, float kmax2) {
    using C = AttnCfg<DK, DV>;
    constexpr int NVB = C::NVB, ND0 = C::ND0, NKI = (DK / 32) * 4, NVI = DV / 8, NI = NKI + NVI;
    static_assert(NI <= 24, "three LDS-DMA pieces per wave per tile");
    const int tid = threadIdx.x, wid = __builtin_amdgcn_readfirstlane(tid >> 6), lane = tid & 63, r32 = lane & 31, hi = lane >> 5;
    char* K_lds = lds; char* V_lds = lds + 3 * C::KBYTES;
    float* al_l = (float*)(lds + 3 * C::KBYTES + 3 * C::VBYTES) + wid * 32;
    float m_reg = 0.f; f32x16 o[NVB], ol, negm; bf16x8 qr[ND0];
#pragma unroll
    for (int d = 0; d < NVB; ++d) o[d] = f32x16{};
    ol = f32x16{}; negm = f32x16{};
    const u32x4 ones_w = {0x3F803F80u, 0x3F803F80u, 0x3F803F80u, 0x3F803F80u}; const bf16x8 ones = *reinterpret_cast<const bf16x8*>(&ones_w);
    const u16* Qw = Qb + (long)(wid * 32 + r32) * DK + hi * 8;
#pragma unroll
    for (int d0 = 0; d0 < ND0; ++d0) qr[d0] = *reinterpret_cast<const bf16x8*>(Qw + d0 * 16);
    const u16* src[3]; int dst[3], stp[3]; bool isk[3];
#pragma unroll
    for (int i = 0; i < 3; ++i) { int q = wid + 8 * i; if (q >= NI) q -= 8;
        if (q < NKI) { const int blk = q >> 2, part = q & 3, row = 16 * part + (lane >> 2), c = (lane & 3) ^ ((row >> 2) & 3);
            isk[i] = true; dst[i] = blk * 4096 + part * 1024 + lane * 16;
            if (DK == 96 && blk == 2) { src[i] = Kb + row * 32 + c * 8; stp[i] = 64 * 32; } else { src[i] = Ka + row * 64 + blk * 32 + c * 8; stp[i] = 64 * 64; } }
        else { const int v = q - NKI; int key, col;
            if (NVB == 2) { key = 8 * v + ((lane & 31) >> 2); col = (lane >> 5) * 32 + (lane & 3) * 8; }
            else { key = 8 * (v >> 1) + ((lane & 31) >> 2); col = ((v & 1) * 2 + (lane >> 5)) * 32 + (lane & 3) * 8; }
            isk[i] = false; dst[i] = 3 * C::KBYTES + v * 1024 + lane * 16; src[i] = Vh + key * DV + col; stp[i] = 64 * DV; } }
    const int NT = nkeys / 64;
#define LOADG(kt, vt) do { const int _kt = (kt) < NT ? (kt) : NT - 1, _vt = (vt) < NT ? (vt) : NT - 1; const int _ks = _kt % 3, _vs = _vt % 3; \
        _Pragma("unroll") for (int _i = 0; _i < 3; ++_i) { const int _t = isk[_i] ? _kt : _vt; const int _so = isk[_i] ? _ks * C::KBYTES : _vs * C::VBYTES; \
            __builtin_amdgcn_global_load_lds((const unsigned*)(src[_i] + (long)_t * stp[_i]), (unsigned*)(lds + _so + dst[_i]), 16, 0, 0); } } while (0)
#define RESC(a) do { if (__any((a) < 1.f)) { if (hi == 0) al_l[r32] = (a); asm volatile("s_waitcnt lgkmcnt(0)" ::: "memory"); \
        _Pragma("unroll") for (int r = 0; r < 16; ++r) { const float _f = al_l[crow(r, hi)]; ol[r] *= _f; _Pragma("unroll") for (int d = 0; d < NVB; ++d) o[d][r] *= _f; } } } while (0)
#define PVL(vb) do { pv_all<NVB>(o, (vb), pa0, pa1, pa2, pa3); \
        ol = __builtin_amdgcn_mfma_f32_32x32x16_bf16(pa0, ones, ol, 0, 0, 0); ol = __builtin_amdgcn_mfma_f32_32x32x16_bf16(pa1, ones, ol, 0, 0, 0); \
        ol = __builtin_amdgcn_mfma_f32_32x32x16_bf16(pa2, ones, ol, 0, 0, 0); ol = __builtin_amdgcn_mfma_f32_32x32x16_bf16(pa3, ones, ol, 0, 0, 0); } while (0)
#define NEGM() do { if constexpr (DV == 128) { _Pragma("unroll") for (int r = 0; r < 16; ++r) negm[r] = -m_reg; } } while (0)
#define TILEBAR(n) do { if ((n) == 3) asm volatile("s_waitcnt vmcnt(3)" ::: "memory"); else asm volatile("s_waitcnt vmcnt(0)" ::: "memory"); __builtin_amdgcn_s_barrier(); asm volatile("" ::: "memory"); } while (0)
    const int vrb = (int)(uintptr_t)V_lds + v_rd_base(lane);
    f32x16 pA0, pA1, pB0, pB1; float alA, alB; bf16x8 pa0, pa1, pa2, pa3;
    __syncthreads();
    LOADG(0, 0); LOADG(1, 0);
    TILEBAR(3); LOADG(2, 1);
    float qs = 0.f;
#pragma unroll
    for (int d0 = 0; d0 < ND0; ++d0)
#pragma unroll
        for (int e = 0; e < 8; ++e) { const float f = bf2f((u16)qr[d0][e]); qs += f * f; }
    { auto rr = __builtin_amdgcn_permlane32_swap(__float_as_uint(qs), __float_as_uint(qs), false, false); qs = __uint_as_float(rr[0]) + __uint_as_float(rr[1]); }
    const float bound = sqrtf(qs * kmax2) * 1.01f + 1.f;
    qkt<ND0>(pA0, pA1, K_lds, qr, r32, hi, negm); psm_first(pA0, pA1, bound, m_reg, negm);
    int ks = 1, vs = 0;
    for (int j = 1; j + 1 < NT; j += 2) {
        TILEBAR(3);
        SBAR(); NEGM(); qkt<ND0>(pB0, pB1, K_lds + ks * C::KBYTES, qr, r32, hi, negm);
        fsm_rel(pA0, pA1, pa0, pa1, pa2, pa3);
        SBAR(); LOADG(j + 2, j + 1); SBAR();
        PVL(vrb + vs * C::VBYTES); psm_fix(pB0);
        ks = ks == 2 ? 0 : ks + 1; vs = vs == 2 ? 0 : vs + 1;
        TILEBAR(3);
        SBAR(); NEGM(); qkt<ND0>(pA0, pA1, K_lds + ks * C::KBYTES, qr, r32, hi, negm);
        fsm_rel(pB0, pB1, pa0, pa1, pa2, pa3);
        SBAR(); LOADG(j + 3, j + 2); SBAR();
        PVL(vrb + vs * C::VBYTES); psm_fix(pA0);
        ks = ks == 2 ? 0 : ks + 1; vs = vs == 2 ? 0 : vs + 1;
    }
    TILEBAR(3);
    SBAR(); NEGM(); qkt<ND0>(pB0, pB1, K_lds + ks * C::KBYTES, qr, r32, hi, negm);
    fsm_rel(pA0, pA1, pa0, pa1, pa2, pa3); SBAR();
    PVL(vrb + vs * C::VBYTES); psm_fix(pB0);
    vs = vs == 2 ? 0 : vs + 1;
    TILEBAR(0);
    fsm_rel(pB0, pB1, pa0, pa1, pa2, pa3); SBAR();
    PVL(vrb + vs * C::VBYTES);
    u16* Ow = Ob + (long)(wid * 32) * ldo;
#pragma unroll
    for (int r = 0; r < 16; ++r) { const int orow = crow(r, hi); const float rl = __builtin_amdgcn_rcpf(ol[r]);
#pragma unroll
        for (int d0 = 0; d0 < NVB; ++d0) Ow[(long)orow * ldo + d0 * 32 + r32] = f2bf(o[d0][r] * rl); }
#undef LOADG
#undef RESC
#undef PVL
#undef NEGM
#undef TILEBAR
}

struct Frame {
    const Params* p; unsigned char* ws; char* lds; float* out; int G, bx;
    __device__ __forceinline__ const float* in(int i) const { return p->in[i]; }
    template <class T> __device__ __forceinline__ T* W(size_t off) const { return (T*)(ws + off); }
};
constexpr int LDS_BYTES = 163840;
constexpr int LDS_BARW  = LDS_BYTES - 16;
constexpr int LDS_TAB   = 147456;

struct ResCtx { const char* src0; long srcd; char* dst0; long dstd; const float* mods;
    __device__ __forceinline__ const float* row_in(int row, int) const { return (const float*)(src0 + (row >= NCTX ? srcd : 0L) + (long)row * (DM * 4)); }
    __device__ __forceinline__ float* row_out(int row) const { return (float*)(dst0 + (row >= NCTX ? dstd : 0L) + (long)row * (DM * 4)); }
    __device__ __forceinline__ const float* mod(int li, int row, int which) const {
        const int mr = row < NCTX ? 4 : ((row - NCTX) >> 13); return mods + (size_t)(li * 5 + mr) * 6144 + which * 1024; }
};
__device__ __forceinline__ ResCtx res_ctx(const Frame& F, bool first = false) {
    const char* sc = (const char*)(first ? F.in(2) : (const float*)F.W<float>(WS_XC)); const char* sl = (const char*)(first ? F.in(0) : (const float*)F.out) - (long)NCTX * DM * 4;
    char* dc = (char*)F.W<float>(WS_XC); char* dl = (char*)F.out - (long)NCTX * DM * 4;
    return ResCtx{sc, (long)(sl - sc), dc, (long)(dl - dc), F.W<float>(WS_MODS)};
}
__device__ __forceinline__ const float* xrow_in(const Frame& F, int row, bool first) { return res_ctx(F, first).row_in(row, 0); }
__device__ __forceinline__ float* xrow_out(const Frame& F, int row) { return res_ctx(F).row_out(row); }
__device__ __forceinline__ const float* mod_vec(const Frame& F, int li, int row, int which) { return res_ctx(F).mod(li, row, which); }

struct EpiResid8 { ResCtx F; int li;
    __device__ __forceinline__ void operator()(const f32x4 (&acc)[2][2][4][2], const pg8::Unit& u, int wr, int wc, int fr, int fq) const {
#pragma unroll
        for (int ai = 0; ai < 2; ++ai)
#pragma unroll
            for (int m = 0; m < 4; ++m) { int frr = fr; asm volatile("" : "+v"(frr));
                const int row = u.pm * 256 + ai * 128 + wr * 64 + m * 16 + frr, c0 = u.pn * 256 + wc * 32 + 4 * fq;
                const float* xi = F.row_in(row, 0) + c0; float* xo = F.row_out(row) + c0; const float* gt = F.mod(li, row, 2) + c0;
#pragma unroll
                for (int bj = 0; bj < 2; ++bj)
#pragma unroll
                    for (int n = 0; n < 2; ++n) { const int c = bj * 128 + n * 16; const f32x4 x = *(const f32x4*)(xi + c), g = *(const f32x4*)(gt + c), a = acc[ai][bj][m][n];
                        f32x4 o = {x[0] + g[0] * a[0], x[1] + g[1] * a[1], x[2] + g[2] * a[2], x[3] + g[3] * a[3]}; *(f32x4*)(xo + c) = o; } }
    } };

__device__ __forceinline__ void p0_mods(const Frame& F) {
    float* s = (float*)F.lds; float* red = s + 5 * 1024;
    const int tid = threadIdx.x, lane = tid & 63, wid = tid >> 6;
    for (int i = tid; i < 5 * 1024; i += NTHR) { const int r = i >> 10, k = i & 1023; const float v = r < 4 ? F.in(1)[r * 1024 + k] : F.in(3)[k]; s[i] = silu_f(v); }
    __syncthreads();
    for (int item = F.bx; item < DEPTH * 96; item += F.G) {
        const int li = item / 96, cg = item % 96;
        const float* w = F.in(4) + (size_t)li * 1024 * 6144 + cg * 64 + lane;
        float a0 = 0, a1 = 0, a2 = 0, a3 = 0, a4 = 0;
        const int k0 = wid * 128;
#pragma unroll 8
        for (int k = k0; k < k0 + 128; ++k) {
            const float wv = w[(size_t)k * 6144];
            a0 += s[k] * wv; a1 += s[1024 + k] * wv; a2 += s[2048 + k] * wv; a3 += s[3072 + k] * wv; a4 += s[4096 + k] * wv;
        }
        red[(wid * 5 + 0) * 64 + lane] = a0; red[(wid * 5 + 1) * 64 + lane] = a1; red[(wid * 5 + 2) * 64 + lane] = a2;
        red[(wid * 5 + 3) * 64 + lane] = a3; red[(wid * 5 + 4) * 64 + lane] = a4;
        __syncthreads();
        if (tid < 320) { const int r = tid >> 6, l = tid & 63; float sum = 0;
#pragma unroll
            for (int ww = 0; ww < 8; ++ww) sum += red[(ww * 5 + r) * 64 + l];
            F.W<float>(WS_MODS)[(size_t)(li * 5 + r) * 6144 + cg * 64 + l] = sum + F.in(5)[li * 6144 + cg * 64 + l]; }
        __syncthreads();
    }
}
__device__ __forceinline__ void p0_rope(const Frame& F) {
    const int gt = F.bx * NTHR + threadIdx.x, gn = F.G * NTHR;
    float* ca = F.W<float>(WS_ROPEA); float* sa = ca + SEQ * 16; float* cb = F.W<float>(WS_ROPEB); float* sb = cb + SEQ * 32;
    for (int i = gt; i < SEQ * 48; i += gn) {
        int n, f, nf; float* co; float* so; int idx;
        if (i < SEQ * 16) { n = i >> 4; f = i & 15; nf = 8; co = ca; so = sa; idx = i; }
        else { const int j = i - SEQ * 16; n = j >> 5; f = j & 31; nf = 16; co = cb; so = sb; idx = j; }
        const int fi = f % nf; const float pos = (f < nf) ? (float)(n >> 6) : (float)(n & 63);
        const float invf = exp2f(-(float)fi / (float)nf * 13.287712379549449f);
        const float ang = pos * invf;
        float rev = ang * 0.15915494309189535f; rev -= floorf(rev);
        co[idx] = __builtin_amdgcn_cosf(rev); so[idx] = __builtin_amdgcn_sinf(rev);
    }
}
__device__ __forceinline__ int rowmap(int n, int kind) {
    if (kind == 0) return n;
    if (kind == 3) { if (n >= 2048) return n; const int hh = n >> 6, dim = n & 63; return (hh >> 2) * 256 + (dim >> 5) * 128 + (hh & 3) * 32 + (dim & 31); }
    return (n >> 7) * 256 + (kind == 2 ? 128 : 0) + (n & 127);
}
__device__ __forceinline__ void cvt_group(float* tl, const float* src, int K, int N, u16* dst, int ldd, int kind, int t0) {
    int tid = threadIdx.x; asm volatile("" : "+v"(tid));
    const int tn = (N + 63) / 64, nt = (K / 64) * tn;
    f32x4 v[4][2];
#pragma unroll
    for (int u = 0; u < 4; ++u) { const int t = t0 + u; const int k0 = (t / tn) * 64, n0 = (t % tn) * 64;
#pragma unroll
        for (int ps = 0; ps < 2; ++ps) { const int k = (tid >> 4) + ps * 32, n4 = (tid & 15) * 4;
            if (t < nt && n0 + n4 < N) v[u][ps] = *(const f32x4*)(src + (size_t)(k0 + k) * N + n0 + n4); else v[u][ps] = f32x4{0.f, 0.f, 0.f, 0.f}; } }
#pragma unroll
    for (int u = 0; u < 4; ++u)
#pragma unroll
        for (int ps = 0; ps < 2; ++ps) { const int k = (tid >> 4) + ps * 32, n4 = (tid & 15) * 4; float* d = tl + u * 4160 + k * 65 + n4;
            d[0] = v[u][ps][0]; d[1] = v[u][ps][1]; d[2] = v[u][ps][2]; d[3] = v[u][ps][3]; }
    __syncthreads();
#pragma unroll
    for (int u = 0; u < 4; ++u) { const int t = t0 + u; const int k0 = (t / tn) * 64, n0 = (t % tn) * 64;
        const int n = tid >> 3, kc = (tid & 7) * 8; const float* sr = tl + u * 4160;
        if (t < nt && n0 + n < N) { u32x4 w;
#pragma unroll
            for (int i = 0; i < 4; ++i) w[i] = cvtpk(sr[(kc + 2 * i) * 65 + n], sr[(kc + 2 * i + 1) * 65 + n]);
            *(u32x4*)(dst + (size_t)rowmap(n0 + n, kind) * ldd + k0 + kc) = w; } }
    __syncthreads();
}
__device__ __forceinline__ void cvt_t(const Frame& F, const float* src, int K, int N, u16* dst, int ldd, int kind, int rot) {
    const int tn = (N + 63) / 64, nt = (K / 64) * tn;
    for (int t0 = ((F.bx + rot) % F.G) * 4; t0 < nt; t0 += F.G * 4) cvt_group((float*)F.lds, src, K, N, dst, ldd, kind, t0);
}
constexpr int MOE_CVT_GROUPS = 16 * 3 * 32, LDS_CVT = 81920;
__device__ __forceinline__ void moe_cvt_group(const Frame& F, int li, int gidx) {
    if (gidx >= MOE_CVT_GROUPS) return;
    const int mat = gidx >> 5, g = gidx & 31, e = mat / 3, kind = mat - e * 3; float* tl = (float*)(F.lds + LDS_CVT);
    if (kind == 0) cvt_group(tl, F.in(27) + (size_t)(li * 16 + e) * 1024 * 512, 1024, 512, F.W<u16>(WS_MOEW) + (size_t)e * 1024 * 1024, 1024, 1, g * 4);
    else if (kind == 1) cvt_group(tl, F.in(28) + (size_t)(li * 16 + e) * 1024 * 512, 1024, 512, F.W<u16>(WS_MOEW) + (size_t)e * 1024 * 1024, 1024, 2, g * 4);
    else cvt_group(tl, F.in(29) + (size_t)(li * 16 + e) * 512 * 1024, 512, 1024, F.W<u16>(WS_MOEW + MOE_WGU_BYTES) + (size_t)e * 1024 * 512, 512, 0, g * 4);
}
__device__ __forceinline__ void p0_weights(const Frame& F) {
    int rot = 0;
    for (int j = 0; j < 2; ++j) {
        cvt_t(F, F.in(8) + (size_t)j * 1024 * 544, 1024, 544, F.W<u16>(WS_WDQKV) + (size_t)j * 640 * 1024, 1024, 0, rot); rot += 36;
        cvt_t(F, F.in(10) + (size_t)j * 256 * 1536, 256, 1536, F.W<u16>(WS_WUQ) + (size_t)j * 1536 * 256, 256, 0, rot); rot += 24;
        cvt_t(F, F.in(12) + (size_t)j * 256 * 2048, 256, 2048, F.W<u16>(WS_WUKV) + (size_t)j * 2048 * 256, 256, 0, rot); rot += 32;
        cvt_t(F, F.in(13) + (size_t)j * 1024 * 1024, 1024, 1024, F.W<u16>(WS_WOM) + (size_t)j * 1024 * 1024, 1024, 0, rot);
    }
    cvt_t(F, F.in(14), 1024, 3072, F.W<u16>(WS_WQKVD), 1024, 3, rot);
    cvt_t(F, F.in(17), 1024, 1024, F.W<u16>(WS_WOD), 1024, 0, rot);
    cvt_t(F, F.in(18), 1024, 3104, F.W<u16>(WS_WING), 1024, 0, rot); rot += 4;
    cvt_t(F, F.in(22), 1024, 1024, F.W<u16>(WS_WOG), 1024, 0, rot);
}
__device__ __forceinline__ void moe_weights(const Frame& F, int li) {
    for (int g = F.bx; g < MOE_CVT_GROUPS; g += F.G) moe_cvt_group(F, li, g);
}

#define DPP_ADD(v, CTRL) (v) += __uint_as_float(__builtin_amdgcn_update_dpp(0u, __float_as_uint(v), (CTRL), 0xF, 0xF, false))
__device__ __forceinline__ float wave_sum_fast(float v) {
    DPP_ADD(v, 0xB1); DPP_ADD(v, 0x4E); DPP_ADD(v, 0x141); DPP_ADD(v, 0x140);
    { auto rr = __builtin_amdgcn_permlane16_swap(__float_as_uint(v), __float_as_uint(v), false, false); v = __uint_as_float(rr[0]) + __uint_as_float(rr[1]); }
    { auto rr = __builtin_amdgcn_permlane32_swap(__float_as_uint(v), __float_as_uint(v), false, false); v = __uint_as_float(rr[0]) + __uint_as_float(rr[1]); }
    return v;
}
constexpr int RT_WG = 0, RT_WR = 16384, RT_REC = 81920, RT_CNT = 81920 + 4096, RT_BASE = RT_CNT + 128;
template <bool ROUTE>
__device__ __forceinline__ void norm_phase(const Frame& F, int li, int row_begin, bool first) {
    const int tid = threadIdx.x, lane = tid & 63, wid = tid >> 6;
    const float* gain = F.in(ROUTE ? 7 : 6) + li * DM;
    u16* H = F.W<u16>(WS_H);
    const int per_block = (NTOK - row_begin + F.G - 1) / F.G;
    const int blk0 = row_begin + F.bx * per_block; int blk1 = blk0 + per_block; if (blk1 > NTOK) blk1 = NTOK;
    f32x4* wgL = (f32x4*)(F.lds + RT_WG); f32x4* wrL = (f32x4*)(F.lds + RT_WR); u32x4* recL = (u32x4*)(F.lds + RT_REC);
    unsigned* cntL = (unsigned*)(F.lds + RT_CNT); unsigned* baseL = (unsigned*)(F.lds + RT_BASE);
    if constexpr (ROUTE) {
        __syncthreads();
        const f32x4* wg = (const f32x4*)(F.in(23) + (size_t)li * DM * 4); const f32x4* wr = (const f32x4*)(F.in(25) + (size_t)li * 4 * DM * 4);
        for (int e = tid; e < 1024; e += NTHR) { const int d = ((e >> 8) * 4 + (e & 3)) * 64 + ((e >> 2) & 63); wgL[d] = wg[e]; }
        for (int e = tid; e < 4096; e += NTHR) { const int g = e >> 10, c = e & 1023; const int d = g * 1024 + ((c >> 8) * 4 + (c & 3)) * 64 + ((c >> 2) & 63); wrL[d] = wr[e]; }
        if (tid < 32) cntL[tid] = 0u;
        __syncthreads();
    }
    for (int it = 0; it * 32 < per_block; ++it) {
        int rows[4]; bool ok[4]; f32x4 v[4][4];
#pragma unroll
        for (int u = 0; u < 4; ++u) { rows[u] = blk0 + wid + 8 * (4 * it + u); ok[u] = rows[u] < blk1; if (!ok[u]) rows[u] = blk0; }
#pragma unroll
        for (int u = 0; u < 4; ++u) { const float* xr = xrow_in(F, rows[u], first);
#pragma unroll
            for (int i = 0; i < 4; ++i) v[u][i] = *(const f32x4*)(xr + i * 256 + lane * 4); }
#pragma unroll
        for (int u = 0; u < 4; ++u) {
            const int row = rows[u];
            float ss = 0;
#pragma unroll
            for (int i = 0; i < 4; ++i) ss += v[u][i][0] * v[u][i][0] + v[u][i][1] * v[u][i][1] + v[u][i][2] * v[u][i][2] + v[u][i][3] * v[u][i][3];
            ss = wave_sum_fast(ss);
            const float rinv = rsqrtf(ss * (1.f / DM) + EPS);
            const float* sh = mod_vec(F, li, row, ROUTE ? 3 : 0); const float* sc = mod_vec(F, li, row, ROUTE ? 4 : 1);
            float hv[16];
#pragma unroll
            for (int i = 0; i < 4; ++i) { const int c = i * 256 + lane * 4;
                const f32x4 g = *(const f32x4*)(gain + c), s1 = *(const f32x4*)(sc + c), s0 = *(const f32x4*)(sh + c);
#pragma unroll
                for (int j = 0; j < 4; ++j) hv[i * 4 + j] = (v[u][i][j] * rinv * g[j]) * (1.f + s1[j]) + s0[j];
                if (ok[u]) { u32x2 w = {cvtpk(hv[i * 4], hv[i * 4 + 1]), cvtpk(hv[i * 4 + 2], hv[i * 4 + 3])}; *(u32x2*)(H + (size_t)row * DM + c) = w; } }
            if constexpr (ROUTE) {
                float gl[4] = {0, 0, 0, 0};
#pragma unroll
                for (int q = 0; q < 16; ++q) { const f32x4 w4 = wgL[q * 64 + lane]; const float h = hv[q];
                    gl[0] += h * w4[0]; gl[1] += h * w4[1]; gl[2] += h * w4[2]; gl[3] += h * w4[3]; }
#pragma unroll
                for (int g = 0; g < 4; ++g) gl[g] = wave_sum_fast(gl[g]) + F.in(24)[li * 4 + g];
                int gi = 0; float gm = gl[0];
#pragma unroll
                for (int g = 1; g < 4; ++g) if (gl[g] > gm) { gm = gl[g]; gi = g; }
                gi = __builtin_amdgcn_readfirstlane(gi);
                float den = 0;
#pragma unroll
                for (int g = 0; g < 4; ++g) den += __expf(gl[g] - gm);
                const float grp_w = 1.f / den;
                float el[4] = {0, 0, 0, 0};
                const f32x4* wrg = wrL + gi * 1024;
#pragma unroll
                for (int q = 0; q < 16; ++q) { const f32x4 w4 = wrg[q * 64 + lane]; const float h = hv[q];
                    el[0] += h * w4[0]; el[1] += h * w4[1]; el[2] += h * w4[2]; el[3] += h * w4[3]; }
#pragma unroll
                for (int e = 0; e < 4; ++e) el[e] = wave_sum_fast(el[e]) + F.in(26)[(li * 4 + gi) * 4 + e];
                int i1 = 0; float v1 = el[0];
#pragma unroll
                for (int e = 1; e < 4; ++e) if (el[e] > v1) { v1 = el[e]; i1 = e; }
                int i2 = -1; float v2 = -3.0e38f;
#pragma unroll
                for (int e = 0; e < 4; ++e) if (e != i1 && el[e] > v2) { v2 = el[e]; i2 = e; }
                const float t = __expf(v2 - v1); const float w1 = grp_w / (1.f + t), w2 = grp_w * t / (1.f + t);
                const int elo = i1 < i2 ? i1 : i2, ehi = i1 < i2 ? i2 : i1;
                const float wlo = i1 < i2 ? w1 : w2, whi = i1 < i2 ? w2 : w1;
                const int pr = elo == 0 ? ehi - 1 : (elo == 1 ? ehi + 1 : 5);
                const int cls = gi * 6 + pr;
                if (lane == 0 && ok[u]) {
                    const unsigned rank = atomicAdd(&cntL[cls], 1u);
                    u32x4 rec = {(unsigned)cls, rank, __float_as_uint(wlo), __float_as_uint(whi)};
                    recL[row - blk0] = rec;
                }
            }
        }
    }
    if constexpr (ROUTE) {
        __syncthreads();
        if (tid < 24) baseL[tid] = atomicAdd(F.W<unsigned>(WS_CTL) + CW_CNT + li * 32 + tid, cntL[tid]);
        __syncthreads();
        for (int t = tid; t < blk1 - blk0; t += NTHR) { u32x4 rec = recL[t]; rec[1] += baseL[rec[0]];
            *(u32x4*)(F.W<unsigned char>(WS_TOK) + (size_t)(blk0 + t) * 16) = rec; }
    }
}

__device__ __forceinline__ void moe_table(const Frame& F, int li, int* tab) {
    if (threadIdx.x == 0) {
        const unsigned* cnt = F.W<unsigned>(WS_CTL) + CW_CNT + li * 32; int off = 0;
        for (int c = 0; c < 24; ++c) { tab[c] = off; const int n = (int)cnt[c]; const int nt = (n + 255) >> 8;
            for (int t = 0; t < nt; ++t) tab[32 + (off >> 8) + t] = c; off += nt << 8; }
        tab[24] = off;
    }
    __syncthreads();
}
__device__ __forceinline__ void moe_scatter(const Frame& F, int li, int row_begin) {
    int* tab = (int*)(F.lds + LDS_TAB);
    moe_table(F, li, tab);
    const unsigned* cnt = F.W<unsigned>(WS_CTL) + CW_CNT + li * 32;
    int* rowtok = F.W<int>(WS_ROWTOK); float* roww = F.W<float>(WS_ROWW);
    const int gt = F.bx * NTHR + threadIdx.x, gn = F.G * NTHR;
    for (int t = row_begin + gt; t < NTOK; t += gn) {
        const u32x4 rec = *(const u32x4*)(F.W<unsigned char>(WS_TOK) + (size_t)t * 16);
        const int r = tab[rec[0]] + (int)rec[1];
        rowtok[r] = t; roww[2 * r] = __uint_as_float(rec[2]); roww[2 * r + 1] = __uint_as_float(rec[3]);
    }
    for (int i = gt; i < 24 * 256; i += gn) { const int c = i >> 8, j = i & 255; const int r = tab[c] + (int)cnt[c] + j;
        const int end = tab[c] + ((((int)cnt[c]) + 255) & ~255);
        if (r < end) { rowtok[r] = -1; roww[2 * r] = 0.f; roww[2 * r + 1] = 0.f; } }
    __syncthreads();
}

#define EPI_ID const int r32 = lane & 31, hi = lane >> 5
__device__ __forceinline__ u32x2 pack4(float a, float b, float c, float d) { u32x2 w = {cvtpk(a, b), cvtpk(c, d)}; return w; }
struct EpiF32 { float* dst; int ld, ncols;
    __device__ __forceinline__ int operator()(f32x16 (&acc)[2][2], int row0, int col0, int lane) const { EPI_ID;
#pragma unroll
        for (int mi = 0; mi < 2; ++mi) { float* o = dst + (size_t)(row0 + mi * 32 + r32) * ld + col0 + 4 * hi;
#pragma unroll
            for (int ni = 0; ni < 2; ++ni) if (col0 + ni * 32 < ncols) {
#pragma unroll
                for (int g = 0; g < 4; ++g) { f32x4 v = {acc[mi][ni][4 * g], acc[mi][ni][4 * g + 1], acc[mi][ni][4 * g + 2], acc[mi][ni][4 * g + 3]}; *(f32x4*)(o + ni * 32 + 8 * g) = v; } } }
        return 0;
    } };
struct EpiMlaQ { u16* Q; const float* cosA; const float* sinA; float scale;
    __device__ __forceinline__ int operator()(f32x16 (&acc)[2][2], int row0, int col0, int lane) const { EPI_ID; const bool lat = row0 >= NCTX;
#pragma unroll
        for (int mi = 0; mi < 2; ++mi) { const int row = row0 + mi * 32 + r32; int b, pos; row_bp(row, b, pos); const int n = (row - NCTX) & (SEQ - 1);
            u16* qrow = Q + ((size_t)(b * 16) * KEYS + pos) * 96 + 4 * hi;
#pragma unroll
            for (int ni = 0; ni < 2; ++ni) { const int s = (col0 >> 5) + ni, head = s / 3, part = s - head * 3; u16* o = qrow + (size_t)head * KEYS * 96 + part * 32;
                float v[16];
#pragma unroll
                for (int r = 0; r < 16; ++r) v[r] = acc[mi][ni][r] * scale;
                if (part == 2 && lat) {
#pragma unroll
                    for (int g = 0; g < 2; ++g) {
#pragma unroll
                        for (int j = 0; j < 4; ++j) { float cs, sn; rope_cs<8>(n, 8 * g + 4 * hi + j, cs, sn);
                            const float t1 = v[4 * g + j], t2 = v[4 * (g + 2) + j]; v[4 * g + j] = t1 * cs - t2 * sn; v[4 * (g + 2) + j] = t1 * sn + t2 * cs; } } }
#pragma unroll
                for (int g = 0; g < 4; ++g) *(u32x2*)(o + 8 * g) = pack4(v[4 * g], v[4 * g + 1], v[4 * g + 2], v[4 * g + 3]); } }
        return 16;
    } };
struct EpiMlaKV { u16* Kn; long vdelta;
    __device__ __forceinline__ int operator()(f32x16 (&acc)[2][2], int row0, int col0, int lane) const { EPI_ID; const int head = col0 >> 7; u16* dst = Kn + (long)((col0 >> 6) & 1) * vdelta;
#pragma unroll
        for (int mi = 0; mi < 2; ++mi) { const int row = row0 + mi * 32 + r32; int b, pos; row_bp(row, b, pos);
            u16* o = dst + ((size_t)(b * 16 + head) * KEYS + pos) * 64 + 4 * hi;
#pragma unroll
            for (int ni = 0; ni < 2; ++ni)
#pragma unroll
                for (int g = 0; g < 4; ++g) *(u32x2*)(o + ni * 32 + 8 * g) = pack4(acc[mi][ni][4 * g], acc[mi][ni][4 * g + 1], acc[mi][ni][4 * g + 2], acc[mi][ni][4 * g + 3]); }
        return 16;
    } };
struct EpiResid { ResCtx F; int li, which, first;
    __device__ __forceinline__ int operator()(f32x16 (&acc)[2][2], int row0, int col0, int lane) const { EPI_ID;
#pragma unroll
        for (int mi = 0; mi < 2; ++mi) { const int row = row0 + mi * 32 + r32;
            const float* xi = F.row_in(row, first) + col0 + 4 * hi; float* xo = F.row_out(row) + col0 + 4 * hi; const float* gt = F.mod(li, row, which) + col0 + 4 * hi;
#pragma unroll
            for (int ni = 0; ni < 2; ++ni)
#pragma unroll
                for (int g = 0; g < 4; ++g) { const int c = ni * 32 + 8 * g; const f32x4 x = *(const f32x4*)(xi + c), gg = *(const f32x4*)(gt + c);
                    f32x4 o = {x[0] + gg[0] * acc[mi][ni][4 * g], x[1] + gg[1] * acc[mi][ni][4 * g + 1], x[2] + gg[2] * acc[mi][ni][4 * g + 2], x[3] + gg[3] * acc[mi][ni][4 * g + 3]};
                    *(f32x4*)(xo + c) = o; } }
        return 48;
    } };
struct EpiMoeB { ResCtx F; int li; const int* rowtok;
    __device__ __forceinline__ int operator()(f32x16 (&acc)[2][2], int row0, int col0, int lane) const { EPI_ID;
#pragma unroll
        for (int mi = 0; mi < 2; ++mi) { const int tok = rowtok[row0 + mi * 32 + r32];
            if (tok >= 0) { float* xo = F.row_out(tok) + col0 + 4 * hi; const float* gt = F.mod(li, tok, 5) + col0 + 4 * hi;
#pragma unroll
                for (int ni = 0; ni < 2; ++ni)
#pragma unroll
                    for (int g = 0; g < 4; ++g) { const int c = ni * 32 + 8 * g; const f32x4 x = *(const f32x4*)(xo + c), gg = *(const f32x4*)(gt + c);
                        f32x4 o = {x[0] + gg[0] * acc[mi][ni][4 * g], x[1] + gg[1] * acc[mi][ni][4 * g + 1], x[2] + gg[2] * acc[mi][ni][4 * g + 2], x[3] + gg[3] * acc[mi][ni][4 * g + 3]};
                        *(f32x4*)(xo + c) = o; } } }
        return 0;
    } };
struct EpiMoeA { u16* act; const float* roww; int half, acol0;
    __device__ __forceinline__ int operator()(f32x16 (&acc)[2][2], int row0, int col0, int lane) const { EPI_ID;
#pragma unroll
        for (int mi = 0; mi < 2; ++mi) { const int row = row0 + mi * 32 + r32; const float w = roww[2 * row + half];
            u16* o = act + (size_t)row * 1024 + acol0 + (col0 >> 6) * 32 + 4 * hi;
#pragma unroll
            for (int g = 0; g < 4; ++g) { float v[4];
#pragma unroll
                for (int j = 0; j < 4; ++j) v[j] = silu_f(acc[mi][0][4 * g + j]) * acc[mi][1][4 * g + j] * w;
                *(u32x2*)(o + 8 * g) = pack4(v[0], v[1], v[2], v[3]); } }
        return 8;
    } };
struct EpiDiffQKV { u16* Q; long kdelta; u16* V; const float* cosB; const float* sinB; float qscale;
    __device__ __forceinline__ int operator()(f32x16 (&acc)[2][2], int row0, int col0, int lane) const { EPI_ID; const int region = col0 >> 10; const bool lat = row0 >= NCTX;
#pragma unroll
        for (int mi = 0; mi < 2; ++mi) { const int row = row0 + mi * 32 + r32; int b, pos; row_bp(row, b, pos); const int n = (row - NCTX) & (SEQ - 1);
            if (region < 2) {
                const int hh = (col0 & 1023) >> 6; const float sc = region == 0 ? qscale : 1.f;
                u16* o = Q + (long)region * kdelta + ((size_t)(b * 16 + hh) * KEYS + pos) * 64 + 4 * hi;
#pragma unroll
                for (int g = 0; g < 4; ++g) {
                    float o1[4], o2[4];
#pragma unroll
                    for (int j = 0; j < 4; ++j) { float cs = 1.f, sn = 0.f; if (lat) rope_cs<16>(n, 8 * g + 4 * hi + j, cs, sn);
                        const float t1 = acc[mi][0][4 * g + j], t2 = acc[mi][1][4 * g + j]; o1[j] = (t1 * cs - t2 * sn) * sc; o2[j] = (t1 * sn + t2 * cs) * sc; }
                    *(u32x2*)(o + 8 * g) = pack4(o1[0], o1[1], o1[2], o1[3]); *(u32x2*)(o + 32 + 8 * g) = pack4(o2[0], o2[1], o2[2], o2[3]); }
            } else {
                const int cv = col0 - 2048, head = cv >> 7;
                u16* o = V + ((size_t)(b * 8 + head) * KEYS + pos) * 128 + (cv & 127) + 4 * hi;
#pragma unroll
                for (int ni = 0; ni < 2; ++ni)
#pragma unroll
                    for (int g = 0; g < 4; ++g) *(u32x2*)(o + ni * 32 + 8 * g) = pack4(acc[mi][ni][4 * g], acc[mi][ni][4 * g + 1], acc[mi][ni][4 * g + 2], acc[mi][ni][4 * g + 3]);
            } }
        return 16;
    } };
struct EpiGlaIn { u16* q; u16* k; u16* v; u16* g; float* z;
    __device__ __forceinline__ int operator()(f32x16 (&acc)[2][2], int row0, int col0, int lane) const { EPI_ID;
#pragma unroll
        for (int mi = 0; mi < 2; ++mi) { const size_t row = row0 + mi * 32 + r32;
            if (col0 < 3072) {
                u16* o; float sc = 1.f;
                if (col0 < 512) { o = q + row * 512 + col0; sc = 0.08838834764831845f; } else if (col0 < 1024) o = k + row * 512 + (col0 - 512);
                else if (col0 < 2048) o = v + row * 1024 + (col0 - 1024); else o = g + row * 1024 + (col0 - 2048);
                o += 4 * hi;
#pragma unroll
                for (int ni = 0; ni < 2; ++ni)
#pragma unroll
                    for (int gg = 0; gg < 4; ++gg) *(u32x2*)(o + ni * 32 + 8 * gg) = pack4(acc[mi][ni][4 * gg] * sc, acc[mi][ni][4 * gg + 1] * sc, acc[mi][ni][4 * gg + 2] * sc, acc[mi][ni][4 * gg + 3] * sc);
            } else if (col0 == 3072) {
                float* o = z + row * 32 + 4 * hi;
#pragma unroll
                for (int gg = 0; gg < 4; ++gg) { f32x4 t = {acc[mi][0][4 * gg], acc[mi][0][4 * gg + 1], acc[mi][0][4 * gg + 2], acc[mi][0][4 * gg + 3]}; *(f32x4*)(o + 8 * gg) = t; }
            } }
        return col0 < 3072 ? 16 : (col0 == 3072 ? 8 : 0);
    } };

template <int WM, int WN, class AL, class BL, class EP>
__device__ __forceinline__ void gemm_phase(const Frame& F, const AL al, const BL bl, EP& ep, int mt0, int mt1, int nN, int nk, int tile_off, int tile_total) {
    PlainTiles<AL, BL, EP> prov{al, bl, ep, mt0, mt1 - mt0, nN, F.bx, F.G}; (void)tile_off;
    gemm_stream<WM, WN>(F.lds, prov, nk);
    (void)tile_total;
}

__device__ __forceinline__ void mla_rowpass(const Frame& F, int j, int li) {
    const int lane = threadIdx.x & 63, wid = threadIdx.x >> 6;
    const float* DQ = F.W<float>(MLA_DQ); u16* CN = F.W<u16>(MLA_CN); u16* KPE = F.W<u16>(MLA_KPE);
    const float* gq = F.in(9) + j * 256; const float* gk = F.in(11) + j * 256;
    const float* ca = F.W<float>(WS_ROPEA); const float* sa = ca + SEQ * 16;
    float pem0 = 0.f, pem1 = 0.f, pem2 = 0.f, pem3 = 0.f;
    for (int row = F.bx * NWAVE + wid; row < NTOK; row += F.G * NWAVE) {
        const float* d = DQ + (size_t)row * 544;
        const f32x4 a = *(const f32x4*)(d + lane * 4), c = *(const f32x4*)(d + 256 + lane * 4);
        float sq = a[0] * a[0] + a[1] * a[1] + a[2] * a[2] + a[3] * a[3], sk = c[0] * c[0] + c[1] * c[1] + c[2] * c[2] + c[3] * c[3];
        sq = wave_sum(sq); sk = wave_sum(sk);
        const float rq = rsqrtf(sq * (1.f / 256.f) + EPS), rk = rsqrtf(sk * (1.f / 256.f) + EPS);
        const f32x4 g1 = *(const f32x4*)(gq + lane * 4), g2 = *(const f32x4*)(gk + lane * 4);
        u32x2 w1 = {cvtpk(a[0] * rq * g1[0], a[1] * rq * g1[1]), cvtpk(a[2] * rq * g1[2], a[3] * rq * g1[3])};
        u32x2 w2 = {cvtpk(c[0] * rk * g2[0], c[1] * rk * g2[1]), cvtpk(c[2] * rk * g2[2], c[3] * rk * g2[3])};
        *(u32x2*)(CN + (size_t)row * 512 + lane * 4) = w1; *(u32x2*)(CN + (size_t)row * 512 + 256 + lane * 4) = w2;
        { float t1 = 0.f, t2 = 0.f; if (lane < 16) { t1 = d[512 + lane]; t2 = d[528 + lane]; }
          const float pe2 = wave_sum_fast(t1 * t1 + t2 * t2); const int bb = row < NCTX ? row >> 8 : (row - NCTX) >> 13;
          pem0 = bb == 0 ? fmaxf(pem0, pe2) : pem0; pem1 = bb == 1 ? fmaxf(pem1, pe2) : pem1; pem2 = bb == 2 ? fmaxf(pem2, pe2) : pem2; pem3 = bb == 3 ? fmaxf(pem3, pe2) : pem3; }
        if (lane < 16) { float t1 = d[512 + lane], t2 = d[528 + lane]; int b, pos; row_bp(row, b, pos);
            if (row >= NCTX) { const int n = (row - NCTX) & (SEQ - 1); const float cs = ca[n * 16 + lane], sn = sa[n * 16 + lane];
                const float o1 = t1 * cs - t2 * sn, o2 = t1 * sn + t2 * cs; t1 = o1; t2 = o2; }
            u16* o = KPE + ((size_t)b * KEYS + pos) * 32 + lane; o[0] = f2bf(t1); o[16] = f2bf(t2); }
    }
    if (lane == 0) { unsigned* pm = F.W<unsigned>(WS_CTL) + CW_PEMAX + li * 4; atomic_fmax_pos(pm, pem0); atomic_fmax_pos(pm + 1, pem1); atomic_fmax_pos(pm + 2, pem2); atomic_fmax_pos(pm + 3, pem3); }
}
__device__ __forceinline__ int vcu_of(const Frame& F) { return (F.G % 8 == 0) ? (F.bx % 8) * (F.G / 8) + F.bx / 8 : F.bx; }
__device__ __forceinline__ void mla_attn(const Frame& F, bool ctx_out, int li) {
    const u16* Q = F.W<u16>(MLA_Q); const u16* Kn = F.W<u16>(MLA_KN); const u16* V = F.W<u16>(MLA_V); const u16* Kpe = F.W<u16>(MLA_KPE);
    u16* O = F.W<u16>(MLA_DQ);
    const int nit = 2048 + (ctx_out ? 64 : 0); int nrun = 0;
#pragma unroll 1
    for (int it = vcu_of(F); it < nit; it += F.G) {
        int b, h, qpos, nkeys, orow;
        if (it < 2048) { const int bh = it >> 5, qt = it & 31; b = bh >> 4; h = bh & 15; qpos = CTXL + qt * 256; nkeys = KEYS; orow = NCTX + b * SEQ + qt * 256; }
        else { const int jj = it - 2048; b = jj >> 4; h = jj & 15; qpos = 0; nkeys = CTXL; orow = b * CTXL; }
        const size_t bh = (size_t)(b * 16 + h);
        const unsigned* km = F.W<unsigned>(WS_CTL) + CW_KMAX + li * 128 + (b * 16 + h) * 2;
        const float kmax2 = __uint_as_float(km[0]) + __uint_as_float(km[1]) + __uint_as_float(F.W<unsigned>(WS_CTL)[CW_PEMAX + li * 4 + b]);
        attn_item<96, 64>(Q + (bh * KEYS + qpos) * 96, Kn + bh * KEYS * 64, Kpe + (size_t)b * KEYS * 32, V + bh * KEYS * 64, nkeys,
                          O + (size_t)orow * DM + h * 64, DM, F.lds, kmax2);
        moe_cvt_group(F, li, F.bx + nrun * F.G); ++nrun;
    }
    for (; F.bx + nrun * F.G < MOE_CVT_GROUPS; ++nrun) moe_cvt_group(F, li, F.bx + nrun * F.G);
}
__device__ __forceinline__ void diff_attn(const Frame& F, int li) {
    const u16* Q = F.W<u16>(DF_Q); const u16* K = F.W<u16>(DF_K); const u16* V = F.W<u16>(DF_V); u16* OS = F.W<u16>(DF_OS);
    const int nit = 2048 + 64; int nrun = 0;
#pragma unroll 1
    for (int it = vcu_of(F); it < nit; it += F.G) {
        int b, hh, qpos, nkeys, orow;
        if (it < 2048) { const int bh = it >> 5, qt = it & 31; b = bh >> 4; hh = bh & 15; qpos = CTXL + qt * 256; nkeys = KEYS; orow = NCTX + b * SEQ + qt * 256; }
        else { const int jj = it - 2048; b = jj >> 4; hh = jj & 15; qpos = 0; nkeys = CTXL; orow = b * CTXL; }
        const size_t bh = (size_t)(b * 16 + hh);
        const float kmax2 = __uint_as_float(F.W<unsigned>(WS_CTL)[CW_KMAX + li * 128 + (b * 16 + hh) * 2]);
        attn_item<64, 128>(Q + (bh * KEYS + qpos) * 64, K + bh * KEYS * 64, nullptr, V + (size_t)(b * 8 + (hh >> 1)) * KEYS * 128, nkeys,
                           OS + (size_t)(hh & 1) * NTOK * DM + (size_t)orow * DM + (hh >> 1) * 128, DM, F.lds, kmax2);
        moe_cvt_group(F, li, F.bx + nrun * F.G); ++nrun;
    }
    for (; F.bx + nrun * F.G < MOE_CVT_GROUPS; ++nrun) moe_cvt_group(F, li, F.bx + nrun * F.G);
}
__device__ __forceinline__ void diff_rowpass(const Frame& F, float lam_init) {
    const int lane = threadIdx.x & 63, wid = threadIdx.x >> 6;
    const u16* OS = F.W<u16>(DF_OS); u16* O = F.W<u16>(DF_Q);
    const float* lm = F.in(15);
    const float lam = __expf(wave_sum(lm[lane] * lm[64 + lane])) - __expf(wave_sum(lm[128 + lane] * lm[192 + lane])) + lam_init;
    const float post = 1.f - lam_init;
    float sg[16];
#pragma unroll
    for (int i = 0; i < 16; ++i) sg[i] = F.in(16)[(lane & 7) * 16 + i] * post;
    for (int row = F.bx * NWAVE + wid; row < NTOK; row += F.G * NWAVE) {
        const u16* p0 = OS + (size_t)row * DM + lane * 16; const u16* p1 = p0 + (size_t)NTOK * DM;
        const bf16x8 a0 = *(const bf16x8*)p0, a1 = *(const bf16x8*)(p0 + 8), b0 = *(const bf16x8*)p1, b1 = *(const bf16x8*)(p1 + 8);
        float o[16]; float ss = 0;
#pragma unroll
        for (int i = 0; i < 8; ++i) { o[i] = bf2f((u16)a0[i]) - lam * bf2f((u16)b0[i]); o[8 + i] = bf2f((u16)a1[i]) - lam * bf2f((u16)b1[i]); }
#pragma unroll
        for (int i = 0; i < 16; ++i) ss += o[i] * o[i];
        ss += __shfl_xor(ss, 1); ss += __shfl_xor(ss, 2); ss += __shfl_xor(ss, 4);
        const float rinv = rsqrtf(ss * (1.f / 128.f) + EPS);
        u32x4 w0, w1;
#pragma unroll
        for (int i = 0; i < 4; ++i) { w0[i] = cvtpk(o[2 * i] * rinv * sg[2 * i], o[2 * i + 1] * rinv * sg[2 * i + 1]);
            w1[i] = cvtpk(o[8 + 2 * i] * rinv * sg[8 + 2 * i], o[9 + 2 * i] * rinv * sg[9 + 2 * i]); }
        *(u32x4*)(O + (size_t)row * DM + lane * 16) = w0; *(u32x4*)(O + (size_t)row * DM + lane * 16 + 8) = w1;
    }
}

__device__ __forceinline__ float logsig16(float x) { return (fminf(x, 0.f) - __logf(1.f + __expf(-fabsf(x)))) * 0.0625f; }
constexpr int NCH = KEYS / 64;

__device__ __forceinline__ void gla_g1(const Frame& F) {
    char* KT = F.lds; char* VV = F.lds + 16384; float* ZT = (float*)(F.lds + 49152); float* SEG = (float*)(F.lds + 53248);
    const u16* Kg = F.W<u16>(GL_K); const u16* Vg = F.W<u16>(GL_V); const float* Zg = F.W<float>(GL_Z);
    u16* ST = F.W<u16>(GL_STATE); float* DEC = F.W<float>(GL_DEC);
#pragma unroll 1
    for (int it = F.bx; it < NBATCH * 4 * 2 * NCH; it += F.G) {
        int tid = threadIdx.x; asm volatile("" : "+v"(tid));
        const int lane = tid & 63, wid = tid >> 6, r32 = lane & 31, hi = lane >> 5, kk = tid & 127, jq = tid >> 7;
        const int c = it % NCH, dir = (it / NCH) & 1, bh = it / (2 * NCH), b = bh >> 2, h = bh & 3;
        const int s0 = 64 * c;
        int tbase, tstep;
        if (dir == 0) { tbase = (c < 4) ? b * CTXL + s0 : NCTX + b * SEQ + s0 - CTXL; tstep = 1; }
        else { tbase = (c < 4) ? b * CTXL + (CTXL - 1) - s0 : NCTX + b * SEQ + (SEQ - 1) - (s0 - CTXL); tstep = -1; }
        __syncthreads();
        for (int i = tid; i < 1024; i += NTHR) { const int j = i >> 4, r = i & 15; ZT[i] = Zg[(size_t)(tbase + tstep * j) * 32 + dir * 16 + r]; }
#pragma unroll
        for (int q = 0; q < 4; ++q) { const int id = tid + q * NTHR, key = id >> 5, cc = (id & 31) * 8;
            *(bf16x8*)(VV + v_st<8>(key, cc)) = *(const bf16x8*)(Vg + (size_t)(tbase + tstep * key) * 1024 + h * 256 + cc); }
        float wg[16];
#pragma unroll
        for (int r = 0; r < 16; ++r) wg[r] = F.in(19)[(dir * 16 + r) * 512 + h * 128 + kk];
        const float bias = F.in(20)[dir * 512 + h * 128 + kk];
        __syncthreads();
        float cv[16]; float run = 0;
#pragma unroll
        for (int jj = 0; jj < 16; ++jj) { const int j = jq * 16 + jj; float x = bias;
#pragma unroll
            for (int r = 0; r < 16; ++r) x += ZT[j * 16 + r] * wg[r];
            run += logsig16(x); cv[jj] = run; }
        SEG[jq * 128 + kk] = run;
        __syncthreads();
        float offset = 0, total = 0;
#pragma unroll
        for (int q = 0; q < 4; ++q) { const float sv = SEG[q * 128 + kk]; total += sv; if (q < jq) offset += sv; }
        u32x4 w0, w1;
#pragma unroll
        for (int i = 0; i < 8; ++i) {
            const int j0 = jq * 16 + 2 * i;
            const float k0 = bf2f(Kg[(size_t)(tbase + tstep * j0) * 512 + h * 128 + kk]) * __expf(total - (offset + cv[2 * i]));
            const float k1 = bf2f(Kg[(size_t)(tbase + tstep * (j0 + 1)) * 512 + h * 128 + kk]) * __expf(total - (offset + cv[2 * i + 1]));
            const unsigned pk = cvtpk(k0, k1); if (i < 4) w0[i] = pk; else w1[i - 4] = pk; }
        *(u32x4*)(KT + kk * 128 + (((jq * 2) ^ ((kk >> 1) & 7)) << 4)) = w0;
        *(u32x4*)(KT + kk * 128 + (((jq * 2 + 1) ^ ((kk >> 1) & 7)) << 4)) = w1;
        if (jq == 0) DEC[(size_t)it * 128 + kk] = __expf(total);
        __syncthreads();
        const int mt = wid & 3, vb = (wid >> 2) * 4;
        const int row = mt * 32 + r32, ab = row * 128 + ((hi ^ ((row >> 1) & 7)) << 4);
        const bf16x8 pa0 = *(const bf16x8*)(KT + (ab ^ 0)), pa1 = *(const bf16x8*)(KT + (ab ^ 32)), pa2 = *(const bf16x8*)(KT + (ab ^ 64)), pa3 = *(const bf16x8*)(KT + (ab ^ 96));
        f32x16 acc[4];
#pragma unroll
        for (int n = 0; n < 4; ++n) acc[n] = f32x16{};
        const int vbase = (int)(uintptr_t)VV + v_rd_base(lane) + vb * 512;
        pv_one<0, 8>(acc[0], vbase, pa0, pa1, pa2, pa3); pv_one<1, 8>(acc[1], vbase, pa0, pa1, pa2, pa3);
        pv_one<2, 8>(acc[2], vbase, pa0, pa1, pa2, pa3); pv_one<3, 8>(acc[3], vbase, pa0, pa1, pa2, pa3);
        u16* S = ST + (size_t)it * 128 * 256;
#pragma unroll
        for (int n = 0; n < 4; ++n)
#pragma unroll
            for (int r = 0; r < 16; ++r) S[(mt * 32 + crow(r, hi)) * 256 + (vb + n) * 32 + r32] = f2bf(acc[n][r]);
    }
}
__device__ __forceinline__ void gla_g2(const Frame& F) {
    u16* ST = F.W<u16>(GL_STATE); const float* DEC = F.W<float>(GL_DEC);
    for (int g = F.bx * NTHR + threadIdx.x; g < 32 * 4096; g += F.G * NTHR) {
        const int chain = g >> 12, e = g & 4095, kk = e >> 5, v8 = (e & 31) * 8;
        u16* p = ST + ((size_t)chain * NCH * 128 + kk) * 256 + v8; const float* d = DEC + (size_t)chain * NCH * 128 + kk;
        float f[8];
#pragma unroll
        for (int i = 0; i < 8; ++i) f[i] = 0.f;
        for (int c = 0; c < NCH; c += 4) {
            bf16x8 kv[4]; float dc[4];
#pragma unroll
            for (int u = 0; u < 4; ++u) { kv[u] = *(const bf16x8*)(p + (size_t)(c + u) * 128 * 256); dc[u] = d[(size_t)(c + u) * 128]; }
#pragma unroll
            for (int u = 0; u < 4; ++u) {
                u32x4 w = {cvtpk(f[0], f[1]), cvtpk(f[2], f[3]), cvtpk(f[4], f[5]), cvtpk(f[6], f[7])};
                *(u32x4*)(p + (size_t)(c + u) * 128 * 256) = w;
#pragma unroll
                for (int i = 0; i < 8; ++i) f[i] = dc[u] * f[i] + bf2f((u16)kv[u][i]);
            }
        }
    }
}
__device__ __forceinline__ void gla_g3(const Frame& F) {
    char* QD = F.lds; char* KI = F.lds + 16384; char* VV = F.lds + 32768; char* SS = F.lds + 65536; float* OL = (float*)(F.lds + 65536);
    float* ZT = (float*)(F.lds + 132096); float* SEG = (float*)(F.lds + 136192);
    const u16* Qg = F.W<u16>(GL_Q); const u16* Kg = F.W<u16>(GL_K); const u16* Vg = F.W<u16>(GL_V); const u16* Gg = F.W<u16>(GL_G); const float* Zg = F.W<float>(GL_Z);
    const u16* ST = F.W<u16>(GL_STATE); u16* OUT = F.W<u16>(WS_H);
#pragma unroll 1
    for (int it = F.bx; it < NBATCH * 4 * NCH; it += F.G) {
        int tid = threadIdx.x; asm volatile("" : "+v"(tid));
        const int lane = tid & 63, wid = tid >> 6, r32 = lane & 31, hi = lane >> 5, kk = tid & 127, jq = tid >> 7;
        const int T = it % NCH, bh = it / NCH, b = bh >> 2, h = bh & 3;
        const int t0 = (T < 4) ? b * CTXL + 64 * T : NCTX + b * SEQ + 64 * (T - 4);
        __syncthreads();
#pragma unroll
        for (int q = 0; q < 4; ++q) { const int id = tid + q * NTHR, key = id >> 5, cc = (id & 31) * 8;
            *(bf16x8*)(VV + v_st<8>(key, cc)) = *(const bf16x8*)(Vg + (size_t)(t0 + key) * 1024 + h * 256 + cc); }
        const int itile = wid & 1, vb = (wid >> 1) * 2;
        f32x16 acc[2]; acc[0] = f32x16{}; acc[1] = f32x16{};
#pragma unroll 1
        for (int dir = 0; dir < 2; ++dir) {
            const int cd = dir == 0 ? T : (T < 4 ? 3 - T : 135 - T);
            const u16* Ssrc = ST + (size_t)((bh * 2 + dir) * NCH + cd) * 128 * 256;
#pragma unroll
            for (int q = 0; q < 8; ++q) { const int id = tid + q * NTHR, key = id >> 5, cc = (id & 31) * 8;
                *(bf16x8*)(SS + v_st<8>(key, cc)) = *(const bf16x8*)(Ssrc + (size_t)key * 256 + cc); }
            for (int i = tid; i < 1024; i += NTHR) { const int j = i >> 4, r = i & 15; ZT[i] = Zg[(size_t)(t0 + j) * 32 + dir * 16 + r]; }
            float wg[16];
#pragma unroll
            for (int r = 0; r < 16; ++r) wg[r] = F.in(19)[(dir * 16 + r) * 512 + h * 128 + kk];
            const float bias = F.in(20)[dir * 512 + h * 128 + kk];
            __syncthreads();
            float cv[16]; float run = 0;
#pragma unroll
            for (int u = 0; u < 16; ++u) { const int j = jq * 16 + u; float x = bias;
#pragma unroll
                for (int r = 0; r < 16; ++r) x += ZT[j * 16 + r] * wg[r];
                cv[u] = logsig16(x); }
            if (dir == 0) {
#pragma unroll
                for (int u = 0; u < 16; ++u) { run += cv[u]; cv[u] = run; }
            } else {
#pragma unroll
                for (int u = 15; u >= 0; --u) { run += cv[u]; cv[u] = run; }
            }
            SEG[jq * 128 + kk] = run;
            __syncthreads();
            float offset = 0;
#pragma unroll
            for (int q = 0; q < 4; ++q) { const float sv = SEG[q * 128 + kk]; if (dir == 0 ? (q < jq) : (q > jq)) offset += sv; }
            const int adb = jq * 4096 + ((kk >> 3) << 4) + (kk & 7) * 2;
#pragma unroll
            for (int jj = 0; jj < 16; ++jj) { const int i = jq * 16 + jj; const float cum = offset + cv[jj];
                const float qv = bf2f(Qg[(size_t)(t0 + i) * 512 + h * 128 + kk]) * __expf(cum);
                const float kv = bf2f(Kg[(size_t)(t0 + i) * 512 + h * 128 + kk]) * __expf(-cum);
                const int ad = (adb ^ (jj << 4)) + jj * 256;
                *(u16*)(QD + ad) = f2bf(qv); *(u16*)(KI + ad) = f2bf(kv); }
            __syncthreads();
            {
                const int row = itile * 32 + r32; bf16x8 qa[8];
#pragma unroll
                for (int ks = 0; ks < 8; ++ks) qa[ks] = *(const bf16x8*)(QD + row * 256 + (((ks * 2 + hi) ^ (row & 15)) << 4));
                const int ssb = (int)(uintptr_t)SS + v_rd_base(lane) + vb * 512;
                pv_one<0, 8>(acc[0], ssb, qa[0], qa[1], qa[2], qa[3]); pv_one<0, 8>(acc[0], ssb + 32768, qa[4], qa[5], qa[6], qa[7]);
                pv_one<1, 8>(acc[1], ssb, qa[0], qa[1], qa[2], qa[3]); pv_one<1, 8>(acc[1], ssb + 32768, qa[4], qa[5], qa[6], qa[7]);
                f32x16 p0 = f32x16{}, p1 = f32x16{};
#pragma unroll
                for (int ks = 0; ks < 8; ++ks) {
                    const bf16x8 k0 = *(const bf16x8*)(KI + r32 * 256 + (((ks * 2 + hi) ^ (r32 & 15)) << 4));
                    const bf16x8 k1 = *(const bf16x8*)(KI + (32 + r32) * 256 + (((ks * 2 + hi) ^ (r32 & 15)) << 4));
                    p0 = __builtin_amdgcn_mfma_f32_32x32x16_bf16(k0, qa[ks], p0, 0, 0, 0);
                    p1 = __builtin_amdgcn_mfma_f32_32x32x16_bf16(k1, qa[ks], p1, 0, 0, 0);
                }
                const int iq = itile * 32 + r32;
#pragma unroll
                for (int r = 0; r < 16; ++r) { const int s0 = crow(r, hi), s1 = 32 + s0;
                    const bool k0 = dir == 0 ? (s0 <= iq) : (s0 >= iq), k1 = dir == 0 ? (s1 <= iq) : (s1 >= iq);
                    p0[r] = k0 ? p0[r] : 0.f; p1[r] = k1 ? p1[r] : 0.f; }
                bf16x8 pa0, pa1, pa2, pa3;
                PK4(p0, 0, pa0); PK4(p0, 8, pa1); PK4(p1, 0, pa2); PK4(p1, 8, pa3);
                const int vvb = (int)(uintptr_t)VV + v_rd_base(lane) + vb * 512;
                pv_one<0, 8>(acc[0], vvb, pa0, pa1, pa2, pa3); pv_one<1, 8>(acc[1], vvb, pa0, pa1, pa2, pa3);
            }
            __syncthreads();
        }
        float* olb = OL + (itile * 32 + 4 * hi) * 260 + vb * 32 + r32;
#pragma unroll
        for (int n = 0; n < 2; ++n)
#pragma unroll
            for (int r = 0; r < 16; ++r) olb[((r & 3) + 8 * (r >> 2)) * 260 + n * 32] = acc[n][r];
        __syncthreads();
        {
            const int i = tid >> 3, sg = tid & 7; const float* ol = OL + i * 260 + sg * 32;
            float ss = 0;
#pragma unroll
            for (int u = 0; u < 8; ++u) { const f32x4 t = *(const f32x4*)(ol + u * 4); ss += t[0] * t[0] + t[1] * t[1] + t[2] * t[2] + t[3] * t[3]; }
            ss += __shfl_xor(ss, 1); ss += __shfl_xor(ss, 2); ss += __shfl_xor(ss, 4);
            const float rinv = rsqrtf(ss * (1.f / 256.f) + EPS);
            const u16* gp = Gg + (size_t)(t0 + i) * 1024 + h * 256 + sg * 32; u16* op = OUT + (size_t)(t0 + i) * 1024 + h * 256 + sg * 32;
            const float* hn = F.in(21) + sg * 32;
#pragma unroll
            for (int q = 0; q < 4; ++q) { const bf16x8 g8 = *(const bf16x8*)(gp + q * 8); u32x4 w;
                const f32x4 oa = *(const f32x4*)(ol + q * 8), ob = *(const f32x4*)(ol + q * 8 + 4);
                const float o8[8] = {oa[0], oa[1], oa[2], oa[3], ob[0], ob[1], ob[2], ob[3]};
#pragma unroll
                for (int u = 0; u < 4; ++u) { const int e0 = q * 8 + 2 * u;
                    w[u] = cvtpk(o8[2 * u] * rinv * hn[e0] * silu_f(bf2f((u16)g8[2 * u])), o8[2 * u + 1] * rinv * hn[e0 + 1] * silu_f(bf2f((u16)g8[2 * u + 1]))); }
                *(u32x4*)(op + q * 8) = w; }
        }
    }
}

__device__ __forceinline__ void pair_decode(int p, int& elo, int& ehi) { elo = p < 3 ? 0 : (p < 5 ? 1 : 2); ehi = p < 3 ? p + 1 : (p < 5 ? p - 1 : 3); }
struct MoeATiles {
    typedef GTile<RowsGather, RowsPlain, EpiMoeA> Tile; static constexpr bool EP_CONST = false; EpiMoeA ep;
    const int* tab; u16* H; const int* rowtok; const u16* wgu; u16* act; const float* roww; int nmt, bx, G;
    __device__ __forceinline__ bool get(int i, Tile& t) const {
        int mt, nt; if (!tile_seq(i, bx, G, nmt, 16, mt, nt)) return false;
        const int c = tab[32 + mt], g = c / 6; int elo, ehi; pair_decode(c % 6, elo, ehi);
        const int half = nt >> 3, e = half ? ehi : elo;
        t.al = RowsGather{H, 1024, rowtok};
        t.bl = RowsPlain{wgu + ((size_t)(g * 4 + e) * 1024 + (nt & 7) * 128) * 1024, 1024};
        t.ep = EpiMoeA{act, roww, half, half * 512 + (nt & 7) * 64};
        t.brow = mt * 256; t.bcol = 0; return true; }
};
struct MoeBTiles {
    typedef GTile<RowsPlain, RowsSplitK, EpiMoeB> Tile; static constexpr bool EP_CONST = false; EpiMoeB ep;
    const int* tab; ResCtx F; int li; const u16* wd; const u16* act; const int* rowtok; int nmt, bx, G;
    __device__ __forceinline__ bool get(int i, Tile& t) const {
        int mt, nt; if (!tile_seq(i, bx, G, nmt, 8, mt, nt)) return false;
        const int c = tab[32 + mt], g = c / 6; int elo, ehi; pair_decode(c % 6, elo, ehi);
        t.al = RowsPlain{act, 1024};
        t.bl = RowsSplitK{wd + (size_t)(g * 4 + elo) * 1024 * 512, wd + (size_t)(g * 4 + ehi) * 1024 * 512, 512, 8};
        t.ep = EpiMoeB{F, li, rowtok};
        t.brow = mt * 256; t.bcol = nt * 128; return true; }
};
__device__ __forceinline__ void moe_gemm_a(const Frame& F, int li) {
    int* tab = (int*)(F.lds + LDS_TAB); moe_table(F, li, tab);
    const int nmt = tab[24] >> 8;
    pg8::MoeAOrder S8{F.W<u16>(WS_H), tab, F.W<int>(WS_ROWTOK), F.W<u16>(WS_MOEW), nmt, F.bx, F.G}; pg8::EpiMoeA8 E8{F.W<u16>(MOE_ACT), F.W<float>(WS_ROWW)};
    pg8::gemm_phase(F.lds, 1024, 1024, S8, E8);
}
__device__ __forceinline__ void moe_gemm_b(const Frame& F, int li) {
    int* tab = (int*)(F.lds + LDS_TAB); moe_table(F, li, tab);
    const int nmt = tab[24] >> 8;
    MoeBTiles prov{EpiMoeB{}, tab, res_ctx(F), li, F.W<u16>(WS_MOEW + MOE_WGU_BYTES), F.W<u16>(MOE_ACT), F.W<int>(WS_ROWTOK), nmt, F.bx, F.G};
    gemm_stream<4, 2>(F.lds, prov, 16);
}
__device__ __forceinline__ void final_norm(const Frame& F) {
    const int lane = threadIdx.x & 63, wid = threadIdx.x >> 6;
    for (int row = F.bx * NWAVE + wid; row < NLAT; row += F.G * NWAVE) {
        float* xr = F.out + (size_t)row * DM; f32x4 v[4];
#pragma unroll
        for (int i = 0; i < 4; ++i) v[i] = *(const f32x4*)(xr + i * 256 + lane * 4);
        float ss = 0;
#pragma unroll
        for (int i = 0; i < 4; ++i) ss += v[i][0] * v[i][0] + v[i][1] * v[i][1] + v[i][2] * v[i][2] + v[i][3] * v[i][3];
        ss = wave_sum(ss); const float rinv = rsqrtf(ss * (1.f / DM) + EPS);
#pragma unroll
        for (int i = 0; i < 4; ++i) { const f32x4 g = *(const f32x4*)(F.in(30) + i * 256 + lane * 4);
            f32x4 o = {v[i][0] * rinv * g[0], v[i][1] * rinv * g[1], v[i][2] * rinv * g[2], v[i][3] * rinv * g[3]};
            *(f32x4*)(xr + i * 256 + lane * 4) = o; }
    }
}

constexpr int N_PHASES = 42;
__global__ void __launch_bounds__(NTHR, 2) fwd_kernel(Params p) {
    extern __shared__ __attribute__((aligned(16))) char lds[];
    Frame F; F.p = &p; F.ws = p.ws; F.lds = lds; F.out = p.out; F.G = (int)gridDim.x; F.bx = (int)blockIdx.x;
    const int lo = p.ph_lo, hi = p.ph_hi;
#if !MK_PER_PHASE
    if (threadIdx.x == 0) *(uint4*)(lds + LDS_BARW) = make_uint4(0u, 0u, 0u, 0u);
    __syncthreads();
    XcdBarrier bar = xcd_barrier_post((unsigned*)(p.ws + WS_CTL), (volatile LAS unsigned*)(lds + LDS_BARW));
#define GRID_BAR() xcd_barrier(bar)
#else
#define GRID_BAR() do {} while (0)
#endif
#ifndef MK_EN
#define MK_EN 0xFFFFFFFFu
#endif
#define EN(g) (((MK_EN) >> (g)) & 1u)
#ifndef MK_REP
#define MK_REP 0u
#endif
#define REP(g) (((MK_REP) >> (g)) & 1u)
#define IN(k) (lo <= (k) && (k) < hi)
#define SEAM(k) do { if ((k) + 1 < hi) GRID_BAR(); } while (0)
#define DUP(g, body) do { body; if (REP(g)) { GRID_BAR(); body; } } while (0)

    if (EN(0) && IN(0)) { DUP(0, (p0_mods(F), __syncthreads(), p0_rope(F), p0_weights(F))); SEAM(0); }

#define LAYER(LI) { constexpr int li = (LI); constexpr int base = 1 + li * 10; constexpr bool first = li == 0, last = li == DEPTH - 1; constexpr int kind = li % 3, j = li / 3; \
        if (EN(1) && IN(base + 0)) { DUP(1, norm_phase<false>(F, li, 0, first)); SEAM(base + 0); } \
        if constexpr (kind == 0) { \
            if (EN(2) && IN(base + 1)) { EpiF32 ep{F.W<float>(MLA_DQ), 544, 544}; \
                gemm_phase<4, 2>(F, RowsPlain{F.W<u16>(WS_H), 1024}, RowsPlain{F.W<u16>(WS_WDQKV) + (size_t)j * 640 * 1024, 1024}, ep, 0, 132, 5, 16, 0, 0); if (REP(2)) { GRID_BAR(); gemm_phase<4, 2>(F, RowsPlain{F.W<u16>(WS_H), 1024}, RowsPlain{F.W<u16>(WS_WDQKV) + (size_t)j * 640 * 1024, 1024}, ep, 0, 132, 5, 16, 0, 0); } SEAM(base + 1); } \
            if (EN(3) && IN(base + 2)) { DUP(3, mla_rowpass(F, j, li)); SEAM(base + 2); } \
            if (EN(2) && IN(base + 3)) { pg8::MlaUpOrder S8{F.W<u16>(MLA_CN), F.W<u16>(WS_WUQ) + (size_t)j * 1536 * 256, F.W<u16>(WS_WUKV) + (size_t)j * 2048 * 256, F.bx, F.G}; \
                pg8::EpiMlaUp8 E8{F.W<u16>(MLA_Q), F.W<u16>(MLA_KN), (long)((MLA_V - MLA_KN) / 2), 0.10206207261596577f * LOG2E, F.W<unsigned>(WS_CTL) + CW_KMAX + li * 128}; \
                pg8::gemm_phase(F.lds, 512, 256, S8, E8); SEAM(base + 3); } \
            if (EN(4) && IN(base + 4)) { DUP(4, mla_attn(F, !last, li)); SEAM(base + 4); } \
            if (EN(2) && IN(base + 5)) { pg8::SeqOrder S8{F.W<u16>(MLA_DQ), F.W<u16>(WS_WOM) + (size_t)j * 1024 * 1024, 1024, last ? 128 : 132, 4, F.bx, F.G, last ? 4 : 0}; EpiResid8 E8{res_ctx(F, first), li}; \
                pg8::gemm_phase(F.lds, 1024, 1024, S8, E8); SEAM(base + 5); } \
        } else if constexpr (kind == 1) { \
            if (EN(5) && IN(base + 1)) { pg8::SeqOrder S8{F.W<u16>(WS_H), F.W<u16>(WS_WQKVD), 1024, 132, 12, F.bx, F.G, 0}; pg8::EpiDiffQKV8 E8{F.W<u16>(DF_Q), (long)((DF_K - DF_Q) / 2), F.W<u16>(DF_V), 0.125f * LOG2E, F.W<unsigned>(WS_CTL) + CW_KMAX + li * 128}; \
                pg8::gemm_phase(F.lds, 1024, 1024, S8, E8); \
                if (REP(5)) { GRID_BAR(); pg8::gemm_phase(F.lds, 1024, 1024, S8, E8); } SEAM(base + 1); } \
            if (EN(6) && IN(base + 2)) { DUP(6, diff_attn(F, li)); SEAM(base + 2); } \
            if (EN(7) && IN(base + 3)) { DUP(7, diff_rowpass(F, 0.35550906759906f)); SEAM(base + 3); } \
            if (EN(5) && IN(base + 4)) { pg8::SeqOrder S8{F.W<u16>(DF_Q), F.W<u16>(WS_WOD), 1024, 132, 4, F.bx, F.G, 0}; EpiResid8 E8{res_ctx(F, first), li}; \
                pg8::gemm_phase(F.lds, 1024, 1024, S8, E8); SEAM(base + 4); } \
        } else { \
            if (EN(8) && IN(base + 1)) { pg8::SeqOrder S8{F.W<u16>(WS_H), F.W<u16>(WS_WING), 1024, 132, 13, F.bx, F.G, 0}; pg8::EpiGlaIn8 E8{F.W<u16>(GL_Q), F.W<u16>(GL_K), F.W<u16>(GL_V), F.W<u16>(GL_G), F.W<float>(GL_Z)}; \
                pg8::gemm_phase(F.lds, 1024, 1024, S8, E8); \
                if (REP(8)) { GRID_BAR(); pg8::gemm_phase(F.lds, 1024, 1024, S8, E8); } SEAM(base + 1); } \
            if (EN(9) && IN(base + 2)) { DUP(9, gla_g1(F)); SEAM(base + 2); } \
            if (EN(10) && IN(base + 3)) { gla_g2(F); SEAM(base + 3); } \
            if (EN(11) && IN(base + 4)) { DUP(11, gla_g3(F)); SEAM(base + 4); } \
            if (EN(8) && IN(base + 5)) { pg8::SeqOrder S8{F.W<u16>(WS_H), F.W<u16>(WS_WOG), 1024, 132, 4, F.bx, F.G, 0}; EpiResid8 E8{res_ctx(F, first), li}; \
                pg8::gemm_phase(F.lds, 1024, 1024, S8, E8); SEAM(base + 5); } \
        } \
        if (EN(12) && IN(base + 6)) { norm_phase<true>(F, li, last ? NCTX : 0, false); SEAM(base + 6); } \
        if (EN(13) && IN(base + 7)) { DUP(13, ((kind == 2 ? moe_weights(F, li) : (void)0), moe_scatter(F, li, last ? NCTX : 0))); SEAM(base + 7); } \
        if (EN(14) && IN(base + 8)) { DUP(14, moe_gemm_a(F, li)); SEAM(base + 8); } \
        if (EN(15) && IN(base + 9)) { moe_gemm_b(F, li); SEAM(base + 9); } \
    }
    LAYER(0) LAYER(1) LAYER(2) LAYER(3)
    if (EN(16) && IN(41)) { final_norm(F); }
}

extern "C" void kernel_launch(void* const* d_in, const int* in_sizes, int n_in, void* d_out, int out_size, void* d_ws, size_t ws_size, hipStream_t stream) {
    static int grid = 0;
    if (grid == 0) {
        if (n_in != 31 || out_size != NLAT * DM || ws_size < WS_END) {
            fprintf(stderr, "kernel_launch: built for 31 inputs, out %d floats, ws >= %zu bytes; got n_in %d out %d ws %zu\n", NLAT * DM, (size_t)WS_END, n_in, out_size, ws_size);
            grid = -1; return; }
        int dev = 0, cus = 0;
        if (hipGetDevice(&dev) != hipSuccess || hipDeviceGetAttribute(&cus, hipDeviceAttributeMultiprocessorCount, dev) != hipSuccess) { grid = -1; return; }
        if (hipFuncSetAttribute((const void*)fwd_kernel, hipFuncAttributeMaxDynamicSharedMemorySize, LDS_BYTES) != hipSuccess) { fprintf(stderr, "kernel_launch: hipFuncSetAttribute failed\n"); grid = -1; return; }
        int per_cu = 0;
        if (hipOccupancyMaxActiveBlocksPerMultiprocessor(&per_cu, (const void*)fwd_kernel, NTHR, LDS_BYTES) != hipSuccess || per_cu < 1)
            fprintf(stderr, "kernel_launch: occupancy query reports %d workgroups per CU\n", per_cu);
        (void)hipGetLastError();
        grid = cus;
    }
    if (grid < 0) return;
    (void)in_sizes;
    (void)hipMemsetAsync((char*)d_ws + WS_CTL, 0, CTL_BYTES, stream);
    Params p{};
    for (int i = 0; i < 31; ++i) p.in[i] = (const float*)d_in[i];
    p.out = (float*)d_out; p.ws = (unsigned char*)d_ws;
#if MK_PER_PHASE
    for (int ph = 0; ph < N_PHASES; ++ph) { p.ph_lo = ph; p.ph_hi = ph + 1; hipLaunchKernelGGL(fwd_kernel, dim3(grid), dim3(NTHR), LDS_BYTES, stream, p); }
#else
#ifdef MK_PROBE_HI
    p.ph_lo = 0; p.ph_hi = MK_PROBE_HI;
    hipLaunchKernelGGL(fwd_kernel, dim3(grid), dim3(NTHR), LDS_BYTES, stream, p);
    (void)hipMemsetAsync((char*)d_ws + WS_CTL, 0, CTL_BYTES, stream);
#endif
    p.ph_lo = 0; p.ph_hi = N_PHASES;
    hipLaunchKernelGGL(fwd_kernel, dim3(grid), dim3(NTHR), LDS_BYTES, stream, p);
#endif
}
```

```cpp
#include <hip/hip_runtime.h>
#include <stdint.h>
#include <stdio.h>

#ifndef MK_PER_PHASE
#define MK_PER_PHASE 0
#endif

typedef unsigned short u16;
using bf16x8 = __attribute__((ext_vector_type(8))) short;
using s16x4  = __attribute__((ext_vector_type(4))) short;
using f32x16 = __attribute__((ext_vector_type(16))) float;
using f32x4  = __attribute__((ext_vector_type(4))) float;
using u32x4  = __attribute__((ext_vector_type(4))) unsigned;
using u32x2  = __attribute__((ext_vector_type(2))) unsigned;

constexpr int DM = 1024, NBATCH = 4, SEQ = 8192, CTXL = 256, DEPTH = 4;
constexpr int NCTX = NBATCH * CTXL;
constexpr int NLAT = NBATCH * SEQ;
constexpr int NTOK = NCTX + NLAT;
constexpr int KEYS = CTXL + SEQ;
constexpr float EPS = 1e-6f;
constexpr int NTHR = 512, NWAVE = 8;
constexpr float LOG2E = 1.4426950408889634f;

constexpr size_t al256(size_t x) { return (x + 255) / 256 * 256; }
constexpr size_t WS_CTL   = 0;
constexpr size_t CTL_BYTES = 32768;
constexpr size_t WS_MODS  = WS_CTL + CTL_BYTES;
constexpr size_t WS_ROPEA = WS_MODS + al256((size_t)DEPTH * 5 * 6144 * 4);
constexpr size_t WS_ROPEB = WS_ROPEA + (size_t)2 * SEQ * 16 * 4;
constexpr size_t WS_XC    = WS_ROPEB + (size_t)2 * SEQ * 32 * 4;
constexpr size_t WS_WDQKV = WS_XC + (size_t)NCTX * DM * 4;
constexpr size_t WS_WUQ   = WS_WDQKV + (size_t)2 * 640 * 1024 * 2;
constexpr size_t WS_WUKV  = WS_WUQ + (size_t)2 * 1536 * 256 * 2;
constexpr size_t WS_WOM   = WS_WUKV + (size_t)2 * 2048 * 256 * 2;
constexpr size_t WS_WQKVD = WS_WOM + (size_t)2 * 1024 * 1024 * 2;
constexpr size_t WS_WOD   = WS_WQKVD + (size_t)3072 * 1024 * 2;
constexpr size_t WS_WING  = WS_WOD + (size_t)1024 * 1024 * 2;
constexpr size_t WS_WOG   = WS_WING + (size_t)3328 * 1024 * 2;
constexpr size_t WS_TOK   = WS_WOG + (size_t)1024 * 1024 * 2;
constexpr size_t WS_ROWTOK= WS_TOK + (size_t)NTOK * 16;
constexpr int    RMAX     = 40960;
constexpr size_t WS_ROWW  = WS_ROWTOK + (size_t)RMAX * 4;
constexpr size_t WS_H     = al256(WS_ROWW + (size_t)RMAX * 8);
constexpr size_t H_BYTES  = (size_t)NTOK * DM * 2;
constexpr size_t WS_MOEW  = WS_H + H_BYTES;
constexpr size_t MOE_WGU_BYTES = (size_t)16 * 1024 * 1024 * 2;
constexpr size_t MOE_WD_BYTES  = (size_t)16 * 1024 * 512 * 2;
constexpr size_t MOEW_BYTES = MOE_WGU_BYTES + MOE_WD_BYTES;
constexpr size_t WS_BIG   = WS_MOEW + MOEW_BYTES;
constexpr size_t MLA_Q    = WS_BIG;
constexpr size_t MLA_KN   = MLA_Q + (size_t)NBATCH * 16 * KEYS * 96 * 2;
constexpr size_t MLA_V    = MLA_KN + (size_t)NBATCH * 16 * KEYS * 64 * 2;
constexpr size_t MLA_KPE  = MLA_V + (size_t)NBATCH * 16 * KEYS * 64 * 2;
constexpr size_t MLA_DQ   = MLA_KPE + al256((size_t)NBATCH * KEYS * 32 * 2);
constexpr size_t MLA_CN   = MLA_DQ + (size_t)NTOK * 544 * 4;
constexpr size_t MLA_END  = MLA_CN + (size_t)NTOK * 512 * 2;
constexpr size_t DF_Q     = WS_BIG;
constexpr size_t DF_K     = DF_Q + (size_t)NBATCH * 16 * KEYS * 64 * 2;
constexpr size_t DF_V     = DF_K + (size_t)NBATCH * 16 * KEYS * 64 * 2;
constexpr size_t DF_OS    = DF_V + (size_t)NBATCH * 8 * KEYS * 128 * 2;
constexpr size_t DF_END   = DF_OS + (size_t)2 * NTOK * DM * 2;
constexpr size_t GL_STATE = WS_MOEW;
constexpr size_t GL_STATE_BYTES = (size_t)NBATCH * 4 * 2 * 132 * 128 * 256 * 2;
constexpr size_t GL_DEC   = GL_STATE + GL_STATE_BYTES;
constexpr size_t GL_Q     = GL_DEC + al256((size_t)4224 * 128 * 4);
constexpr size_t GL_K     = GL_Q + (size_t)NTOK * 512 * 2;
constexpr size_t GL_V     = GL_K + (size_t)NTOK * 512 * 2;
constexpr size_t GL_G     = GL_V + (size_t)NTOK * 1024 * 2;
constexpr size_t GL_Z     = GL_G + (size_t)NTOK * 1024 * 2;
constexpr size_t GL_END   = GL_Z + (size_t)NTOK * 32 * 4;
constexpr size_t MOE_ACT  = WS_BIG;
constexpr size_t MOE_END  = MOE_ACT + (size_t)RMAX * 1024 * 2;
constexpr size_t cmax(size_t a, size_t b) { return a > b ? a : b; }
constexpr size_t WS_END   = cmax(cmax(MLA_END, DF_END), cmax(GL_END, MOE_END));

#define XCD_BAR_WORDS 3456
constexpr int CW_CNT = 4096;
constexpr int CW_KMAX = 4352;
constexpr int CW_PEMAX = CW_KMAX + 512;

#define XB_TMO      128
#define XB_XCNT(j)  (256  + 64 * (j))
#define XB_XSUB(j)  (1280 + 64 * (j))
#define XB_XGEN(j)  (2304 + 64 * (j))
#define XB_TOP      3328
#define XB_TOPGEN   3392
#define XB_SPIN_CAP (1u << 24)
#define LAS __attribute__((address_space(3)))
__device__ __forceinline__ unsigned xb_ld(unsigned* p)              { return __hip_atomic_load(p, __ATOMIC_RELAXED, __HIP_MEMORY_SCOPE_AGENT); }
__device__ __forceinline__ unsigned xb_add(unsigned* p, unsigned v) { return __hip_atomic_fetch_add(p, v, __ATOMIC_RELAXED, __HIP_MEMORY_SCOPE_AGENT); }
__device__ __forceinline__ unsigned xb_xcc_id() { return (unsigned)__builtin_amdgcn_s_getreg((3 << 11) | 20) & 0xFu; }
#define XB_SPIN(cond, bar) do { unsigned _sp = 0; while (cond) { __builtin_amdgcn_s_sleep(1); \
    if ((++_sp & 255u) == 0u) { if (xb_ld(&(bar)[XB_TMO])) break; if (_sp > XB_SPIN_CAP) { atomicAdd(&(bar)[XB_TMO], 1u); break; } } } } while (0)
struct XcdBarrier { unsigned* bar; unsigned x; volatile LAS unsigned* st; };
__device__ __forceinline__ XcdBarrier xcd_barrier_post(unsigned* bar, volatile LAS unsigned* st) {
    XcdBarrier b; b.bar = bar; b.x = xb_xcc_id(); b.st = st;
    if (threadIdx.x == 0) (void)xb_add(&bar[XB_XCNT(b.x)], 1u);
    return b;
}
__device__ __forceinline__ void xcd_barrier_complete(unsigned* bar, unsigned x, unsigned& nloc, unsigned& nx) {
    const unsigned G = gridDim.x * gridDim.y * gridDim.z;
    unsigned sum, cnt, mine, sp = 0u;
    for (;;) {
        sum = 0u; cnt = 0u; mine = 0u;
#pragma unroll
        for (unsigned j = 0; j < 16; ++j) { const unsigned c = xb_ld(&bar[XB_XCNT(j)]); sum += c; cnt += (c > 0u) ? 1u : 0u; mine = (j == x) ? c : mine; }
        if (sum == G) break;
        __builtin_amdgcn_s_sleep(1);
        if ((++sp & 255u) == 0u) { if (xb_ld(&bar[XB_TMO])) break; if (sp > XB_SPIN_CAP) { atomicAdd(&bar[XB_TMO], 1u); break; } }
    }
    nloc = mine > 0u ? mine : 1u; nx = cnt > 0u ? cnt : 1u;
}
__device__ __forceinline__ void xcd_barrier(const XcdBarrier& b) {
    asm volatile("s_waitcnt vmcnt(0)" ::: "memory");
    __syncthreads();
    if (threadIdx.x == 0) {
        unsigned* bar = b.bar;
        __builtin_amdgcn_s_waitcnt(0);
        unsigned nloc = b.st[0], nx = b.st[1];
        if (nloc == 0u) { xcd_barrier_complete(bar, b.x, nloc, nx); b.st[0] = nloc; b.st[1] = nx; }
        const unsigned old = xb_add(&bar[XB_XSUB(b.x)], 1u);
        const unsigned gen = old / nloc;
        if (old + 1u == (gen + 1u) * nloc) {
            __builtin_amdgcn_fence(__ATOMIC_RELEASE, "agent");
            asm volatile("s_waitcnt vmcnt(0)" ::: "memory");
            const unsigned og = xb_add(&bar[XB_TOP], 1u);
            const unsigned tg = og / nx;
            if (og + 1u == (tg + 1u) * nx) xb_add(&bar[XB_TOPGEN], 1u);
            else XB_SPIN(xb_ld(&bar[XB_TOPGEN]) == tg, bar);
            __builtin_amdgcn_fence(__ATOMIC_ACQUIRE, "agent");
            xb_add(&bar[XB_XGEN(b.x)], 1u);
            asm volatile("s_waitcnt vmcnt(0)" ::: "memory");
        } else {
            XB_SPIN(xb_ld(&bar[XB_XGEN(b.x)]) == gen, bar);
            __builtin_amdgcn_fence(__ATOMIC_ACQUIRE, "agent");
            asm volatile("s_waitcnt vmcnt(0)" ::: "memory");
        }
    }
    __syncthreads();
}

__device__ __forceinline__ u16 f2bf(float f) { unsigned u = __float_as_uint(f); u += 0x7FFFu + ((u >> 16) & 1u); return (u16)(u >> 16); }
__device__ __forceinline__ float bf2f(u16 h) { return __uint_as_float((unsigned)h << 16); }
__device__ __forceinline__ unsigned cvtpk(float lo, float hi) { unsigned r; asm volatile("v_cvt_pk_bf16_f32 %0, %1, %2" : "=v"(r) : "v"(lo), "v"(hi)); return r; }
__device__ __forceinline__ float wave_sum(float v) {
#pragma unroll
    for (int o = 32; o; o >>= 1) v += __shfl_xor(v, o);
    return v;
}
__device__ __forceinline__ float wave_max_fast(float v) {
#define DPP_MAX(v, CTRL) (v) = fmaxf((v), __uint_as_float(__builtin_amdgcn_update_dpp(0u, __float_as_uint(v), (CTRL), 0xF, 0xF, false)))
    DPP_MAX(v, 0xB1); DPP_MAX(v, 0x4E); DPP_MAX(v, 0x141); DPP_MAX(v, 0x140);
#undef DPP_MAX
    { auto rr = __builtin_amdgcn_permlane16_swap(__float_as_uint(v), __float_as_uint(v), false, false); v = fmaxf(__uint_as_float(rr[0]), __uint_as_float(rr[1])); }
    { auto rr = __builtin_amdgcn_permlane32_swap(__float_as_uint(v), __float_as_uint(v), false, false); v = fmaxf(__uint_as_float(rr[0]), __uint_as_float(rr[1])); }
    return v;
}
__device__ __forceinline__ float sum_fq(float v) {
    { auto rr = __builtin_amdgcn_permlane16_swap(__float_as_uint(v), __float_as_uint(v), false, false); v = __uint_as_float(rr[0]) + __uint_as_float(rr[1]); }
    { auto rr = __builtin_amdgcn_permlane32_swap(__float_as_uint(v), __float_as_uint(v), false, false); v = __uint_as_float(rr[0]) + __uint_as_float(rr[1]); }
    return v;
}
__device__ __forceinline__ void atomic_fmax_pos(unsigned* p, float v) { atomicMax(p, __float_as_uint(v)); }
__device__ __forceinline__ int crow(int r, int hi) { return (r & 3) + 8 * (r >> 2) + 4 * hi; }
__device__ __forceinline__ void row_bp(int row, int& b, int& pos) {
    if (row < NCTX) { b = row >> 8; pos = row & 255; } else { const int r = row - NCTX; b = r >> 13; pos = CTXL + (r & (SEQ - 1)); }
}
__device__ __forceinline__ float silu_f(float x) { return x / (1.f + __expf(-x)); }
#define SBAR() __builtin_amdgcn_sched_barrier(0)

struct Params { const float* in[31]; float* out; unsigned char* ws; int ph_lo, ph_hi; };

struct RowsPlain  { const u16* base; long ld;
    __device__ __forceinline__ long off(int r) const { return (long)r * ld; }
    __device__ __forceinline__ const u16* kbase(int kt) const { return base + kt * 64; } };
struct RowsGather { const u16* base; long ld; const int* idx;
    __device__ __forceinline__ long off(int r) const { int t = idx[r]; t = t < 0 ? 0 : t; return (long)t * ld; }
    __device__ __forceinline__ const u16* kbase(int kt) const { return base + kt * 64; } };
struct RowsSplitK { const u16* b0; const u16* b1; long ld; int ks;
    __device__ __forceinline__ long off(int r) const { return (long)r * ld; }
    __device__ __forceinline__ const u16* kbase(int kt) const { return kt < ks ? b0 + kt * 64 : b1 + (kt - ks) * 64; } };

constexpr int GEMM_LDS = 2 * 384 * 128;

template <int WM, int WN, class AL, class BL, class EP>
__device__ __forceinline__ void gemm_tile(char* lds, const AL al, const BL bl, EP& ep, int brow, int bcol, int nk) {
    constexpr int BM = WM * 64, BN = WN * 64, STG = (BM + BN) * 128, NA = BM / 64, NB = BN / 64;
    const int tid = threadIdx.x, lane = tid & 63, wid = __builtin_amdgcn_readfirstlane(tid >> 6);
    const int wm = wid / WN, wn = wid % WN, r32 = lane & 31, hi = lane >> 5;
    long aoff[NA], boff[NB];
#pragma unroll
    for (int i = 0; i < NA; ++i) { const int r = (i * 8 + wid) * 8 + (lane >> 3); const int c = (lane & 7) ^ ((r >> 1) & 7); aoff[i] = al.off(brow + r) + c * 8; }
#pragma unroll
    for (int i = 0; i < NB; ++i) { const int r = (i * 8 + wid) * 8 + (lane >> 3); const int c = (lane & 7) ^ ((r >> 1) & 7); boff[i] = bl.off(bcol + r) + c * 8; }
    const int ldsw = wid * 1024 + lane * 16;
    int abase[2], bbase[2];
#pragma unroll
    for (int i = 0; i < 2; ++i) {
        const int ra = wm * 64 + i * 32 + r32; abase[i] = ra * 128 + ((hi ^ ((ra >> 1) & 7)) << 4);
        const int rb = wn * 64 + i * 32 + r32; bbase[i] = BM * 128 + rb * 128 + ((hi ^ ((rb >> 1) & 7)) << 4);
    }
    f32x16 acc[2][2];
#pragma unroll
    for (int i = 0; i < 2; ++i)
#pragma unroll
        for (int j = 0; j < 2; ++j) acc[i][j] = f32x16{};
#define GSTAGE(kt, buf) do { const u16* _ka = al.kbase(kt); const u16* _kb = bl.kbase(kt); char* _d = lds + (buf) * STG + ldsw; \
        _Pragma("unroll") for (int _i = 0; _i < NA; ++_i) __builtin_amdgcn_global_load_lds((const unsigned*)(_ka + aoff[_i]), (unsigned*)(_d + _i * 8192), 16, 0, 0); \
        _Pragma("unroll") for (int _i = 0; _i < NB; ++_i) __builtin_amdgcn_global_load_lds((const unsigned*)(_kb + boff[_i]), (unsigned*)(_d + BM * 128 + _i * 8192), 16, 0, 0); } while (0)
    __syncthreads();
    GSTAGE(0, 0);
    for (int kt = 0; kt < nk; ++kt) {
        asm volatile("s_waitcnt vmcnt(0)" ::: "memory");
        __syncthreads();
        if (kt + 1 < nk) GSTAGE(kt + 1, (kt + 1) & 1);
        const char* sb = lds + (kt & 1) * STG;
#pragma unroll
        for (int ks = 0; ks < 4; ++ks) {
            bf16x8 a0 = *(const bf16x8*)(sb + (abase[0] ^ (ks << 5)));
            bf16x8 a1 = *(const bf16x8*)(sb + (abase[1] ^ (ks << 5)));
            bf16x8 b0 = *(const bf16x8*)(sb + (bbase[0] ^ (ks << 5)));
            bf16x8 b1 = *(const bf16x8*)(sb + (bbase[1] ^ (ks << 5)));
            acc[0][0] = __builtin_amdgcn_mfma_f32_32x32x16_bf16(a0, b0, acc[0][0], 0, 0, 0);
            acc[0][1] = __builtin_amdgcn_mfma_f32_32x32x16_bf16(a0, b1, acc[0][1], 0, 0, 0);
            acc[1][0] = __builtin_amdgcn_mfma_f32_32x32x16_bf16(a1, b0, acc[1][0], 0, 0, 0);
            acc[1][1] = __builtin_amdgcn_mfma_f32_32x32x16_bf16(a1, b1, acc[1][1], 0, 0, 0);
        }
    }
#undef GSTAGE
    ep(acc, brow + wm * 64, bcol + wn * 64, lane);
}


constexpr int GSTG = 384 * 128;
template <class AL_, class BL_, class EP_> struct GTile { typedef EP_ EPT; AL_ al; BL_ bl; EP_ ep; int brow, bcol; };
__device__ __forceinline__ bool tile_seq(int i, int bx, int G, int nM, int nN, int& m, int& n) {
    const int s = (G == 256) ? (i * 8 + (bx & 7)) * 32 + (bx >> 3) : bx + i * G;
    if (s >= nM * nN) return false;
    const int full = (nM >> 2) * 4 * nN;
    if (s < full) { const int band = s / (4 * nN), rem = s - band * 4 * nN; n = rem >> 2; m = band * 4 + (rem & 3); }
    else { const int h = nM & 3, rem = s - full; n = rem / h; m = (nM & ~3) + rem - n * h; }
    return true;
}
template <class AL_, class BL_, class EP_> struct PlainTiles {
    typedef GTile<AL_, BL_, EP_> Tile; static constexpr bool EP_CONST = true;
    AL_ al; BL_ bl; EP_ ep; int mt0, nM, nN, bx, G;
    __device__ __forceinline__ bool get(int i, Tile& t) const {
        int m, n; if (!tile_seq(i, bx, G, nM, nN, m, n)) return false;
        t.al = al; t.bl = bl; t.ep = ep; t.brow = (mt0 + m) * 256; t.bcol = n * 128; return true; }
};
template <int WM, int WN, class P>
__device__ __forceinline__ void gemm_stream(char* lds, const P& prov, int nk) {
    constexpr int BM = WM * 64, BN = WN * 64, NA = BM / 64, NB = BN / 64;
    static_assert(NA + NB == 6, "the counted wait assumes six LDS-DMA loads per wave per K-step");
    const int tid = threadIdx.x, lane = tid & 63, wid = __builtin_amdgcn_readfirstlane(tid >> 6);
    const int wm = wid / WN, wn = wid % WN, r32 = lane & 31, hi = lane >> 5;
    typename P::Tile cur, nxt;
    if (!prov.get(0, cur)) return;
    unsigned aoff[NA], boff[NB], aoffn[NA], boffn[NB];
#define GOFFS(T, AO, BO) do { \
    _Pragma("unroll") for (int _i = 0; _i < NA; ++_i) { const int _r = (_i * 8 + wid) * 8 + (lane >> 3); const int _c = (lane & 7) ^ ((_r >> 1) & 7); AO[_i] = (unsigned)((T).al.off((T).brow + _r) + _c * 8); } \
    _Pragma("unroll") for (int _i = 0; _i < NB; ++_i) { const int _r = (_i * 8 + wid) * 8 + (lane >> 3); const int _c = (lane & 7) ^ ((_r >> 1) & 7); BO[_i] = (unsigned)((T).bl.off((T).bcol + _r) + _c * 8); } } while (0)
#define GSTAGE2(T, AO, BO, kt, slot) do { const u16* _ka = (T).al.kbase(kt); const u16* _kb = (T).bl.kbase(kt); char* _d = lds + (slot) * GSTG + ldsw; \
        _Pragma("unroll") for (int _i = 0; _i < NA; ++_i) __builtin_amdgcn_global_load_lds((const unsigned*)(_ka + AO[_i]), (unsigned*)(_d + _i * 8192), 16, 0, 0); \
        _Pragma("unroll") for (int _i = 0; _i < NB; ++_i) __builtin_amdgcn_global_load_lds((const unsigned*)(_kb + BO[_i]), (unsigned*)(_d + BM * 128 + _i * 8192), 16, 0, 0); } while (0)
    GOFFS(cur, aoff, boff);
    const int ldsw = wid * 1024 + lane * 16;
    int abase[2], bbase[2];
#pragma unroll
    for (int i = 0; i < 2; ++i) {
        const int ra = wm * 64 + i * 32 + r32; abase[i] = ra * 128 + ((hi ^ ((ra >> 1) & 7)) << 4);
        const int rb = wn * 64 + i * 32 + r32; bbase[i] = BM * 128 + rb * 128 + ((hi ^ ((rb >> 1) & 7)) << 4);
    }
    f32x16 acc[2][2];
#pragma unroll
    for (int i = 0; i < 2; ++i)
#pragma unroll
        for (int j = 0; j < 2; ++j) acc[i][j] = f32x16{};
    __syncthreads();
    GSTAGE2(cur, aoff, boff, 0, 0); GSTAGE2(cur, aoff, boff, 1, 1);
    int slot = 0; bool pendE = false; typename P::Tile::EPT pep = cur.ep; int pbrow = 0, pbcol = 0;
    for (int i = 0;; ++i) {
        const bool has_next = prov.get(i + 1, nxt);
        if (has_next) GOFFS(nxt, aoffn, boffn);
        for (int kt = 0; kt < nk; ++kt) {
            if ((kt + 1 < nk) || has_next) asm volatile("s_waitcnt vmcnt(6)" ::: "memory"); else asm volatile("s_waitcnt vmcnt(0)" ::: "memory");
            __builtin_amdgcn_s_barrier(); asm volatile("" ::: "memory");
            const int s2 = slot >= 1 ? slot - 1 : 2;
            if (kt + 2 < nk) GSTAGE2(cur, aoff, boff, kt + 2, s2); else if (has_next) GSTAGE2(nxt, aoffn, boffn, kt + 2 - nk, s2);
            if (kt == 0 && pendE) {
                if constexpr (P::EP_CONST) (void)prov.ep(acc, pbrow + wm * 64, pbcol + wn * 64, lane); else (void)pep(acc, pbrow + wm * 64, pbcol + wn * 64, lane);
                pendE = false;
#pragma unroll
                for (int a = 0; a < 2; ++a)
#pragma unroll
                    for (int b = 0; b < 2; ++b) acc[a][b] = f32x16{};
            }
            const char* sb = lds + slot * GSTG;
#pragma unroll
            for (int ks = 0; ks < 4; ++ks) {
                bf16x8 a0 = *(const bf16x8*)(sb + (abase[0] ^ (ks << 5)));
                bf16x8 a1 = *(const bf16x8*)(sb + (abase[1] ^ (ks << 5)));
                bf16x8 b0 = *(const bf16x8*)(sb + (bbase[0] ^ (ks << 5)));
                bf16x8 b1 = *(const bf16x8*)(sb + (bbase[1] ^ (ks << 5)));
                acc[0][0] = __builtin_amdgcn_mfma_f32_32x32x16_bf16(b0, a0, acc[0][0], 0, 0, 0);
                acc[0][1] = __builtin_amdgcn_mfma_f32_32x32x16_bf16(b1, a0, acc[0][1], 0, 0, 0);
                acc[1][0] = __builtin_amdgcn_mfma_f32_32x32x16_bf16(b0, a1, acc[1][0], 0, 0, 0);
                acc[1][1] = __builtin_amdgcn_mfma_f32_32x32x16_bf16(b1, a1, acc[1][1], 0, 0, 0);
            }
            slot = slot == 2 ? 0 : slot + 1;
        }
        if (!has_next) { (void)cur.ep(acc, cur.brow + wm * 64, cur.bcol + wn * 64, lane); break; }
        if constexpr (!P::EP_CONST) pep = cur.ep;
        pbrow = cur.brow; pbcol = cur.bcol; pendE = true;
        cur = nxt;
#pragma unroll
        for (int a = 0; a < NA; ++a) aoff[a] = aoffn[a];
#pragma unroll
        for (int b = 0; b < NB; ++b) boff[b] = boffn[b];
    }
    asm volatile("s_waitcnt vmcnt(0)" ::: "memory");
    __syncthreads();
#undef GOFFS
#undef GSTAGE2
}


template <int NF> __device__ __forceinline__ void rope_cs(int n, int i, float& cs, float& sn) {
    const int fi = i & (NF - 1); const float pos = (i < NF) ? (float)(n >> 6) : (float)(n & 63);
    const float invf = __builtin_amdgcn_exp2f(-(float)fi / (float)NF * 13.287712379549449f);
    const float ang = pos * invf; float rev = ang * 0.15915494309189535f; rev -= floorf(rev);
    cs = __builtin_amdgcn_cosf(rev); sn = __builtin_amdgcn_sinf(rev);
}
namespace pg8 {
constexpr int BM = 256, BK = 64, HALF = 128, HTB = HALF * BK * 2, STAGE_BYTES = 8 * HTB;
__device__ __forceinline__ int lds_byte(int r, int c) { const int st = (r >> 4) * 2 + (c >> 5), rr = r & 15, cc = c & 31, ob = rr * 64 + cc * 2; return st * 1024 + (ob ^ (((ob >> 9) & 1) << 5)); }
__device__ __forceinline__ void stage_rc(int b, int& R, int& C) { const int st = b / 1024, sb = b % 1024, swz = sb ^ (((sb >> 9) & 1) << 5); R = (st >> 1) * 16 + swz / 64; C = (st & 1) * 32 + (swz % 64) / 2; }
struct Unit { int pm, pn; };
template <class Epi, class Sched>
__device__ __forceinline__ void gemm_phase(char* lds, int lda, int K, const Sched& S, const Epi& E) {
    constexpr bool GA = Sched::GATHER;
    const int tid = threadIdx.x, wid = __builtin_amdgcn_readfirstlane(tid >> 6), lane = tid & 63, wr = wid >> 2, wc = wid & 3, fr = lane & 15, fq = lane >> 4;
    const int nt = K / BK;
    unsigned voffB[2], vbA[2], vc0[2], vc1[2], vn0[2], vn1[2]; int sR[2], sC[2];
#pragma unroll
    for (int i = 0; i < 2; ++i) { stage_rc(tid * 16 + i * 8192, sR[i], sC[i]); voffB[i] = (unsigned)(sR[i] * K + sC[i]) * 2u; vbA[i] = (unsigned)(sR[i] * lda + sC[i]) * 2u; }
    const size_t kstep = (size_t)(BK * 2), hstep = (size_t)HALF * K * 2, hstepA = (size_t)HALF * lda * 2;
    const unsigned ldsw = (unsigned)wid * 1024u;
    const int aoff = lds_byte(wr * 64 + fr, fq * 8), boff = lds_byte(wc * 32 + fr, fq * 8);
#define PG8_AOFFS(u, v0, v1) do { _Pragma("unroll") for (int _i = 0; _i < 2; ++_i) { \
        if constexpr (GA) { v0[_i] = (unsigned)S.arow(u, sR[_i]) * (unsigned)(lda * 2) + (unsigned)sC[_i] * 2u; v1[_i] = (unsigned)S.arow(u, HALF + sR[_i]) * (unsigned)(lda * 2) + (unsigned)sC[_i] * 2u; } \
        else { v0[_i] = vbA[_i] + (unsigned)(u).pm * (unsigned)(256 * lda * 2); v1[_i] = v0[_i] + (unsigned)hstepA; } } } while (0)
#define PG8_SA(b, h) (((b) * 2 + (h)) * HTB)
#define PG8_SB(b, h) ((4 + (b) * 2 + (h)) * HTB)
#define PG8_STAGE(bufoff, gbase, voff) do { _Pragma("unroll") for (int _i = 0; _i < 2; ++_i) \
        __builtin_amdgcn_global_load_lds((const unsigned*)((const char*)(gbase) + (voff)[_i]), (unsigned*)(lds + (bufoff) + ldsw + _i * 8192), 16, 0, 0); } while (0)
#define PG8_STA(bufoff, kt, h, nx) do { const char* _g = ((nx) ? nAb : cAb) + (size_t)(kt) * kstep; unsigned _v[2]; \
        _Pragma("unroll") for (int _i = 0; _i < 2; ++_i) _v[_i] = (nx) ? ((h) ? vn1[_i] : vn0[_i]) : ((h) ? vc1[_i] : vc0[_i]); PG8_STAGE(bufoff, _g, _v); } while (0)
#define PG8_LDA(dst, b, h) do { _Pragma("unroll") for (int m = 0; m < 4; ++m) _Pragma("unroll") for (int k = 0; k < 2; ++k) dst[m][k] = *(const bf16x8*)(lds + PG8_SA(b, h) + aoff + m * 2048 + k * 1024); } while (0)
#define PG8_LDB(dst, b, h) do { _Pragma("unroll") for (int n = 0; n < 2; ++n) _Pragma("unroll") for (int k = 0; k < 2; ++k) dst[n][k] = *(const bf16x8*)(lds + PG8_SB(b, h) + boff + n * 2048 + k * 1024); } while (0)
#define PG8_MMA(ai, bj, At, Bt_) do { __builtin_amdgcn_s_setprio(1); _Pragma("unroll") for (int m = 0; m < 4; ++m) _Pragma("unroll") for (int n = 0; n < 2; ++n) _Pragma("unroll") for (int k = 0; k < 2; ++k) \
        acc[ai][bj][m][n] = __builtin_amdgcn_mfma_f32_16x16x32_bf16(Bt_[n][k], At[m][k], acc[ai][bj][m][n], 0, 0, 0); __builtin_amdgcn_s_setprio(0); } while (0)
#define PG8_WAIT_V(n) asm volatile("s_waitcnt vmcnt(" #n ")" ::: "memory")
#define PG8_WAIT_L(n) asm volatile("s_waitcnt lgkmcnt(" #n ")" ::: "memory")
#define PG8_BAR __builtin_amdgcn_s_barrier()
#define PG8_SCHED __builtin_amdgcn_sched_barrier(0)
    Unit cur, nxt; int ui = 0;
    if (!S.next(0, cur)) return;
    f32x4 acc[2][2][4][2];
#pragma unroll
    for (int a = 0; a < 2; ++a)
#pragma unroll
        for (int b = 0; b < 2; ++b)
#pragma unroll
            for (int m = 0; m < 4; ++m)
#pragma unroll
                for (int n = 0; n < 2; ++n) acc[a][b][m][n] = (f32x4){0.f, 0.f, 0.f, 0.f};
    bf16x8 At[4][2], B0[2][2], B1[2][2];
    PG8_AOFFS(cur, vc0, vc1);
    const char* cB = (const char*)S.bbase(cur); const char* cAb = (const char*)S.abase(cur); const char* nAb = cAb;
    __syncthreads();
    PG8_STAGE(PG8_SB(0, 0), cB, voffB); PG8_STA(PG8_SA(0, 0), 0, 0, false); PG8_STAGE(PG8_SB(0, 1), cB + hstep, voffB); PG8_STA(PG8_SA(0, 1), 0, 1, false);
    if (wr == 1) PG8_BAR;
    PG8_WAIT_V(4); PG8_BAR;
    PG8_STAGE(PG8_SB(1, 0), cB + kstep, voffB); PG8_STA(PG8_SA(1, 0), 1, 0, false); PG8_STAGE(PG8_SB(1, 1), cB + hstep + kstep, voffB);
    PG8_WAIT_V(6); PG8_BAR;
    for (;;) {
        const bool has_next = S.next(ui + 1, nxt);
        const char* nB = cB;
        nAb = cAb;
        if (has_next) { PG8_AOFFS(nxt, vn0, vn1); nB = (const char*)S.bbase(nxt); nAb = (const char*)S.abase(nxt); }
        else {
#pragma unroll
            for (int i = 0; i < 2; ++i) { vn0[i] = vc0[i]; vn1[i] = vc1[i]; } }
#pragma unroll 1
        for (int t = 0; t < nt; t += 2) {
            const bool last = (t == nt - 2);
            const int k2 = last ? 0 : t + 2, k3 = k2 + 1;
            const char* b2 = last ? nB : cB + (size_t)(t + 2) * kstep; const char* b3 = b2 + kstep;
            PG8_LDB(B0, 0, 0); PG8_SCHED; PG8_LDA(At, 0, 0); PG8_STA(PG8_SA(1, 1), t + 1, 1, false);
            PG8_WAIT_L(8); PG8_BAR; PG8_WAIT_L(0); PG8_MMA(0, 0, At, B0); PG8_BAR; PG8_SCHED;
            PG8_LDB(B1, 0, 1); PG8_STAGE(PG8_SB(0, 0), b2, voffB);
            PG8_BAR; PG8_WAIT_L(0); PG8_MMA(0, 1, At, B1); PG8_BAR;
            PG8_LDA(At, 0, 1); PG8_STA(PG8_SA(0, 0), k2, 0, last);
            PG8_BAR; PG8_WAIT_L(0); PG8_MMA(1, 0, At, B0); PG8_BAR; PG8_SCHED;
            PG8_STAGE(PG8_SB(0, 1), b2 + hstep, voffB);
            PG8_WAIT_V(6); PG8_BAR; PG8_MMA(1, 1, At, B1); PG8_BAR;
            PG8_LDB(B0, 1, 0); PG8_SCHED; PG8_LDA(At, 1, 0); PG8_STA(PG8_SA(0, 1), k2, 1, last);
            PG8_WAIT_L(8); PG8_BAR; PG8_WAIT_L(0); PG8_MMA(0, 0, At, B0); PG8_BAR; PG8_SCHED;
            PG8_LDB(B1, 1, 1); PG8_STAGE(PG8_SB(1, 0), b3, voffB);
            PG8_BAR; PG8_WAIT_L(0); PG8_MMA(0, 1, At, B1); PG8_BAR;
            PG8_LDA(At, 1, 1); PG8_STA(PG8_SA(1, 0), k3, 0, last);
            PG8_BAR; PG8_WAIT_L(0); PG8_MMA(1, 0, At, B0); PG8_BAR; PG8_SCHED;
            PG8_STAGE(PG8_SB(1, 1), b3 + hstep, voffB);
            PG8_WAIT_V(6); PG8_BAR; PG8_MMA(1, 1, At, B1); PG8_BAR;
        }
        E(acc, cur, wr, wc, fr, fq);
        if (!has_next) break;
#pragma unroll
        for (int a = 0; a < 2; ++a)
#pragma unroll
            for (int b = 0; b < 2; ++b)
#pragma unroll
                for (int m = 0; m < 4; ++m)
#pragma unroll
                    for (int n = 0; n < 2; ++n) acc[a][b][m][n] = (f32x4){0.f, 0.f, 0.f, 0.f};
        cur = nxt; cB = nB; cAb = nAb; ++ui;
#pragma unroll
        for (int i = 0; i < 2; ++i) { vc0[i] = vn0[i]; vc1[i] = vn1[i]; }
    }
    PG8_WAIT_V(0);
    if (wr == 0) PG8_BAR;
    PG8_BAR;
#undef PG8_AOFFS
#undef PG8_STA
#undef PG8_SA
#undef PG8_SB
#undef PG8_STAGE
#undef PG8_LDA
#undef PG8_LDB
#undef PG8_MMA
#undef PG8_WAIT_V
#undef PG8_WAIT_L
#undef PG8_BAR
#undef PG8_SCHED
}
struct SeqOrder { static constexpr bool GATHER = false; const u16* A; const u16* Bt; int K, nM, nN, bx, G, mt0;
    __device__ __forceinline__ const u16* abase(const Unit&) const { return A; }
    __device__ __forceinline__ bool next(int i, Unit& u) const { const bool ok = tile_seq(i, bx, G, nM, nN, u.pm, u.pn); u.pm += mt0; return ok; }
    __device__ __forceinline__ const u16* bbase(const Unit& u) const { return Bt + (size_t)u.pn * 256 * K; }
    __device__ __forceinline__ int arow(const Unit& u, int r) const { return u.pm * 256 + r; } };
struct EpiGlaIn8 { u16* q; u16* k; u16* v; u16* g; float* z;
    __device__ __forceinline__ void operator()(const f32x4 (&acc)[2][2][4][2], const Unit& u, int wr, int wc, int fr, int fq) const {
#pragma unroll
        for (int bj = 0; bj < 2; ++bj)
#pragma unroll
            for (int n = 0; n < 2; ++n) { const int c0 = u.pn * 256 + bj * 128 + wc * 32 + n * 16, col = c0 + 4 * fq;
                if (c0 >= 3104) continue;
                u16* base; int ld, cc; float scl = 1.f;
                if (c0 < 512) { base = q; ld = 512; cc = col; scl = 0.08838834764831845f; } else if (c0 < 1024) { base = k; ld = 512; cc = col - 512; }
                else if (c0 < 2048) { base = v; ld = 1024; cc = col - 1024; } else if (c0 < 3072) { base = g; ld = 1024; cc = col - 2048; } else { base = nullptr; ld = 32; cc = col - 3072; }
#pragma unroll
                for (int ai = 0; ai < 2; ++ai)
#pragma unroll
                    for (int m = 0; m < 4; ++m) { const size_t row = (size_t)u.pm * 256 + ai * 128 + wr * 64 + m * 16 + fr; const f32x4 a = acc[ai][bj][m][n];
                        if (c0 < 3072) { u32x2 w = {cvtpk(a[0] * scl, a[1] * scl), cvtpk(a[2] * scl, a[3] * scl)}; *(u32x2*)(base + row * ld + cc) = w; }
                        else *(f32x4*)(z + row * 32 + cc) = a; } }
    } };
struct EpiDiffQKV8 { u16* Q; long kdelta; u16* V; float qscale; unsigned* km;
    __device__ __forceinline__ void operator()(const f32x4 (&acc)[2][2][4][2], const Unit& u, int wr, int wc, int fr, int fq) const {
        float kmx = 0.f;
#pragma unroll
        for (int ai = 0; ai < 2; ++ai)
#pragma unroll
            for (int m = 0; m < 4; ++m) { int frr = fr; asm volatile("" : "+v"(frr));
                const int row = u.pm * 256 + ai * 128 + wr * 64 + m * 16 + frr; int b, pos; row_bp(row, b, pos); const bool lat = row >= NCTX; const int np = (row - NCTX) & (SEQ - 1);
                if (u.pn < 8) { const int region = u.pn >> 2, hh = (u.pn & 3) * 4 + wc; const float scl = region == 0 ? qscale : 1.f; float ks2 = 0.f;
                    u16* o = Q + (long)region * kdelta + ((size_t)(b * 16 + hh) * KEYS + pos) * 64;
#pragma unroll
                    for (int n = 0; n < 2; ++n) { const int d0 = 16 * n + 4 * fq; const f32x4 t1 = acc[ai][0][m][n], t2 = acc[ai][1][m][n]; float o1[4], o2[4];
#pragma unroll
                        for (int j = 0; j < 4; ++j) { float cs = 1.f, sn = 0.f; if (lat) rope_cs<16>(np, d0 + j, cs, sn); o1[j] = (t1[j] * cs - t2[j] * sn) * scl; o2[j] = (t1[j] * sn + t2[j] * cs) * scl; }
                        u32x2 w1 = {cvtpk(o1[0], o1[1]), cvtpk(o1[2], o1[3])}, w2 = {cvtpk(o2[0], o2[1]), cvtpk(o2[2], o2[3])};
                        *(u32x2*)(o + d0) = w1; *(u32x2*)(o + 32 + d0) = w2;
#pragma unroll
                        for (int j = 0; j < 4; ++j) ks2 += o1[j] * o1[j] + o2[j] * o2[j]; }
                    kmx = fmaxf(kmx, ks2);
                } else {
#pragma unroll
                    for (int bj = 0; bj < 2; ++bj) { const int head = (u.pn - 8) * 2 + bj; u16* o = V + ((size_t)(b * 8 + head) * KEYS + pos) * 128 + wc * 32 + 4 * fq;
#pragma unroll
                        for (int n = 0; n < 2; ++n) { const f32x4 a = acc[ai][bj][m][n]; u32x2 w = {cvtpk(a[0], a[1]), cvtpk(a[2], a[3])}; *(u32x2*)(o + 16 * n) = w; } }
                } }
        if (u.pn >= 4 && u.pn < 8) {
            const int b = u.pm < 4 ? u.pm : ((u.pm - 4) >> 5); const float v = wave_max_fast(sum_fq(kmx));
            if (fr == 0 && fq == 0) atomic_fmax_pos(km + ((b * 16 + (u.pn & 3) * 4 + wc) * 2), v); }
    } };
struct MoeAOrder { static constexpr bool GATHER = true; const u16* A; const int* tab; const int* rowtok; const u16* wgu; int nmt, bx, G;
    __device__ __forceinline__ const u16* abase(const Unit&) const { return A; }
    __device__ __forceinline__ bool next(int i, Unit& u) const { return tile_seq(i, bx, G, nmt, 8, u.pm, u.pn); }
    __device__ __forceinline__ const u16* bbase(const Unit& u) const {
        const int c = tab[32 + u.pm], g = c / 6, p = c - g * 6; const int elo = p < 3 ? 0 : (p < 5 ? 1 : 2), ehi = p < 3 ? p + 1 : (p < 5 ? p - 1 : 3);
        const int e = (u.pn >> 2) ? ehi : elo; return wgu + ((size_t)(g * 4 + e) * 1024 + (u.pn & 3) * 256) * 1024; }
    __device__ __forceinline__ int arow(const Unit& u, int r) const { const int t = rowtok[u.pm * 256 + r]; return t < 0 ? 0 : t; } };
struct EpiMoeA8 { u16* act; const float* roww;
    __device__ __forceinline__ void operator()(const f32x4 (&acc)[2][2][4][2], const Unit& u, int wr, int wc, int fr, int fq) const {
        const int half = u.pn >> 2, cb = half * 512 + (u.pn & 3) * 128 + wc * 32 + 4 * fq;
#pragma unroll
        for (int ai = 0; ai < 2; ++ai)
#pragma unroll
            for (int m = 0; m < 4; ++m) { const size_t row = (size_t)u.pm * 256 + ai * 128 + wr * 64 + m * 16 + fr; const float w = roww[2 * row + half];
#pragma unroll
                for (int n = 0; n < 2; ++n) { const f32x4 gt = acc[ai][0][m][n], up = acc[ai][1][m][n]; float v[4];
#pragma unroll
                    for (int j = 0; j < 4; ++j) v[j] = silu_f(gt[j]) * up[j] * w;
                    u32x2 pk = {cvtpk(v[0], v[1]), cvtpk(v[2], v[3])}; *(u32x2*)(act + row * 1024 + cb + 16 * n) = pk; } }
    } };
struct MlaUpOrder { static constexpr bool GATHER = false; const u16* CN; const u16* wuq; const u16* wukv; int bx, G;
    __device__ __forceinline__ bool next(int i, Unit& u) const { return tile_seq(i, bx, G, 132, 14, u.pm, u.pn); }
    __device__ __forceinline__ const u16* abase(const Unit& u) const { return u.pn < 6 ? CN : CN + 256; }
    __device__ __forceinline__ const u16* bbase(const Unit& u) const { return u.pn < 6 ? wuq + (size_t)u.pn * 256 * 256 : wukv + (size_t)(u.pn - 6) * 256 * 256; }
    __device__ __forceinline__ int arow(const Unit& u, int r) const { return u.pm * 256 + r; } };
struct EpiMlaUp8 { u16* Q; u16* Kn; long vdelta; float qscale; unsigned* km; const float* SS;
    __device__ __forceinline__ void operator()(const f32x4 (&acc)[2][2][4][2], const Unit& u, int wr, int wc, int fr, int fq) const {
        float kmx[2] = {0.f, 0.f};
#pragma unroll
        for (int ai = 0; ai < 2; ++ai)
#pragma unroll
            for (int m = 0; m < 4; ++m) { int frr = fr; asm volatile("" : "+v"(frr));
                const int row = u.pm * 256 + ai * 128 + wr * 64 + m * 16 + frr; int b, pos; row_bp(row, b, pos); const bool lat = row >= NCTX; const int np = (row - NCTX) & (SEQ - 1);
                const f32x4 ssq = *(const f32x4*)(SS + (size_t)row * 8 + (u.pn < 6 ? 0 : 4));
                const float rinv = rsqrtf((ssq[0] + ssq[1] + ssq[2] + ssq[3]) * (1.f / 256.f) + EPS);
                if (u.pn < 6) { const float qs = qscale * rinv;
#pragma unroll
                    for (int bj = 0; bj < 2; ++bj) { const int sb = 8 * u.pn + 4 * bj + wc, head = sb / 3, part = sb - head * 3;
                        f32x4 v0 = acc[ai][bj][m][0] * qs, v1 = acc[ai][bj][m][1] * qs;
                        if (part == 2 && lat) {
#pragma unroll
                            for (int j = 0; j < 4; ++j) { float cs, sn; rope_cs<8>(np, 4 * fq + j, cs, sn); const float t1 = v0[j], t2 = v1[j]; v0[j] = t1 * cs - t2 * sn; v1[j] = t1 * sn + t2 * cs; } }
                        u16* o = Q + ((size_t)(b * 16 + head) * KEYS + pos) * 96 + part * 32 + 4 * fq;
                        u32x2 w0 = {cvtpk(v0[0], v0[1]), cvtpk(v0[2], v0[3])}, w1 = {cvtpk(v1[0], v1[1]), cvtpk(v1[2], v1[3])}; *(u32x2*)o = w0; *(u32x2*)(o + 16) = w1; }
                } else {
#pragma unroll
                    for (int bj = 0; bj < 2; ++bj) { const int head = (u.pn - 6) * 2 + bj; u16* o = Kn + (long)(wc >> 1) * vdelta + ((size_t)(b * 16 + head) * KEYS + pos) * 64 + (wc & 1) * 32 + 4 * fq;
                        float s2 = 0.f;
#pragma unroll
                        for (int n = 0; n < 2; ++n) { const f32x4 a = acc[ai][bj][m][n] * rinv; u32x2 w = {cvtpk(a[0], a[1]), cvtpk(a[2], a[3])}; *(u32x2*)(o + 16 * n) = w;
                            s2 += a[0] * a[0] + a[1] * a[1] + a[2] * a[2] + a[3] * a[3]; }
                        kmx[bj] = fmaxf(kmx[bj], s2); }
                } }
        if (u.pn >= 6 && wc < 2) {
            const int b = u.pm < 4 ? u.pm : ((u.pm - 4) >> 5);
#pragma unroll
            for (int bj = 0; bj < 2; ++bj) { const float v = wave_max_fast(sum_fq(kmx[bj])); if (fr == 0 && fq == 0) atomic_fmax_pos(km + ((b * 16 + (u.pn - 6) * 2 + bj) * 2 + wc), v); }
        }
    } };
}

template <int DK, int DV> struct AttnCfg {
    static constexpr int NKB = DK / 32, NVB = DV / 32, ND0 = DK / 16;
    static constexpr int KBYTES = 64 * DK * 2, VBYTES = 64 * DV * 2;
    static constexpr int LDS = 2 * KBYTES + 2 * VBYTES + NWAVE * 64 * 4;
};
constexpr float ATT_THR = 8.f;

__device__ __forceinline__ void partialSM(f32x16& p0, f32x16& p1, float& m_reg, float& mn, float& alpha) {
    float pmax = p0[0];
#pragma unroll
    for (int r = 1; r < 16; ++r) pmax = fmaxf(pmax, p0[r]);
#pragma unroll
    for (int r = 0; r < 16; ++r) pmax = fmaxf(pmax, p1[r]);
    { auto rr = __builtin_amdgcn_permlane32_swap(__float_as_uint(pmax), __float_as_uint(pmax), false, false);
      pmax = fmaxf(__uint_as_float(rr[0]), __uint_as_float(rr[1])); }
    if (__builtin_expect(__all(pmax - m_reg <= ATT_THR), 1)) { mn = m_reg; alpha = 1.f; }
    else { mn = fmaxf(m_reg, pmax); alpha = __builtin_amdgcn_exp2f(m_reg - mn); m_reg = mn; }
#pragma unroll
    for (int r = 0; r < 16; ++r) p0[r] = p0[r] - mn;
#pragma unroll
    for (int r = 0; r < 16; ++r) p1[r] = p1[r] - mn;
#pragma unroll
    for (int r = 0; r < 16; ++r) p0[r] = __builtin_amdgcn_exp2f(p0[r]);
}
#define PK4(P, BASE, OUT) do { unsigned a0 = cvtpk(P[BASE + 0], P[BASE + 1]), a1 = cvtpk(P[BASE + 2], P[BASE + 3]);   \
    unsigned b0 = cvtpk(P[BASE + 4], P[BASE + 5]), b1 = cvtpk(P[BASE + 6], P[BASE + 7]);                              \
    auto r0 = __builtin_amdgcn_permlane32_swap(a0, b0, false, false); auto r1 = __builtin_amdgcn_permlane32_swap(a1, b1, false, false); \
    u32x4 w = {r0[0], r1[0], r0[1], r1[1]}; OUT = *reinterpret_cast<bf16x8*>(&w); } while (0)
__device__ __forceinline__ void finishSM(f32x16& p0, f32x16& p1, float alpha, float& l_reg, bf16x8& pa0, bf16x8& pa1, bf16x8& pa2, bf16x8& pa3) {
#pragma unroll
    for (int r = 0; r < 16; ++r) p1[r] = __builtin_amdgcn_exp2f(p1[r]);
    float ps = 0;
#pragma unroll
    for (int r = 0; r < 16; ++r) ps += p0[r];
#pragma unroll
    for (int r = 0; r < 16; ++r) ps += p1[r];
    { auto rr = __builtin_amdgcn_permlane32_swap(__float_as_uint(ps), __float_as_uint(ps), false, false);
      ps = __uint_as_float(rr[0]) + __uint_as_float(rr[1]); }
    l_reg = l_reg * alpha + ps;
    PK4(p0, 0, pa0); PK4(p0, 8, pa1); PK4(p1, 0, pa2); PK4(p1, 8, pa3);
}
__device__ __forceinline__ void psm_first(f32x16& p0, f32x16& p1, float bound, float& m_reg, f32x16& negm) {
    float pmax = fmaxf(p0[0], p1[0]);
#pragma unroll
    for (int r = 1; r < 16; ++r) pmax = fmaxf(pmax, fmaxf(p0[r], p1[r]));
    { auto rr = __builtin_amdgcn_permlane32_swap(__float_as_uint(pmax), __float_as_uint(pmax), false, false);
      pmax = fmaxf(__uint_as_float(rr[0]), __uint_as_float(rr[1])); }
    m_reg = fminf(bound, pmax + 64.f);
#pragma unroll
    for (int r = 0; r < 16; ++r) { p0[r] -= m_reg; p1[r] -= m_reg; negm[r] = -m_reg; }
#pragma unroll
    for (int r = 0; r < 16; ++r) p0[r] = __builtin_amdgcn_exp2f(p0[r]);
}
__device__ __forceinline__ void psm_fix(f32x16& p0) {
#pragma unroll
    for (int r = 0; r < 16; ++r) p0[r] = __builtin_amdgcn_exp2f(p0[r]);
}
template <bool FIRST, bool KEEPN>
__device__ __forceinline__ void psm_rel(f32x16& p0, f32x16& p1, float& m_reg, f32x16& negm, float& alpha) {
    float pmax = fmaxf(p0[0], p1[0]);
#pragma unroll
    for (int r = 1; r < 16; ++r) pmax = fmaxf(pmax, fmaxf(p0[r], p1[r]));
    { auto rr = __builtin_amdgcn_permlane32_swap(__float_as_uint(pmax), __float_as_uint(pmax), false, false);
      pmax = fmaxf(__uint_as_float(rr[0]), __uint_as_float(rr[1])); }
    alpha = 1.f;
    if (FIRST || !__builtin_expect(__all(pmax <= ATT_THR), 1)) {
        const float d = FIRST ? pmax : fmaxf(pmax, 0.f);
        if (!FIRST) alpha = __builtin_amdgcn_exp2f(-d);
        m_reg += d;
#pragma unroll
        for (int r = 0; r < 16; ++r) { p0[r] -= d; p1[r] -= d; if (KEEPN) negm[r] = -m_reg; }
    }
#pragma unroll
    for (int r = 0; r < 16; ++r) p0[r] = __builtin_amdgcn_exp2f(p0[r]);
}
__device__ __forceinline__ bf16x8 pack8(const f32x16& p, int base) {
    u32x4 w = {cvtpk(p[base], p[base + 1]), cvtpk(p[base + 2], p[base + 3]), cvtpk(p[base + 4], p[base + 5]), cvtpk(p[base + 6], p[base + 7])};
    return *reinterpret_cast<bf16x8*>(&w);
}
__device__ __forceinline__ void fsm_rel(f32x16& p0, f32x16& p1, bf16x8& pa0, bf16x8& pa1, bf16x8& pa2, bf16x8& pa3) {
#pragma unroll
    for (int r = 0; r < 16; ++r) p1[r] = __builtin_amdgcn_exp2f(p1[r]);
    pa0 = pack8(p0, 0); pa1 = pack8(p0, 8); pa2 = pack8(p1, 0); pa3 = pack8(p1, 8);
}
__device__ __forceinline__ int k_lds_off(int row, int blk, int chunk) { return blk * 4096 + row * 64 + ((chunk ^ ((row >> 2) & 3)) << 4); }
template <int ND0>
__device__ __forceinline__ void qkt(f32x16& p0, f32x16& p1, const char* Ks, const bf16x8* qr, int r32, int hi, const f32x16& cinit) {
    p0 = cinit; p1 = cinit;
#pragma unroll
    for (int d0 = 0; d0 < ND0; ++d0) {
        const int ch = (d0 & 1) * 2 + hi;
        bf16x8 b0 = *reinterpret_cast<const bf16x8*>(Ks + k_lds_off(r32, d0 >> 1, ch));
        bf16x8 b1 = *reinterpret_cast<const bf16x8*>(Ks + k_lds_off(32 + r32, d0 >> 1, ch));
        p0 = __builtin_amdgcn_mfma_f32_32x32x16_bf16(b0, qr[d0], p0, 0, 0, 0);
        p1 = __builtin_amdgcn_mfma_f32_32x32x16_bf16(b1, qr[d0], p1, 0, 0, 0);
    }
}
template <int NVB, bool SWAP = true> __device__ __forceinline__ int v_st(int k, int c) {
    const int kk = SWAP ? ((k & ~0xC) | ((k & 4) << 1) | ((k & 8) >> 1)) : k;
    return ((kk >> 3) * NVB + (c >> 5)) * 512 + ((kk & 7) * 32 + (c & 31)) * 2;
}
__device__ __forceinline__ int v_rd_base(int lane) { return ((lane & 3) << 3) | (((lane >> 2) & 3) << 6) | (((lane >> 4) & 1) << 5) | (((lane >> 5) & 1) << 8); }
template <int OFF> __device__ __forceinline__ s16x4 tr_read(int vb) {
    return __builtin_amdgcn_ds_read_tr16_b64_v4i16((LAS s16x4*)(unsigned)(vb + OFF));
}
#define PKV(L, H) (bf16x8){L[0], L[1], L[2], L[3], H[0], H[1], H[2], H[3]}
template <int D0, int NVB> __device__ __forceinline__ void pv_one(f32x16& od, int vb, bf16x8 pa0, bf16x8 pa1, bf16x8 pa2, bf16x8 pa3) {
    constexpr int KS = 2 * NVB * 512, HF = NVB * 512, B0 = D0 * 512;
    const s16x4 l0 = tr_read<B0 + 0 * KS>(vb), h0 = tr_read<B0 + 0 * KS + HF>(vb), l1 = tr_read<B0 + 1 * KS>(vb), h1 = tr_read<B0 + 1 * KS + HF>(vb);
    const s16x4 l2 = tr_read<B0 + 2 * KS>(vb), h2 = tr_read<B0 + 2 * KS + HF>(vb), l3 = tr_read<B0 + 3 * KS>(vb), h3 = tr_read<B0 + 3 * KS + HF>(vb);
    od = __builtin_amdgcn_mfma_f32_32x32x16_bf16(pa0, PKV(l0, h0), od, 0, 0, 0);
    od = __builtin_amdgcn_mfma_f32_32x32x16_bf16(pa1, PKV(l1, h1), od, 0, 0, 0);
    od = __builtin_amdgcn_mfma_f32_32x32x16_bf16(pa2, PKV(l2, h2), od, 0, 0, 0);
    od = __builtin_amdgcn_mfma_f32_32x32x16_bf16(pa3, PKV(l3, h3), od, 0, 0, 0);
}
template <int NVB> __device__ __forceinline__ void pv_all(f32x16* o, int vb, bf16x8 pa0, bf16x8 pa1, bf16x8 pa2, bf16x8 pa3) {
    pv_one<0, NVB>(o[0], vb, pa0, pa1, pa2, pa3); pv_one<1, NVB>(o[1], vb, pa0, pa1, pa2, pa3);
    if constexpr (NVB == 4) { pv_one<2, NVB>(o[2], vb, pa0, pa1, pa2, pa3); pv_one<3, NVB>(o[3], vb, pa0, pa1, pa2, pa3); }
}

template <int DK, int DV>
__device__ __forceinline__ void attn_item(const u16* __restrict__ Qb, const u16* __restrict__ Ka, const u16* __restrict__ Kb, const u16* __restrict__ Vh,
                                          int nkeys, u16* __restrict__ Ob, long ldo, char* lds, float kmax2) {
    using C = AttnCfg<DK, DV>;
    constexpr int NVB = C::NVB, ND0 = C::ND0, NKI = (DK / 32) * 4, NVI = DV / 8, NI = NKI + NVI;
    static_assert(NI <= 24, "three LDS-DMA pieces per wave per tile");
    const int tid = threadIdx.x, wid = __builtin_amdgcn_readfirstlane(tid >> 6), lane = tid & 63, r32 = lane & 31, hi = lane >> 5;
    char* K_lds = lds; char* V_lds = lds + 3 * C::KBYTES;
    float* al_l = (float*)(lds + 3 * C::KBYTES + 3 * C::VBYTES) + wid * 32;
    float m_reg = 0.f; f32x16 o[NVB], ol, negm; bf16x8 qr[ND0];
#pragma unroll
    for (int d = 0; d < NVB; ++d) o[d] = f32x16{};
    ol = f32x16{}; negm = f32x16{};
    const u32x4 ones_w = {0x3F803F80u, 0x3F803F80u, 0x3F803F80u, 0x3F803F80u}; const bf16x8 ones = *reinterpret_cast<const bf16x8*>(&ones_w);
    const u16* Qw = Qb + (long)(wid * 32 + r32) * DK + hi * 8;
#pragma unroll
    for (int d0 = 0; d0 < ND0; ++d0) qr[d0] = *reinterpret_cast<const bf16x8*>(Qw + d0 * 16);
    const u16* src[3]; int dst[3], stp[3]; bool isk[3];
#pragma unroll
    for (int i = 0; i < 3; ++i) { int q = wid + 8 * i; if (q >= NI) q -= 8;
        if (q < NKI) { const int blk = q >> 2, part = q & 3, row = 16 * part + (lane >> 2), c = (lane & 3) ^ ((row >> 2) & 3);
            isk[i] = true; dst[i] = blk * 4096 + part * 1024 + lane * 16;
            if (DK == 96 && blk == 2) { src[i] = Kb + row * 32 + c * 8; stp[i] = 64 * 32; } else { src[i] = Ka + row * 64 + blk * 32 + c * 8; stp[i] = 64 * 64; } }
        else { const int v = q - NKI; int key, col;
            if (NVB == 2) { key = 8 * v + ((lane & 31) >> 2); col = (lane >> 5) * 32 + (lane & 3) * 8; }
            else { key = 8 * (v >> 1) + ((lane & 31) >> 2); col = ((v & 1) * 2 + (lane >> 5)) * 32 + (lane & 3) * 8; }
            isk[i] = false; dst[i] = 3 * C::KBYTES + v * 1024 + lane * 16; src[i] = Vh + key * DV + col; stp[i] = 64 * DV; } }
    const int NT = nkeys / 64;
#define LOADG(kt, vt) do { const int _kt = (kt) < NT ? (kt) : NT - 1, _vt = (vt) < NT ? (vt) : NT - 1; const int _ks = _kt % 3, _vs = _vt % 3; \
        _Pragma("unroll") for (int _i = 0; _i < 3; ++_i) { const int _t = isk[_i] ? _kt : _vt; const int _so = isk[_i] ? _ks * C::KBYTES : _vs * C::VBYTES; \
            __builtin_amdgcn_global_load_lds((const unsigned*)(src[_i] + (long)_t * stp[_i]), (unsigned*)(lds + _so + dst[_i]), 16, 0, 0); } } while (0)
#define RESC(a) do { if (__any((a) < 1.f)) { if (hi == 0) al_l[r32] = (a); asm volatile("s_waitcnt lgkmcnt(0)" ::: "memory"); \
        _Pragma("unroll") for (int r = 0; r < 16; ++r) { const float _f = al_l[crow(r, hi)]; ol[r] *= _f; _Pragma("unroll") for (int d = 0; d < NVB; ++d) o[d][r] *= _f; } } } while (0)
#define PVL(vb) do { pv_all<NVB>(o, (vb), pa0, pa1, pa2, pa3); \
        ol = __builtin_amdgcn_mfma_f32_32x32x16_bf16(pa0, ones, ol, 0, 0, 0); ol = __builtin_amdgcn_mfma_f32_32x32x16_bf16(pa1, ones, ol, 0, 0, 0); \
        ol = __builtin_amdgcn_mfma_f32_32x32x16_bf16(pa2, ones, ol, 0, 0, 0); ol = __builtin_amdgcn_mfma_f32_32x32x16_bf16(pa3, ones, ol, 0, 0, 0); } while (0)
#define NEGM() do { if constexpr (DV == 128) { _Pragma("unroll") for (int r = 0; r < 16; ++r) negm[r] = -m_reg; } } while (0)
#define TILEBAR(n) do { if ((n) == 3) asm volatile("s_waitcnt vmcnt(3)" ::: "memory"); else asm volatile("s_waitcnt vmcnt(0)" ::: "memory"); __builtin_amdgcn_s_barrier(); asm volatile("" ::: "memory"); } while (0)
    const int vrb = (int)(uintptr_t)V_lds + v_rd_base(lane);
    f32x16 pA0, pA1, pB0, pB1; float alA, alB; bf16x8 pa0, pa1, pa2, pa3;
    __syncthreads();
    LOADG(0, 0); LOADG(1, 0);
    TILEBAR(3); LOADG(2, 1);
    float qs = 0.f;
#pragma unroll
    for (int d0 = 0; d0 < ND0; ++d0)
#pragma unroll
        for (int e = 0; e < 8; ++e) { const float f = bf2f((u16)qr[d0][e]); qs += f * f; }
    { auto rr = __builtin_amdgcn_permlane32_swap(__float_as_uint(qs), __float_as_uint(qs), false, false); qs = __uint_as_float(rr[0]) + __uint_as_float(rr[1]); }
    const float bound = sqrtf(qs * kmax2) * 1.01f + 1.f;
    qkt<ND0>(pA0, pA1, K_lds, qr, r32, hi, negm); psm_first(pA0, pA1, bound, m_reg, negm);
    int ks = 1, vs = 0;
    for (int j = 1; j + 1 < NT; j += 2) {
        TILEBAR(3);
        SBAR(); NEGM(); qkt<ND0>(pB0, pB1, K_lds + ks * C::KBYTES, qr, r32, hi, negm);
        fsm_rel(pA0, pA1, pa0, pa1, pa2, pa3);
        SBAR(); LOADG(j + 2, j + 1); SBAR();
        PVL(vrb + vs * C::VBYTES); psm_fix(pB0);
        ks = ks == 2 ? 0 : ks + 1; vs = vs == 2 ? 0 : vs + 1;
        TILEBAR(3);
        SBAR(); NEGM(); qkt<ND0>(pA0, pA1, K_lds + ks * C::KBYTES, qr, r32, hi, negm);
        fsm_rel(pB0, pB1, pa0, pa1, pa2, pa3);
        SBAR(); LOADG(j + 3, j + 2); SBAR();
        PVL(vrb + vs * C::VBYTES); psm_fix(pA0);
        ks = ks == 2 ? 0 : ks + 1; vs = vs == 2 ? 0 : vs + 1;
    }
    TILEBAR(3);
    SBAR(); NEGM(); qkt<ND0>(pB0, pB1, K_lds + ks * C::KBYTES, qr, r32, hi, negm);
    fsm_rel(pA0, pA1, pa0, pa1, pa2, pa3); SBAR();
    PVL(vrb + vs * C::VBYTES); psm_fix(pB0);
    vs = vs == 2 ? 0 : vs + 1;
    TILEBAR(0);
    fsm_rel(pB0, pB1, pa0, pa1, pa2, pa3); SBAR();
    PVL(vrb + vs * C::VBYTES);
    u16* Ow = Ob + (long)(wid * 32) * ldo;
#pragma unroll
    for (int r = 0; r < 16; ++r) { const int orow = crow(r, hi); const float rl = __builtin_amdgcn_rcpf(ol[r]);
#pragma unroll
        for (int d0 = 0; d0 < NVB; ++d0) Ow[(long)orow * ldo + d0 * 32 + r32] = f2bf(o[d0][r] * rl); }
#undef LOADG
#undef RESC
#undef PVL
#undef NEGM
#undef TILEBAR
}

struct Frame {
    const Params* p; unsigned char* ws; char* lds; float* out; int G, bx;
    __device__ __forceinline__ const float* in(int i) const { return p->in[i]; }
    template <class T> __device__ __forceinline__ T* W(size_t off) const { return (T*)(ws + off); }
};
constexpr int LDS_BYTES = 163840;
constexpr int LDS_BARW  = LDS_BYTES - 16;
constexpr int LDS_TAB   = 147456;

struct ResCtx { const char* src0; long srcd; char* dst0; long dstd; const float* mods;
    __device__ __forceinline__ const float* row_in(int row, int) const { return (const float*)(src0 + (row >= NCTX ? srcd : 0L) + (long)row * (DM * 4)); }
    __device__ __forceinline__ float* row_out(int row) const { return (float*)(dst0 + (row >= NCTX ? dstd : 0L) + (long)row * (DM * 4)); }
    __device__ __forceinline__ const float* mod(int li, int row, int which) const {
        const int mr = row < NCTX ? 4 : ((row - NCTX) >> 13); return mods + (size_t)(li * 5 + mr) * 6144 + which * 1024; }
};
__device__ __forceinline__ ResCtx res_ctx(const Frame& F, bool first = false) {
    const char* sc = (const char*)(first ? F.in(2) : (const float*)F.W<float>(WS_XC)); const char* sl = (const char*)(first ? F.in(0) : (const float*)F.out) - (long)NCTX * DM * 4;
    char* dc = (char*)F.W<float>(WS_XC); char* dl = (char*)F.out - (long)NCTX * DM * 4;
    return ResCtx{sc, (long)(sl - sc), dc, (long)(dl - dc), F.W<float>(WS_MODS)};
}
__device__ __forceinline__ const float* xrow_in(const Frame& F, int row, bool first) { return res_ctx(F, first).row_in(row, 0); }
__device__ __forceinline__ float* xrow_out(const Frame& F, int row) { return res_ctx(F).row_out(row); }
__device__ __forceinline__ const float* mod_vec(const Frame& F, int li, int row, int which) { return res_ctx(F).mod(li, row, which); }

struct EpiResid8 { ResCtx F; int li;
    __device__ __forceinline__ void operator()(const f32x4 (&acc)[2][2][4][2], const pg8::Unit& u, int wr, int wc, int fr, int fq) const {
#pragma unroll
        for (int ai = 0; ai < 2; ++ai)
#pragma unroll
            for (int m = 0; m < 4; ++m) { int frr = fr; asm volatile("" : "+v"(frr));
                const int row = u.pm * 256 + ai * 128 + wr * 64 + m * 16 + frr, c0 = u.pn * 256 + wc * 32 + 4 * fq;
                const float* xi = F.row_in(row, 0) + c0; float* xo = F.row_out(row) + c0; const float* gt = F.mod(li, row, 2) + c0;
#pragma unroll
                for (int bj = 0; bj < 2; ++bj)
#pragma unroll
                    for (int n = 0; n < 2; ++n) { const int c = bj * 128 + n * 16; const f32x4 x = *(const f32x4*)(xi + c), g = *(const f32x4*)(gt + c), a = acc[ai][bj][m][n];
                        f32x4 o = {x[0] + g[0] * a[0], x[1] + g[1] * a[1], x[2] + g[2] * a[2], x[3] + g[3] * a[3]}; *(f32x4*)(xo + c) = o; } }
    } };

__device__ __forceinline__ void p0_mods(const Frame& F) {
    float* s = (float*)F.lds; float* red = s + 5 * 1024;
    const int tid = threadIdx.x, lane = tid & 63, wid = tid >> 6;
    for (int i = tid; i < 5 * 1024; i += NTHR) { const int r = i >> 10, k = i & 1023; const float v = r < 4 ? F.in(1)[r * 1024 + k] : F.in(3)[k]; s[i] = silu_f(v); }
    __syncthreads();
    for (int item = F.bx; item < DEPTH * 96; item += F.G) {
        const int li = item / 96, cg = item % 96;
        const float* w = F.in(4) + (size_t)li * 1024 * 6144 + cg * 64 + lane;
        float a0 = 0, a1 = 0, a2 = 0, a3 = 0, a4 = 0;
        const int k0 = wid * 128;
#pragma unroll 8
        for (int k = k0; k < k0 + 128; ++k) {
            const float wv = w[(size_t)k * 6144];
            a0 += s[k] * wv; a1 += s[1024 + k] * wv; a2 += s[2048 + k] * wv; a3 += s[3072 + k] * wv; a4 += s[4096 + k] * wv;
        }
        red[(wid * 5 + 0) * 64 + lane] = a0; red[(wid * 5 + 1) * 64 + lane] = a1; red[(wid * 5 + 2) * 64 + lane] = a2;
        red[(wid * 5 + 3) * 64 + lane] = a3; red[(wid * 5 + 4) * 64 + lane] = a4;
        __syncthreads();
        if (tid < 320) { const int r = tid >> 6, l = tid & 63; float sum = 0;
#pragma unroll
            for (int ww = 0; ww < 8; ++ww) sum += red[(ww * 5 + r) * 64 + l];
            F.W<float>(WS_MODS)[(size_t)(li * 5 + r) * 6144 + cg * 64 + l] = sum + F.in(5)[li * 6144 + cg * 64 + l]; }
        __syncthreads();
    }
}
__device__ __forceinline__ void p0_rope(const Frame& F) {
    const int gt = F.bx * NTHR + threadIdx.x, gn = F.G * NTHR;
    float* ca = F.W<float>(WS_ROPEA); float* sa = ca + SEQ * 16; float* cb = F.W<float>(WS_ROPEB); float* sb = cb + SEQ * 32;
    for (int i = gt; i < SEQ * 48; i += gn) {
        int n, f, nf; float* co; float* so; int idx;
        if (i < SEQ * 16) { n = i >> 4; f = i & 15; nf = 8; co = ca; so = sa; idx = i; }
        else { const int j = i - SEQ * 16; n = j >> 5; f = j & 31; nf = 16; co = cb; so = sb; idx = j; }
        const int fi = f % nf; const float pos = (f < nf) ? (float)(n >> 6) : (float)(n & 63);
        const float invf = exp2f(-(float)fi / (float)nf * 13.287712379549449f);
        const float ang = pos * invf;
        float rev = ang * 0.15915494309189535f; rev -= floorf(rev);
        co[idx] = __builtin_amdgcn_cosf(rev); so[idx] = __builtin_amdgcn_sinf(rev);
    }
}
__device__ __forceinline__ int rowmap(int n, int kind) {
    if (kind == 0) return n;
    if (kind == 3) { if (n >= 2048) return n; const int hh = n >> 6, dim = n & 63; return (hh >> 2) * 256 + (dim >> 5) * 128 + (hh & 3) * 32 + (dim & 31); }
    return (n >> 7) * 256 + (kind == 2 ? 128 : 0) + (n & 127);
}
__device__ __forceinline__ void cvt_group(float* tl, const float* src, int K, int N, u16* dst, int ldd, int kind, int t0, const float* kscale = nullptr) {
    int tid = threadIdx.x; asm volatile("" : "+v"(tid));
    const int tn = (N + 63) / 64, nt = (K / 64) * tn;
    f32x4 v[4][2];
#pragma unroll
    for (int u = 0; u < 4; ++u) { const int t = t0 + u; const int k0 = (t / tn) * 64, n0 = (t % tn) * 64;
#pragma unroll
        for (int ps = 0; ps < 2; ++ps) { const int k = (tid >> 4) + ps * 32, n4 = (tid & 15) * 4;
            if (t < nt && n0 + n4 < N) v[u][ps] = *(const f32x4*)(src + (size_t)(k0 + k) * N + n0 + n4); else v[u][ps] = f32x4{0.f, 0.f, 0.f, 0.f}; } }
#pragma unroll
    for (int u = 0; u < 4; ++u)
#pragma unroll
        for (int ps = 0; ps < 2; ++ps) { const int k = (tid >> 4) + ps * 32, n4 = (tid & 15) * 4; float* d = tl + u * 4160 + k * 65 + n4;
            const int t = t0 + u; const float sc = (kscale && t < nt) ? kscale[(t / tn) * 64 + k] : 1.f;
            d[0] = v[u][ps][0] * sc; d[1] = v[u][ps][1] * sc; d[2] = v[u][ps][2] * sc; d[3] = v[u][ps][3] * sc; }
    __syncthreads();
#pragma unroll
    for (int u = 0; u < 4; ++u) { const int t = t0 + u; const int k0 = (t / tn) * 64, n0 = (t % tn) * 64;
        const int n = tid >> 3, kc = (tid & 7) * 8; const float* sr = tl + u * 4160;
        if (t < nt && n0 + n < N) { u32x4 w;
#pragma unroll
            for (int i = 0; i < 4; ++i) w[i] = cvtpk(sr[(kc + 2 * i) * 65 + n], sr[(kc + 2 * i + 1) * 65 + n]);
            *(u32x4*)(dst + (size_t)rowmap(n0 + n, kind) * ldd + k0 + kc) = w; } }
    __syncthreads();
}
__device__ __forceinline__ void cvt_t(const Frame& F, const float* src, int K, int N, u16* dst, int ldd, int kind, int rot, const float* kscale = nullptr) {
    const int tn = (N + 63) / 64, nt = (K / 64) * tn;
    for (int t0 = ((F.bx + rot) % F.G) * 4; t0 < nt; t0 += F.G * 4) cvt_group((float*)F.lds, src, K, N, dst, ldd, kind, t0, kscale);
}
constexpr int MOE_CVT_GROUPS = 16 * 3 * 32, LDS_CVT = 81920;
__device__ __forceinline__ void moe_cvt_group(const Frame& F, int li, int gidx) {
    if (gidx >= MOE_CVT_GROUPS) return;
    const int mat = gidx >> 5, g = gidx & 31, e = mat / 3, kind = mat - e * 3; float* tl = (float*)(F.lds + LDS_CVT);
    if (kind == 0) cvt_group(tl, F.in(27) + (size_t)(li * 16 + e) * 1024 * 512, 1024, 512, F.W<u16>(WS_MOEW) + (size_t)e * 1024 * 1024, 1024, 1, g * 4);
    else if (kind == 1) cvt_group(tl, F.in(28) + (size_t)(li * 16 + e) * 1024 * 512, 1024, 512, F.W<u16>(WS_MOEW) + (size_t)e * 1024 * 1024, 1024, 2, g * 4);
    else cvt_group(tl, F.in(29) + (size_t)(li * 16 + e) * 512 * 1024, 512, 1024, F.W<u16>(WS_MOEW + MOE_WGU_BYTES) + (size_t)e * 1024 * 512, 512, 0, g * 4);
}
__device__ __forceinline__ void p0_weights(const Frame& F) {
    int rot = 0;
    for (int j = 0; j < 2; ++j) {
        cvt_t(F, F.in(8) + (size_t)j * 1024 * 544, 1024, 544, F.W<u16>(WS_WDQKV) + (size_t)j * 640 * 1024, 1024, 0, rot); rot += 36;
        cvt_t(F, F.in(10) + (size_t)j * 256 * 1536, 256, 1536, F.W<u16>(WS_WUQ) + (size_t)j * 1536 * 256, 256, 0, rot, F.in(9) + j * 256); rot += 24;
        cvt_t(F, F.in(12) + (size_t)j * 256 * 2048, 256, 2048, F.W<u16>(WS_WUKV) + (size_t)j * 2048 * 256, 256, 0, rot, F.in(11) + j * 256); rot += 32;
        cvt_t(F, F.in(13) + (size_t)j * 1024 * 1024, 1024, 1024, F.W<u16>(WS_WOM) + (size_t)j * 1024 * 1024, 1024, 0, rot);
    }
    cvt_t(F, F.in(14), 1024, 3072, F.W<u16>(WS_WQKVD), 1024, 3, rot);
    cvt_t(F, F.in(17), 1024, 1024, F.W<u16>(WS_WOD), 1024, 0, rot);
    cvt_t(F, F.in(18), 1024, 3104, F.W<u16>(WS_WING), 1024, 0, rot); rot += 4;
    cvt_t(F, F.in(22), 1024, 1024, F.W<u16>(WS_WOG), 1024, 0, rot);
}
__device__ __forceinline__ void moe_weights(const Frame& F, int li) {
    for (int g = F.bx; g < MOE_CVT_GROUPS; g += F.G) moe_cvt_group(F, li, g);
}

#define DPP_ADD(v, CTRL) (v) += __uint_as_float(__builtin_amdgcn_update_dpp(0u, __float_as_uint(v), (CTRL), 0xF, 0xF, false))
__device__ __forceinline__ float wave_sum_fast(float v) {
    DPP_ADD(v, 0xB1); DPP_ADD(v, 0x4E); DPP_ADD(v, 0x141); DPP_ADD(v, 0x140);
    { auto rr = __builtin_amdgcn_permlane16_swap(__float_as_uint(v), __float_as_uint(v), false, false); v = __uint_as_float(rr[0]) + __uint_as_float(rr[1]); }
    { auto rr = __builtin_amdgcn_permlane32_swap(__float_as_uint(v), __float_as_uint(v), false, false); v = __uint_as_float(rr[0]) + __uint_as_float(rr[1]); }
    return v;
}
constexpr int RT_WG = 0, RT_WR = 16384, RT_REC = 81920, RT_CNT = 81920 + 4096, RT_BASE = RT_CNT + 128;
template <bool ROUTE>
__device__ __forceinline__ void norm_phase(const Frame& F, int li, int row_begin, bool first) {
    const int tid = threadIdx.x, lane = tid & 63, wid = tid >> 6;
    const float* gain = F.in(ROUTE ? 7 : 6) + li * DM;
    u16* H = F.W<u16>(WS_H);
    const int per_block = (NTOK - row_begin + F.G - 1) / F.G;
    const int blk0 = row_begin + F.bx * per_block; int blk1 = blk0 + per_block; if (blk1 > NTOK) blk1 = NTOK;
    f32x4* wgL = (f32x4*)(F.lds + RT_WG); f32x4* wrL = (f32x4*)(F.lds + RT_WR); u32x4* recL = (u32x4*)(F.lds + RT_REC);
    unsigned* cntL = (unsigned*)(F.lds + RT_CNT); unsigned* baseL = (unsigned*)(F.lds + RT_BASE);
    if constexpr (ROUTE) {
        __syncthreads();
        const f32x4* wg = (const f32x4*)(F.in(23) + (size_t)li * DM * 4); const f32x4* wr = (const f32x4*)(F.in(25) + (size_t)li * 4 * DM * 4);
        for (int e = tid; e < 1024; e += NTHR) { const int d = ((e >> 8) * 4 + (e & 3)) * 64 + ((e >> 2) & 63); wgL[d] = wg[e]; }
        for (int e = tid; e < 4096; e += NTHR) { const int g = e >> 10, c = e & 1023; const int d = g * 1024 + ((c >> 8) * 4 + (c & 3)) * 64 + ((c >> 2) & 63); wrL[d] = wr[e]; }
        if (tid < 32) cntL[tid] = 0u;
        __syncthreads();
    }
    f32x4 vn[4][4];
#define NLOAD(IT) do { _Pragma("unroll") for (int u = 0; u < 4; ++u) { int _r = blk0 + wid + 8 * (4 * (IT) + u); if (_r >= blk1) _r = blk0; const float* xr = xrow_in(F, _r, first); \
        _Pragma("unroll") for (int i = 0; i < 4; ++i) vn[u][i] = *(const f32x4*)(xr + i * 256 + lane * 4); } } while (0)
    NLOAD(0);
    for (int it = 0; it * 32 < per_block; ++it) {
        int rows[4]; bool ok[4]; f32x4 v[4][4];
#pragma unroll
        for (int u = 0; u < 4; ++u) { rows[u] = blk0 + wid + 8 * (4 * it + u); ok[u] = rows[u] < blk1; if (!ok[u]) rows[u] = blk0; }
#pragma unroll
        for (int u = 0; u < 4; ++u)
#pragma unroll
            for (int i = 0; i < 4; ++i) v[u][i] = vn[u][i];
        if ((it + 1) * 32 < per_block) NLOAD(it + 1);
#pragma unroll
        for (int u = 0; u < 4; ++u) {
            const int row = rows[u];
            float ss = 0;
#pragma unroll
            for (int i = 0; i < 4; ++i) ss += v[u][i][0] * v[u][i][0] + v[u][i][1] * v[u][i][1] + v[u][i][2] * v[u][i][2] + v[u][i][3] * v[u][i][3];
            ss = wave_sum_fast(ss);
            const float rinv = rsqrtf(ss * (1.f / DM) + EPS);
            const float* sh = mod_vec(F, li, row, ROUTE ? 3 : 0); const float* sc = mod_vec(F, li, row, ROUTE ? 4 : 1);
            float hv[16];
#pragma unroll
            for (int i = 0; i < 4; ++i) { const int c = i * 256 + lane * 4;
                const f32x4 g = *(const f32x4*)(gain + c), s1 = *(const f32x4*)(sc + c), s0 = *(const f32x4*)(sh + c);
#pragma unroll
                for (int j = 0; j < 4; ++j) hv[i * 4 + j] = (v[u][i][j] * rinv * g[j]) * (1.f + s1[j]) + s0[j];
                if (ok[u]) { u32x2 w = {cvtpk(hv[i * 4], hv[i * 4 + 1]), cvtpk(hv[i * 4 + 2], hv[i * 4 + 3])}; *(u32x2*)(H + (size_t)row * DM + c) = w; } }
            if constexpr (ROUTE) {
                float gl[4] = {0, 0, 0, 0};
#pragma unroll
                for (int q = 0; q < 16; ++q) { const f32x4 w4 = wgL[q * 64 + lane]; const float h = hv[q];
                    gl[0] += h * w4[0]; gl[1] += h * w4[1]; gl[2] += h * w4[2]; gl[3] += h * w4[3]; }
#pragma unroll
                for (int g = 0; g < 4; ++g) gl[g] = wave_sum_fast(gl[g]) + F.in(24)[li * 4 + g];
                int gi = 0; float gm = gl[0];
#pragma unroll
                for (int g = 1; g < 4; ++g) if (gl[g] > gm) { gm = gl[g]; gi = g; }
                gi = __builtin_amdgcn_readfirstlane(gi);
                float den = 0;
#pragma unroll
                for (int g = 0; g < 4; ++g) den += __expf(gl[g] - gm);
                const float grp_w = 1.f / den;
                float el[4] = {0, 0, 0, 0};
                const f32x4* wrg = wrL + gi * 1024;
#pragma unroll
                for (int q = 0; q < 16; ++q) { const f32x4 w4 = wrg[q * 64 + lane]; const float h = hv[q];
                    el[0] += h * w4[0]; el[1] += h * w4[1]; el[2] += h * w4[2]; el[3] += h * w4[3]; }
#pragma unroll
                for (int e = 0; e < 4; ++e) el[e] = wave_sum_fast(el[e]) + F.in(26)[(li * 4 + gi) * 4 + e];
                int i1 = 0; float v1 = el[0];
#pragma unroll
                for (int e = 1; e < 4; ++e) if (el[e] > v1) { v1 = el[e]; i1 = e; }
                int i2 = -1; float v2 = -3.0e38f;
#pragma unroll
                for (int e = 0; e < 4; ++e) if (e != i1 && el[e] > v2) { v2 = el[e]; i2 = e; }
                const float t = __expf(v2 - v1); const float w1 = grp_w / (1.f + t), w2 = grp_w * t / (1.f + t);
                const int elo = i1 < i2 ? i1 : i2, ehi = i1 < i2 ? i2 : i1;
                const float wlo = i1 < i2 ? w1 : w2, whi = i1 < i2 ? w2 : w1;
                const int pr = elo == 0 ? ehi - 1 : (elo == 1 ? ehi + 1 : 5);
                const int cls = gi * 6 + pr;
                if (lane == 0 && ok[u]) {
                    const unsigned rank = atomicAdd(&cntL[cls], 1u);
                    u32x4 rec = {(unsigned)cls, rank, __float_as_uint(wlo), __float_as_uint(whi)};
                    recL[row - blk0] = rec;
                }
            }
        }
    }
#undef NLOAD
    if constexpr (ROUTE) {
        __syncthreads();
        if (tid < 24) baseL[tid] = atomicAdd(F.W<unsigned>(WS_CTL) + CW_CNT + li * 32 + tid, cntL[tid]);
        __syncthreads();
        for (int t = tid; t < blk1 - blk0; t += NTHR) { u32x4 rec = recL[t]; rec[1] += baseL[rec[0]];
            *(u32x4*)(F.W<unsigned char>(WS_TOK) + (size_t)(blk0 + t) * 16) = rec; }
    }
}

__device__ __forceinline__ void moe_table(const Frame& F, int li, int* tab) {
    if (threadIdx.x == 0) {
        const unsigned* cnt = F.W<unsigned>(WS_CTL) + CW_CNT + li * 32; int off = 0;
        for (int c = 0; c < 24; ++c) { tab[c] = off; const int n = (int)cnt[c]; const int nt = (n + 255) >> 8;
            for (int t = 0; t < nt; ++t) tab[32 + (off >> 8) + t] = c; off += nt << 8; }
        tab[24] = off;
    }
    __syncthreads();
}
__device__ __forceinline__ void moe_scatter(const Frame& F, int li, int row_begin) {
    int* tab = (int*)(F.lds + LDS_TAB);
    moe_table(F, li, tab);
    const unsigned* cnt = F.W<unsigned>(WS_CTL) + CW_CNT + li * 32;
    int* rowtok = F.W<int>(WS_ROWTOK); float* roww = F.W<float>(WS_ROWW);
    const int gt = F.bx * NTHR + threadIdx.x, gn = F.G * NTHR;
    for (int t = row_begin + gt; t < NTOK; t += gn) {
        const u32x4 rec = *(const u32x4*)(F.W<unsigned char>(WS_TOK) + (size_t)t * 16);
        const int r = tab[rec[0]] + (int)rec[1];
        rowtok[r] = t; roww[2 * r] = __uint_as_float(rec[2]); roww[2 * r + 1] = __uint_as_float(rec[3]);
    }
    for (int i = gt; i < 24 * 256; i += gn) { const int c = i >> 8, j = i & 255; const int r = tab[c] + (int)cnt[c] + j;
        const int end = tab[c] + ((((int)cnt[c]) + 255) & ~255);
        if (r < end) { rowtok[r] = -1; roww[2 * r] = 0.f; roww[2 * r + 1] = 0.f; } }
    __syncthreads();
}

#define EPI_ID const int r32 = lane & 31, hi = lane >> 5
__device__ __forceinline__ u32x2 pack4(float a, float b, float c, float d) { u32x2 w = {cvtpk(a, b), cvtpk(c, d)}; return w; }
struct EpiF32 { float* dst; int ld, ncols;
    __device__ __forceinline__ int operator()(f32x16 (&acc)[2][2], int row0, int col0, int lane) const { EPI_ID;
#pragma unroll
        for (int mi = 0; mi < 2; ++mi) { float* o = dst + (size_t)(row0 + mi * 32 + r32) * ld + col0 + 4 * hi;
#pragma unroll
            for (int ni = 0; ni < 2; ++ni) if (col0 + ni * 32 < ncols) {
#pragma unroll
                for (int g = 0; g < 4; ++g) { f32x4 v = {acc[mi][ni][4 * g], acc[mi][ni][4 * g + 1], acc[mi][ni][4 * g + 2], acc[mi][ni][4 * g + 3]}; *(f32x4*)(o + ni * 32 + 8 * g) = v; } } }
        return 0;
    } };
struct EpiMlaDown { u16* CN; float* SS; u16* KPE; unsigned* pemax;
    __device__ __forceinline__ int operator()(f32x16 (&acc)[2][2], int row0, int col0, int lane) const { EPI_ID;
        if (col0 < 512) {
#pragma unroll
            for (int mi = 0; mi < 2; ++mi) { const size_t row = row0 + mi * 32 + r32; u16* o = CN + row * 512 + col0 + 4 * hi; float ss = 0.f;
#pragma unroll
                for (int ni = 0; ni < 2; ++ni)
#pragma unroll
                    for (int g = 0; g < 4; ++g) { const float a = acc[mi][ni][4 * g], b = acc[mi][ni][4 * g + 1], c = acc[mi][ni][4 * g + 2], d = acc[mi][ni][4 * g + 3];
                        ss += a * a + b * b + c * c + d * d; *(u32x2*)(o + ni * 32 + 8 * g) = pack4(a, b, c, d); }
                { auto rr = __builtin_amdgcn_permlane32_swap(__float_as_uint(ss), __float_as_uint(ss), false, false); ss = __uint_as_float(rr[0]) + __uint_as_float(rr[1]); }
                if (hi == 0) SS[row * 8 + (col0 >> 6)] = ss; }
        } else if (col0 == 512) {
            const bool lat = row0 >= NCTX; float pmx = 0.f;
#pragma unroll
            for (int mi = 0; mi < 2; ++mi) { const int row = row0 + mi * 32 + r32; int b, pos; row_bp(row, b, pos); const int n = (row - NCTX) & (SEQ - 1);
                u16* o = KPE + ((size_t)b * KEYS + pos) * 32 + 4 * hi; float s2 = 0.f;
#pragma unroll
                for (int g = 0; g < 2; ++g) { float o1[4], o2[4];
#pragma unroll
                    for (int j = 0; j < 4; ++j) { const float t1 = acc[mi][0][4 * g + j], t2 = acc[mi][0][4 * (g + 2) + j]; float cs = 1.f, sn = 0.f; if (lat) rope_cs<8>(n, 8 * g + 4 * hi + j, cs, sn);
                        o1[j] = t1 * cs - t2 * sn; o2[j] = t1 * sn + t2 * cs; s2 += t1 * t1 + t2 * t2; }
                    *(u32x2*)(o + 8 * g) = pack4(o1[0], o1[1], o1[2], o1[3]); *(u32x2*)(o + 16 + 8 * g) = pack4(o2[0], o2[1], o2[2], o2[3]); }
                { auto rr = __builtin_amdgcn_permlane32_swap(__float_as_uint(s2), __float_as_uint(s2), false, false); s2 = __uint_as_float(rr[0]) + __uint_as_float(rr[1]); }
                pmx = fmaxf(pmx, s2); }
            const float v = wave_max_fast(pmx); const int bb = row0 < NCTX ? row0 >> 8 : (row0 - NCTX) >> 13;
            if (lane == 0) atomic_fmax_pos(pemax + bb, v);
        }
        return 0;
    } };
struct EpiMlaQ { u16* Q; const float* cosA; const float* sinA; float scale;
    __device__ __forceinline__ int operator()(f32x16 (&acc)[2][2], int row0, int col0, int lane) const { EPI_ID; const bool lat = row0 >= NCTX;
#pragma unroll
        for (int mi = 0; mi < 2; ++mi) { const int row = row0 + mi * 32 + r32; int b, pos; row_bp(row, b, pos); const int n = (row - NCTX) & (SEQ - 1);
            u16* qrow = Q + ((size_t)(b * 16) * KEYS + pos) * 96 + 4 * hi;
#pragma unroll
            for (int ni = 0; ni < 2; ++ni) { const int s = (col0 >> 5) + ni, head = s / 3, part = s - head * 3; u16* o = qrow + (size_t)head * KEYS * 96 + part * 32;
                float v[16];
#pragma unroll
                for (int r = 0; r < 16; ++r) v[r] = acc[mi][ni][r] * scale;
                if (part == 2 && lat) {
#pragma unroll
                    for (int g = 0; g < 2; ++g) {
#pragma unroll
                        for (int j = 0; j < 4; ++j) { float cs, sn; rope_cs<8>(n, 8 * g + 4 * hi + j, cs, sn);
                            const float t1 = v[4 * g + j], t2 = v[4 * (g + 2) + j]; v[4 * g + j] = t1 * cs - t2 * sn; v[4 * (g + 2) + j] = t1 * sn + t2 * cs; } } }
#pragma unroll
                for (int g = 0; g < 4; ++g) *(u32x2*)(o + 8 * g) = pack4(v[4 * g], v[4 * g + 1], v[4 * g + 2], v[4 * g + 3]); } }
        return 16;
    } };
struct EpiMlaKV { u16* Kn; long vdelta;
    __device__ __forceinline__ int operator()(f32x16 (&acc)[2][2], int row0, int col0, int lane) const { EPI_ID; const int head = col0 >> 7; u16* dst = Kn + (long)((col0 >> 6) & 1) * vdelta;
#pragma unroll
        for (int mi = 0; mi < 2; ++mi) { const int row = row0 + mi * 32 + r32; int b, pos; row_bp(row, b, pos);
            u16* o = dst + ((size_t)(b * 16 + head) * KEYS + pos) * 64 + 4 * hi;
#pragma unroll
            for (int ni = 0; ni < 2; ++ni)
#pragma unroll
                for (int g = 0; g < 4; ++g) *(u32x2*)(o + ni * 32 + 8 * g) = pack4(acc[mi][ni][4 * g], acc[mi][ni][4 * g + 1], acc[mi][ni][4 * g + 2], acc[mi][ni][4 * g + 3]); }
        return 16;
    } };
struct EpiResid { ResCtx F; int li, which, first;
    __device__ __forceinline__ int operator()(f32x16 (&acc)[2][2], int row0, int col0, int lane) const { EPI_ID;
#pragma unroll
        for (int mi = 0; mi < 2; ++mi) { const int row = row0 + mi * 32 + r32;
            const float* xi = F.row_in(row, first) + col0 + 4 * hi; float* xo = F.row_out(row) + col0 + 4 * hi; const float* gt = F.mod(li, row, which) + col0 + 4 * hi;
#pragma unroll
            for (int ni = 0; ni < 2; ++ni)
#pragma unroll
                for (int g = 0; g < 4; ++g) { const int c = ni * 32 + 8 * g; const f32x4 x = *(const f32x4*)(xi + c), gg = *(const f32x4*)(gt + c);
                    f32x4 o = {x[0] + gg[0] * acc[mi][ni][4 * g], x[1] + gg[1] * acc[mi][ni][4 * g + 1], x[2] + gg[2] * acc[mi][ni][4 * g + 2], x[3] + gg[3] * acc[mi][ni][4 * g + 3]};
                    *(f32x4*)(xo + c) = o; } }
        return 48;
    } };
struct EpiMoeB { ResCtx F; int li; const int* rowtok;
    __device__ __forceinline__ int operator()(f32x16 (&acc)[2][2], int row0, int col0, int lane) const { EPI_ID;
#pragma unroll
        for (int mi = 0; mi < 2; ++mi) { const int tok = rowtok[row0 + mi * 32 + r32];
            if (tok >= 0) { float* xo = F.row_out(tok) + col0 + 4 * hi; const float* gt = F.mod(li, tok, 5) + col0 + 4 * hi;
#pragma unroll
                for (int ni = 0; ni < 2; ++ni)
#pragma unroll
                    for (int g = 0; g < 4; ++g) { const int c = ni * 32 + 8 * g; const f32x4 x = *(const f32x4*)(xo + c), gg = *(const f32x4*)(gt + c);
                        f32x4 o = {x[0] + gg[0] * acc[mi][ni][4 * g], x[1] + gg[1] * acc[mi][ni][4 * g + 1], x[2] + gg[2] * acc[mi][ni][4 * g + 2], x[3] + gg[3] * acc[mi][ni][4 * g + 3]};
                        *(f32x4*)(xo + c) = o; } } }
        return 0;
    } };
struct EpiMoeA { u16* act; const float* roww; int half, acol0;
    __device__ __forceinline__ int operator()(f32x16 (&acc)[2][2], int row0, int col0, int lane) const { EPI_ID;
#pragma unroll
        for (int mi = 0; mi < 2; ++mi) { const int row = row0 + mi * 32 + r32; const float w = roww[2 * row + half];
            u16* o = act + (size_t)row * 1024 + acol0 + (col0 >> 6) * 32 + 4 * hi;
#pragma unroll
            for (int g = 0; g < 4; ++g) { float v[4];
#pragma unroll
                for (int j = 0; j < 4; ++j) v[j] = silu_f(acc[mi][0][4 * g + j]) * acc[mi][1][4 * g + j] * w;
                *(u32x2*)(o + 8 * g) = pack4(v[0], v[1], v[2], v[3]); } }
        return 8;
    } };
struct EpiDiffQKV { u16* Q; long kdelta; u16* V; const float* cosB; const float* sinB; float qscale;
    __device__ __forceinline__ int operator()(f32x16 (&acc)[2][2], int row0, int col0, int lane) const { EPI_ID; const int region = col0 >> 10; const bool lat = row0 >= NCTX;
#pragma unroll
        for (int mi = 0; mi < 2; ++mi) { const int row = row0 + mi * 32 + r32; int b, pos; row_bp(row, b, pos); const int n = (row - NCTX) & (SEQ - 1);
            if (region < 2) {
                const int hh = (col0 & 1023) >> 6; const float sc = region == 0 ? qscale : 1.f;
                u16* o = Q + (long)region * kdelta + ((size_t)(b * 16 + hh) * KEYS + pos) * 64 + 4 * hi;
#pragma unroll
                for (int g = 0; g < 4; ++g) {
                    float o1[4], o2[4];
#pragma unroll
                    for (int j = 0; j < 4; ++j) { float cs = 1.f, sn = 0.f; if (lat) rope_cs<16>(n, 8 * g + 4 * hi + j, cs, sn);
                        const float t1 = acc[mi][0][4 * g + j], t2 = acc[mi][1][4 * g + j]; o1[j] = (t1 * cs - t2 * sn) * sc; o2[j] = (t1 * sn + t2 * cs) * sc; }
                    *(u32x2*)(o + 8 * g) = pack4(o1[0], o1[1], o1[2], o1[3]); *(u32x2*)(o + 32 + 8 * g) = pack4(o2[0], o2[1], o2[2], o2[3]); }
            } else {
                const int cv = col0 - 2048, head = cv >> 7;
                u16* o = V + ((size_t)(b * 8 + head) * KEYS + pos) * 128 + (cv & 127) + 4 * hi;
#pragma unroll
                for (int ni = 0; ni < 2; ++ni)
#pragma unroll
                    for (int g = 0; g < 4; ++g) *(u32x2*)(o + ni * 32 + 8 * g) = pack4(acc[mi][ni][4 * g], acc[mi][ni][4 * g + 1], acc[mi][ni][4 * g + 2], acc[mi][ni][4 * g + 3]);
            } }
        return 16;
    } };
struct EpiGlaIn { u16* q; u16* k; u16* v; u16* g; float* z;
    __device__ __forceinline__ int operator()(f32x16 (&acc)[2][2], int row0, int col0, int lane) const { EPI_ID;
#pragma unroll
        for (int mi = 0; mi < 2; ++mi) { const size_t row = row0 + mi * 32 + r32;
            if (col0 < 3072) {
                u16* o; float sc = 1.f;
                if (col0 < 512) { o = q + row * 512 + col0; sc = 0.08838834764831845f; } else if (col0 < 1024) o = k + row * 512 + (col0 - 512);
                else if (col0 < 2048) o = v + row * 1024 + (col0 - 1024); else o = g + row * 1024 + (col0 - 2048);
                o += 4 * hi;
#pragma unroll
                for (int ni = 0; ni < 2; ++ni)
#pragma unroll
                    for (int gg = 0; gg < 4; ++gg) *(u32x2*)(o + ni * 32 + 8 * gg) = pack4(acc[mi][ni][4 * gg] * sc, acc[mi][ni][4 * gg + 1] * sc, acc[mi][ni][4 * gg + 2] * sc, acc[mi][ni][4 * gg + 3] * sc);
            } else if (col0 == 3072) {
                float* o = z + row * 32 + 4 * hi;
#pragma unroll
                for (int gg = 0; gg < 4; ++gg) { f32x4 t = {acc[mi][0][4 * gg], acc[mi][0][4 * gg + 1], acc[mi][0][4 * gg + 2], acc[mi][0][4 * gg + 3]}; *(f32x4*)(o + 8 * gg) = t; }
            } }
        return col0 < 3072 ? 16 : (col0 == 3072 ? 8 : 0);
    } };

template <int WM, int WN, class AL, class BL, class EP>
__device__ __forceinline__ void gemm_phase(const Frame& F, const AL al, const BL bl, EP& ep, int mt0, int mt1, int nN, int nk, int tile_off, int tile_total) {
    PlainTiles<AL, BL, EP> prov{al, bl, ep, mt0, mt1 - mt0, nN, F.bx, F.G}; (void)tile_off;
    gemm_stream<WM, WN>(F.lds, prov, nk);
    (void)tile_total;
}

__device__ __forceinline__ void mla_rowpass(const Frame& F, int j, int li) {
    const int lane = threadIdx.x & 63, wid = threadIdx.x >> 6;
    const float* DQ = F.W<float>(MLA_DQ); u16* CN = F.W<u16>(MLA_CN); u16* KPE = F.W<u16>(MLA_KPE);
    const float* gq = F.in(9) + j * 256; const float* gk = F.in(11) + j * 256;
    const float* ca = F.W<float>(WS_ROPEA); const float* sa = ca + SEQ * 16;
    float pem0 = 0.f, pem1 = 0.f, pem2 = 0.f, pem3 = 0.f;
    for (int row = F.bx * NWAVE + wid; row < NTOK; row += F.G * NWAVE) {
        const float* d = DQ + (size_t)row * 544;
        const f32x4 a = *(const f32x4*)(d + lane * 4), c = *(const f32x4*)(d + 256 + lane * 4);
        float sq = a[0] * a[0] + a[1] * a[1] + a[2] * a[2] + a[3] * a[3], sk = c[0] * c[0] + c[1] * c[1] + c[2] * c[2] + c[3] * c[3];
        sq = wave_sum(sq); sk = wave_sum(sk);
        const float rq = rsqrtf(sq * (1.f / 256.f) + EPS), rk = rsqrtf(sk * (1.f / 256.f) + EPS);
        const f32x4 g1 = *(const f32x4*)(gq + lane * 4), g2 = *(const f32x4*)(gk + lane * 4);
        u32x2 w1 = {cvtpk(a[0] * rq * g1[0], a[1] * rq * g1[1]), cvtpk(a[2] * rq * g1[2], a[3] * rq * g1[3])};
        u32x2 w2 = {cvtpk(c[0] * rk * g2[0], c[1] * rk * g2[1]), cvtpk(c[2] * rk * g2[2], c[3] * rk * g2[3])};
        *(u32x2*)(CN + (size_t)row * 512 + lane * 4) = w1; *(u32x2*)(CN + (size_t)row * 512 + 256 + lane * 4) = w2;
        { float t1 = 0.f, t2 = 0.f; if (lane < 16) { t1 = d[512 + lane]; t2 = d[528 + lane]; }
          const float pe2 = wave_sum_fast(t1 * t1 + t2 * t2); const int bb = row < NCTX ? row >> 8 : (row - NCTX) >> 13;
          pem0 = bb == 0 ? fmaxf(pem0, pe2) : pem0; pem1 = bb == 1 ? fmaxf(pem1, pe2) : pem1; pem2 = bb == 2 ? fmaxf(pem2, pe2) : pem2; pem3 = bb == 3 ? fmaxf(pem3, pe2) : pem3; }
        if (lane < 16) { float t1 = d[512 + lane], t2 = d[528 + lane]; int b, pos; row_bp(row, b, pos);
            if (row >= NCTX) { const int n = (row - NCTX) & (SEQ - 1); const float cs = ca[n * 16 + lane], sn = sa[n * 16 + lane];
                const float o1 = t1 * cs - t2 * sn, o2 = t1 * sn + t2 * cs; t1 = o1; t2 = o2; }
            u16* o = KPE + ((size_t)b * KEYS + pos) * 32 + lane; o[0] = f2bf(t1); o[16] = f2bf(t2); }
    }
    if (lane == 0) { unsigned* pm = F.W<unsigned>(WS_CTL) + CW_PEMAX + li * 4; atomic_fmax_pos(pm, pem0); atomic_fmax_pos(pm + 1, pem1); atomic_fmax_pos(pm + 2, pem2); atomic_fmax_pos(pm + 3, pem3); }
}
__device__ __forceinline__ int vcu_of(const Frame& F) { return (F.G % 8 == 0) ? (F.bx % 8) * (F.G / 8) + F.bx / 8 : F.bx; }
__device__ __forceinline__ void mla_attn(const Frame& F, bool ctx_out, int li) {
    const u16* Q = F.W<u16>(MLA_Q); const u16* Kn = F.W<u16>(MLA_KN); const u16* V = F.W<u16>(MLA_V); const u16* Kpe = F.W<u16>(MLA_KPE);
    u16* O = F.W<u16>(MLA_DQ);
    const int nit = 2048 + (ctx_out ? 64 : 0); int nrun = 0;
#pragma unroll 1
    for (int it = vcu_of(F); it < nit; it += F.G) {
        int b, h, qpos, nkeys, orow;
        if (it < 2048) { const int bh = it >> 5, qt = it & 31; b = bh >> 4; h = bh & 15; qpos = CTXL + qt * 256; nkeys = KEYS; orow = NCTX + b * SEQ + qt * 256; }
        else { const int jj = it - 2048; b = jj >> 4; h = jj & 15; qpos = 0; nkeys = CTXL; orow = b * CTXL; }
        const size_t bh = (size_t)(b * 16 + h);
        const unsigned* km = F.W<unsigned>(WS_CTL) + CW_KMAX + li * 128 + (b * 16 + h) * 2;
        const float kmax2 = __uint_as_float(km[0]) + __uint_as_float(km[1]) + __uint_as_float(F.W<unsigned>(WS_CTL)[CW_PEMAX + li * 4 + b]);
        attn_item<96, 64>(Q + (bh * KEYS + qpos) * 96, Kn + bh * KEYS * 64, Kpe + (size_t)b * KEYS * 32, V + bh * KEYS * 64, nkeys,
                          O + (size_t)orow * DM + h * 64, DM, F.lds, kmax2);
        moe_cvt_group(F, li, F.bx + nrun * F.G); ++nrun;
    }
    for (; F.bx + nrun * F.G < MOE_CVT_GROUPS; ++nrun) moe_cvt_group(F, li, F.bx + nrun * F.G);
}
__device__ __forceinline__ void diff_attn(const Frame& F, int li) {
    const u16* Q = F.W<u16>(DF_Q); const u16* K = F.W<u16>(DF_K); const u16* V = F.W<u16>(DF_V); u16* OS = F.W<u16>(DF_OS);
    const int nit = 2048 + 64; int nrun = 0;
#pragma unroll 1
    for (int it = vcu_of(F); it < nit; it += F.G) {
        int b, hh, qpos, nkeys, orow;
        if (it < 2048) { const int bh = it >> 5, qt = it & 31; b = bh >> 4; hh = bh & 15; qpos = CTXL + qt * 256; nkeys = KEYS; orow = NCTX + b * SEQ + qt * 256; }
        else { const int jj = it - 2048; b = jj >> 4; hh = jj & 15; qpos = 0; nkeys = CTXL; orow = b * CTXL; }
        const size_t bh = (size_t)(b * 16 + hh);
        const float kmax2 = __uint_as_float(F.W<unsigned>(WS_CTL)[CW_KMAX + li * 128 + (b * 16 + hh) * 2]);
        attn_item<64, 128>(Q + (bh * KEYS + qpos) * 64, K + bh * KEYS * 64, nullptr, V + (size_t)(b * 8 + (hh >> 1)) * KEYS * 128, nkeys,
                           OS + (size_t)(hh & 1) * NTOK * DM + (size_t)orow * DM + (hh >> 1) * 128, DM, F.lds, kmax2);
        moe_cvt_group(F, li, F.bx + nrun * F.G); ++nrun;
    }
    for (; F.bx + nrun * F.G < MOE_CVT_GROUPS; ++nrun) moe_cvt_group(F, li, F.bx + nrun * F.G);
}
__device__ __forceinline__ void diff_rowpass(const Frame& F, float lam_init) {
    const int lane = threadIdx.x & 63, wid = threadIdx.x >> 6;
    const u16* OS = F.W<u16>(DF_OS); u16* O = F.W<u16>(DF_Q);
    const float* lm = F.in(15);
    const float lam = __expf(wave_sum(lm[lane] * lm[64 + lane])) - __expf(wave_sum(lm[128 + lane] * lm[192 + lane])) + lam_init;
    const float post = 1.f - lam_init;
    float sg[16];
#pragma unroll
    for (int i = 0; i < 16; ++i) sg[i] = F.in(16)[(lane & 7) * 16 + i] * post;
    for (int row = F.bx * NWAVE + wid; row < NTOK; row += F.G * NWAVE) {
        const u16* p0 = OS + (size_t)row * DM + lane * 16; const u16* p1 = p0 + (size_t)NTOK * DM;
        const bf16x8 a0 = *(const bf16x8*)p0, a1 = *(const bf16x8*)(p0 + 8), b0 = *(const bf16x8*)p1, b1 = *(const bf16x8*)(p1 + 8);
        float o[16]; float ss = 0;
#pragma unroll
        for (int i = 0; i < 8; ++i) { o[i] = bf2f((u16)a0[i]) - lam * bf2f((u16)b0[i]); o[8 + i] = bf2f((u16)a1[i]) - lam * bf2f((u16)b1[i]); }
#pragma unroll
        for (int i = 0; i < 16; ++i) ss += o[i] * o[i];
        ss += __shfl_xor(ss, 1); ss += __shfl_xor(ss, 2); ss += __shfl_xor(ss, 4);
        const float rinv = rsqrtf(ss * (1.f / 128.f) + EPS);
        u32x4 w0, w1;
#pragma unroll
        for (int i = 0; i < 4; ++i) { w0[i] = cvtpk(o[2 * i] * rinv * sg[2 * i], o[2 * i + 1] * rinv * sg[2 * i + 1]);
            w1[i] = cvtpk(o[8 + 2 * i] * rinv * sg[8 + 2 * i], o[9 + 2 * i] * rinv * sg[9 + 2 * i]); }
        *(u32x4*)(O + (size_t)row * DM + lane * 16) = w0; *(u32x4*)(O + (size_t)row * DM + lane * 16 + 8) = w1;
    }
}

__device__ __forceinline__ float logsig16(float x) { return (fminf(x, 0.f) - __logf(1.f + __expf(-fabsf(x)))) * 0.0625f; }
constexpr int NCH = KEYS / 64;

__device__ __forceinline__ void gla_g1(const Frame& F) {
    char* KT = F.lds; char* VV = F.lds + 16384; float* ZT = (float*)(F.lds + 49152); float* SEG = (float*)(F.lds + 53248);
    const u16* Kg = F.W<u16>(GL_K); const u16* Vg = F.W<u16>(GL_V); const float* Zg = F.W<float>(GL_Z);
    u16* ST = F.W<u16>(GL_STATE); float* DEC = F.W<float>(GL_DEC);
#pragma unroll 1
    for (int it = F.bx; it < NBATCH * 4 * 2 * NCH; it += F.G) {
        int tid = threadIdx.x; asm volatile("" : "+v"(tid));
        const int lane = tid & 63, wid = tid >> 6, r32 = lane & 31, hi = lane >> 5, kk = tid & 127, jq = tid >> 7;
        const int c = it % NCH, dir = (it / NCH) & 1, bh = it / (2 * NCH), b = bh >> 2, h = bh & 3;
        const int s0 = 64 * c;
        int tbase, tstep;
        if (dir == 0) { tbase = (c < 4) ? b * CTXL + s0 : NCTX + b * SEQ + s0 - CTXL; tstep = 1; }
        else { tbase = (c < 4) ? b * CTXL + (CTXL - 1) - s0 : NCTX + b * SEQ + (SEQ - 1) - (s0 - CTXL); tstep = -1; }
        __syncthreads();
        for (int i = tid; i < 1024; i += NTHR) { const int j = i >> 4, r = i & 15; ZT[i] = Zg[(size_t)(tbase + tstep * j) * 32 + dir * 16 + r]; }
#pragma unroll
        for (int q = 0; q < 4; ++q) { const int id = tid + q * NTHR, key = id >> 5, cc = (id & 31) * 8;
            *(bf16x8*)(VV + v_st<8>(key, cc)) = *(const bf16x8*)(Vg + (size_t)(tbase + tstep * key) * 1024 + h * 256 + cc); }
        float wg[16];
#pragma unroll
        for (int r = 0; r < 16; ++r) wg[r] = F.in(19)[(dir * 16 + r) * 512 + h * 128 + kk];
        const float bias = F.in(20)[dir * 512 + h * 128 + kk];
        __syncthreads();
        float cv[16]; float run = 0;
#pragma unroll
        for (int jj = 0; jj < 16; ++jj) { const int j = jq * 16 + jj; float x = bias;
#pragma unroll
            for (int r = 0; r < 16; ++r) x += ZT[j * 16 + r] * wg[r];
            run += logsig16(x); cv[jj] = run; }
        SEG[jq * 128 + kk] = run;
        __syncthreads();
        float offset = 0, total = 0;
#pragma unroll
        for (int q = 0; q < 4; ++q) { const float sv = SEG[q * 128 + kk]; total += sv; if (q < jq) offset += sv; }
        u32x4 w0, w1;
#pragma unroll
        for (int i = 0; i < 8; ++i) {
            const int j0 = jq * 16 + 2 * i;
            const float k0 = bf2f(Kg[(size_t)(tbase + tstep * j0) * 512 + h * 128 + kk]) * __expf(total - (offset + cv[2 * i]));
            const float k1 = bf2f(Kg[(size_t)(tbase + tstep * (j0 + 1)) * 512 + h * 128 + kk]) * __expf(total - (offset + cv[2 * i + 1]));
            const unsigned pk = cvtpk(k0, k1); if (i < 4) w0[i] = pk; else w1[i - 4] = pk; }
        *(u32x4*)(KT + kk * 128 + (((jq * 2) ^ ((kk >> 1) & 7)) << 4)) = w0;
        *(u32x4*)(KT + kk * 128 + (((jq * 2 + 1) ^ ((kk >> 1) & 7)) << 4)) = w1;
        if (jq == 0) DEC[(size_t)it * 128 + kk] = __expf(total);
        __syncthreads();
        const int mt = wid & 3, vb = (wid >> 2) * 4;
        const int row = mt * 32 + r32, ab = row * 128 + ((hi ^ ((row >> 1) & 7)) << 4);
        const bf16x8 pa0 = *(const bf16x8*)(KT + (ab ^ 0)), pa1 = *(const bf16x8*)(KT + (ab ^ 32)), pa2 = *(const bf16x8*)(KT + (ab ^ 64)), pa3 = *(const bf16x8*)(KT + (ab ^ 96));
        f32x16 acc[4];
#pragma unroll
        for (int n = 0; n < 4; ++n) acc[n] = f32x16{};
        const int vbase = (int)(uintptr_t)VV + v_rd_base(lane) + vb * 512;
        pv_one<0, 8>(acc[0], vbase, pa0, pa1, pa2, pa3); pv_one<1, 8>(acc[1], vbase, pa0, pa1, pa2, pa3);
        pv_one<2, 8>(acc[2], vbase, pa0, pa1, pa2, pa3); pv_one<3, 8>(acc[3], vbase, pa0, pa1, pa2, pa3);
        u16* S = ST + (size_t)it * 128 * 256;
#pragma unroll
        for (int n = 0; n < 4; ++n)
#pragma unroll
            for (int r = 0; r < 16; ++r) S[(mt * 32 + crow(r, hi)) * 256 + (vb + n) * 32 + r32] = f2bf(acc[n][r]);
    }
}
__device__ __forceinline__ void gla_g2(const Frame& F) {
    u16* ST = F.W<u16>(GL_STATE); const float* DEC = F.W<float>(GL_DEC);
    for (int g = F.bx * NTHR + threadIdx.x; g < 32 * 4096; g += F.G * NTHR) {
        const int chain = g >> 12, e = g & 4095, kk = e >> 5, v8 = (e & 31) * 8;
        u16* p = ST + ((size_t)chain * NCH * 128 + kk) * 256 + v8; const float* d = DEC + (size_t)chain * NCH * 128 + kk;
        float f[8];
#pragma unroll
        for (int i = 0; i < 8; ++i) f[i] = 0.f;
        for (int c = 0; c < NCH; c += 4) {
            bf16x8 kv[4]; float dc[4];
#pragma unroll
            for (int u = 0; u < 4; ++u) { kv[u] = *(const bf16x8*)(p + (size_t)(c + u) * 128 * 256); dc[u] = d[(size_t)(c + u) * 128]; }
#pragma unroll
            for (int u = 0; u < 4; ++u) {
                u32x4 w = {cvtpk(f[0], f[1]), cvtpk(f[2], f[3]), cvtpk(f[4], f[5]), cvtpk(f[6], f[7])};
                *(u32x4*)(p + (size_t)(c + u) * 128 * 256) = w;
#pragma unroll
                for (int i = 0; i < 8; ++i) f[i] = dc[u] * f[i] + bf2f((u16)kv[u][i]);
            }
        }
    }
}
__device__ __forceinline__ void gla_g3(const Frame& F) {
    char* QD = F.lds; char* KI = F.lds + 16384; char* VV = F.lds + 32768; char* SS = F.lds + 65536; float* OL = (float*)(F.lds + 65536);
    float* ZT = (float*)(F.lds + 132096); float* SEG = (float*)(F.lds + 136192);
    const u16* Qg = F.W<u16>(GL_Q); const u16* Kg = F.W<u16>(GL_K); const u16* Vg = F.W<u16>(GL_V); const u16* Gg = F.W<u16>(GL_G); const float* Zg = F.W<float>(GL_Z);
    const u16* ST = F.W<u16>(GL_STATE); u16* OUT = F.W<u16>(WS_H);
#pragma unroll 1
    for (int it = F.bx; it < NBATCH * 4 * NCH; it += F.G) {
        int tid = threadIdx.x; asm volatile("" : "+v"(tid));
        const int lane = tid & 63, wid = tid >> 6, r32 = lane & 31, hi = lane >> 5, kk = tid & 127, jq = tid >> 7;
        const int T = it % NCH, bh = it / NCH, b = bh >> 2, h = bh & 3;
        const int t0 = (T < 4) ? b * CTXL + 64 * T : NCTX + b * SEQ + 64 * (T - 4);
        __syncthreads();
#pragma unroll
        for (int q = 0; q < 4; ++q) { const int id = tid + q * NTHR, key = id >> 5, cc = (id & 31) * 8;
            *(bf16x8*)(VV + v_st<8>(key, cc)) = *(const bf16x8*)(Vg + (size_t)(t0 + key) * 1024 + h * 256 + cc); }
        const int itile = wid & 1, vb = (wid >> 1) * 2;
        f32x16 acc[2]; acc[0] = f32x16{}; acc[1] = f32x16{};
#pragma unroll 1
        for (int dir = 0; dir < 2; ++dir) {
            const int cd = dir == 0 ? T : (T < 4 ? 3 - T : 135 - T);
            const u16* Ssrc = ST + (size_t)((bh * 2 + dir) * NCH + cd) * 128 * 256;
#pragma unroll
            for (int q = 0; q < 8; ++q) { const int id = tid + q * NTHR, key = id >> 5, cc = (id & 31) * 8;
                *(bf16x8*)(SS + v_st<8>(key, cc)) = *(const bf16x8*)(Ssrc + (size_t)key * 256 + cc); }
            for (int i = tid; i < 1024; i += NTHR) { const int j = i >> 4, r = i & 15; ZT[i] = Zg[(size_t)(t0 + j) * 32 + dir * 16 + r]; }
            float wg[16];
#pragma unroll
            for (int r = 0; r < 16; ++r) wg[r] = F.in(19)[(dir * 16 + r) * 512 + h * 128 + kk];
            const float bias = F.in(20)[dir * 512 + h * 128 + kk];
            __syncthreads();
            float cv[16]; float run = 0;
#pragma unroll
            for (int u = 0; u < 16; ++u) { const int j = jq * 16 + u; float x = bias;
#pragma unroll
                for (int r = 0; r < 16; ++r) x += ZT[j * 16 + r] * wg[r];
                cv[u] = logsig16(x); }
            if (dir == 0) {
#pragma unroll
                for (int u = 0; u < 16; ++u) { run += cv[u]; cv[u] = run; }
            } else {
#pragma unroll
                for (int u = 15; u >= 0; --u) { run += cv[u]; cv[u] = run; }
            }
            SEG[jq * 128 + kk] = run;
            __syncthreads();
            float offset = 0;
#pragma unroll
            for (int q = 0; q < 4; ++q) { const float sv = SEG[q * 128 + kk]; if (dir == 0 ? (q < jq) : (q > jq)) offset += sv; }
            const int adb = jq * 4096 + ((kk >> 3) << 4) + (kk & 7) * 2;
#pragma unroll
            for (int jj = 0; jj < 16; ++jj) { const int i = jq * 16 + jj; const float cum = offset + cv[jj];
                const float qv = bf2f(Qg[(size_t)(t0 + i) * 512 + h * 128 + kk]) * __expf(cum);
                const float kv = bf2f(Kg[(size_t)(t0 + i) * 512 + h * 128 + kk]) * __expf(-cum);
                const int ad = (adb ^ (jj << 4)) + jj * 256;
                *(u16*)(QD + ad) = f2bf(qv); *(u16*)(KI + ad) = f2bf(kv); }
            __syncthreads();
            {
                const int row = itile * 32 + r32; bf16x8 qa[8];
#pragma unroll
                for (int ks = 0; ks < 8; ++ks) qa[ks] = *(const bf16x8*)(QD + row * 256 + (((ks * 2 + hi) ^ (row & 15)) << 4));
                const int ssb = (int)(uintptr_t)SS + v_rd_base(lane) + vb * 512;
                pv_one<0, 8>(acc[0], ssb, qa[0], qa[1], qa[2], qa[3]); pv_one<0, 8>(acc[0], ssb + 32768, qa[4], qa[5], qa[6], qa[7]);
                pv_one<1, 8>(acc[1], ssb, qa[0], qa[1], qa[2], qa[3]); pv_one<1, 8>(acc[1], ssb + 32768, qa[4], qa[5], qa[6], qa[7]);
                f32x16 p0 = f32x16{}, p1 = f32x16{};
#pragma unroll
                for (int ks = 0; ks < 8; ++ks) {
                    const bf16x8 k0 = *(const bf16x8*)(KI + r32 * 256 + (((ks * 2 + hi) ^ (r32 & 15)) << 4));
                    const bf16x8 k1 = *(const bf16x8*)(KI + (32 + r32) * 256 + (((ks * 2 + hi) ^ (r32 & 15)) << 4));
                    p0 = __builtin_amdgcn_mfma_f32_32x32x16_bf16(k0, qa[ks], p0, 0, 0, 0);
                    p1 = __builtin_amdgcn_mfma_f32_32x32x16_bf16(k1, qa[ks], p1, 0, 0, 0);
                }
                const int iq = itile * 32 + r32;
#pragma unroll
                for (int r = 0; r < 16; ++r) { const int s0 = crow(r, hi), s1 = 32 + s0;
                    const bool k0 = dir == 0 ? (s0 <= iq) : (s0 >= iq), k1 = dir == 0 ? (s1 <= iq) : (s1 >= iq);
                    p0[r] = k0 ? p0[r] : 0.f; p1[r] = k1 ? p1[r] : 0.f; }
                bf16x8 pa0, pa1, pa2, pa3;
                PK4(p0, 0, pa0); PK4(p0, 8, pa1); PK4(p1, 0, pa2); PK4(p1, 8, pa3);
                const int vvb = (int)(uintptr_t)VV + v_rd_base(lane) + vb * 512;
                pv_one<0, 8>(acc[0], vvb, pa0, pa1, pa2, pa3); pv_one<1, 8>(acc[1], vvb, pa0, pa1, pa2, pa3);
            }
            __syncthreads();
        }
        float* olb = OL + (itile * 32 + 4 * hi) * 260 + vb * 32 + r32;
#pragma unroll
        for (int n = 0; n < 2; ++n)
#pragma unroll
            for (int r = 0; r < 16; ++r) olb[((r & 3) + 8 * (r >> 2)) * 260 + n * 32] = acc[n][r];
        __syncthreads();
        {
            const int i = tid >> 3, sg = tid & 7; const float* ol = OL + i * 260 + sg * 32;
            float ss = 0;
#pragma unroll
            for (int u = 0; u < 8; ++u) { const f32x4 t = *(const f32x4*)(ol + u * 4); ss += t[0] * t[0] + t[1] * t[1] + t[2] * t[2] + t[3] * t[3]; }
            ss += __shfl_xor(ss, 1); ss += __shfl_xor(ss, 2); ss += __shfl_xor(ss, 4);
            const float rinv = rsqrtf(ss * (1.f / 256.f) + EPS);
            const u16* gp = Gg + (size_t)(t0 + i) * 1024 + h * 256 + sg * 32; u16* op = OUT + (size_t)(t0 + i) * 1024 + h * 256 + sg * 32;
            const float* hn = F.in(21) + sg * 32;
#pragma unroll
            for (int q = 0; q < 4; ++q) { const bf16x8 g8 = *(const bf16x8*)(gp + q * 8); u32x4 w;
                const f32x4 oa = *(const f32x4*)(ol + q * 8), ob = *(const f32x4*)(ol + q * 8 + 4);
                const float o8[8] = {oa[0], oa[1], oa[2], oa[3], ob[0], ob[1], ob[2], ob[3]};
#pragma unroll
                for (int u = 0; u < 4; ++u) { const int e0 = q * 8 + 2 * u;
                    w[u] = cvtpk(o8[2 * u] * rinv * hn[e0] * silu_f(bf2f((u16)g8[2 * u])), o8[2 * u + 1] * rinv * hn[e0 + 1] * silu_f(bf2f((u16)g8[2 * u + 1]))); }
                *(u32x4*)(op + q * 8) = w; }
        }
    }
}

__device__ __forceinline__ void pair_decode(int p, int& elo, int& ehi) { elo = p < 3 ? 0 : (p < 5 ? 1 : 2); ehi = p < 3 ? p + 1 : (p < 5 ? p - 1 : 3); }
struct MoeATiles {
    typedef GTile<RowsGather, RowsPlain, EpiMoeA> Tile; static constexpr bool EP_CONST = false; EpiMoeA ep;
    const int* tab; u16* H; const int* rowtok; const u16* wgu; u16* act; const float* roww; int nmt, bx, G;
    __device__ __forceinline__ bool get(int i, Tile& t) const {
        int mt, nt; if (!tile_seq(i, bx, G, nmt, 16, mt, nt)) return false;
        const int c = tab[32 + mt], g = c / 6; int elo, ehi; pair_decode(c % 6, elo, ehi);
        const int half = nt >> 3, e = half ? ehi : elo;
        t.al = RowsGather{H, 1024, rowtok};
        t.bl = RowsPlain{wgu + ((size_t)(g * 4 + e) * 1024 + (nt & 7) * 128) * 1024, 1024};
        t.ep = EpiMoeA{act, roww, half, half * 512 + (nt & 7) * 64};
        t.brow = mt * 256; t.bcol = 0; return true; }
};
struct MoeBTiles {
    typedef GTile<RowsPlain, RowsSplitK, EpiMoeB> Tile; static constexpr bool EP_CONST = false; EpiMoeB ep;
    const int* tab; ResCtx F; int li; const u16* wd; const u16* act; const int* rowtok; int nmt, bx, G;
    __device__ __forceinline__ bool get(int i, Tile& t) const {
        int mt, nt; if (!tile_seq(i, bx, G, nmt, 8, mt, nt)) return false;
        const int c = tab[32 + mt], g = c / 6; int elo, ehi; pair_decode(c % 6, elo, ehi);
        t.al = RowsPlain{act, 1024};
        t.bl = RowsSplitK{wd + (size_t)(g * 4 + elo) * 1024 * 512, wd + (size_t)(g * 4 + ehi) * 1024 * 512, 512, 8};
        t.ep = EpiMoeB{F, li, rowtok};
        t.brow = mt * 256; t.bcol = nt * 128; return true; }
};
__device__ __forceinline__ void moe_gemm_a(const Frame& F, int li) {
    int* tab = (int*)(F.lds + LDS_TAB); moe_table(F, li, tab);
    const int nmt = tab[24] >> 8;
    pg8::MoeAOrder S8{F.W<u16>(WS_H), tab, F.W<int>(WS_ROWTOK), F.W<u16>(WS_MOEW), nmt, F.bx, F.G}; pg8::EpiMoeA8 E8{F.W<u16>(MOE_ACT), F.W<float>(WS_ROWW)};
    pg8::gemm_phase(F.lds, 1024, 1024, S8, E8);
}
__device__ __forceinline__ void moe_gemm_b(const Frame& F, int li) {
    int* tab = (int*)(F.lds + LDS_TAB); moe_table(F, li, tab);
    const int nmt = tab[24] >> 8;
    MoeBTiles prov{EpiMoeB{}, tab, res_ctx(F), li, F.W<u16>(WS_MOEW + MOE_WGU_BYTES), F.W<u16>(MOE_ACT), F.W<int>(WS_ROWTOK), nmt, F.bx, F.G};
    gemm_stream<4, 2>(F.lds, prov, 16);
}
__device__ __forceinline__ void final_norm(const Frame& F) {
    const int lane = threadIdx.x & 63, wid = threadIdx.x >> 6;
    for (int row = F.bx * NWAVE + wid; row < NLAT; row += F.G * NWAVE) {
        float* xr = F.out + (size_t)row * DM; f32x4 v[4];
#pragma unroll
        for (int i = 0; i < 4; ++i) v[i] = *(const f32x4*)(xr + i * 256 + lane * 4);
        float ss = 0;
#pragma unroll
        for (int i = 0; i < 4; ++i) ss += v[i][0] * v[i][0] + v[i][1] * v[i][1] + v[i][2] * v[i][2] + v[i][3] * v[i][3];
        ss = wave_sum(ss); const float rinv = rsqrtf(ss * (1.f / DM) + EPS);
#pragma unroll
        for (int i = 0; i < 4; ++i) { const f32x4 g = *(const f32x4*)(F.in(30) + i * 256 + lane * 4);
            f32x4 o = {v[i][0] * rinv * g[0], v[i][1] * rinv * g[1], v[i][2] * rinv * g[2], v[i][3] * rinv * g[3]};
            *(f32x4*)(xr + i * 256 + lane * 4) = o; }
    }
}

constexpr int N_PHASES = 42;
__global__ void __launch_bounds__(NTHR, 2) fwd_kernel(Params p) {
    extern __shared__ __attribute__((aligned(16))) char lds[];
    Frame F; F.p = &p; F.ws = p.ws; F.lds = lds; F.out = p.out; F.G = (int)gridDim.x; F.bx = (int)blockIdx.x;
    const int lo = p.ph_lo, hi = p.ph_hi;
#if !MK_PER_PHASE
    if (threadIdx.x == 0) *(uint4*)(lds + LDS_BARW) = make_uint4(0u, 0u, 0u, 0u);
    __syncthreads();
    XcdBarrier bar = xcd_barrier_post((unsigned*)(p.ws + WS_CTL), (volatile LAS unsigned*)(lds + LDS_BARW));
#define GRID_BAR() xcd_barrier(bar)
#else
#define GRID_BAR() do {} while (0)
#endif
#ifndef MK_EN
#define MK_EN 0xFFFFFFFFu
#endif
#define EN(g) (((MK_EN) >> (g)) & 1u)
#ifndef MK_REP
#define MK_REP 0u
#endif
#define REP(g) (((MK_REP) >> (g)) & 1u)
#define IN(k) (lo <= (k) && (k) < hi)
#define SEAM(k) do { if ((k) + 1 < hi) GRID_BAR(); } while (0)
#define DUP(g, body) do { body; if (REP(g)) { GRID_BAR(); body; } } while (0)

    if (EN(0) && IN(0)) { DUP(0, (p0_mods(F), __syncthreads(), p0_rope(F), p0_weights(F))); SEAM(0); }

#define LAYER(LI) { constexpr int li = (LI); constexpr int base = 1 + li * 10; constexpr bool first = li == 0, last = li == DEPTH - 1; constexpr int kind = li % 3, j = li / 3; \
        if (EN(1) && IN(base + 0)) { DUP(1, norm_phase<false>(F, li, 0, first)); SEAM(base + 0); } \
        if constexpr (kind == 0) { \
            if (EN(2) && IN(base + 1)) { EpiMlaDown ep{F.W<u16>(MLA_CN), F.W<float>(MLA_DQ), F.W<u16>(MLA_KPE), F.W<unsigned>(WS_CTL) + CW_PEMAX + li * 4}; \
                gemm_phase<4, 2>(F, RowsPlain{F.W<u16>(WS_H), 1024}, RowsPlain{F.W<u16>(WS_WDQKV) + (size_t)j * 640 * 1024, 1024}, ep, 0, 132, 5, 16, 0, 0); SEAM(base + 1); } \
            if (EN(2) && IN(base + 3)) { pg8::MlaUpOrder S8{F.W<u16>(MLA_CN), F.W<u16>(WS_WUQ) + (size_t)j * 1536 * 256, F.W<u16>(WS_WUKV) + (size_t)j * 2048 * 256, F.bx, F.G}; \
                pg8::EpiMlaUp8 E8{F.W<u16>(MLA_Q), F.W<u16>(MLA_KN), (long)((MLA_V - MLA_KN) / 2), 0.10206207261596577f * LOG2E, F.W<unsigned>(WS_CTL) + CW_KMAX + li * 128, F.W<float>(MLA_DQ)}; \
                pg8::gemm_phase(F.lds, 512, 256, S8, E8); SEAM(base + 3); } \
            if (EN(4) && IN(base + 4)) { DUP(4, mla_attn(F, !last, li)); SEAM(base + 4); } \
            if (EN(2) && IN(base + 5)) { pg8::SeqOrder S8{F.W<u16>(MLA_DQ), F.W<u16>(WS_WOM) + (size_t)j * 1024 * 1024, 1024, last ? 128 : 132, 4, F.bx, F.G, last ? 4 : 0}; EpiResid8 E8{res_ctx(F, first), li}; \
                pg8::gemm_phase(F.lds, 1024, 1024, S8, E8); SEAM(base + 5); } \
        } else if constexpr (kind == 1) { \
            if (EN(5) && IN(base + 1)) { pg8::SeqOrder S8{F.W<u16>(WS_H), F.W<u16>(WS_WQKVD), 1024, 132, 12, F.bx, F.G, 0}; pg8::EpiDiffQKV8 E8{F.W<u16>(DF_Q), (long)((DF_K - DF_Q) / 2), F.W<u16>(DF_V), 0.125f * LOG2E, F.W<unsigned>(WS_CTL) + CW_KMAX + li * 128}; \
                pg8::gemm_phase(F.lds, 1024, 1024, S8, E8); \
                if (REP(5)) { GRID_BAR(); pg8::gemm_phase(F.lds, 1024, 1024, S8, E8); } SEAM(base + 1); } \
            if (EN(6) && IN(base + 2)) { DUP(6, diff_attn(F, li)); SEAM(base + 2); } \
            if (EN(7) && IN(base + 3)) { DUP(7, diff_rowpass(F, 0.35550906759906f)); SEAM(base + 3); } \
            if (EN(5) && IN(base + 4)) { pg8::SeqOrder S8{F.W<u16>(DF_Q), F.W<u16>(WS_WOD), 1024, 132, 4, F.bx, F.G, 0}; EpiResid8 E8{res_ctx(F, first), li}; \
                pg8::gemm_phase(F.lds, 1024, 1024, S8, E8); SEAM(base + 4); } \
        } else { \
            if (EN(8) && IN(base + 1)) { pg8::SeqOrder S8{F.W<u16>(WS_H), F.W<u16>(WS_WING), 1024, 132, 13, F.bx, F.G, 0}; pg8::EpiGlaIn8 E8{F.W<u16>(GL_Q), F.W<u16>(GL_K), F.W<u16>(GL_V), F.W<u16>(GL_G), F.W<float>(GL_Z)}; \
                pg8::gemm_phase(F.lds, 1024, 1024, S8, E8); \
                if (REP(8)) { GRID_BAR(); pg8::gemm_phase(F.lds, 1024, 1024, S8, E8); } SEAM(base + 1); } \
            if (EN(9) && IN(base + 2)) { DUP(9, gla_g1(F)); SEAM(base + 2); } \
            if (EN(10) && IN(base + 3)) { gla_g2(F); SEAM(base + 3); } \
            if (EN(11) && IN(base + 4)) { DUP(11, gla_g3(F)); SEAM(base + 4); } \
            if (EN(8) && IN(base + 5)) { pg8::SeqOrder S8{F.W<u16>(WS_H), F.W<u16>(WS_WOG), 1024, 132, 4, F.bx, F.G, 0}; EpiResid8 E8{res_ctx(F, first), li}; \
                pg8::gemm_phase(F.lds, 1024, 1024, S8, E8); SEAM(base + 5); } \
        } \
        if (EN(12) && IN(base + 6)) { norm_phase<true>(F, li, last ? NCTX : 0, false); SEAM(base + 6); } \
        if (EN(13) && IN(base + 7)) { DUP(13, ((kind == 2 ? moe_weights(F, li) : (void)0), moe_scatter(F, li, last ? NCTX : 0))); SEAM(base + 7); } \
        if (EN(14) && IN(base + 8)) { DUP(14, moe_gemm_a(F, li)); SEAM(base + 8); } \
        if (EN(15) && IN(base + 9)) { moe_gemm_b(F, li); SEAM(base + 9); } \
    }
    LAYER(0) LAYER(1) LAYER(2) LAYER(3)
    if (EN(16) && IN(41)) { final_norm(F); }
}

extern "C" void kernel_launch(void* const* d_in, const int* in_sizes, int n_in, void* d_out, int out_size, void* d_ws, size_t ws_size, hipStream_t stream) {
    static int grid = 0;
    if (grid == 0) {
        if (n_in != 31 || out_size != NLAT * DM || ws_size < WS_END) {
            fprintf(stderr, "kernel_launch: built for 31 inputs, out %d floats, ws >= %zu bytes; got n_in %d out %d ws %zu\n", NLAT * DM, (size_t)WS_END, n_in, out_size, ws_size);
            grid = -1; return; }
        int dev = 0, cus = 0;
        if (hipGetDevice(&dev) != hipSuccess || hipDeviceGetAttribute(&cus, hipDeviceAttributeMultiprocessorCount, dev) != hipSuccess) { grid = -1; return; }
        if (hipFuncSetAttribute((const void*)fwd_kernel, hipFuncAttributeMaxDynamicSharedMemorySize, LDS_BYTES) != hipSuccess) { fprintf(stderr, "kernel_launch: hipFuncSetAttribute failed\n"); grid = -1; return; }
        int per_cu = 0;
        if (hipOccupancyMaxActiveBlocksPerMultiprocessor(&per_cu, (const void*)fwd_kernel, NTHR, LDS_BYTES) != hipSuccess || per_cu < 1)
            fprintf(stderr, "kernel_launch: occupancy query reports %d workgroups per CU\n", per_cu);
        (void)hipGetLastError();
        grid = cus;
    }
    if (grid < 0) return;
    (void)in_sizes;
    (void)hipMemsetAsync((char*)d_ws + WS_CTL, 0, CTL_BYTES, stream);
    Params p{};
    for (int i = 0; i < 31; ++i) p.in[i] = (const float*)d_in[i];
    p.out = (float*)d_out; p.ws = (unsigned char*)d_ws;
#if MK_PER_PHASE
    for (int ph = 0; ph < N_PHASES; ++ph) { p.ph_lo = ph; p.ph_hi = ph + 1; hipLaunchKernelGGL(fwd_kernel, dim3(grid), dim3(NTHR), LDS_BYTES, stream, p); }
#else
#ifdef MK_PROBE_HI
    p.ph_lo = 0; p.ph_hi = MK_PROBE_HI;
    hipLaunchKernelGGL(fwd_kernel, dim3(grid), dim3(NTHR), LDS_BYTES, stream, p);
    (void)hipMemsetAsync((char*)d_ws + WS_CTL, 0, CTL_BYTES, stream);
#endif
    p.ph_lo = 0; p.ph_hi = N_PHASES;
    hipLaunchKernelGGL(fwd_kernel, dim3(grid), dim3(NTHR), LDS_BYTES, stream, p);
#endif
}
```

```cpp
#include <hip/hip_runtime.h>
#include <stdint.h>
#include <stdio.h>

#ifndef MK_PER_PHASE
#define MK_PER_PHASE 0
#endif

typedef unsigned short u16;
using bf16x8 = __attribute__((ext_vector_type(8))) short;
using s16x4  = __attribute__((ext_vector_type(4))) short;
using f32x16 = __attribute__((ext_vector_type(16))) float;
using f32x4  = __attribute__((ext_vector_type(4))) float;
using u32x4  = __attribute__((ext_vector_type(4))) unsigned;
using u32x2  = __attribute__((ext_vector_type(2))) unsigned;

constexpr int DM = 1024, NBATCH = 4, SEQ = 8192, CTXL = 256, DEPTH = 4;
constexpr int NCTX = NBATCH * CTXL;
constexpr int NLAT = NBATCH * SEQ;
constexpr int NTOK = NCTX + NLAT;
constexpr int KEYS = CTXL + SEQ;
constexpr float EPS = 1e-6f;
constexpr int NTHR = 512, NWAVE = 8;
constexpr float LOG2E = 1.4426950408889634f;

constexpr size_t al256(size_t x) { return (x + 255) / 256 * 256; }
constexpr size_t WS_CTL   = 0;
constexpr size_t CTL_BYTES = 32768;
constexpr size_t WS_MODS  = WS_CTL + CTL_BYTES;
constexpr size_t WS_ROPEA = WS_MODS + al256((size_t)DEPTH * 5 * 6144 * 4);
constexpr size_t WS_ROPEB = WS_ROPEA + (size_t)2 * SEQ * 16 * 4;
constexpr size_t WS_XC    = WS_ROPEB + (size_t)2 * SEQ * 32 * 4;
constexpr size_t WS_WDQKV = WS_XC + (size_t)NCTX * DM * 4;
constexpr size_t WS_WUQ   = WS_WDQKV + (size_t)2 * 640 * 1024 * 2;
constexpr size_t WS_WUKV  = WS_WUQ + (size_t)2 * 1536 * 256 * 2;
constexpr size_t WS_WOM   = WS_WUKV + (size_t)2 * 2048 * 256 * 2;
constexpr size_t WS_WQKVD = WS_WOM + (size_t)2 * 1024 * 1024 * 2;
constexpr size_t WS_WOD   = WS_WQKVD + (size_t)3072 * 1024 * 2;
constexpr size_t WS_WING  = WS_WOD + (size_t)1024 * 1024 * 2;
constexpr size_t WS_WOG   = WS_WING + (size_t)3328 * 1024 * 2;
constexpr size_t WS_TOK   = WS_WOG + (size_t)1024 * 1024 * 2;
constexpr size_t WS_ROWTOK= WS_TOK + (size_t)NTOK * 16;
constexpr int    RMAX     = 40960;
constexpr size_t WS_ROWW  = WS_ROWTOK + (size_t)RMAX * 4;
constexpr size_t WS_H     = al256(WS_ROWW + (size_t)RMAX * 8);
constexpr size_t H_BYTES  = (size_t)NTOK * DM * 2;
constexpr size_t WS_MOEW  = WS_H + H_BYTES;
constexpr size_t MOE_WGU_BYTES = (size_t)16 * 1024 * 1024 * 2;
constexpr size_t MOE_WD_BYTES  = (size_t)16 * 1024 * 512 * 2;
constexpr size_t MOEW_BYTES = MOE_WGU_BYTES + MOE_WD_BYTES;
constexpr size_t WS_BIG   = WS_MOEW + MOEW_BYTES;
constexpr size_t MLA_Q    = WS_BIG;
constexpr size_t MLA_KN   = MLA_Q + (size_t)NBATCH * 16 * KEYS * 96 * 2;
constexpr size_t MLA_V    = MLA_KN + (size_t)NBATCH * 16 * KEYS * 64 * 2;
constexpr size_t MLA_KPE  = MLA_V + (size_t)NBATCH * 16 * KEYS * 64 * 2;
constexpr size_t MLA_DQ   = MLA_KPE + al256((size_t)NBATCH * KEYS * 32 * 2);
constexpr size_t MLA_CN   = MLA_DQ + (size_t)NTOK * 544 * 4;
constexpr size_t MLA_END  = MLA_CN + (size_t)NTOK * 512 * 2;
constexpr size_t DF_Q     = WS_BIG;
constexpr size_t DF_K     = DF_Q + (size_t)NBATCH * 16 * KEYS * 64 * 2;
constexpr size_t DF_V     = DF_K + (size_t)NBATCH * 16 * KEYS * 64 * 2;
constexpr size_t DF_OS    = DF_V + (size_t)NBATCH * 8 * KEYS * 128 * 2;
constexpr size_t DF_END   = DF_OS + (size_t)2 * NTOK * DM * 2;
constexpr size_t GL_STATE = WS_MOEW;
constexpr size_t GL_STATE_BYTES = (size_t)NBATCH * 4 * 2 * 132 * 128 * 256 * 2;
constexpr size_t GL_DEC   = GL_STATE + GL_STATE_BYTES;
constexpr size_t GL_Q     = GL_DEC + al256((size_t)4224 * 128 * 4);
constexpr size_t GL_K     = GL_Q + (size_t)NTOK * 512 * 2;
constexpr size_t GL_V     = GL_K + (size_t)NTOK * 512 * 2;
constexpr size_t GL_G     = GL_V + (size_t)NTOK * 1024 * 2;
constexpr size_t GL_Z     = GL_G + (size_t)NTOK * 1024 * 2;
constexpr size_t GL_END   = GL_Z + (size_t)NTOK * 32 * 4;
constexpr size_t MOE_ACT  = WS_BIG;
constexpr size_t MOE_END  = MOE_ACT + (size_t)RMAX * 1024 * 2;
constexpr size_t cmax(size_t a, size_t b) { return a > b ? a : b; }
constexpr size_t WS_END   = cmax(cmax(MLA_END, DF_END), cmax(GL_END, MOE_END));

#define XCD_BAR_WORDS 3456
constexpr int CW_CNT = 4096;
constexpr int CW_KMAX = 4352;
constexpr int CW_PEMAX = CW_KMAX + 512;

#define XB_TMO      128
#define XB_XCNT(j)  (256  + 64 * (j))
#define XB_XSUB(j)  (1280 + 64 * (j))
#define XB_XGEN(j)  (2304 + 64 * (j))
#define XB_TOP      3328
#define XB_TOPGEN   3392
#define XB_SPIN_CAP (1u << 24)
#define LAS __attribute__((address_space(3)))
__device__ __forceinline__ unsigned xb_ld(unsigned* p)              { return __hip_atomic_load(p, __ATOMIC_RELAXED, __HIP_MEMORY_SCOPE_AGENT); }
__device__ __forceinline__ unsigned xb_add(unsigned* p, unsigned v) { return __hip_atomic_fetch_add(p, v, __ATOMIC_RELAXED, __HIP_MEMORY_SCOPE_AGENT); }
__device__ __forceinline__ unsigned xb_xcc_id() { return (unsigned)__builtin_amdgcn_s_getreg((3 << 11) | 20) & 0xFu; }
#define XB_SPIN(cond, bar) do { unsigned _sp = 0; while (cond) { __builtin_amdgcn_s_sleep(1); \
    if ((++_sp & 255u) == 0u) { if (xb_ld(&(bar)[XB_TMO])) break; if (_sp > XB_SPIN_CAP) { atomicAdd(&(bar)[XB_TMO], 1u); break; } } } } while (0)
struct XcdBarrier { unsigned* bar; unsigned x; volatile LAS unsigned* st; };
__device__ __forceinline__ XcdBarrier xcd_barrier_post(unsigned* bar, volatile LAS unsigned* st) {
    XcdBarrier b; b.bar = bar; b.x = xb_xcc_id(); b.st = st;
    if (threadIdx.x == 0) (void)xb_add(&bar[XB_XCNT(b.x)], 1u);
    return b;
}
__device__ __forceinline__ void xcd_barrier_complete(unsigned* bar, unsigned x, unsigned& nloc, unsigned& nx) {
    const unsigned G = gridDim.x * gridDim.y * gridDim.z;
    unsigned sum, cnt, mine, sp = 0u;
    for (;;) {
        sum = 0u; cnt = 0u; mine = 0u;
#pragma unroll
        for (unsigned j = 0; j < 16; ++j) { const unsigned c = xb_ld(&bar[XB_XCNT(j)]); sum += c; cnt += (c > 0u) ? 1u : 0u; mine = (j == x) ? c : mine; }
        if (sum == G) break;
        __builtin_amdgcn_s_sleep(1);
        if ((++sp & 255u) == 0u) { if (xb_ld(&bar[XB_TMO])) break; if (sp > XB_SPIN_CAP) { atomicAdd(&bar[XB_TMO], 1u); break; } }
    }
    nloc = mine > 0u ? mine : 1u; nx = cnt > 0u ? cnt : 1u;
}
__device__ __forceinline__ void xcd_barrier(const XcdBarrier& b) {
    asm volatile("s_waitcnt vmcnt(0)" ::: "memory");
    __syncthreads();
    if (threadIdx.x == 0) {
        unsigned* bar = b.bar;
        __builtin_amdgcn_s_waitcnt(0);
        unsigned nloc = b.st[0], nx = b.st[1];
        if (nloc == 0u) { xcd_barrier_complete(bar, b.x, nloc, nx); b.st[0] = nloc; b.st[1] = nx; }
        const unsigned old = xb_add(&bar[XB_XSUB(b.x)], 1u);
        const unsigned gen = old / nloc;
        if (old + 1u == (gen + 1u) * nloc) {
            __builtin_amdgcn_fence(__ATOMIC_RELEASE, "agent");
            asm volatile("s_waitcnt vmcnt(0)" ::: "memory");
            const unsigned og = xb_add(&bar[XB_TOP], 1u);
            const unsigned tg = og / nx;
            if (og + 1u == (tg + 1u) * nx) xb_add(&bar[XB_TOPGEN], 1u);
            else XB_SPIN(xb_ld(&bar[XB_TOPGEN]) == tg, bar);
            __builtin_amdgcn_fence(__ATOMIC_ACQUIRE, "agent");
            xb_add(&bar[XB_XGEN(b.x)], 1u);
            asm volatile("s_waitcnt vmcnt(0)" ::: "memory");
        } else {
            XB_SPIN(xb_ld(&bar[XB_XGEN(b.x)]) == gen, bar);
            __builtin_amdgcn_fence(__ATOMIC_ACQUIRE, "agent");
            asm volatile("s_waitcnt vmcnt(0)" ::: "memory");
        }
    }
    __syncthreads();
}

__device__ __forceinline__ u16 f2bf(float f) { unsigned u = __float_as_uint(f); u += 0x7FFFu + ((u >> 16) & 1u); return (u16)(u >> 16); }
__device__ __forceinline__ float bf2f(u16 h) { return __uint_as_float((unsigned)h << 16); }
__device__ __forceinline__ unsigned cvtpk(float lo, float hi) { unsigned r; asm volatile("v_cvt_pk_bf16_f32 %0, %1, %2" : "=v"(r) : "v"(lo), "v"(hi)); return r; }
__device__ __forceinline__ float wave_sum(float v) {
#pragma unroll
    for (int o = 32; o; o >>= 1) v += __shfl_xor(v, o);
    return v;
}
__device__ __forceinline__ float wave_max_fast(float v) {
#define DPP_MAX(v, CTRL) (v) = fmaxf((v), __uint_as_float(__builtin_amdgcn_update_dpp(0u, __float_as_uint(v), (CTRL), 0xF, 0xF, false)))
    DPP_MAX(v, 0xB1); DPP_MAX(v, 0x4E); DPP_MAX(v, 0x141); DPP_MAX(v, 0x140);
#undef DPP_MAX
    { auto rr = __builtin_amdgcn_permlane16_swap(__float_as_uint(v), __float_as_uint(v), false, false); v = fmaxf(__uint_as_float(rr[0]), __uint_as_float(rr[1])); }
    { auto rr = __builtin_amdgcn_permlane32_swap(__float_as_uint(v), __float_as_uint(v), false, false); v = fmaxf(__uint_as_float(rr[0]), __uint_as_float(rr[1])); }
    return v;
}
__device__ __forceinline__ float sum_fq(float v) {
    { auto rr = __builtin_amdgcn_permlane16_swap(__float_as_uint(v), __float_as_uint(v), false, false); v = __uint_as_float(rr[0]) + __uint_as_float(rr[1]); }
    { auto rr = __builtin_amdgcn_permlane32_swap(__float_as_uint(v), __float_as_uint(v), false, false); v = __uint_as_float(rr[0]) + __uint_as_float(rr[1]); }
    return v;
}
__device__ __forceinline__ void atomic_fmax_pos(unsigned* p, float v) { atomicMax(p, __float_as_uint(v)); }
__device__ __forceinline__ int crow(int r, int hi) { return (r & 3) + 8 * (r >> 2) + 4 * hi; }
__device__ __forceinline__ void row_bp(int row, int& b, int& pos) {
    if (row < NCTX) { b = row >> 8; pos = row & 255; } else { const int r = row - NCTX; b = r >> 13; pos = CTXL + (r & (SEQ - 1)); }
}
__device__ __forceinline__ float silu_f(float x) { return x / (1.f + __expf(-x)); }
#define SBAR() __builtin_amdgcn_sched_barrier(0)

struct Params { const float* in[31]; float* out; unsigned char* ws; int ph_lo, ph_hi; };

struct RowsPlain  { const u16* base; long ld;
    __device__ __forceinline__ long off(int r) const { return (long)r * ld; }
    __device__ __forceinline__ const u16* kbase(int kt) const { return base + kt * 64; } };
struct RowsGather { const u16* base; long ld; const int* idx;
    __device__ __forceinline__ long off(int r) const { int t = idx[r]; t = t < 0 ? 0 : t; return (long)t * ld; }
    __device__ __forceinline__ const u16* kbase(int kt) const { return base + kt * 64; } };
struct RowsSplitK { const u16* b0; const u16* b1; long ld; int ks;
    __device__ __forceinline__ long off(int r) const { return (long)r * ld; }
    __device__ __forceinline__ const u16* kbase(int kt) const { return kt < ks ? b0 + kt * 64 : b1 + (kt - ks) * 64; } };

constexpr int GEMM_LDS = 2 * 384 * 128;

template <int WM, int WN, class AL, class BL, class EP>
__device__ __forceinline__ void gemm_tile(char* lds, const AL al, const BL bl, EP& ep, int brow, int bcol, int nk) {
    constexpr int BM = WM * 64, BN = WN * 64, STG = (BM + BN) * 128, NA = BM / 64, NB = BN / 64;
    const int tid = threadIdx.x, lane = tid & 63, wid = __builtin_amdgcn_readfirstlane(tid >> 6);
    const int wm = wid / WN, wn = wid % WN, r32 = lane & 31, hi = lane >> 5;
    long aoff[NA], boff[NB];
#pragma unroll
    for (int i = 0; i < NA; ++i) { const int r = (i * 8 + wid) * 8 + (lane >> 3); const int c = (lane & 7) ^ ((r >> 1) & 7); aoff[i] = al.off(brow + r) + c * 8; }
#pragma unroll
    for (int i = 0; i < NB; ++i) { const int r = (i * 8 + wid) * 8 + (lane >> 3); const int c = (lane & 7) ^ ((r >> 1) & 7); boff[i] = bl.off(bcol + r) + c * 8; }
    const int ldsw = wid * 1024 + lane * 16;
    int abase[2], bbase[2];
#pragma unroll
    for (int i = 0; i < 2; ++i) {
        const int ra = wm * 64 + i * 32 + r32; abase[i] = ra * 128 + ((hi ^ ((ra >> 1) & 7)) << 4);
        const int rb = wn * 64 + i * 32 + r32; bbase[i] = BM * 128 + rb * 128 + ((hi ^ ((rb >> 1) & 7)) << 4);
    }
    f32x16 acc[2][2];
#pragma unroll
    for (int i = 0; i < 2; ++i)
#pragma unroll
        for (int j = 0; j < 2; ++j) acc[i][j] = f32x16{};
#define GSTAGE(kt, buf) do { const u16* _ka = al.kbase(kt); const u16* _kb = bl.kbase(kt); char* _d = lds + (buf) * STG + ldsw; \
        _Pragma("unroll") for (int _i = 0; _i < NA; ++_i) __builtin_amdgcn_global_load_lds((const unsigned*)(_ka + aoff[_i]), (unsigned*)(_d + _i * 8192), 16, 0, 0); \
        _Pragma("unroll") for (int _i = 0; _i < NB; ++_i) __builtin_amdgcn_global_load_lds((const unsigned*)(_kb + boff[_i]), (unsigned*)(_d + BM * 128 + _i * 8192), 16, 0, 0); } while (0)
    __syncthreads();
    GSTAGE(0, 0);
    for (int kt = 0; kt < nk; ++kt) {
        asm volatile("s_waitcnt vmcnt(0)" ::: "memory");
        __syncthreads();
        if (kt + 1 < nk) GSTAGE(kt + 1, (kt + 1) & 1);
        const char* sb = lds + (kt & 1) * STG;
#pragma unroll
        for (int ks = 0; ks < 4; ++ks) {
            bf16x8 a0 = *(const bf16x8*)(sb + (abase[0] ^ (ks << 5)));
            bf16x8 a1 = *(const bf16x8*)(sb + (abase[1] ^ (ks << 5)));
            bf16x8 b0 = *(const bf16x8*)(sb + (bbase[0] ^ (ks << 5)));
            bf16x8 b1 = *(const bf16x8*)(sb + (bbase[1] ^ (ks << 5)));
            acc[0][0] = __builtin_amdgcn_mfma_f32_32x32x16_bf16(a0, b0, acc[0][0], 0, 0, 0);
            acc[0][1] = __builtin_amdgcn_mfma_f32_32x32x16_bf16(a0, b1, acc[0][1], 0, 0, 0);
            acc[1][0] = __builtin_amdgcn_mfma_f32_32x32x16_bf16(a1, b0, acc[1][0], 0, 0, 0);
            acc[1][1] = __builtin_amdgcn_mfma_f32_32x32x16_bf16(a1, b1, acc[1][1], 0, 0, 0);
        }
    }
#undef GSTAGE
    ep(acc, brow + wm * 64, bcol + wn * 64, lane);
}


constexpr int GSTG = 384 * 128;
template <class AL_, class BL_, class EP_> struct GTile { typedef EP_ EPT; AL_ al; BL_ bl; EP_ ep; int brow, bcol; };
__device__ __forceinline__ bool tile_seq(int i, int bx, int G, int nM, int nN, int& m, int& n) {
    const int s = (G == 256) ? (i * 8 + (bx & 7)) * 32 + (bx >> 3) : bx + i * G;
    if (s >= nM * nN) return false;
    const int full = (nM >> 2) * 4 * nN;
    if (s < full) { const int band = s / (4 * nN), rem = s - band * 4 * nN; n = rem >> 2; m = band * 4 + (rem & 3); }
    else { const int h = nM & 3, rem = s - full; n = rem / h; m = (nM & ~3) + rem - n * h; }
    return true;
}
template <class AL_, class BL_, class EP_> struct PlainTiles {
    typedef GTile<AL_, BL_, EP_> Tile; static constexpr bool EP_CONST = true;
    AL_ al; BL_ bl; EP_ ep; int mt0, nM, nN, bx, G;
    __device__ __forceinline__ bool get(int i, Tile& t) const {
        int m, n; if (!tile_seq(i, bx, G, nM, nN, m, n)) return false;
        t.al = al; t.bl = bl; t.ep = ep; t.brow = (mt0 + m) * 256; t.bcol = n * 128; return true; }
};
template <int WM, int WN, class P>
__device__ __forceinline__ void gemm_stream(char* lds, const P& prov, int nk) {
    constexpr int BM = WM * 64, BN = WN * 64, NA = BM / 64, NB = BN / 64;
    static_assert(NA + NB == 6, "the counted wait assumes six LDS-DMA loads per wave per K-step");
    const int tid = threadIdx.x, lane = tid & 63, wid = __builtin_amdgcn_readfirstlane(tid >> 6);
    const int wm = wid / WN, wn = wid % WN, r32 = lane & 31, hi = lane >> 5;
    typename P::Tile cur, nxt;
    if (!prov.get(0, cur)) return;
    unsigned aoff[NA], boff[NB], aoffn[NA], boffn[NB];
#define GOFFS(T, AO, BO) do { \
    _Pragma("unroll") for (int _i = 0; _i < NA; ++_i) { const int _r = (_i * 8 + wid) * 8 + (lane >> 3); const int _c = (lane & 7) ^ ((_r >> 1) & 7); AO[_i] = (unsigned)((T).al.off((T).brow + _r) + _c * 8); } \
    _Pragma("unroll") for (int _i = 0; _i < NB; ++_i) { const int _r = (_i * 8 + wid) * 8 + (lane >> 3); const int _c = (lane & 7) ^ ((_r >> 1) & 7); BO[_i] = (unsigned)((T).bl.off((T).bcol + _r) + _c * 8); } } while (0)
#define GSTAGE2(T, AO, BO, kt, slot) do { const u16* _ka = (T).al.kbase(kt); const u16* _kb = (T).bl.kbase(kt); char* _d = lds + (slot) * GSTG + ldsw; \
        _Pragma("unroll") for (int _i = 0; _i < NA; ++_i) __builtin_amdgcn_global_load_lds((const unsigned*)(_ka + AO[_i]), (unsigned*)(_d + _i * 8192), 16, 0, 0); \
        _Pragma("unroll") for (int _i = 0; _i < NB; ++_i) __builtin_amdgcn_global_load_lds((const unsigned*)(_kb + BO[_i]), (unsigned*)(_d + BM * 128 + _i * 8192), 16, 0, 0); } while (0)
    GOFFS(cur, aoff, boff);
    const int ldsw = wid * 1024 + lane * 16;
    int abase[2], bbase[2];
#pragma unroll
    for (int i = 0; i < 2; ++i) {
        const int ra = wm * 64 + i * 32 + r32; abase[i] = ra * 128 + ((hi ^ ((ra >> 1) & 7)) << 4);
        const int rb = wn * 64 + i * 32 + r32; bbase[i] = BM * 128 + rb * 128 + ((hi ^ ((rb >> 1) & 7)) << 4);
    }
    f32x16 acc[2][2];
#pragma unroll
    for (int i = 0; i < 2; ++i)
#pragma unroll
        for (int j = 0; j < 2; ++j) acc[i][j] = f32x16{};
    __syncthreads();
    GSTAGE2(cur, aoff, boff, 0, 0); GSTAGE2(cur, aoff, boff, 1, 1);
    int slot = 0; bool pendE = false; typename P::Tile::EPT pep = cur.ep; int pbrow = 0, pbcol = 0;
    for (int i = 0;; ++i) {
        const bool has_next = prov.get(i + 1, nxt);
        if (has_next) GOFFS(nxt, aoffn, boffn);
        for (int kt = 0; kt < nk; ++kt) {
            if ((kt + 1 < nk) || has_next) asm volatile("s_waitcnt vmcnt(6)" ::: "memory"); else asm volatile("s_waitcnt vmcnt(0)" ::: "memory");
            __builtin_amdgcn_s_barrier(); asm volatile("" ::: "memory");
            const int s2 = slot >= 1 ? slot - 1 : 2;
            if (kt + 2 < nk) GSTAGE2(cur, aoff, boff, kt + 2, s2); else if (has_next) GSTAGE2(nxt, aoffn, boffn, kt + 2 - nk, s2);
            if (kt == 0 && pendE) {
                if constexpr (P::EP_CONST) (void)prov.ep(acc, pbrow + wm * 64, pbcol + wn * 64, lane); else (void)pep(acc, pbrow + wm * 64, pbcol + wn * 64, lane);
                pendE = false;
#pragma unroll
                for (int a = 0; a < 2; ++a)
#pragma unroll
                    for (int b = 0; b < 2; ++b) acc[a][b] = f32x16{};
            }
            const char* sb = lds + slot * GSTG;
#pragma unroll
            for (int ks = 0; ks < 4; ++ks) {
                bf16x8 a0 = *(const bf16x8*)(sb + (abase[0] ^ (ks << 5)));
                bf16x8 a1 = *(const bf16x8*)(sb + (abase[1] ^ (ks << 5)));
                bf16x8 b0 = *(const bf16x8*)(sb + (bbase[0] ^ (ks << 5)));
                bf16x8 b1 = *(const bf16x8*)(sb + (bbase[1] ^ (ks << 5)));
                acc[0][0] = __builtin_amdgcn_mfma_f32_32x32x16_bf16(b0, a0, acc[0][0], 0, 0, 0);
                acc[0][1] = __builtin_amdgcn_mfma_f32_32x32x16_bf16(b1, a0, acc[0][1], 0, 0, 0);
                acc[1][0] = __builtin_amdgcn_mfma_f32_32x32x16_bf16(b0, a1, acc[1][0], 0, 0, 0);
                acc[1][1] = __builtin_amdgcn_mfma_f32_32x32x16_bf16(b1, a1, acc[1][1], 0, 0, 0);
            }
            slot = slot == 2 ? 0 : slot + 1;
        }
        if (!has_next) { (void)cur.ep(acc, cur.brow + wm * 64, cur.bcol + wn * 64, lane); break; }
        if constexpr (!P::EP_CONST) pep = cur.ep;
        pbrow = cur.brow; pbcol = cur.bcol; pendE = true;
        cur = nxt;
#pragma unroll
        for (int a = 0; a < NA; ++a) aoff[a] = aoffn[a];
#pragma unroll
        for (int b = 0; b < NB; ++b) boff[b] = boffn[b];
    }
    asm volatile("s_waitcnt vmcnt(0)" ::: "memory");
    __syncthreads();
#undef GOFFS
#undef GSTAGE2
}


template <int NF> __device__ __forceinline__ void rope_cs(int n, int i, float& cs, float& sn) {
    const int fi = i & (NF - 1); const float pos = (i < NF) ? (float)(n >> 6) : (float)(n & 63);
    const float invf = __builtin_amdgcn_exp2f(-(float)fi / (float)NF * 13.287712379549449f);
    const float ang = pos * invf; float rev = ang * 0.15915494309189535f; rev -= floorf(rev);
    cs = __builtin_amdgcn_cosf(rev); sn = __builtin_amdgcn_sinf(rev);
}
namespace pg8 {
constexpr int BM = 256, BK = 64, HALF = 128, HTB = HALF * BK * 2, STAGE_BYTES = 8 * HTB;
__device__ __forceinline__ int lds_byte(int r, int c) { const int st = (r >> 4) * 2 + (c >> 5), rr = r & 15, cc = c & 31, ob = rr * 64 + cc * 2; return st * 1024 + (ob ^ (((ob >> 9) & 1) << 5)); }
__device__ __forceinline__ void stage_rc(int b, int& R, int& C) { const int st = b / 1024, sb = b % 1024, swz = sb ^ (((sb >> 9) & 1) << 5); R = (st >> 1) * 16 + swz / 64; C = (st & 1) * 32 + (swz % 64) / 2; }
struct Unit { int pm, pn; };
template <class Epi, class Sched>
__device__ __forceinline__ void gemm_phase(char* lds, int lda, int K, const Sched& S, const Epi& E) {
    constexpr bool GA = Sched::GATHER, SK = Sched::SPLITK;
    const int tid = threadIdx.x, wid = __builtin_amdgcn_readfirstlane(tid >> 6), lane = tid & 63, wr = wid >> 2, wc = wid & 3, fr = lane & 15, fq = lane >> 4;
    const int nt = K / BK, ldb = SK ? (K >> 1) : K;
    unsigned voffB[2], vbA[2], vc0[2], vc1[2], vn0[2], vn1[2]; int sR[2], sC[2];
#pragma unroll
    for (int i = 0; i < 2; ++i) { stage_rc(tid * 16 + i * 8192, sR[i], sC[i]); voffB[i] = (unsigned)(sR[i] * ldb + sC[i]) * 2u; vbA[i] = (unsigned)(sR[i] * lda + sC[i]) * 2u; }
    const size_t kstep = (size_t)(BK * 2), hstep = (size_t)HALF * ldb * 2, hstepA = (size_t)HALF * lda * 2;
    const unsigned ldsw = (unsigned)wid * 1024u;
    const int aoff = lds_byte(wr * 64 + fr, fq * 8), boff = lds_byte(wc * 32 + fr, fq * 8);
#define PG8_AOFFS(u, v0, v1) do { _Pragma("unroll") for (int _i = 0; _i < 2; ++_i) { \
        if constexpr (GA) { v0[_i] = (unsigned)S.arow(u, sR[_i]) * (unsigned)(lda * 2) + (unsigned)sC[_i] * 2u; v1[_i] = (unsigned)S.arow(u, HALF + sR[_i]) * (unsigned)(lda * 2) + (unsigned)sC[_i] * 2u; } \
        else { v0[_i] = vbA[_i] + (unsigned)(u).pm * (unsigned)(256 * lda * 2); v1[_i] = v0[_i] + (unsigned)hstepA; } } } while (0)
#define PG8_SA(b, h) (((b) * 2 + (h)) * HTB)
#define PG8_SB(b, h) ((4 + (b) * 2 + (h)) * HTB)
#define PG8_STAGE(bufoff, gbase, voff) do { _Pragma("unroll") for (int _i = 0; _i < 2; ++_i) \
        __builtin_amdgcn_global_load_lds((const unsigned*)((const char*)(gbase) + (voff)[_i]), (unsigned*)(lds + (bufoff) + ldsw + _i * 8192), 16, 0, 0); } while (0)
#define PG8_STA(bufoff, kt, h, nx) do { const char* _g = ((nx) ? nAb : cAb) + (size_t)(kt) * kstep; unsigned _v[2]; \
        _Pragma("unroll") for (int _i = 0; _i < 2; ++_i) _v[_i] = (nx) ? ((h) ? vn1[_i] : vn0[_i]) : ((h) ? vc1[_i] : vc0[_i]); PG8_STAGE(bufoff, _g, _v); } while (0)
#define PG8_LDA(dst, b, h) do { _Pragma("unroll") for (int m = 0; m < 4; ++m) _Pragma("unroll") for (int k = 0; k < 2; ++k) dst[m][k] = *(const bf16x8*)(lds + PG8_SA(b, h) + aoff + m * 2048 + k * 1024); } while (0)
#define PG8_LDB(dst, b, h) do { _Pragma("unroll") for (int n = 0; n < 2; ++n) _Pragma("unroll") for (int k = 0; k < 2; ++k) dst[n][k] = *(const bf16x8*)(lds + PG8_SB(b, h) + boff + n * 2048 + k * 1024); } while (0)
#define PG8_MMA(ai, bj, At, Bt_) do { __builtin_amdgcn_s_setprio(1); _Pragma("unroll") for (int m = 0; m < 4; ++m) _Pragma("unroll") for (int n = 0; n < 2; ++n) _Pragma("unroll") for (int k = 0; k < 2; ++k) \
        acc[ai][bj][m][n] = __builtin_amdgcn_mfma_f32_16x16x32_bf16(Bt_[n][k], At[m][k], acc[ai][bj][m][n], 0, 0, 0); __builtin_amdgcn_s_setprio(0); } while (0)
#define PG8_WAIT_V(n) asm volatile("s_waitcnt vmcnt(" #n ")" ::: "memory")
#define PG8_WAIT_L(n) asm volatile("s_waitcnt lgkmcnt(" #n ")" ::: "memory")
#define PG8_BAR __builtin_amdgcn_s_barrier()
#define PG8_SCHED __builtin_amdgcn_sched_barrier(0)
    Unit cur, nxt; int ui = 0;
    if (!S.next(0, cur)) return;
    f32x4 acc[2][2][4][2];
#pragma unroll
    for (int a = 0; a < 2; ++a)
#pragma unroll
        for (int b = 0; b < 2; ++b)
#pragma unroll
            for (int m = 0; m < 4; ++m)
#pragma unroll
                for (int n = 0; n < 2; ++n) acc[a][b][m][n] = (f32x4){0.f, 0.f, 0.f, 0.f};
    bf16x8 At[4][2], B0[2][2], B1[2][2];
    PG8_AOFFS(cur, vc0, vc1);
    const char* cB = (const char*)S.bbase(cur); const char* cAb = (const char*)S.abase(cur); const char* nAb = cAb;
    long dB = 0; if constexpr (SK) dB = (const char*)S.bbase1(cur) - cB - (long)(nt >> 1) * (long)kstep;
    __syncthreads();
    PG8_STAGE(PG8_SB(0, 0), cB, voffB); PG8_STA(PG8_SA(0, 0), 0, 0, false); PG8_STAGE(PG8_SB(0, 1), cB + hstep, voffB); PG8_STA(PG8_SA(0, 1), 0, 1, false);
    if (wr == 1) PG8_BAR;
    PG8_WAIT_V(4); PG8_BAR;
    PG8_STAGE(PG8_SB(1, 0), cB + kstep, voffB); PG8_STA(PG8_SA(1, 0), 1, 0, false); PG8_STAGE(PG8_SB(1, 1), cB + hstep + kstep, voffB);
    PG8_WAIT_V(6); PG8_BAR;
    for (;;) {
        const bool has_next = S.next(ui + 1, nxt);
        const char* nB = cB; long ndB = dB;
        nAb = cAb;
        if (has_next) { PG8_AOFFS(nxt, vn0, vn1); nB = (const char*)S.bbase(nxt); nAb = (const char*)S.abase(nxt);
            if constexpr (SK) ndB = (const char*)S.bbase1(nxt) - nB - (long)(nt >> 1) * (long)kstep; }
        else {
#pragma unroll
            for (int i = 0; i < 2; ++i) { vn0[i] = vc0[i]; vn1[i] = vc1[i]; } }
#pragma unroll 1
        for (int t = 0; t < nt; t += 2) {
            const bool last = (t == nt - 2);
            const int k2 = last ? 0 : t + 2, k3 = k2 + 1;
            const char* b2 = last ? nB : cB + (size_t)(t + 2) * kstep + ((SK && t + 2 >= (nt >> 1)) ? dB : 0L); const char* b3 = b2 + kstep;
            PG8_LDB(B0, 0, 0); PG8_SCHED; PG8_LDA(At, 0, 0); PG8_STA(PG8_SA(1, 1), t + 1, 1, false);
            PG8_WAIT_L(8); PG8_BAR; PG8_WAIT_L(0); PG8_MMA(0, 0, At, B0); PG8_BAR; PG8_SCHED;
            PG8_LDB(B1, 0, 1); PG8_STAGE(PG8_SB(0, 0), b2, voffB);
            PG8_BAR; PG8_WAIT_L(0); PG8_MMA(0, 1, At, B1); PG8_BAR;
            PG8_LDA(At, 0, 1); PG8_STA(PG8_SA(0, 0), k2, 0, last);
            PG8_BAR; PG8_WAIT_L(0); PG8_MMA(1, 0, At, B0); PG8_BAR; PG8_SCHED;
            PG8_STAGE(PG8_SB(0, 1), b2 + hstep, voffB);
            PG8_WAIT_V(6); PG8_BAR; PG8_MMA(1, 1, At, B1); PG8_BAR;
            PG8_LDB(B0, 1, 0); PG8_SCHED; PG8_LDA(At, 1, 0); PG8_STA(PG8_SA(0, 1), k2, 1, last);
            PG8_WAIT_L(8); PG8_BAR; PG8_WAIT_L(0); PG8_MMA(0, 0, At, B0); PG8_BAR; PG8_SCHED;
            PG8_LDB(B1, 1, 1); PG8_STAGE(PG8_SB(1, 0), b3, voffB);
            PG8_BAR; PG8_WAIT_L(0); PG8_MMA(0, 1, At, B1); PG8_BAR;
            PG8_LDA(At, 1, 1); PG8_STA(PG8_SA(1, 0), k3, 0, last);
            PG8_BAR; PG8_WAIT_L(0); PG8_MMA(1, 0, At, B0); PG8_BAR; PG8_SCHED;
            PG8_STAGE(PG8_SB(1, 1), b3 + hstep, voffB);
            PG8_WAIT_V(6); PG8_BAR; PG8_MMA(1, 1, At, B1); PG8_BAR;
        }
        E(acc, cur, wr, wc, fr, fq);
        if (!has_next) break;
#pragma unroll
        for (int a = 0; a < 2; ++a)
#pragma unroll
            for (int b = 0; b < 2; ++b)
#pragma unroll
                for (int m = 0; m < 4; ++m)
#pragma unroll
                    for (int n = 0; n < 2; ++n) acc[a][b][m][n] = (f32x4){0.f, 0.f, 0.f, 0.f};
        cur = nxt; cB = nB; cAb = nAb; dB = ndB; ++ui;
#pragma unroll
        for (int i = 0; i < 2; ++i) { vc0[i] = vn0[i]; vc1[i] = vn1[i]; }
    }
    PG8_WAIT_V(0);
    if (wr == 0) PG8_BAR;
    PG8_BAR;
#undef PG8_AOFFS
#undef PG8_STA
#undef PG8_SA
#undef PG8_SB
#undef PG8_STAGE
#undef PG8_LDA
#undef PG8_LDB
#undef PG8_MMA
#undef PG8_WAIT_V
#undef PG8_WAIT_L
#undef PG8_BAR
#undef PG8_SCHED
}
struct SeqOrder { static constexpr bool GATHER = false, SPLITK = false; const u16* A; const u16* Bt; int K, nM, nN, bx, G, mt0;
    __device__ __forceinline__ const u16* abase(const Unit&) const { return A; }
    __device__ __forceinline__ bool next(int i, Unit& u) const { const bool ok = tile_seq(i, bx, G, nM, nN, u.pm, u.pn); u.pm += mt0; return ok; }
    __device__ __forceinline__ const u16* bbase(const Unit& u) const { return Bt + (size_t)u.pn * 256 * K; }
    __device__ __forceinline__ int arow(const Unit& u, int r) const { return u.pm * 256 + r; } };
struct EpiGlaIn8 { u16* q; u16* k; u16* v; u16* g; float* z;
    __device__ __forceinline__ void operator()(const f32x4 (&acc)[2][2][4][2], const Unit& u, int wr, int wc, int fr, int fq) const {
#pragma unroll
        for (int bj = 0; bj < 2; ++bj)
#pragma unroll
            for (int n = 0; n < 2; ++n) { const int c0 = u.pn * 256 + bj * 128 + wc * 32 + n * 16, col = c0 + 4 * fq;
                if (c0 >= 3104) continue;
                u16* base; int ld, cc; float scl = 1.f;
                if (c0 < 512) { base = q; ld = 512; cc = col; scl = 0.08838834764831845f; } else if (c0 < 1024) { base = k; ld = 512; cc = col - 512; }
                else if (c0 < 2048) { base = v; ld = 1024; cc = col - 1024; } else if (c0 < 3072) { base = g; ld = 1024; cc = col - 2048; } else { base = nullptr; ld = 32; cc = col - 3072; }
#pragma unroll
                for (int ai = 0; ai < 2; ++ai)
#pragma unroll
                    for (int m = 0; m < 4; ++m) { const size_t row = (size_t)u.pm * 256 + ai * 128 + wr * 64 + m * 16 + fr; const f32x4 a = acc[ai][bj][m][n];
                        if (c0 < 3072) { u32x2 w = {cvtpk(a[0] * scl, a[1] * scl), cvtpk(a[2] * scl, a[3] * scl)}; *(u32x2*)(base + row * ld + cc) = w; }
                        else *(f32x4*)(z + row * 32 + cc) = a; } }
    } };
struct EpiDiffQKV8 { u16* Q; long kdelta; u16* V; float qscale; unsigned* km;
    __device__ __forceinline__ void operator()(const f32x4 (&acc)[2][2][4][2], const Unit& u, int wr, int wc, int fr, int fq) const {
        float kmx = 0.f;
#pragma unroll
        for (int ai = 0; ai < 2; ++ai)
#pragma unroll
            for (int m = 0; m < 4; ++m) { int frr = fr; asm volatile("" : "+v"(frr));
                const int row = u.pm * 256 + ai * 128 + wr * 64 + m * 16 + frr; int b, pos; row_bp(row, b, pos); const bool lat = row >= NCTX; const int np = (row - NCTX) & (SEQ - 1);
                if (u.pn < 8) { const int region = u.pn >> 2, hh = (u.pn & 3) * 4 + wc; const float scl = region == 0 ? qscale : 1.f; float ks2 = 0.f;
                    u16* o = Q + (long)region * kdelta + ((size_t)(b * 16 + hh) * KEYS + pos) * 64;
#pragma unroll
                    for (int n = 0; n < 2; ++n) { const int d0 = 16 * n + 4 * fq; const f32x4 t1 = acc[ai][0][m][n], t2 = acc[ai][1][m][n]; float o1[4], o2[4];
#pragma unroll
                        for (int j = 0; j < 4; ++j) { float cs = 1.f, sn = 0.f; if (lat) rope_cs<16>(np, d0 + j, cs, sn); o1[j] = (t1[j] * cs - t2[j] * sn) * scl; o2[j] = (t1[j] * sn + t2[j] * cs) * scl; }
                        u32x2 w1 = {cvtpk(o1[0], o1[1]), cvtpk(o1[2], o1[3])}, w2 = {cvtpk(o2[0], o2[1]), cvtpk(o2[2], o2[3])};
                        *(u32x2*)(o + d0) = w1; *(u32x2*)(o + 32 + d0) = w2;
#pragma unroll
                        for (int j = 0; j < 4; ++j) ks2 += o1[j] * o1[j] + o2[j] * o2[j]; }
                    kmx = fmaxf(kmx, ks2);
                } else {
#pragma unroll
                    for (int bj = 0; bj < 2; ++bj) { const int head = (u.pn - 8) * 2 + bj; u16* o = V + ((size_t)(b * 8 + head) * KEYS + pos) * 128 + wc * 32 + 4 * fq;
#pragma unroll
                        for (int n = 0; n < 2; ++n) { const f32x4 a = acc[ai][bj][m][n]; u32x2 w = {cvtpk(a[0], a[1]), cvtpk(a[2], a[3])}; *(u32x2*)(o + 16 * n) = w; } }
                } }
        if (u.pn >= 4 && u.pn < 8) {
            const int b = u.pm < 4 ? u.pm : ((u.pm - 4) >> 5); const float v = wave_max_fast(sum_fq(kmx));
            if (fr == 0 && fq == 0) atomic_fmax_pos(km + ((b * 16 + (u.pn & 3) * 4 + wc) * 2), v); }
    } };
struct MoeAOrder { static constexpr bool GATHER = true, SPLITK = false; const u16* A; const int* tab; const int* rowtok; const u16* wgu; int nmt, bx, G;
    __device__ __forceinline__ const u16* abase(const Unit&) const { return A; }
    __device__ __forceinline__ bool next(int i, Unit& u) const { return tile_seq(i, bx, G, nmt, 8, u.pm, u.pn); }
    __device__ __forceinline__ const u16* bbase(const Unit& u) const {
        const int c = tab[32 + u.pm], g = c / 6, p = c - g * 6; const int elo = p < 3 ? 0 : (p < 5 ? 1 : 2), ehi = p < 3 ? p + 1 : (p < 5 ? p - 1 : 3);
        const int e = (u.pn >> 2) ? ehi : elo; return wgu + ((size_t)(g * 4 + e) * 1024 + (u.pn & 3) * 256) * 1024; }
    __device__ __forceinline__ int arow(const Unit& u, int r) const { const int t = rowtok[u.pm * 256 + r]; return t < 0 ? 0 : t; } };
struct EpiMoeA8 { u16* act; const float* roww;
    __device__ __forceinline__ void operator()(const f32x4 (&acc)[2][2][4][2], const Unit& u, int wr, int wc, int fr, int fq) const {
        const int half = u.pn >> 2, cb = half * 512 + (u.pn & 3) * 128 + wc * 32 + 4 * fq;
        float wv[8];
#pragma unroll
        for (int G = 0; G < 8; ++G) wv[G] = roww[2 * ((size_t)u.pm * 256 + (G >> 2) * 128 + wr * 64 + (G & 3) * 16 + fr) + half];
#pragma unroll
        for (int ai = 0; ai < 2; ++ai)
#pragma unroll
            for (int m = 0; m < 4; ++m) { const size_t row = (size_t)u.pm * 256 + ai * 128 + wr * 64 + m * 16 + fr; const float w = wv[ai * 4 + m];
#pragma unroll
                for (int n = 0; n < 2; ++n) { const f32x4 gt = acc[ai][0][m][n], up = acc[ai][1][m][n]; float v[4];
#pragma unroll
                    for (int j = 0; j < 4; ++j) v[j] = silu_f(gt[j]) * up[j] * w;
                    u32x2 pk = {cvtpk(v[0], v[1]), cvtpk(v[2], v[3])}; *(u32x2*)(act + row * 1024 + cb + 16 * n) = pk; } }
    } };
struct MlaUpOrder { static constexpr bool GATHER = false, SPLITK = false; const u16* CN; const u16* wuq; const u16* wukv; int bx, G;
    __device__ __forceinline__ bool next(int i, Unit& u) const { return tile_seq(i, bx, G, 132, 14, u.pm, u.pn); }
    __device__ __forceinline__ const u16* abase(const Unit& u) const { return u.pn < 6 ? CN : CN + 256; }
    __device__ __forceinline__ const u16* bbase(const Unit& u) const { return u.pn < 6 ? wuq + (size_t)u.pn * 256 * 256 : wukv + (size_t)(u.pn - 6) * 256 * 256; }
    __device__ __forceinline__ int arow(const Unit& u, int r) const { return u.pm * 256 + r; } };
struct EpiMlaUp8 { u16* Q; u16* Kn; long vdelta; float qscale; unsigned* km; const float* SS;
    __device__ __forceinline__ void operator()(const f32x4 (&acc)[2][2][4][2], const Unit& u, int wr, int wc, int fr, int fq) const {
        float kmx[2] = {0.f, 0.f}, rv[8];
#pragma unroll
        for (int G = 0; G < 8; ++G) {
            const f32x4 ssq = *(const f32x4*)(SS + (size_t)(u.pm * 256 + (G >> 2) * 128 + wr * 64 + (G & 3) * 16 + fr) * 8 + (u.pn < 6 ? 0 : 4));
            rv[G] = rsqrtf((ssq[0] + ssq[1] + ssq[2] + ssq[3]) * (1.f / 256.f) + EPS); }
#pragma unroll
        for (int ai = 0; ai < 2; ++ai)
#pragma unroll
            for (int m = 0; m < 4; ++m) { int frr = fr; asm volatile("" : "+v"(frr));
                const int row = u.pm * 256 + ai * 128 + wr * 64 + m * 16 + frr; int b, pos; row_bp(row, b, pos); const bool lat = row >= NCTX; const int np = (row - NCTX) & (SEQ - 1);
                const float rinv = rv[ai * 4 + m];
                if (u.pn < 6) { const float qs = qscale * rinv;
#pragma unroll
                    for (int bj = 0; bj < 2; ++bj) { const int sb = 8 * u.pn + 4 * bj + wc, head = sb / 3, part = sb - head * 3;
                        f32x4 v0 = acc[ai][bj][m][0] * qs, v1 = acc[ai][bj][m][1] * qs;
                        if (part == 2 && lat) {
#pragma unroll
                            for (int j = 0; j < 4; ++j) { float cs, sn; rope_cs<8>(np, 4 * fq + j, cs, sn); const float t1 = v0[j], t2 = v1[j]; v0[j] = t1 * cs - t2 * sn; v1[j] = t1 * sn + t2 * cs; } }
                        u16* o = Q + ((size_t)(b * 16 + head) * KEYS + pos) * 96 + part * 32 + 4 * fq;
                        u32x2 w0 = {cvtpk(v0[0], v0[1]), cvtpk(v0[2], v0[3])}, w1 = {cvtpk(v1[0], v1[1]), cvtpk(v1[2], v1[3])}; *(u32x2*)o = w0; *(u32x2*)(o + 16) = w1; }
                } else {
#pragma unroll
                    for (int bj = 0; bj < 2; ++bj) { const int head = (u.pn - 6) * 2 + bj; u16* o = Kn + (long)(wc >> 1) * vdelta + ((size_t)(b * 16 + head) * KEYS + pos) * 64 + (wc & 1) * 32 + 4 * fq;
                        float s2 = 0.f;
#pragma unroll
                        for (int n = 0; n < 2; ++n) { const f32x4 a = acc[ai][bj][m][n] * rinv; u32x2 w = {cvtpk(a[0], a[1]), cvtpk(a[2], a[3])}; *(u32x2*)(o + 16 * n) = w;
                            s2 += a[0] * a[0] + a[1] * a[1] + a[2] * a[2] + a[3] * a[3]; }
                        kmx[bj] = fmaxf(kmx[bj], s2); }
                } }
        if (u.pn >= 6 && wc < 2) {
            const int b = u.pm < 4 ? u.pm : ((u.pm - 4) >> 5);
#pragma unroll
            for (int bj = 0; bj < 2; ++bj) { const float v = wave_max_fast(sum_fq(kmx[bj])); if (fr == 0 && fq == 0) atomic_fmax_pos(km + ((b * 16 + (u.pn - 6) * 2 + bj) * 2 + wc), v); }
        }
    } };
}

template <int DK, int DV> struct AttnCfg {
    static constexpr int NKB = DK / 32, NVB = DV / 32, ND0 = DK / 16;
    static constexpr int KBYTES = 64 * DK * 2, VBYTES = 64 * DV * 2;
    static constexpr int LDS = 2 * KBYTES + 2 * VBYTES + NWAVE * 64 * 4;
};
constexpr float ATT_THR = 8.f;

__device__ __forceinline__ void partialSM(f32x16& p0, f32x16& p1, float& m_reg, float& mn, float& alpha) {
    float pmax = p0[0];
#pragma unroll
    for (int r = 1; r < 16; ++r) pmax = fmaxf(pmax, p0[r]);
#pragma unroll
    for (int r = 0; r < 16; ++r) pmax = fmaxf(pmax, p1[r]);
    { auto rr = __builtin_amdgcn_permlane32_swap(__float_as_uint(pmax), __float_as_uint(pmax), false, false);
      pmax = fmaxf(__uint_as_float(rr[0]), __uint_as_float(rr[1])); }
    if (__builtin_expect(__all(pmax - m_reg <= ATT_THR), 1)) { mn = m_reg; alpha = 1.f; }
    else { mn = fmaxf(m_reg, pmax); alpha = __builtin_amdgcn_exp2f(m_reg - mn); m_reg = mn; }
#pragma unroll
    for (int r = 0; r < 16; ++r) p0[r] = p0[r] - mn;
#pragma unroll
    for (int r = 0; r < 16; ++r) p1[r] = p1[r] - mn;
#pragma unroll
    for (int r = 0; r < 16; ++r) p0[r] = __builtin_amdgcn_exp2f(p0[r]);
}
#define PK4(P, BASE, OUT) do { unsigned a0 = cvtpk(P[BASE + 0], P[BASE + 1]), a1 = cvtpk(P[BASE + 2], P[BASE + 3]);   \
    unsigned b0 = cvtpk(P[BASE + 4], P[BASE + 5]), b1 = cvtpk(P[BASE + 6], P[BASE + 7]);                              \
    auto r0 = __builtin_amdgcn_permlane32_swap(a0, b0, false, false); auto r1 = __builtin_amdgcn_permlane32_swap(a1, b1, false, false); \
    u32x4 w = {r0[0], r1[0], r0[1], r1[1]}; OUT = *reinterpret_cast<bf16x8*>(&w); } while (0)
__device__ __forceinline__ void finishSM(f32x16& p0, f32x16& p1, float alpha, float& l_reg, bf16x8& pa0, bf16x8& pa1, bf16x8& pa2, bf16x8& pa3) {
#pragma unroll
    for (int r = 0; r < 16; ++r) p1[r] = __builtin_amdgcn_exp2f(p1[r]);
    float ps = 0;
#pragma unroll
    for (int r = 0; r < 16; ++r) ps += p0[r];
#pragma unroll
    for (int r = 0; r < 16; ++r) ps += p1[r];
    { auto rr = __builtin_amdgcn_permlane32_swap(__float_as_uint(ps), __float_as_uint(ps), false, false);
      ps = __uint_as_float(rr[0]) + __uint_as_float(rr[1]); }
    l_reg = l_reg * alpha + ps;
    PK4(p0, 0, pa0); PK4(p0, 8, pa1); PK4(p1, 0, pa2); PK4(p1, 8, pa3);
}
__device__ __forceinline__ void psm_first(f32x16& p0, f32x16& p1, float bound, float& m_reg, f32x16& negm) {
    float pmax = fmaxf(p0[0], p1[0]);
#pragma unroll
    for (int r = 1; r < 16; ++r) pmax = fmaxf(pmax, fmaxf(p0[r], p1[r]));
    { auto rr = __builtin_amdgcn_permlane32_swap(__float_as_uint(pmax), __float_as_uint(pmax), false, false);
      pmax = fmaxf(__uint_as_float(rr[0]), __uint_as_float(rr[1])); }
    m_reg = fminf(bound, pmax + 64.f);
#pragma unroll
    for (int r = 0; r < 16; ++r) { p0[r] -= m_reg; p1[r] -= m_reg; negm[r] = -m_reg; }
#pragma unroll
    for (int r = 0; r < 16; ++r) p0[r] = __builtin_amdgcn_exp2f(p0[r]);
}
__device__ __forceinline__ void psm_fix(f32x16& p0) {
#pragma unroll
    for (int r = 0; r < 16; ++r) p0[r] = __builtin_amdgcn_exp2f(p0[r]);
}
template <bool FIRST, bool KEEPN>
__device__ __forceinline__ void psm_rel(f32x16& p0, f32x16& p1, float& m_reg, f32x16& negm, float& alpha) {
    float pmax = fmaxf(p0[0], p1[0]);
#pragma unroll
    for (int r = 1; r < 16; ++r) pmax = fmaxf(pmax, fmaxf(p0[r], p1[r]));
    { auto rr = __builtin_amdgcn_permlane32_swap(__float_as_uint(pmax), __float_as_uint(pmax), false, false);
      pmax = fmaxf(__uint_as_float(rr[0]), __uint_as_float(rr[1])); }
    alpha = 1.f;
    if (FIRST || !__builtin_expect(__all(pmax <= ATT_THR), 1)) {
        const float d = FIRST ? pmax : fmaxf(pmax, 0.f);
        if (!FIRST) alpha = __builtin_amdgcn_exp2f(-d);
        m_reg += d;
#pragma unroll
        for (int r = 0; r < 16; ++r) { p0[r] -= d; p1[r] -= d; if (KEEPN) negm[r] = -m_reg; }
    }
#pragma unroll
    for (int r = 0; r < 16; ++r) p0[r] = __builtin_amdgcn_exp2f(p0[r]);
}
__device__ __forceinline__ bf16x8 pack8(const f32x16& p, int base) {
    u32x4 w = {cvtpk(p[base], p[base + 1]), cvtpk(p[base + 2], p[base + 3]), cvtpk(p[base + 4], p[base + 5]), cvtpk(p[base + 6], p[base + 7])};
    return *reinterpret_cast<bf16x8*>(&w);
}
__device__ __forceinline__ void fsm_rel(f32x16& p0, f32x16& p1, bf16x8& pa0, bf16x8& pa1, bf16x8& pa2, bf16x8& pa3) {
#pragma unroll
    for (int r = 0; r < 16; ++r) p1[r] = __builtin_amdgcn_exp2f(p1[r]);
    pa0 = pack8(p0, 0); pa1 = pack8(p0, 8); pa2 = pack8(p1, 0); pa3 = pack8(p1, 8);
}
__device__ __forceinline__ int k_lds_off(int row, int blk, int chunk) { return blk * 4096 + row * 64 + ((chunk ^ ((row >> 2) & 3)) << 4); }
template <int ND0>
__device__ __forceinline__ void qkt(f32x16& p0, f32x16& p1, const char* Ks, const bf16x8* qr, int r32, int hi, const f32x16& cinit) {
    p0 = cinit; p1 = cinit;
#pragma unroll
    for (int d0 = 0; d0 < ND0; ++d0) {
        const int ch = (d0 & 1) * 2 + hi;
        bf16x8 b0 = *reinterpret_cast<const bf16x8*>(Ks + k_lds_off(r32, d0 >> 1, ch));
        bf16x8 b1 = *reinterpret_cast<const bf16x8*>(Ks + k_lds_off(32 + r32, d0 >> 1, ch));
        p0 = __builtin_amdgcn_mfma_f32_32x32x16_bf16(b0, qr[d0], p0, 0, 0, 0);
        p1 = __builtin_amdgcn_mfma_f32_32x32x16_bf16(b1, qr[d0], p1, 0, 0, 0);
    }
}
template <int NVB, bool SWAP = true> __device__ __forceinline__ int v_st(int k, int c) {
    const int kk = SWAP ? ((k & ~0xC) | ((k & 4) << 1) | ((k & 8) >> 1)) : k;
    return ((kk >> 3) * NVB + (c >> 5)) * 512 + ((kk & 7) * 32 + (c & 31)) * 2;
}
__device__ __forceinline__ int v_rd_base(int lane) { return ((lane & 3) << 3) | (((lane >> 2) & 3) << 6) | (((lane >> 4) & 1) << 5) | (((lane >> 5) & 1) << 8); }
template <int OFF> __device__ __forceinline__ s16x4 tr_read(int vb) {
    return __builtin_amdgcn_ds_read_tr16_b64_v4i16((LAS s16x4*)(unsigned)(vb + OFF));
}
#define PKV(L, H) (bf16x8){L[0], L[1], L[2], L[3], H[0], H[1], H[2], H[3]}
template <int D0, int NVB> __device__ __forceinline__ void pv_one(f32x16& od, int vb, bf16x8 pa0, bf16x8 pa1, bf16x8 pa2, bf16x8 pa3) {
    constexpr int KS = 2 * NVB * 512, HF = NVB * 512, B0 = D0 * 512;
    const s16x4 l0 = tr_read<B0 + 0 * KS>(vb), h0 = tr_read<B0 + 0 * KS + HF>(vb), l1 = tr_read<B0 + 1 * KS>(vb), h1 = tr_read<B0 + 1 * KS + HF>(vb);
    const s16x4 l2 = tr_read<B0 + 2 * KS>(vb), h2 = tr_read<B0 + 2 * KS + HF>(vb), l3 = tr_read<B0 + 3 * KS>(vb), h3 = tr_read<B0 + 3 * KS + HF>(vb);
    od = __builtin_amdgcn_mfma_f32_32x32x16_bf16(pa0, PKV(l0, h0), od, 0, 0, 0);
    od = __builtin_amdgcn_mfma_f32_32x32x16_bf16(pa1, PKV(l1, h1), od, 0, 0, 0);
    od = __builtin_amdgcn_mfma_f32_32x32x16_bf16(pa2, PKV(l2, h2), od, 0, 0, 0);
    od = __builtin_amdgcn_mfma_f32_32x32x16_bf16(pa3, PKV(l3, h3), od, 0, 0, 0);
}
template <int NVB> __device__ __forceinline__ void pv_all(f32x16* o, int vb, bf16x8 pa0, bf16x8 pa1, bf16x8 pa2, bf16x8 pa3) {
    pv_one<0, NVB>(o[0], vb, pa0, pa1, pa2, pa3); pv_one<1, NVB>(o[1], vb, pa0, pa1, pa2, pa3);
    if constexpr (NVB == 4) { pv_one<2, NVB>(o[2], vb, pa0, pa1, pa2, pa3); pv_one<3, NVB>(o[3], vb, pa0, pa1, pa2, pa3); }
}

template <int DK, int DV>
__device__ __forceinline__ void attn_item(const u16* __restrict__ Qb, const u16* __restrict__ Ka, const u16* __restrict__ Kb, const u16* __restrict__ Vh,
                                          int nkeys, u16* __restrict__ Ob, long ldo, char* lds, float kmax2) {
    using C = AttnCfg<DK, DV>;
    constexpr int NVB = C::NVB, ND0 = C::ND0, NKI = (DK / 32) * 4, NVI = DV / 8, NI = NKI + NVI;
    static_assert(NI <= 24, "three LDS-DMA pieces per wave per tile");
    const int tid = threadIdx.x, wid = __builtin_amdgcn_readfirstlane(tid >> 6), lane = tid & 63, r32 = lane & 31, hi = lane >> 5;
    char* K_lds = lds; char* V_lds = lds + 3 * C::KBYTES;
    float* al_l = (float*)(lds + 3 * C::KBYTES + 3 * C::VBYTES) + wid * 32;
    float m_reg = 0.f; f32x16 o[NVB], ol, negm; bf16x8 qr[ND0];
#pragma unroll
    for (int d = 0; d < NVB; ++d) o[d] = f32x16{};
    ol = f32x16{}; negm = f32x16{};
    const u32x4 ones_w = {0x3F803F80u, 0x3F803F80u, 0x3F803F80u, 0x3F803F80u}; const bf16x8 ones = *reinterpret_cast<const bf16x8*>(&ones_w);
    const u16* Qw = Qb + (long)(wid * 32 + r32) * DK + hi * 8;
#pragma unroll
    for (int d0 = 0; d0 < ND0; ++d0) qr[d0] = *reinterpret_cast<const bf16x8*>(Qw + d0 * 16);
    const u16* src[3]; int dst[3], stp[3]; bool isk[3];
#pragma unroll
    for (int i = 0; i < 3; ++i) { int q = wid + 8 * i; if (q >= NI) q -= 8;
        if (q < NKI) { const int blk = q >> 2, part = q & 3, row = 16 * part + (lane >> 2), c = (lane & 3) ^ ((row >> 2) & 3);
            isk[i] = true; dst[i] = blk * 4096 + part * 1024 + lane * 16;
            if (DK == 96 && blk == 2) { src[i] = Kb + row * 32 + c * 8; stp[i] = 64 * 32; } else { src[i] = Ka + row * 64 + blk * 32 + c * 8; stp[i] = 64 * 64; } }
        else { const int v = q - NKI; int key, col;
            if (NVB == 2) { key = 8 * v + ((lane & 31) >> 2); col = (lane >> 5) * 32 + (lane & 3) * 8; }
            else { key = 8 * (v >> 1) + ((lane & 31) >> 2); col = ((v & 1) * 2 + (lane >> 5)) * 32 + (lane & 3) * 8; }
            isk[i] = false; dst[i] = 3 * C::KBYTES + v * 1024 + lane * 16; src[i] = Vh + key * DV + col; stp[i] = 64 * DV; } }
    const int NT = nkeys / 64;
#define LOADG(kt, vt) do { const int _kt = (kt) < NT ? (kt) : NT - 1, _vt = (vt) < NT ? (vt) : NT - 1; const int _ks = _kt % 3, _vs = _vt % 3; \
        _Pragma("unroll") for (int _i = 0; _i < 3; ++_i) { const int _t = isk[_i] ? _kt : _vt; const int _so = isk[_i] ? _ks * C::KBYTES : _vs * C::VBYTES; \
            __builtin_amdgcn_global_load_lds((const unsigned*)(src[_i] + (long)_t * stp[_i]), (unsigned*)(lds + _so + dst[_i]), 16, 0, 0); } } while (0)
#define RESC(a) do { if (__any((a) < 1.f)) { if (hi == 0) al_l[r32] = (a); asm volatile("s_waitcnt lgkmcnt(0)" ::: "memory"); \
        _Pragma("unroll") for (int r = 0; r < 16; ++r) { const float _f = al_l[crow(r, hi)]; ol[r] *= _f; _Pragma("unroll") for (int d = 0; d < NVB; ++d) o[d][r] *= _f; } } } while (0)
#define PVL(vb) do { pv_all<NVB>(o, (vb), pa0, pa1, pa2, pa3); \
        ol = __builtin_amdgcn_mfma_f32_32x32x16_bf16(pa0, ones, ol, 0, 0, 0); ol = __builtin_amdgcn_mfma_f32_32x32x16_bf16(pa1, ones, ol, 0, 0, 0); \
        ol = __builtin_amdgcn_mfma_f32_32x32x16_bf16(pa2, ones, ol, 0, 0, 0); ol = __builtin_amdgcn_mfma_f32_32x32x16_bf16(pa3, ones, ol, 0, 0, 0); } while (0)
#define NEGM() do { if constexpr (DV == 128) { _Pragma("unroll") for (int r = 0; r < 16; ++r) negm[r] = -m_reg; } } while (0)
#define TILEBAR(n) do { if ((n) == 3) asm volatile("s_waitcnt vmcnt(3)" ::: "memory"); else asm volatile("s_waitcnt vmcnt(0)" ::: "memory"); __builtin_amdgcn_s_barrier(); asm volatile("" ::: "memory"); } while (0)
    const int vrb = (int)(uintptr_t)V_lds + v_rd_base(lane);
    f32x16 pA0, pA1, pB0, pB1; float alA, alB; bf16x8 pa0, pa1, pa2, pa3;
    __syncthreads();
    LOADG(0, 0); LOADG(1, 0);
    TILEBAR(3); LOADG(2, 1);
    float qs = 0.f;
#pragma unroll
    for (int d0 = 0; d0 < ND0; ++d0)
#pragma unroll
        for (int e = 0; e < 8; ++e) { const float f = bf2f((u16)qr[d0][e]); qs += f * f; }
    { auto rr = __builtin_amdgcn_permlane32_swap(__float_as_uint(qs), __float_as_uint(qs), false, false); qs = __uint_as_float(rr[0]) + __uint_as_float(rr[1]); }
    const float bound = sqrtf(qs * kmax2) * 1.01f + 1.f;
    qkt<ND0>(pA0, pA1, K_lds, qr, r32, hi, negm); psm_first(pA0, pA1, bound, m_reg, negm);
    int ks = 1, vs = 0;
    for (int j = 1; j + 1 < NT; j += 2) {
        TILEBAR(3);
        SBAR(); NEGM(); qkt<ND0>(pB0, pB1, K_lds + ks * C::KBYTES, qr, r32, hi, negm);
        fsm_rel(pA0, pA1, pa0, pa1, pa2, pa3);
        SBAR(); LOADG(j + 2, j + 1); SBAR();
        PVL(vrb + vs * C::VBYTES); psm_fix(pB0);
        ks = ks == 2 ? 0 : ks + 1; vs = vs == 2 ? 0 : vs + 1;
        TILEBAR(3);
        SBAR(); NEGM(); qkt<ND0>(pA0, pA1, K_lds + ks * C::KBYTES, qr, r32, hi, negm);
        fsm_rel(pB0, pB1, pa0, pa1, pa2, pa3);
        SBAR(); LOADG(j + 3, j + 2); SBAR();
        PVL(vrb + vs * C::VBYTES); psm_fix(pA0);
        ks = ks == 2 ? 0 : ks + 1; vs = vs == 2 ? 0 : vs + 1;
    }
    TILEBAR(3);
    SBAR(); NEGM(); qkt<ND0>(pB0, pB1, K_lds + ks * C::KBYTES, qr, r32, hi, negm);
    fsm_rel(pA0, pA1, pa0, pa1, pa2, pa3); SBAR();
    PVL(vrb + vs * C::VBYTES); psm_fix(pB0);
    vs = vs == 2 ? 0 : vs + 1;
    TILEBAR(0);
    fsm_rel(pB0, pB1, pa0, pa1, pa2, pa3); SBAR();
    PVL(vrb + vs * C::VBYTES);
    u16* Ow = Ob + (long)(wid * 32) * ldo;
#pragma unroll
    for (int r = 0; r < 16; ++r) { const int orow = crow(r, hi); const float rl = __builtin_amdgcn_rcpf(ol[r]);
#pragma unroll
        for (int d0 = 0; d0 < NVB; ++d0) Ow[(long)orow * ldo + d0 * 32 + r32] = f2bf(o[d0][r] * rl); }
#undef LOADG
#undef RESC
#undef PVL
#undef NEGM
#undef TILEBAR
}

struct Frame {
    const Params* p; unsigned char* ws; char* lds; float* out; int G, bx;
    __device__ __forceinline__ const float* in(int i) const { return p->in[i]; }
    template <class T> __device__ __forceinline__ T* W(size_t off) const { return (T*)(ws + off); }
};
constexpr int LDS_BYTES = 163840;
constexpr int LDS_BARW  = LDS_BYTES - 16;
constexpr int LDS_TAB   = 147456;

struct ResCtx { const char* src0; long srcd; char* dst0; long dstd; const float* mods;
    __device__ __forceinline__ const float* row_in(int row, int) const { return (const float*)(src0 + (row >= NCTX ? srcd : 0L) + (long)row * (DM * 4)); }
    __device__ __forceinline__ float* row_out(int row) const { return (float*)(dst0 + (row >= NCTX ? dstd : 0L) + (long)row * (DM * 4)); }
    __device__ __forceinline__ const float* mod(int li, int row, int which) const {
        const int mr = row < NCTX ? 4 : ((row - NCTX) >> 13); return mods + (size_t)(li * 5 + mr) * 6144 + which * 1024; }
};
__device__ __forceinline__ ResCtx res_ctx(const Frame& F, bool first = false) {
    const char* sc = (const char*)(first ? F.in(2) : (const float*)F.W<float>(WS_XC)); const char* sl = (const char*)(first ? F.in(0) : (const float*)F.out) - (long)NCTX * DM * 4;
    char* dc = (char*)F.W<float>(WS_XC); char* dl = (char*)F.out - (long)NCTX * DM * 4;
    return ResCtx{sc, (long)(sl - sc), dc, (long)(dl - dc), F.W<float>(WS_MODS)};
}
__device__ __forceinline__ const float* xrow_in(const Frame& F, int row, bool first) { return res_ctx(F, first).row_in(row, 0); }
__device__ __forceinline__ float* xrow_out(const Frame& F, int row) { return res_ctx(F).row_out(row); }
__device__ __forceinline__ const float* mod_vec(const Frame& F, int li, int row, int which) { return res_ctx(F).mod(li, row, which); }

struct EpiResid8 { ResCtx F; int li;
    __device__ __forceinline__ void operator()(const f32x4 (&acc)[2][2][4][2], const pg8::Unit& u, int wr, int wc, int fr, int fq) const {
        const int c0 = u.pn * 256 + wc * 32 + 4 * fq;
        const float* gt = F.mod(li, u.pm * 256, 2) + c0;
        f32x4 g[4], xb[3][4];
#pragma unroll
        for (int q = 0; q < 4; ++q) g[q] = *(const f32x4*)(gt + (q >> 1) * 128 + (q & 1) * 16);
#define ER8_LDX(G, B) do { int frr = fr; asm volatile("" : "+v"(frr)); const int row = u.pm * 256 + ((G) >> 2) * 128 + wr * 64 + ((G) & 3) * 16 + frr; const float* xi = F.row_in(row, 0) + c0; \
        _Pragma("unroll") for (int q = 0; q < 4; ++q) xb[B][q] = *(const f32x4*)(xi + (q >> 1) * 128 + (q & 1) * 16); } while (0)
        ER8_LDX(0, 0); ER8_LDX(1, 1); ER8_LDX(2, 2);
#pragma unroll
        for (int G = 0; G < 8; ++G) {
            { int frr = fr; asm volatile("" : "+v"(frr)); const int row = u.pm * 256 + (G >> 2) * 128 + wr * 64 + (G & 3) * 16 + frr; float* xo = F.row_out(row) + c0;
#pragma unroll
                for (int q = 0; q < 4; ++q) { const f32x4 a = acc[G >> 2][q >> 1][G & 3][q & 1], x = xb[G % 3][q];
                    f32x4 o = {x[0] + g[q][0] * a[0], x[1] + g[q][1] * a[1], x[2] + g[q][2] * a[2], x[3] + g[q][3] * a[3]}; *(f32x4*)(xo + (q >> 1) * 128 + (q & 1) * 16) = o; } }
            if (G + 3 < 8) ER8_LDX(G + 3, G % 3);
        }
#undef ER8_LDX
    } };

struct MoeBOrder { static constexpr bool GATHER = false, SPLITK = true; const u16* act; const int* tab; const u16* wd; int nmt, bx, G;
    __device__ __forceinline__ const u16* abase(const pg8::Unit&) const { return act; }
    __device__ __forceinline__ bool next(int i, pg8::Unit& u) const { return tile_seq(i, bx, G, nmt, 4, u.pm, u.pn); }
    __device__ __forceinline__ const u16* bsel(const pg8::Unit& u, int which) const {
        const int c = tab[32 + u.pm], g = c / 6, p = c - g * 6; const int elo = p < 3 ? 0 : (p < 5 ? 1 : 2), ehi = p < 3 ? p + 1 : (p < 5 ? p - 1 : 3);
        return wd + ((size_t)(g * 4 + (which ? ehi : elo)) * 1024 + u.pn * 256) * 512; }
    __device__ __forceinline__ const u16* bbase(const pg8::Unit& u) const { return bsel(u, 0); }
    __device__ __forceinline__ const u16* bbase1(const pg8::Unit& u) const { return bsel(u, 1); }
    __device__ __forceinline__ int arow(const pg8::Unit& u, int r) const { return u.pm * 256 + r; } };
struct EpiMoeB8 { ResCtx F; int li; const int* rowtok;
    __device__ __forceinline__ void operator()(const f32x4 (&acc)[2][2][4][2], const pg8::Unit& u, int wr, int wc, int fr, int fq) const {
        const int c0 = u.pn * 256 + wc * 32 + 4 * fq;
        int tok[8];
#pragma unroll
        for (int G = 0; G < 8; ++G) tok[G] = rowtok[u.pm * 256 + (G >> 2) * 128 + wr * 64 + (G & 3) * 16 + fr];
        f32x4 xb[2][4], gb[2][4];
#define EB8_LD(G, B) do { int t = tok[G] < 0 ? 0 : tok[G]; asm volatile("" : "+v"(t)); const float* xi = F.row_out(t) + c0; const float* gt = F.mod(li, t, 5) + c0; \
        _Pragma("unroll") for (int q = 0; q < 4; ++q) { xb[B][q] = *(const f32x4*)(xi + (q >> 1) * 128 + (q & 1) * 16); gb[B][q] = *(const f32x4*)(gt + (q >> 1) * 128 + (q & 1) * 16); } } while (0)
        EB8_LD(0, 0); EB8_LD(1, 1);
#pragma unroll
        for (int G = 0; G < 8; ++G) {
            if (tok[G] >= 0) { int t = tok[G]; asm volatile("" : "+v"(t)); float* xo = F.row_out(t) + c0;
#pragma unroll
                for (int q = 0; q < 4; ++q) { const f32x4 a = acc[G >> 2][q >> 1][G & 3][q & 1], x = xb[G & 1][q], g = gb[G & 1][q];
                    f32x4 o = {x[0] + g[0] * a[0], x[1] + g[1] * a[1], x[2] + g[2] * a[2], x[3] + g[3] * a[3]}; *(f32x4*)(xo + (q >> 1) * 128 + (q & 1) * 16) = o; } }
            if (G + 2 < 8) EB8_LD(G + 2, G & 1);
        }
#undef EB8_LD
    } };

__device__ __forceinline__ void p0_mods(const Frame& F) {
    float* s = (float*)F.lds; float* red = s + 5 * 1024;
    const int tid = threadIdx.x, lane = tid & 63, wid = tid >> 6;
    for (int i = tid; i < 5 * 1024; i += NTHR) { const int r = i >> 10, k = i & 1023; const float v = r < 4 ? F.in(1)[r * 1024 + k] : F.in(3)[k]; s[i] = silu_f(v); }
    __syncthreads();
    for (int item = F.bx; item < DEPTH * 96; item += F.G) {
        const int li = item / 96, cg = item % 96;
        const float* w = F.in(4) + (size_t)li * 1024 * 6144 + cg * 64 + lane;
        float a0 = 0, a1 = 0, a2 = 0, a3 = 0, a4 = 0;
        const int k0 = wid * 128;
#pragma unroll 8
        for (int k = k0; k < k0 + 128; ++k) {
            const float wv = w[(size_t)k * 6144];
            a0 += s[k] * wv; a1 += s[1024 + k] * wv; a2 += s[2048 + k] * wv; a3 += s[3072 + k] * wv; a4 += s[4096 + k] * wv;
        }
        red[(wid * 5 + 0) * 64 + lane] = a0; red[(wid * 5 + 1) * 64 + lane] = a1; red[(wid * 5 + 2) * 64 + lane] = a2;
        red[(wid * 5 + 3) * 64 + lane] = a3; red[(wid * 5 + 4) * 64 + lane] = a4;
        __syncthreads();
        if (tid < 320) { const int r = tid >> 6, l = tid & 63; float sum = 0;
#pragma unroll
            for (int ww = 0; ww < 8; ++ww) sum += red[(ww * 5 + r) * 64 + l];
            F.W<float>(WS_MODS)[(size_t)(li * 5 + r) * 6144 + cg * 64 + l] = sum + F.in(5)[li * 6144 + cg * 64 + l]; }
        __syncthreads();
    }
}
__device__ __forceinline__ void p0_rope(const Frame& F) {
    const int gt = F.bx * NTHR + threadIdx.x, gn = F.G * NTHR;
    float* ca = F.W<float>(WS_ROPEA); float* sa = ca + SEQ * 16; float* cb = F.W<float>(WS_ROPEB); float* sb = cb + SEQ * 32;
    for (int i = gt; i < SEQ * 48; i += gn) {
        int n, f, nf; float* co; float* so; int idx;
        if (i < SEQ * 16) { n = i >> 4; f = i & 15; nf = 8; co = ca; so = sa; idx = i; }
        else { const int j = i - SEQ * 16; n = j >> 5; f = j & 31; nf = 16; co = cb; so = sb; idx = j; }
        const int fi = f % nf; const float pos = (f < nf) ? (float)(n >> 6) : (float)(n & 63);
        const float invf = exp2f(-(float)fi / (float)nf * 13.287712379549449f);
        const float ang = pos * invf;
        float rev = ang * 0.15915494309189535f; rev -= floorf(rev);
        co[idx] = __builtin_amdgcn_cosf(rev); so[idx] = __builtin_amdgcn_sinf(rev);
    }
}
__device__ __forceinline__ int rowmap(int n, int kind) {
    if (kind == 0) return n;
    if (kind == 3) { if (n >= 2048) return n; const int hh = n >> 6, dim = n & 63; return (hh >> 2) * 256 + (dim >> 5) * 128 + (hh & 3) * 32 + (dim & 31); }
    return (n >> 7) * 256 + (kind == 2 ? 128 : 0) + (n & 127);
}
__device__ __forceinline__ void cvt_group(float* tl, const float* src, int K, int N, u16* dst, int ldd, int kind, int t0, const float* kscale = nullptr) {
    int tid = threadIdx.x; asm volatile("" : "+v"(tid));
    const int tn = (N + 63) / 64, nt = (K / 64) * tn;
    f32x4 v[4][2];
#pragma unroll
    for (int u = 0; u < 4; ++u) { const int t = t0 + u; const int k0 = (t / tn) * 64, n0 = (t % tn) * 64;
#pragma unroll
        for (int ps = 0; ps < 2; ++ps) { const int k = (tid >> 4) + ps * 32, n4 = (tid & 15) * 4;
            if (t < nt && n0 + n4 < N) v[u][ps] = *(const f32x4*)(src + (size_t)(k0 + k) * N + n0 + n4); else v[u][ps] = f32x4{0.f, 0.f, 0.f, 0.f}; } }
#pragma unroll
    for (int u = 0; u < 4; ++u)
#pragma unroll
        for (int ps = 0; ps < 2; ++ps) { const int k = (tid >> 4) + ps * 32, n4 = (tid & 15) * 4; float* d = tl + u * 4160 + k * 65 + n4;
            const int t = t0 + u; const float sc = (kscale && t < nt) ? kscale[(t / tn) * 64 + k] : 1.f;
            d[0] = v[u][ps][0] * sc; d[1] = v[u][ps][1] * sc; d[2] = v[u][ps][2] * sc; d[3] = v[u][ps][3] * sc; }
    __syncthreads();
#pragma unroll
    for (int u = 0; u < 4; ++u) { const int t = t0 + u; const int k0 = (t / tn) * 64, n0 = (t % tn) * 64;
        const int n = tid >> 3, kc = (tid & 7) * 8; const float* sr = tl + u * 4160;
        if (t < nt && n0 + n < N) { u32x4 w;
#pragma unroll
            for (int i = 0; i < 4; ++i) w[i] = cvtpk(sr[(kc + 2 * i) * 65 + n], sr[(kc + 2 * i + 1) * 65 + n]);
            *(u32x4*)(dst + (size_t)rowmap(n0 + n, kind) * ldd + k0 + kc) = w; } }
    __syncthreads();
}
__device__ __forceinline__ void cvt_t(const Frame& F, const float* src, int K, int N, u16* dst, int ldd, int kind, int rot, const float* kscale = nullptr) {
    const int tn = (N + 63) / 64, nt = (K / 64) * tn;
    for (int t0 = ((F.bx + rot) % F.G) * 4; t0 < nt; t0 += F.G * 4) cvt_group((float*)F.lds, src, K, N, dst, ldd, kind, t0, kscale);
}
constexpr int MOE_CVT_GROUPS = 16 * 3 * 32, LDS_CVT = 81920;
__device__ __forceinline__ void moe_cvt_group(const Frame& F, int li, int gidx) {
    if (gidx >= MOE_CVT_GROUPS) return;
    const int mat = gidx >> 5, g = gidx & 31, e = mat / 3, kind = mat - e * 3; float* tl = (float*)(F.lds + LDS_CVT);
    if (kind == 0) cvt_group(tl, F.in(27) + (size_t)(li * 16 + e) * 1024 * 512, 1024, 512, F.W<u16>(WS_MOEW) + (size_t)e * 1024 * 1024, 1024, 1, g * 4);
    else if (kind == 1) cvt_group(tl, F.in(28) + (size_t)(li * 16 + e) * 1024 * 512, 1024, 512, F.W<u16>(WS_MOEW) + (size_t)e * 1024 * 1024, 1024, 2, g * 4);
    else cvt_group(tl, F.in(29) + (size_t)(li * 16 + e) * 512 * 1024, 512, 1024, F.W<u16>(WS_MOEW + MOE_WGU_BYTES) + (size_t)e * 1024 * 512, 512, 0, g * 4);
}
__device__ __forceinline__ void p0_weights(const Frame& F) {
    int rot = 0;
    for (int j = 0; j < 2; ++j) {
        cvt_t(F, F.in(8) + (size_t)j * 1024 * 544, 1024, 544, F.W<u16>(WS_WDQKV) + (size_t)j * 640 * 1024, 1024, 0, rot); rot += 36;
        cvt_t(F, F.in(10) + (size_t)j * 256 * 1536, 256, 1536, F.W<u16>(WS_WUQ) + (size_t)j * 1536 * 256, 256, 0, rot, F.in(9) + j * 256); rot += 24;
        cvt_t(F, F.in(12) + (size_t)j * 256 * 2048, 256, 2048, F.W<u16>(WS_WUKV) + (size_t)j * 2048 * 256, 256, 0, rot, F.in(11) + j * 256); rot += 32;
        cvt_t(F, F.in(13) + (size_t)j * 1024 * 1024, 1024, 1024, F.W<u16>(WS_WOM) + (size_t)j * 1024 * 1024, 1024, 0, rot);
    }
    cvt_t(F, F.in(14), 1024, 3072, F.W<u16>(WS_WQKVD), 1024, 3, rot);
    cvt_t(F, F.in(17), 1024, 1024, F.W<u16>(WS_WOD), 1024, 0, rot);
    cvt_t(F, F.in(18), 1024, 3104, F.W<u16>(WS_WING), 1024, 0, rot); rot += 4;
    cvt_t(F, F.in(22), 1024, 1024, F.W<u16>(WS_WOG), 1024, 0, rot);
}
__device__ __forceinline__ void moe_weights(const Frame& F, int li) {
    for (int g = F.bx; g < MOE_CVT_GROUPS; g += F.G) moe_cvt_group(F, li, g);
}

#define DPP_ADD(v, CTRL) (v) += __uint_as_float(__builtin_amdgcn_update_dpp(0u, __float_as_uint(v), (CTRL), 0xF, 0xF, false))
__device__ __forceinline__ float wave_sum_fast(float v) {
    DPP_ADD(v, 0xB1); DPP_ADD(v, 0x4E); DPP_ADD(v, 0x141); DPP_ADD(v, 0x140);
    { auto rr = __builtin_amdgcn_permlane16_swap(__float_as_uint(v), __float_as_uint(v), false, false); v = __uint_as_float(rr[0]) + __uint_as_float(rr[1]); }
    { auto rr = __builtin_amdgcn_permlane32_swap(__float_as_uint(v), __float_as_uint(v), false, false); v = __uint_as_float(rr[0]) + __uint_as_float(rr[1]); }
    return v;
}
constexpr int RT_WG = 0, RT_WR = 16384, RT_REC = 81920, RT_CNT = 81920 + 4096, RT_BASE = RT_CNT + 128;
template <bool ROUTE>
__device__ __forceinline__ void norm_phase(const Frame& F, int li, int row_begin, bool first) {
    const int tid = threadIdx.x, lane = tid & 63, wid = tid >> 6;
    const float* gain = F.in(ROUTE ? 7 : 6) + li * DM;
    u16* H = F.W<u16>(WS_H);
    const int per_block = (NTOK - row_begin + F.G - 1) / F.G;
    const int blk0 = row_begin + F.bx * per_block; int blk1 = blk0 + per_block; if (blk1 > NTOK) blk1 = NTOK;
    f32x4* wgL = (f32x4*)(F.lds + RT_WG); f32x4* wrL = (f32x4*)(F.lds + RT_WR); u32x4* recL = (u32x4*)(F.lds + RT_REC);
    unsigned* cntL = (unsigned*)(F.lds + RT_CNT); unsigned* baseL = (unsigned*)(F.lds + RT_BASE);
    if constexpr (ROUTE) {
        __syncthreads();
        const f32x4* wg = (const f32x4*)(F.in(23) + (size_t)li * DM * 4); const f32x4* wr = (const f32x4*)(F.in(25) + (size_t)li * 4 * DM * 4);
        for (int e = tid; e < 1024; e += NTHR) { const int d = ((e >> 8) * 4 + (e & 3)) * 64 + ((e >> 2) & 63); wgL[d] = wg[e]; }
        for (int e = tid; e < 4096; e += NTHR) { const int g = e >> 10, c = e & 1023; const int d = g * 1024 + ((c >> 8) * 4 + (c & 3)) * 64 + ((c >> 2) & 63); wrL[d] = wr[e]; }
        if (tid < 32) cntL[tid] = 0u;
        __syncthreads();
    }
    f32x4 vn[4][4];
#define NLOAD(IT) do { _Pragma("unroll") for (int u = 0; u < 4; ++u) { int _r = blk0 + wid + 8 * (4 * (IT) + u); if (_r >= blk1) _r = blk0; const float* xr = xrow_in(F, _r, first); \
        _Pragma("unroll") for (int i = 0; i < 4; ++i) vn[u][i] = *(const f32x4*)(xr + i * 256 + lane * 4); } } while (0)
    NLOAD(0);
    for (int it = 0; it * 32 < per_block; ++it) {
        int rows[4]; bool ok[4]; f32x4 v[4][4];
#pragma unroll
        for (int u = 0; u < 4; ++u) { rows[u] = blk0 + wid + 8 * (4 * it + u); ok[u] = rows[u] < blk1; if (!ok[u]) rows[u] = blk0; }
#pragma unroll
        for (int u = 0; u < 4; ++u)
#pragma unroll
            for (int i = 0; i < 4; ++i) v[u][i] = vn[u][i];
        if ((it + 1) * 32 < per_block) NLOAD(it + 1);
#pragma unroll
        for (int u = 0; u < 4; ++u) {
            const int row = rows[u];
            float ss = 0;
#pragma unroll
            for (int i = 0; i < 4; ++i) ss += v[u][i][0] * v[u][i][0] + v[u][i][1] * v[u][i][1] + v[u][i][2] * v[u][i][2] + v[u][i][3] * v[u][i][3];
            ss = wave_sum_fast(ss);
            const float rinv = rsqrtf(ss * (1.f / DM) + EPS);
            const float* sh = mod_vec(F, li, row, ROUTE ? 3 : 0); const float* sc = mod_vec(F, li, row, ROUTE ? 4 : 1);
            float hv[16];
#pragma unroll
            for (int i = 0; i < 4; ++i) { const int c = i * 256 + lane * 4;
                const f32x4 g = *(const f32x4*)(gain + c), s1 = *(const f32x4*)(sc + c), s0 = *(const f32x4*)(sh + c);
#pragma unroll
                for (int j = 0; j < 4; ++j) hv[i * 4 + j] = (v[u][i][j] * rinv * g[j]) * (1.f + s1[j]) + s0[j];
                if (ok[u]) { u32x2 w = {cvtpk(hv[i * 4], hv[i * 4 + 1]), cvtpk(hv[i * 4 + 2], hv[i * 4 + 3])}; *(u32x2*)(H + (size_t)row * DM + c) = w; } }
            if constexpr (ROUTE) {
                float gl[4] = {0, 0, 0, 0};
#pragma unroll
                for (int q = 0; q < 16; ++q) { const f32x4 w4 = wgL[q * 64 + lane]; const float h = hv[q];
                    gl[0] += h * w4[0]; gl[1] += h * w4[1]; gl[2] += h * w4[2]; gl[3] += h * w4[3]; }
#pragma unroll
                for (int g = 0; g < 4; ++g) gl[g] = wave_sum_fast(gl[g]) + F.in(24)[li * 4 + g];
                int gi = 0; float gm = gl[0];
#pragma unroll
                for (int g = 1; g < 4; ++g) if (gl[g] > gm) { gm = gl[g]; gi = g; }
                gi = __builtin_amdgcn_readfirstlane(gi);
                float den = 0;
#pragma unroll
                for (int g = 0; g < 4; ++g) den += __expf(gl[g] - gm);
                const float grp_w = 1.f / den;
                float el[4] = {0, 0, 0, 0};
                const f32x4* wrg = wrL + gi * 1024;
#pragma unroll
                for (int q = 0; q < 16; ++q) { const f32x4 w4 = wrg[q * 64 + lane]; const float h = hv[q];
                    el[0] += h * w4[0]; el[1] += h * w4[1]; el[2] += h * w4[2]; el[3] += h * w4[3]; }
#pragma unroll
                for (int e = 0; e < 4; ++e) el[e] = wave_sum_fast(el[e]) + F.in(26)[(li * 4 + gi) * 4 + e];
                int i1 = 0; float v1 = el[0];
#pragma unroll
                for (int e = 1; e < 4; ++e) if (el[e] > v1) { v1 = el[e]; i1 = e; }
                int i2 = -1; float v2 = -3.0e38f;
#pragma unroll
                for (int e = 0; e < 4; ++e) if (e != i1 && el[e] > v2) { v2 = el[e]; i2 = e; }
                const float t = __expf(v2 - v1); const float w1 = grp_w / (1.f + t), w2 = grp_w * t / (1.f + t);
                const int elo = i1 < i2 ? i1 : i2, ehi = i1 < i2 ? i2 : i1;
                const float wlo = i1 < i2 ? w1 : w2, whi = i1 < i2 ? w2 : w1;
                const int pr = elo == 0 ? ehi - 1 : (elo == 1 ? ehi + 1 : 5);
                const int cls = gi * 6 + pr;
                if (lane == 0 && ok[u]) {
                    const unsigned rank = atomicAdd(&cntL[cls], 1u);
                    u32x4 rec = {(unsigned)cls, rank, __float_as_uint(wlo), __float_as_uint(whi)};
                    recL[row - blk0] = rec;
                }
            }
        }
    }
#undef NLOAD
    if constexpr (ROUTE) {
        __syncthreads();
        if (tid < 24) baseL[tid] = atomicAdd(F.W<unsigned>(WS_CTL) + CW_CNT + li * 32 + tid, cntL[tid]);
        __syncthreads();
        for (int t = tid; t < blk1 - blk0; t += NTHR) { u32x4 rec = recL[t]; rec[1] += baseL[rec[0]];
            *(u32x4*)(F.W<unsigned char>(WS_TOK) + (size_t)(blk0 + t) * 16) = rec; }
    }
}

__device__ __forceinline__ void moe_table(const Frame& F, int li, int* tab) {
    if (threadIdx.x == 0) {
        const unsigned* cnt = F.W<unsigned>(WS_CTL) + CW_CNT + li * 32; int off = 0;
        for (int c = 0; c < 24; ++c) { tab[c] = off; const int n = (int)cnt[c]; const int nt = (n + 255) >> 8;
            for (int t = 0; t < nt; ++t) tab[32 + (off >> 8) + t] = c; off += nt << 8; }
        tab[24] = off;
    }
    __syncthreads();
}
__device__ __forceinline__ void moe_scatter(const Frame& F, int li, int row_begin) {
    int* tab = (int*)(F.lds + LDS_TAB);
    moe_table(F, li, tab);
    const unsigned* cnt = F.W<unsigned>(WS_CTL) + CW_CNT + li * 32;
    int* rowtok = F.W<int>(WS_ROWTOK); float* roww = F.W<float>(WS_ROWW);
    const int gt = F.bx * NTHR + threadIdx.x, gn = F.G * NTHR;
    for (int t = row_begin + gt; t < NTOK; t += gn) {
        const u32x4 rec = *(const u32x4*)(F.W<unsigned char>(WS_TOK) + (size_t)t * 16);
        const int r = tab[rec[0]] + (int)rec[1];
        rowtok[r] = t; roww[2 * r] = __uint_as_float(rec[2]); roww[2 * r + 1] = __uint_as_float(rec[3]);
    }
    for (int i = gt; i < 24 * 256; i += gn) { const int c = i >> 8, j = i & 255; const int r = tab[c] + (int)cnt[c] + j;
        const int end = tab[c] + ((((int)cnt[c]) + 255) & ~255);
        if (r < end) { rowtok[r] = -1; roww[2 * r] = 0.f; roww[2 * r + 1] = 0.f; } }
    __syncthreads();
}

#define EPI_ID const int r32 = lane & 31, hi = lane >> 5
__device__ __forceinline__ u32x2 pack4(float a, float b, float c, float d) { u32x2 w = {cvtpk(a, b), cvtpk(c, d)}; return w; }
struct EpiF32 { float* dst; int ld, ncols;
    __device__ __forceinline__ int operator()(f32x16 (&acc)[2][2], int row0, int col0, int lane) const { EPI_ID;
#pragma unroll
        for (int mi = 0; mi < 2; ++mi) { float* o = dst + (size_t)(row0 + mi * 32 + r32) * ld + col0 + 4 * hi;
#pragma unroll
            for (int ni = 0; ni < 2; ++ni) if (col0 + ni * 32 < ncols) {
#pragma unroll
                for (int g = 0; g < 4; ++g) { f32x4 v = {acc[mi][ni][4 * g], acc[mi][ni][4 * g + 1], acc[mi][ni][4 * g + 2], acc[mi][ni][4 * g + 3]}; *(f32x4*)(o + ni * 32 + 8 * g) = v; } } }
        return 0;
    } };
struct EpiMlaDown { u16* CN; float* SS; u16* KPE; unsigned* pemax;
    __device__ __forceinline__ int operator()(f32x16 (&acc)[2][2], int row0, int col0, int lane) const { EPI_ID;
        if (col0 < 512) {
#pragma unroll
            for (int mi = 0; mi < 2; ++mi) { const size_t row = row0 + mi * 32 + r32; u16* o = CN + row * 512 + col0 + 4 * hi; float ss = 0.f;
#pragma unroll
                for (int ni = 0; ni < 2; ++ni)
#pragma unroll
                    for (int g = 0; g < 4; ++g) { const float a = acc[mi][ni][4 * g], b = acc[mi][ni][4 * g + 1], c = acc[mi][ni][4 * g + 2], d = acc[mi][ni][4 * g + 3];
                        ss += a * a + b * b + c * c + d * d; *(u32x2*)(o + ni * 32 + 8 * g) = pack4(a, b, c, d); }
                { auto rr = __builtin_amdgcn_permlane32_swap(__float_as_uint(ss), __float_as_uint(ss), false, false); ss = __uint_as_float(rr[0]) + __uint_as_float(rr[1]); }
                if (hi == 0) SS[row * 8 + (col0 >> 6)] = ss; }
        } else if (col0 == 512) {
            const bool lat = row0 >= NCTX; float pmx = 0.f;
#pragma unroll
            for (int mi = 0; mi < 2; ++mi) { const int row = row0 + mi * 32 + r32; int b, pos; row_bp(row, b, pos); const int n = (row - NCTX) & (SEQ - 1);
                u16* o = KPE + ((size_t)b * KEYS + pos) * 32 + 4 * hi; float s2 = 0.f;
#pragma unroll
                for (int g = 0; g < 2; ++g) { float o1[4], o2[4];
#pragma unroll
                    for (int j = 0; j < 4; ++j) { const float t1 = acc[mi][0][4 * g + j], t2 = acc[mi][0][4 * (g + 2) + j]; float cs = 1.f, sn = 0.f; if (lat) rope_cs<8>(n, 8 * g + 4 * hi + j, cs, sn);
                        o1[j] = t1 * cs - t2 * sn; o2[j] = t1 * sn + t2 * cs; s2 += t1 * t1 + t2 * t2; }
                    *(u32x2*)(o + 8 * g) = pack4(o1[0], o1[1], o1[2], o1[3]); *(u32x2*)(o + 16 + 8 * g) = pack4(o2[0], o2[1], o2[2], o2[3]); }
                { auto rr = __builtin_amdgcn_permlane32_swap(__float_as_uint(s2), __float_as_uint(s2), false, false); s2 = __uint_as_float(rr[0]) + __uint_as_float(rr[1]); }
                pmx = fmaxf(pmx, s2); }
            const float v = wave_max_fast(pmx); const int bb = row0 < NCTX ? row0 >> 8 : (row0 - NCTX) >> 13;
            if (lane == 0) atomic_fmax_pos(pemax + bb, v);
        }
        return 0;
    } };
struct EpiMlaQ { u16* Q; const float* cosA; const float* sinA; float scale;
    __device__ __forceinline__ int operator()(f32x16 (&acc)[2][2], int row0, int col0, int lane) const { EPI_ID; const bool lat = row0 >= NCTX;
#pragma unroll
        for (int mi = 0; mi < 2; ++mi) { const int row = row0 + mi * 32 + r32; int b, pos; row_bp(row, b, pos); const int n = (row - NCTX) & (SEQ - 1);
            u16* qrow = Q + ((size_t)(b * 16) * KEYS + pos) * 96 + 4 * hi;
#pragma unroll
            for (int ni = 0; ni < 2; ++ni) { const int s = (col0 >> 5) + ni, head = s / 3, part = s - head * 3; u16* o = qrow + (size_t)head * KEYS * 96 + part * 32;
                float v[16];
#pragma unroll
                for (int r = 0; r < 16; ++r) v[r] = acc[mi][ni][r] * scale;
                if (part == 2 && lat) {
#pragma unroll
                    for (int g = 0; g < 2; ++g) {
#pragma unroll
                        for (int j = 0; j < 4; ++j) { float cs, sn; rope_cs<8>(n, 8 * g + 4 * hi + j, cs, sn);
                            const float t1 = v[4 * g + j], t2 = v[4 * (g + 2) + j]; v[4 * g + j] = t1 * cs - t2 * sn; v[4 * (g + 2) + j] = t1 * sn + t2 * cs; } } }
#pragma unroll
                for (int g = 0; g < 4; ++g) *(u32x2*)(o + 8 * g) = pack4(v[4 * g], v[4 * g + 1], v[4 * g + 2], v[4 * g + 3]); } }
        return 16;
    } };
struct EpiMlaKV { u16* Kn; long vdelta;
    __device__ __forceinline__ int operator()(f32x16 (&acc)[2][2], int row0, int col0, int lane) const { EPI_ID; const int head = col0 >> 7; u16* dst = Kn + (long)((col0 >> 6) & 1) * vdelta;
#pragma unroll
        for (int mi = 0; mi < 2; ++mi) { const int row = row0 + mi * 32 + r32; int b, pos; row_bp(row, b, pos);
            u16* o = dst + ((size_t)(b * 16 + head) * KEYS + pos) * 64 + 4 * hi;
#pragma unroll
            for (int ni = 0; ni < 2; ++ni)
#pragma unroll
                for (int g = 0; g < 4; ++g) *(u32x2*)(o + ni * 32 + 8 * g) = pack4(acc[mi][ni][4 * g], acc[mi][ni][4 * g + 1], acc[mi][ni][4 * g + 2], acc[mi][ni][4 * g + 3]); }
        return 16;
    } };
struct EpiResid { ResCtx F; int li, which, first;
    __device__ __forceinline__ int operator()(f32x16 (&acc)[2][2], int row0, int col0, int lane) const { EPI_ID;
#pragma unroll
        for (int mi = 0; mi < 2; ++mi) { const int row = row0 + mi * 32 + r32;
            const float* xi = F.row_in(row, first) + col0 + 4 * hi; float* xo = F.row_out(row) + col0 + 4 * hi; const float* gt = F.mod(li, row, which) + col0 + 4 * hi;
#pragma unroll
            for (int ni = 0; ni < 2; ++ni)
#pragma unroll
                for (int g = 0; g < 4; ++g) { const int c = ni * 32 + 8 * g; const f32x4 x = *(const f32x4*)(xi + c), gg = *(const f32x4*)(gt + c);
                    f32x4 o = {x[0] + gg[0] * acc[mi][ni][4 * g], x[1] + gg[1] * acc[mi][ni][4 * g + 1], x[2] + gg[2] * acc[mi][ni][4 * g + 2], x[3] + gg[3] * acc[mi][ni][4 * g + 3]};
                    *(f32x4*)(xo + c) = o; } }
        return 48;
    } };
struct EpiMoeB { ResCtx F; int li; const int* rowtok;
    __device__ __forceinline__ int operator()(f32x16 (&acc)[2][2], int row0, int col0, int lane) const { EPI_ID;
#pragma unroll
        for (int mi = 0; mi < 2; ++mi) { const int tok = rowtok[row0 + mi * 32 + r32];
            if (tok >= 0) { float* xo = F.row_out(tok) + col0 + 4 * hi; const float* gt = F.mod(li, tok, 5) + col0 + 4 * hi;
#pragma unroll
                for (int ni = 0; ni < 2; ++ni)
#pragma unroll
                    for (int g = 0; g < 4; ++g) { const int c = ni * 32 + 8 * g; const f32x4 x = *(const f32x4*)(xo + c), gg = *(const f32x4*)(gt + c);
                        f32x4 o = {x[0] + gg[0] * acc[mi][ni][4 * g], x[1] + gg[1] * acc[mi][ni][4 * g + 1], x[2] + gg[2] * acc[mi][ni][4 * g + 2], x[3] + gg[3] * acc[mi][ni][4 * g + 3]};
                        *(f32x4*)(xo + c) = o; } } }
        return 0;
    } };
struct EpiMoeA { u16* act; const float* roww; int half, acol0;
    __device__ __forceinline__ int operator()(f32x16 (&acc)[2][2], int row0, int col0, int lane) const { EPI_ID;
#pragma unroll
        for (int mi = 0; mi < 2; ++mi) { const int row = row0 + mi * 32 + r32; const float w = roww[2 * row + half];
            u16* o = act + (size_t)row * 1024 + acol0 + (col0 >> 6) * 32 + 4 * hi;
#pragma unroll
            for (int g = 0; g < 4; ++g) { float v[4];
#pragma unroll
                for (int j = 0; j < 4; ++j) v[j] = silu_f(acc[mi][0][4 * g + j]) * acc[mi][1][4 * g + j] * w;
                *(u32x2*)(o + 8 * g) = pack4(v[0], v[1], v[2], v[3]); } }
        return 8;
    } };
struct EpiDiffQKV { u16* Q; long kdelta; u16* V; const float* cosB; const float* sinB; float qscale;
    __device__ __forceinline__ int operator()(f32x16 (&acc)[2][2], int row0, int col0, int lane) const { EPI_ID; const int region = col0 >> 10; const bool lat = row0 >= NCTX;
#pragma unroll
        for (int mi = 0; mi < 2; ++mi) { const int row = row0 + mi * 32 + r32; int b, pos; row_bp(row, b, pos); const int n = (row - NCTX) & (SEQ - 1);
            if (region < 2) {
                const int hh = (col0 & 1023) >> 6; const float sc = region == 0 ? qscale : 1.f;
                u16* o = Q + (long)region * kdelta + ((size_t)(b * 16 + hh) * KEYS + pos) * 64 + 4 * hi;
#pragma unroll
                for (int g = 0; g < 4; ++g) {
                    float o1[4], o2[4];
#pragma unroll
                    for (int j = 0; j < 4; ++j) { float cs = 1.f, sn = 0.f; if (lat) rope_cs<16>(n, 8 * g + 4 * hi + j, cs, sn);
                        const float t1 = acc[mi][0][4 * g + j], t2 = acc[mi][1][4 * g + j]; o1[j] = (t1 * cs - t2 * sn) * sc; o2[j] = (t1 * sn + t2 * cs) * sc; }
                    *(u32x2*)(o + 8 * g) = pack4(o1[0], o1[1], o1[2], o1[3]); *(u32x2*)(o + 32 + 8 * g) = pack4(o2[0], o2[1], o2[2], o2[3]); }
            } else {
                const int cv = col0 - 2048, head = cv >> 7;
                u16* o = V + ((size_t)(b * 8 + head) * KEYS + pos) * 128 + (cv & 127) + 4 * hi;
#pragma unroll
                for (int ni = 0; ni < 2; ++ni)
#pragma unroll
                    for (int g = 0; g < 4; ++g) *(u32x2*)(o + ni * 32 + 8 * g) = pack4(acc[mi][ni][4 * g], acc[mi][ni][4 * g + 1], acc[mi][ni][4 * g + 2], acc[mi][ni][4 * g + 3]);
            } }
        return 16;
    } };
struct EpiGlaIn { u16* q; u16* k; u16* v; u16* g; float* z;
    __device__ __forceinline__ int operator()(f32x16 (&acc)[2][2], int row0, int col0, int lane) const { EPI_ID;
#pragma unroll
        for (int mi = 0; mi < 2; ++mi) { const size_t row = row0 + mi * 32 + r32;
            if (col0 < 3072) {
                u16* o; float sc = 1.f;
                if (col0 < 512) { o = q + row * 512 + col0; sc = 0.08838834764831845f; } else if (col0 < 1024) o = k + row * 512 + (col0 - 512);
                else if (col0 < 2048) o = v + row * 1024 + (col0 - 1024); else o = g + row * 1024 + (col0 - 2048);
                o += 4 * hi;
#pragma unroll
                for (int ni = 0; ni < 2; ++ni)
#pragma unroll
                    for (int gg = 0; gg < 4; ++gg) *(u32x2*)(o + ni * 32 + 8 * gg) = pack4(acc[mi][ni][4 * gg] * sc, acc[mi][ni][4 * gg + 1] * sc, acc[mi][ni][4 * gg + 2] * sc, acc[mi][ni][4 * gg + 3] * sc);
            } else if (col0 == 3072) {
                float* o = z + row * 32 + 4 * hi;
#pragma unroll
                for (int gg = 0; gg < 4; ++gg) { f32x4 t = {acc[mi][0][4 * gg], acc[mi][0][4 * gg + 1], acc[mi][0][4 * gg + 2], acc[mi][0][4 * gg + 3]}; *(f32x4*)(o + 8 * gg) = t; }
            } }
        return col0 < 3072 ? 16 : (col0 == 3072 ? 8 : 0);
    } };

template <int WM, int WN, class AL, class BL, class EP>
__device__ __forceinline__ void gemm_phase(const Frame& F, const AL al, const BL bl, EP& ep, int mt0, int mt1, int nN, int nk, int tile_off, int tile_total) {
    PlainTiles<AL, BL, EP> prov{al, bl, ep, mt0, mt1 - mt0, nN, F.bx, F.G}; (void)tile_off;
    gemm_stream<WM, WN>(F.lds, prov, nk);
    (void)tile_total;
}

__device__ __forceinline__ void mla_rowpass(const Frame& F, int j, int li) {
    const int lane = threadIdx.x & 63, wid = threadIdx.x >> 6;
    const float* DQ = F.W<float>(MLA_DQ); u16* CN = F.W<u16>(MLA_CN); u16* KPE = F.W<u16>(MLA_KPE);
    const float* gq = F.in(9) + j * 256; const float* gk = F.in(11) + j * 256;
    const float* ca = F.W<float>(WS_ROPEA); const float* sa = ca + SEQ * 16;
    float pem0 = 0.f, pem1 = 0.f, pem2 = 0.f, pem3 = 0.f;
    for (int row = F.bx * NWAVE + wid; row < NTOK; row += F.G * NWAVE) {
        const float* d = DQ + (size_t)row * 544;
        const f32x4 a = *(const f32x4*)(d + lane * 4), c = *(const f32x4*)(d + 256 + lane * 4);
        float sq = a[0] * a[0] + a[1] * a[1] + a[2] * a[2] + a[3] * a[3], sk = c[0] * c[0] + c[1] * c[1] + c[2] * c[2] + c[3] * c[3];
        sq = wave_sum(sq); sk = wave_sum(sk);
        const float rq = rsqrtf(sq * (1.f / 256.f) + EPS), rk = rsqrtf(sk * (1.f / 256.f) + EPS);
        const f32x4 g1 = *(const f32x4*)(gq + lane * 4), g2 = *(const f32x4*)(gk + lane * 4);
        u32x2 w1 = {cvtpk(a[0] * rq * g1[0], a[1] * rq * g1[1]), cvtpk(a[2] * rq * g1[2], a[3] * rq * g1[3])};
        u32x2 w2 = {cvtpk(c[0] * rk * g2[0], c[1] * rk * g2[1]), cvtpk(c[2] * rk * g2[2], c[3] * rk * g2[3])};
        *(u32x2*)(CN + (size_t)row * 512 + lane * 4) = w1; *(u32x2*)(CN + (size_t)row * 512 + 256 + lane * 4) = w2;
        { float t1 = 0.f, t2 = 0.f; if (lane < 16) { t1 = d[512 + lane]; t2 = d[528 + lane]; }
          const float pe2 = wave_sum_fast(t1 * t1 + t2 * t2); const int bb = row < NCTX ? row >> 8 : (row - NCTX) >> 13;
          pem0 = bb == 0 ? fmaxf(pem0, pe2) : pem0; pem1 = bb == 1 ? fmaxf(pem1, pe2) : pem1; pem2 = bb == 2 ? fmaxf(pem2, pe2) : pem2; pem3 = bb == 3 ? fmaxf(pem3, pe2) : pem3; }
        if (lane < 16) { float t1 = d[512 + lane], t2 = d[528 + lane]; int b, pos; row_bp(row, b, pos);
            if (row >= NCTX) { const int n = (row - NCTX) & (SEQ - 1); const float cs = ca[n * 16 + lane], sn = sa[n * 16 + lane];
                const float o1 = t1 * cs - t2 * sn, o2 = t1 * sn + t2 * cs; t1 = o1; t2 = o2; }
            u16* o = KPE + ((size_t)b * KEYS + pos) * 32 + lane; o[0] = f2bf(t1); o[16] = f2bf(t2); }
    }
    if (lane == 0) { unsigned* pm = F.W<unsigned>(WS_CTL) + CW_PEMAX + li * 4; atomic_fmax_pos(pm, pem0); atomic_fmax_pos(pm + 1, pem1); atomic_fmax_pos(pm + 2, pem2); atomic_fmax_pos(pm + 3, pem3); }
}
__device__ __forceinline__ int vcu_of(const Frame& F) { return (F.G % 8 == 0) ? (F.bx % 8) * (F.G / 8) + F.bx / 8 : F.bx; }
__device__ __forceinline__ void mla_attn(const Frame& F, bool ctx_out, int li) {
    const u16* Q = F.W<u16>(MLA_Q); const u16* Kn = F.W<u16>(MLA_KN); const u16* V = F.W<u16>(MLA_V); const u16* Kpe = F.W<u16>(MLA_KPE);
    u16* O = F.W<u16>(MLA_DQ);
    const int nit = 2048 + (ctx_out ? 64 : 0); int nrun = 0;
#pragma unroll 1
    for (int it = vcu_of(F); it < nit; it += F.G) {
        int b, h, qpos, nkeys, orow;
        if (it < 2048) { const int bh = it >> 5, qt = it & 31; b = bh >> 4; h = bh & 15; qpos = CTXL + qt * 256; nkeys = KEYS; orow = NCTX + b * SEQ + qt * 256; }
        else { const int jj = it - 2048; b = jj >> 4; h = jj & 15; qpos = 0; nkeys = CTXL; orow = b * CTXL; }
        const size_t bh = (size_t)(b * 16 + h);
        const unsigned* km = F.W<unsigned>(WS_CTL) + CW_KMAX + li * 128 + (b * 16 + h) * 2;
        const float kmax2 = __uint_as_float(km[0]) + __uint_as_float(km[1]) + __uint_as_float(F.W<unsigned>(WS_CTL)[CW_PEMAX + li * 4 + b]);
        attn_item<96, 64>(Q + (bh * KEYS + qpos) * 96, Kn + bh * KEYS * 64, Kpe + (size_t)b * KEYS * 32, V + bh * KEYS * 64, nkeys,
                          O + (size_t)orow * DM + h * 64, DM, F.lds, kmax2);
        moe_cvt_group(F, li, F.bx + nrun * F.G); ++nrun;
    }
    for (; F.bx + nrun * F.G < MOE_CVT_GROUPS; ++nrun) moe_cvt_group(F, li, F.bx + nrun * F.G);
}
__device__ __forceinline__ void diff_attn(const Frame& F, int li) {
    const u16* Q = F.W<u16>(DF_Q); const u16* K = F.W<u16>(DF_K); const u16* V = F.W<u16>(DF_V); u16* OS = F.W<u16>(DF_OS);
    const int nit = 2048 + 64; int nrun = 0;
#pragma unroll 1
    for (int it = vcu_of(F); it < nit; it += F.G) {
        int b, hh, qpos, nkeys, orow;
        if (it < 2048) { const int bh = it >> 5, qt = it & 31; b = bh >> 4; hh = bh & 15; qpos = CTXL + qt * 256; nkeys = KEYS; orow = NCTX + b * SEQ + qt * 256; }
        else { const int jj = it - 2048; b = jj >> 4; hh = jj & 15; qpos = 0; nkeys = CTXL; orow = b * CTXL; }
        const size_t bh = (size_t)(b * 16 + hh);
        const float kmax2 = __uint_as_float(F.W<unsigned>(WS_CTL)[CW_KMAX + li * 128 + (b * 16 + hh) * 2]);
        attn_item<64, 128>(Q + (bh * KEYS + qpos) * 64, K + bh * KEYS * 64, nullptr, V + (size_t)(b * 8 + (hh >> 1)) * KEYS * 128, nkeys,
                           OS + (size_t)(hh & 1) * NTOK * DM + (size_t)orow * DM + (hh >> 1) * 128, DM, F.lds, kmax2);
        moe_cvt_group(F, li, F.bx + nrun * F.G); ++nrun;
    }
    for (; F.bx + nrun * F.G < MOE_CVT_GROUPS; ++nrun) moe_cvt_group(F, li, F.bx + nrun * F.G);
}
__device__ __forceinline__ void diff_rowpass(const Frame& F, float lam_init) {
    const int lane = threadIdx.x & 63, wid = threadIdx.x >> 6;
    const u16* OS = F.W<u16>(DF_OS); u16* O = F.W<u16>(DF_Q);
    const float* lm = F.in(15);
    const float lam = __expf(wave_sum(lm[lane] * lm[64 + lane])) - __expf(wave_sum(lm[128 + lane] * lm[192 + lane])) + lam_init;
    const float post = 1.f - lam_init;
    float sg[16];
#pragma unroll
    for (int i = 0; i < 16; ++i) sg[i] = F.in(16)[(lane & 7) * 16 + i] * post;
    for (int row = F.bx * NWAVE + wid; row < NTOK; row += F.G * NWAVE) {
        const u16* p0 = OS + (size_t)row * DM + lane * 16; const u16* p1 = p0 + (size_t)NTOK * DM;
        const bf16x8 a0 = *(const bf16x8*)p0, a1 = *(const bf16x8*)(p0 + 8), b0 = *(const bf16x8*)p1, b1 = *(const bf16x8*)(p1 + 8);
        float o[16]; float ss = 0;
#pragma unroll
        for (int i = 0; i < 8; ++i) { o[i] = bf2f((u16)a0[i]) - lam * bf2f((u16)b0[i]); o[8 + i] = bf2f((u16)a1[i]) - lam * bf2f((u16)b1[i]); }
#pragma unroll
        for (int i = 0; i < 16; ++i) ss += o[i] * o[i];
        ss += __shfl_xor(ss, 1); ss += __shfl_xor(ss, 2); ss += __shfl_xor(ss, 4);
        const float rinv = rsqrtf(ss * (1.f / 128.f) + EPS);
        u32x4 w0, w1;
#pragma unroll
        for (int i = 0; i < 4; ++i) { w0[i] = cvtpk(o[2 * i] * rinv * sg[2 * i], o[2 * i + 1] * rinv * sg[2 * i + 1]);
            w1[i] = cvtpk(o[8 + 2 * i] * rinv * sg[8 + 2 * i], o[9 + 2 * i] * rinv * sg[9 + 2 * i]); }
        *(u32x4*)(O + (size_t)row * DM + lane * 16) = w0; *(u32x4*)(O + (size_t)row * DM + lane * 16 + 8) = w1;
    }
}

__device__ __forceinline__ float logsig16(float x) { return (fminf(x, 0.f) - __logf(1.f + __expf(-fabsf(x)))) * 0.0625f; }
constexpr int NCH = KEYS / 64;

__device__ __forceinline__ void gla_g1(const Frame& F) {
    char* KT = F.lds; char* VV = F.lds + 16384; float* ZT = (float*)(F.lds + 49152); float* SEG = (float*)(F.lds + 53248);
    const u16* Kg = F.W<u16>(GL_K); const u16* Vg = F.W<u16>(GL_V); const float* Zg = F.W<float>(GL_Z);
    u16* ST = F.W<u16>(GL_STATE); float* DEC = F.W<float>(GL_DEC);
#pragma unroll 1
    for (int it = F.bx; it < NBATCH * 4 * 2 * NCH; it += F.G) {
        int tid = threadIdx.x; asm volatile("" : "+v"(tid));
        const int lane = tid & 63, wid = tid >> 6, r32 = lane & 31, hi = lane >> 5, kk = tid & 127, jq = tid >> 7;
        const int c = it % NCH, dir = (it / NCH) & 1, bh = it / (2 * NCH), b = bh >> 2, h = bh & 3;
        const int s0 = 64 * c;
        int tbase, tstep;
        if (dir == 0) { tbase = (c < 4) ? b * CTXL + s0 : NCTX + b * SEQ + s0 - CTXL; tstep = 1; }
        else { tbase = (c < 4) ? b * CTXL + (CTXL - 1) - s0 : NCTX + b * SEQ + (SEQ - 1) - (s0 - CTXL); tstep = -1; }
        __syncthreads();
        for (int i = tid; i < 1024; i += NTHR) { const int j = i >> 4, r = i & 15; ZT[i] = Zg[(size_t)(tbase + tstep * j) * 32 + dir * 16 + r]; }
#pragma unroll
        for (int q = 0; q < 4; ++q) { const int id = tid + q * NTHR, key = id >> 5, cc = (id & 31) * 8;
            *(bf16x8*)(VV + v_st<8>(key, cc)) = *(const bf16x8*)(Vg + (size_t)(tbase + tstep * key) * 1024 + h * 256 + cc); }
        float wg[16];
#pragma unroll
        for (int r = 0; r < 16; ++r) wg[r] = F.in(19)[(dir * 16 + r) * 512 + h * 128 + kk];
        const float bias = F.in(20)[dir * 512 + h * 128 + kk];
        __syncthreads();
        float cv[16]; float run = 0;
#pragma unroll
        for (int jj = 0; jj < 16; ++jj) { const int j = jq * 16 + jj; float x = bias;
#pragma unroll
            for (int r = 0; r < 16; ++r) x += ZT[j * 16 + r] * wg[r];
            run += logsig16(x); cv[jj] = run; }
        SEG[jq * 128 + kk] = run;
        __syncthreads();
        float offset = 0, total = 0;
#pragma unroll
        for (int q = 0; q < 4; ++q) { const float sv = SEG[q * 128 + kk]; total += sv; if (q < jq) offset += sv; }
        u32x4 w0, w1;
#pragma unroll
        for (int i = 0; i < 8; ++i) {
            const int j0 = jq * 16 + 2 * i;
            const float k0 = bf2f(Kg[(size_t)(tbase + tstep * j0) * 512 + h * 128 + kk]) * __expf(total - (offset + cv[2 * i]));
            const float k1 = bf2f(Kg[(size_t)(tbase + tstep * (j0 + 1)) * 512 + h * 128 + kk]) * __expf(total - (offset + cv[2 * i + 1]));
            const unsigned pk = cvtpk(k0, k1); if (i < 4) w0[i] = pk; else w1[i - 4] = pk; }
        *(u32x4*)(KT + kk * 128 + (((jq * 2) ^ ((kk >> 1) & 7)) << 4)) = w0;
        *(u32x4*)(KT + kk * 128 + (((jq * 2 + 1) ^ ((kk >> 1) & 7)) << 4)) = w1;
        if (jq == 0) DEC[(size_t)it * 128 + kk] = __expf(total);
        __syncthreads();
        const int mt = wid & 3, vb = (wid >> 2) * 4;
        const int row = mt * 32 + r32, ab = row * 128 + ((hi ^ ((row >> 1) & 7)) << 4);
        const bf16x8 pa0 = *(const bf16x8*)(KT + (ab ^ 0)), pa1 = *(const bf16x8*)(KT + (ab ^ 32)), pa2 = *(const bf16x8*)(KT + (ab ^ 64)), pa3 = *(const bf16x8*)(KT + (ab ^ 96));
        f32x16 acc[4];
#pragma unroll
        for (int n = 0; n < 4; ++n) acc[n] = f32x16{};
        const int vbase = (int)(uintptr_t)VV + v_rd_base(lane) + vb * 512;
        pv_one<0, 8>(acc[0], vbase, pa0, pa1, pa2, pa3); pv_one<1, 8>(acc[1], vbase, pa0, pa1, pa2, pa3);
        pv_one<2, 8>(acc[2], vbase, pa0, pa1, pa2, pa3); pv_one<3, 8>(acc[3], vbase, pa0, pa1, pa2, pa3);
        u16* S = ST + (size_t)it * 128 * 256;
#pragma unroll
        for (int n = 0; n < 4; ++n)
#pragma unroll
            for (int r = 0; r < 16; ++r) S[(mt * 32 + crow(r, hi)) * 256 + (vb + n) * 32 + r32] = f2bf(acc[n][r]);
    }
}
__device__ __forceinline__ void gla_g2(const Frame& F) {
    u16* ST = F.W<u16>(GL_STATE); const float* DEC = F.W<float>(GL_DEC);
    for (int g = F.bx * NTHR + threadIdx.x; g < 32 * 4096; g += F.G * NTHR) {
        const int chain = g >> 12, e = g & 4095, kk = e >> 5, v8 = (e & 31) * 8;
        u16* p = ST + ((size_t)chain * NCH * 128 + kk) * 256 + v8; const float* d = DEC + (size_t)chain * NCH * 128 + kk;
        float f[8];
#pragma unroll
        for (int i = 0; i < 8; ++i) f[i] = 0.f;
        for (int c = 0; c < NCH; c += 4) {
            bf16x8 kv[4]; float dc[4];
#pragma unroll
            for (int u = 0; u < 4; ++u) { kv[u] = *(const bf16x8*)(p + (size_t)(c + u) * 128 * 256); dc[u] = d[(size_t)(c + u) * 128]; }
#pragma unroll
            for (int u = 0; u < 4; ++u) {
                u32x4 w = {cvtpk(f[0], f[1]), cvtpk(f[2], f[3]), cvtpk(f[4], f[5]), cvtpk(f[6], f[7])};
                *(u32x4*)(p + (size_t)(c + u) * 128 * 256) = w;
#pragma unroll
                for (int i = 0; i < 8; ++i) f[i] = dc[u] * f[i] + bf2f((u16)kv[u][i]);
            }
        }
    }
}
__device__ __forceinline__ void gla_g3(const Frame& F) {
    char* QD = F.lds; char* KI = F.lds + 16384; char* VV = F.lds + 32768; char* SS = F.lds + 65536; float* OL = (float*)(F.lds + 65536);
    float* ZT = (float*)(F.lds + 132096); float* SEG = (float*)(F.lds + 136192);
    const u16* Qg = F.W<u16>(GL_Q); const u16* Kg = F.W<u16>(GL_K); const u16* Vg = F.W<u16>(GL_V); const u16* Gg = F.W<u16>(GL_G); const float* Zg = F.W<float>(GL_Z);
    const u16* ST = F.W<u16>(GL_STATE); u16* OUT = F.W<u16>(WS_H);
#pragma unroll 1
    for (int it = F.bx; it < NBATCH * 4 * NCH; it += F.G) {
        int tid = threadIdx.x; asm volatile("" : "+v"(tid));
        const int lane = tid & 63, wid = tid >> 6, r32 = lane & 31, hi = lane >> 5, kk = tid & 127, jq = tid >> 7;
        const int T = it % NCH, bh = it / NCH, b = bh >> 2, h = bh & 3;
        const int t0 = (T < 4) ? b * CTXL + 64 * T : NCTX + b * SEQ + 64 * (T - 4);
        __syncthreads();
#pragma unroll
        for (int q = 0; q < 4; ++q) { const int id = tid + q * NTHR, key = id >> 5, cc = (id & 31) * 8;
            *(bf16x8*)(VV + v_st<8>(key, cc)) = *(const bf16x8*)(Vg + (size_t)(t0 + key) * 1024 + h * 256 + cc); }
        const int itile = wid & 1, vb = (wid >> 1) * 2;
        f32x16 acc[2]; acc[0] = f32x16{}; acc[1] = f32x16{};
#pragma unroll 1
        for (int dir = 0; dir < 2; ++dir) {
            const int cd = dir == 0 ? T : (T < 4 ? 3 - T : 135 - T);
            const u16* Ssrc = ST + (size_t)((bh * 2 + dir) * NCH + cd) * 128 * 256;
#pragma unroll
            for (int q = 0; q < 8; ++q) { const int id = tid + q * NTHR, key = id >> 5, cc = (id & 31) * 8;
                *(bf16x8*)(SS + v_st<8>(key, cc)) = *(const bf16x8*)(Ssrc + (size_t)key * 256 + cc); }
            for (int i = tid; i < 1024; i += NTHR) { const int j = i >> 4, r = i & 15; ZT[i] = Zg[(size_t)(t0 + j) * 32 + dir * 16 + r]; }
            float wg[16];
#pragma unroll
            for (int r = 0; r < 16; ++r) wg[r] = F.in(19)[(dir * 16 + r) * 512 + h * 128 + kk];
            const float bias = F.in(20)[dir * 512 + h * 128 + kk];
            __syncthreads();
            float cv[16]; float run = 0;
#pragma unroll
            for (int u = 0; u < 16; ++u) { const int j = jq * 16 + u; float x = bias;
#pragma unroll
                for (int r = 0; r < 16; ++r) x += ZT[j * 16 + r] * wg[r];
                cv[u] = logsig16(x); }
            if (dir == 0) {
#pragma unroll
                for (int u = 0; u < 16; ++u) { run += cv[u]; cv[u] = run; }
            } else {
#pragma unroll
                for (int u = 15; u >= 0; --u) { run += cv[u]; cv[u] = run; }
            }
            SEG[jq * 128 + kk] = run;
            __syncthreads();
            float offset = 0;
#pragma unroll
            for (int q = 0; q < 4; ++q) { const float sv = SEG[q * 128 + kk]; if (dir == 0 ? (q < jq) : (q > jq)) offset += sv; }
            const int adb = jq * 4096 + ((kk >> 3) << 4) + (kk & 7) * 2;
#pragma unroll
            for (int jj = 0; jj < 16; ++jj) { const int i = jq * 16 + jj; const float cum = offset + cv[jj];
                const float qv = bf2f(Qg[(size_t)(t0 + i) * 512 + h * 128 + kk]) * __expf(cum);
                const float kv = bf2f(Kg[(size_t)(t0 + i) * 512 + h * 128 + kk]) * __expf(-cum);
                const int ad = (adb ^ (jj << 4)) + jj * 256;
                *(u16*)(QD + ad) = f2bf(qv); *(u16*)(KI + ad) = f2bf(kv); }
            __syncthreads();
            {
                const int row = itile * 32 + r32; bf16x8 qa[8];
#pragma unroll
                for (int ks = 0; ks < 8; ++ks) qa[ks] = *(const bf16x8*)(QD + row * 256 + (((ks * 2 + hi) ^ (row & 15)) << 4));
                const int ssb = (int)(uintptr_t)SS + v_rd_base(lane) + vb * 512;
                pv_one<0, 8>(acc[0], ssb, qa[0], qa[1], qa[2], qa[3]); pv_one<0, 8>(acc[0], ssb + 32768, qa[4], qa[5], qa[6], qa[7]);
                pv_one<1, 8>(acc[1], ssb, qa[0], qa[1], qa[2], qa[3]); pv_one<1, 8>(acc[1], ssb + 32768, qa[4], qa[5], qa[6], qa[7]);
                f32x16 p0 = f32x16{}, p1 = f32x16{};
#pragma unroll
                for (int ks = 0; ks < 8; ++ks) {
                    const bf16x8 k0 = *(const bf16x8*)(KI + r32 * 256 + (((ks * 2 + hi) ^ (r32 & 15)) << 4));
                    const bf16x8 k1 = *(const bf16x8*)(KI + (32 + r32) * 256 + (((ks * 2 + hi) ^ (r32 & 15)) << 4));
                    p0 = __builtin_amdgcn_mfma_f32_32x32x16_bf16(k0, qa[ks], p0, 0, 0, 0);
                    p1 = __builtin_amdgcn_mfma_f32_32x32x16_bf16(k1, qa[ks], p1, 0, 0, 0);
                }
                const int iq = itile * 32 + r32;
#pragma unroll
                for (int r = 0; r < 16; ++r) { const int s0 = crow(r, hi), s1 = 32 + s0;
                    const bool k0 = dir == 0 ? (s0 <= iq) : (s0 >= iq), k1 = dir == 0 ? (s1 <= iq) : (s1 >= iq);
                    p0[r] = k0 ? p0[r] : 0.f; p1[r] = k1 ? p1[r] : 0.f; }
                bf16x8 pa0, pa1, pa2, pa3;
                PK4(p0, 0, pa0); PK4(p0, 8, pa1); PK4(p1, 0, pa2); PK4(p1, 8, pa3);
                const int vvb = (int)(uintptr_t)VV + v_rd_base(lane) + vb * 512;
                pv_one<0, 8>(acc[0], vvb, pa0, pa1, pa2, pa3); pv_one<1, 8>(acc[1], vvb, pa0, pa1, pa2, pa3);
            }
            __syncthreads();
        }
        float* olb = OL + (itile * 32 + 4 * hi) * 260 + vb * 32 + r32;
#pragma unroll
        for (int n = 0; n < 2; ++n)
#pragma unroll
            for (int r = 0; r < 16; ++r) olb[((r & 3) + 8 * (r >> 2)) * 260 + n * 32] = acc[n][r];
        __syncthreads();
        {
            const int i = tid >> 3, sg = tid & 7; const float* ol = OL + i * 260 + sg * 32;
            float ss = 0;
#pragma unroll
            for (int u = 0; u < 8; ++u) { const f32x4 t = *(const f32x4*)(ol + u * 4); ss += t[0] * t[0] + t[1] * t[1] + t[2] * t[2] + t[3] * t[3]; }
            ss += __shfl_xor(ss, 1); ss += __shfl_xor(ss, 2); ss += __shfl_xor(ss, 4);
            const float rinv = rsqrtf(ss * (1.f / 256.f) + EPS);
            const u16* gp = Gg + (size_t)(t0 + i) * 1024 + h * 256 + sg * 32; u16* op = OUT + (size_t)(t0 + i) * 1024 + h * 256 + sg * 32;
            const float* hn = F.in(21) + sg * 32;
#pragma unroll
            for (int q = 0; q < 4; ++q) { const bf16x8 g8 = *(const bf16x8*)(gp + q * 8); u32x4 w;
                const f32x4 oa = *(const f32x4*)(ol + q * 8), ob = *(const f32x4*)(ol + q * 8 + 4);
                const float o8[8] = {oa[0], oa[1], oa[2], oa[3], ob[0], ob[1], ob[2], ob[3]};
#pragma unroll
                for (int u = 0; u < 4; ++u) { const int e0 = q * 8 + 2 * u;
                    w[u] = cvtpk(o8[2 * u] * rinv * hn[e0] * silu_f(bf2f((u16)g8[2 * u])), o8[2 * u + 1] * rinv * hn[e0 + 1] * silu_f(bf2f((u16)g8[2 * u + 1]))); }
                *(u32x4*)(op + q * 8) = w; }
        }
    }
}

__device__ __forceinline__ void pair_decode(int p, int& elo, int& ehi) { elo = p < 3 ? 0 : (p < 5 ? 1 : 2); ehi = p < 3 ? p + 1 : (p < 5 ? p - 1 : 3); }
struct MoeATiles {
    typedef GTile<RowsGather, RowsPlain, EpiMoeA> Tile; static constexpr bool EP_CONST = false; EpiMoeA ep;
    const int* tab; u16* H; const int* rowtok; const u16* wgu; u16* act; const float* roww; int nmt, bx, G;
    __device__ __forceinline__ bool get(int i, Tile& t) const {
        int mt, nt; if (!tile_seq(i, bx, G, nmt, 16, mt, nt)) return false;
        const int c = tab[32 + mt], g = c / 6; int elo, ehi; pair_decode(c % 6, elo, ehi);
        const int half = nt >> 3, e = half ? ehi : elo;
        t.al = RowsGather{H, 1024, rowtok};
        t.bl = RowsPlain{wgu + ((size_t)(g * 4 + e) * 1024 + (nt & 7) * 128) * 1024, 1024};
        t.ep = EpiMoeA{act, roww, half, half * 512 + (nt & 7) * 64};
        t.brow = mt * 256; t.bcol = 0; return true; }
};
struct MoeBTiles {
    typedef GTile<RowsPlain, RowsSplitK, EpiMoeB> Tile; static constexpr bool EP_CONST = false; EpiMoeB ep;
    const int* tab; ResCtx F; int li; const u16* wd; const u16* act; const int* rowtok; int nmt, bx, G;
    __device__ __forceinline__ bool get(int i, Tile& t) const {
        int mt, nt; if (!tile_seq(i, bx, G, nmt, 8, mt, nt)) return false;
        const int c = tab[32 + mt], g = c / 6; int elo, ehi; pair_decode(c % 6, elo, ehi);
        t.al = RowsPlain{act, 1024};
        t.bl = RowsSplitK{wd + (size_t)(g * 4 + elo) * 1024 * 512, wd + (size_t)(g * 4 + ehi) * 1024 * 512, 512, 8};
        t.ep = EpiMoeB{F, li, rowtok};
        t.brow = mt * 256; t.bcol = nt * 128; return true; }
};
__device__ __forceinline__ void moe_gemm_a(const Frame& F, int li) {
    int* tab = (int*)(F.lds + LDS_TAB); moe_table(F, li, tab);
    const int nmt = tab[24] >> 8;
    pg8::MoeAOrder S8{F.W<u16>(WS_H), tab, F.W<int>(WS_ROWTOK), F.W<u16>(WS_MOEW), nmt, F.bx, F.G}; pg8::EpiMoeA8 E8{F.W<u16>(MOE_ACT), F.W<float>(WS_ROWW)};
    pg8::gemm_phase(F.lds, 1024, 1024, S8, E8);
}
__device__ __forceinline__ void moe_gemm_b(const Frame& F, int li) {
    int* tab = (int*)(F.lds + LDS_TAB); moe_table(F, li, tab);
    const int nmt = tab[24] >> 8;
    MoeBOrder S8{F.W<u16>(MOE_ACT), tab, F.W<u16>(WS_MOEW + MOE_WGU_BYTES), nmt, F.bx, F.G}; EpiMoeB8 E8{res_ctx(F), li, F.W<int>(WS_ROWTOK)};
    pg8::gemm_phase(F.lds, 1024, 1024, S8, E8);
}
__device__ __forceinline__ void final_norm(const Frame& F) {
    const int lane = threadIdx.x & 63, wid = threadIdx.x >> 6;
    for (int row = F.bx * NWAVE + wid; row < NLAT; row += F.G * NWAVE) {
        float* xr = F.out + (size_t)row * DM; f32x4 v[4];
#pragma unroll
        for (int i = 0; i < 4; ++i) v[i] = *(const f32x4*)(xr + i * 256 + lane * 4);
        float ss = 0;
#pragma unroll
        for (int i = 0; i < 4; ++i) ss += v[i][0] * v[i][0] + v[i][1] * v[i][1] + v[i][2] * v[i][2] + v[i][3] * v[i][3];
        ss = wave_sum(ss); const float rinv = rsqrtf(ss * (1.f / DM) + EPS);
#pragma unroll
        for (int i = 0; i < 4; ++i) { const f32x4 g = *(const f32x4*)(F.in(30) + i * 256 + lane * 4);
            f32x4 o = {v[i][0] * rinv * g[0], v[i][1] * rinv * g[1], v[i][2] * rinv * g[2], v[i][3] * rinv * g[3]};
            *(f32x4*)(xr + i * 256 + lane * 4) = o; }
    }
}

constexpr int N_PHASES = 42;
__global__ void __launch_bounds__(NTHR, 2) fwd_kernel(Params p) {
    extern __shared__ __attribute__((aligned(16))) char lds[];
    Frame F; F.p = &p; F.ws = p.ws; F.lds = lds; F.out = p.out; F.G = (int)gridDim.x; F.bx = (int)blockIdx.x;
    const int lo = p.ph_lo, hi = p.ph_hi;
#if !MK_PER_PHASE
    if (threadIdx.x == 0) *(uint4*)(lds + LDS_BARW) = make_uint4(0u, 0u, 0u, 0u);
    __syncthreads();
    XcdBarrier bar = xcd_barrier_post((unsigned*)(p.ws + WS_CTL), (volatile LAS unsigned*)(lds + LDS_BARW));
#define GRID_BAR() xcd_barrier(bar)
#else
#define GRID_BAR() do {} while (0)
#endif
#ifndef MK_EN
#define MK_EN 0xFFFFFFFFu
#endif
#define EN(g) (((MK_EN) >> (g)) & 1u)
#ifndef MK_REP
#define MK_REP 0u
#endif
#define REP(g) (((MK_REP) >> (g)) & 1u)
#define IN(k) (lo <= (k) && (k) < hi)
#define SEAM(k) do { if ((k) + 1 < hi) GRID_BAR(); } while (0)
#define DUP(g, body) do { body; if (REP(g)) { GRID_BAR(); body; } } while (0)

    if (EN(0) && IN(0)) { DUP(0, (p0_mods(F), __syncthreads(), p0_rope(F), p0_weights(F))); SEAM(0); }

#define LAYER(LI) { constexpr int li = (LI); constexpr int base = 1 + li * 10; constexpr bool first = li == 0, last = li == DEPTH - 1; constexpr int kind = li % 3, j = li / 3; \
        if (EN(1) && IN(base + 0)) { DUP(1, norm_phase<false>(F, li, 0, first)); SEAM(base + 0); } \
        if constexpr (kind == 0) { \
            if (EN(2) && IN(base + 1)) { EpiMlaDown ep{F.W<u16>(MLA_CN), F.W<float>(MLA_DQ), F.W<u16>(MLA_KPE), F.W<unsigned>(WS_CTL) + CW_PEMAX + li * 4}; \
                gemm_phase<4, 2>(F, RowsPlain{F.W<u16>(WS_H), 1024}, RowsPlain{F.W<u16>(WS_WDQKV) + (size_t)j * 640 * 1024, 1024}, ep, 0, 132, 5, 16, 0, 0); SEAM(base + 1); } \
            if (EN(2) && IN(base + 3)) { pg8::MlaUpOrder S8{F.W<u16>(MLA_CN), F.W<u16>(WS_WUQ) + (size_t)j * 1536 * 256, F.W<u16>(WS_WUKV) + (size_t)j * 2048 * 256, F.bx, F.G}; \
                pg8::EpiMlaUp8 E8{F.W<u16>(MLA_Q), F.W<u16>(MLA_KN), (long)((MLA_V - MLA_KN) / 2), 0.10206207261596577f * LOG2E, F.W<unsigned>(WS_CTL) + CW_KMAX + li * 128, F.W<float>(MLA_DQ)}; \
                pg8::gemm_phase(F.lds, 512, 256, S8, E8); SEAM(base + 3); } \
            if (EN(4) && IN(base + 4)) { DUP(4, mla_attn(F, !last, li)); SEAM(base + 4); } \
            if (EN(2) && IN(base + 5)) { pg8::SeqOrder S8{F.W<u16>(MLA_DQ), F.W<u16>(WS_WOM) + (size_t)j * 1024 * 1024, 1024, last ? 128 : 132, 4, F.bx, F.G, last ? 4 : 0}; EpiResid8 E8{res_ctx(F, first), li}; \
                pg8::gemm_phase(F.lds, 1024, 1024, S8, E8); SEAM(base + 5); } \
        } else if constexpr (kind == 1) { \
            if (EN(5) && IN(base + 1)) { pg8::SeqOrder S8{F.W<u16>(WS_H), F.W<u16>(WS_WQKVD), 1024, 132, 12, F.bx, F.G, 0}; pg8::EpiDiffQKV8 E8{F.W<u16>(DF_Q), (long)((DF_K - DF_Q) / 2), F.W<u16>(DF_V), 0.125f * LOG2E, F.W<unsigned>(WS_CTL) + CW_KMAX + li * 128}; \
                pg8::gemm_phase(F.lds, 1024, 1024, S8, E8); \
                if (REP(5)) { GRID_BAR(); pg8::gemm_phase(F.lds, 1024, 1024, S8, E8); } SEAM(base + 1); } \
            if (EN(6) && IN(base + 2)) { DUP(6, diff_attn(F, li)); SEAM(base + 2); } \
            if (EN(7) && IN(base + 3)) { DUP(7, diff_rowpass(F, 0.35550906759906f)); SEAM(base + 3); } \
            if (EN(5) && IN(base + 4)) { pg8::SeqOrder S8{F.W<u16>(DF_Q), F.W<u16>(WS_WOD), 1024, 132, 4, F.bx, F.G, 0}; EpiResid8 E8{res_ctx(F, first), li}; \
                pg8::gemm_phase(F.lds, 1024, 1024, S8, E8); SEAM(base + 4); } \
        } else { \
            if (EN(8) && IN(base + 1)) { pg8::SeqOrder S8{F.W<u16>(WS_H), F.W<u16>(WS_WING), 1024, 132, 13, F.bx, F.G, 0}; pg8::EpiGlaIn8 E8{F.W<u16>(GL_Q), F.W<u16>(GL_K), F.W<u16>(GL_V), F.W<u16>(GL_G), F.W<float>(GL_Z)}; \
                pg8::gemm_phase(F.lds, 1024, 1024, S8, E8); \
                if (REP(8)) { GRID_BAR(); pg8::gemm_phase(F.lds, 1024, 1024, S8, E8); } SEAM(base + 1); } \
            if (EN(9) && IN(base + 2)) { DUP(9, gla_g1(F)); SEAM(base + 2); } \
            if (EN(10) && IN(base + 3)) { gla_g2(F); SEAM(base + 3); } \
            if (EN(11) && IN(base + 4)) { DUP(11, gla_g3(F)); SEAM(base + 4); } \
            if (EN(8) && IN(base + 5)) { pg8::SeqOrder S8{F.W<u16>(WS_H), F.W<u16>(WS_WOG), 1024, 132, 4, F.bx, F.G, 0}; EpiResid8 E8{res_ctx(F, first), li}; \
                pg8::gemm_phase(F.lds, 1024, 1024, S8, E8); SEAM(base + 5); } \
        } \
        if (EN(12) && IN(base + 6)) { norm_phase<true>(F, li, last ? NCTX : 0, false); SEAM(base + 6); } \
        if (EN(13) && IN(base + 7)) { DUP(13, ((kind == 2 ? moe_weights(F, li) : (void)0), moe_scatter(F, li, last ? NCTX : 0))); SEAM(base + 7); } \
        if (EN(14) && IN(base + 8)) { DUP(14, moe_gemm_a(F, li)); SEAM(base + 8); } \
        if (EN(15) && IN(base + 9)) { moe_gemm_b(F, li); SEAM(base + 9); } \
    }
    LAYER(0) LAYER(1) LAYER(2) LAYER(3)
    if (EN(16) && IN(41)) { final_norm(F); }
}

extern "C" void kernel_launch(void* const* d_in, const int* in_sizes, int n_in, void* d_out, int out_size, void* d_ws, size_t ws_size, hipStream_t stream) {
    static int grid = 0;
    if (grid == 0) {
        if (n_in != 31 || out_size != NLAT * DM || ws_size < WS_END) {
            fprintf(stderr, "kernel_launch: built for 31 inputs, out %d floats, ws >= %zu bytes; got n_in %d out %d ws %zu\n", NLAT * DM, (size_t)WS_END, n_in, out_size, ws_size);
            grid = -1; return; }
        int dev = 0, cus = 0;
        if (hipGetDevice(&dev) != hipSuccess || hipDeviceGetAttribute(&cus, hipDeviceAttributeMultiprocessorCount, dev) != hipSuccess) { grid = -1; return; }
        if (hipFuncSetAttribute((const void*)fwd_kernel, hipFuncAttributeMaxDynamicSharedMemorySize, LDS_BYTES) != hipSuccess) { fprintf(stderr, "kernel_launch: hipFuncSetAttribute failed\n"); grid = -1; return; }
        int per_cu = 0;
        if (hipOccupancyMaxActiveBlocksPerMultiprocessor(&per_cu, (const void*)fwd_kernel, NTHR, LDS_BYTES) != hipSuccess || per_cu < 1)
            fprintf(stderr, "kernel_launch: occupancy query reports %d workgroups per CU\n", per_cu);
        (void)hipGetLastError();
        grid = cus;
    }
    if (grid < 0) return;
    (void)in_sizes;
    (void)hipMemsetAsync((char*)d_ws + WS_CTL, 0, CTL_BYTES, stream);
    Params p{};
    for (int i = 0; i < 31; ++i) p.in[i] = (const float*)d_in[i];
    p.out = (float*)d_out; p.ws = (unsigned char*)d_ws;
#if MK_PER_PHASE
    for (int ph = 0; ph < N_PHASES; ++ph) { p.ph_lo = ph; p.ph_hi = ph + 1; hipLaunchKernelGGL(fwd_kernel, dim3(grid), dim3(NTHR), LDS_BYTES, stream, p); }
#else
#ifdef MK_PROBE_HI
    p.ph_lo = 0; p.ph_hi = MK_PROBE_HI;
    hipLaunchKernelGGL(fwd_kernel, dim3(grid), dim3(NTHR), LDS_BYTES, stream, p);
    (void)hipMemsetAsync((char*)d_ws + WS_CTL, 0, CTL_BYTES, stream);
#endif
    p.ph_lo = 0; p.ph_hi = N_PHASES;
    hipLaunchKernelGGL(fwd_kernel, dim3(grid), dim3(NTHR), LDS_BYTES, stream, p);
#endif
}
```

```cpp
#include <hip/hip_runtime.h>
#include <stdint.h>
#include <stdio.h>

#ifndef MK_PER_PHASE
#define MK_PER_PHASE 0
#endif

typedef unsigned short u16;
using bf16x8 = __attribute__((ext_vector_type(8))) short;
using s16x4  = __attribute__((ext_vector_type(4))) short;
using f32x16 = __attribute__((ext_vector_type(16))) float;
using f32x4  = __attribute__((ext_vector_type(4))) float;
using u32x4  = __attribute__((ext_vector_type(4))) unsigned;
using u32x2  = __attribute__((ext_vector_type(2))) unsigned;

constexpr int DM = 1024, NBATCH = 4, SEQ = 8192, CTXL = 256, DEPTH = 4;
constexpr int NCTX = NBATCH * CTXL;
constexpr int NLAT = NBATCH * SEQ;
constexpr int NTOK = NCTX + NLAT;
constexpr int KEYS = CTXL + SEQ;
constexpr float EPS = 1e-6f;
constexpr int NTHR = 512, NWAVE = 8;
constexpr float LOG2E = 1.4426950408889634f;

constexpr size_t al256(size_t x) { return (x + 255) / 256 * 256; }
constexpr size_t WS_CTL   = 0;
constexpr size_t CTL_BYTES = 32768;
constexpr size_t WS_MODS  = WS_CTL + CTL_BYTES;
constexpr size_t WS_ROPEA = WS_MODS + al256((size_t)DEPTH * 5 * 6144 * 4);
constexpr size_t WS_ROPEB = WS_ROPEA + (size_t)2 * SEQ * 16 * 4;
constexpr size_t WS_XC    = WS_ROPEB + (size_t)2 * SEQ * 32 * 4;
constexpr size_t WS_WDQKV = WS_XC + (size_t)NCTX * DM * 4;
constexpr size_t WS_WUQ   = WS_WDQKV + (size_t)2 * 640 * 1024 * 2;
constexpr size_t WS_WUKV  = WS_WUQ + (size_t)2 * 1536 * 256 * 2;
constexpr size_t WS_WOM   = WS_WUKV + (size_t)2 * 2048 * 256 * 2;
constexpr size_t WS_WQKVD = WS_WOM + (size_t)2 * 1024 * 1024 * 2;
constexpr size_t WS_WOD   = WS_WQKVD + (size_t)3072 * 1024 * 2;
constexpr size_t WS_WING  = WS_WOD + (size_t)1024 * 1024 * 2;
constexpr size_t WS_WOG   = WS_WING + (size_t)3328 * 1024 * 2;
constexpr size_t WS_TOK   = WS_WOG + (size_t)1024 * 1024 * 2;
constexpr size_t WS_ROWTOK= WS_TOK + (size_t)NTOK * 16;
constexpr int    RMAX     = 40960;
constexpr size_t WS_ROWW  = WS_ROWTOK + (size_t)RMAX * 4;
constexpr size_t WS_H     = al256(WS_ROWW + (size_t)RMAX * 8);
constexpr size_t H_BYTES  = (size_t)NTOK * DM * 2;
constexpr size_t WS_MOEW  = WS_H + H_BYTES;
constexpr size_t MOE_WGU_BYTES = (size_t)16 * 1024 * 1024 * 2;
constexpr size_t MOE_WD_BYTES  = (size_t)16 * 1024 * 512 * 2;
constexpr size_t MOEW_BYTES = MOE_WGU_BYTES + MOE_WD_BYTES;
constexpr size_t WS_BIG   = WS_MOEW + MOEW_BYTES;
constexpr size_t MLA_Q    = WS_BIG;
constexpr size_t MLA_KN   = MLA_Q + (size_t)NBATCH * 16 * KEYS * 96 * 2;
constexpr size_t MLA_V    = MLA_KN + (size_t)NBATCH * 16 * KEYS * 64 * 2;
constexpr size_t MLA_KPE  = MLA_V + (size_t)NBATCH * 16 * KEYS * 64 * 2;
constexpr size_t MLA_DQ   = MLA_KPE + al256((size_t)NBATCH * KEYS * 32 * 2);
constexpr size_t MLA_CN   = MLA_DQ + (size_t)NTOK * 544 * 4;
constexpr size_t MLA_END  = MLA_CN + (size_t)NTOK * 512 * 2;
constexpr size_t DF_Q     = WS_BIG;
constexpr size_t DF_K     = DF_Q + (size_t)NBATCH * 16 * KEYS * 64 * 2;
constexpr size_t DF_V     = DF_K + (size_t)NBATCH * 16 * KEYS * 64 * 2;
constexpr size_t DF_OS    = DF_V + (size_t)NBATCH * 8 * KEYS * 128 * 2;
constexpr size_t DF_END   = DF_OS + (size_t)2 * NTOK * DM * 2;
constexpr size_t GL_STATE = WS_MOEW;
constexpr size_t GL_STATE_BYTES = (size_t)NBATCH * 4 * 2 * 132 * 128 * 256 * 2;
constexpr size_t GL_DEC   = GL_STATE + GL_STATE_BYTES;
constexpr size_t GL_Q     = GL_DEC + al256((size_t)4224 * 128 * 4);
constexpr size_t GL_K     = GL_Q + (size_t)NTOK * 512 * 2;
constexpr size_t GL_V     = GL_K + (size_t)NTOK * 512 * 2;
constexpr size_t GL_G     = GL_V + (size_t)NTOK * 1024 * 2;
constexpr size_t GL_Z     = GL_G + (size_t)NTOK * 1024 * 2;
constexpr size_t GL_END   = GL_Z + (size_t)NTOK * 32 * 4;
constexpr size_t MOE_ACT  = WS_BIG;
constexpr size_t MOE_END  = MOE_ACT + (size_t)RMAX * 1024 * 2;
constexpr size_t cmax(size_t a, size_t b) { return a > b ? a : b; }
constexpr size_t WS_END   = cmax(cmax(MLA_END, DF_END), cmax(GL_END, MOE_END));

#define XCD_BAR_WORDS 3456
constexpr int CW_CNT = 4096;
constexpr int CW_KMAX = 4352;
constexpr int CW_PEMAX = CW_KMAX + 512;

#define XB_TMO      128
#define XB_XCNT(j)  (256  + 64 * (j))
#define XB_XSUB(j)  (1280 + 64 * (j))
#define XB_XGEN(j)  (2304 + 64 * (j))
#define XB_TOP      3328
#define XB_TOPGEN   3392
#define XB_SPIN_CAP (1u << 24)
#define LAS __attribute__((address_space(3)))
__device__ __forceinline__ unsigned xb_ld(unsigned* p)              { return __hip_atomic_load(p, __ATOMIC_RELAXED, __HIP_MEMORY_SCOPE_AGENT); }
__device__ __forceinline__ unsigned xb_add(unsigned* p, unsigned v) { return __hip_atomic_fetch_add(p, v, __ATOMIC_RELAXED, __HIP_MEMORY_SCOPE_AGENT); }
__device__ __forceinline__ unsigned xb_xcc_id() { return (unsigned)__builtin_amdgcn_s_getreg((3 << 11) | 20) & 0xFu; }
#define XB_SPIN(cond, bar) do { unsigned _sp = 0; while (cond) { __builtin_amdgcn_s_sleep(1); \
    if ((++_sp & 255u) == 0u) { if (xb_ld(&(bar)[XB_TMO])) break; if (_sp > XB_SPIN_CAP) { atomicAdd(&(bar)[XB_TMO], 1u); break; } } } } while (0)
struct XcdBarrier { unsigned* bar; unsigned x; volatile LAS unsigned* st; };
__device__ __forceinline__ XcdBarrier xcd_barrier_post(unsigned* bar, volatile LAS unsigned* st) {
    XcdBarrier b; b.bar = bar; b.x = xb_xcc_id(); b.st = st;
    if (threadIdx.x == 0) (void)xb_add(&bar[XB_XCNT(b.x)], 1u);
    return b;
}
__device__ __forceinline__ void xcd_barrier_complete(unsigned* bar, unsigned x, unsigned& nloc, unsigned& nx) {
    const unsigned G = gridDim.x * gridDim.y * gridDim.z;
    unsigned sum, cnt, mine, sp = 0u;
    for (;;) {
        sum = 0u; cnt = 0u; mine = 0u;
#pragma unroll
        for (unsigned j = 0; j < 16; ++j) { const unsigned c = xb_ld(&bar[XB_XCNT(j)]); sum += c; cnt += (c > 0u) ? 1u : 0u; mine = (j == x) ? c : mine; }
        if (sum == G) break;
        __builtin_amdgcn_s_sleep(1);
        if ((++sp & 255u) == 0u) { if (xb_ld(&bar[XB_TMO])) break; if (sp > XB_SPIN_CAP) { atomicAdd(&bar[XB_TMO], 1u); break; } }
    }
    nloc = mine > 0u ? mine : 1u; nx = cnt > 0u ? cnt : 1u;
}
__device__ __forceinline__ void xcd_barrier(const XcdBarrier& b) {
    asm volatile("s_waitcnt vmcnt(0)" ::: "memory");
    __syncthreads();
    if (threadIdx.x == 0) {
        unsigned* bar = b.bar;
        __builtin_amdgcn_s_waitcnt(0);
        unsigned nloc = b.st[0], nx = b.st[1];
        if (nloc == 0u) { xcd_barrier_complete(bar, b.x, nloc, nx); b.st[0] = nloc; b.st[1] = nx; }
        const unsigned old = xb_add(&bar[XB_XSUB(b.x)], 1u);
        const unsigned gen = old / nloc;
        if (old + 1u == (gen + 1u) * nloc) {
            __builtin_amdgcn_fence(__ATOMIC_RELEASE, "agent");
            asm volatile("s_waitcnt vmcnt(0)" ::: "memory");
            const unsigned og = xb_add(&bar[XB_TOP], 1u);
            const unsigned tg = og / nx;
            if (og + 1u == (tg + 1u) * nx) xb_add(&bar[XB_TOPGEN], 1u);
            else XB_SPIN(xb_ld(&bar[XB_TOPGEN]) == tg, bar);
            __builtin_amdgcn_fence(__ATOMIC_ACQUIRE, "agent");
            xb_add(&bar[XB_XGEN(b.x)], 1u);
            asm volatile("s_waitcnt vmcnt(0)" ::: "memory");
        } else {
            XB_SPIN(xb_ld(&bar[XB_XGEN(b.x)]) == gen, bar);
            __builtin_amdgcn_fence(__ATOMIC_ACQUIRE, "agent");
            asm volatile("s_waitcnt vmcnt(0)" ::: "memory");
        }
    }
    __syncthreads();
}

__device__ __forceinline__ u16 f2bf(float f) { unsigned u = __float_as_uint(f); u += 0x7FFFu + ((u >> 16) & 1u); return (u16)(u >> 16); }
__device__ __forceinline__ float bf2f(u16 h) { return __uint_as_float((unsigned)h << 16); }
typedef float cv_f32x2 __attribute__((ext_vector_type(2)));
typedef __bf16 cv_bf16x2 __attribute__((ext_vector_type(2)));
__device__ __forceinline__ unsigned cvtpk(float lo, float hi) { const cv_f32x2 v = {lo, hi}; return __builtin_bit_cast(unsigned, __builtin_convertvector(v, cv_bf16x2)); }
__device__ __forceinline__ unsigned cvtpk_a(float lo, float hi) { unsigned r; asm volatile("v_cvt_pk_bf16_f32 %0, %1, %2" : "=v"(r) : "v"(lo), "v"(hi)); return r; }
__device__ __forceinline__ float wave_sum(float v) {
#pragma unroll
    for (int o = 32; o; o >>= 1) v += __shfl_xor(v, o);
    return v;
}
__device__ __forceinline__ float wave_max_fast(float v) {
#define DPP_MAX(v, CTRL) (v) = fmaxf((v), __uint_as_float(__builtin_amdgcn_update_dpp(0u, __float_as_uint(v), (CTRL), 0xF, 0xF, false)))
    DPP_MAX(v, 0xB1); DPP_MAX(v, 0x4E); DPP_MAX(v, 0x141); DPP_MAX(v, 0x140);
#undef DPP_MAX
    { auto rr = __builtin_amdgcn_permlane16_swap(__float_as_uint(v), __float_as_uint(v), false, false); v = fmaxf(__uint_as_float(rr[0]), __uint_as_float(rr[1])); }
    { auto rr = __builtin_amdgcn_permlane32_swap(__float_as_uint(v), __float_as_uint(v), false, false); v = fmaxf(__uint_as_float(rr[0]), __uint_as_float(rr[1])); }
    return v;
}
__device__ __forceinline__ float sum_fq(float v) {
    { auto rr = __builtin_amdgcn_permlane16_swap(__float_as_uint(v), __float_as_uint(v), false, false); v = __uint_as_float(rr[0]) + __uint_as_float(rr[1]); }
    { auto rr = __builtin_amdgcn_permlane32_swap(__float_as_uint(v), __float_as_uint(v), false, false); v = __uint_as_float(rr[0]) + __uint_as_float(rr[1]); }
    return v;
}
__device__ __forceinline__ void atomic_fmax_pos(unsigned* p, float v) { atomicMax(p, __float_as_uint(v)); }
__device__ __forceinline__ int crow(int r, int hi) { return (r & 3) + 8 * (r >> 2) + 4 * hi; }
__device__ __forceinline__ void row_bp(int row, int& b, int& pos) {
    if (row < NCTX) { b = row >> 8; pos = row & 255; } else { const int r = row - NCTX; b = r >> 13; pos = CTXL + (r & (SEQ - 1)); }
}
__device__ __forceinline__ float silu_f(float x) { return x / (1.f + __expf(-x)); }
#define SBAR() __builtin_amdgcn_sched_barrier(0)

struct Params { const float* in[31]; float* out; unsigned char* ws; int ph_lo, ph_hi; };

struct RowsPlain  { const u16* base; long ld;
    __device__ __forceinline__ long off(int r) const { return (long)r * ld; }
    __device__ __forceinline__ const u16* kbase(int kt) const { return base + kt * 64; } };
struct RowsGather { const u16* base; long ld; const int* idx;
    __device__ __forceinline__ long off(int r) const { int t = idx[r]; t = t < 0 ? 0 : t; return (long)t * ld; }
    __device__ __forceinline__ const u16* kbase(int kt) const { return base + kt * 64; } };
struct RowsSplitK { const u16* b0; const u16* b1; long ld; int ks;
    __device__ __forceinline__ long off(int r) const { return (long)r * ld; }
    __device__ __forceinline__ const u16* kbase(int kt) const { return kt < ks ? b0 + kt * 64 : b1 + (kt - ks) * 64; } };

constexpr int GEMM_LDS = 2 * 384 * 128;

template <int WM, int WN, class AL, class BL, class EP>
__device__ __forceinline__ void gemm_tile(char* lds, const AL al, const BL bl, EP& ep, int brow, int bcol, int nk) {
    constexpr int BM = WM * 64, BN = WN * 64, STG = (BM + BN) * 128, NA = BM / 64, NB = BN / 64;
    const int tid = threadIdx.x, lane = tid & 63, wid = __builtin_amdgcn_readfirstlane(tid >> 6);
    const int wm = wid / WN, wn = wid % WN, r32 = lane & 31, hi = lane >> 5;
    long aoff[NA], boff[NB];
#pragma unroll
    for (int i = 0; i < NA; ++i) { const int r = (i * 8 + wid) * 8 + (lane >> 3); const int c = (lane & 7) ^ ((r >> 1) & 7); aoff[i] = al.off(brow + r) + c * 8; }
#pragma unroll
    for (int i = 0; i < NB; ++i) { const int r = (i * 8 + wid) * 8 + (lane >> 3); const int c = (lane & 7) ^ ((r >> 1) & 7); boff[i] = bl.off(bcol + r) + c * 8; }
    const int ldsw = wid * 1024 + lane * 16;
    int abase[2], bbase[2];
#pragma unroll
    for (int i = 0; i < 2; ++i) {
        const int ra = wm * 64 + i * 32 + r32; abase[i] = ra * 128 + ((hi ^ ((ra >> 1) & 7)) << 4);
        const int rb = wn * 64 + i * 32 + r32; bbase[i] = BM * 128 + rb * 128 + ((hi ^ ((rb >> 1) & 7)) << 4);
    }
    f32x16 acc[2][2];
#pragma unroll
    for (int i = 0; i < 2; ++i)
#pragma unroll
        for (int j = 0; j < 2; ++j) acc[i][j] = f32x16{};
#define GSTAGE(kt, buf) do { const u16* _ka = al.kbase(kt); const u16* _kb = bl.kbase(kt); char* _d = lds + (buf) * STG + ldsw; \
        _Pragma("unroll") for (int _i = 0; _i < NA; ++_i) __builtin_amdgcn_global_load_lds((const unsigned*)(_ka + aoff[_i]), (unsigned*)(_d + _i * 8192), 16, 0, 0); \
        _Pragma("unroll") for (int _i = 0; _i < NB; ++_i) __builtin_amdgcn_global_load_lds((const unsigned*)(_kb + boff[_i]), (unsigned*)(_d + BM * 128 + _i * 8192), 16, 0, 0); } while (0)
    __syncthreads();
    GSTAGE(0, 0);
    for (int kt = 0; kt < nk; ++kt) {
        asm volatile("s_waitcnt vmcnt(0)" ::: "memory");
        __syncthreads();
        if (kt + 1 < nk) GSTAGE(kt + 1, (kt + 1) & 1);
        const char* sb = lds + (kt & 1) * STG;
#pragma unroll
        for (int ks = 0; ks < 4; ++ks) {
            bf16x8 a0 = *(const bf16x8*)(sb + (abase[0] ^ (ks << 5)));
            bf16x8 a1 = *(const bf16x8*)(sb + (abase[1] ^ (ks << 5)));
            bf16x8 b0 = *(const bf16x8*)(sb + (bbase[0] ^ (ks << 5)));
            bf16x8 b1 = *(const bf16x8*)(sb + (bbase[1] ^ (ks << 5)));
            acc[0][0] = __builtin_amdgcn_mfma_f32_32x32x16_bf16(a0, b0, acc[0][0], 0, 0, 0);
            acc[0][1] = __builtin_amdgcn_mfma_f32_32x32x16_bf16(a0, b1, acc[0][1], 0, 0, 0);
            acc[1][0] = __builtin_amdgcn_mfma_f32_32x32x16_bf16(a1, b0, acc[1][0], 0, 0, 0);
            acc[1][1] = __builtin_amdgcn_mfma_f32_32x32x16_bf16(a1, b1, acc[1][1], 0, 0, 0);
        }
    }
#undef GSTAGE
    ep(acc, brow + wm * 64, bcol + wn * 64, lane);
}


constexpr int GSTG = 384 * 128;
template <class AL_, class BL_, class EP_> struct GTile { typedef EP_ EPT; AL_ al; BL_ bl; EP_ ep; int brow, bcol; };
__device__ __forceinline__ bool tile_seq(int i, int bx, int G, int nM, int nN, int& m, int& n) {
    const int s = (G == 256) ? (i * 8 + (bx & 7)) * 32 + (bx >> 3) : bx + i * G;
    if (s >= nM * nN) return false;
    const int full = (nM >> 2) * 4 * nN;
    if (s < full) { const int band = s / (4 * nN), rem = s - band * 4 * nN; n = rem >> 2; m = band * 4 + (rem & 3); }
    else { const int h = nM & 3, rem = s - full; n = rem / h; m = (nM & ~3) + rem - n * h; }
    return true;
}
template <class AL_, class BL_, class EP_> struct PlainTiles {
    typedef GTile<AL_, BL_, EP_> Tile; static constexpr bool EP_CONST = true;
    AL_ al; BL_ bl; EP_ ep; int mt0, nM, nN, bx, G;
    __device__ __forceinline__ bool get(int i, Tile& t) const {
        int m, n; if (!tile_seq(i, bx, G, nM, nN, m, n)) return false;
        t.al = al; t.bl = bl; t.ep = ep; t.brow = (mt0 + m) * 256; t.bcol = n * 128; return true; }
};
template <int WM, int WN, class P>
__device__ __forceinline__ void gemm_stream(char* lds, const P& prov, int nk) {
    constexpr int BM = WM * 64, BN = WN * 64, NA = BM / 64, NB = BN / 64;
    static_assert(NA + NB == 6, "the counted wait assumes six LDS-DMA loads per wave per K-step");
    const int tid = threadIdx.x, lane = tid & 63, wid = __builtin_amdgcn_readfirstlane(tid >> 6);
    const int wm = wid / WN, wn = wid % WN, r32 = lane & 31, hi = lane >> 5;
    typename P::Tile cur, nxt;
    if (!prov.get(0, cur)) return;
    unsigned aoff[NA], boff[NB], aoffn[NA], boffn[NB];
#define GOFFS(T, AO, BO) do { \
    _Pragma("unroll") for (int _i = 0; _i < NA; ++_i) { const int _r = (_i * 8 + wid) * 8 + (lane >> 3); const int _c = (lane & 7) ^ ((_r >> 1) & 7); AO[_i] = (unsigned)((T).al.off((T).brow + _r) + _c * 8); } \
    _Pragma("unroll") for (int _i = 0; _i < NB; ++_i) { const int _r = (_i * 8 + wid) * 8 + (lane >> 3); const int _c = (lane & 7) ^ ((_r >> 1) & 7); BO[_i] = (unsigned)((T).bl.off((T).bcol + _r) + _c * 8); } } while (0)
#define GSTAGE2(T, AO, BO, kt, slot) do { const u16* _ka = (T).al.kbase(kt); const u16* _kb = (T).bl.kbase(kt); char* _d = lds + (slot) * GSTG + ldsw; \
        _Pragma("unroll") for (int _i = 0; _i < NA; ++_i) __builtin_amdgcn_global_load_lds((const unsigned*)(_ka + AO[_i]), (unsigned*)(_d + _i * 8192), 16, 0, 0); \
        _Pragma("unroll") for (int _i = 0; _i < NB; ++_i) __builtin_amdgcn_global_load_lds((const unsigned*)(_kb + BO[_i]), (unsigned*)(_d + BM * 128 + _i * 8192), 16, 0, 0); } while (0)
    GOFFS(cur, aoff, boff);
    const int ldsw = wid * 1024 + lane * 16;
    int abase[2], bbase[2];
#pragma unroll
    for (int i = 0; i < 2; ++i) {
        const int ra = wm * 64 + i * 32 + r32; abase[i] = ra * 128 + ((hi ^ ((ra >> 1) & 7)) << 4);
        const int rb = wn * 64 + i * 32 + r32; bbase[i] = BM * 128 + rb * 128 + ((hi ^ ((rb >> 1) & 7)) << 4);
    }
    f32x16 acc[2][2];
#pragma unroll
    for (int i = 0; i < 2; ++i)
#pragma unroll
        for (int j = 0; j < 2; ++j) acc[i][j] = f32x16{};
    __syncthreads();
    GSTAGE2(cur, aoff, boff, 0, 0); GSTAGE2(cur, aoff, boff, 1, 1);
    int slot = 0; bool pendE = false; typename P::Tile::EPT pep = cur.ep; int pbrow = 0, pbcol = 0;
    for (int i = 0;; ++i) {
        const bool has_next = prov.get(i + 1, nxt);
        if (has_next) GOFFS(nxt, aoffn, boffn);
        for (int kt = 0; kt < nk; ++kt) {
            if ((kt + 1 < nk) || has_next) asm volatile("s_waitcnt vmcnt(6)" ::: "memory"); else asm volatile("s_waitcnt vmcnt(0)" ::: "memory");
            __builtin_amdgcn_s_barrier(); asm volatile("" ::: "memory");
            const int s2 = slot >= 1 ? slot - 1 : 2;
            if (kt + 2 < nk) GSTAGE2(cur, aoff, boff, kt + 2, s2); else if (has_next) GSTAGE2(nxt, aoffn, boffn, kt + 2 - nk, s2);
            if (kt == 0 && pendE) {
                if constexpr (P::EP_CONST) (void)prov.ep(acc, pbrow + wm * 64, pbcol + wn * 64, lane); else (void)pep(acc, pbrow + wm * 64, pbcol + wn * 64, lane);
                pendE = false;
#pragma unroll
                for (int a = 0; a < 2; ++a)
#pragma unroll
                    for (int b = 0; b < 2; ++b) acc[a][b] = f32x16{};
            }
            const char* sb = lds + slot * GSTG;
#pragma unroll
            for (int ks = 0; ks < 4; ++ks) {
                bf16x8 a0 = *(const bf16x8*)(sb + (abase[0] ^ (ks << 5)));
                bf16x8 a1 = *(const bf16x8*)(sb + (abase[1] ^ (ks << 5)));
                bf16x8 b0 = *(const bf16x8*)(sb + (bbase[0] ^ (ks << 5)));
                bf16x8 b1 = *(const bf16x8*)(sb + (bbase[1] ^ (ks << 5)));
                acc[0][0] = __builtin_amdgcn_mfma_f32_32x32x16_bf16(b0, a0, acc[0][0], 0, 0, 0);
                acc[0][1] = __builtin_amdgcn_mfma_f32_32x32x16_bf16(b1, a0, acc[0][1], 0, 0, 0);
                acc[1][0] = __builtin_amdgcn_mfma_f32_32x32x16_bf16(b0, a1, acc[1][0], 0, 0, 0);
                acc[1][1] = __builtin_amdgcn_mfma_f32_32x32x16_bf16(b1, a1, acc[1][1], 0, 0, 0);
            }
            slot = slot == 2 ? 0 : slot + 1;
        }
        if (!has_next) { (void)cur.ep(acc, cur.brow + wm * 64, cur.bcol + wn * 64, lane); break; }
        if constexpr (!P::EP_CONST) pep = cur.ep;
        pbrow = cur.brow; pbcol = cur.bcol; pendE = true;
        cur = nxt;
#pragma unroll
        for (int a = 0; a < NA; ++a) aoff[a] = aoffn[a];
#pragma unroll
        for (int b = 0; b < NB; ++b) boff[b] = boffn[b];
    }
    asm volatile("s_waitcnt vmcnt(0)" ::: "memory");
    __syncthreads();
#undef GOFFS
#undef GSTAGE2
}


template <int NF> __device__ __forceinline__ void rope_cs(int n, int i, float& cs, float& sn) {
    const int fi = i & (NF - 1); const float pos = (i < NF) ? (float)(n >> 6) : (float)(n & 63);
    const float invf = __builtin_amdgcn_exp2f(-(float)fi / (float)NF * 13.287712379549449f);
    const float ang = pos * invf; float rev = ang * 0.15915494309189535f; rev -= floorf(rev);
    cs = __builtin_amdgcn_cosf(rev); sn = __builtin_amdgcn_sinf(rev);
}
namespace pg8 {
constexpr int BM = 256, BK = 64, HALF = 128, HTB = HALF * BK * 2, STAGE_BYTES = 8 * HTB;
__device__ __forceinline__ int lds_byte(int r, int c) { const int st = (r >> 4) * 2 + (c >> 5), rr = r & 15, cc = c & 31, ob = rr * 64 + cc * 2; return st * 1024 + (ob ^ (((ob >> 9) & 1) << 5)); }
__device__ __forceinline__ void stage_rc(int b, int& R, int& C) { const int st = b / 1024, sb = b % 1024, swz = sb ^ (((sb >> 9) & 1) << 5); R = (st >> 1) * 16 + swz / 64; C = (st & 1) * 32 + (swz % 64) / 2; }
struct Unit { int pm, pn; };
template <class Epi, class Sched>
__device__ __forceinline__ void gemm_phase(char* lds, int lda, int K, const Sched& S, const Epi& E) {
    constexpr bool GA = Sched::GATHER, SK = Sched::SPLITK;
    const int tid = threadIdx.x, wid = __builtin_amdgcn_readfirstlane(tid >> 6), lane = tid & 63, wr = wid >> 2, wc = wid & 3, fr = lane & 15, fq = lane >> 4;
    const int nt = K / BK, ldb = SK ? (K >> 1) : K;
    unsigned voffB[2], vbA[2], vc0[2], vc1[2], vn0[2], vn1[2]; int sR[2], sC[2];
#pragma unroll
    for (int i = 0; i < 2; ++i) { stage_rc(tid * 16 + i * 8192, sR[i], sC[i]); voffB[i] = (unsigned)(sR[i] * ldb + sC[i]) * 2u; vbA[i] = (unsigned)(sR[i] * lda + sC[i]) * 2u; }
    const size_t kstep = (size_t)(BK * 2), hstep = (size_t)HALF * ldb * 2, hstepA = (size_t)HALF * lda * 2;
    const unsigned ldsw = (unsigned)wid * 1024u;
    const int aoff = lds_byte(wr * 64 + fr, fq * 8), boff = lds_byte(wc * 32 + fr, fq * 8);
#define PG8_AOFFS(u, v0, v1) do { _Pragma("unroll") for (int _i = 0; _i < 2; ++_i) { \
        if constexpr (GA) { v0[_i] = (unsigned)S.arow(u, sR[_i]) * (unsigned)(lda * 2) + (unsigned)sC[_i] * 2u; v1[_i] = (unsigned)S.arow(u, HALF + sR[_i]) * (unsigned)(lda * 2) + (unsigned)sC[_i] * 2u; } \
        else { v0[_i] = vbA[_i] + (unsigned)(u).pm * (unsigned)(256 * lda * 2); v1[_i] = v0[_i] + (unsigned)hstepA; } } } while (0)
#define PG8_SA(b, h) (((b) * 2 + (h)) * HTB)
#define PG8_SB(b, h) ((4 + (b) * 2 + (h)) * HTB)
#define PG8_STAGE(bufoff, gbase, voff) do { _Pragma("unroll") for (int _i = 0; _i < 2; ++_i) \
        __builtin_amdgcn_global_load_lds((const unsigned*)((const char*)(gbase) + (voff)[_i]), (unsigned*)(lds + (bufoff) + ldsw + _i * 8192), 16, 0, 0); } while (0)
#define PG8_STA(bufoff, kt, h, nx) do { const char* _g = ((nx) ? nAb : cAb) + (size_t)(kt) * kstep; unsigned _v[2]; \
        _Pragma("unroll") for (int _i = 0; _i < 2; ++_i) _v[_i] = (nx) ? ((h) ? vn1[_i] : vn0[_i]) : ((h) ? vc1[_i] : vc0[_i]); PG8_STAGE(bufoff, _g, _v); } while (0)
#define PG8_LDA(dst, b, h) do { _Pragma("unroll") for (int m = 0; m < 4; ++m) _Pragma("unroll") for (int k = 0; k < 2; ++k) dst[m][k] = *(const bf16x8*)(lds + PG8_SA(b, h) + aoff + m * 2048 + k * 1024); } while (0)
#define PG8_LDB(dst, b, h) do { _Pragma("unroll") for (int n = 0; n < 2; ++n) _Pragma("unroll") for (int k = 0; k < 2; ++k) dst[n][k] = *(const bf16x8*)(lds + PG8_SB(b, h) + boff + n * 2048 + k * 1024); } while (0)
#define PG8_MMA(ai, bj, At, Bt_) do { __builtin_amdgcn_s_setprio(1); _Pragma("unroll") for (int m = 0; m < 4; ++m) _Pragma("unroll") for (int n = 0; n < 2; ++n) _Pragma("unroll") for (int k = 0; k < 2; ++k) \
        acc[ai][bj][m][n] = __builtin_amdgcn_mfma_f32_16x16x32_bf16(Bt_[n][k], At[m][k], acc[ai][bj][m][n], 0, 0, 0); __builtin_amdgcn_s_setprio(0); } while (0)
#define PG8_WAIT_V(n) asm volatile("s_waitcnt vmcnt(" #n ")" ::: "memory")
#define PG8_WAIT_L(n) asm volatile("s_waitcnt lgkmcnt(" #n ")" ::: "memory")
#define PG8_BAR __builtin_amdgcn_s_barrier()
#define PG8_SCHED __builtin_amdgcn_sched_barrier(0)
    Unit cur, nxt; int ui = 0;
    if (!S.next(0, cur)) return;
    f32x4 acc[2][2][4][2];
#pragma unroll
    for (int a = 0; a < 2; ++a)
#pragma unroll
        for (int b = 0; b < 2; ++b)
#pragma unroll
            for (int m = 0; m < 4; ++m)
#pragma unroll
                for (int n = 0; n < 2; ++n) acc[a][b][m][n] = (f32x4){0.f, 0.f, 0.f, 0.f};
    bf16x8 At[4][2], B0[2][2], B1[2][2];
    PG8_AOFFS(cur, vc0, vc1);
    const char* cB = (const char*)S.bbase(cur); const char* cAb = (const char*)S.abase(cur); const char* nAb = cAb;
    long dB = 0; if constexpr (SK) dB = (const char*)S.bbase1(cur) - cB - (long)(nt >> 1) * (long)kstep;
    __syncthreads();
    PG8_STAGE(PG8_SB(0, 0), cB, voffB); PG8_STA(PG8_SA(0, 0), 0, 0, false); PG8_STAGE(PG8_SB(0, 1), cB + hstep, voffB); PG8_STA(PG8_SA(0, 1), 0, 1, false);
    if (wr == 1) PG8_BAR;
    PG8_WAIT_V(4); PG8_BAR;
    PG8_STAGE(PG8_SB(1, 0), cB + kstep, voffB); PG8_STA(PG8_SA(1, 0), 1, 0, false); PG8_STAGE(PG8_SB(1, 1), cB + hstep + kstep, voffB);
    PG8_WAIT_V(6); PG8_BAR;
    for (;;) {
        const bool has_next = S.next(ui + 1, nxt);
        const char* nB = cB; long ndB = dB;
        nAb = cAb;
        if (has_next) { PG8_AOFFS(nxt, vn0, vn1); nB = (const char*)S.bbase(nxt); nAb = (const char*)S.abase(nxt);
            if constexpr (SK) ndB = (const char*)S.bbase1(nxt) - nB - (long)(nt >> 1) * (long)kstep; }
        else {
#pragma unroll
            for (int i = 0; i < 2; ++i) { vn0[i] = vc0[i]; vn1[i] = vc1[i]; } }
#pragma unroll 1
        for (int t = 0; t < nt; t += 2) {
            const bool last = (t == nt - 2);
            const int k2 = last ? 0 : t + 2, k3 = k2 + 1;
            const char* b2 = last ? nB : cB + (size_t)(t + 2) * kstep + ((SK && t + 2 >= (nt >> 1)) ? dB : 0L); const char* b3 = b2 + kstep;
            PG8_LDB(B0, 0, 0); PG8_SCHED; PG8_LDA(At, 0, 0); PG8_STA(PG8_SA(1, 1), t + 1, 1, false);
            PG8_WAIT_L(8); PG8_BAR; PG8_WAIT_L(0); PG8_MMA(0, 0, At, B0); PG8_BAR; PG8_SCHED;
            PG8_LDB(B1, 0, 1); PG8_STAGE(PG8_SB(0, 0), b2, voffB);
            PG8_BAR; PG8_WAIT_L(0); PG8_MMA(0, 1, At, B1); PG8_BAR;
            PG8_LDA(At, 0, 1); PG8_STA(PG8_SA(0, 0), k2, 0, last);
            PG8_BAR; PG8_WAIT_L(0); PG8_MMA(1, 0, At, B0); PG8_BAR; PG8_SCHED;
            PG8_STAGE(PG8_SB(0, 1), b2 + hstep, voffB);
            PG8_WAIT_V(6); PG8_BAR; PG8_MMA(1, 1, At, B1); PG8_BAR;
            PG8_LDB(B0, 1, 0); PG8_SCHED; PG8_LDA(At, 1, 0); PG8_STA(PG8_SA(0, 1), k2, 1, last);
            PG8_WAIT_L(8); PG8_BAR; PG8_WAIT_L(0); PG8_MMA(0, 0, At, B0); PG8_BAR; PG8_SCHED;
            PG8_LDB(B1, 1, 1); PG8_STAGE(PG8_SB(1, 0), b3, voffB);
            PG8_BAR; PG8_WAIT_L(0); PG8_MMA(0, 1, At, B1); PG8_BAR;
            PG8_LDA(At, 1, 1); PG8_STA(PG8_SA(1, 0), k3, 0, last);
            PG8_BAR; PG8_WAIT_L(0); PG8_MMA(1, 0, At, B0); PG8_BAR; PG8_SCHED;
            PG8_STAGE(PG8_SB(1, 1), b3 + hstep, voffB);
            PG8_WAIT_V(6); PG8_BAR; PG8_MMA(1, 1, At, B1); PG8_BAR;
        }
        E(acc, cur, wr, wc, fr, fq);
        if (!has_next) break;
#pragma unroll
        for (int a = 0; a < 2; ++a)
#pragma unroll
            for (int b = 0; b < 2; ++b)
#pragma unroll
                for (int m = 0; m < 4; ++m)
#pragma unroll
                    for (int n = 0; n < 2; ++n) acc[a][b][m][n] = (f32x4){0.f, 0.f, 0.f, 0.f};
        cur = nxt; cB = nB; cAb = nAb; dB = ndB; ++ui;
#pragma unroll
        for (int i = 0; i < 2; ++i) { vc0[i] = vn0[i]; vc1[i] = vn1[i]; }
    }
    PG8_WAIT_V(0);
    if (wr == 0) PG8_BAR;
    PG8_BAR;
#undef PG8_AOFFS
#undef PG8_STA
#undef PG8_SA
#undef PG8_SB
#undef PG8_STAGE
#undef PG8_LDA
#undef PG8_LDB
#undef PG8_MMA
#undef PG8_WAIT_V
#undef PG8_WAIT_L
#undef PG8_BAR
#undef PG8_SCHED
}
struct SeqOrder { static constexpr bool GATHER = false, SPLITK = false; const u16* A; const u16* Bt; int K, nM, nN, bx, G, mt0;
    __device__ __forceinline__ const u16* abase(const Unit&) const { return A; }
    __device__ __forceinline__ bool next(int i, Unit& u) const { const bool ok = tile_seq(i, bx, G, nM, nN, u.pm, u.pn); u.pm += mt0; return ok; }
    __device__ __forceinline__ const u16* bbase(const Unit& u) const { return Bt + (size_t)u.pn * 256 * K; }
    __device__ __forceinline__ int arow(const Unit& u, int r) const { return u.pm * 256 + r; } };
struct EpiGlaIn8 { u16* q; u16* k; u16* v; u16* g; float* z;
    __device__ __forceinline__ void operator()(const f32x4 (&acc)[2][2][4][2], const Unit& u, int wr, int wc, int fr, int fq) const {
#pragma unroll
        for (int bj = 0; bj < 2; ++bj)
#pragma unroll
            for (int n = 0; n < 2; ++n) { const int c0 = u.pn * 256 + bj * 128 + wc * 32 + n * 16, col = c0 + 4 * fq;
                if (c0 >= 3104) continue;
                u16* base; int ld, cc; float scl = 1.f;
                if (c0 < 512) { base = q; ld = 512; cc = col; scl = 0.08838834764831845f; } else if (c0 < 1024) { base = k; ld = 512; cc = col - 512; }
                else if (c0 < 2048) { base = v; ld = 1024; cc = col - 1024; } else if (c0 < 3072) { base = g; ld = 1024; cc = col - 2048; } else { base = nullptr; ld = 32; cc = col - 3072; }
#pragma unroll
                for (int ai = 0; ai < 2; ++ai)
#pragma unroll
                    for (int m = 0; m < 4; ++m) { const size_t row = (size_t)u.pm * 256 + ai * 128 + wr * 64 + m * 16 + fr; const f32x4 a = acc[ai][bj][m][n];
                        if (c0 < 3072) { u32x2 w = {cvtpk(a[0] * scl, a[1] * scl), cvtpk(a[2] * scl, a[3] * scl)}; *(u32x2*)(base + row * ld + cc) = w; }
                        else *(f32x4*)(z + row * 32 + cc) = a; } }
    } };
struct EpiDiffQKV8 { u16* Q; long kdelta; u16* V; float qscale; unsigned* km;
    __device__ __forceinline__ void operator()(const f32x4 (&acc)[2][2][4][2], const Unit& u, int wr, int wc, int fr, int fq) const {
        float kmx = 0.f;
#pragma unroll
        for (int ai = 0; ai < 2; ++ai)
#pragma unroll
            for (int m = 0; m < 4; ++m) { int frr = fr; asm volatile("" : "+v"(frr));
                const int row = u.pm * 256 + ai * 128 + wr * 64 + m * 16 + frr; int b, pos; row_bp(row, b, pos); const bool lat = row >= NCTX; const int np = (row - NCTX) & (SEQ - 1);
                if (u.pn < 8) { const int region = u.pn >> 2, hh = (u.pn & 3) * 4 + wc; const float scl = region == 0 ? qscale : 1.f; float ks2 = 0.f;
                    u16* o = Q + (long)region * kdelta + ((size_t)(b * 16 + hh) * KEYS + pos) * 64;
#pragma unroll
                    for (int n = 0; n < 2; ++n) { const int d0 = 16 * n + 4 * fq; const f32x4 t1 = acc[ai][0][m][n], t2 = acc[ai][1][m][n]; float o1[4], o2[4];
#pragma unroll
                        for (int j = 0; j < 4; ++j) { float cs = 1.f, sn = 0.f; if (lat) rope_cs<16>(np, d0 + j, cs, sn); o1[j] = (t1[j] * cs - t2[j] * sn) * scl; o2[j] = (t1[j] * sn + t2[j] * cs) * scl; }
                        u32x2 w1 = {cvtpk(o1[0], o1[1]), cvtpk(o1[2], o1[3])}, w2 = {cvtpk(o2[0], o2[1]), cvtpk(o2[2], o2[3])};
                        *(u32x2*)(o + d0) = w1; *(u32x2*)(o + 32 + d0) = w2;
#pragma unroll
                        for (int j = 0; j < 4; ++j) ks2 += o1[j] * o1[j] + o2[j] * o2[j]; }
                    kmx = fmaxf(kmx, ks2);
                } else {
#pragma unroll
                    for (int bj = 0; bj < 2; ++bj) { const int head = (u.pn - 8) * 2 + bj; u16* o = V + ((size_t)(b * 8 + head) * KEYS + pos) * 128 + wc * 32 + 4 * fq;
#pragma unroll
                        for (int n = 0; n < 2; ++n) { const f32x4 a = acc[ai][bj][m][n]; u32x2 w = {cvtpk(a[0], a[1]), cvtpk(a[2], a[3])}; *(u32x2*)(o + 16 * n) = w; } }
                } }
        if (u.pn >= 4 && u.pn < 8) {
            const int b = u.pm < 4 ? u.pm : ((u.pm - 4) >> 5); const float v = wave_max_fast(sum_fq(kmx));
            if (fr == 0 && fq == 0) atomic_fmax_pos(km + ((b * 16 + (u.pn & 3) * 4 + wc) * 2), v); }
    } };
struct MoeAOrder { static constexpr bool GATHER = true, SPLITK = false; const u16* A; const int* tab; const int* rowtok; const u16* wgu; int nmt, bx, G;
    __device__ __forceinline__ const u16* abase(const Unit&) const { return A; }
    __device__ __forceinline__ bool next(int i, Unit& u) const { return tile_seq(i, bx, G, nmt, 8, u.pm, u.pn); }
    __device__ __forceinline__ const u16* bbase(const Unit& u) const {
        const int c = tab[32 + u.pm], g = c / 6, p = c - g * 6; const int elo = p < 3 ? 0 : (p < 5 ? 1 : 2), ehi = p < 3 ? p + 1 : (p < 5 ? p - 1 : 3);
        const int e = (u.pn >> 2) ? ehi : elo; return wgu + ((size_t)(g * 4 + e) * 1024 + (u.pn & 3) * 256) * 1024; }
    __device__ __forceinline__ int arow(const Unit& u, int r) const { const int t = rowtok[u.pm * 256 + r]; return t < 0 ? 0 : t; } };
struct EpiMoeA8 { u16* act; const float* roww;
    __device__ __forceinline__ void operator()(const f32x4 (&acc)[2][2][4][2], const Unit& u, int wr, int wc, int fr, int fq) const {
        const int half = u.pn >> 2, cb = half * 512 + (u.pn & 3) * 128 + wc * 32 + 4 * fq;
        float wv[8];
#pragma unroll
        for (int G = 0; G < 8; ++G) wv[G] = roww[2 * ((size_t)u.pm * 256 + (G >> 2) * 128 + wr * 64 + (G & 3) * 16 + fr) + half];
#pragma unroll
        for (int ai = 0; ai < 2; ++ai)
#pragma unroll
            for (int m = 0; m < 4; ++m) { const size_t row = (size_t)u.pm * 256 + ai * 128 + wr * 64 + m * 16 + fr; const float w = wv[ai * 4 + m];
#pragma unroll
                for (int n = 0; n < 2; ++n) { const f32x4 gt = acc[ai][0][m][n], up = acc[ai][1][m][n]; float v[4];
#pragma unroll
                    for (int j = 0; j < 4; ++j) v[j] = silu_f(gt[j]) * up[j] * w;
                    u32x2 pk = {cvtpk(v[0], v[1]), cvtpk(v[2], v[3])}; *(u32x2*)(act + row * 1024 + cb + 16 * n) = pk; } }
    } };
struct MlaUpOrder { static constexpr bool GATHER = false, SPLITK = false; const u16* CN; const u16* wuq; const u16* wukv; int bx, G;
    __device__ __forceinline__ bool next(int i, Unit& u) const { return tile_seq(i, bx, G, 132, 14, u.pm, u.pn); }
    __device__ __forceinline__ const u16* abase(const Unit& u) const { return u.pn < 6 ? CN : CN + 256; }
    __device__ __forceinline__ const u16* bbase(const Unit& u) const { return u.pn < 6 ? wuq + (size_t)u.pn * 256 * 256 : wukv + (size_t)(u.pn - 6) * 256 * 256; }
    __device__ __forceinline__ int arow(const Unit& u, int r) const { return u.pm * 256 + r; } };
struct EpiMlaUp8 { u16* Q; u16* Kn; long vdelta; float qscale; unsigned* km; const float* SS;
    __device__ __forceinline__ void operator()(const f32x4 (&acc)[2][2][4][2], const Unit& u, int wr, int wc, int fr, int fq) const {
        float kmx[2] = {0.f, 0.f}, rv[8];
#pragma unroll
        for (int G = 0; G < 8; ++G) {
            const f32x4 ssq = *(const f32x4*)(SS + (size_t)(u.pm * 256 + (G >> 2) * 128 + wr * 64 + (G & 3) * 16 + fr) * 8 + (u.pn < 6 ? 0 : 4));
            rv[G] = rsqrtf((ssq[0] + ssq[1] + ssq[2] + ssq[3]) * (1.f / 256.f) + EPS); }
#pragma unroll
        for (int ai = 0; ai < 2; ++ai)
#pragma unroll
            for (int m = 0; m < 4; ++m) { int frr = fr; asm volatile("" : "+v"(frr));
                const int row = u.pm * 256 + ai * 128 + wr * 64 + m * 16 + frr; int b, pos; row_bp(row, b, pos); const bool lat = row >= NCTX; const int np = (row - NCTX) & (SEQ - 1);
                const float rinv = rv[ai * 4 + m];
                if (u.pn < 6) { const float qs = qscale * rinv;
#pragma unroll
                    for (int bj = 0; bj < 2; ++bj) { const int sb = 8 * u.pn + 4 * bj + wc, head = sb / 3, part = sb - head * 3;
                        f32x4 v0 = acc[ai][bj][m][0] * qs, v1 = acc[ai][bj][m][1] * qs;
                        if (part == 2 && lat) {
#pragma unroll
                            for (int j = 0; j < 4; ++j) { float cs, sn; rope_cs<8>(np, 4 * fq + j, cs, sn); const float t1 = v0[j], t2 = v1[j]; v0[j] = t1 * cs - t2 * sn; v1[j] = t1 * sn + t2 * cs; } }
                        u16* o = Q + ((size_t)(b * 16 + head) * KEYS + pos) * 96 + part * 32 + 4 * fq;
                        u32x2 w0 = {cvtpk(v0[0], v0[1]), cvtpk(v0[2], v0[3])}, w1 = {cvtpk(v1[0], v1[1]), cvtpk(v1[2], v1[3])}; *(u32x2*)o = w0; *(u32x2*)(o + 16) = w1; }
                } else {
#pragma unroll
                    for (int bj = 0; bj < 2; ++bj) { const int head = (u.pn - 6) * 2 + bj; u16* o = Kn + (long)(wc >> 1) * vdelta + ((size_t)(b * 16 + head) * KEYS + pos) * 64 + (wc & 1) * 32 + 4 * fq;
                        float s2 = 0.f;
#pragma unroll
                        for (int n = 0; n < 2; ++n) { const f32x4 a = acc[ai][bj][m][n] * rinv; u32x2 w = {cvtpk(a[0], a[1]), cvtpk(a[2], a[3])}; *(u32x2*)(o + 16 * n) = w;
                            s2 += a[0] * a[0] + a[1] * a[1] + a[2] * a[2] + a[3] * a[3]; }
                        kmx[bj] = fmaxf(kmx[bj], s2); }
                } }
        if (u.pn >= 6 && wc < 2) {
            const int b = u.pm < 4 ? u.pm : ((u.pm - 4) >> 5);
#pragma unroll
            for (int bj = 0; bj < 2; ++bj) { const float v = wave_max_fast(sum_fq(kmx[bj])); if (fr == 0 && fq == 0) atomic_fmax_pos(km + ((b * 16 + (u.pn - 6) * 2 + bj) * 2 + wc), v); }
        }
    } };
}

template <int DK, int DV> struct AttnCfg {
    static constexpr int NKB = DK / 32, NVB = DV / 32, ND0 = DK / 16;
    static constexpr int KBYTES = 64 * DK * 2, VBYTES = 64 * DV * 2;
    static constexpr int LDS = 2 * KBYTES + 2 * VBYTES + NWAVE * 64 * 4;
};
constexpr float ATT_THR = 8.f;

__device__ __forceinline__ void partialSM(f32x16& p0, f32x16& p1, float& m_reg, float& mn, float& alpha) {
    float pmax = p0[0];
#pragma unroll
    for (int r = 1; r < 16; ++r) pmax = fmaxf(pmax, p0[r]);
#pragma unroll
    for (int r = 0; r < 16; ++r) pmax = fmaxf(pmax, p1[r]);
    { auto rr = __builtin_amdgcn_permlane32_swap(__float_as_uint(pmax), __float_as_uint(pmax), false, false);
      pmax = fmaxf(__uint_as_float(rr[0]), __uint_as_float(rr[1])); }
    if (__builtin_expect(__all(pmax - m_reg <= ATT_THR), 1)) { mn = m_reg; alpha = 1.f; }
    else { mn = fmaxf(m_reg, pmax); alpha = __builtin_amdgcn_exp2f(m_reg - mn); m_reg = mn; }
#pragma unroll
    for (int r = 0; r < 16; ++r) p0[r] = p0[r] - mn;
#pragma unroll
    for (int r = 0; r < 16; ++r) p1[r] = p1[r] - mn;
#pragma unroll
    for (int r = 0; r < 16; ++r) p0[r] = __builtin_amdgcn_exp2f(p0[r]);
}
#define PK4(P, BASE, OUT) do { unsigned a0 = cvtpk_a(P[BASE + 0], P[BASE + 1]), a1 = cvtpk_a(P[BASE + 2], P[BASE + 3]);   \
    unsigned b0 = cvtpk_a(P[BASE + 4], P[BASE + 5]), b1 = cvtpk_a(P[BASE + 6], P[BASE + 7]);                              \
    auto r0 = __builtin_amdgcn_permlane32_swap(a0, b0, false, false); auto r1 = __builtin_amdgcn_permlane32_swap(a1, b1, false, false); \
    u32x4 w = {r0[0], r1[0], r0[1], r1[1]}; OUT = *reinterpret_cast<bf16x8*>(&w); } while (0)
__device__ __forceinline__ void finishSM(f32x16& p0, f32x16& p1, float alpha, float& l_reg, bf16x8& pa0, bf16x8& pa1, bf16x8& pa2, bf16x8& pa3) {
#pragma unroll
    for (int r = 0; r < 16; ++r) p1[r] = __builtin_amdgcn_exp2f(p1[r]);
    float ps = 0;
#pragma unroll
    for (int r = 0; r < 16; ++r) ps += p0[r];
#pragma unroll
    for (int r = 0; r < 16; ++r) ps += p1[r];
    { auto rr = __builtin_amdgcn_permlane32_swap(__float_as_uint(ps), __float_as_uint(ps), false, false);
      ps = __uint_as_float(rr[0]) + __uint_as_float(rr[1]); }
    l_reg = l_reg * alpha + ps;
    PK4(p0, 0, pa0); PK4(p0, 8, pa1); PK4(p1, 0, pa2); PK4(p1, 8, pa3);
}
__device__ __forceinline__ void psm_first(f32x16& p0, f32x16& p1, float bound, float& m_reg, f32x16& negm) {
    float pmax = fmaxf(p0[0], p1[0]);
#pragma unroll
    for (int r = 1; r < 16; ++r) pmax = fmaxf(pmax, fmaxf(p0[r], p1[r]));
    { auto rr = __builtin_amdgcn_permlane32_swap(__float_as_uint(pmax), __float_as_uint(pmax), false, false);
      pmax = fmaxf(__uint_as_float(rr[0]), __uint_as_float(rr[1])); }
    m_reg = fminf(bound, pmax + 64.f);
#pragma unroll
    for (int r = 0; r < 16; ++r) { p0[r] -= m_reg; p1[r] -= m_reg; negm[r] = -m_reg; }
#pragma unroll
    for (int r = 0; r < 16; ++r) p0[r] = __builtin_amdgcn_exp2f(p0[r]);
}
__device__ __forceinline__ void psm_fix(f32x16& p0) {
#pragma unroll
    for (int r = 0; r < 16; ++r) p0[r] = __builtin_amdgcn_exp2f(p0[r]);
}
template <bool FIRST, bool KEEPN>
__device__ __forceinline__ void psm_rel(f32x16& p0, f32x16& p1, float& m_reg, f32x16& negm, float& alpha) {
    float pmax = fmaxf(p0[0], p1[0]);
#pragma unroll
    for (int r = 1; r < 16; ++r) pmax = fmaxf(pmax, fmaxf(p0[r], p1[r]));
    { auto rr = __builtin_amdgcn_permlane32_swap(__float_as_uint(pmax), __float_as_uint(pmax), false, false);
      pmax = fmaxf(__uint_as_float(rr[0]), __uint_as_float(rr[1])); }
    alpha = 1.f;
    if (FIRST || !__builtin_expect(__all(pmax <= ATT_THR), 1)) {
        const float d = FIRST ? pmax : fmaxf(pmax, 0.f);
        if (!FIRST) alpha = __builtin_amdgcn_exp2f(-d);
        m_reg += d;
#pragma unroll
        for (int r = 0; r < 16; ++r) { p0[r] -= d; p1[r] -= d; if (KEEPN) negm[r] = -m_reg; }
    }
#pragma unroll
    for (int r = 0; r < 16; ++r) p0[r] = __builtin_amdgcn_exp2f(p0[r]);
}
__device__ __forceinline__ bf16x8 pack8(const f32x16& p, int base) {
    u32x4 w = {cvtpk_a(p[base], p[base + 1]), cvtpk_a(p[base + 2], p[base + 3]), cvtpk_a(p[base + 4], p[base + 5]), cvtpk_a(p[base + 6], p[base + 7])};
    return *reinterpret_cast<bf16x8*>(&w);
}
__device__ __forceinline__ void fsm_rel(f32x16& p0, f32x16& p1, bf16x8& pa0, bf16x8& pa1, bf16x8& pa2, bf16x8& pa3) {
#pragma unroll
    for (int r = 0; r < 16; ++r) p1[r] = __builtin_amdgcn_exp2f(p1[r]);
    pa0 = pack8(p0, 0); pa1 = pack8(p0, 8); pa2 = pack8(p1, 0); pa3 = pack8(p1, 8);
}
__device__ __forceinline__ int k_lds_off(int row, int blk, int chunk) { return blk * 4096 + row * 64 + ((chunk ^ ((row >> 2) & 3)) << 4); }
template <int ND0>
__device__ __forceinline__ void qkt(f32x16& p0, f32x16& p1, const char* Ks, const bf16x8* qr, int r32, int hi, const f32x16& cinit) {
    p0 = cinit; p1 = cinit;
#pragma unroll
    for (int d0 = 0; d0 < ND0; ++d0) {
        const int ch = (d0 & 1) * 2 + hi;
        bf16x8 b0 = *reinterpret_cast<const bf16x8*>(Ks + k_lds_off(r32, d0 >> 1, ch));
        bf16x8 b1 = *reinterpret_cast<const bf16x8*>(Ks + k_lds_off(32 + r32, d0 >> 1, ch));
        p0 = __builtin_amdgcn_mfma_f32_32x32x16_bf16(b0, qr[d0], p0, 0, 0, 0);
        p1 = __builtin_amdgcn_mfma_f32_32x32x16_bf16(b1, qr[d0], p1, 0, 0, 0);
    }
}
template <int NVB, bool SWAP = true> __device__ __forceinline__ int v_st(int k, int c) {
    const int kk = SWAP ? ((k & ~0xC) | ((k & 4) << 1) | ((k & 8) >> 1)) : k;
    return ((kk >> 3) * NVB + (c >> 5)) * 512 + ((kk & 7) * 32 + (c & 31)) * 2;
}
__device__ __forceinline__ int v_rd_base(int lane) { return ((lane & 3) << 3) | (((lane >> 2) & 3) << 6) | (((lane >> 4) & 1) << 5) | (((lane >> 5) & 1) << 8); }
template <int OFF> __device__ __forceinline__ s16x4 tr_read(int vb) {
    return __builtin_amdgcn_ds_read_tr16_b64_v4i16((LAS s16x4*)(unsigned)(vb + OFF));
}
#define PKV(L, H) (bf16x8){L[0], L[1], L[2], L[3], H[0], H[1], H[2], H[3]}
template <int D0, int NVB> __device__ __forceinline__ void pv_one(f32x16& od, int vb, bf16x8 pa0, bf16x8 pa1, bf16x8 pa2, bf16x8 pa3) {
    constexpr int KS = 2 * NVB * 512, HF = NVB * 512, B0 = D0 * 512;
    const s16x4 l0 = tr_read<B0 + 0 * KS>(vb), h0 = tr_read<B0 + 0 * KS + HF>(vb), l1 = tr_read<B0 + 1 * KS>(vb), h1 = tr_read<B0 + 1 * KS + HF>(vb);
    const s16x4 l2 = tr_read<B0 + 2 * KS>(vb), h2 = tr_read<B0 + 2 * KS + HF>(vb), l3 = tr_read<B0 + 3 * KS>(vb), h3 = tr_read<B0 + 3 * KS + HF>(vb);
    od = __builtin_amdgcn_mfma_f32_32x32x16_bf16(pa0, PKV(l0, h0), od, 0, 0, 0);
    od = __builtin_amdgcn_mfma_f32_32x32x16_bf16(pa1, PKV(l1, h1), od, 0, 0, 0);
    od = __builtin_amdgcn_mfma_f32_32x32x16_bf16(pa2, PKV(l2, h2), od, 0, 0, 0);
    od = __builtin_amdgcn_mfma_f32_32x32x16_bf16(pa3, PKV(l3, h3), od, 0, 0, 0);
}
template <int D0, int NVB> __device__ __forceinline__ void pv_one_t(f32x16& od, int vb, bf16x8 pa0, bf16x8 pa1, bf16x8 pa2, bf16x8 pa3) {
    constexpr int KS = 2 * NVB * 512, HF = NVB * 512, B0 = D0 * 512;
    const s16x4 l0 = tr_read<B0 + 0 * KS>(vb), h0 = tr_read<B0 + 0 * KS + HF>(vb), l1 = tr_read<B0 + 1 * KS>(vb), h1 = tr_read<B0 + 1 * KS + HF>(vb);
    const s16x4 l2 = tr_read<B0 + 2 * KS>(vb), h2 = tr_read<B0 + 2 * KS + HF>(vb), l3 = tr_read<B0 + 3 * KS>(vb), h3 = tr_read<B0 + 3 * KS + HF>(vb);
    od = __builtin_amdgcn_mfma_f32_32x32x16_bf16(PKV(l0, h0), pa0, od, 0, 0, 0);
    od = __builtin_amdgcn_mfma_f32_32x32x16_bf16(PKV(l1, h1), pa1, od, 0, 0, 0);
    od = __builtin_amdgcn_mfma_f32_32x32x16_bf16(PKV(l2, h2), pa2, od, 0, 0, 0);
    od = __builtin_amdgcn_mfma_f32_32x32x16_bf16(PKV(l3, h3), pa3, od, 0, 0, 0);
}
template <int NVB> __device__ __forceinline__ void pv_all(f32x16* o, int vb, bf16x8 pa0, bf16x8 pa1, bf16x8 pa2, bf16x8 pa3) {
    pv_one<0, NVB>(o[0], vb, pa0, pa1, pa2, pa3); pv_one<1, NVB>(o[1], vb, pa0, pa1, pa2, pa3);
    if constexpr (NVB == 4) { pv_one<2, NVB>(o[2], vb, pa0, pa1, pa2, pa3); pv_one<3, NVB>(o[3], vb, pa0, pa1, pa2, pa3); }
}

template <int DK, int DV>
__device__ __forceinline__ void attn_item(const u16* __restrict__ Qb, const u16* __restrict__ Ka, const u16* __restrict__ Kb, const u16* __restrict__ Vh,
                                          int nkeys, u16* __restrict__ Ob, long ldo, char* lds, float kmax2) {
    using C = AttnCfg<DK, DV>;
    constexpr int NVB = C::NVB, ND0 = C::ND0, NKI = (DK / 32) * 4, NVI = DV / 8, NI = NKI + NVI;
    static_assert(NI <= 24, "three LDS-DMA pieces per wave per tile");
    const int tid = threadIdx.x, wid = __builtin_amdgcn_readfirstlane(tid >> 6), lane = tid & 63, r32 = lane & 31, hi = lane >> 5;
    char* K_lds = lds; char* V_lds = lds + 3 * C::KBYTES;
    float* al_l = (float*)(lds + 3 * C::KBYTES + 3 * C::VBYTES) + wid * 32;
    float m_reg = 0.f; f32x16 o[NVB], ol, negm; bf16x8 qr[ND0];
#pragma unroll
    for (int d = 0; d < NVB; ++d) o[d] = f32x16{};
    ol = f32x16{}; negm = f32x16{};
    const u32x4 ones_w = {0x3F803F80u, 0x3F803F80u, 0x3F803F80u, 0x3F803F80u}; const bf16x8 ones = *reinterpret_cast<const bf16x8*>(&ones_w);
    const u16* Qw = Qb + (long)(wid * 32 + r32) * DK + hi * 8;
#pragma unroll
    for (int d0 = 0; d0 < ND0; ++d0) qr[d0] = *reinterpret_cast<const bf16x8*>(Qw + d0 * 16);
    const u16* src[3]; int dst[3], stp[3]; bool isk[3];
#pragma unroll
    for (int i = 0; i < 3; ++i) { int q = wid + 8 * i; if (q >= NI) q -= 8;
        if (q < NKI) { const int blk = q >> 2, part = q & 3, row = 16 * part + (lane >> 2), c = (lane & 3) ^ ((row >> 2) & 3);
            isk[i] = true; dst[i] = blk * 4096 + part * 1024 + lane * 16;
            if (DK == 96 && blk == 2) { src[i] = Kb + row * 32 + c * 8; stp[i] = 64 * 32; } else { src[i] = Ka + row * 64 + blk * 32 + c * 8; stp[i] = 64 * 64; } }
        else { const int v = q - NKI; int key, col;
            if (NVB == 2) { key = 8 * v + ((lane & 31) >> 2); col = (lane >> 5) * 32 + (lane & 3) * 8; }
            else { key = 8 * (v >> 1) + ((lane & 31) >> 2); col = ((v & 1) * 2 + (lane >> 5)) * 32 + (lane & 3) * 8; }
            isk[i] = false; dst[i] = 3 * C::KBYTES + v * 1024 + lane * 16; src[i] = Vh + key * DV + col; stp[i] = 64 * DV; } }
    const int NT = nkeys / 64;
#define LOADG(kt, vt) do { const int _kt = (kt) < NT ? (kt) : NT - 1, _vt = (vt) < NT ? (vt) : NT - 1; const int _ks = _kt % 3, _vs = _vt % 3; \
        _Pragma("unroll") for (int _i = 0; _i < 3; ++_i) { const int _t = isk[_i] ? _kt : _vt; const int _so = isk[_i] ? _ks * C::KBYTES : _vs * C::VBYTES; \
            __builtin_amdgcn_global_load_lds((const unsigned*)(src[_i] + (long)_t * stp[_i]), (unsigned*)(lds + _so + dst[_i]), 16, 0, 0); } } while (0)
#define RESC(a) do { if (__any((a) < 1.f)) { if (hi == 0) al_l[r32] = (a); asm volatile("s_waitcnt lgkmcnt(0)" ::: "memory"); \
        _Pragma("unroll") for (int r = 0; r < 16; ++r) { const float _f = al_l[crow(r, hi)]; ol[r] *= _f; _Pragma("unroll") for (int d = 0; d < NVB; ++d) o[d][r] *= _f; } } } while (0)
#define PVL(vb) do { pv_all<NVB>(o, (vb), pa0, pa1, pa2, pa3); \
        ol = __builtin_amdgcn_mfma_f32_32x32x16_bf16(pa0, ones, ol, 0, 0, 0); ol = __builtin_amdgcn_mfma_f32_32x32x16_bf16(pa1, ones, ol, 0, 0, 0); \
        ol = __builtin_amdgcn_mfma_f32_32x32x16_bf16(pa2, ones, ol, 0, 0, 0); ol = __builtin_amdgcn_mfma_f32_32x32x16_bf16(pa3, ones, ol, 0, 0, 0); } while (0)
#define NEGM() do { if constexpr (DV == 128) { _Pragma("unroll") for (int r = 0; r < 16; ++r) negm[r] = -m_reg; } } while (0)
#define TILEBAR(n) do { if ((n) == 3) asm volatile("s_waitcnt vmcnt(3)" ::: "memory"); else asm volatile("s_waitcnt vmcnt(0)" ::: "memory"); __builtin_amdgcn_s_barrier(); asm volatile("" ::: "memory"); } while (0)
    const int vrb = (int)(uintptr_t)V_lds + v_rd_base(lane);
    f32x16 pA0, pA1, pB0, pB1; float alA, alB; bf16x8 pa0, pa1, pa2, pa3;
    __syncthreads();
    LOADG(0, 0); LOADG(1, 0);
    TILEBAR(3); LOADG(2, 1);
    float qs = 0.f;
#pragma unroll
    for (int d0 = 0; d0 < ND0; ++d0)
#pragma unroll
        for (int e = 0; e < 8; ++e) { const float f = bf2f((u16)qr[d0][e]); qs += f * f; }
    { auto rr = __builtin_amdgcn_permlane32_swap(__float_as_uint(qs), __float_as_uint(qs), false, false); qs = __uint_as_float(rr[0]) + __uint_as_float(rr[1]); }
    const float bound = sqrtf(qs * kmax2) * 1.01f + 1.f;
    qkt<ND0>(pA0, pA1, K_lds, qr, r32, hi, negm); psm_first(pA0, pA1, bound, m_reg, negm);
    int ks = 1, vs = 0;
    for (int j = 1; j + 1 < NT; j += 2) {
        TILEBAR(3);
        SBAR(); NEGM(); qkt<ND0>(pB0, pB1, K_lds + ks * C::KBYTES, qr, r32, hi, negm);
        fsm_rel(pA0, pA1, pa0, pa1, pa2, pa3);
        SBAR(); LOADG(j + 2, j + 1); SBAR();
        PVL(vrb + vs * C::VBYTES); psm_fix(pB0);
        ks = ks == 2 ? 0 : ks + 1; vs = vs == 2 ? 0 : vs + 1;
        TILEBAR(3);
        SBAR(); NEGM(); qkt<ND0>(pA0, pA1, K_lds + ks * C::KBYTES, qr, r32, hi, negm);
        fsm_rel(pB0, pB1, pa0, pa1, pa2, pa3);
        SBAR(); LOADG(j + 3, j + 2); SBAR();
        PVL(vrb + vs * C::VBYTES); psm_fix(pA0);
        ks = ks == 2 ? 0 : ks + 1; vs = vs == 2 ? 0 : vs + 1;
    }
    TILEBAR(3);
    SBAR(); NEGM(); qkt<ND0>(pB0, pB1, K_lds + ks * C::KBYTES, qr, r32, hi, negm);
    fsm_rel(pA0, pA1, pa0, pa1, pa2, pa3); SBAR();
    PVL(vrb + vs * C::VBYTES); psm_fix(pB0);
    vs = vs == 2 ? 0 : vs + 1;
    TILEBAR(0);
    fsm_rel(pB0, pB1, pa0, pa1, pa2, pa3); SBAR();
    PVL(vrb + vs * C::VBYTES);
    u16* Ow = Ob + (long)(wid * 32) * ldo;
#pragma unroll
    for (int r = 0; r < 16; ++r) { const int orow = crow(r, hi); const float rl = __builtin_amdgcn_rcpf(ol[r]);
#pragma unroll
        for (int d0 = 0; d0 < NVB; ++d0) Ow[(long)orow * ldo + d0 * 32 + r32] = f2bf(o[d0][r] * rl); }
#undef LOADG
#undef RESC
#undef PVL
#undef NEGM
#undef TILEBAR
}

struct Frame {
    const Params* p; unsigned char* ws; char* lds; float* out; int G, bx;
    __device__ __forceinline__ const float* in(int i) const { return p->in[i]; }
    template <class T> __device__ __forceinline__ T* W(size_t off) const { return (T*)(ws + off); }
};
constexpr int LDS_BYTES = 163840;
constexpr int LDS_BARW  = LDS_BYTES - 16;
constexpr int LDS_TAB   = 147456;

struct ResCtx { const char* src0; long srcd; char* dst0; long dstd; const float* mods;
    __device__ __forceinline__ const float* row_in(int row, int) const { return (const float*)(src0 + (row >= NCTX ? srcd : 0L) + (long)row * (DM * 4)); }
    __device__ __forceinline__ float* row_out(int row) const { return (float*)(dst0 + (row >= NCTX ? dstd : 0L) + (long)row * (DM * 4)); }
    __device__ __forceinline__ const float* mod(int li, int row, int which) const {
        const int mr = row < NCTX ? 4 : ((row - NCTX) >> 13); return mods + (size_t)(li * 5 + mr) * 6144 + which * 1024; }
};
__device__ __forceinline__ ResCtx res_ctx(const Frame& F, bool first = false) {
    const char* sc = (const char*)(first ? F.in(2) : (const float*)F.W<float>(WS_XC)); const char* sl = (const char*)(first ? F.in(0) : (const float*)F.out) - (long)NCTX * DM * 4;
    char* dc = (char*)F.W<float>(WS_XC); char* dl = (char*)F.out - (long)NCTX * DM * 4;
    return ResCtx{sc, (long)(sl - sc), dc, (long)(dl - dc), F.W<float>(WS_MODS)};
}
__device__ __forceinline__ const float* xrow_in(const Frame& F, int row, bool first) { return res_ctx(F, first).row_in(row, 0); }
__device__ __forceinline__ float* xrow_out(const Frame& F, int row) { return res_ctx(F).row_out(row); }
__device__ __forceinline__ const float* mod_vec(const Frame& F, int li, int row, int which) { return res_ctx(F).mod(li, row, which); }

struct EpiResid8 { ResCtx F; int li;
    __device__ __forceinline__ void operator()(const f32x4 (&acc)[2][2][4][2], const pg8::Unit& u, int wr, int wc, int fr, int fq) const {
        const int c0 = u.pn * 256 + wc * 32 + 4 * fq;
        const float* gt = F.mod(li, u.pm * 256, 2) + c0;
        f32x4 g[4], xb[4][4];
#pragma unroll
        for (int q = 0; q < 4; ++q) g[q] = *(const f32x4*)(gt + (q >> 1) * 128 + (q & 1) * 16);
#pragma unroll
        for (int h = 0; h < 2; ++h) {
#pragma unroll
            for (int m = 0; m < 4; ++m) { int frr = fr; asm volatile("" : "+v"(frr)); const int row = u.pm * 256 + h * 128 + wr * 64 + m * 16 + frr; const float* xi = F.row_in(row, 0) + c0;
#pragma unroll
                for (int q = 0; q < 4; ++q) xb[m][q] = *(const f32x4*)(xi + (q >> 1) * 128 + (q & 1) * 16); }
#pragma unroll
            for (int m = 0; m < 4; ++m) { int frr = fr; asm volatile("" : "+v"(frr)); const int row = u.pm * 256 + h * 128 + wr * 64 + m * 16 + frr; float* xo = F.row_out(row) + c0;
#pragma unroll
                for (int q = 0; q < 4; ++q) { const f32x4 a = acc[h][q >> 1][m][q & 1], x = xb[m][q];
                    f32x4 o = {x[0] + g[q][0] * a[0], x[1] + g[q][1] * a[1], x[2] + g[q][2] * a[2], x[3] + g[q][3] * a[3]}; *(f32x4*)(xo + (q >> 1) * 128 + (q & 1) * 16) = o; } }
        }
    } };

struct MoeBOrder { static constexpr bool GATHER = false, SPLITK = true; const u16* act; const int* tab; const u16* wd; int nmt, bx, G;
    __device__ __forceinline__ const u16* abase(const pg8::Unit&) const { return act; }
    __device__ __forceinline__ bool next(int i, pg8::Unit& u) const { return tile_seq(i, bx, G, nmt, 4, u.pm, u.pn); }
    __device__ __forceinline__ const u16* bsel(const pg8::Unit& u, int which) const {
        const int c = tab[32 + u.pm], g = c / 6, p = c - g * 6; const int elo = p < 3 ? 0 : (p < 5 ? 1 : 2), ehi = p < 3 ? p + 1 : (p < 5 ? p - 1 : 3);
        return wd + ((size_t)(g * 4 + (which ? ehi : elo)) * 1024 + u.pn * 256) * 512; }
    __device__ __forceinline__ const u16* bbase(const pg8::Unit& u) const { return bsel(u, 0); }
    __device__ __forceinline__ const u16* bbase1(const pg8::Unit& u) const { return bsel(u, 1); }
    __device__ __forceinline__ int arow(const pg8::Unit& u, int r) const { return u.pm * 256 + r; } };
constexpr int LDS_GATE = 131072;
__device__ __forceinline__ int lds_gate_off(int mr) { return LDS_GATE + mr * 4096 + (mr == 4 ? 1024 : 0); }
struct EpiMoeB8 { ResCtx F; int li; const int* rowtok; const char* lds;
    __device__ __forceinline__ void operator()(const f32x4 (&acc)[2][2][4][2], const pg8::Unit& u, int wr, int wc, int fr, int fq) const {
        const int c0 = u.pn * 256 + wc * 32 + 4 * fq;
        int tok[8];
#pragma unroll
        for (int G = 0; G < 8; ++G) tok[G] = rowtok[u.pm * 256 + (G >> 2) * 128 + wr * 64 + (G & 3) * 16 + fr];
        f32x4 xb[4][4];
#pragma unroll
        for (int h = 0; h < 2; ++h) {
#pragma unroll
            for (int m = 0; m < 4; ++m) { int t = tok[h * 4 + m] < 0 ? 0 : tok[h * 4 + m]; asm volatile("" : "+v"(t)); const float* xi = F.row_out(t) + c0;
#pragma unroll
                for (int q = 0; q < 4; ++q) xb[m][q] = *(const f32x4*)(xi + (q >> 1) * 128 + (q & 1) * 16); }
#pragma unroll
            for (int m = 0; m < 4; ++m) { int t = tok[h * 4 + m]; asm volatile("" : "+v"(t));
                if (t >= 0) { float* xo = F.row_out(t) + c0; const char* gl = lds + lds_gate_off(t < NCTX ? 4 : ((t - NCTX) >> 13)) + c0 * 4;
#pragma unroll
                    for (int q = 0; q < 4; ++q) { const f32x4 a = acc[h][q >> 1][m][q & 1], x = xb[m][q], g = *(const f32x4*)(gl + ((q >> 1) * 128 + (q & 1) * 16) * 4);
                        f32x4 o = {x[0] + g[0] * a[0], x[1] + g[1] * a[1], x[2] + g[2] * a[2], x[3] + g[3] * a[3]}; *(f32x4*)(xo + (q >> 1) * 128 + (q & 1) * 16) = o; } } }
        }
    } };

__device__ __forceinline__ void p0_mods(const Frame& F) {
    float* s = (float*)F.lds; float* red = s + 5 * 1024;
    const int tid = threadIdx.x, lane = tid & 63, wid = tid >> 6;
    for (int i = tid; i < 5 * 1024; i += NTHR) { const int r = i >> 10, k = i & 1023; const float v = r < 4 ? F.in(1)[r * 1024 + k] : F.in(3)[k]; s[i] = silu_f(v); }
    __syncthreads();
    for (int item = F.bx; item < DEPTH * 96; item += F.G) {
        const int li = item / 96, cg = item % 96;
        const float* w = F.in(4) + (size_t)li * 1024 * 6144 + cg * 64 + lane;
        float a0 = 0, a1 = 0, a2 = 0, a3 = 0, a4 = 0;
        const int k0 = wid * 128;
#pragma unroll 8
        for (int k = k0; k < k0 + 128; ++k) {
            const float wv = w[(size_t)k * 6144];
            a0 += s[k] * wv; a1 += s[1024 + k] * wv; a2 += s[2048 + k] * wv; a3 += s[3072 + k] * wv; a4 += s[4096 + k] * wv;
        }
        red[(wid * 5 + 0) * 64 + lane] = a0; red[(wid * 5 + 1) * 64 + lane] = a1; red[(wid * 5 + 2) * 64 + lane] = a2;
        red[(wid * 5 + 3) * 64 + lane] = a3; red[(wid * 5 + 4) * 64 + lane] = a4;
        __syncthreads();
        if (tid < 320) { const int r = tid >> 6, l = tid & 63; float sum = 0;
#pragma unroll
            for (int ww = 0; ww < 8; ++ww) sum += red[(ww * 5 + r) * 64 + l];
            F.W<float>(WS_MODS)[(size_t)(li * 5 + r) * 6144 + cg * 64 + l] = sum + F.in(5)[li * 6144 + cg * 64 + l]; }
        __syncthreads();
    }
}
__device__ __forceinline__ void p0_rope(const Frame& F) {
    const int gt = F.bx * NTHR + threadIdx.x, gn = F.G * NTHR;
    float* ca = F.W<float>(WS_ROPEA); float* sa = ca + SEQ * 16; float* cb = F.W<float>(WS_ROPEB); float* sb = cb + SEQ * 32;
    for (int i = gt; i < SEQ * 48; i += gn) {
        int n, f, nf; float* co; float* so; int idx;
        if (i < SEQ * 16) { n = i >> 4; f = i & 15; nf = 8; co = ca; so = sa; idx = i; }
        else { const int j = i - SEQ * 16; n = j >> 5; f = j & 31; nf = 16; co = cb; so = sb; idx = j; }
        const int fi = f % nf; const float pos = (f < nf) ? (float)(n >> 6) : (float)(n & 63);
        const float invf = exp2f(-(float)fi / (float)nf * 13.287712379549449f);
        const float ang = pos * invf;
        float rev = ang * 0.15915494309189535f; rev -= floorf(rev);
        co[idx] = __builtin_amdgcn_cosf(rev); so[idx] = __builtin_amdgcn_sinf(rev);
    }
}
__device__ __forceinline__ int rowmap(int n, int kind) {
    if (kind == 0) return n;
    if (kind == 3) { if (n >= 2048) return n; const int hh = n >> 6, dim = n & 63; return (hh >> 2) * 256 + (dim >> 5) * 128 + (hh & 3) * 32 + (dim & 31); }
    return (n >> 7) * 256 + (kind == 2 ? 128 : 0) + (n & 127);
}
__device__ __forceinline__ void cvt_group(float* tl, const float* src, int K, int N, u16* dst, int ldd, int kind, int t0, const float* kscale = nullptr) {
    int tid = threadIdx.x; asm volatile("" : "+v"(tid));
    const int tn = (N + 63) / 64, nt = (K / 64) * tn;
    f32x4 v[4][2];
#pragma unroll
    for (int u = 0; u < 4; ++u) { const int t = t0 + u; const int k0 = (t / tn) * 64, n0 = (t % tn) * 64;
#pragma unroll
        for (int ps = 0; ps < 2; ++ps) { const int k = (tid >> 4) + ps * 32, n4 = (tid & 15) * 4;
            if (t < nt && n0 + n4 < N) v[u][ps] = *(const f32x4*)(src + (size_t)(k0 + k) * N + n0 + n4); else v[u][ps] = f32x4{0.f, 0.f, 0.f, 0.f}; } }
#pragma unroll
    for (int u = 0; u < 4; ++u)
#pragma unroll
        for (int ps = 0; ps < 2; ++ps) { const int k = (tid >> 4) + ps * 32, n4 = (tid & 15) * 4; float* d = tl + u * 4160 + k * 65 + n4;
            const int t = t0 + u; const float sc = (kscale && t < nt) ? kscale[(t / tn) * 64 + k] : 1.f;
            d[0] = v[u][ps][0] * sc; d[1] = v[u][ps][1] * sc; d[2] = v[u][ps][2] * sc; d[3] = v[u][ps][3] * sc; }
    __syncthreads();
#pragma unroll
    for (int u = 0; u < 4; ++u) { const int t = t0 + u; const int k0 = (t / tn) * 64, n0 = (t % tn) * 64;
        const int n = tid >> 3, kc = (tid & 7) * 8; const float* sr = tl + u * 4160;
        if (t < nt && n0 + n < N) { u32x4 w;
#pragma unroll
            for (int i = 0; i < 4; ++i) w[i] = cvtpk(sr[(kc + 2 * i) * 65 + n], sr[(kc + 2 * i + 1) * 65 + n]);
            *(u32x4*)(dst + (size_t)rowmap(n0 + n, kind) * ldd + k0 + kc) = w; } }
    __syncthreads();
}
__device__ __forceinline__ void cvt_t(const Frame& F, const float* src, int K, int N, u16* dst, int ldd, int kind, int rot, const float* kscale = nullptr) {
    const int tn = (N + 63) / 64, nt = (K / 64) * tn;
    for (int t0 = ((F.bx + rot) % F.G) * 4; t0 < nt; t0 += F.G * 4) cvt_group((float*)F.lds, src, K, N, dst, ldd, kind, t0, kscale);
}
constexpr int MOE_CVT_GROUPS = 16 * 3 * 32, LDS_CVT = 81920;
__device__ __forceinline__ void moe_cvt_group(const Frame& F, int li, int gidx) {
    if (gidx >= MOE_CVT_GROUPS) return;
    const int mat = gidx >> 5, g = gidx & 31, e = mat / 3, kind = mat - e * 3; float* tl = (float*)(F.lds + LDS_CVT);
    if (kind == 0) cvt_group(tl, F.in(27) + (size_t)(li * 16 + e) * 1024 * 512, 1024, 512, F.W<u16>(WS_MOEW) + (size_t)e * 1024 * 1024, 1024, 1, g * 4);
    else if (kind == 1) cvt_group(tl, F.in(28) + (size_t)(li * 16 + e) * 1024 * 512, 1024, 512, F.W<u16>(WS_MOEW) + (size_t)e * 1024 * 1024, 1024, 2, g * 4);
    else cvt_group(tl, F.in(29) + (size_t)(li * 16 + e) * 512 * 1024, 512, 1024, F.W<u16>(WS_MOEW + MOE_WGU_BYTES) + (size_t)e * 1024 * 512, 512, 0, g * 4);
}
__device__ __forceinline__ void p0_weights(const Frame& F) {
    int rot = 0;
    for (int j = 0; j < 2; ++j) {
        cvt_t(F, F.in(8) + (size_t)j * 1024 * 544, 1024, 544, F.W<u16>(WS_WDQKV) + (size_t)j * 640 * 1024, 1024, 0, rot); rot += 36;
        cvt_t(F, F.in(10) + (size_t)j * 256 * 1536, 256, 1536, F.W<u16>(WS_WUQ) + (size_t)j * 1536 * 256, 256, 0, rot, F.in(9) + j * 256); rot += 24;
        cvt_t(F, F.in(12) + (size_t)j * 256 * 2048, 256, 2048, F.W<u16>(WS_WUKV) + (size_t)j * 2048 * 256, 256, 0, rot, F.in(11) + j * 256); rot += 32;
        cvt_t(F, F.in(13) + (size_t)j * 1024 * 1024, 1024, 1024, F.W<u16>(WS_WOM) + (size_t)j * 1024 * 1024, 1024, 0, rot);
    }
    cvt_t(F, F.in(14), 1024, 3072, F.W<u16>(WS_WQKVD), 1024, 3, rot);
    cvt_t(F, F.in(17), 1024, 1024, F.W<u16>(WS_WOD), 1024, 0, rot);
    cvt_t(F, F.in(18), 1024, 3104, F.W<u16>(WS_WING), 1024, 0, rot); rot += 4;
    cvt_t(F, F.in(22), 1024, 1024, F.W<u16>(WS_WOG), 1024, 0, rot);
}
__device__ __forceinline__ void moe_weights(const Frame& F, int li) {
    for (int g = F.bx; g < MOE_CVT_GROUPS; g += F.G) moe_cvt_group(F, li, g);
}

#define DPP_ADD(v, CTRL) (v) += __uint_as_float(__builtin_amdgcn_update_dpp(0u, __float_as_uint(v), (CTRL), 0xF, 0xF, false))
__device__ __forceinline__ float wave_sum_fast(float v) {
    DPP_ADD(v, 0xB1); DPP_ADD(v, 0x4E); DPP_ADD(v, 0x141); DPP_ADD(v, 0x140);
    { auto rr = __builtin_amdgcn_permlane16_swap(__float_as_uint(v), __float_as_uint(v), false, false); v = __uint_as_float(rr[0]) + __uint_as_float(rr[1]); }
    { auto rr = __builtin_amdgcn_permlane32_swap(__float_as_uint(v), __float_as_uint(v), false, false); v = __uint_as_float(rr[0]) + __uint_as_float(rr[1]); }
    return v;
}
constexpr int RT_WG = 0, RT_WR = 16384, RT_REC = 81920, RT_CNT = 81920 + 4096, RT_BASE = RT_CNT + 128, RT_MA = 90112, RT_MB = RT_MA + 20480;
template <bool ROUTE>
__device__ __forceinline__ void norm_phase(const Frame& F, int li, int row_begin, bool first) {
    const int tid = threadIdx.x, lane = tid & 63, wid = tid >> 6;
    const float* gain = F.in(ROUTE ? 7 : 6) + li * DM;
    u16* H = F.W<u16>(WS_H);
    const int per_block = (NTOK - row_begin + F.G - 1) / F.G;
    const int blk0 = row_begin + F.bx * per_block; int blk1 = blk0 + per_block; if (blk1 > NTOK) blk1 = NTOK;
    f32x4* wgL = (f32x4*)(F.lds + RT_WG); f32x4* wrL = (f32x4*)(F.lds + RT_WR); u32x4* recL = (u32x4*)(F.lds + RT_REC);
    unsigned* cntL = (unsigned*)(F.lds + RT_CNT); unsigned* baseL = (unsigned*)(F.lds + RT_BASE);
    __syncthreads();
    for (int e = tid; e < 5 * 256; e += NTHR) { const int mr = e >> 8, c4 = e & 255; const float* mv = F.W<float>(WS_MODS) + (size_t)(li * 5 + mr) * 6144 + c4 * 4;
        const f32x4 g = *(const f32x4*)(gain + c4 * 4), s1 = *(const f32x4*)(mv + (ROUTE ? 4 : 1) * 1024), s0 = *(const f32x4*)(mv + (ROUTE ? 3 : 0) * 1024);
        f32x4 a = {g[0] * (1.f + s1[0]), g[1] * (1.f + s1[1]), g[2] * (1.f + s1[2]), g[3] * (1.f + s1[3])};
        *(f32x4*)(F.lds + RT_MA + e * 16) = a; *(f32x4*)(F.lds + RT_MB + e * 16) = s0; }
    if constexpr (!ROUTE) __syncthreads();
    if constexpr (ROUTE) {
        const f32x4* wg = (const f32x4*)(F.in(23) + (size_t)li * DM * 4); const f32x4* wr = (const f32x4*)(F.in(25) + (size_t)li * 4 * DM * 4);
        for (int e = tid; e < 1024; e += NTHR) { const int d = ((e >> 8) * 4 + (e & 3)) * 64 + ((e >> 2) & 63); wgL[d] = wg[e]; }
        for (int e = tid; e < 4096; e += NTHR) { const int g = e >> 10, c = e & 1023; const int d = g * 1024 + ((c >> 8) * 4 + (c & 3)) * 64 + ((c >> 2) & 63); wrL[d] = wr[e]; }
        if (tid < 32) cntL[tid] = 0u;
        __syncthreads();
    }
    f32x4 vn[4][4];
#define NLOAD(IT) do { _Pragma("unroll") for (int u = 0; u < 4; ++u) { int _r = blk0 + wid + 8 * (4 * (IT) + u); if (_r >= blk1) _r = blk0; const float* xr = xrow_in(F, _r, first); \
        _Pragma("unroll") for (int i = 0; i < 4; ++i) vn[u][i] = *(const f32x4*)(xr + i * 256 + lane * 4); } } while (0)
    NLOAD(0);
    for (int it = 0; it * 32 < per_block; ++it) {
        int rows[4]; bool ok[4]; f32x4 v[4][4];
#pragma unroll
        for (int u = 0; u < 4; ++u) { rows[u] = blk0 + wid + 8 * (4 * it + u); ok[u] = rows[u] < blk1; if (!ok[u]) rows[u] = blk0; }
#pragma unroll
        for (int u = 0; u < 4; ++u)
#pragma unroll
            for (int i = 0; i < 4; ++i) v[u][i] = vn[u][i];
        if ((it + 1) * 32 < per_block) NLOAD(it + 1);
#pragma unroll
        for (int u = 0; u < 4; ++u) {
            const int row = rows[u];
            float ss = 0;
#pragma unroll
            for (int i = 0; i < 4; ++i) ss += v[u][i][0] * v[u][i][0] + v[u][i][1] * v[u][i][1] + v[u][i][2] * v[u][i][2] + v[u][i][3] * v[u][i][3];
            ss = wave_sum_fast(ss);
            const float rinv = rsqrtf(ss * (1.f / DM) + EPS);
            const int mro = (row < NCTX ? 4 : ((row - NCTX) >> 13)) * 4096;
            float hv[16];
#pragma unroll
            for (int i = 0; i < 4; ++i) { const int c = i * 256 + lane * 4;
                const f32x4 ga = *(const f32x4*)(F.lds + RT_MA + mro + c * 4), s0 = *(const f32x4*)(F.lds + RT_MB + mro + c * 4);
#pragma unroll
                for (int j = 0; j < 4; ++j) hv[i * 4 + j] = (v[u][i][j] * rinv) * ga[j] + s0[j];
                if (ok[u]) { u32x2 w = {cvtpk(hv[i * 4], hv[i * 4 + 1]), cvtpk(hv[i * 4 + 2], hv[i * 4 + 3])}; *(u32x2*)(H + (size_t)row * DM + c) = w; } }
            if constexpr (ROUTE) {
                float gl[4] = {0, 0, 0, 0};
#pragma unroll
                for (int q = 0; q < 16; ++q) { const f32x4 w4 = wgL[q * 64 + lane]; const float h = hv[q];
                    gl[0] += h * w4[0]; gl[1] += h * w4[1]; gl[2] += h * w4[2]; gl[3] += h * w4[3]; }
#pragma unroll
                for (int g = 0; g < 4; ++g) gl[g] = wave_sum_fast(gl[g]) + F.in(24)[li * 4 + g];
                int gi = 0; float gm = gl[0];
#pragma unroll
                for (int g = 1; g < 4; ++g) if (gl[g] > gm) { gm = gl[g]; gi = g; }
                gi = __builtin_amdgcn_readfirstlane(gi);
                float den = 0;
#pragma unroll
                for (int g = 0; g < 4; ++g) den += __expf(gl[g] - gm);
                const float grp_w = 1.f / den;
                float el[4] = {0, 0, 0, 0};
                const f32x4* wrg = wrL + gi * 1024;
#pragma unroll
                for (int q = 0; q < 16; ++q) { const f32x4 w4 = wrg[q * 64 + lane]; const float h = hv[q];
                    el[0] += h * w4[0]; el[1] += h * w4[1]; el[2] += h * w4[2]; el[3] += h * w4[3]; }
#pragma unroll
                for (int e = 0; e < 4; ++e) el[e] = wave_sum_fast(el[e]) + F.in(26)[(li * 4 + gi) * 4 + e];
                int i1 = 0; float v1 = el[0];
#pragma unroll
                for (int e = 1; e < 4; ++e) if (el[e] > v1) { v1 = el[e]; i1 = e; }
                int i2 = -1; float v2 = -3.0e38f;
#pragma unroll
                for (int e = 0; e < 4; ++e) if (e != i1 && el[e] > v2) { v2 = el[e]; i2 = e; }
                const float t = __expf(v2 - v1); const float w1 = grp_w / (1.f + t), w2 = grp_w * t / (1.f + t);
                const int elo = i1 < i2 ? i1 : i2, ehi = i1 < i2 ? i2 : i1;
                const float wlo = i1 < i2 ? w1 : w2, whi = i1 < i2 ? w2 : w1;
                const int pr = elo == 0 ? ehi - 1 : (elo == 1 ? ehi + 1 : 5);
                const int cls = gi * 6 + pr;
                if (lane == 0 && ok[u]) {
                    const unsigned rank = atomicAdd(&cntL[cls], 1u);
                    u32x4 rec = {(unsigned)cls, rank, __float_as_uint(wlo), __float_as_uint(whi)};
                    recL[row - blk0] = rec;
                }
            }
        }
    }
#undef NLOAD
    if constexpr (ROUTE) {
        __syncthreads();
        if (tid < 24) baseL[tid] = atomicAdd(F.W<unsigned>(WS_CTL) + CW_CNT + li * 32 + tid, cntL[tid]);
        __syncthreads();
        for (int t = tid; t < blk1 - blk0; t += NTHR) { u32x4 rec = recL[t]; rec[1] += baseL[rec[0]];
            *(u32x4*)(F.W<unsigned char>(WS_TOK) + (size_t)(blk0 + t) * 16) = rec; }
    }
}

__device__ __forceinline__ void moe_table(const Frame& F, int li, int* tab) {
    if (threadIdx.x == 0) {
        const unsigned* cnt = F.W<unsigned>(WS_CTL) + CW_CNT + li * 32; int off = 0;
        for (int c = 0; c < 24; ++c) { tab[c] = off; const int n = (int)cnt[c]; const int nt = (n + 255) >> 8;
            for (int t = 0; t < nt; ++t) tab[32 + (off >> 8) + t] = c; off += nt << 8; }
        tab[24] = off;
    }
    __syncthreads();
}
__device__ __forceinline__ void moe_scatter(const Frame& F, int li, int row_begin) {
    int* tab = (int*)(F.lds + LDS_TAB);
    moe_table(F, li, tab);
    const unsigned* cnt = F.W<unsigned>(WS_CTL) + CW_CNT + li * 32;
    int* rowtok = F.W<int>(WS_ROWTOK); float* roww = F.W<float>(WS_ROWW);
    const int gt = F.bx * NTHR + threadIdx.x, gn = F.G * NTHR;
    for (int t = row_begin + gt; t < NTOK; t += gn) {
        const u32x4 rec = *(const u32x4*)(F.W<unsigned char>(WS_TOK) + (size_t)t * 16);
        const int r = tab[rec[0]] + (int)rec[1];
        rowtok[r] = t; roww[2 * r] = __uint_as_float(rec[2]); roww[2 * r + 1] = __uint_as_float(rec[3]);
    }
    for (int i = gt; i < 24 * 256; i += gn) { const int c = i >> 8, j = i & 255; const int r = tab[c] + (int)cnt[c] + j;
        const int end = tab[c] + ((((int)cnt[c]) + 255) & ~255);
        if (r < end) { rowtok[r] = -1; roww[2 * r] = 0.f; roww[2 * r + 1] = 0.f; } }
    __syncthreads();
}

#define EPI_ID const int r32 = lane & 31, hi = lane >> 5
__device__ __forceinline__ u32x2 pack4(float a, float b, float c, float d) { u32x2 w = {cvtpk(a, b), cvtpk(c, d)}; return w; }
struct EpiF32 { float* dst; int ld, ncols;
    __device__ __forceinline__ int operator()(f32x16 (&acc)[2][2], int row0, int col0, int lane) const { EPI_ID;
#pragma unroll
        for (int mi = 0; mi < 2; ++mi) { float* o = dst + (size_t)(row0 + mi * 32 + r32) * ld + col0 + 4 * hi;
#pragma unroll
            for (int ni = 0; ni < 2; ++ni) if (col0 + ni * 32 < ncols) {
#pragma unroll
                for (int g = 0; g < 4; ++g) { f32x4 v = {acc[mi][ni][4 * g], acc[mi][ni][4 * g + 1], acc[mi][ni][4 * g + 2], acc[mi][ni][4 * g + 3]}; *(f32x4*)(o + ni * 32 + 8 * g) = v; } } }
        return 0;
    } };
struct EpiMlaDown { u16* CN; float* SS; u16* KPE; unsigned* pemax;
    __device__ __forceinline__ int operator()(f32x16 (&acc)[2][2], int row0, int col0, int lane) const { EPI_ID;
        if (col0 < 512) {
#pragma unroll
            for (int mi = 0; mi < 2; ++mi) { const size_t row = row0 + mi * 32 + r32; u16* o = CN + row * 512 + col0 + 4 * hi; float ss = 0.f;
#pragma unroll
                for (int ni = 0; ni < 2; ++ni)
#pragma unroll
                    for (int g = 0; g < 4; ++g) { const float a = acc[mi][ni][4 * g], b = acc[mi][ni][4 * g + 1], c = acc[mi][ni][4 * g + 2], d = acc[mi][ni][4 * g + 3];
                        ss += a * a + b * b + c * c + d * d; *(u32x2*)(o + ni * 32 + 8 * g) = pack4(a, b, c, d); }
                { auto rr = __builtin_amdgcn_permlane32_swap(__float_as_uint(ss), __float_as_uint(ss), false, false); ss = __uint_as_float(rr[0]) + __uint_as_float(rr[1]); }
                if (hi == 0) SS[row * 8 + (col0 >> 6)] = ss; }
        } else if (col0 == 512) {
            const bool lat = row0 >= NCTX; float pmx = 0.f;
#pragma unroll
            for (int mi = 0; mi < 2; ++mi) { const int row = row0 + mi * 32 + r32; int b, pos; row_bp(row, b, pos); const int n = (row - NCTX) & (SEQ - 1);
                u16* o = KPE + ((size_t)b * KEYS + pos) * 32 + 4 * hi; float s2 = 0.f;
#pragma unroll
                for (int g = 0; g < 2; ++g) { float o1[4], o2[4];
#pragma unroll
                    for (int j = 0; j < 4; ++j) { const float t1 = acc[mi][0][4 * g + j], t2 = acc[mi][0][4 * (g + 2) + j]; float cs = 1.f, sn = 0.f; if (lat) rope_cs<8>(n, 8 * g + 4 * hi + j, cs, sn);
                        o1[j] = t1 * cs - t2 * sn; o2[j] = t1 * sn + t2 * cs; s2 += t1 * t1 + t2 * t2; }
                    *(u32x2*)(o + 8 * g) = pack4(o1[0], o1[1], o1[2], o1[3]); *(u32x2*)(o + 16 + 8 * g) = pack4(o2[0], o2[1], o2[2], o2[3]); }
                { auto rr = __builtin_amdgcn_permlane32_swap(__float_as_uint(s2), __float_as_uint(s2), false, false); s2 = __uint_as_float(rr[0]) + __uint_as_float(rr[1]); }
                pmx = fmaxf(pmx, s2); }
            const float v = wave_max_fast(pmx); const int bb = row0 < NCTX ? row0 >> 8 : (row0 - NCTX) >> 13;
            if (lane == 0) atomic_fmax_pos(pemax + bb, v);
        }
        return 0;
    } };
struct EpiMlaQ { u16* Q; const float* cosA; const float* sinA; float scale;
    __device__ __forceinline__ int operator()(f32x16 (&acc)[2][2], int row0, int col0, int lane) const { EPI_ID; const bool lat = row0 >= NCTX;
#pragma unroll
        for (int mi = 0; mi < 2; ++mi) { const int row = row0 + mi * 32 + r32; int b, pos; row_bp(row, b, pos); const int n = (row - NCTX) & (SEQ - 1);
            u16* qrow = Q + ((size_t)(b * 16) * KEYS + pos) * 96 + 4 * hi;
#pragma unroll
            for (int ni = 0; ni < 2; ++ni) { const int s = (col0 >> 5) + ni, head = s / 3, part = s - head * 3; u16* o = qrow + (size_t)head * KEYS * 96 + part * 32;
                float v[16];
#pragma unroll
                for (int r = 0; r < 16; ++r) v[r] = acc[mi][ni][r] * scale;
                if (part == 2 && lat) {
#pragma unroll
                    for (int g = 0; g < 2; ++g) {
#pragma unroll
                        for (int j = 0; j < 4; ++j) { float cs, sn; rope_cs<8>(n, 8 * g + 4 * hi + j, cs, sn);
                            const float t1 = v[4 * g + j], t2 = v[4 * (g + 2) + j]; v[4 * g + j] = t1 * cs - t2 * sn; v[4 * (g + 2) + j] = t1 * sn + t2 * cs; } } }
#pragma unroll
                for (int g = 0; g < 4; ++g) *(u32x2*)(o + 8 * g) = pack4(v[4 * g], v[4 * g + 1], v[4 * g + 2], v[4 * g + 3]); } }
        return 16;
    } };
struct EpiMlaKV { u16* Kn; long vdelta;
    __device__ __forceinline__ int operator()(f32x16 (&acc)[2][2], int row0, int col0, int lane) const { EPI_ID; const int head = col0 >> 7; u16* dst = Kn + (long)((col0 >> 6) & 1) * vdelta;
#pragma unroll
        for (int mi = 0; mi < 2; ++mi) { const int row = row0 + mi * 32 + r32; int b, pos; row_bp(row, b, pos);
            u16* o = dst + ((size_t)(b * 16 + head) * KEYS + pos) * 64 + 4 * hi;
#pragma unroll
            for (int ni = 0; ni < 2; ++ni)
#pragma unroll
                for (int g = 0; g < 4; ++g) *(u32x2*)(o + ni * 32 + 8 * g) = pack4(acc[mi][ni][4 * g], acc[mi][ni][4 * g + 1], acc[mi][ni][4 * g + 2], acc[mi][ni][4 * g + 3]); }
        return 16;
    } };
struct EpiResid { ResCtx F; int li, which, first;
    __device__ __forceinline__ int operator()(f32x16 (&acc)[2][2], int row0, int col0, int lane) const { EPI_ID;
#pragma unroll
        for (int mi = 0; mi < 2; ++mi) { const int row = row0 + mi * 32 + r32;
            const float* xi = F.row_in(row, first) + col0 + 4 * hi; float* xo = F.row_out(row) + col0 + 4 * hi; const float* gt = F.mod(li, row, which) + col0 + 4 * hi;
#pragma unroll
            for (int ni = 0; ni < 2; ++ni)
#pragma unroll
                for (int g = 0; g < 4; ++g) { const int c = ni * 32 + 8 * g; const f32x4 x = *(const f32x4*)(xi + c), gg = *(const f32x4*)(gt + c);
                    f32x4 o = {x[0] + gg[0] * acc[mi][ni][4 * g], x[1] + gg[1] * acc[mi][ni][4 * g + 1], x[2] + gg[2] * acc[mi][ni][4 * g + 2], x[3] + gg[3] * acc[mi][ni][4 * g + 3]};
                    *(f32x4*)(xo + c) = o; } }
        return 48;
    } };
struct EpiMoeB { ResCtx F; int li; const int* rowtok;
    __device__ __forceinline__ int operator()(f32x16 (&acc)[2][2], int row0, int col0, int lane) const { EPI_ID;
#pragma unroll
        for (int mi = 0; mi < 2; ++mi) { const int tok = rowtok[row0 + mi * 32 + r32];
            if (tok >= 0) { float* xo = F.row_out(tok) + col0 + 4 * hi; const float* gt = F.mod(li, tok, 5) + col0 + 4 * hi;
#pragma unroll
                for (int ni = 0; ni < 2; ++ni)
#pragma unroll
                    for (int g = 0; g < 4; ++g) { const int c = ni * 32 + 8 * g; const f32x4 x = *(const f32x4*)(xo + c), gg = *(const f32x4*)(gt + c);
                        f32x4 o = {x[0] + gg[0] * acc[mi][ni][4 * g], x[1] + gg[1] * acc[mi][ni][4 * g + 1], x[2] + gg[2] * acc[mi][ni][4 * g + 2], x[3] + gg[3] * acc[mi][ni][4 * g + 3]};
                        *(f32x4*)(xo + c) = o; } } }
        return 0;
    } };
struct EpiMoeA { u16* act; const float* roww; int half, acol0;
    __device__ __forceinline__ int operator()(f32x16 (&acc)[2][2], int row0, int col0, int lane) const { EPI_ID;
#pragma unroll
        for (int mi = 0; mi < 2; ++mi) { const int row = row0 + mi * 32 + r32; const float w = roww[2 * row + half];
            u16* o = act + (size_t)row * 1024 + acol0 + (col0 >> 6) * 32 + 4 * hi;
#pragma unroll
            for (int g = 0; g < 4; ++g) { float v[4];
#pragma unroll
                for (int j = 0; j < 4; ++j) v[j] = silu_f(acc[mi][0][4 * g + j]) * acc[mi][1][4 * g + j] * w;
                *(u32x2*)(o + 8 * g) = pack4(v[0], v[1], v[2], v[3]); } }
        return 8;
    } };
struct EpiDiffQKV { u16* Q; long kdelta; u16* V; const float* cosB; const float* sinB; float qscale;
    __device__ __forceinline__ int operator()(f32x16 (&acc)[2][2], int row0, int col0, int lane) const { EPI_ID; const int region = col0 >> 10; const bool lat = row0 >= NCTX;
#pragma unroll
        for (int mi = 0; mi < 2; ++mi) { const int row = row0 + mi * 32 + r32; int b, pos; row_bp(row, b, pos); const int n = (row - NCTX) & (SEQ - 1);
            if (region < 2) {
                const int hh = (col0 & 1023) >> 6; const float sc = region == 0 ? qscale : 1.f;
                u16* o = Q + (long)region * kdelta + ((size_t)(b * 16 + hh) * KEYS + pos) * 64 + 4 * hi;
#pragma unroll
                for (int g = 0; g < 4; ++g) {
                    float o1[4], o2[4];
#pragma unroll
                    for (int j = 0; j < 4; ++j) { float cs = 1.f, sn = 0.f; if (lat) rope_cs<16>(n, 8 * g + 4 * hi + j, cs, sn);
                        const float t1 = acc[mi][0][4 * g + j], t2 = acc[mi][1][4 * g + j]; o1[j] = (t1 * cs - t2 * sn) * sc; o2[j] = (t1 * sn + t2 * cs) * sc; }
                    *(u32x2*)(o + 8 * g) = pack4(o1[0], o1[1], o1[2], o1[3]); *(u32x2*)(o + 32 + 8 * g) = pack4(o2[0], o2[1], o2[2], o2[3]); }
            } else {
                const int cv = col0 - 2048, head = cv >> 7;
                u16* o = V + ((size_t)(b * 8 + head) * KEYS + pos) * 128 + (cv & 127) + 4 * hi;
#pragma unroll
                for (int ni = 0; ni < 2; ++ni)
#pragma unroll
                    for (int g = 0; g < 4; ++g) *(u32x2*)(o + ni * 32 + 8 * g) = pack4(acc[mi][ni][4 * g], acc[mi][ni][4 * g + 1], acc[mi][ni][4 * g + 2], acc[mi][ni][4 * g + 3]);
            } }
        return 16;
    } };
struct EpiGlaIn { u16* q; u16* k; u16* v; u16* g; float* z;
    __device__ __forceinline__ int operator()(f32x16 (&acc)[2][2], int row0, int col0, int lane) const { EPI_ID;
#pragma unroll
        for (int mi = 0; mi < 2; ++mi) { const size_t row = row0 + mi * 32 + r32;
            if (col0 < 3072) {
                u16* o; float sc = 1.f;
                if (col0 < 512) { o = q + row * 512 + col0; sc = 0.08838834764831845f; } else if (col0 < 1024) o = k + row * 512 + (col0 - 512);
                else if (col0 < 2048) o = v + row * 1024 + (col0 - 1024); else o = g + row * 1024 + (col0 - 2048);
                o += 4 * hi;
#pragma unroll
                for (int ni = 0; ni < 2; ++ni)
#pragma unroll
                    for (int gg = 0; gg < 4; ++gg) *(u32x2*)(o + ni * 32 + 8 * gg) = pack4(acc[mi][ni][4 * gg] * sc, acc[mi][ni][4 * gg + 1] * sc, acc[mi][ni][4 * gg + 2] * sc, acc[mi][ni][4 * gg + 3] * sc);
            } else if (col0 == 3072) {
                float* o = z + row * 32 + 4 * hi;
#pragma unroll
                for (int gg = 0; gg < 4; ++gg) { f32x4 t = {acc[mi][0][4 * gg], acc[mi][0][4 * gg + 1], acc[mi][0][4 * gg + 2], acc[mi][0][4 * gg + 3]}; *(f32x4*)(o + 8 * gg) = t; }
            } }
        return col0 < 3072 ? 16 : (col0 == 3072 ? 8 : 0);
    } };

template <int WM, int WN, class AL, class BL, class EP>
__device__ __forceinline__ void gemm_phase(const Frame& F, const AL al, const BL bl, EP& ep, int mt0, int mt1, int nN, int nk, int tile_off, int tile_total) {
    PlainTiles<AL, BL, EP> prov{al, bl, ep, mt0, mt1 - mt0, nN, F.bx, F.G}; (void)tile_off;
    gemm_stream<WM, WN>(F.lds, prov, nk);
    (void)tile_total;
}

__device__ __forceinline__ void mla_rowpass(const Frame& F, int j, int li) {
    const int lane = threadIdx.x & 63, wid = threadIdx.x >> 6;
    const float* DQ = F.W<float>(MLA_DQ); u16* CN = F.W<u16>(MLA_CN); u16* KPE = F.W<u16>(MLA_KPE);
    const float* gq = F.in(9) + j * 256; const float* gk = F.in(11) + j * 256;
    const float* ca = F.W<float>(WS_ROPEA); const float* sa = ca + SEQ * 16;
    float pem0 = 0.f, pem1 = 0.f, pem2 = 0.f, pem3 = 0.f;
    for (int row = F.bx * NWAVE + wid; row < NTOK; row += F.G * NWAVE) {
        const float* d = DQ + (size_t)row * 544;
        const f32x4 a = *(const f32x4*)(d + lane * 4), c = *(const f32x4*)(d + 256 + lane * 4);
        float sq = a[0] * a[0] + a[1] * a[1] + a[2] * a[2] + a[3] * a[3], sk = c[0] * c[0] + c[1] * c[1] + c[2] * c[2] + c[3] * c[3];
        sq = wave_sum(sq); sk = wave_sum(sk);
        const float rq = rsqrtf(sq * (1.f / 256.f) + EPS), rk = rsqrtf(sk * (1.f / 256.f) + EPS);
        const f32x4 g1 = *(const f32x4*)(gq + lane * 4), g2 = *(const f32x4*)(gk + lane * 4);
        u32x2 w1 = {cvtpk(a[0] * rq * g1[0], a[1] * rq * g1[1]), cvtpk(a[2] * rq * g1[2], a[3] * rq * g1[3])};
        u32x2 w2 = {cvtpk(c[0] * rk * g2[0], c[1] * rk * g2[1]), cvtpk(c[2] * rk * g2[2], c[3] * rk * g2[3])};
        *(u32x2*)(CN + (size_t)row * 512 + lane * 4) = w1; *(u32x2*)(CN + (size_t)row * 512 + 256 + lane * 4) = w2;
        { float t1 = 0.f, t2 = 0.f; if (lane < 16) { t1 = d[512 + lane]; t2 = d[528 + lane]; }
          const float pe2 = wave_sum_fast(t1 * t1 + t2 * t2); const int bb = row < NCTX ? row >> 8 : (row - NCTX) >> 13;
          pem0 = bb == 0 ? fmaxf(pem0, pe2) : pem0; pem1 = bb == 1 ? fmaxf(pem1, pe2) : pem1; pem2 = bb == 2 ? fmaxf(pem2, pe2) : pem2; pem3 = bb == 3 ? fmaxf(pem3, pe2) : pem3; }
        if (lane < 16) { float t1 = d[512 + lane], t2 = d[528 + lane]; int b, pos; row_bp(row, b, pos);
            if (row >= NCTX) { const int n = (row - NCTX) & (SEQ - 1); const float cs = ca[n * 16 + lane], sn = sa[n * 16 + lane];
                const float o1 = t1 * cs - t2 * sn, o2 = t1 * sn + t2 * cs; t1 = o1; t2 = o2; }
            u16* o = KPE + ((size_t)b * KEYS + pos) * 32 + lane; o[0] = f2bf(t1); o[16] = f2bf(t2); }
    }
    if (lane == 0) { unsigned* pm = F.W<unsigned>(WS_CTL) + CW_PEMAX + li * 4; atomic_fmax_pos(pm, pem0); atomic_fmax_pos(pm + 1, pem1); atomic_fmax_pos(pm + 2, pem2); atomic_fmax_pos(pm + 3, pem3); }
}
__device__ __forceinline__ int vcu_of(const Frame& F) { return (F.G % 8 == 0) ? (F.bx % 8) * (F.G / 8) + F.bx / 8 : F.bx; }
__device__ __forceinline__ void mla_attn(const Frame& F, bool ctx_out, int li) {
    const u16* Q = F.W<u16>(MLA_Q); const u16* Kn = F.W<u16>(MLA_KN); const u16* V = F.W<u16>(MLA_V); const u16* Kpe = F.W<u16>(MLA_KPE);
    u16* O = F.W<u16>(MLA_DQ);
    const int nit = 2048 + (ctx_out ? 64 : 0); int nrun = 0;
#pragma unroll 1
    for (int it = vcu_of(F); it < nit; it += F.G) {
        int b, h, qpos, nkeys, orow;
        if (it < 2048) { const int bh = it >> 5, qt = it & 31; b = bh >> 4; h = bh & 15; qpos = CTXL + qt * 256; nkeys = KEYS; orow = NCTX + b * SEQ + qt * 256; }
        else { const int jj = it - 2048; b = jj >> 4; h = jj & 15; qpos = 0; nkeys = CTXL; orow = b * CTXL; }
        const size_t bh = (size_t)(b * 16 + h);
        const unsigned* km = F.W<unsigned>(WS_CTL) + CW_KMAX + li * 128 + (b * 16 + h) * 2;
        const float kmax2 = __uint_as_float(km[0]) + __uint_as_float(km[1]) + __uint_as_float(F.W<unsigned>(WS_CTL)[CW_PEMAX + li * 4 + b]);
        attn_item<96, 64>(Q + (bh * KEYS + qpos) * 96, Kn + bh * KEYS * 64, Kpe + (size_t)b * KEYS * 32, V + bh * KEYS * 64, nkeys,
                          O + (size_t)orow * DM + h * 64, DM, F.lds, kmax2);
        moe_cvt_group(F, li, F.bx + nrun * F.G); ++nrun;
    }
    for (; F.bx + nrun * F.G < MOE_CVT_GROUPS; ++nrun) moe_cvt_group(F, li, F.bx + nrun * F.G);
}
__device__ __forceinline__ void diff_attn(const Frame& F, int li) {
    const u16* Q = F.W<u16>(DF_Q); const u16* K = F.W<u16>(DF_K); const u16* V = F.W<u16>(DF_V); u16* OS = F.W<u16>(DF_OS);
    const int nit = 2048 + 64; int nrun = 0;
#pragma unroll 1
    for (int it = vcu_of(F); it < nit; it += F.G) {
        int b, hh, qpos, nkeys, orow;
        if (it < 2048) { const int bh = it >> 5, qt = it & 31; b = bh >> 4; hh = bh & 15; qpos = CTXL + qt * 256; nkeys = KEYS; orow = NCTX + b * SEQ + qt * 256; }
        else { const int jj = it - 2048; b = jj >> 4; hh = jj & 15; qpos = 0; nkeys = CTXL; orow = b * CTXL; }
        const size_t bh = (size_t)(b * 16 + hh);
        const float kmax2 = __uint_as_float(F.W<unsigned>(WS_CTL)[CW_KMAX + li * 128 + (b * 16 + hh) * 2]);
        attn_item<64, 128>(Q + (bh * KEYS + qpos) * 64, K + bh * KEYS * 64, nullptr, V + (size_t)(b * 8 + (hh >> 1)) * KEYS * 128, nkeys,
                           OS + (size_t)(hh & 1) * NTOK * DM + (size_t)orow * DM + (hh >> 1) * 128, DM, F.lds, kmax2);
        moe_cvt_group(F, li, F.bx + nrun * F.G); ++nrun;
    }
    for (; F.bx + nrun * F.G < MOE_CVT_GROUPS; ++nrun) moe_cvt_group(F, li, F.bx + nrun * F.G);
}
__device__ __forceinline__ void diff_rowpass(const Frame& F, float lam_init) {
    const int lane = threadIdx.x & 63, wid = threadIdx.x >> 6;
    const u16* OS = F.W<u16>(DF_OS); u16* O = F.W<u16>(DF_Q);
    const float* lm = F.in(15);
    const float lam = __expf(wave_sum(lm[lane] * lm[64 + lane])) - __expf(wave_sum(lm[128 + lane] * lm[192 + lane])) + lam_init;
    const float post = 1.f - lam_init;
    float sg[16];
#pragma unroll
    for (int i = 0; i < 16; ++i) sg[i] = F.in(16)[(lane & 7) * 16 + i] * post;
    const int stride = F.G * NWAVE, r0 = F.bx * NWAVE + wid;
    bf16x8 an[4][4];
#define DR_LOAD(K0) do { _Pragma("unroll") for (int u = 0; u < 4; ++u) { int _r = r0 + ((K0) + u) * stride; if (_r >= NTOK) _r = r0; const u16* p0 = OS + (size_t)_r * DM + lane * 16; const u16* p1 = p0 + (size_t)NTOK * DM; \
        an[u][0] = *(const bf16x8*)p0; an[u][1] = *(const bf16x8*)(p0 + 8); an[u][2] = *(const bf16x8*)p1; an[u][3] = *(const bf16x8*)(p1 + 8); } } while (0)
    DR_LOAD(0);
    for (int k0 = 0; r0 + k0 * stride < NTOK; k0 += 4) {
        bf16x8 av[4][4];
#pragma unroll
        for (int u = 0; u < 4; ++u)
#pragma unroll
            for (int i = 0; i < 4; ++i) av[u][i] = an[u][i];
        if (r0 + (k0 + 4) * stride < NTOK) DR_LOAD(k0 + 4);
#pragma unroll
        for (int u = 0; u < 4; ++u) { const int row = r0 + (k0 + u) * stride;
            float o[16]; float ss = 0;
#pragma unroll
            for (int i = 0; i < 8; ++i) { o[i] = bf2f((u16)av[u][0][i]) - lam * bf2f((u16)av[u][2][i]); o[8 + i] = bf2f((u16)av[u][1][i]) - lam * bf2f((u16)av[u][3][i]); }
#pragma unroll
            for (int i = 0; i < 16; ++i) ss += o[i] * o[i];
            ss += __shfl_xor(ss, 1); ss += __shfl_xor(ss, 2); ss += __shfl_xor(ss, 4);
            const float rinv = rsqrtf(ss * (1.f / 128.f) + EPS);
            u32x4 w0, w1;
#pragma unroll
            for (int i = 0; i < 4; ++i) { w0[i] = cvtpk(o[2 * i] * rinv * sg[2 * i], o[2 * i + 1] * rinv * sg[2 * i + 1]);
                w1[i] = cvtpk(o[8 + 2 * i] * rinv * sg[8 + 2 * i], o[9 + 2 * i] * rinv * sg[9 + 2 * i]); }
            if (row < NTOK) { *(u32x4*)(O + (size_t)row * DM + lane * 16) = w0; *(u32x4*)(O + (size_t)row * DM + lane * 16 + 8) = w1; } }
    }
#undef DR_LOAD
}

__device__ __forceinline__ float logsig16(float x) { return (fminf(x, 0.f) - __logf(1.f + __expf(-fabsf(x)))) * 0.0625f; }
constexpr int NCH = KEYS / 64;

__device__ __forceinline__ void gla_g1(const Frame& F) {
    char* KT = F.lds; char* VV = F.lds + 16384; float* ZT = (float*)(F.lds + 49152); float* SEG = (float*)(F.lds + 53248); char* KR = F.lds + 57344; char* OSG = F.lds + 73728;
    const u16* Kg = F.W<u16>(GL_K); const u16* Vg = F.W<u16>(GL_V); const float* Zg = F.W<float>(GL_Z);
    u16* ST = F.W<u16>(GL_STATE); float* DEC = F.W<float>(GL_DEC);
    constexpr int NIT = NBATCH * 4 * 2 * NCH;
    float zr[2], wgn[16], biasn; bf16x8 vr[4], kr[2];
#define G1_LOAD(IT) do { int tid = threadIdx.x; asm volatile("" : "+v"(tid)); const int kk = tid & 127; \
        const int c = (IT) % NCH, dir = ((IT) / NCH) & 1, bh = (IT) / (2 * NCH), b = bh >> 2, h = bh & 3, s0 = 64 * c; int tbase, tstep; \
        if (dir == 0) { tbase = (c < 4) ? b * CTXL + s0 : NCTX + b * SEQ + s0 - CTXL; tstep = 1; } \
        else { tbase = (c < 4) ? b * CTXL + (CTXL - 1) - s0 : NCTX + b * SEQ + (SEQ - 1) - (s0 - CTXL); tstep = -1; } \
        _Pragma("unroll") for (int q = 0; q < 2; ++q) { const int i = tid + q * NTHR; zr[q] = Zg[(size_t)(tbase + tstep * (i >> 4)) * 32 + dir * 16 + (i & 15)]; } \
        _Pragma("unroll") for (int q = 0; q < 4; ++q) { const int id = tid + q * NTHR, key = id >> 5, cc = (id & 31) * 8; vr[q] = *(const bf16x8*)(Vg + (size_t)(tbase + tstep * key) * 1024 + h * 256 + cc); } \
        _Pragma("unroll") for (int q = 0; q < 2; ++q) { const int id = tid + q * NTHR, key = id >> 4, cc = (id & 15) * 8; kr[q] = *(const bf16x8*)(Kg + (size_t)(tbase + tstep * key) * 512 + h * 128 + cc); } \
        _Pragma("unroll") for (int r = 0; r < 16; ++r) wgn[r] = F.in(19)[(dir * 16 + r) * 512 + h * 128 + kk]; \
        biasn = F.in(20)[dir * 512 + h * 128 + kk]; } while (0)
    if (F.bx < NIT) G1_LOAD(F.bx);
#pragma unroll 1
    for (int it = F.bx; it < NIT; it += F.G) {
        int tid = threadIdx.x; asm volatile("" : "+v"(tid));
        const int lane = tid & 63, wid = tid >> 6, r32 = lane & 31, hi = lane >> 5, kk = tid & 127, jq = tid >> 7;
        __syncthreads();
#pragma unroll
        for (int q = 0; q < 2; ++q) ZT[tid + q * NTHR] = zr[q];
#pragma unroll
        for (int q = 0; q < 4; ++q) { const int id = tid + q * NTHR, key = id >> 5, cc = (id & 31) * 8; *(bf16x8*)(VV + v_st<8>(key, cc)) = vr[q]; }
#pragma unroll
        for (int q = 0; q < 2; ++q) { const int id = tid + q * NTHR; *(bf16x8*)(KR + id * 16) = kr[q]; }
        float wg[16];
#pragma unroll
        for (int r = 0; r < 16; ++r) wg[r] = wgn[r];
        const float bias = biasn;
        __syncthreads();
        float cv[16]; float run = 0;
#pragma unroll
        for (int jj = 0; jj < 16; ++jj) { const int j = jq * 16 + jj; float x = bias;
#pragma unroll
            for (int r = 0; r < 16; ++r) x += ZT[j * 16 + r] * wg[r];
            run += logsig16(x); cv[jj] = run; }
        SEG[jq * 128 + kk] = run;
        __syncthreads();
        float offset = 0, total = 0;
#pragma unroll
        for (int q = 0; q < 4; ++q) { const float sv = SEG[q * 128 + kk]; total += sv; if (q < jq) offset += sv; }
        u32x4 w0, w1;
#pragma unroll
        for (int i = 0; i < 8; ++i) {
            const int j0 = jq * 16 + 2 * i;
            const float k0 = bf2f(*(const u16*)(KR + j0 * 256 + kk * 2)) * __expf(total - (offset + cv[2 * i]));
            const float k1 = bf2f(*(const u16*)(KR + (j0 + 1) * 256 + kk * 2)) * __expf(total - (offset + cv[2 * i + 1]));
            const unsigned pk = cvtpk(k0, k1); if (i < 4) w0[i] = pk; else w1[i - 4] = pk; }
        *(u32x4*)(KT + kk * 128 + (((jq * 2) ^ ((kk >> 1) & 7)) << 4)) = w0;
        *(u32x4*)(KT + kk * 128 + (((jq * 2 + 1) ^ ((kk >> 1) & 7)) << 4)) = w1;
        __syncthreads();
        const int mt = wid & 3, vb = (wid >> 2) * 4;
        const int row = mt * 32 + r32, ab = row * 128 + ((hi ^ ((row >> 1) & 7)) << 4);
        const bf16x8 pa0 = *(const bf16x8*)(KT + (ab ^ 0)), pa1 = *(const bf16x8*)(KT + (ab ^ 32)), pa2 = *(const bf16x8*)(KT + (ab ^ 64)), pa3 = *(const bf16x8*)(KT + (ab ^ 96));
        f32x16 acc[4];
#pragma unroll
        for (int n = 0; n < 4; ++n) acc[n] = f32x16{};
        const int vbase = (int)(uintptr_t)VV + v_rd_base(lane) + vb * 512;
        pv_one_t<0, 8>(acc[0], vbase, pa0, pa1, pa2, pa3); pv_one_t<1, 8>(acc[1], vbase, pa0, pa1, pa2, pa3);
        pv_one_t<2, 8>(acc[2], vbase, pa0, pa1, pa2, pa3); pv_one_t<3, 8>(acc[3], vbase, pa0, pa1, pa2, pa3);
        char* osw = OSG + (mt * 32 + r32) * 528 + (vb * 32 + 4 * hi) * 2;
#pragma unroll
        for (int n = 0; n < 4; ++n)
#pragma unroll
            for (int g = 0; g < 4; ++g) { u32x2 w = {cvtpk(acc[n][4 * g], acc[n][4 * g + 1]), cvtpk(acc[n][4 * g + 2], acc[n][4 * g + 3])}; *(u32x2*)(osw + n * 64 + g * 16) = w; }
        if (it + F.G < NIT) G1_LOAD(it + F.G);
        __syncthreads();
        if (jq == 0) DEC[(size_t)it * 128 + kk] = __expf(total);
        u16* S = ST + (size_t)it * 128 * 256;
#pragma unroll
        for (int q = 0; q < 8; ++q) { const int id = tid + q * NTHR, srow = id >> 5, c16 = id & 31; *(u32x4*)(S + srow * 256 + c16 * 8) = *(const u32x4*)(OSG + srow * 528 + c16 * 16); }
    }
#undef G1_LOAD
}
__device__ __forceinline__ void gla_g2(const Frame& F) {
    u16* ST = F.W<u16>(GL_STATE); const float* DEC = F.W<float>(GL_DEC);
    for (int g = F.bx * NTHR + threadIdx.x; g < 32 * 4096; g += F.G * NTHR) {
        const int chain = g >> 12, e = g & 4095, kk = e >> 5, v8 = (e & 31) * 8;
        u16* p = ST + ((size_t)chain * NCH * 128 + kk) * 256 + v8; const float* d = DEC + (size_t)chain * NCH * 128 + kk;
        float f[8];
#pragma unroll
        for (int i = 0; i < 8; ++i) f[i] = 0.f;
        for (int c = 0; c < NCH; c += 4) {
            bf16x8 kv[4]; float dc[4];
#pragma unroll
            for (int u = 0; u < 4; ++u) { kv[u] = *(const bf16x8*)(p + (size_t)(c + u) * 128 * 256); dc[u] = d[(size_t)(c + u) * 128]; }
#pragma unroll
            for (int u = 0; u < 4; ++u) {
                u32x4 w = {cvtpk(f[0], f[1]), cvtpk(f[2], f[3]), cvtpk(f[4], f[5]), cvtpk(f[6], f[7])};
                *(u32x4*)(p + (size_t)(c + u) * 128 * 256) = w;
#pragma unroll
                for (int i = 0; i < 8; ++i) f[i] = dc[u] * f[i] + bf2f((u16)kv[u][i]);
            }
        }
    }
}
__device__ __forceinline__ void gla_g3(const Frame& F) {
    char* QD = F.lds; char* KI = F.lds + 16384; char* VV = F.lds + 32768; char* SS = F.lds + 65536; float* OL = (float*)(F.lds + 65536);
    float* ZT = (float*)(F.lds + 132096); float* SEG = (float*)(F.lds + 136192);
    const u16* Qg = F.W<u16>(GL_Q); const u16* Kg = F.W<u16>(GL_K); const u16* Vg = F.W<u16>(GL_V); const u16* Gg = F.W<u16>(GL_G); const float* Zg = F.W<float>(GL_Z);
    const u16* ST = F.W<u16>(GL_STATE); u16* OUT = F.W<u16>(WS_H);
#pragma unroll 1
    for (int it = F.bx; it < NBATCH * 4 * NCH; it += F.G) {
        int tid = threadIdx.x; asm volatile("" : "+v"(tid));
        const int lane = tid & 63, wid = tid >> 6, r32 = lane & 31, hi = lane >> 5, kk = tid & 127, jq = tid >> 7;
        const int T = it % NCH, bh = it / NCH, b = bh >> 2, h = bh & 3;
        const int t0 = (T < 4) ? b * CTXL + 64 * T : NCTX + b * SEQ + 64 * (T - 4);
        __syncthreads();
#pragma unroll
        for (int q = 0; q < 4; ++q) { const int id = tid + q * NTHR, key = id >> 5, cc = (id & 31) * 8;
            *(bf16x8*)(VV + v_st<8>(key, cc)) = *(const bf16x8*)(Vg + (size_t)(t0 + key) * 1024 + h * 256 + cc); }
        const int itile = wid & 1, vb = (wid >> 1) * 2;
        f32x16 acc[2]; acc[0] = f32x16{}; acc[1] = f32x16{};
#pragma unroll 1
        for (int dir = 0; dir < 2; ++dir) {
            const int cd = dir == 0 ? T : (T < 4 ? 3 - T : 135 - T);
            const u16* Ssrc = ST + (size_t)((bh * 2 + dir) * NCH + cd) * 128 * 256;
#pragma unroll
            for (int q = 0; q < 8; ++q) { const int id = tid + q * NTHR, key = id >> 5, cc = (id & 31) * 8;
                *(bf16x8*)(SS + v_st<8>(key, cc)) = *(const bf16x8*)(Ssrc + (size_t)key * 256 + cc); }
            for (int i = tid; i < 1024; i += NTHR) { const int j = i >> 4, r = i & 15; ZT[i] = Zg[(size_t)(t0 + j) * 32 + dir * 16 + r]; }
            float wg[16];
#pragma unroll
            for (int r = 0; r < 16; ++r) wg[r] = F.in(19)[(dir * 16 + r) * 512 + h * 128 + kk];
            const float bias = F.in(20)[dir * 512 + h * 128 + kk];
            __syncthreads();
            float cv[16]; float run = 0;
#pragma unroll
            for (int u = 0; u < 16; ++u) { const int j = jq * 16 + u; float x = bias;
#pragma unroll
                for (int r = 0; r < 16; ++r) x += ZT[j * 16 + r] * wg[r];
                cv[u] = logsig16(x); }
            if (dir == 0) {
#pragma unroll
                for (int u = 0; u < 16; ++u) { run += cv[u]; cv[u] = run; }
            } else {
#pragma unroll
                for (int u = 15; u >= 0; --u) { run += cv[u]; cv[u] = run; }
            }
            SEG[jq * 128 + kk] = run;
            __syncthreads();
            float offset = 0;
#pragma unroll
            for (int q = 0; q < 4; ++q) { const float sv = SEG[q * 128 + kk]; if (dir == 0 ? (q < jq) : (q > jq)) offset += sv; }
            const int adb = jq * 4096 + ((kk >> 3) << 4) + (kk & 7) * 2;
#pragma unroll
            for (int jj = 0; jj < 16; ++jj) { const int i = jq * 16 + jj; const float cum = offset + cv[jj];
                const float qv = bf2f(Qg[(size_t)(t0 + i) * 512 + h * 128 + kk]) * __expf(cum);
                const float kv = bf2f(Kg[(size_t)(t0 + i) * 512 + h * 128 + kk]) * __expf(-cum);
                const int ad = (adb ^ (jj << 4)) + jj * 256;
                *(u16*)(QD + ad) = f2bf(qv); *(u16*)(KI + ad) = f2bf(kv); }
            __syncthreads();
            {
                const int row = itile * 32 + r32; bf16x8 qa[8];
#pragma unroll
                for (int ks = 0; ks < 8; ++ks) qa[ks] = *(const bf16x8*)(QD + row * 256 + (((ks * 2 + hi) ^ (row & 15)) << 4));
                const int ssb = (int)(uintptr_t)SS + v_rd_base(lane) + vb * 512;
                pv_one<0, 8>(acc[0], ssb, qa[0], qa[1], qa[2], qa[3]); pv_one<0, 8>(acc[0], ssb + 32768, qa[4], qa[5], qa[6], qa[7]);
                pv_one<1, 8>(acc[1], ssb, qa[0], qa[1], qa[2], qa[3]); pv_one<1, 8>(acc[1], ssb + 32768, qa[4], qa[5], qa[6], qa[7]);
                f32x16 p0 = f32x16{}, p1 = f32x16{};
#pragma unroll
                for (int ks = 0; ks < 8; ++ks) {
                    const bf16x8 k0 = *(const bf16x8*)(KI + r32 * 256 + (((ks * 2 + hi) ^ (r32 & 15)) << 4));
                    const bf16x8 k1 = *(const bf16x8*)(KI + (32 + r32) * 256 + (((ks * 2 + hi) ^ (r32 & 15)) << 4));
                    p0 = __builtin_amdgcn_mfma_f32_32x32x16_bf16(k0, qa[ks], p0, 0, 0, 0);
                    p1 = __builtin_amdgcn_mfma_f32_32x32x16_bf16(k1, qa[ks], p1, 0, 0, 0);
                }
                const int iq = itile * 32 + r32;
#pragma unroll
                for (int r = 0; r < 16; ++r) { const int s0 = crow(r, hi), s1 = 32 + s0;
                    const bool k0 = dir == 0 ? (s0 <= iq) : (s0 >= iq), k1 = dir == 0 ? (s1 <= iq) : (s1 >= iq);
                    p0[r] = k0 ? p0[r] : 0.f; p1[r] = k1 ? p1[r] : 0.f; }
                bf16x8 pa0, pa1, pa2, pa3;
                PK4(p0, 0, pa0); PK4(p0, 8, pa1); PK4(p1, 0, pa2); PK4(p1, 8, pa3);
                const int vvb = (int)(uintptr_t)VV + v_rd_base(lane) + vb * 512;
                pv_one<0, 8>(acc[0], vvb, pa0, pa1, pa2, pa3); pv_one<1, 8>(acc[1], vvb, pa0, pa1, pa2, pa3);
            }
            __syncthreads();
        }
        float* olb = OL + (itile * 32 + 4 * hi) * 260 + vb * 32 + r32;
#pragma unroll
        for (int n = 0; n < 2; ++n)
#pragma unroll
            for (int r = 0; r < 16; ++r) olb[((r & 3) + 8 * (r >> 2)) * 260 + n * 32] = acc[n][r];
        __syncthreads();
        {
            const int i = tid >> 3, sg = tid & 7; const float* ol = OL + i * 260 + sg * 32;
            float ss = 0;
#pragma unroll
            for (int u = 0; u < 8; ++u) { const f32x4 t = *(const f32x4*)(ol + u * 4); ss += t[0] * t[0] + t[1] * t[1] + t[2] * t[2] + t[3] * t[3]; }
            ss += __shfl_xor(ss, 1); ss += __shfl_xor(ss, 2); ss += __shfl_xor(ss, 4);
            const float rinv = rsqrtf(ss * (1.f / 256.f) + EPS);
            const u16* gp = Gg + (size_t)(t0 + i) * 1024 + h * 256 + sg * 32; u16* op = OUT + (size_t)(t0 + i) * 1024 + h * 256 + sg * 32;
            const float* hn = F.in(21) + sg * 32;
#pragma unroll
            for (int q = 0; q < 4; ++q) { const bf16x8 g8 = *(const bf16x8*)(gp + q * 8); u32x4 w;
                const f32x4 oa = *(const f32x4*)(ol + q * 8), ob = *(const f32x4*)(ol + q * 8 + 4);
                const float o8[8] = {oa[0], oa[1], oa[2], oa[3], ob[0], ob[1], ob[2], ob[3]};
#pragma unroll
                for (int u = 0; u < 4; ++u) { const int e0 = q * 8 + 2 * u;
                    w[u] = cvtpk(o8[2 * u] * rinv * hn[e0] * silu_f(bf2f((u16)g8[2 * u])), o8[2 * u + 1] * rinv * hn[e0 + 1] * silu_f(bf2f((u16)g8[2 * u + 1]))); }
                *(u32x4*)(op + q * 8) = w; }
        }
    }
}

__device__ __forceinline__ void pair_decode(int p, int& elo, int& ehi) { elo = p < 3 ? 0 : (p < 5 ? 1 : 2); ehi = p < 3 ? p + 1 : (p < 5 ? p - 1 : 3); }
struct MoeATiles {
    typedef GTile<RowsGather, RowsPlain, EpiMoeA> Tile; static constexpr bool EP_CONST = false; EpiMoeA ep;
    const int* tab; u16* H; const int* rowtok; const u16* wgu; u16* act; const float* roww; int nmt, bx, G;
    __device__ __forceinline__ bool get(int i, Tile& t) const {
        int mt, nt; if (!tile_seq(i, bx, G, nmt, 16, mt, nt)) return false;
        const int c = tab[32 + mt], g = c / 6; int elo, ehi; pair_decode(c % 6, elo, ehi);
        const int half = nt >> 3, e = half ? ehi : elo;
        t.al = RowsGather{H, 1024, rowtok};
        t.bl = RowsPlain{wgu + ((size_t)(g * 4 + e) * 1024 + (nt & 7) * 128) * 1024, 1024};
        t.ep = EpiMoeA{act, roww, half, half * 512 + (nt & 7) * 64};
        t.brow = mt * 256; t.bcol = 0; return true; }
};
struct MoeBTiles {
    typedef GTile<RowsPlain, RowsSplitK, EpiMoeB> Tile; static constexpr bool EP_CONST = false; EpiMoeB ep;
    const int* tab; ResCtx F; int li; const u16* wd; const u16* act; const int* rowtok; int nmt, bx, G;
    __device__ __forceinline__ bool get(int i, Tile& t) const {
        int mt, nt; if (!tile_seq(i, bx, G, nmt, 8, mt, nt)) return false;
        const int c = tab[32 + mt], g = c / 6; int elo, ehi; pair_decode(c % 6, elo, ehi);
        t.al = RowsPlain{act, 1024};
        t.bl = RowsSplitK{wd + (size_t)(g * 4 + elo) * 1024 * 512, wd + (size_t)(g * 4 + ehi) * 1024 * 512, 512, 8};
        t.ep = EpiMoeB{F, li, rowtok};
        t.brow = mt * 256; t.bcol = nt * 128; return true; }
};
__device__ __forceinline__ void moe_gemm_a(const Frame& F, int li) {
    int* tab = (int*)(F.lds + LDS_TAB); moe_table(F, li, tab);
    const int nmt = tab[24] >> 8;
    pg8::MoeAOrder S8{F.W<u16>(WS_H), tab, F.W<int>(WS_ROWTOK), F.W<u16>(WS_MOEW), nmt, F.bx, F.G}; pg8::EpiMoeA8 E8{F.W<u16>(MOE_ACT), F.W<float>(WS_ROWW)};
    pg8::gemm_phase(F.lds, 1024, 1024, S8, E8);
}
__device__ __forceinline__ void moe_gemm_b(const Frame& F, int li) {
    __syncthreads();
    for (int e = threadIdx.x; e < 5 * 256; e += NTHR) { const int mr = e >> 8, c4 = e & 255;
        *(f32x4*)(F.lds + lds_gate_off(mr) + c4 * 16) = *(const f32x4*)(F.W<float>(WS_MODS) + (size_t)(li * 5 + mr) * 6144 + 5 * 1024 + c4 * 4); }
    int* tab = (int*)(F.lds + LDS_TAB); moe_table(F, li, tab);
    const int nmt = tab[24] >> 8;
    MoeBOrder S8{F.W<u16>(MOE_ACT), tab, F.W<u16>(WS_MOEW + MOE_WGU_BYTES), nmt, F.bx, F.G}; EpiMoeB8 E8{res_ctx(F), li, F.W<int>(WS_ROWTOK), F.lds};
    pg8::gemm_phase(F.lds, 1024, 1024, S8, E8);
}
__device__ __forceinline__ void final_norm(const Frame& F) {
    const int lane = threadIdx.x & 63, wid = threadIdx.x >> 6;
    f32x4 g[4], vn[4][4];
#pragma unroll
    for (int i = 0; i < 4; ++i) g[i] = *(const f32x4*)(F.in(30) + i * 256 + lane * 4);
    const int stride = F.G * NWAVE, r0 = F.bx * NWAVE + wid;
#define FN_LOAD(K0) do { _Pragma("unroll") for (int u = 0; u < 4; ++u) { int _r = r0 + ((K0) + u) * stride; if (_r >= NLAT) _r = r0; const float* xr = F.out + (size_t)_r * DM; \
        _Pragma("unroll") for (int i = 0; i < 4; ++i) vn[u][i] = *(const f32x4*)(xr + i * 256 + lane * 4); } } while (0)
    FN_LOAD(0);
    for (int k0 = 0; r0 + k0 * stride < NLAT; k0 += 4) {
        f32x4 v[4][4];
#pragma unroll
        for (int u = 0; u < 4; ++u)
#pragma unroll
            for (int i = 0; i < 4; ++i) v[u][i] = vn[u][i];
        if (r0 + (k0 + 4) * stride < NLAT) FN_LOAD(k0 + 4);
#pragma unroll
        for (int u = 0; u < 4; ++u) { const int row = r0 + (k0 + u) * stride;
            float ss = 0;
#pragma unroll
            for (int i = 0; i < 4; ++i) ss += v[u][i][0] * v[u][i][0] + v[u][i][1] * v[u][i][1] + v[u][i][2] * v[u][i][2] + v[u][i][3] * v[u][i][3];
            ss = wave_sum_fast(ss); const float rinv = rsqrtf(ss * (1.f / DM) + EPS);
            if (row < NLAT) { float* xr = F.out + (size_t)row * DM;
#pragma unroll
                for (int i = 0; i < 4; ++i) { f32x4 o = {v[u][i][0] * rinv * g[i][0], v[u][i][1] * rinv * g[i][1], v[u][i][2] * rinv * g[i][2], v[u][i][3] * rinv * g[i][3]};
                    *(f32x4*)(xr + i * 256 + lane * 4) = o; } } }
    }
#undef FN_LOAD
}

constexpr int N_PHASES = 42;
__global__ void __launch_bounds__(NTHR, 2) fwd_kernel(Params p) {
    extern __shared__ __attribute__((aligned(16))) char lds[];
    Frame F; F.p = &p; F.ws = p.ws; F.lds = lds; F.out = p.out; F.G = (int)gridDim.x; F.bx = (int)blockIdx.x;
    const int lo = p.ph_lo, hi = p.ph_hi;
#if !MK_PER_PHASE
    if (threadIdx.x == 0) *(uint4*)(lds + LDS_BARW) = make_uint4(0u, 0u, 0u, 0u);
    __syncthreads();
    XcdBarrier bar = xcd_barrier_post((unsigned*)(p.ws + WS_CTL), (volatile LAS unsigned*)(lds + LDS_BARW));
#define GRID_BAR() xcd_barrier(bar)
#else
#define GRID_BAR() do {} while (0)
#endif
#ifndef MK_EN
#define MK_EN 0xFFFFFFFFu
#endif
#define EN(g) (((MK_EN) >> (g)) & 1u)
#ifndef MK_REP
#define MK_REP 0u
#endif
#define REP(g) (((MK_REP) >> (g)) & 1u)
#define IN(k) (lo <= (k) && (k) < hi)
#define SEAM(k) do { if ((k) + 1 < hi) GRID_BAR(); } while (0)
#define DUP(g, body) do { body; if (REP(g)) { GRID_BAR(); body; } } while (0)

    if (EN(0) && IN(0)) { DUP(0, (p0_mods(F), __syncthreads(), p0_rope(F), p0_weights(F))); SEAM(0); }

#define LAYER(LI) { constexpr int li = (LI); constexpr int base = 1 + li * 10; constexpr bool first = li == 0, last = li == DEPTH - 1; constexpr int kind = li % 3, j = li / 3; \
        if (EN(1) && IN(base + 0)) { DUP(1, norm_phase<false>(F, li, 0, first)); SEAM(base + 0); } \
        if constexpr (kind == 0) { \
            if (EN(2) && IN(base + 1)) { EpiMlaDown ep{F.W<u16>(MLA_CN), F.W<float>(MLA_DQ), F.W<u16>(MLA_KPE), F.W<unsigned>(WS_CTL) + CW_PEMAX + li * 4}; \
                gemm_phase<4, 2>(F, RowsPlain{F.W<u16>(WS_H), 1024}, RowsPlain{F.W<u16>(WS_WDQKV) + (size_t)j * 640 * 1024, 1024}, ep, 0, 132, 5, 16, 0, 0); SEAM(base + 1); } \
            if (EN(2) && IN(base + 3)) { pg8::MlaUpOrder S8{F.W<u16>(MLA_CN), F.W<u16>(WS_WUQ) + (size_t)j * 1536 * 256, F.W<u16>(WS_WUKV) + (size_t)j * 2048 * 256, F.bx, F.G}; \
                pg8::EpiMlaUp8 E8{F.W<u16>(MLA_Q), F.W<u16>(MLA_KN), (long)((MLA_V - MLA_KN) / 2), 0.10206207261596577f * LOG2E, F.W<unsigned>(WS_CTL) + CW_KMAX + li * 128, F.W<float>(MLA_DQ)}; \
                pg8::gemm_phase(F.lds, 512, 256, S8, E8); SEAM(base + 3); } \
            if (EN(4) && IN(base + 4)) { DUP(4, mla_attn(F, !last, li)); SEAM(base + 4); } \
            if (EN(2) && IN(base + 5)) { pg8::SeqOrder S8{F.W<u16>(MLA_DQ), F.W<u16>(WS_WOM) + (size_t)j * 1024 * 1024, 1024, last ? 128 : 132, 4, F.bx, F.G, last ? 4 : 0}; EpiResid8 E8{res_ctx(F, first), li}; \
                pg8::gemm_phase(F.lds, 1024, 1024, S8, E8); SEAM(base + 5); } \
        } else if constexpr (kind == 1) { \
            if (EN(5) && IN(base + 1)) { pg8::SeqOrder S8{F.W<u16>(WS_H), F.W<u16>(WS_WQKVD), 1024, 132, 12, F.bx, F.G, 0}; pg8::EpiDiffQKV8 E8{F.W<u16>(DF_Q), (long)((DF_K - DF_Q) / 2), F.W<u16>(DF_V), 0.125f * LOG2E, F.W<unsigned>(WS_CTL) + CW_KMAX + li * 128}; \
                pg8::gemm_phase(F.lds, 1024, 1024, S8, E8); \
                if (REP(5)) { GRID_BAR(); pg8::gemm_phase(F.lds, 1024, 1024, S8, E8); } SEAM(base + 1); } \
            if (EN(6) && IN(base + 2)) { DUP(6, diff_attn(F, li)); SEAM(base + 2); } \
            if (EN(7) && IN(base + 3)) { DUP(7, diff_rowpass(F, 0.35550906759906f)); SEAM(base + 3); } \
            if (EN(5) && IN(base + 4)) { pg8::SeqOrder S8{F.W<u16>(DF_Q), F.W<u16>(WS_WOD), 1024, 132, 4, F.bx, F.G, 0}; EpiResid8 E8{res_ctx(F, first), li}; \
                pg8::gemm_phase(F.lds, 1024, 1024, S8, E8); SEAM(base + 4); } \
        } else { \
            if (EN(8) && IN(base + 1)) { pg8::SeqOrder S8{F.W<u16>(WS_H), F.W<u16>(WS_WING), 1024, 132, 13, F.bx, F.G, 0}; pg8::EpiGlaIn8 E8{F.W<u16>(GL_Q), F.W<u16>(GL_K), F.W<u16>(GL_V), F.W<u16>(GL_G), F.W<float>(GL_Z)}; \
                pg8::gemm_phase(F.lds, 1024, 1024, S8, E8); \
                if (REP(8)) { GRID_BAR(); pg8::gemm_phase(F.lds, 1024, 1024, S8, E8); } SEAM(base + 1); } \
            if (EN(9) && IN(base + 2)) { DUP(9, gla_g1(F)); SEAM(base + 2); } \
            if (EN(10) && IN(base + 3)) { gla_g2(F); SEAM(base + 3); } \
            if (EN(11) && IN(base + 4)) { DUP(11, gla_g3(F)); SEAM(base + 4); } \
            if (EN(8) && IN(base + 5)) { pg8::SeqOrder S8{F.W<u16>(WS_H), F.W<u16>(WS_WOG), 1024, 132, 4, F.bx, F.G, 0}; EpiResid8 E8{res_ctx(F, first), li}; \
                pg8::gemm_phase(F.lds, 1024, 1024, S8, E8); SEAM(base + 5); } \
        } \
        if (EN(12) && IN(base + 6)) { norm_phase<true>(F, li, last ? NCTX : 0, false); SEAM(base + 6); } \
        if (EN(13) && IN(base + 7)) { DUP(13, ((kind == 2 ? moe_weights(F, li) : (void)0), moe_scatter(F, li, last ? NCTX : 0))); SEAM(base + 7); } \
        if (EN(14) && IN(base + 8)) { DUP(14, moe_gemm_a(F, li)); SEAM(base + 8); } \
        if (EN(15) && IN(base + 9)) { moe_gemm_b(F, li); SEAM(base + 9); } \
    }
    LAYER(0) LAYER(1) LAYER(2) LAYER(3)
    if (EN(16) && IN(41)) { final_norm(F); }
}

extern "C" void kernel_launch(void* const* d_in, const int* in_sizes, int n_in, void* d_out, int out_size, void* d_ws, size_t ws_size, hipStream_t stream) {
    static int grid = 0;
    if (grid == 0) {
        if (n_in != 31 || out_size != NLAT * DM || ws_size < WS_END) {
            fprintf(stderr, "kernel_launch: built for 31 inputs, out %d floats, ws >= %zu bytes; got n_in %d out %d ws %zu\n", NLAT * DM, (size_t)WS_END, n_in, out_size, ws_size);
            grid = -1; return; }
        int dev = 0, cus = 0;
        if (hipGetDevice(&dev) != hipSuccess || hipDeviceGetAttribute(&cus, hipDeviceAttributeMultiprocessorCount, dev) != hipSuccess) { grid = -1; return; }
        if (hipFuncSetAttribute((const void*)fwd_kernel, hipFuncAttributeMaxDynamicSharedMemorySize, LDS_BYTES) != hipSuccess) { fprintf(stderr, "kernel_launch: hipFuncSetAttribute failed\n"); grid = -1; return; }
        int per_cu = 0;
        if (hipOccupancyMaxActiveBlocksPerMultiprocessor(&per_cu, (const void*)fwd_kernel, NTHR, LDS_BYTES) != hipSuccess || per_cu < 1)
            fprintf(stderr, "kernel_launch: occupancy query reports %d workgroups per CU\n", per_cu);
        (void)hipGetLastError();
        grid = cus;
    }
    if (grid < 0) return;
    (void)in_sizes;
    (void)hipMemsetAsync((char*)d_ws + WS_CTL, 0, CTL_BYTES, stream);
    Params p{};
    for (int i = 0; i < 31; ++i) p.in[i] = (const float*)d_in[i];
    p.out = (float*)d_out; p.ws = (unsigned char*)d_ws;
#if MK_PER_PHASE
    for (int ph = 0; ph < N_PHASES; ++ph) { p.ph_lo = ph; p.ph_hi = ph + 1; hipLaunchKernelGGL(fwd_kernel, dim3(grid), dim3(NTHR), LDS_BYTES, stream, p); }
#else
#ifdef MK_PROBE_HI
    p.ph_lo = 0; p.ph_hi = MK_PROBE_HI;
    hipLaunchKernelGGL(fwd_kernel, dim3(grid), dim3(NTHR), LDS_BYTES, stream, p);
    (void)hipMemsetAsync((char*)d_ws + WS_CTL, 0, CTL_BYTES, stream);
#endif
    p.ph_lo = 0; p.ph_hi = N_PHASES;
    hipLaunchKernelGGL(fwd_kernel, dim3(grid), dim3(NTHR), LDS_BYTES, stream, p);
#endif
}
```
